# Optimizing an MI355X kernel written in HIP

```python
import jax
import jax.numpy as jnp
from jax import lax
import numpy as np


D_MODEL = 2048
BATCH = 2
SEQ = 4096
DEPTH = 1

HEAD_DIM = 128
ROPE_THETA = 10000.0
GRID_W = 64
DIL_PATTERNS = ((128, 1), (512, 4), (2048, 16))
N_DIL = len(DIL_PATTERNS)
A_HEADS = 8
A_QKV = N_DIL * A_HEADS * HEAD_DIM
A_OUT = A_HEADS * HEAD_DIM
A_QBLOCK = 64
B_Q_HEADS = 16
B_KV_HEADS = 4
B_GROUP = B_Q_HEADS // B_KV_HEADS
B_Q = B_Q_HEADS * HEAD_DIM
B_KV = B_KV_HEADS * HEAD_DIM
B_QBLOCK = 128
N_BRANCH = 2
IN_COLS = 3 * A_QKV + B_Q + 2 * B_KV + N_BRANCH * D_MODEL
N_GROUPS = 4
EXPERTS_PER_GROUP = 8
N_EXPERTS = N_GROUPS * EXPERTS_PER_GROUP
TOP_K = 2
EXPERT_FF = 1024
MOE_BLOCK = 128
DN_ALPHA = (2 * DEPTH) ** 0.25
DN_BETA = (8 * DEPTH) ** -0.25
LN_EPS = 1e-5
RMS_EPS = 1e-6
NEG_INF = -1e30

kernel_name = 'hybrid_dilated_axial_hmoe_encoder'


def layer_norm(x, g, b):
    xf = x.astype(jnp.float32)
    mu = xf.mean(-1, keepdims=True)
    var = jnp.square(xf - mu).mean(-1, keepdims=True)
    y = (xf - mu) * lax.rsqrt(var + LN_EPS) * g.astype(jnp.float32) + b.astype(jnp.float32)
    return y.astype(x.dtype)


def rms_norm(x, g):
    xf = x.astype(jnp.float32)
    y = xf * lax.rsqrt(jnp.mean(xf * xf, -1, keepdims=True) + RMS_EPS) * g.astype(jnp.float32)
    return y.astype(x.dtype)


def rope_1d_angles(seq):
    half = HEAD_DIM // 2
    inv = ROPE_THETA ** (-jnp.arange(half, dtype=jnp.float32) / half)
    return jnp.arange(seq, dtype=jnp.float32)[:, None] * inv[None, :]


def rope_axial_angles(seq):
    rows = seq // GRID_W
    r, c = jnp.meshgrid(jnp.arange(rows, dtype=jnp.float32), jnp.arange(GRID_W, dtype=jnp.float32), indexing='ij')
    n_axis = HEAD_DIM // 4
    inv = ROPE_THETA ** (-jnp.arange(n_axis, dtype=jnp.float32) / n_axis)
    return jnp.concatenate([r.reshape(-1, 1) * inv[None, :], c.reshape(-1, 1) * inv[None, :]], axis=-1)


def apply_rope(x, ang):
    xf = x.astype(jnp.float32)
    half = HEAD_DIM // 2
    x1, x2 = xf[..., :half], xf[..., half:]
    cos = jnp.cos(ang)[None, :, None, :]
    sin = jnp.sin(ang)[None, :, None, :]
    return jnp.concatenate([x1 * cos - x2 * sin, x2 * cos + x1 * sin], axis=-1).astype(x.dtype)


def dilated_window_attention(q, k, v, window, dilation):
    bsz, seq, nh, hd = q.shape
    half = window // (2 * dilation)
    sub_len = seq // dilation
    n_blk = -(-sub_len // A_QBLOCK)
    sub_pad = n_blk * A_QBLOCK
    kb_len = A_QBLOCK + 2 * half

    def to_residues(t):
        return t.reshape(bsz, sub_len, dilation, nh, hd).transpose(0, 2, 3, 1, 4)

    qr = jnp.pad(to_residues(q), ((0, 0), (0, 0), (0, 0), (0, sub_pad - sub_len), (0, 0)))
    qr = qr.reshape(bsz, dilation, nh, n_blk, A_QBLOCK, hd)
    kpad = ((0, 0), (0, 0), (0, 0), (half, sub_pad - sub_len + half), (0, 0))
    kr = jnp.pad(to_residues(k), kpad)
    vr = jnp.pad(to_residues(v), kpad)
    key_idx = jnp.arange(n_blk)[:, None] * A_QBLOCK + jnp.arange(kb_len)[None, :]
    kb = kr[:, :, :, key_idx]
    vb = vr[:, :, :, key_idx]
    key_pos = (key_idx - half)[:, None, :]
    q_pos = jnp.arange(sub_pad).reshape(n_blk, A_QBLOCK)[:, :, None]
    mask = (jnp.abs(key_pos - q_pos) <= half) & (key_pos >= 0) & (key_pos < sub_len)
    s = jnp.einsum('bdhnqe,bdhnke->bdhnqk', qr, kb, preferred_element_type=jnp.float32) * (HEAD_DIM ** -0.5)
    s = jnp.where(mask, s, NEG_INF)
    m = jnp.max(s, axis=-1, keepdims=True)
    lse = m + jnp.log(jnp.sum(jnp.exp(s - m), axis=-1, keepdims=True))
    p = jnp.exp(s - lse)
    o = jnp.einsum('bdhnqk,bdhnke->bdhnqe', p.astype(vb.dtype), vb)
    o = o.reshape(bsz, dilation, nh, sub_pad, hd)[:, :, :, :sub_len]
    o = o.transpose(0, 3, 1, 2, 4).reshape(bsz, seq, nh, hd)
    lse = lse[..., 0].reshape(bsz, dilation, nh, sub_pad)[:, :, :, :sub_len]
    lse = lse.transpose(0, 3, 1, 2).reshape(bsz, seq, nh)
    return o, lse


def gqa_block_sweep(q, k, v):
    bsz, seq = q.shape[0], q.shape[1]
    nqb = seq // B_QBLOCK
    qb = q.reshape(bsz, nqb, B_QBLOCK, B_KV_HEADS, B_GROUP, HEAD_DIM).transpose(1, 0, 3, 4, 2, 5)
    kt = k.transpose(0, 2, 1, 3)
    vt = v.transpose(0, 2, 1, 3)

    def one_block(qblk):
        s = jnp.einsum('bhgqe,bhke->bhgqk', qblk, kt, preferred_element_type=jnp.float32) * (HEAD_DIM ** -0.5)
        p = jax.nn.softmax(s, axis=-1)
        return jnp.einsum('bhgqk,bhke->bhgqe', p.astype(vt.dtype), vt)

    o = lax.map(one_block, qb)
    return o.transpose(1, 0, 4, 2, 3, 5).reshape(bsz, seq, B_Q)


def hybrid_mixer(x, w_in, q_norm_g, k_norm_g, w_branch_a, w_branch_b, w_out):
    bsz, seq, _ = x.shape
    proj = x @ w_in
    cuts = [A_QKV, 2 * A_QKV, 3 * A_QKV, 3 * A_QKV + B_Q, 3 * A_QKV + B_Q + B_KV, 3 * A_QKV + B_Q + 2 * B_KV]
    qa, ka, va, qb, kb, vb, gate_logits = jnp.split(proj, cuts, axis=-1)

    ang1 = rope_1d_angles(seq)
    qa = apply_rope(qa.reshape(bsz, seq, N_DIL * A_HEADS, HEAD_DIM), ang1).reshape(bsz, seq, N_DIL, A_HEADS, HEAD_DIM)
    ka = apply_rope(ka.reshape(bsz, seq, N_DIL * A_HEADS, HEAD_DIM), ang1).reshape(bsz, seq, N_DIL, A_HEADS, HEAD_DIM)
    va = va.reshape(bsz, seq, N_DIL, A_HEADS, HEAD_DIM)
    outs, lses = [], []
    for gi, (window, dilation) in enumerate(DIL_PATTERNS):
        o, l = dilated_window_attention(qa[:, :, gi], ka[:, :, gi], va[:, :, gi], window, dilation)
        outs.append(o)
        lses.append(l)
    wts = jax.nn.softmax(jnp.stack(lses, axis=0), axis=0)
    o_a = jnp.sum(wts[..., None] * jnp.stack(outs, axis=0).astype(jnp.float32), axis=0)
    o_a = o_a.astype(x.dtype).reshape(bsz, seq, A_OUT)

    ang2 = rope_axial_angles(seq)
    qb = apply_rope(rms_norm(qb.reshape(bsz, seq, B_Q_HEADS, HEAD_DIM), q_norm_g), ang2)
    kb = apply_rope(rms_norm(kb.reshape(bsz, seq, B_KV_HEADS, HEAD_DIM), k_norm_g), ang2)
    vb = vb.reshape(bsz, seq, B_KV_HEADS, HEAD_DIM)
    o_b = gqa_block_sweep(qb, kb, vb)

    gates = jax.nn.sigmoid(gate_logits.astype(jnp.float32)).reshape(bsz, seq, N_BRANCH, D_MODEL)
    y_a = (o_a @ w_branch_a).astype(jnp.float32)
    y_b = (o_b @ w_branch_b).astype(jnp.float32)
    merged = (gates[:, :, 0] * y_a + gates[:, :, 1] * y_b).astype(x.dtype)
    return merged @ w_out


def hierarchical_moe(h, w_group, b_group, w_router, b_router, w_gate, w_up, w_down):
    bsz, seq, dm = h.shape
    xt = h.reshape(-1, dm)
    n_tok = xt.shape[0]
    g_logits = (xt @ w_group).astype(jnp.float32) + b_group.astype(jnp.float32)
    g_prob = jax.nn.softmax(g_logits, axis=-1)
    g_idx = jnp.argmax(g_logits, axis=-1)
    g_gate = jnp.take_along_axis(g_prob, g_idx[:, None], axis=1)[:, 0]
    e_logits = (xt @ w_router).astype(jnp.float32) + b_router.astype(jnp.float32)
    e_logits = e_logits.reshape(n_tok, N_GROUPS, EXPERTS_PER_GROUP)
    e_logits = jnp.take_along_axis(e_logits, g_idx[:, None, None], axis=1)[:, 0]
    e_prob = jax.nn.softmax(e_logits, axis=-1)
    top_p, top_i = lax.top_k(e_prob, TOP_K)
    top_p = top_p / jnp.sum(top_p, axis=-1, keepdims=True)
    weights = g_gate[:, None] * top_p
    expert = g_idx[:, None] * EXPERTS_PER_GROUP + top_i

    n_slot = n_tok * TOP_K
    e_flat = expert.reshape(n_slot).astype(jnp.int32)
    t_flat = jnp.repeat(jnp.arange(n_tok, dtype=jnp.int32), TOP_K)
    w_flat = weights.reshape(n_slot)
    order = jnp.argsort(e_flat)
    e_sorted = e_flat[order]
    t_sorted = t_flat[order]
    w_sorted = w_flat[order]
    counts = jnp.bincount(e_flat, length=N_EXPERTS).astype(jnp.int32)
    starts = jnp.cumsum(counts) - counts
    padded = ((counts + MOE_BLOCK - 1) // MOE_BLOCK) * MOE_BLOCK
    p_ends = jnp.cumsum(padded)
    p_starts = p_ends - padded
    dest = p_starts[e_sorted] + (jnp.arange(n_slot, dtype=jnp.int32) - starts[e_sorted])
    buf_len = n_slot + N_EXPERTS * MOE_BLOCK
    n_blocks = buf_len // MOE_BLOCK
    tok_buf = jnp.zeros((buf_len,), jnp.int32).at[dest].set(t_sorted)
    w_buf = jnp.zeros((buf_len,), jnp.float32).at[dest].set(w_sorted)
    x_buf = xt[tok_buf].reshape(n_blocks, MOE_BLOCK, dm)
    block_start = jnp.arange(n_blocks, dtype=jnp.int32) * MOE_BLOCK
    block_expert = jnp.clip(jnp.searchsorted(p_ends, block_start, side='right'), 0, N_EXPERTS - 1)

    def expert_block(args):
        xb, e = args
        a = xb @ w_gate[e]
        u = xb @ w_up[e]
        return (jax.nn.silu(a) * u) @ w_down[e]

    y_buf = lax.map(expert_block, (x_buf, block_expert)).reshape(buf_len, dm)
    out = jnp.zeros((n_tok, dm), jnp.float32).at[tok_buf].add(y_buf.astype(jnp.float32) * w_buf[:, None])
    return out.astype(h.dtype).reshape(bsz, seq, dm)


def setup_inputs(seed: int = 0) -> dict:
    key = jax.random.key(seed)
    ks = jax.random.split(key, 18)

    def nrm(k, shape, scale):
        return jax.random.normal(k, shape, jnp.float32) * scale

    return {
        'x': nrm(ks[0], (BATCH, SEQ, D_MODEL), 1.0),
        'w_in': nrm(ks[1], (DEPTH, D_MODEL, IN_COLS), D_MODEL ** -0.5),
        'q_norm_g': 1.0 + nrm(ks[2], (DEPTH, HEAD_DIM), 0.02),
        'k_norm_g': 1.0 + nrm(ks[3], (DEPTH, HEAD_DIM), 0.02),
        'w_branch_a': nrm(ks[4], (DEPTH, A_OUT, D_MODEL), A_OUT ** -0.5),
        'w_branch_b': nrm(ks[5], (DEPTH, B_Q, D_MODEL), B_Q ** -0.5),
        'w_out': nrm(ks[6], (DEPTH, D_MODEL, D_MODEL), D_MODEL ** -0.5 * DN_BETA),
        'ln1_g': 1.0 + nrm(ks[7], (DEPTH, D_MODEL), 0.02),
        'ln1_b': nrm(ks[8], (DEPTH, D_MODEL), 0.02),
        'w_group': nrm(ks[9], (DEPTH, D_MODEL, N_GROUPS), D_MODEL ** -0.5),
        'b_group': nrm(ks[10], (DEPTH, N_GROUPS), 0.01),
        'w_router': nrm(ks[11], (DEPTH, D_MODEL, N_EXPERTS), D_MODEL ** -0.5),
        'b_router': nrm(ks[12], (DEPTH, N_EXPERTS), 0.01),
        'w_gate': nrm(ks[13], (DEPTH, N_EXPERTS, D_MODEL, EXPERT_FF), D_MODEL ** -0.5),
        'w_up': nrm(ks[14], (DEPTH, N_EXPERTS, D_MODEL, EXPERT_FF), D_MODEL ** -0.5),
        'w_down': nrm(ks[15], (DEPTH, N_EXPERTS, EXPERT_FF, D_MODEL), EXPERT_FF ** -0.5 * DN_BETA),
        'ln2_g': 1.0 + nrm(ks[16], (DEPTH, D_MODEL), 0.02),
        'ln2_b': nrm(ks[17], (DEPTH, D_MODEL), 0.02),
    }


def reference(x, w_in, q_norm_g, k_norm_g, w_branch_a, w_branch_b, w_out, ln1_g, ln1_b, w_group, b_group, w_router, b_router, w_gate, w_up, w_down, ln2_g, ln2_b):
    h = x
    for layer in range(DEPTH):
        mix = hybrid_mixer(h, w_in[layer], q_norm_g[layer], k_norm_g[layer], w_branch_a[layer], w_branch_b[layer], w_out[layer])
        h = layer_norm(DN_ALPHA * h + mix, ln1_g[layer], ln1_b[layer])
        ffn = hierarchical_moe(h, w_group[layer], b_group[layer], w_router[layer], b_router[layer], w_gate[layer], w_up[layer], w_down[layer])
        h = layer_norm(DN_ALPHA * h + ffn, ln2_g[layer], ln2_b[layer])
    return h
```

```cpp
#include <hip/hip_runtime.h>
#include <cstdio>
#include <cstdint>

typedef unsigned short bf16_t;
typedef short bf16x8 __attribute__((ext_vector_type(8)));
typedef float f32x4 __attribute__((ext_vector_type(4)));
typedef unsigned u32x4 __attribute__((ext_vector_type(4)));

constexpr int NTOK = 8192, SEQ = 4096, DM = 2048, HD = 128;
constexpr int IN_COLS = 16384;
constexpr int NEXP = 32, FF = 1024;
constexpr float ALPHA = 1.189207115002721f;
constexpr float LN_EPS = 1e-5f, RMS_EPS = 1e-6f;
constexpr float SM_SCALE = 0.08838834764831845f;
constexpr int ECAP = 8192;

constexpr size_t MiB = 1u << 20;
constexpr size_t WS_CTL = 0;
constexpr size_t WS_WGUT = 1 * MiB;
constexpr size_t WS_WDT = 257 * MiB;
constexpr size_t WS_WAT = 385 * MiB;
constexpr size_t WS_WBT = 389 * MiB;
constexpr size_t WS_WOT = 397 * MiB;
constexpr size_t WS_XB = 405 * MiB;
constexpr size_t WS_WINT = 437 * MiB;
constexpr size_t WS_QA = 501 * MiB;
constexpr size_t WS_KA = 549 * MiB;
constexpr size_t WS_VA = 597 * MiB;
constexpr size_t WS_QB = 645 * MiB;
constexpr size_t WS_KB = 677 * MiB;
constexpr size_t WS_VB = 685 * MiB;
constexpr size_t WS_GATES = 693 * MiB;
constexpr size_t WS_OAG = 757 * MiB;
constexpr size_t WS_LSE = 805 * MiB;
constexpr size_t WS_OA = 806 * MiB;
constexpr size_t WS_OB = 822 * MiB;
constexpr size_t WS_T = 405 * MiB;
constexpr size_t WS_MERGED = 469 * MiB;
constexpr size_t WS_PRE1 = 501 * MiB;
constexpr size_t WS_H1 = 565 * MiB;
constexpr size_t WS_H1B = 629 * MiB;
constexpr size_t WS_TOKIDX = 661 * MiB;
constexpr size_t WS_SLOT = 662 * MiB;
constexpr size_t WS_ACT = 693 * MiB;
constexpr size_t WS_Y = 757 * MiB;
constexpr size_t WS_END = 854 * MiB;
constexpr int CW_CNT = 64;

__device__ __forceinline__ float bf2f(bf16_t v) { return __uint_as_float(((unsigned)v) << 16); }
__device__ __forceinline__ bf16_t f2bf(float f) { unsigned u = __float_as_uint(f); u += 0x7fffu + ((u >> 16) & 1u); return (bf16_t)(u >> 16); }
__device__ __forceinline__ unsigned pk2(float lo, float hi) { return (unsigned)f2bf(lo) | ((unsigned)f2bf(hi) << 16); }
__device__ __forceinline__ float wave_sum(float v) {
#pragma unroll
    for (int o = 1; o < 64; o <<= 1) v += __shfl_xor(v, o);
    return v;
}

__device__ const float INV64[64] = {
    1.000000000e+00f, 8.659643234e-01f, 7.498942093e-01f, 6.493816316e-01f, 5.623413252e-01f, 4.869675252e-01f, 4.216965034e-01f, 3.651741273e-01f,
    3.162277660e-01f, 2.738419634e-01f, 2.371373706e-01f, 2.053525026e-01f, 1.778279410e-01f, 1.539926526e-01f, 1.333521432e-01f, 1.154781985e-01f,
    1.000000000e-01f, 8.659643234e-02f, 7.498942093e-02f, 6.493816316e-02f, 5.623413252e-02f, 4.869675252e-02f, 4.216965034e-02f, 3.651741273e-02f,
    3.162277660e-02f, 2.738419634e-02f, 2.371373706e-02f, 2.053525026e-02f, 1.778279410e-02f, 1.539926526e-02f, 1.333521432e-02f, 1.154781985e-02f,
    1.000000000e-02f, 8.659643234e-03f, 7.498942093e-03f, 6.493816316e-03f, 5.623413252e-03f, 4.869675252e-03f, 4.216965034e-03f, 3.651741273e-03f,
    3.162277660e-03f, 2.738419634e-03f, 2.371373706e-03f, 2.053525026e-03f, 1.778279410e-03f, 1.539926526e-03f, 1.333521432e-03f, 1.154781985e-03f,
    1.000000000e-03f, 8.659643234e-04f, 7.498942093e-04f, 6.493816316e-04f, 5.623413252e-04f, 4.869675252e-04f, 4.216965034e-04f, 3.651741273e-04f,
    3.162277660e-04f, 2.738419634e-04f, 2.371373706e-04f, 2.053525026e-04f, 1.778279410e-04f, 1.539926526e-04f, 1.333521432e-04f, 1.154781985e-04f};

__device__ __forceinline__ void cs_angle(float ang, float& c, float& s) {
    const double a = (double)ang * 0.15915494309189535;
    const float f = (float)(a - floor(a));
    s = __builtin_amdgcn_sinf(f); c = __builtin_amdgcn_cosf(f);
}
__device__ __forceinline__ void rope1(int t, int i, float& c, float& s) { cs_angle((float)t * INV64[i], c, s); }
__device__ __forceinline__ void rope2(int t, int i, float& c, float& s) {
    const float p = (i < 32) ? (float)(t >> 6) : (float)(t & 63);
    cs_angle(p * INV64[2 * (i & 31)], c, s);
}
__device__ __forceinline__ int dil_of(int g) { return g == 0 ? 1 : (g == 1 ? 4 : 16); }
__device__ __forceinline__ int perm_pos(int g, int t) { const int sh = 2 * g; const int d = 1 << sh; return (t & (d - 1)) * (SEQ >> sh) + (t >> sh); }

__global__ void __launch_bounds__(256) k_cvt(const float* __restrict__ x, bf16_t* __restrict__ xb, size_t n8) {
    for (size_t i = (size_t)blockIdx.x * 256 + threadIdx.x; i < n8; i += (size_t)gridDim.x * 256) {
        const f32x4 a = *(const f32x4*)(x + i * 8), b = *(const f32x4*)(x + i * 8 + 4);
        u32x4 w; w.x = pk2(a.x, a.y); w.y = pk2(a.z, a.w); w.z = pk2(b.x, b.y); w.w = pk2(b.z, b.w);
        *(u32x4*)(xb + i * 8) = w;
    }
}
__global__ void __launch_bounds__(256) k_transpose(const float* __restrict__ src, bf16_t* __restrict__ dst, int K, int N, int rowblk, int roff, size_t sstride, size_t dstride) {
    __shared__ float tile[32][33];
    const float* s = src + (size_t)blockIdx.z * sstride; bf16_t* d = dst + (size_t)blockIdx.z * dstride;
    const int n0 = blockIdx.x * 32, k0 = blockIdx.y * 32, tx = threadIdx.x & 31, ty = threadIdx.x >> 5;
    for (int i = ty; i < 32; i += 8) tile[i][tx] = s[(size_t)(k0 + i) * N + n0 + tx];
    __syncthreads();
    for (int i = ty; i < 32; i += 8) { const int n = n0 + i; const int dr = (n >> 7) * rowblk + roff + (n & 127); d[(size_t)dr * K + k0 + tx] = f2bf(tile[tx][i]); }
}

__device__ __forceinline__ void wave_gemm16x128(const bf16_t* arow, const bf16_t* bt, int ldb, int K, f32x4 (&acc)[8]) {
    const int lane = threadIdx.x & 63, fr = lane & 15, fq = lane >> 4;
    const bf16_t* ap = arow + fq * 8;
    const bf16_t* bp = bt + (size_t)fr * ldb + fq * 8;
    for (int k = 0; k < K; k += 32) {
        const bf16x8 a = *(const bf16x8*)(ap + k);
#pragma unroll
        for (int j = 0; j < 8; ++j) { const bf16x8 b = *(const bf16x8*)(bp + (size_t)j * 16 * ldb + k); acc[j] = __builtin_amdgcn_mfma_f32_16x16x32_bf16(a, b, acc[j], 0, 0, 0); }
    }
}

struct P1Args { const bf16_t* xb; const bf16_t* wint; const float* qg; const float* kg; bf16_t *qa, *ka, *va, *qb, *kb, *vb, *gates; };
__global__ void __launch_bounds__(256) k_proj(P1Args a) {
    const int wave = threadIdx.x >> 6, lane = threadIdx.x & 63, fr = lane & 15, fq = lane >> 4;
    const int ng = blockIdx.x, mt = blockIdx.y * 4 + wave;
    f32x4 acc[8];
#pragma unroll
    for (int j = 0; j < 8; ++j) acc[j] = (f32x4){0.f, 0.f, 0.f, 0.f};
    wave_gemm16x128(a.xb + (size_t)(mt * 16 + fr) * DM, a.wint + (size_t)ng * 128 * DM, DM, DM, acc);
#pragma unroll
    for (int r = 0; r < 4; ++r) {
        const int m = mt * 16 + fq * 4 + r, b = m >> 12, t = m & 4095;
        if (ng < 72) {
            const int which = ng / 24, hh = ng % 24, g = hh >> 3, h = hh & 7;
            bf16_t* base = (which == 0 ? a.qa : (which == 1 ? a.ka : a.va)) + ((size_t)((g * 2 + b) * 8 + h) * SEQ + perm_pos(g, t)) * HD;
#pragma unroll
            for (int j = 0; j < 4; ++j) { const int c = 16 * j + fr; float x1 = acc[j][r], x2 = acc[j + 4][r];
                if (which < 2) { float cs, sn; rope1(t, c, cs, sn); const float y1 = x1 * cs - x2 * sn, y2 = x2 * cs + x1 * sn; x1 = y1; x2 = y2; }
                base[c] = f2bf(x1); base[c + 64] = f2bf(x2); }
        } else if (ng < 96) {
            const int k = ng - 72;
            if (k < 20) {
                float ss = 0.f;
#pragma unroll
                for (int j = 0; j < 8; ++j) ss += acc[j][r] * acc[j][r];
                ss += __shfl_xor(ss, 1); ss += __shfl_xor(ss, 2); ss += __shfl_xor(ss, 4); ss += __shfl_xor(ss, 8);
                const float rinv = 1.0f / sqrtf(ss * (1.0f / 128.0f) + RMS_EPS);
                const float* gn = (k < 16) ? a.qg : a.kg;
                bf16_t* base = (k < 16) ? a.qb + ((size_t)(b * 16 + k) * SEQ + t) * HD : a.kb + ((size_t)(b * 4 + (k - 16)) * SEQ + t) * HD;
#pragma unroll
                for (int j = 0; j < 4; ++j) { const int c = 16 * j + fr; const float x1 = acc[j][r] * rinv * gn[c], x2 = acc[j + 4][r] * rinv * gn[c + 64];
                    float cs, sn; rope2(t, c, cs, sn); base[c] = f2bf(x1 * cs - x2 * sn); base[c + 64] = f2bf(x2 * cs + x1 * sn); }
            } else {
                bf16_t* base = a.vb + ((size_t)(b * 4 + (k - 20)) * SEQ + t) * HD;
#pragma unroll
                for (int j = 0; j < 8; ++j) base[16 * j + fr] = f2bf(acc[j][r]);
            }
        } else {
            bf16_t* base = a.gates + (size_t)m * 4096 + (ng - 96) * 128;
#pragma unroll
            for (int j = 0; j < 8; ++j) base[16 * j + fr] = f2bf(1.0f / (1.0f + __expf(-acc[j][r])));
        }
    }
}

struct P2Args { const bf16_t *q, *k, *v; bf16_t* o; float* lse; int mode; };
__global__ void __launch_bounds__(128) k_attn(P2Args a) {
    const int half = threadIdx.x & 1, qi = blockIdx.x * 64 + (threadIdx.x >> 1), sid = blockIdx.y;
    const bf16_t *Q, *K, *V; int k_lo, k_hi;
    if (a.mode == 0) { const int b = sid >> 4, hq = sid & 15; Q = a.q + (size_t)sid * SEQ * HD; K = a.k + (size_t)(b * 4 + (hq >> 2)) * SEQ * HD; V = a.v + (size_t)(b * 4 + (hq >> 2)) * SEQ * HD; k_lo = 0; k_hi = SEQ - 1; }
    else { const int g = sid >> 4; const int L = SEQ >> (2 * g); Q = a.q + (size_t)sid * SEQ * HD; K = a.k + (size_t)sid * SEQ * HD; V = a.v + (size_t)sid * SEQ * HD;
        const int r0 = (qi / L) * L, p = qi - r0; k_lo = r0 + (p - 64 > 0 ? p - 64 : 0); k_hi = r0 + (p + 64 < L - 1 ? p + 64 : L - 1); }
    float q[64], o[64];
    { const bf16_t* qp = Q + (size_t)qi * HD + half * 64;
#pragma unroll
      for (int d = 0; d < 64; ++d) { q[d] = bf2f(qp[d]) * SM_SCALE; o[d] = 0.f; } }
    float m = -1e30f, l = 0.f;
    for (int kk = k_lo; kk <= k_hi; ++kk) {
        const bf16_t* kp = K + (size_t)kk * HD + half * 64; const bf16_t* vp = V + (size_t)kk * HD + half * 64;
        float s = 0.f;
#pragma unroll
        for (int d = 0; d < 64; ++d) s += q[d] * bf2f(kp[d]);
        s += __shfl_xor(s, 1);
        const float mn = fmaxf(m, s), al = __expf(m - mn), p = __expf(s - mn);
        l = l * al + p; m = mn;
#pragma unroll
        for (int d = 0; d < 64; ++d) o[d] = o[d] * al + p * bf2f(vp[d]);
    }
    const float rl = 1.0f / l;
    if (a.mode == 0) { const int b = sid >> 4, hq = sid & 15; bf16_t* op = a.o + (size_t)(b * SEQ + qi) * 2048 + hq * HD + half * 64;
#pragma unroll
        for (int d = 0; d < 64; ++d) op[d] = f2bf(o[d] * rl); }
    else { const int g = sid >> 4, b = (sid >> 3) & 1, h = sid & 7; const int sh = 2 * g, L = SEQ >> sh; const int r = qi / L, p = qi - r * L, t = (p << sh) + r;
        const size_t mrow = (size_t)b * SEQ + t;
        bf16_t* op = a.o + ((size_t)g * NTOK + mrow) * 1024 + h * HD + half * 64;
#pragma unroll
        for (int d = 0; d < 64; ++d) op[d] = f2bf(o[d] * rl);
        if (half == 0) a.lse[((size_t)g * NTOK + mrow) * 8 + h] = m + __logf(l); }
}
__global__ void __launch_bounds__(256) k_merge(const bf16_t* __restrict__ oag, const float* __restrict__ lse, bf16_t* __restrict__ oa) {
    const size_t i = (size_t)blockIdx.x * 256 + threadIdx.x;
    const size_t m = i >> 10; const int c = (int)(i & 1023), h = c >> 7;
    const float l0 = lse[(0 * (size_t)NTOK + m) * 8 + h], l1 = lse[(1 * (size_t)NTOK + m) * 8 + h], l2 = lse[(2 * (size_t)NTOK + m) * 8 + h];
    const float mx = fmaxf(l0, fmaxf(l1, l2)); const float e0 = __expf(l0 - mx), e1 = __expf(l1 - mx), e2 = __expf(l2 - mx); const float inv = 1.0f / (e0 + e1 + e2);
    const float v = (e0 * bf2f(oag[(0 * (size_t)NTOK + m) * 1024 + c]) + e1 * bf2f(oag[(1 * (size_t)NTOK + m) * 1024 + c]) + e2 * bf2f(oag[(2 * (size_t)NTOK + m) * 1024 + c])) * inv;
    oa[i] = f2bf(v);
}

struct P3Args { const bf16_t* A; const bf16_t* Bt; int K; const bf16_t* gates; float* T; bf16_t* merged; const float* x; float* pre1; int mode; };
__global__ void __launch_bounds__(256) k_gemm3(P3Args a) {
    const int wave = threadIdx.x >> 6, lane = threadIdx.x & 63, fr = lane & 15, fq = lane >> 4;
    const int ng = blockIdx.x, mt = blockIdx.y * 4 + wave;
    f32x4 acc[8];
#pragma unroll
    for (int j = 0; j < 8; ++j) acc[j] = (f32x4){0.f, 0.f, 0.f, 0.f};
    wave_gemm16x128(a.A + (size_t)(mt * 16 + fr) * a.K, a.Bt + (size_t)ng * 128 * a.K, a.K, a.K, acc);
#pragma unroll
    for (int r = 0; r < 4; ++r) { const size_t m = (size_t)mt * 16 + fq * 4 + r;
#pragma unroll
        for (int j = 0; j < 8; ++j) { const int c = ng * 128 + 16 * j + fr; const size_t o = m * DM + c;
            if (a.mode == 0) a.T[o] = bf2f(a.gates[m * 4096 + c]) * acc[j][r];
            else if (a.mode == 1) a.merged[o] = f2bf(a.T[o] + bf2f(a.gates[m * 4096 + 2048 + c]) * acc[j][r]);
            else a.pre1[o] = ALPHA * a.x[o] + acc[j][r]; } }
}

struct P5Args { const float* pre1; const float* g; const float* b; float* h1; bf16_t* h1b; const float* wg; const float* bg; const float* wr; const float* br; unsigned* cnt; int* tokidx; int* slot; };
__global__ void __launch_bounds__(256) k_ln1_route(P5Args a) {
    const int lane = threadIdx.x & 63, m = blockIdx.x * 4 + (threadIdx.x >> 6);
    const f32x4* xr = (const f32x4*)(a.pre1 + (size_t)m * DM) + lane;
    f32x4 v[8]; float s = 0.f;
#pragma unroll
    for (int j = 0; j < 8; ++j) { v[j] = xr[64 * j]; s += (v[j].x + v[j].y) + (v[j].z + v[j].w); }
    const float mean = wave_sum(s) * (1.0f / DM); float s2 = 0.f;
#pragma unroll
    for (int j = 0; j < 8; ++j) { v[j] = v[j] - mean; s2 += (v[j].x * v[j].x + v[j].y * v[j].y) + (v[j].z * v[j].z + v[j].w * v[j].w); }
    const float rstd = 1.0f / sqrtf(wave_sum(s2) * (1.0f / DM) + LN_EPS);
    float gl[4] = {0.f, 0.f, 0.f, 0.f};
#pragma unroll
    for (int j = 0; j < 8; ++j) { const int c = 4 * lane + 256 * j; const f32x4 gg = *(const f32x4*)(a.g + c), bb = *(const f32x4*)(a.b + c);
        v[j] = v[j] * rstd * gg + bb;
        *(f32x4*)(a.h1 + (size_t)m * DM + c) = v[j];
        *(uint2*)(a.h1b + (size_t)m * DM + c) = make_uint2(pk2(v[j].x, v[j].y), pk2(v[j].z, v[j].w));
#pragma unroll
        for (int i = 0; i < 4; ++i) { const f32x4 w = *(const f32x4*)(a.wg + (size_t)(c + i) * 4); const float hv = v[j][i]; gl[0] += hv * w.x; gl[1] += hv * w.y; gl[2] += hv * w.z; gl[3] += hv * w.w; } }
#pragma unroll
    for (int i = 0; i < 4; ++i) gl[i] = wave_sum(gl[i]) + a.bg[i];
    int gi = 0; float gm = gl[0];
#pragma unroll
    for (int i = 1; i < 4; ++i) if (gl[i] > gm) { gm = gl[i]; gi = i; }
    float gs = 0.f;
#pragma unroll
    for (int i = 0; i < 4; ++i) gs += __expf(gl[i] - gm);
    const float ggate = 1.0f / gs;
    float el[8] = {0.f, 0.f, 0.f, 0.f, 0.f, 0.f, 0.f, 0.f};
#pragma unroll
    for (int j = 0; j < 8; ++j) { const int c = 4 * lane + 256 * j;
#pragma unroll
        for (int i = 0; i < 4; ++i) { const float* wp = a.wr + (size_t)(c + i) * 32 + gi * 8; const f32x4 w0 = *(const f32x4*)wp, w1 = *(const f32x4*)(wp + 4); const float hv = v[j][i];
            el[0] += hv * w0.x; el[1] += hv * w0.y; el[2] += hv * w0.z; el[3] += hv * w0.w; el[4] += hv * w1.x; el[5] += hv * w1.y; el[6] += hv * w1.z; el[7] += hv * w1.w; } }
#pragma unroll
    for (int i = 0; i < 8; ++i) el[i] = wave_sum(el[i]) + a.br[gi * 8 + i];
    int i1 = 0; float m1 = el[0];
#pragma unroll
    for (int i = 1; i < 8; ++i) if (el[i] > m1) { m1 = el[i]; i1 = i; }
    int i2 = -1; float m2 = -3.0e38f;
#pragma unroll
    for (int i = 0; i < 8; ++i) if (i != i1 && el[i] > m2) { m2 = el[i]; i2 = i; }
    const float e2 = __expf(m2 - m1); const float w1 = ggate / (1.0f + e2), w2 = ggate * e2 / (1.0f + e2);
    if (lane == 0) {
        const int ex1 = gi * 8 + i1, ex2 = gi * 8 + i2;
        const int p1 = (int)atomicAdd(a.cnt + ex1, 1u), p2 = (int)atomicAdd(a.cnt + ex2, 1u);
        a.tokidx[ex1 * ECAP + p1] = m; a.tokidx[ex2 * ECAP + p2] = m;
        int* sl = a.slot + (size_t)m * 6; sl[0] = ex1; sl[1] = ex2; sl[2] = p1; sl[3] = p2; ((float*)sl)[4] = w1; ((float*)sl)[5] = w2;
    }
}

__device__ __forceinline__ int row_start(const unsigned* cnt, int e) { int s = 0; for (int i = 0; i < e; ++i) s += ((int)cnt[i] + 255) & ~255; return s; }

struct P6Args { const bf16_t* h1b; const bf16_t* wgut; const bf16_t* wdt; const unsigned* cnt; const int* tokidx; bf16_t* act; bf16_t* y; };
__global__ void __launch_bounds__(256) k_moe_up(P6Args a) {
    const int wave = threadIdx.x >> 6, lane = threadIdx.x & 63, fr = lane & 15, fq = lane >> 4;
    const int R0 = blockIdx.y * 64;
    int e = 0, rs = 0;
    for (; e < NEXP; ++e) { const int n = ((int)a.cnt[e] + 255) & ~255; if (R0 < rs + n) break; rs += n; }
    if (e == NEXP) return;
    const int pos = R0 - rs + wave * 16 + fr; const int tok = pos < (int)a.cnt[e] ? a.tokidx[e * ECAP + pos] : 0;
    const int jb = blockIdx.x;
    f32x4 ag[8], au[8];
#pragma unroll
    for (int j = 0; j < 8; ++j) { ag[j] = (f32x4){0.f, 0.f, 0.f, 0.f}; au[j] = (f32x4){0.f, 0.f, 0.f, 0.f}; }
    const bf16_t* wb = a.wgut + ((size_t)e * 2048 + jb * 256) * DM;
    wave_gemm16x128(a.h1b + (size_t)tok * DM, wb, DM, DM, ag);
    wave_gemm16x128(a.h1b + (size_t)tok * DM, wb + (size_t)128 * DM, DM, DM, au);
#pragma unroll
    for (int r = 0; r < 4; ++r) { const size_t row = (size_t)R0 + wave * 16 + fq * 4 + r;
#pragma unroll
        for (int j = 0; j < 8; ++j) { const float g = ag[j][r], u = au[j][r]; a.act[row * FF + jb * 128 + 16 * j + fr] = f2bf(g / (1.0f + __expf(-g)) * u); } }
}
__global__ void __launch_bounds__(256) k_moe_down(P6Args a) {
    const int wave = threadIdx.x >> 6, lane = threadIdx.x & 63, fr = lane & 15, fq = lane >> 4;
    const int R0 = blockIdx.y * 64;
    int e = 0, rs = 0;
    for (; e < NEXP; ++e) { const int n = ((int)a.cnt[e] + 255) & ~255; if (R0 < rs + n) break; rs += n; }
    if (e == NEXP) return;
    f32x4 acc[8];
#pragma unroll
    for (int j = 0; j < 8; ++j) acc[j] = (f32x4){0.f, 0.f, 0.f, 0.f};
    wave_gemm16x128(a.act + ((size_t)R0 + wave * 16 + fr) * FF, a.wdt + ((size_t)e * 2048 + blockIdx.x * 128) * FF, FF, FF, acc);
#pragma unroll
    for (int r = 0; r < 4; ++r) { const size_t row = (size_t)R0 + wave * 16 + fq * 4 + r;
#pragma unroll
        for (int j = 0; j < 8; ++j) a.y[row * DM + blockIdx.x * 128 + 16 * j + fr] = f2bf(acc[j][r]); }
}

struct P8Args { const float* h1; const bf16_t* y; const unsigned* cnt; const int* slot; const float* g; const float* b; float* out; };
__global__ void __launch_bounds__(256) k_final(P8Args a) {
    const int lane = threadIdx.x & 63, m = blockIdx.x * 4 + (threadIdx.x >> 6);
    const int* sl = a.slot + (size_t)m * 6; const int e1 = sl[0], e2 = sl[1], p1 = sl[2], p2 = sl[3]; const float w1 = ((const float*)sl)[4], w2 = ((const float*)sl)[5];
    const size_t r1 = (size_t)row_start(a.cnt, e1) + p1, r2 = (size_t)row_start(a.cnt, e2) + p2;
    f32x4 v[8]; float s = 0.f;
#pragma unroll
    for (int j = 0; j < 8; ++j) { const int c = 4 * lane + 256 * j; const f32x4 hv = *(const f32x4*)(a.h1 + (size_t)m * DM + c);
        const uint2 ya = *(const uint2*)(a.y + r1 * DM + c), yb = *(const uint2*)(a.y + r2 * DM + c);
        f32x4 f; f.x = w1 * __uint_as_float(ya.x << 16) + w2 * __uint_as_float(yb.x << 16); f.y = w1 * __uint_as_float(ya.x & 0xffff0000u) + w2 * __uint_as_float(yb.x & 0xffff0000u);
        f.z = w1 * __uint_as_float(ya.y << 16) + w2 * __uint_as_float(yb.y << 16); f.w = w1 * __uint_as_float(ya.y & 0xffff0000u) + w2 * __uint_as_float(yb.y & 0xffff0000u);
        v[j] = hv * ALPHA + f; s += (v[j].x + v[j].y) + (v[j].z + v[j].w); }
    const float mean = wave_sum(s) * (1.0f / DM); float s2 = 0.f;
#pragma unroll
    for (int j = 0; j < 8; ++j) { v[j] = v[j] - mean; s2 += (v[j].x * v[j].x + v[j].y * v[j].y) + (v[j].z * v[j].z + v[j].w * v[j].w); }
    const float rstd = 1.0f / sqrtf(wave_sum(s2) * (1.0f / DM) + LN_EPS);
#pragma unroll
    for (int j = 0; j < 8; ++j) { const int c = 4 * lane + 256 * j; const f32x4 gg = *(const f32x4*)(a.g + c), bb = *(const f32x4*)(a.b + c);
        *(f32x4*)(a.out + (size_t)m * DM + c) = v[j] * rstd * gg + bb; }
}

extern "C" void kernel_launch(void* const* d_in, const int* in_sizes, int n_in, void* d_out, int out_size, void* d_ws, size_t ws_size, hipStream_t stream) {
    if (n_in != 18 || in_sizes[0] != NTOK * DM || out_size != NTOK * DM || ws_size < WS_END) { fprintf(stderr, "kernel_launch: unexpected shapes (n_in %d, in0 %d, out %d, ws %zu)\n", n_in, n_in > 0 ? in_sizes[0] : -1, out_size, ws_size); return; }
    const float* x = (const float*)d_in[0]; const float* w_in = (const float*)d_in[1]; const float* qg = (const float*)d_in[2]; const float* kg = (const float*)d_in[3];
    const float* wa = (const float*)d_in[4]; const float* wb = (const float*)d_in[5]; const float* wo = (const float*)d_in[6];
    const float* ln1g = (const float*)d_in[7]; const float* ln1b = (const float*)d_in[8]; const float* wgrp = (const float*)d_in[9]; const float* bgrp = (const float*)d_in[10];
    const float* wrt = (const float*)d_in[11]; const float* brt = (const float*)d_in[12]; const float* wgate = (const float*)d_in[13]; const float* wup = (const float*)d_in[14]; const float* wdown = (const float*)d_in[15];
    const float* ln2g = (const float*)d_in[16]; const float* ln2b = (const float*)d_in[17];
    unsigned char* ws = (unsigned char*)d_ws;
    bf16_t* XB = (bf16_t*)(ws + WS_XB); bf16_t* WINT = (bf16_t*)(ws + WS_WINT); bf16_t* WAT = (bf16_t*)(ws + WS_WAT); bf16_t* WBT = (bf16_t*)(ws + WS_WBT); bf16_t* WOT = (bf16_t*)(ws + WS_WOT);
    bf16_t* WGUT = (bf16_t*)(ws + WS_WGUT); bf16_t* WDT = (bf16_t*)(ws + WS_WDT);
    unsigned* ctl = (unsigned*)(ws + WS_CTL);
    hipMemsetAsync(ws + WS_CTL, 0, 1 * MiB, stream);
    hipLaunchKernelGGL(k_cvt, dim3(2048), dim3(256), 0, stream, x, XB, (size_t)NTOK * DM / 8);
    hipLaunchKernelGGL(k_transpose, dim3(IN_COLS / 32, DM / 32, 1), dim3(256), 0, stream, w_in, WINT, DM, IN_COLS, 128, 0, (size_t)0, (size_t)0);
    hipLaunchKernelGGL(k_transpose, dim3(DM / 32, 1024 / 32, 1), dim3(256), 0, stream, wa, WAT, 1024, DM, 128, 0, (size_t)0, (size_t)0);
    hipLaunchKernelGGL(k_transpose, dim3(DM / 32, DM / 32, 1), dim3(256), 0, stream, wb, WBT, DM, DM, 128, 0, (size_t)0, (size_t)0);
    hipLaunchKernelGGL(k_transpose, dim3(DM / 32, DM / 32, 1), dim3(256), 0, stream, wo, WOT, DM, DM, 128, 0, (size_t)0, (size_t)0);
    hipLaunchKernelGGL(k_transpose, dim3(FF / 32, DM / 32, NEXP), dim3(256), 0, stream, wgate, WGUT, DM, FF, 256, 0, (size_t)DM * FF, (size_t)2048 * DM);
    hipLaunchKernelGGL(k_transpose, dim3(FF / 32, DM / 32, NEXP), dim3(256), 0, stream, wup, WGUT, DM, FF, 256, 128, (size_t)DM * FF, (size_t)2048 * DM);
    hipLaunchKernelGGL(k_transpose, dim3(DM / 32, FF / 32, NEXP), dim3(256), 0, stream, wdown, WDT, FF, DM, 128, 0, (size_t)FF * DM, (size_t)DM * FF);
    P1Args p1{}; p1.xb = XB; p1.wint = WINT; p1.qg = qg; p1.kg = kg; p1.qa = (bf16_t*)(ws + WS_QA); p1.ka = (bf16_t*)(ws + WS_KA); p1.va = (bf16_t*)(ws + WS_VA);
    p1.qb = (bf16_t*)(ws + WS_QB); p1.kb = (bf16_t*)(ws + WS_KB); p1.vb = (bf16_t*)(ws + WS_VB); p1.gates = (bf16_t*)(ws + WS_GATES);
    hipLaunchKernelGGL(k_proj, dim3(IN_COLS / 128, NTOK / 64), dim3(256), 0, stream, p1);
    P2Args p2b{}; p2b.q = p1.qb; p2b.k = p1.kb; p2b.v = p1.vb; p2b.o = (bf16_t*)(ws + WS_OB); p2b.lse = nullptr; p2b.mode = 0;
    hipLaunchKernelGGL(k_attn, dim3(SEQ / 64, 32), dim3(128), 0, stream, p2b);
    P2Args p2a{}; p2a.q = p1.qa; p2a.k = p1.ka; p2a.v = p1.va; p2a.o = (bf16_t*)(ws + WS_OAG); p2a.lse = (float*)(ws + WS_LSE); p2a.mode = 1;
    hipLaunchKernelGGL(k_attn, dim3(SEQ / 64, 48), dim3(128), 0, stream, p2a);
    hipLaunchKernelGGL(k_merge, dim3(NTOK * 1024 / 256), dim3(256), 0, stream, (const bf16_t*)(ws + WS_OAG), (const float*)(ws + WS_LSE), (bf16_t*)(ws + WS_OA));
    P3Args p3{}; p3.gates = p1.gates; p3.T = (float*)(ws + WS_T); p3.merged = (bf16_t*)(ws + WS_MERGED); p3.x = x; p3.pre1 = (float*)(ws + WS_PRE1);
    p3.A = (bf16_t*)(ws + WS_OA); p3.Bt = WAT; p3.K = 1024; p3.mode = 0;
    hipLaunchKernelGGL(k_gemm3, dim3(DM / 128, NTOK / 64), dim3(256), 0, stream, p3);
    p3.A = (bf16_t*)(ws + WS_OB); p3.Bt = WBT; p3.K = 2048; p3.mode = 1;
    hipLaunchKernelGGL(k_gemm3, dim3(DM / 128, NTOK / 64), dim3(256), 0, stream, p3);
    p3.A = p3.merged; p3.Bt = WOT; p3.K = 2048; p3.mode = 2;
    hipLaunchKernelGGL(k_gemm3, dim3(DM / 128, NTOK / 64), dim3(256), 0, stream, p3);
    P5Args p5{}; p5.pre1 = p3.pre1; p5.g = ln1g; p5.b = ln1b; p5.h1 = (float*)(ws + WS_H1); p5.h1b = (bf16_t*)(ws + WS_H1B); p5.wg = wgrp; p5.bg = bgrp; p5.wr = wrt; p5.br = brt;
    p5.cnt = ctl + CW_CNT; p5.tokidx = (int*)(ws + WS_TOKIDX); p5.slot = (int*)(ws + WS_SLOT);
    hipLaunchKernelGGL(k_ln1_route, dim3(NTOK / 4), dim3(256), 0, stream, p5);
    P6Args p6{}; p6.h1b = p5.h1b; p6.wgut = WGUT; p6.wdt = WDT; p6.cnt = ctl + CW_CNT; p6.tokidx = p5.tokidx; p6.act = (bf16_t*)(ws + WS_ACT); p6.y = (bf16_t*)(ws + WS_Y);
    hipLaunchKernelGGL(k_moe_up, dim3(FF / 128, 24576 / 64), dim3(256), 0, stream, p6);
    hipLaunchKernelGGL(k_moe_down, dim3(DM / 128, 24576 / 64), dim3(256), 0, stream, p6);
    P8Args p8{}; p8.h1 = p5.h1; p8.y = p6.y; p8.cnt = ctl + CW_CNT; p8.slot = p5.slot; p8.g = ln2g; p8.b = ln2b; p8.out = (float*)d_out;
    hipLaunchKernelGGL(k_final, dim3(NTOK / 4), dim3(256), 0, stream, p8);
}
```

```cpp
#include <hip/hip_runtime.h>
#include <hip/hip_cooperative_groups.h>
#include <cstdio>
#include <cstdint>

typedef unsigned short bf16_t;
typedef short bf16x8 __attribute__((ext_vector_type(8)));
typedef short s16x4 __attribute__((ext_vector_type(4)));
typedef float f32x4 __attribute__((ext_vector_type(4)));
typedef float f32x16 __attribute__((ext_vector_type(16)));
typedef unsigned u32x4 __attribute__((ext_vector_type(4)));
typedef unsigned u32x2 __attribute__((ext_vector_type(2)));
#define LAS __attribute__((address_space(3)))

#ifndef MK_FAST_MASK
#define MK_FAST_MASK 0x1ff
#endif
#ifndef MK_ONE_LAUNCH
#define MK_ONE_LAUNCH 0
#endif
#ifndef PG8_SP2
#define PG8_SP2 true
#endif
#ifndef PG8_ALIGN
#define PG8_ALIGN true
#endif

constexpr int NTOK = 8192, SEQ = 4096, DM = 2048, HD = 128;
constexpr int IN_COLS = 16384;
constexpr int NEXP = 32, FF = 1024;
constexpr float ALPHA = 1.189207115002721f;
constexpr float LN_EPS = 1e-5f, RMS_EPS = 1e-6f;
constexpr float SM_SCALE = 0.08838834764831845f;
constexpr int ECAP = 8192;
constexpr int NPHASE = 9;

constexpr size_t MiB = 1u << 20;
constexpr size_t WS_CTL = 0;
constexpr size_t WS_WGUT = 1 * MiB;
constexpr size_t WS_WDT = 257 * MiB;
constexpr size_t WS_WAT = 385 * MiB;
constexpr size_t WS_WBT = 389 * MiB;
constexpr size_t WS_WOT = 397 * MiB;
constexpr size_t WS_XB = 405 * MiB;
constexpr size_t WS_WINT = 437 * MiB;
constexpr size_t WS_QA = 501 * MiB;
constexpr size_t WS_KA = 549 * MiB;
constexpr size_t WS_VA = 597 * MiB;
constexpr size_t WS_QB = 645 * MiB;
constexpr size_t WS_KB = 677 * MiB;
constexpr size_t WS_VB = 685 * MiB;
constexpr size_t WS_GATES = 693 * MiB;
constexpr size_t WS_OAG = 757 * MiB;
constexpr size_t WS_LSE = 805 * MiB;
constexpr size_t WS_OA = 806 * MiB;
constexpr size_t WS_OB = 822 * MiB;
constexpr size_t WS_T = 405 * MiB;
constexpr size_t WS_MERGED = 469 * MiB;
constexpr size_t WS_PRE1 = 501 * MiB;
constexpr size_t WS_H1 = 565 * MiB;
constexpr size_t WS_H1B = 629 * MiB;
constexpr size_t WS_TOKIDX = 661 * MiB;
constexpr size_t WS_SLOT = 662 * MiB;
constexpr size_t WS_ACT = 693 * MiB;
constexpr size_t WS_Y = 757 * MiB;
constexpr size_t WS_RT1 = 854 * MiB;
constexpr size_t WS_RT2 = 856 * MiB;
constexpr size_t WS_END = 858 * MiB;
constexpr int CW_CNT = 64;
constexpr int CW_BAR = 4096;

__device__ __forceinline__ float bf2f(bf16_t v) { return __uint_as_float(((unsigned)v) << 16); }
__device__ __forceinline__ bf16_t f2bf(float f) { unsigned u = __float_as_uint(f); u += 0x7fffu + ((u >> 16) & 1u); return (bf16_t)(u >> 16); }
__device__ __forceinline__ unsigned pk2(float lo, float hi) { return (unsigned)f2bf(lo) | ((unsigned)f2bf(hi) << 16); }
__device__ __forceinline__ unsigned cvtpk(float lo, float hi) { unsigned r; asm volatile("v_cvt_pk_bf16_f32 %0, %1, %2" : "=v"(r) : "v"(lo), "v"(hi)); return r; }
__device__ __forceinline__ float wave_sum(float v) {
#pragma unroll
    for (int o = 1; o < 64; o <<= 1) v += __shfl_xor(v, o);
    return v;
}
__device__ __forceinline__ int lane_id() { int l; asm volatile("v_mbcnt_lo_u32_b32 %0, -1, 0\n\tv_mbcnt_hi_u32_b32 %0, -1, %0" : "=v"(l)); return l; }
__device__ __forceinline__ float bflo(unsigned w) { return __uint_as_float(w << 16); }
__device__ __forceinline__ float bfhi(unsigned w) { return __uint_as_float(w & 0xffff0000u); }

__device__ const float INV64[64] = {
    1.000000000e+00f, 8.659643234e-01f, 7.498942093e-01f, 6.493816316e-01f, 5.623413252e-01f, 4.869675252e-01f, 4.216965034e-01f, 3.651741273e-01f,
    3.162277660e-01f, 2.738419634e-01f, 2.371373706e-01f, 2.053525026e-01f, 1.778279410e-01f, 1.539926526e-01f, 1.333521432e-01f, 1.154781985e-01f,
    1.000000000e-01f, 8.659643234e-02f, 7.498942093e-02f, 6.493816316e-02f, 5.623413252e-02f, 4.869675252e-02f, 4.216965034e-02f, 3.651741273e-02f,
    3.162277660e-02f, 2.738419634e-02f, 2.371373706e-02f, 2.053525026e-02f, 1.778279410e-02f, 1.539926526e-02f, 1.333521432e-02f, 1.154781985e-02f,
    1.000000000e-02f, 8.659643234e-03f, 7.498942093e-03f, 6.493816316e-03f, 5.623413252e-03f, 4.869675252e-03f, 4.216965034e-03f, 3.651741273e-03f,
    3.162277660e-03f, 2.738419634e-03f, 2.371373706e-03f, 2.053525026e-03f, 1.778279410e-03f, 1.539926526e-03f, 1.333521432e-03f, 1.154781985e-03f,
    1.000000000e-03f, 8.659643234e-04f, 7.498942093e-04f, 6.493816316e-04f, 5.623413252e-04f, 4.869675252e-04f, 4.216965034e-04f, 3.651741273e-04f,
    3.162277660e-04f, 2.738419634e-04f, 2.371373706e-04f, 2.053525026e-04f, 1.778279410e-04f, 1.539926526e-04f, 1.333521432e-04f, 1.154781985e-04f};

__device__ __forceinline__ void cs_angle(float ang, float& c, float& s) {
    const double a = (double)ang * 0.15915494309189535;
    const float f = (float)(a - floor(a));
    s = __builtin_amdgcn_sinf(f); c = __builtin_amdgcn_cosf(f);
}
__device__ __forceinline__ void rope1(int t, int i, float& c, float& s) { cs_angle((float)t * INV64[i], c, s); }
__device__ __forceinline__ void rope2(int t, int i, float& c, float& s) {
    const float p = (i < 32) ? (float)(t >> 6) : (float)(t & 63);
    cs_angle(p * INV64[2 * (i & 31)], c, s);
}
__device__ __forceinline__ int perm_pos(int g, int t) { const int sh = 2 * g; const int d = 1 << sh; return (t & (d - 1)) * (SEQ >> sh) + (t >> sh); }

__global__ void __launch_bounds__(256) k_cvt(const float* __restrict__ x, bf16_t* __restrict__ xb, size_t n8) {
    for (size_t i = (size_t)blockIdx.x * 256 + threadIdx.x; i < n8; i += (size_t)gridDim.x * 256) {
        const f32x4 a = *(const f32x4*)(x + i * 8), b = *(const f32x4*)(x + i * 8 + 4);
        u32x4 w; w.x = pk2(a.x, a.y); w.y = pk2(a.z, a.w); w.z = pk2(b.x, b.y); w.w = pk2(b.z, b.w);
        *(u32x4*)(xb + i * 8) = w;
    }
}
__global__ void __launch_bounds__(256) k_transpose(const float* __restrict__ src, bf16_t* __restrict__ dst, int K, int N, int rowblk, int roff, size_t sstride, size_t dstride) {
    __shared__ float tile[32][33];
    const float* s = src + (size_t)blockIdx.z * sstride; bf16_t* d = dst + (size_t)blockIdx.z * dstride;
    const int n0 = blockIdx.x * 32, k0 = blockIdx.y * 32, tx = threadIdx.x & 31, ty = threadIdx.x >> 5;
    for (int i = ty; i < 32; i += 8) tile[i][tx] = s[(size_t)(k0 + i) * N + n0 + tx];
    __syncthreads();
    for (int i = ty; i < 32; i += 8) { const int n = n0 + i; const int dr = (n >> 7) * rowblk + roff + (n & 127); d[(size_t)dr * K + k0 + tx] = f2bf(tile[tx][i]); }
}
__global__ void __launch_bounds__(256) k_ropetab(float2* rt1, float2* rt2) {
    const int i = blockIdx.x * 256 + threadIdx.x; const int t = i >> 6, c = i & 63; float cs, sn;
    rope1(t, c, cs, sn); rt1[i] = make_float2(cs, sn); rope2(t, c, cs, sn); rt2[i] = make_float2(cs, sn);
}
__device__ __forceinline__ void wave_gemm16x128(const bf16_t* arow, const bf16_t* bt, int ldb, int K, f32x4 (&acc)[8]) {
    const int lane = threadIdx.x & 63, fr = lane & 15, fq = lane >> 4;
    const bf16_t* ap = arow + fq * 8;
    const bf16_t* bp = bt + (size_t)fr * ldb + fq * 8;
    for (int k = 0; k < K; k += 32) {
        const bf16x8 a = *(const bf16x8*)(ap + k);
#pragma unroll
        for (int j = 0; j < 8; ++j) { const bf16x8 b = *(const bf16x8*)(bp + (size_t)j * 16 * ldb + k); acc[j] = __builtin_amdgcn_mfma_f32_16x16x32_bf16(a, b, acc[j], 0, 0, 0); }
    }
}
struct P1Args { const bf16_t* xb; const bf16_t* wint; const float* qg; const float* kg; bf16_t *qa, *ka, *va, *qb, *kb, *vb, *gates; };
__global__ void __launch_bounds__(256) k_proj(P1Args a) {
    const int wave = threadIdx.x >> 6, lane = threadIdx.x & 63, fr = lane & 15, fq = lane >> 4;
    const int ng = blockIdx.x, mt = blockIdx.y * 4 + wave;
    f32x4 acc[8];
#pragma unroll
    for (int j = 0; j < 8; ++j) acc[j] = (f32x4){0.f, 0.f, 0.f, 0.f};
    wave_gemm16x128(a.xb + (size_t)(mt * 16 + fr) * DM, a.wint + (size_t)ng * 128 * DM, DM, DM, acc);
#pragma unroll
    for (int r = 0; r < 4; ++r) {
        const int m = mt * 16 + fq * 4 + r, b = m >> 12, t = m & 4095;
        if (ng < 72) {
            const int which = ng / 24, hh = ng % 24, g = hh >> 3, h = hh & 7;
            bf16_t* base = (which == 0 ? a.qa : (which == 1 ? a.ka : a.va)) + ((size_t)((g * 2 + b) * 8 + h) * SEQ + perm_pos(g, t)) * HD;
#pragma unroll
            for (int j = 0; j < 4; ++j) { const int c = 16 * j + fr; float x1 = acc[j][r], x2 = acc[j + 4][r];
                if (which < 2) { float cs, sn; rope1(t, c, cs, sn); const float y1 = x1 * cs - x2 * sn, y2 = x2 * cs + x1 * sn; x1 = y1; x2 = y2; }
                base[c] = f2bf(x1); base[c + 64] = f2bf(x2); }
        } else if (ng < 96) {
            const int k = ng - 72;
            if (k < 20) {
                float ss = 0.f;
#pragma unroll
                for (int j = 0; j < 8; ++j) ss += acc[j][r] * acc[j][r];
                ss += __shfl_xor(ss, 1); ss += __shfl_xor(ss, 2); ss += __shfl_xor(ss, 4); ss += __shfl_xor(ss, 8);
                const float rinv = 1.0f / sqrtf(ss * (1.0f / 128.0f) + RMS_EPS);
                const float* gn = (k < 16) ? a.qg : a.kg;
                bf16_t* base = (k < 16) ? a.qb + ((size_t)(b * 16 + k) * SEQ + t) * HD : a.kb + ((size_t)(b * 4 + (k - 16)) * SEQ + t) * HD;
#pragma unroll
                for (int j = 0; j < 4; ++j) { const int c = 16 * j + fr; const float x1 = acc[j][r] * rinv * gn[c], x2 = acc[j + 4][r] * rinv * gn[c + 64];
                    float cs, sn; rope2(t, c, cs, sn); base[c] = f2bf(x1 * cs - x2 * sn); base[c + 64] = f2bf(x2 * cs + x1 * sn); }
            } else {
                bf16_t* base = a.vb + ((size_t)(b * 4 + (k - 20)) * SEQ + t) * HD;
#pragma unroll
                for (int j = 0; j < 8; ++j) base[16 * j + fr] = f2bf(acc[j][r]);
            }
        } else {
            bf16_t* base = a.gates + (size_t)m * 4096 + (ng - 96) * 128;
#pragma unroll
            for (int j = 0; j < 8; ++j) base[16 * j + fr] = f2bf(1.0f / (1.0f + __expf(-acc[j][r])));
        }
    }
}
struct P2Args { const bf16_t *q, *k, *v; bf16_t* o; float* lse; int mode; };
__global__ void __launch_bounds__(128) k_attn(P2Args a) {
    const int half = threadIdx.x & 1, qi = blockIdx.x * 64 + (threadIdx.x >> 1), sid = blockIdx.y;
    const bf16_t *Q, *K, *V; int k_lo, k_hi;
    if (a.mode == 0) { const int b = sid >> 4, hq = sid & 15; Q = a.q + (size_t)sid * SEQ * HD; K = a.k + (size_t)(b * 4 + (hq >> 2)) * SEQ * HD; V = a.v + (size_t)(b * 4 + (hq >> 2)) * SEQ * HD; k_lo = 0; k_hi = SEQ - 1; }
    else { const int g = sid >> 4; const int L = SEQ >> (2 * g); Q = a.q + (size_t)sid * SEQ * HD; K = a.k + (size_t)sid * SEQ * HD; V = a.v + (size_t)sid * SEQ * HD;
        const int r0 = (qi / L) * L, p = qi - r0; k_lo = r0 + (p - 64 > 0 ? p - 64 : 0); k_hi = r0 + (p + 64 < L - 1 ? p + 64 : L - 1); }
    float q[64], o[64];
    { const bf16_t* qp = Q + (size_t)qi * HD + half * 64;
#pragma unroll
      for (int d = 0; d < 64; ++d) { q[d] = bf2f(qp[d]) * SM_SCALE; o[d] = 0.f; } }
    float m = -1e30f, l = 0.f;
    for (int kk = k_lo; kk <= k_hi; ++kk) {
        const bf16_t* kp = K + (size_t)kk * HD + half * 64; const bf16_t* vp = V + (size_t)kk * HD + half * 64;
        float s = 0.f;
#pragma unroll
        for (int d = 0; d < 64; ++d) s += q[d] * bf2f(kp[d]);
        s += __shfl_xor(s, 1);
        const float mn = fmaxf(m, s), al = __expf(m - mn), p = __expf(s - mn);
        l = l * al + p; m = mn;
#pragma unroll
        for (int d = 0; d < 64; ++d) o[d] = o[d] * al + p * bf2f(vp[d]);
    }
    const float rl = 1.0f / l;
    if (a.mode == 0) { const int b = sid >> 4, hq = sid & 15; bf16_t* op = a.o + (size_t)(b * SEQ + qi) * 2048 + hq * HD + half * 64;
#pragma unroll
        for (int d = 0; d < 64; ++d) op[d] = f2bf(o[d] * rl); }
    else { const int g = sid >> 4, b = (sid >> 3) & 1, h = sid & 7; const int sh = 2 * g, L = SEQ >> sh; const int r = qi / L, p = qi - r * L, t = (p << sh) + r;
        const size_t mrow = (size_t)b * SEQ + t;
        bf16_t* op = a.o + ((size_t)g * NTOK + mrow) * 1024 + h * HD + half * 64;
#pragma unroll
        for (int d = 0; d < 64; ++d) op[d] = f2bf(o[d] * rl);
        if (half == 0) a.lse[((size_t)g * NTOK + mrow) * 8 + h] = m + __logf(l); }
}
__global__ void __launch_bounds__(256) k_merge(const bf16_t* __restrict__ oag, const float* __restrict__ lse, bf16_t* __restrict__ oa) {
    const size_t i = (size_t)blockIdx.x * 256 + threadIdx.x;
    const size_t m = i >> 10; const int c = (int)(i & 1023), h = c >> 7;
    const float l0 = lse[(0 * (size_t)NTOK + m) * 8 + h], l1 = lse[(1 * (size_t)NTOK + m) * 8 + h], l2 = lse[(2 * (size_t)NTOK + m) * 8 + h];
    const float mx = fmaxf(l0, fmaxf(l1, l2)); const float e0 = __expf(l0 - mx), e1 = __expf(l1 - mx), e2 = __expf(l2 - mx); const float inv = 1.0f / (e0 + e1 + e2);
    const float v = (e0 * bf2f(oag[(0 * (size_t)NTOK + m) * 1024 + c]) + e1 * bf2f(oag[(1 * (size_t)NTOK + m) * 1024 + c]) + e2 * bf2f(oag[(2 * (size_t)NTOK + m) * 1024 + c])) * inv;
    oa[i] = f2bf(v);
}
struct P3Args { const bf16_t* A; const bf16_t* Bt; int K; const bf16_t* gates; float* T; bf16_t* merged; const float* x; float* pre1; int mode; };
__global__ void __launch_bounds__(256) k_gemm3(P3Args a) {
    const int wave = threadIdx.x >> 6, lane = threadIdx.x & 63, fr = lane & 15, fq = lane >> 4;
    const int ng = blockIdx.x, mt = blockIdx.y * 4 + wave;
    f32x4 acc[8];
#pragma unroll
    for (int j = 0; j < 8; ++j) acc[j] = (f32x4){0.f, 0.f, 0.f, 0.f};
    wave_gemm16x128(a.A + (size_t)(mt * 16 + fr) * a.K, a.Bt + (size_t)ng * 128 * a.K, a.K, a.K, acc);
#pragma unroll
    for (int r = 0; r < 4; ++r) { const size_t m = (size_t)mt * 16 + fq * 4 + r;
#pragma unroll
        for (int j = 0; j < 8; ++j) { const int c = ng * 128 + 16 * j + fr; const size_t o = m * DM + c;
            if (a.mode == 0) a.T[o] = bf2f(a.gates[m * 4096 + c]) * acc[j][r];
            else if (a.mode == 1) a.merged[o] = f2bf(a.T[o] + bf2f(a.gates[m * 4096 + 2048 + c]) * acc[j][r]);
            else a.pre1[o] = ALPHA * a.x[o] + acc[j][r]; } }
}
struct RouteArgs { const float* g; const float* b; float* h1; bf16_t* h1b; const float* wg; const float* bg; const float* wr; const float* br; unsigned* cnt; int* tokidx; int* slot; };
__device__ __forceinline__ void ln1_route_row(const float* pre1, const RouteArgs& a, int m, int lane) {
    const f32x4* xr = (const f32x4*)(pre1 + (size_t)m * DM) + lane;
    f32x4 v[8]; float s = 0.f;
#pragma unroll
    for (int j = 0; j < 8; ++j) { v[j] = xr[64 * j]; s += (v[j].x + v[j].y) + (v[j].z + v[j].w); }
    const float mean = wave_sum(s) * (1.0f / DM); float s2 = 0.f;
#pragma unroll
    for (int j = 0; j < 8; ++j) { v[j] = v[j] - mean; s2 += (v[j].x * v[j].x + v[j].y * v[j].y) + (v[j].z * v[j].z + v[j].w * v[j].w); }
    const float rstd = 1.0f / sqrtf(wave_sum(s2) * (1.0f / DM) + LN_EPS);
    float gl[4] = {0.f, 0.f, 0.f, 0.f};
#pragma unroll
    for (int j = 0; j < 8; ++j) { const int c = 4 * lane + 256 * j; const f32x4 gg = *(const f32x4*)(a.g + c), bb = *(const f32x4*)(a.b + c);
        v[j] = v[j] * rstd * gg + bb;
        *(f32x4*)(a.h1 + (size_t)m * DM + c) = v[j];
        *(uint2*)(a.h1b + (size_t)m * DM + c) = make_uint2(pk2(v[j].x, v[j].y), pk2(v[j].z, v[j].w));
#pragma unroll
        for (int i = 0; i < 4; ++i) { const f32x4 w = *(const f32x4*)(a.wg + (size_t)(c + i) * 4); const float hv = v[j][i]; gl[0] += hv * w.x; gl[1] += hv * w.y; gl[2] += hv * w.z; gl[3] += hv * w.w; } }
#pragma unroll
    for (int i = 0; i < 4; ++i) gl[i] = wave_sum(gl[i]) + a.bg[i];
    int gi = 0; float gm = gl[0];
#pragma unroll
    for (int i = 1; i < 4; ++i) if (gl[i] > gm) { gm = gl[i]; gi = i; }
    float gs = 0.f;
#pragma unroll
    for (int i = 0; i < 4; ++i) gs += __expf(gl[i] - gm);
    const float ggate = 1.0f / gs;
    float el[8] = {0.f, 0.f, 0.f, 0.f, 0.f, 0.f, 0.f, 0.f};
#pragma unroll
    for (int j = 0; j < 8; ++j) { const int c = 4 * lane + 256 * j;
#pragma unroll
        for (int i = 0; i < 4; ++i) { const float* wp = a.wr + (size_t)(c + i) * 32 + gi * 8; const f32x4 w0 = *(const f32x4*)wp, w1 = *(const f32x4*)(wp + 4); const float hv = v[j][i];
            el[0] += hv * w0.x; el[1] += hv * w0.y; el[2] += hv * w0.z; el[3] += hv * w0.w; el[4] += hv * w1.x; el[5] += hv * w1.y; el[6] += hv * w1.z; el[7] += hv * w1.w; } }
#pragma unroll
    for (int i = 0; i < 8; ++i) el[i] = wave_sum(el[i]) + a.br[gi * 8 + i];
    int i1 = 0; float m1 = el[0];
#pragma unroll
    for (int i = 1; i < 8; ++i) if (el[i] > m1) { m1 = el[i]; i1 = i; }
    int i2 = -1; float m2 = -3.0e38f;
#pragma unroll
    for (int i = 0; i < 8; ++i) if (i != i1 && el[i] > m2) { m2 = el[i]; i2 = i; }
    const float e2 = __expf(m2 - m1); const float w1 = ggate / (1.0f + e2), w2 = ggate * e2 / (1.0f + e2);
    if (lane == 0) {
        const int ex1 = gi * 8 + i1, ex2 = gi * 8 + i2;
        const int p1 = (int)atomicAdd(a.cnt + ex1, 1u), p2 = (int)atomicAdd(a.cnt + ex2, 1u);
        a.tokidx[ex1 * ECAP + p1] = m; a.tokidx[ex2 * ECAP + p2] = m;
        int* sl = a.slot + (size_t)m * 6; sl[0] = ex1; sl[1] = ex2; sl[2] = p1; sl[3] = p2; ((float*)sl)[4] = w1; ((float*)sl)[5] = w2;
    }
}
__global__ void __launch_bounds__(256) k_ln1_route(const float* pre1, RouteArgs a) { ln1_route_row(pre1, a, blockIdx.x * 4 + (threadIdx.x >> 6), threadIdx.x & 63); }

__device__ __forceinline__ int row_start(const unsigned* cnt, int e) { int s = 0; for (int i = 0; i < e; ++i) s += ((int)cnt[i] + 255) & ~255; return s; }
struct P6Args { const bf16_t* h1b; const bf16_t* wgut; const bf16_t* wdt; const unsigned* cnt; const int* tokidx; bf16_t* act; bf16_t* y; };
__global__ void __launch_bounds__(256) k_moe_up(P6Args a) {
    const int wave = threadIdx.x >> 6, lane = threadIdx.x & 63, fr = lane & 15, fq = lane >> 4;
    const int R0 = blockIdx.y * 64;
    int e = 0, rs = 0;
    for (; e < NEXP; ++e) { const int n = ((int)a.cnt[e] + 255) & ~255; if (R0 < rs + n) break; rs += n; }
    if (e == NEXP) return;
    const int pos = R0 - rs + wave * 16 + fr; const int tok = pos < (int)a.cnt[e] ? a.tokidx[e * ECAP + pos] : 0;
    const int jb = blockIdx.x;
    f32x4 ag[8], au[8];
#pragma unroll
    for (int j = 0; j < 8; ++j) { ag[j] = (f32x4){0.f, 0.f, 0.f, 0.f}; au[j] = (f32x4){0.f, 0.f, 0.f, 0.f}; }
    const bf16_t* wb = a.wgut + ((size_t)e * 2048 + jb * 256) * DM;
    wave_gemm16x128(a.h1b + (size_t)tok * DM, wb, DM, DM, ag);
    wave_gemm16x128(a.h1b + (size_t)tok * DM, wb + (size_t)128 * DM, DM, DM, au);
#pragma unroll
    for (int r = 0; r < 4; ++r) { const size_t row = (size_t)R0 + wave * 16 + fq * 4 + r;
#pragma unroll
        for (int j = 0; j < 8; ++j) { const float g = ag[j][r], u = au[j][r]; a.act[row * FF + jb * 128 + 16 * j + fr] = f2bf(g / (1.0f + __expf(-g)) * u); } }
}
__global__ void __launch_bounds__(256) k_moe_down(P6Args a) {
    const int wave = threadIdx.x >> 6, lane = threadIdx.x & 63, fr = lane & 15, fq = lane >> 4;
    const int R0 = blockIdx.y * 64;
    int e = 0, rs = 0;
    for (; e < NEXP; ++e) { const int n = ((int)a.cnt[e] + 255) & ~255; if (R0 < rs + n) break; rs += n; }
    if (e == NEXP) return;
    f32x4 acc[8];
#pragma unroll
    for (int j = 0; j < 8; ++j) acc[j] = (f32x4){0.f, 0.f, 0.f, 0.f};
    wave_gemm16x128(a.act + ((size_t)R0 + wave * 16 + fr) * FF, a.wdt + ((size_t)e * 2048 + blockIdx.x * 128) * FF, FF, FF, acc);
#pragma unroll
    for (int r = 0; r < 4; ++r) { const size_t row = (size_t)R0 + wave * 16 + fq * 4 + r;
#pragma unroll
        for (int j = 0; j < 8; ++j) a.y[row * DM + blockIdx.x * 128 + 16 * j + fr] = f2bf(acc[j][r]); }
}
struct P8Args { const float* h1; const bf16_t* y; const unsigned* cnt; const int* slot; const float* g; const float* b; float* out; };
__device__ __forceinline__ void final_row(const P8Args& a, int m, int lane, size_t r1, size_t r2, float w1, float w2) {
    f32x4 v[8]; float s = 0.f;
#pragma unroll
    for (int j = 0; j < 8; ++j) { const int c = 4 * lane + 256 * j; const f32x4 hv = *(const f32x4*)(a.h1 + (size_t)m * DM + c);
        const uint2 ya = *(const uint2*)(a.y + r1 * DM + c), yb = *(const uint2*)(a.y + r2 * DM + c);
        f32x4 f; f.x = w1 * bflo(ya.x) + w2 * bflo(yb.x); f.y = w1 * bfhi(ya.x) + w2 * bfhi(yb.x); f.z = w1 * bflo(ya.y) + w2 * bflo(yb.y); f.w = w1 * bfhi(ya.y) + w2 * bfhi(yb.y);
        v[j] = hv * ALPHA + f; s += (v[j].x + v[j].y) + (v[j].z + v[j].w); }
    const float mean = wave_sum(s) * (1.0f / DM); float s2 = 0.f;
#pragma unroll
    for (int j = 0; j < 8; ++j) { v[j] = v[j] - mean; s2 += (v[j].x * v[j].x + v[j].y * v[j].y) + (v[j].z * v[j].z + v[j].w * v[j].w); }
    const float rstd = 1.0f / sqrtf(wave_sum(s2) * (1.0f / DM) + LN_EPS);
#pragma unroll
    for (int j = 0; j < 8; ++j) { const int c = 4 * lane + 256 * j; const f32x4 gg = *(const f32x4*)(a.g + c), bb = *(const f32x4*)(a.b + c);
        *(f32x4*)(a.out + (size_t)m * DM + c) = v[j] * rstd * gg + bb; }
}
__global__ void __launch_bounds__(256) k_final(P8Args a) {
    const int lane = threadIdx.x & 63, m = blockIdx.x * 4 + (threadIdx.x >> 6);
    const int* sl = a.slot + (size_t)m * 6; const int e1 = sl[0], e2 = sl[1], p1 = sl[2], p2 = sl[3]; const float w1 = ((const float*)sl)[4], w2 = ((const float*)sl)[5];
    final_row(a, m, lane, (size_t)row_start(a.cnt, e1) + p1, (size_t)row_start(a.cnt, e2) + p2, w1, w2);
}

namespace pg8 {
constexpr int BM = 256, BK = 64, HALF = 128, HTB = HALF * BK * 2  , STAGE_BYTES = 8 * HTB;
__device__ __forceinline__ int lds_byte(int r, int c) { const int st = (r >> 4) * 2 + (c >> 5), rr = r & 15, cc = c & 31, ob = rr * 64 + cc * 2; return st * 1024 + (ob ^ (((ob >> 9) & 1) << 5)); }
__device__ __forceinline__ void stage_rc(int b, int& R, int& C) { const int st = b / 1024, sb = b % 1024, swz = sb ^ (((sb >> 9) & 1) << 5); R = (st >> 1) * 16 + swz / 64; C = (st & 1) * 32 + (swz % 64) / 2; }

struct Unit { const char* A; const char* B; unsigned lda, ldb; int nt; int pm, pn, aux; const int* gidx; int gcnt; };
struct Voff { unsigned a[2][2], b[2][2]; };
__device__ __forceinline__ int brow_perm8(int h, int R) { return 128 * h + (R & ~31) + 8 * ((R >> 2) & 3) + 4 * ((R >> 4) & 1) + (R & 3); }
__device__ __forceinline__ int brow_rope(int h, int R) { return 128 * (R >> 6) + 64 * h + 32 * ((R >> 5) & 1) + 8 * ((R >> 2) & 3) + 4 * ((R >> 4) & 1) + (R & 3); }

template <class Epi> __device__ __forceinline__ void make_voff(const Unit& u, Voff& v, int tid) {
#pragma unroll
    for (int i = 0; i < 2; ++i) { int R, C; stage_rc(tid * 16 + i * 8192, R, C);
#pragma unroll
        for (int h = 0; h < 2; ++h) {
            int ra = h * HALF + R;
            if (u.gidx) ra = (ra < u.gcnt) ? u.gidx[ra] : 0;
            v.a[h][i] = (unsigned)ra * u.lda + (unsigned)C * 2u;
            v.b[h][i] = (unsigned)Epi::brow(h, R) * u.ldb + (unsigned)C * 2u;
        } }
}

template <class Epi, class Sched, bool ALIGN_EPI, bool SP2>
__device__ __forceinline__ void gemm_phase(LAS unsigned char* lds, LAS unsigned char* ex, const Sched& S, const Epi& E, int wid) {
    const int lane = lane_id(), tid = wid * 64 + lane, wr = wid >> 2, wc = wid & 3, fr = lane & 15, fq = lane >> 4;
    const unsigned ldsw = (unsigned)wid * 1024u;
    const int aoff = lds_byte(wr * 64 + fr, fq * 8), boff = lds_byte(wc * 32 + fr, fq * 8);
#define PG8_SA(b, h) (((b) * 2 + (h)) * HTB)
#define PG8_SB(b, h) ((4 + (b) * 2 + (h)) * HTB)
#define PG8_STAGE(bufoff, gbase, voff) do { _Pragma("unroll") for (int _i = 0; _i < 2; ++_i) \
        __builtin_amdgcn_global_load_lds((const unsigned*)((const char*)(gbase) + (voff)[_i]), (LAS unsigned*)(lds + (bufoff) + ldsw + _i * 8192), 16, 0, 0); } while (0)
#define PG8_LDA(dst, b, h) do { _Pragma("unroll") for (int m = 0; m < 4; ++m) _Pragma("unroll") for (int k = 0; k < 2; ++k) dst[m][k] = *(const LAS bf16x8*)(lds + PG8_SA(b, h) + aoff + m * 2048 + k * 1024); } while (0)
#define PG8_LDB(dst, b, h) do { _Pragma("unroll") for (int n = 0; n < 2; ++n) _Pragma("unroll") for (int k = 0; k < 2; ++k) dst[n][k] = *(const LAS bf16x8*)(lds + PG8_SB(b, h) + boff + n * 2048 + k * 1024); } while (0)
#define PG8_MMA(ai, bj, At, Bt) do { __builtin_amdgcn_s_setprio(1); _Pragma("unroll") for (int m = 0; m < 4; ++m) _Pragma("unroll") for (int n = 0; n < 2; ++n) _Pragma("unroll") for (int k = 0; k < 2; ++k) \
        acc[ai][bj][m][n] = __builtin_amdgcn_mfma_f32_16x16x32_bf16(Bt[n][k], At[m][k], acc[ai][bj][m][n], 0, 0, 0); __builtin_amdgcn_s_setprio(0); } while (0)
#define PG8_WAIT_V(n) asm volatile("s_waitcnt vmcnt(" #n ")" ::: "memory")
#define PG8_WAIT_L(n) asm volatile("s_waitcnt lgkmcnt(" #n ")" ::: "memory")
#define PG8_BAR __builtin_amdgcn_s_barrier()
#define PG8_SCHED __builtin_amdgcn_sched_barrier(0)
    Unit cur, nxt; int ui = 0;
    if (!S.next(0, cur)) return;
    Voff vo, nvo;
    make_voff<Epi>(cur, vo, tid);
    f32x4 acc[2][2][4][2];
#pragma unroll
    for (int a = 0; a < 2; ++a)
#pragma unroll
        for (int b = 0; b < 2; ++b)
#pragma unroll
            for (int m = 0; m < 4; ++m)
#pragma unroll
                for (int n = 0; n < 2; ++n) acc[a][b][m][n] = (f32x4){0.f, 0.f, 0.f, 0.f};
    bf16x8 At[4][2], B0[2][2], B1[2][2];
    const char* cA = cur.A; const char* cB = cur.B;
    const size_t kstep = (size_t)(BK * 2);
    if constexpr (SP2) {
        PG8_STAGE(PG8_SB(0, 0), cB, vo.b[0]); PG8_STAGE(PG8_SB(0, 1), cB, vo.b[1]); PG8_STAGE(PG8_SA(0, 0), cA, vo.a[0]); PG8_STAGE(PG8_SA(0, 1), cA, vo.a[1]);
        if (wr == 1) PG8_BAR;
        PG8_WAIT_V(2); PG8_BAR;
        PG8_STAGE(PG8_SB(1, 0), cB + kstep, vo.b[0]); PG8_STAGE(PG8_SA(1, 0), cA + kstep, vo.a[0]); PG8_STAGE(PG8_SB(1, 1), cB + kstep, vo.b[1]);
        PG8_WAIT_V(6); PG8_BAR;
    } else {
        PG8_STAGE(PG8_SB(0, 0), cB, vo.b[0]); PG8_STAGE(PG8_SA(0, 0), cA, vo.a[0]); PG8_STAGE(PG8_SB(0, 1), cB, vo.b[1]); PG8_STAGE(PG8_SA(0, 1), cA, vo.a[1]);
        if (wr == 1) PG8_BAR;
        PG8_WAIT_V(4); PG8_BAR;
        PG8_STAGE(PG8_SB(1, 0), cB + kstep, vo.b[0]); PG8_STAGE(PG8_SA(1, 0), cA + kstep, vo.a[0]); PG8_STAGE(PG8_SB(1, 1), cB + kstep, vo.b[1]);
        PG8_WAIT_V(6); PG8_BAR;
    }
    for (;;) {
        const bool has_next = S.next(ui + 1, nxt);
        if (has_next) make_voff<Epi>(nxt, nvo, tid); else nvo = vo;
        const char* nA = has_next ? nxt.A : cA; const char* nB = has_next ? nxt.B : cB;
        const int nt = cur.nt;
        for (int t = 0; t < nt; t += 2) {
            const bool last = (t == nt - 2);
            const char* a1 = cA + (size_t)(t + 1) * kstep;
            const char* a2 = last ? nA : cA + (size_t)(t + 2) * kstep; const char* b2 = last ? nB : cB + (size_t)(t + 2) * kstep;
            const char* a3 = a2 + kstep; const char* b3 = b2 + kstep;
            Voff w;
#pragma unroll
            for (int h = 0; h < 2; ++h)
#pragma unroll
                for (int i = 0; i < 2; ++i) { w.a[h][i] = last ? nvo.a[h][i] : vo.a[h][i]; w.b[h][i] = last ? nvo.b[h][i] : vo.b[h][i]; }
            if constexpr (SP2) {
            PG8_LDB(B0, 0, 0); PG8_LDB(B1, 0, 1); PG8_SCHED; PG8_LDA(At, 0, 0); PG8_STAGE(PG8_SA(1, 1), a1, vo.a[1]);
            PG8_WAIT_V(8); PG8_WAIT_L(0); PG8_BAR; PG8_MMA(0, 0, At, B0); PG8_MMA(0, 1, At, B1); PG8_BAR; PG8_SCHED;
            PG8_LDA(At, 0, 1); PG8_STAGE(PG8_SB(0, 0), b2, w.b[0]); PG8_STAGE(PG8_SB(0, 1), b2, w.b[1]); PG8_STAGE(PG8_SA(0, 0), a2, w.a[0]);
            PG8_WAIT_V(8); PG8_WAIT_L(0); PG8_BAR; PG8_MMA(1, 0, At, B0); PG8_MMA(1, 1, At, B1); PG8_BAR; PG8_SCHED;
            PG8_LDB(B0, 1, 0); PG8_LDB(B1, 1, 1); PG8_SCHED; PG8_LDA(At, 1, 0); PG8_STAGE(PG8_SA(0, 1), a2, w.a[1]);
            PG8_WAIT_V(8); PG8_WAIT_L(0); PG8_BAR; PG8_MMA(0, 0, At, B0); PG8_MMA(0, 1, At, B1); PG8_BAR; PG8_SCHED;
            PG8_LDA(At, 1, 1); PG8_STAGE(PG8_SB(1, 0), b3, w.b[0]); PG8_STAGE(PG8_SB(1, 1), b3, w.b[1]); PG8_STAGE(PG8_SA(1, 0), a3, w.a[0]);
            PG8_WAIT_V(8); PG8_WAIT_L(0); PG8_BAR; PG8_MMA(1, 0, At, B0); PG8_MMA(1, 1, At, B1); PG8_BAR; PG8_SCHED;
            } else {
            PG8_LDB(B0, 0, 0); PG8_SCHED; PG8_LDA(At, 0, 0); PG8_STAGE(PG8_SA(1, 1), a1, vo.a[1]);
            PG8_WAIT_L(8); PG8_BAR; PG8_WAIT_L(0); PG8_MMA(0, 0, At, B0); PG8_BAR; PG8_SCHED;
            PG8_LDB(B1, 0, 1); PG8_STAGE(PG8_SB(0, 0), b2, w.b[0]);
            PG8_BAR; PG8_WAIT_L(0); PG8_MMA(0, 1, At, B1); PG8_BAR;
            PG8_LDA(At, 0, 1); PG8_STAGE(PG8_SA(0, 0), a2, w.a[0]);
            PG8_BAR; PG8_WAIT_L(0); PG8_MMA(1, 0, At, B0); PG8_BAR; PG8_SCHED;
            PG8_STAGE(PG8_SB(0, 1), b2, w.b[1]);
            PG8_WAIT_V(6); PG8_BAR; PG8_MMA(1, 1, At, B1); PG8_BAR;
            PG8_LDB(B0, 1, 0); PG8_SCHED; PG8_LDA(At, 1, 0); PG8_STAGE(PG8_SA(0, 1), a2, w.a[1]);
            PG8_WAIT_L(8); PG8_BAR; PG8_WAIT_L(0); PG8_MMA(0, 0, At, B0); PG8_BAR; PG8_SCHED;
            PG8_LDB(B1, 1, 1); PG8_STAGE(PG8_SB(1, 0), b3, w.b[0]);
            PG8_BAR; PG8_WAIT_L(0); PG8_MMA(0, 1, At, B1); PG8_BAR;
            PG8_LDA(At, 1, 1); PG8_STAGE(PG8_SA(1, 0), a3, w.a[0]);
            PG8_BAR; PG8_WAIT_L(0); PG8_MMA(1, 0, At, B0); PG8_BAR; PG8_SCHED;
            PG8_STAGE(PG8_SB(1, 1), b3, w.b[1]);
            PG8_WAIT_V(6); PG8_BAR; PG8_MMA(1, 1, At, B1); PG8_BAR;
            }
        }
        if constexpr (ALIGN_EPI) { if (wr == 0) PG8_BAR; }
        E(acc, cur, wr, wc, fr, fq, ex);
        if (!has_next) break;
#pragma unroll
        for (int a = 0; a < 2; ++a)
#pragma unroll
            for (int b = 0; b < 2; ++b)
#pragma unroll
                for (int m = 0; m < 4; ++m)
#pragma unroll
                    for (int n = 0; n < 2; ++n) acc[a][b][m][n] = (f32x4){0.f, 0.f, 0.f, 0.f};
        cur = nxt; cA = nA; cB = nB; vo = nvo; ++ui;
        if constexpr (ALIGN_EPI) { if (wr == 1) PG8_BAR; }
    }
    PG8_WAIT_V(0);
    if constexpr (!ALIGN_EPI) { if (wr == 0) PG8_BAR; }
    PG8_BAR;
#undef PG8_SA
#undef PG8_SB
#undef PG8_STAGE
#undef PG8_LDA
#undef PG8_LDB
#undef PG8_MMA
#undef PG8_WAIT_V
#undef PG8_WAIT_L
#undef PG8_BAR
#undef PG8_SCHED
}

struct TileOrder {
    int nM, nN, nwg, G, c;
    __device__ void init(int M, int N, int G_, int c_) { nM = M / BM; nN = N / BM; nwg = nM * nN; G = G_; c = c_; }
    __device__ bool tile(int i, int& pm, int& pn) const {
        const long L = (long)i * G + c; if (L >= nwg) return false;
        int wgid = (int)L; { const int q = nwg / 8, r = nwg % 8, xcd = wgid % 8, off = wgid / 8; wgid = (xcd < r ? xcd * (q + 1) : r * (q + 1) + (xcd - r) * q) + off; }
        const int nig = 8 * nN, gid = wgid / nig, fm = gid * 8, gsz = (nM - fm) < 8 ? (nM - fm) : 8;
        pm = fm + ((wgid % nig) % gsz); pn = (wgid % nig) / gsz; return true;
    }
};
}

typedef float f32x2 __attribute__((ext_vector_type(2)));
#define ACC_T f32x4 (&acc)[2][2][4][2]

struct EpiProj {
    __device__ static __forceinline__ int brow(int h, int R) { return pg8::brow_rope(h, R); }
    unsigned char* ws; const float *qg, *kg;
    __device__ static __forceinline__ void rot4(const f32x4 x1, const f32x4 x2, const f32x4 t0, const f32x4 t1, f32x4& y1, f32x4& y2) {
        y1.x = x1.x * t0.x - x2.x * t0.y; y2.x = x2.x * t0.x + x1.x * t0.y;
        y1.y = x1.y * t0.z - x2.y * t0.w; y2.y = x2.y * t0.z + x1.y * t0.w;
        y1.z = x1.z * t1.x - x2.z * t1.y; y2.z = x2.z * t1.x + x1.z * t1.y;
        y1.w = x1.w * t1.z - x2.w * t1.w; y2.w = x2.w * t1.z + x1.w * t1.w;
    }
    __device__ static __forceinline__ void store8(bf16_t* dst, const f32x4 a, const f32x4 b) {
        u32x4 w; w.x = cvtpk(a.x, a.y); w.y = cvtpk(a.z, a.w); w.z = cvtpk(b.x, b.y); w.w = cvtpk(b.z, b.w); *(u32x4*)dst = w; }
    __device__ __forceinline__ void operator()(ACC_T, const pg8::Unit& u, int wr, int wc, int fr, int fq, LAS unsigned char* ex) const {
        const int ng = 2 * u.pn + (wc >> 1), c0 = 32 * (wc & 1) + 8 * fq;
        if (ng < 72) {
            const int which = ng / 24, hh = ng % 24, g = hh >> 3, h = hh & 7;
            bf16_t* buf = (bf16_t*)(ws + WS_QA + (size_t)which * (WS_KA - WS_QA));
            const float2* rt1 = (const float2*)(ws + WS_RT1);
#pragma unroll
            for (int ai = 0; ai < 2; ++ai)
#pragma unroll
                for (int m = 0; m < 4; ++m) {
                    const int mrow = u.pm * 256 + ai * 128 + wr * 64 + m * 16 + fr, b = mrow >> 12, t = mrow & 4095;
                    bf16_t* dst = buf + ((size_t)((g * 2 + b) * 8 + h) * SEQ + perm_pos(g, t)) * HD + c0;
                    f32x4 y1a = acc[ai][0][m][0], y1b = acc[ai][0][m][1], y2a = acc[ai][1][m][0], y2b = acc[ai][1][m][1];
                    if (which < 2) {
                        const f32x4* tp = (const f32x4*)(rt1 + (size_t)t * 64 + c0);
                        const f32x4 t0 = tp[0], t1 = tp[1], t2 = tp[2], t3 = tp[3];
                        rot4(acc[ai][0][m][0], acc[ai][1][m][0], t0, t1, y1a, y2a); rot4(acc[ai][0][m][1], acc[ai][1][m][1], t2, t3, y1b, y2b);
                    }
                    store8(dst, y1a, y1b); store8(dst + 64, y2a, y2b);
                }
        } else if (ng < 92) {
            const int k = ng - 72;
            LAS float* X = (LAS float*)ex;
#pragma unroll
            for (int ai = 0; ai < 2; ++ai)
#pragma unroll
                for (int m = 0; m < 4; ++m) { float s = 0.f;
#pragma unroll
                    for (int bj = 0; bj < 2; ++bj)
#pragma unroll
                        for (int n = 0; n < 2; ++n) { const f32x4 x = acc[ai][bj][m][n]; s += (x.x * x.x + x.y * x.y) + (x.z * x.z + x.w * x.w); }
                    s += __shfl_xor(s, 16); s += __shfl_xor(s, 32);
                    if (fq == 0) X[(ai * 128 + wr * 64 + m * 16 + fr) * 4 + wc] = s; }
            asm volatile("s_waitcnt lgkmcnt(0)" ::: "memory"); __builtin_amdgcn_s_barrier(); asm volatile("" ::: "memory");
            const float* gn = (k < 16) ? qg : kg; const float2* rt2 = (const float2*)(ws + WS_RT2);
            bf16_t* qb = (bf16_t*)(ws + WS_QB); bf16_t* kb = (bf16_t*)(ws + WS_KB);
            const f32x4 g1a = *(const f32x4*)(gn + c0), g1b = *(const f32x4*)(gn + c0 + 4), g2a = *(const f32x4*)(gn + 64 + c0), g2b = *(const f32x4*)(gn + 64 + c0 + 4);
#pragma unroll
            for (int ai = 0; ai < 2; ++ai)
#pragma unroll
                for (int m = 0; m < 4; ++m) {
                    const int r = ai * 128 + wr * 64 + m * 16 + fr;
                    const float ssum = X[r * 4 + (wc & 2)] + X[r * 4 + (wc & 2) + 1];
                    const int mrow = u.pm * 256 + r, b = mrow >> 12, t = mrow & 4095;
                    bf16_t* dst = ((k < 16) ? qb + ((size_t)(b * 16 + k) * SEQ + t) * HD : kb + ((size_t)(b * 4 + (k - 16)) * SEQ + t) * HD) + c0;
                    const float rinv = 1.0f / sqrtf(ssum * (1.0f / 128.0f) + RMS_EPS);
                    const f32x4* tp = (const f32x4*)(rt2 + (size_t)t * 64 + c0);
                    const f32x4 t0 = tp[0], t1 = tp[1], t2 = tp[2], t3 = tp[3];
                    f32x4 y1a, y1b, y2a, y2b;
                    rot4(acc[ai][0][m][0] * rinv * g1a, acc[ai][1][m][0] * rinv * g2a, t0, t1, y1a, y2a); rot4(acc[ai][0][m][1] * rinv * g1b, acc[ai][1][m][1] * rinv * g2b, t2, t3, y1b, y2b);
                    store8(dst, y1a, y1b); store8(dst + 64, y2a, y2b);
                }
        } else {
#pragma unroll
            for (int ai = 0; ai < 2; ++ai)
#pragma unroll
                for (int m = 0; m < 4; ++m) {
                    const int mrow = u.pm * 256 + ai * 128 + wr * 64 + m * 16 + fr, b = mrow >> 12, t = mrow & 4095;
                    bf16_t* dst = (ng < 96 ? (bf16_t*)(ws + WS_VB) + ((size_t)(b * 4 + (ng - 92)) * SEQ + t) * HD : (bf16_t*)(ws + WS_GATES) + (size_t)mrow * 4096 + (ng - 96) * 128) + c0;
                    f32x4 y1a = acc[ai][0][m][0], y1b = acc[ai][0][m][1], y2a = acc[ai][1][m][0], y2b = acc[ai][1][m][1];
                    if (ng >= 96) {
#pragma unroll
                        for (int q = 0; q < 4; ++q) { y1a[q] = __builtin_amdgcn_rcpf(1.0f + __expf(-y1a[q])); y1b[q] = __builtin_amdgcn_rcpf(1.0f + __expf(-y1b[q]));
                            y2a[q] = __builtin_amdgcn_rcpf(1.0f + __expf(-y2a[q])); y2b[q] = __builtin_amdgcn_rcpf(1.0f + __expf(-y2b[q])); } }
                    store8(dst, y1a, y1b); store8(dst + 64, y2a, y2b);
                }
        }
    }
};
struct ProjSched {
    pg8::TileOrder o; const char* ws;
    __device__ __forceinline__ bool next(int i, pg8::Unit& u) const { int pm, pn; if (!o.tile(i, pm, pn)) return false;
        u.A = ws + WS_XB + (size_t)pm * 256 * (DM * 2); u.B = ws + WS_WINT + (size_t)pn * 256 * (DM * 2); u.lda = DM * 2; u.ldb = DM * 2; u.nt = DM / 64; u.pm = pm; u.pn = pn; u.aux = 0; u.gidx = nullptr; u.gcnt = 0; return true; }
};

struct EpiMix {
    __device__ static __forceinline__ int brow(int h, int R) { return pg8::brow_perm8(h, R); }
    unsigned char* ws; const float* x;
    __device__ __forceinline__ void operator()(ACC_T, const pg8::Unit& u, int wr, int wc, int fr, int fq, LAS unsigned char* ex) const {
        const bf16_t* gates = (const bf16_t*)(ws + WS_GATES); float* T = (float*)(ws + WS_T); bf16_t* merged = (bf16_t*)(ws + WS_MERGED); float* pre1 = (float*)(ws + WS_PRE1);
#pragma unroll
        for (int ai = 0; ai < 2; ++ai)
#pragma unroll
            for (int m = 0; m < 4; ++m) { const size_t mrow = (size_t)u.pm * 256 + ai * 128 + wr * 64 + m * 16 + fr;
#pragma unroll
                for (int bj = 0; bj < 2; ++bj) { const int col = u.pn * 256 + bj * 128 + wc * 32 + 8 * fq; const size_t o = mrow * DM + col;
                    const f32x4 a0 = acc[ai][bj][m][0], a1 = acc[ai][bj][m][1];
                    if (u.aux == 2) {
                        const f32x4 x0 = *(const f32x4*)(x + o), x1 = *(const f32x4*)(x + o + 4);
                        *(f32x4*)(pre1 + o) = x0 * ALPHA + a0; *(f32x4*)(pre1 + o + 4) = x1 * ALPHA + a1;
                    } else {
                        const u32x4 gw = *(const u32x4*)(gates + mrow * 4096 + (u.aux ? 2048 : 0) + col);
                        f32x4 g0, g1; g0.x = bflo(gw.x); g0.y = bfhi(gw.x); g0.z = bflo(gw.y); g0.w = bfhi(gw.y); g1.x = bflo(gw.z); g1.y = bfhi(gw.z); g1.z = bflo(gw.w); g1.w = bfhi(gw.w);
                        if (u.aux == 0) { *(f32x4*)(T + o) = g0 * a0; *(f32x4*)(T + o + 4) = g1 * a1; }
                        else { const f32x4 t0 = *(const f32x4*)(T + o) + g0 * a0, t1 = *(const f32x4*)(T + o + 4) + g1 * a1;
                            u32x4 w; w.x = cvtpk(t0.x, t0.y); w.y = cvtpk(t0.z, t0.w); w.z = cvtpk(t1.x, t1.y); w.w = cvtpk(t1.z, t1.w); *(u32x4*)(merged + o) = w; }
                    } } }
    }
};
struct MixSched {
    int mode, c; const char* ws;
    __device__ __forceinline__ bool next(int i, pg8::Unit& u) const {
        if (c >= 256) return false;
        const int pm = c >> 3, pn = c & 7; u.pm = pm; u.pn = pn; u.gidx = nullptr; u.gcnt = 0;
        if (mode == 0) { if (i > 1) return false;
            if (i == 0) { u.A = ws + WS_OA + (size_t)pm * 256 * 2048; u.B = ws + WS_WAT + (size_t)pn * 256 * 2048; u.lda = 2048; u.ldb = 2048; u.nt = 16; u.aux = 0; }
            else { u.A = ws + WS_OB + (size_t)pm * 256 * 4096; u.B = ws + WS_WBT + (size_t)pn * 256 * 4096; u.lda = 4096; u.ldb = 4096; u.nt = 32; u.aux = 1; }
            return true; }
        if (i > 0) return false;
        u.A = ws + WS_MERGED + (size_t)pm * 256 * 4096; u.B = ws + WS_WOT + (size_t)pn * 256 * 4096; u.lda = 4096; u.ldb = 4096; u.nt = 32; u.aux = 2; return true;
    }
};

struct MoeSched {
    int G, vcu, down; unsigned cnt_l, tpe_l;
    const char* ws;
    __device__ __forceinline__ void init(const unsigned* cnt, int lane) {
        unsigned c = 0; if (lane < NEXP) c = __hip_atomic_load(cnt + lane, __ATOMIC_RELAXED, __HIP_MEMORY_SCOPE_AGENT);
        unsigned t = (c + 255u) >> 8, inc = t;
#pragma unroll
        for (int o = 1; o < 32; o <<= 1) { const unsigned v = __shfl_up(inc, o); if ((lane & 31) >= o) inc += v; }
        cnt_l = c; tpe_l = inc - t;
    }
    __device__ __forceinline__ bool next(int i, pg8::Unit& u) const {
        const int lane = lane_id();
        const int total = (int)__builtin_amdgcn_readfirstlane(__shfl(tpe_l + ((cnt_l + 255u) >> 8), 31));
        const int L = i * G + vcu; if (L >= total * 8) return false;
        const int tg = L >> 3;
        const unsigned long long mk = __ballot(lane < NEXP && (int)tpe_l <= tg && (cnt_l > 0u));
        const int e = 63 - __builtin_clzll(mk);
        const int tp = (int)__builtin_amdgcn_readfirstlane(__shfl(tpe_l, e)), ce = (int)__builtin_amdgcn_readfirstlane(__shfl(cnt_l, e));
        const int te = (ce + 255) >> 8, q = L - 8 * tp, j = q / te, mt = q - j * te;
        u.pm = tp + mt; u.pn = j; u.aux = e; u.nt = down ? 16 : 32;
        if (!down) { u.A = ws + WS_H1B; u.lda = DM * 2; u.gidx = (const int*)(ws + WS_TOKIDX) + (size_t)e * ECAP + 256 * mt; u.gcnt = ce - 256 * mt; u.B = ws + WS_WGUT + ((size_t)e * 2048 + j * 256) * (DM * 2); u.ldb = DM * 2; }
        else { u.A = ws + WS_ACT + (size_t)(tp + mt) * 256 * (FF * 2); u.lda = FF * 2; u.gidx = nullptr; u.gcnt = 0; u.B = ws + WS_WDT + ((size_t)e * 2048 + j * 256) * (FF * 2); u.ldb = FF * 2; }
        return true;
    }
};
struct EpiMoe {
    __device__ static __forceinline__ int brow(int h, int R) { return pg8::brow_perm8(h, R); }
    int down; unsigned char* ws;
    __device__ __forceinline__ void operator()(ACC_T, const pg8::Unit& u, int wr, int wc, int fr, int fq, LAS unsigned char* ex) const {
        bf16_t* act = (bf16_t*)(ws + WS_ACT); bf16_t* y = (bf16_t*)(ws + WS_Y);
#pragma unroll
        for (int ai = 0; ai < 2; ++ai)
#pragma unroll
            for (int m = 0; m < 4; ++m) { const size_t row = (size_t)u.pm * 256 + ai * 128 + wr * 64 + m * 16 + fr;
                if (!down) {
                    f32x4 v0, v1;
#pragma unroll
                    for (int q = 0; q < 4; ++q) { const float g0 = acc[ai][0][m][0][q], u0 = acc[ai][1][m][0][q], g1 = acc[ai][0][m][1][q], u1 = acc[ai][1][m][1][q];
                        v0[q] = g0 * __builtin_amdgcn_rcpf(1.0f + __expf(-g0)) * u0; v1[q] = g1 * __builtin_amdgcn_rcpf(1.0f + __expf(-g1)) * u1; }
                    u32x4 w; w.x = cvtpk(v0.x, v0.y); w.y = cvtpk(v0.z, v0.w); w.z = cvtpk(v1.x, v1.y); w.w = cvtpk(v1.z, v1.w);
                    *(u32x4*)(act + row * FF + u.pn * 128 + wc * 32 + 8 * fq) = w;
                } else {
#pragma unroll
                    for (int bj = 0; bj < 2; ++bj) { const f32x4 a0 = acc[ai][bj][m][0], a1 = acc[ai][bj][m][1];
                        u32x4 w; w.x = cvtpk(a0.x, a0.y); w.y = cvtpk(a0.z, a0.w); w.z = cvtpk(a1.x, a1.y); w.w = cvtpk(a1.z, a1.w);
                        *(u32x4*)(y + row * DM + u.pn * 256 + bj * 128 + wc * 32 + 8 * fq) = w; }
                } }
    }
};

namespace att {
constexpr int D = 128, NW = 8, QBLK = 32, KVBLK = 64;
constexpr float SCALE = SM_SCALE, THR = 8.f;
constexpr int SHM_V = KVBLK * D * 2, SHM_K = KVBLK * D * 2, SHM_ATTN = 2 * SHM_V + 2 * SHM_K + NW * 64 * 4;
#define KSWZ(row, colB) ((row) * 256 + ((colB) ^ (((row) & 7) << 4)))
#define SBAR() __builtin_amdgcn_sched_barrier(0)
__device__ __forceinline__ int crow(int r, int hi) { return (r & 3) + 8 * (r >> 2) + 4 * hi; }
template <bool BAND> __device__ __forceinline__ void partialSM(f32x16& p0, f32x16& p1, float& m_reg, float& mn, float& alpha, int dv, bool tv) {
    constexpr float C = SCALE * 1.4426950408889634f;
    if constexpr (BAND) {
#pragma unroll
        for (int r = 0; r < 16; ++r) { const int kx = (r & 3) + 8 * (r >> 2);
            if (!tv || (unsigned)(dv + kx) > 128u) p0[r] = -INFINITY;
            if (!tv || (unsigned)(dv + kx + 32) > 128u) p1[r] = -INFINITY; } }
    float pmax = p0[0];
#pragma unroll
    for (int r = 1; r < 16; ++r) pmax = fmaxf(pmax, p0[r]);
#pragma unroll
    for (int r = 0; r < 16; ++r) pmax = fmaxf(pmax, p1[r]);
    { auto rr = __builtin_amdgcn_permlane32_swap(__float_as_uint(pmax), __float_as_uint(pmax), false, false);
      pmax = fmaxf(__uint_as_float(rr[0]), __uint_as_float(rr[1])); }
    if (__builtin_expect(__all(pmax - m_reg <= THR / SCALE), 1)) { mn = m_reg; alpha = 1.f; }
    else { mn = fmaxf(m_reg, pmax); alpha = __builtin_amdgcn_exp2f((m_reg - mn) * C); m_reg = mn; }
    const float mnC = -mn * C;
#pragma unroll
    for (int r = 0; r < 16; ++r) p0[r] = fmaf(p0[r], C, mnC);
#pragma unroll
    for (int r = 0; r < 16; ++r) p1[r] = fmaf(p1[r], C, mnC);
#pragma unroll
    for (int r = 0; r < 16; ++r) p0[r] = __builtin_amdgcn_exp2f(p0[r]);
}
__device__ __forceinline__ void finishSM(f32x16& p0, f32x16& p1, float alpha, float& l_reg, bf16x8& pa0, bf16x8& pa1, bf16x8& pa2, bf16x8& pa3) {
#pragma unroll
    for (int r = 0; r < 16; ++r) p1[r] = __builtin_amdgcn_exp2f(p1[r]);
    float ps = 0;
#pragma unroll
    for (int r = 0; r < 16; ++r) ps += p0[r];
#pragma unroll
    for (int r = 0; r < 16; ++r) ps += p1[r];
    { auto rr = __builtin_amdgcn_permlane32_swap(__float_as_uint(ps), __float_as_uint(ps), false, false);
      ps = __uint_as_float(rr[0]) + __uint_as_float(rr[1]); }
    l_reg = l_reg * alpha + ps;
#define PK4(P, BASE, OUT) do { unsigned a0 = cvtpk(P[BASE + 0], P[BASE + 1]), a1 = cvtpk(P[BASE + 2], P[BASE + 3]);   \
    unsigned b0 = cvtpk(P[BASE + 4], P[BASE + 5]), b1 = cvtpk(P[BASE + 6], P[BASE + 7]);                              \
    auto r0 = __builtin_amdgcn_permlane32_swap(a0, b0, false, false); auto r1 = __builtin_amdgcn_permlane32_swap(a1, b1, false, false); \
    u32x4 w = {r0[0], r1[0], r0[1], r1[1]}; OUT = *reinterpret_cast<bf16x8*>(&w); } while (0)
    PK4(p0, 0, pa0); PK4(p0, 8, pa1); PK4(p1, 0, pa2); PK4(p1, 8, pa3);
#undef PK4
}
__device__ __forceinline__ void qkt(f32x16& p0, f32x16& p1, const LAS unsigned char* Ks, const bf16x8* qr, int r32, int hi) {
    p0 = f32x16{}; p1 = f32x16{};
#pragma unroll
    for (int d0 = 0; d0 < 8; ++d0) { const int cb = (d0 * 16 + hi * 8) * 2;
        const bf16x8 b0 = *(const LAS bf16x8*)(Ks + KSWZ(r32, cb));
        const bf16x8 b1 = *(const LAS bf16x8*)(Ks + KSWZ(32 + r32, cb));
        p0 = __builtin_amdgcn_mfma_f32_32x32x16_bf16(b0, qr[d0], p0, 0, 0, 0);
        p1 = __builtin_amdgcn_mfma_f32_32x32x16_bf16(b1, qr[d0], p1, 0, 0, 0); }
}
__device__ __forceinline__ int v_st(int k, int c) { const int kk = (k & ~0xC) | ((k & 4) << 1) | ((k & 8) >> 1); return ((kk >> 3) * 4 + (c >> 5)) * 512 + ((kk & 7) * 32 + (c & 31)) * 2; }
__device__ __forceinline__ int v_rd_base(int lane) { return ((lane & 3) << 3) | (((lane >> 2) & 3) << 6) | (((lane >> 4) & 1) << 5) | (((lane >> 5) & 1) << 8); }
constexpr int v_rd_off(int d0, int ks, int half) { return d0 * 512 + ks * 4096 + half * 2048; }
template <int OFF> __device__ __forceinline__ s16x4 tr_read(int vb) { s16x4 r; asm volatile("ds_read_b64_tr_b16 %0, %1 offset:%2" : "=&v"(r) : "v"(vb), "i"(OFF) : "memory"); return r; }
template <int D0> __device__ __forceinline__ void pv_one(f32x16& od, int vb, bf16x8 pa0, bf16x8 pa1, bf16x8 pa2, bf16x8 pa3) {
    const s16x4 l0 = tr_read<v_rd_off(D0, 0, 0)>(vb), h0 = tr_read<v_rd_off(D0, 0, 1)>(vb), l1 = tr_read<v_rd_off(D0, 1, 0)>(vb), h1 = tr_read<v_rd_off(D0, 1, 1)>(vb);
    const s16x4 l2 = tr_read<v_rd_off(D0, 2, 0)>(vb), h2 = tr_read<v_rd_off(D0, 2, 1)>(vb), l3 = tr_read<v_rd_off(D0, 3, 0)>(vb), h3 = tr_read<v_rd_off(D0, 3, 1)>(vb);
    asm volatile("s_waitcnt lgkmcnt(0)" ::: "memory"); SBAR();
#define PK(L, H) (bf16x8){L[0], L[1], L[2], L[3], H[0], H[1], H[2], H[3]}
    od = __builtin_amdgcn_mfma_f32_32x32x16_bf16(pa0, PK(l0, h0), od, 0, 0, 0);
    od = __builtin_amdgcn_mfma_f32_32x32x16_bf16(pa1, PK(l1, h1), od, 0, 0, 0);
    od = __builtin_amdgcn_mfma_f32_32x32x16_bf16(pa2, PK(l2, h2), od, 0, 0, 0);
    od = __builtin_amdgcn_mfma_f32_32x32x16_bf16(pa3, PK(l3, h3), od, 0, 0, 0);
#undef PK
}
__device__ __forceinline__ void pv_d0(f32x16* o, int vb, bf16x8 pa0, bf16x8 pa1, bf16x8 pa2, bf16x8 pa3) {
    pv_one<0>(o[0], vb, pa0, pa1, pa2, pa3); pv_one<1>(o[1], vb, pa0, pa1, pa2, pa3); pv_one<2>(o[2], vb, pa0, pa1, pa2, pa3); pv_one<3>(o[3], vb, pa0, pa1, pa2, pa3);
}
struct Unit { const bf16_t *Q, *K, *V; bf16_t* O; float* lse; int ldo, lse_stride, nt, kt0, klo, khi, q0; };
__device__ __forceinline__ void body(const Unit& u, LAS unsigned char* lds, int wid) {
    const int lane = lane_id(), tid = wid * 64 + lane,
        r32 = lane & 31, hi = lane >> 5;
    LAS unsigned char* V_lds = lds; LAS unsigned char* K_lds = lds + 2 * SHM_V;
    LAS float* ws = (LAS float*)(lds + 2 * SHM_V + 2 * SHM_K) + wid * 64; LAS float* li_l = ws; LAS float* al_l = ws + 32;
    float m_reg = -1e30f, l_reg = 0; f32x16 o[4] = {}; bf16x8 qr[8];
    const bf16_t* Qw = u.Q + (size_t)(wid * QBLK + r32) * D + hi * 8;
#pragma unroll
    for (int d0 = 0; d0 < 8; ++d0) qr[d0] = *(const bf16x8*)(Qw + d0 * 16);
    const int sr = tid >> 4, sc = (tid & 15) * 8, vst0 = v_st(sr, sc), vst1 = v_st(32 + sr, sc);
    const int vb0 = (int)(unsigned)(uintptr_t)V_lds + v_rd_base(lane);
    const bf16_t* Kh = u.K; const bf16_t* Vh = u.V;
    constexpr bool BAND = false; constexpr int SD = 1; const int dq = 0;
#define TVALID(j) true
    struct { bf16x8 vs0, vs1, ks0, ks1; } sr_[SD];
#define KROW(j) (BAND ? ((u.kt0 + 64 * (j)) < u.klo ? u.klo : ((u.kt0 + 64 * (j)) > u.khi - 64 ? u.khi - 64 : (u.kt0 + 64 * (j)))) : (u.kt0 + 64 * (j)))
#define SLOAD(i, j) do { const int k0_ = KROW(j); sr_[i].vs0 = *(const bf16x8*)(&Vh[(size_t)(k0_ + sr) * D + sc]); sr_[i].vs1 = *(const bf16x8*)(&Vh[(size_t)(k0_ + 32 + sr) * D + sc]); \
    sr_[i].ks0 = *(const bf16x8*)(&Kh[(size_t)(k0_ + sr) * D + sc]); sr_[i].ks1 = *(const bf16x8*)(&Kh[(size_t)(k0_ + 32 + sr) * D + sc]); } while (0)
#define SWRITE(b, i) do { *(LAS bf16x8*)(V_lds + (b) * SHM_V + vst0) = sr_[i].vs0; *(LAS bf16x8*)(V_lds + (b) * SHM_V + vst1) = sr_[i].vs1; const int kc = sc * 2; \
    *(LAS bf16x8*)(K_lds + (b) * SHM_K + KSWZ(sr, kc)) = sr_[i].ks0; *(LAS bf16x8*)(K_lds + (b) * SHM_K + KSWZ(32 + sr, kc)) = sr_[i].ks1; } while (0)
#define SWAIT() do { if constexpr (SD == 2) asm volatile("s_waitcnt vmcnt(4)" ::: "memory"); else asm volatile("s_waitcnt vmcnt(0)" ::: "memory"); } while (0)
#define RESC(a) do { if (__any((a) < 1.f)) { if (hi == 0) al_l[r32] = (a); asm volatile("s_waitcnt lgkmcnt(0)" ::: "memory"); \
    _Pragma("unroll") for (int d = 0; d < 4; ++d) _Pragma("unroll") for (int r = 0; r < 16; ++r) o[d][r] *= al_l[crow(r, hi)]; } } while (0)
    f32x16 pA0, pA1, pB0, pB1; float mnA, mnB, alA, alB; bf16x8 pa0, pa1, pa2, pa3; const int NT = u.nt;
    constexpr int SE = 0, SO = SD - 1;
    SLOAD(SE, 0); asm volatile("s_waitcnt vmcnt(0)" ::: "memory"); SWRITE(0, SE); __syncthreads();
    qkt(pA0, pA1, K_lds, qr, r32, hi); partialSM<BAND>(pA0, pA1, m_reg, mnA, alA, dq, TVALID(0));
    SLOAD(SO, 1); if constexpr (SD == 2) { if (2 < NT) SLOAD(SE, 2); }
    SWAIT(); SWRITE(1, SO); __syncthreads();
    for (int j = 1; j + 1 < NT; j += 2) {
        SBAR(); qkt(pB0, pB1, K_lds + SHM_K, qr, r32, hi);
        finishSM(pA0, pA1, alA, l_reg, pa0, pa1, pa2, pa3); SBAR();
        SLOAD(SO, j + SD); SBAR();
        pv_d0(o, vb0, pa0, pa1, pa2, pa3); partialSM<BAND>(pB0, pB1, m_reg, mnB, alB, dq + 64 * j, TVALID(j));
        __syncthreads(); SWAIT(); SWRITE(0, SE);
        RESC(alB); __syncthreads();
        SBAR(); qkt(pA0, pA1, K_lds, qr, r32, hi);
        finishSM(pB0, pB1, alB, l_reg, pa0, pa1, pa2, pa3); SBAR();
        if (SD == 1 || j + 3 < NT) SLOAD(SE, j + 1 + SD); SBAR();
        pv_d0(o, vb0 + SHM_V, pa0, pa1, pa2, pa3); partialSM<BAND>(pA0, pA1, m_reg, mnA, alA, dq + 64 * (j + 1), TVALID(j + 1));
        __syncthreads(); SWAIT(); SWRITE(1, SO);
        RESC(alA); __syncthreads();
    }
    SBAR(); qkt(pB0, pB1, K_lds + SHM_K, qr, r32, hi);
    finishSM(pA0, pA1, alA, l_reg, pa0, pa1, pa2, pa3); SBAR();
    pv_d0(o, vb0, pa0, pa1, pa2, pa3); partialSM<BAND>(pB0, pB1, m_reg, mnB, alB, dq + 64 * (NT - 1), TVALID(NT - 1));
    __syncthreads(); RESC(alB);
    finishSM(pB0, pB1, alB, l_reg, pa0, pa1, pa2, pa3); SBAR();
    pv_d0(o, vb0 + SHM_V, pa0, pa1, pa2, pa3);
    if (hi == 0) li_l[r32] = l_reg; asm volatile("s_waitcnt lgkmcnt(0)" ::: "memory");
    float rli[16];
#pragma unroll
    for (int r = 0; r < 16; ++r) rli[r] = __builtin_amdgcn_rcpf(li_l[crow(r, hi)]);
    bf16_t* Ow = u.O + (size_t)(wid * QBLK) * u.ldo;
#pragma unroll
    for (int r = 0; r < 16; ++r) { const int orow = crow(r, hi);
#pragma unroll
        for (int d0 = 0; d0 < 4; ++d0) Ow[(size_t)orow * u.ldo + d0 * 32 + r32] = f2bf(o[d0][r] * rli[r]); }
    if (u.lse && hi == 0) u.lse[(size_t)(wid * QBLK + r32) * u.lse_stride] = m_reg * SCALE + __logf(l_reg);
    __syncthreads();
#undef KROW
#undef TVALID
#undef SLOAD
#undef SWRITE
#undef SWAIT
#undef RESC
}

__device__ __forceinline__ void band_body(const Unit& u, LAS unsigned char* lds, int wid) {
    const int lane = lane_id(), tid = wid * 64 + lane, r32 = lane & 31, hi = lane >> 5;
    LAS unsigned char* V_lds = lds; LAS unsigned char* K_lds = lds + 2 * SHM_V;
    LAS float* ws = (LAS float*)(lds + 2 * SHM_V + 2 * SHM_K) + wid * 64; LAS float* li_l = ws; LAS float* al_l = ws + 32;
    float m_reg = -1e30f, l_reg = 0; f32x16 o[4] = {}; bf16x8 qr[8];
    const bf16_t* Qw = u.Q + (size_t)(wid * QBLK + r32) * D + hi * 8;
#pragma unroll
    for (int d0 = 0; d0 < 8; ++d0) qr[d0] = *(const bf16x8*)(Qw + d0 * 16);
    const int sr = tid >> 4, sc = (tid & 15) * 8, vst0 = v_st(sr, sc), vst1 = v_st(32 + sr, sc);
    const int vb0 = (int)(unsigned)(uintptr_t)V_lds + v_rd_base(lane);
    const bf16_t* Kh = u.K; const bf16_t* Vh = u.V;
    const int dq = u.kt0 - (u.q0 + wid * QBLK + r32) + 4 * hi + 64;
    bf16x8 vs0, vs1, ks0, ks1;
#define KROW(j) ((u.kt0 + 64 * (j)) < u.klo ? u.klo : ((u.kt0 + 64 * (j)) > u.khi - 64 ? u.khi - 64 : (u.kt0 + 64 * (j))))
#define TVALID(j) ((u.kt0 + 64 * (j)) >= u.klo && (u.kt0 + 64 * (j)) < u.khi)
#define SLOAD(j) do { const int k0_ = KROW(j); vs0 = *(const bf16x8*)(&Vh[(size_t)(k0_ + sr) * D + sc]); vs1 = *(const bf16x8*)(&Vh[(size_t)(k0_ + 32 + sr) * D + sc]); \
    ks0 = *(const bf16x8*)(&Kh[(size_t)(k0_ + sr) * D + sc]); ks1 = *(const bf16x8*)(&Kh[(size_t)(k0_ + 32 + sr) * D + sc]); } while (0)
#define SWRITE(b) do { *(LAS bf16x8*)(V_lds + (b) * SHM_V + vst0) = vs0; *(LAS bf16x8*)(V_lds + (b) * SHM_V + vst1) = vs1; const int kc = sc * 2; \
    *(LAS bf16x8*)(K_lds + (b) * SHM_K + KSWZ(sr, kc)) = ks0; *(LAS bf16x8*)(K_lds + (b) * SHM_K + KSWZ(32 + sr, kc)) = ks1; } while (0)
    const int NT = u.nt;
    SLOAD(0); asm volatile("s_waitcnt vmcnt(0)" ::: "memory"); SWRITE(0);
    if (1 < NT) SLOAD(1);
    __syncthreads();
    for (int j = 0; j < NT; ++j) {
        const int cur = j & 1;
        f32x16 p0, p1; float mn, al; bf16x8 pa0, pa1, pa2, pa3;
        qkt(p0, p1, K_lds + cur * SHM_K, qr, r32, hi);
        partialSM<true>(p0, p1, m_reg, mn, al, dq + 64 * j, TVALID(j));
        if (__any(al < 1.f)) { if (hi == 0) al_l[r32] = al; asm volatile("s_waitcnt lgkmcnt(0)" ::: "memory");
#pragma unroll
            for (int d = 0; d < 4; ++d)
#pragma unroll
                for (int r = 0; r < 16; ++r) o[d][r] *= al_l[crow(r, hi)]; }
        finishSM(p0, p1, al, l_reg, pa0, pa1, pa2, pa3); SBAR();
        if (j + 1 < NT) { asm volatile("s_waitcnt vmcnt(0)" ::: "memory"); SWRITE(cur ^ 1); }
        if (j + 2 < NT) SLOAD(j + 2);
        SBAR();
        pv_d0(o, vb0 + cur * SHM_V, pa0, pa1, pa2, pa3);
        __syncthreads();
    }
    if (hi == 0) li_l[r32] = l_reg; asm volatile("s_waitcnt lgkmcnt(0)" ::: "memory");
    float rli[16];
#pragma unroll
    for (int r = 0; r < 16; ++r) rli[r] = __builtin_amdgcn_rcpf(li_l[crow(r, hi)]);
    bf16_t* Ow = u.O + (size_t)(wid * QBLK) * u.ldo;
#pragma unroll
    for (int r = 0; r < 16; ++r) { const int orow = crow(r, hi);
#pragma unroll
        for (int d0 = 0; d0 < 4; ++d0) Ow[(size_t)orow * u.ldo + d0 * 32 + r32] = f2bf(o[d0][r] * rli[r]); }
    if (hi == 0) u.lse[(size_t)(wid * QBLK + r32) * u.lse_stride] = m_reg * SCALE + __logf(l_reg);
    __syncthreads();
#undef KROW
#undef TVALID
#undef SLOAD
#undef SWRITE
}
}

#define XB_TMO      128
#define XB_XCNT(j)  (256  + 64 * (j))
#define XB_XSUB(j)  (1280 + 64 * (j))
#define XB_XGEN(j)  (2304 + 64 * (j))
#define XB_TOP      3328
#define XB_TOPGEN   3392
#define XCD_BAR_WORDS 3456
#define XB_SPIN_CAP (1u << 20)
__device__ __forceinline__ unsigned xb_ld(unsigned* p)              { return __hip_atomic_load(p, __ATOMIC_RELAXED, __HIP_MEMORY_SCOPE_AGENT); }
__device__ __forceinline__ unsigned xb_add(unsigned* p, unsigned v) { return __hip_atomic_fetch_add(p, v, __ATOMIC_RELAXED, __HIP_MEMORY_SCOPE_AGENT); }
__device__ __forceinline__ unsigned xb_xcc_id() { return (unsigned)__builtin_amdgcn_s_getreg((3 << 11) | 20) & 0xFu; }
#define XB_SPIN(cond, bar) do { unsigned _sp = 0; while (cond) { __builtin_amdgcn_s_sleep(1); \
    if ((++_sp & 255u) == 0u) { if (xb_ld(&(bar)[XB_TMO])) break; if (_sp > XB_SPIN_CAP) { atomicAdd(&(bar)[XB_TMO], 1u); break; } } } } while (0)
__device__ __forceinline__ void xcd_barrier_post(unsigned* bar, bool leader) { if (leader) (void)xb_add(&bar[XB_XCNT(xb_xcc_id())], 1u); }
__device__ __forceinline__ void xcd_barrier_complete(unsigned* bar, unsigned x, unsigned G, unsigned& nloc, unsigned& nx) {
    unsigned sum, cnt, mine, sp = 0u;
    for (;;) {
        sum = 0u; cnt = 0u; mine = 0u;
#pragma unroll
        for (unsigned j = 0; j < 16; ++j) { const unsigned c = xb_ld(&bar[XB_XCNT(j)]); sum += c; cnt += (c > 0u) ? 1u : 0u; mine = (j == x) ? c : mine; }
        if (sum == G) break;
        __builtin_amdgcn_s_sleep(1);
        if ((++sp & 255u) == 0u) { if (xb_ld(&bar[XB_TMO])) break; if (sp > XB_SPIN_CAP) { atomicAdd(&bar[XB_TMO], 1u); break; } }
    }
    nloc = mine > 0u ? mine : 1u; nx = cnt > 0u ? cnt : 1u;
}
__device__ __forceinline__ void xcd_barrier(unsigned* bar, volatile LAS unsigned* st, unsigned G, bool leader) {
    asm volatile("s_waitcnt vmcnt(0)" ::: "memory");
    __syncthreads();
    if (leader) {
        __builtin_amdgcn_s_waitcnt(0);
        const unsigned x = xb_xcc_id();
        unsigned nloc = st[0], nx = st[1];
        if (nloc == 0u) { xcd_barrier_complete(bar, x, G, nloc, nx); st[0] = nloc; st[1] = nx; }
        const unsigned old = xb_add(&bar[XB_XSUB(x)], 1u);
        const unsigned gen = old / nloc;
        if (old + 1u == (gen + 1u) * nloc) {
            __builtin_amdgcn_fence(__ATOMIC_RELEASE, "agent");
            asm volatile("s_waitcnt vmcnt(0)" ::: "memory");
            const unsigned og = xb_add(&bar[XB_TOP], 1u);
            const unsigned tg = og / nx;
            if (og + 1u == (tg + 1u) * nx) xb_add(&bar[XB_TOPGEN], 1u);
            else XB_SPIN(xb_ld(&bar[XB_TOPGEN]) == tg, bar);
            __builtin_amdgcn_fence(__ATOMIC_ACQUIRE, "agent");
            xb_add(&bar[XB_XGEN(x)], 1u);
            asm volatile("s_waitcnt vmcnt(0)" ::: "memory");
        } else {
            XB_SPIN(xb_ld(&bar[XB_XGEN(x)]) == gen, bar);
            __builtin_amdgcn_fence(__ATOMIC_ACQUIRE, "agent");
            asm volatile("s_waitcnt vmcnt(0)" ::: "memory");
        }
    }
    __syncthreads();
}

constexpr int RING_BYTES = 131072, EX_OFF = RING_BYTES, MISC_OFF = EX_OFF + 4096, LDS_BYTES = 147456;
constexpr int NWAVES = 8;

struct Args {
    const float* in[18]; float* out; unsigned char* ws; int ph_lo, ph_hi; int use_bar, pad;
};

__device__ __forceinline__ void p0_transpose_item(const float* W, int K, int N, bf16_t* WT, int rowblk, int roff, LAS float* scr, int item, int lane) {
    const int nblk = N / 32, kb = item / nblk, nb = item % nblk, k0 = 64 * kb, n0 = 32 * nb;
#pragma unroll 8
    for (int i = 0; i < 32; ++i) { const int kk = 2 * i + (lane >> 5); scr[kk * 33 + (lane & 31)] = W[(size_t)(k0 + kk) * N + n0 + (lane & 31)]; }
    asm volatile("s_waitcnt lgkmcnt(0)" ::: "memory");
    const int c = lane & 7;
#pragma unroll
    for (int j = 0; j < 4; ++j) { const int nl = (lane >> 3) + 8 * j; const LAS float* s = scr + (8 * c) * 33 + nl; const int n = n0 + nl;
        u32x4 o; o.x = pk2(s[0 * 33], s[1 * 33]); o.y = pk2(s[2 * 33], s[3 * 33]); o.z = pk2(s[4 * 33], s[5 * 33]); o.w = pk2(s[6 * 33], s[7 * 33]);
        const int dr = (n >> 7) * rowblk + roff + (n & 127);
        *(u32x4*)(WT + (size_t)dr * K + k0 + 8 * c) = o; }
    asm volatile("s_waitcnt lgkmcnt(0)" ::: "memory");
}

__global__ void __launch_bounds__(NWAVES * 64, 2) mk_fwd(Args args) {
    extern __shared__ __attribute__((aligned(16))) unsigned char lds_raw[];
    LAS unsigned char* lds = (LAS unsigned char*)lds_raw;
    const int wave = __builtin_amdgcn_readfirstlane(threadIdx.x >> 6);
#define PHASE_IDS() const int lane = lane_id(), tid = wave * 64 + lane; (void)tid; const int gw = vcu * NWAVES + wave, NGW = G * NWAVES; (void)lane; (void)gw; (void)NGW
    const int G = gridDim.x, bx = blockIdx.x; const int vcu = (G % 8 == 0) ? (bx % 8) * (G / 8) + bx / 8 : bx;
    unsigned char* ws = args.ws;
    unsigned* ctl = (unsigned*)(ws + WS_CTL);
    if (threadIdx.x < 64) ((volatile LAS unsigned*)(lds + MISC_OFF))[threadIdx.x] = 0u;
    __syncthreads();
    if (args.use_bar) xcd_barrier_post((unsigned*)(args.ws + WS_CTL) + CW_BAR, wave == 0 && lane_id() == 0);
    if (args.use_bar == 12345) cooperative_groups::this_grid().sync();
#define GRID_BAR() do { if (args.use_bar) xcd_barrier((unsigned*)(args.ws + WS_CTL) + CW_BAR, (volatile LAS unsigned*)(lds + MISC_OFF) + 8, (unsigned)G, wave == 0 && lane_id() == 0); } while (0)
    const int lo = args.ph_lo, hi = args.ph_hi;
#ifndef MK_CMASK
#define MK_CMASK 0x1ff
#endif
#define IN(k) ((((MK_CMASK) >> (k)) & 1) && lo <= (k) && (k) < hi)
#define BOTH(k) (IN(k) && IN((k) + 1))

    if (IN(0)) {
        PHASE_IDS();
        const float* x = args.in[0];
        bf16_t* XB = (bf16_t*)(ws + WS_XB); bf16_t* WINT = (bf16_t*)(ws + WS_WINT); bf16_t* WAT = (bf16_t*)(ws + WS_WAT); bf16_t* WBT = (bf16_t*)(ws + WS_WBT); bf16_t* WOT = (bf16_t*)(ws + WS_WOT);
        bf16_t* WGUT = (bf16_t*)(ws + WS_WGUT); bf16_t* WDT = (bf16_t*)(ws + WS_WDT);
        LAS float* scr = (LAS float*)(lds + wave * 16384);
        constexpr int I_IN = (DM / 64) * (IN_COLS / 32), I_A = (1024 / 64) * (DM / 32), I_B = (DM / 64) * (DM / 32), I_O = I_B;
        constexpr int I_G = (DM / 64) * (FF / 32), I_D = (FF / 64) * (DM / 32);
        constexpr int NITEMS = I_IN + I_A + I_B + I_O + NEXP * (2 * I_G + I_D);
        for (int it = gw; it < NITEMS; it += NGW) {
            int r = it;
            if (r < I_IN) { p0_transpose_item(args.in[1], DM, IN_COLS, WINT, 128, 0, scr, r, lane); continue; } r -= I_IN;
            if (r < I_A) { p0_transpose_item(args.in[4], 1024, DM, WAT, 128, 0, scr, r, lane); continue; } r -= I_A;
            if (r < I_B) { p0_transpose_item(args.in[5], DM, DM, WBT, 128, 0, scr, r, lane); continue; } r -= I_B;
            if (r < I_O) { p0_transpose_item(args.in[6], DM, DM, WOT, 128, 0, scr, r, lane); continue; } r -= I_O;
            const int e = r / (2 * I_G + I_D); r -= e * (2 * I_G + I_D);
            if (r < I_G) { p0_transpose_item(args.in[13] + (size_t)e * DM * FF, DM, FF, WGUT + (size_t)e * 2048 * DM, 256, 0, scr, r, lane); continue; } r -= I_G;
            if (r < I_G) { p0_transpose_item(args.in[14] + (size_t)e * DM * FF, DM, FF, WGUT + (size_t)e * 2048 * DM, 256, 128, scr, r, lane); continue; } r -= I_G;
            p0_transpose_item(args.in[15] + (size_t)e * FF * DM, FF, DM, WDT + (size_t)e * DM * FF, 128, 0, scr, r, lane);
        }
        for (int m = gw; m < NTOK; m += NGW) {
            const f32x4* xr = (const f32x4*)(x + (size_t)m * DM) + lane; u32x2* o8 = (u32x2*)(XB + (size_t)m * DM) + lane;
#pragma unroll
            for (int j = 0; j < 8; ++j) { const f32x4 v = xr[64 * j]; u32x2 w; w.x = pk2(v.x, v.y); w.y = pk2(v.z, v.w); o8[64 * j] = w; }
        }
        { float2* rt1 = (float2*)(ws + WS_RT1); float2* rt2 = (float2*)(ws + WS_RT2);
          for (int i = (vcu * NWAVES * 64) + tid; i < SEQ * 64; i += G * NWAVES * 64) { const int t = i >> 6, c = i & 63; float cs, sn;
              rope1(t, c, cs, sn); rt1[i] = make_float2(cs, sn); rope2(t, c, cs, sn); rt2[i] = make_float2(cs, sn); } }
        if (BOTH(0)) GRID_BAR();
    }

    if (IN(1)) {
        EpiProj E; E.ws = ws; E.qg = args.in[2]; E.kg = args.in[3];
        ProjSched S; S.o.init(NTOK, IN_COLS, G, bx); S.ws = (const char*)ws;
        pg8::gemm_phase<EpiProj, ProjSched, PG8_ALIGN, PG8_SP2>(lds, lds + EX_OFF, S, E, wave);
        if (BOTH(1)) GRID_BAR();
    }

    if (IN(2)) {
        for (int i = 0; i < 2; ++i) {
            const int idx = bx + i * G; if (idx >= 512) break;
            const int bk = idx & 7, rest = idx >> 3, b = bk >> 2, kvh = bk & 3, hq = kvh * 4 + (rest & 3), qblk = rest >> 2;
            att::Unit u; u.Q = (const bf16_t*)(ws + WS_QB) + ((size_t)(b * 16 + hq) * SEQ + qblk * 256) * HD;
            u.K = (const bf16_t*)(ws + WS_KB) + (size_t)(b * 4 + kvh) * SEQ * HD; u.V = (const bf16_t*)(ws + WS_VB) + (size_t)(b * 4 + kvh) * SEQ * HD;
            u.O = (bf16_t*)(ws + WS_OB) + ((size_t)b * SEQ + qblk * 256) * 2048 + hq * HD; u.ldo = 2048; u.lse = nullptr; u.lse_stride = 0; u.nt = 64; u.kt0 = 0; u.klo = 0; u.khi = SEQ; u.q0 = 0;
            att::body(u, lds, wave);
        }
        for (int i = 0; i < 3; ++i) {
            const int idx = bx + i * G; if (idx >= 768) break;
            const int sid = idx >> 4, qblk = idx & 15, g = sid >> 4, b = (sid >> 3) & 1, h = sid & 7, sh = 2 * g, L = SEQ >> sh;
            const int P0 = qblk * 256, r = P0 / L, p0 = P0 - r * L;
            att::Unit u; u.Q = (const bf16_t*)(ws + WS_QA) + ((size_t)sid * SEQ + P0) * HD; u.K = (const bf16_t*)(ws + WS_KA) + (size_t)sid * SEQ * HD; u.V = (const bf16_t*)(ws + WS_VA) + (size_t)sid * SEQ * HD;
            const size_t tok0 = (size_t)b * SEQ + ((size_t)p0 << sh) + r;
            u.O = (bf16_t*)(ws + WS_OAG) + ((size_t)g * NTOK + tok0) * 1024 + h * HD; u.ldo = 1024 << sh;
            u.lse = (float*)(ws + WS_LSE) + ((size_t)g * NTOK + tok0) * 8 + h; u.lse_stride = 8 << sh;
            u.nt = 6; u.kt0 = P0 - 64; u.klo = r * L; u.khi = r * L + L; u.q0 = P0;
            att::band_body(u, lds, wave);
        }
        GRID_BAR();
        {
            PHASE_IDS();
            const bf16_t* oag = (const bf16_t*)(ws + WS_OAG); const float* lse = (const float*)(ws + WS_LSE); bf16_t* oa = (bf16_t*)(ws + WS_OA);
            for (int m = gw; m < NTOK; m += NGW) { const int c = lane * 16, h = lane >> 3;
                const float l0 = lse[(0 * (size_t)NTOK + m) * 8 + h], l1 = lse[(1 * (size_t)NTOK + m) * 8 + h], l2 = lse[(2 * (size_t)NTOK + m) * 8 + h];
                const float mx = fmaxf(l0, fmaxf(l1, l2)); float e0 = __expf(l0 - mx), e1 = __expf(l1 - mx), e2 = __expf(l2 - mx); const float inv = 1.0f / (e0 + e1 + e2); e0 *= inv; e1 *= inv; e2 *= inv;
#pragma unroll
                for (int q = 0; q < 2; ++q) { const u32x4 a = *(const u32x4*)(oag + (0 * (size_t)NTOK + m) * 1024 + c + 8 * q), bq = *(const u32x4*)(oag + (1 * (size_t)NTOK + m) * 1024 + c + 8 * q), cq = *(const u32x4*)(oag + (2 * (size_t)NTOK + m) * 1024 + c + 8 * q);
                    u32x4 w;
#pragma unroll
                    for (int k = 0; k < 4; ++k) w[k] = cvtpk(e0 * bflo(a[k]) + e1 * bflo(bq[k]) + e2 * bflo(cq[k]), e0 * bfhi(a[k]) + e1 * bfhi(bq[k]) + e2 * bfhi(cq[k]));
                    *(u32x4*)(oa + (size_t)m * 1024 + c + 8 * q) = w; } }
        }
        if (BOTH(2)) GRID_BAR();
    }

    if (IN(3) || IN(4)) {
        EpiMix E; E.ws = ws; E.x = args.in[0];
        MixSched S; S.c = vcu; S.ws = (const char*)ws;
        if (IN(3)) { S.mode = 0; pg8::gemm_phase<EpiMix, MixSched, false, PG8_SP2>(lds, lds + EX_OFF, S, E, wave); if (BOTH(3)) GRID_BAR(); }
        if (IN(4)) { S.mode = 1; pg8::gemm_phase<EpiMix, MixSched, false, PG8_SP2>(lds, lds + EX_OFF, S, E, wave); if (BOTH(4)) GRID_BAR(); }
    }

    if (IN(5)) {
        PHASE_IDS();
        RouteArgs ra; ra.g = args.in[7]; ra.b = args.in[8]; ra.h1 = (float*)(ws + WS_H1); ra.h1b = (bf16_t*)(ws + WS_H1B); ra.wg = args.in[9]; ra.bg = args.in[10]; ra.wr = args.in[11]; ra.br = args.in[12];
        ra.cnt = ctl + CW_CNT; ra.tokidx = (int*)(ws + WS_TOKIDX); ra.slot = (int*)(ws + WS_SLOT);
        for (int m = gw; m < NTOK; m += NGW) ln1_route_row((const float*)(ws + WS_PRE1), ra, m, lane_id());
        if (BOTH(5)) GRID_BAR();
    }

    if (IN(6) || IN(7)) {
        MoeSched S; S.G = G; S.vcu = vcu; S.ws = (const char*)ws;
        S.init(ctl + CW_CNT, lane_id());
        EpiMoe E; E.ws = ws;
        if (IN(6)) { S.down = 0; E.down = 0; pg8::gemm_phase<EpiMoe, MoeSched, PG8_ALIGN, PG8_SP2>(lds, lds + EX_OFF, S, E, wave); if (BOTH(6)) GRID_BAR(); }
        if (IN(7)) { S.down = 1; E.down = 1; pg8::gemm_phase<EpiMoe, MoeSched, PG8_ALIGN, PG8_SP2>(lds, lds + EX_OFF, S, E, wave); if (BOTH(7)) GRID_BAR(); }
    }

    if (IN(8)) {
        PHASE_IDS();
        P8Args pa; pa.h1 = (const float*)(ws + WS_H1); pa.y = (const bf16_t*)(ws + WS_Y); pa.cnt = ctl + CW_CNT; pa.slot = (const int*)(ws + WS_SLOT); pa.g = args.in[16]; pa.b = args.in[17]; pa.out = args.out;
        unsigned c = 0; if (lane < NEXP) c = __hip_atomic_load(ctl + CW_CNT + lane, __ATOMIC_RELAXED, __HIP_MEMORY_SCOPE_AGENT);
        unsigned t = (c + 255u) >> 8, inc = t;
#pragma unroll
        for (int o = 1; o < 32; o <<= 1) { const unsigned v = __shfl_up(inc, o); if ((lane & 31) >= o) inc += v; }
        const unsigned tpe = inc - t;
        for (int m = gw; m < NTOK; m += NGW) {
            const int* sl = pa.slot + (size_t)m * 6; const int e1 = sl[0], e2 = sl[1], p1 = sl[2], p2 = sl[3]; const float w1 = ((const float*)sl)[4], w2 = ((const float*)sl)[5];
            const size_t r1 = (size_t)__shfl(tpe, e1) * 256 + p1, r2 = (size_t)__shfl(tpe, e2) * 256 + p2;
            final_row(pa, m, lane_id(), r1, r2, w1, w2);
        }
    }
#undef IN
#undef BOTH
#undef GRID_BAR
}

extern "C" void kernel_launch(void* const* d_in, const int* in_sizes, int n_in, void* d_out, int out_size, void* d_ws, size_t ws_size, hipStream_t stream) {
    static int grid = 0;
    if (grid == 0) {
        if (n_in != 18 || in_sizes[0] != NTOK * DM || out_size != NTOK * DM || ws_size < WS_END) { fprintf(stderr, "kernel_launch: unexpected shapes (n_in %d, in0 %d, out %d, ws %zu)\n", n_in, n_in > 0 ? in_sizes[0] : -1, out_size, ws_size); grid = -1; return; }
        int dev = 0, cus = 0, per_cu = 0;
        if (hipGetDevice(&dev) != hipSuccess || hipDeviceGetAttribute(&cus, hipDeviceAttributeMultiprocessorCount, dev) != hipSuccess) { fprintf(stderr, "kernel_launch: device query failed\n"); grid = -1; return; }
        if (hipFuncSetAttribute((const void*)mk_fwd, hipFuncAttributeMaxDynamicSharedMemorySize, LDS_BYTES) != hipSuccess) { fprintf(stderr, "kernel_launch: hipFuncSetAttribute failed\n"); grid = -1; return; }
        if (hipOccupancyMaxActiveBlocksPerMultiprocessor(&per_cu, (const void*)mk_fwd, NWAVES * 64, LDS_BYTES) != hipSuccess || per_cu < 1) { fprintf(stderr, "kernel_launch: occupancy query says %d blocks per CU\n", per_cu); per_cu = 1; }
        (void)hipGetLastError();
        grid = cus * 1;
        fprintf(stderr, "kernel_launch: grid %d (cus %d, occupancy %d)\n", grid, cus, per_cu);
    }
    if (grid < 0) return;
    unsigned char* ws = (unsigned char*)d_ws;
    (void)hipMemsetAsync(ws + WS_CTL, 0, 1 * MiB, stream);
    Args a{};
    for (int i = 0; i < 18; ++i) a.in[i] = (const float*)d_in[i];
    a.out = (float*)d_out; a.ws = ws;
    const float* x = a.in[0];
    bf16_t* XB = (bf16_t*)(ws + WS_XB); bf16_t* WINT = (bf16_t*)(ws + WS_WINT); bf16_t* WAT = (bf16_t*)(ws + WS_WAT); bf16_t* WBT = (bf16_t*)(ws + WS_WBT); bf16_t* WOT = (bf16_t*)(ws + WS_WOT);
    bf16_t* WGUT = (bf16_t*)(ws + WS_WGUT); bf16_t* WDT = (bf16_t*)(ws + WS_WDT);
    unsigned* ctl = (unsigned*)(ws + WS_CTL);
    auto launch_mk = [&](int lo, int hi, int use_bar) {
        a.ph_lo = lo; a.ph_hi = hi; a.use_bar = use_bar;
        void* kargs[] = {&a};
        hipError_t e = hipLaunchCooperativeKernel((const void*)mk_fwd, dim3(grid), dim3(NWAVES * 64), kargs, LDS_BYTES, stream);
        if (e != hipSuccess) fprintf(stderr, "kernel_launch: cooperative launch failed: %s (grid %d)\n", hipGetErrorString(e), grid);
    };
    if (MK_ONE_LAUNCH && MK_FAST_MASK == 0x1ff) { launch_mk(0, NPHASE, 1); return; }
    for (int ph = 0; ph < NPHASE; ++ph) {
        if ((MK_FAST_MASK >> ph) & 1) { launch_mk(ph, ph + 1, (ph == 2) ? 1 : 0); continue; }
        switch (ph) {
        case 0:
            hipLaunchKernelGGL(k_cvt, dim3(2048), dim3(256), 0, stream, x, XB, (size_t)NTOK * DM / 8);
            hipLaunchKernelGGL(k_transpose, dim3(IN_COLS / 32, DM / 32, 1), dim3(256), 0, stream, a.in[1], WINT, DM, IN_COLS, 128, 0, (size_t)0, (size_t)0);
            hipLaunchKernelGGL(k_transpose, dim3(DM / 32, 1024 / 32, 1), dim3(256), 0, stream, a.in[4], WAT, 1024, DM, 128, 0, (size_t)0, (size_t)0);
            hipLaunchKernelGGL(k_transpose, dim3(DM / 32, DM / 32, 1), dim3(256), 0, stream, a.in[5], WBT, DM, DM, 128, 0, (size_t)0, (size_t)0);
            hipLaunchKernelGGL(k_transpose, dim3(DM / 32, DM / 32, 1), dim3(256), 0, stream, a.in[6], WOT, DM, DM, 128, 0, (size_t)0, (size_t)0);
            hipLaunchKernelGGL(k_transpose, dim3(FF / 32, DM / 32, NEXP), dim3(256), 0, stream, a.in[13], WGUT, DM, FF, 256, 0, (size_t)DM * FF, (size_t)2048 * DM);
            hipLaunchKernelGGL(k_transpose, dim3(FF / 32, DM / 32, NEXP), dim3(256), 0, stream, a.in[14], WGUT, DM, FF, 256, 128, (size_t)DM * FF, (size_t)2048 * DM);
            hipLaunchKernelGGL(k_transpose, dim3(DM / 32, FF / 32, NEXP), dim3(256), 0, stream, a.in[15], WDT, FF, DM, 128, 0, (size_t)FF * DM, (size_t)DM * FF);
            hipLaunchKernelGGL(k_ropetab, dim3(SEQ * 64 / 256), dim3(256), 0, stream, (float2*)(ws + WS_RT1), (float2*)(ws + WS_RT2));
            break;
        case 1: { P1Args p1{}; p1.xb = XB; p1.wint = WINT; p1.qg = a.in[2]; p1.kg = a.in[3]; p1.qa = (bf16_t*)(ws + WS_QA); p1.ka = (bf16_t*)(ws + WS_KA); p1.va = (bf16_t*)(ws + WS_VA);
            p1.qb = (bf16_t*)(ws + WS_QB); p1.kb = (bf16_t*)(ws + WS_KB); p1.vb = (bf16_t*)(ws + WS_VB); p1.gates = (bf16_t*)(ws + WS_GATES);
            hipLaunchKernelGGL(k_proj, dim3(IN_COLS / 128, NTOK / 64), dim3(256), 0, stream, p1); } break;
        case 2: { P2Args p2b{}; p2b.q = (bf16_t*)(ws + WS_QB); p2b.k = (bf16_t*)(ws + WS_KB); p2b.v = (bf16_t*)(ws + WS_VB); p2b.o = (bf16_t*)(ws + WS_OB); p2b.lse = nullptr; p2b.mode = 0;
            hipLaunchKernelGGL(k_attn, dim3(SEQ / 64, 32), dim3(128), 0, stream, p2b);
            P2Args p2a{}; p2a.q = (bf16_t*)(ws + WS_QA); p2a.k = (bf16_t*)(ws + WS_KA); p2a.v = (bf16_t*)(ws + WS_VA); p2a.o = (bf16_t*)(ws + WS_OAG); p2a.lse = (float*)(ws + WS_LSE); p2a.mode = 1;
            hipLaunchKernelGGL(k_attn, dim3(SEQ / 64, 48), dim3(128), 0, stream, p2a);
            hipLaunchKernelGGL(k_merge, dim3(NTOK * 1024 / 256), dim3(256), 0, stream, (const bf16_t*)(ws + WS_OAG), (const float*)(ws + WS_LSE), (bf16_t*)(ws + WS_OA)); } break;
        case 3: case 4: { P3Args p3{}; p3.gates = (bf16_t*)(ws + WS_GATES); p3.T = (float*)(ws + WS_T); p3.merged = (bf16_t*)(ws + WS_MERGED); p3.x = x; p3.pre1 = (float*)(ws + WS_PRE1);
            if (ph == 3) { p3.A = (bf16_t*)(ws + WS_OA); p3.Bt = WAT; p3.K = 1024; p3.mode = 0;
                hipLaunchKernelGGL(k_gemm3, dim3(DM / 128, NTOK / 64), dim3(256), 0, stream, p3);
                p3.A = (bf16_t*)(ws + WS_OB); p3.Bt = WBT; p3.K = 2048; p3.mode = 1;
                hipLaunchKernelGGL(k_gemm3, dim3(DM / 128, NTOK / 64), dim3(256), 0, stream, p3); }
            else { p3.A = p3.merged; p3.Bt = WOT; p3.K = 2048; p3.mode = 2; hipLaunchKernelGGL(k_gemm3, dim3(DM / 128, NTOK / 64), dim3(256), 0, stream, p3); } } break;
        case 5: { RouteArgs ra{}; ra.g = a.in[7]; ra.b = a.in[8]; ra.h1 = (float*)(ws + WS_H1); ra.h1b = (bf16_t*)(ws + WS_H1B); ra.wg = a.in[9]; ra.bg = a.in[10]; ra.wr = a.in[11]; ra.br = a.in[12];
            ra.cnt = ctl + CW_CNT; ra.tokidx = (int*)(ws + WS_TOKIDX); ra.slot = (int*)(ws + WS_SLOT);
            hipLaunchKernelGGL(k_ln1_route, dim3(NTOK / 4), dim3(256), 0, stream, (const float*)(ws + WS_PRE1), ra); } break;
        case 6: case 7: { P6Args p6{}; p6.h1b = (bf16_t*)(ws + WS_H1B); p6.wgut = WGUT; p6.wdt = WDT; p6.cnt = ctl + CW_CNT; p6.tokidx = (int*)(ws + WS_TOKIDX); p6.act = (bf16_t*)(ws + WS_ACT); p6.y = (bf16_t*)(ws + WS_Y);
            if (ph == 6) hipLaunchKernelGGL(k_moe_up, dim3(FF / 128, 24576 / 64), dim3(256), 0, stream, p6);
            else hipLaunchKernelGGL(k_moe_down, dim3(DM / 128, 24576 / 64), dim3(256), 0, stream, p6); } break;
        case 8: { P8Args p8{}; p8.h1 = (float*)(ws + WS_H1); p8.y = (bf16_t*)(ws + WS_Y); p8.cnt = ctl + CW_CNT; p8.slot = (int*)(ws + WS_SLOT); p8.g = a.in[16]; p8.b = a.in[17]; p8.out = (float*)d_out;
            hipLaunchKernelGGL(k_final, dim3(NTOK / 4), dim3(256), 0, stream, p8); } break;
        }
    }
}
```

```cpp
#include <hip/hip_runtime.h>
#include <hip/hip_cooperative_groups.h>
#include <cstdio>
#include <cstdint>

typedef unsigned short bf16_t;
typedef short bf16x8 __attribute__((ext_vector_type(8)));
typedef short s16x4 __attribute__((ext_vector_type(4)));
typedef float f32x4 __attribute__((ext_vector_type(4)));
typedef float f32x16 __attribute__((ext_vector_type(16)));
typedef unsigned u32x4 __attribute__((ext_vector_type(4)));
typedef unsigned u32x2 __attribute__((ext_vector_type(2)));
#define LAS __attribute__((address_space(3)))

#ifndef MK_FAST_MASK
#define MK_FAST_MASK 0x1ff
#endif
#ifndef MK_ONE_LAUNCH
#define MK_ONE_LAUNCH 1
#endif
#ifndef PG8_SP2
#define PG8_SP2 true
#endif
#ifndef PG8_ALIGN
#define PG8_ALIGN true
#endif

constexpr int NTOK = 8192, SEQ = 4096, DM = 2048, HD = 128;
constexpr int IN_COLS = 16384;
constexpr int NEXP = 32, FF = 1024;
constexpr float ALPHA = 1.189207115002721f;
constexpr float LN_EPS = 1e-5f, RMS_EPS = 1e-6f;
constexpr float SM_SCALE = 0.08838834764831845f;
constexpr int ECAP = 8192;
constexpr int NPHASE = 9;

constexpr size_t MiB = 1u << 20;
constexpr size_t WS_CTL = 0;
constexpr size_t WS_WGUT = 1 * MiB;
constexpr size_t WS_WDT = 257 * MiB;
constexpr size_t WS_WAT = 385 * MiB;
constexpr size_t WS_WBT = 389 * MiB;
constexpr size_t WS_WOT = 397 * MiB;
constexpr size_t WS_XB = 405 * MiB;
constexpr size_t WS_WINT = 437 * MiB;
constexpr size_t WS_QA = 501 * MiB;
constexpr size_t WS_KA = 549 * MiB;
constexpr size_t WS_VA = 597 * MiB;
constexpr size_t WS_QB = 645 * MiB;
constexpr size_t WS_KB = 677 * MiB;
constexpr size_t WS_VB = 685 * MiB;
constexpr size_t WS_GATES = 693 * MiB;
constexpr size_t WS_OAG = 757 * MiB;
constexpr size_t WS_LSE = 805 * MiB;
constexpr size_t WS_OA = 806 * MiB;
constexpr size_t WS_OB = 822 * MiB;
constexpr size_t WS_T = 405 * MiB;
constexpr size_t WS_MERGED = 469 * MiB;
constexpr size_t WS_PRE1 = 501 * MiB;
constexpr size_t WS_H1 = 565 * MiB;
constexpr size_t WS_H1B = 629 * MiB;
constexpr size_t WS_TOKIDX = 661 * MiB;
constexpr size_t WS_SLOT = 662 * MiB;
constexpr size_t WS_ACT = 693 * MiB;
constexpr size_t WS_Y = 757 * MiB;
constexpr size_t WS_RT1 = 854 * MiB;
constexpr size_t WS_RT2 = 856 * MiB;
constexpr size_t WS_END = 858 * MiB;
constexpr int CW_CNT = 64;
constexpr int CW_BAR = 4096;

__device__ __forceinline__ float bf2f(bf16_t v) { return __uint_as_float(((unsigned)v) << 16); }
__device__ __forceinline__ bf16_t f2bf(float f) { unsigned u = __float_as_uint(f); u += 0x7fffu + ((u >> 16) & 1u); return (bf16_t)(u >> 16); }
__device__ __forceinline__ unsigned pk2(float lo, float hi) { return (unsigned)f2bf(lo) | ((unsigned)f2bf(hi) << 16); }
__device__ __forceinline__ unsigned cvtpk(float lo, float hi) { unsigned r; asm volatile("v_cvt_pk_bf16_f32 %0, %1, %2" : "=v"(r) : "v"(lo), "v"(hi)); return r; }
__device__ __forceinline__ float wave_sum(float v) {
#pragma unroll
    for (int o = 1; o < 64; o <<= 1) v += __shfl_xor(v, o);
    return v;
}
__device__ __forceinline__ int lane_id() { int l; asm volatile("v_mbcnt_lo_u32_b32 %0, -1, 0\n\tv_mbcnt_hi_u32_b32 %0, -1, %0" : "=v"(l)); return l; }
__device__ __forceinline__ float bflo(unsigned w) { return __uint_as_float(w << 16); }
__device__ __forceinline__ float bfhi(unsigned w) { return __uint_as_float(w & 0xffff0000u); }

__device__ const float INV64[64] = {
    1.000000000e+00f, 8.659643234e-01f, 7.498942093e-01f, 6.493816316e-01f, 5.623413252e-01f, 4.869675252e-01f, 4.216965034e-01f, 3.651741273e-01f,
    3.162277660e-01f, 2.738419634e-01f, 2.371373706e-01f, 2.053525026e-01f, 1.778279410e-01f, 1.539926526e-01f, 1.333521432e-01f, 1.154781985e-01f,
    1.000000000e-01f, 8.659643234e-02f, 7.498942093e-02f, 6.493816316e-02f, 5.623413252e-02f, 4.869675252e-02f, 4.216965034e-02f, 3.651741273e-02f,
    3.162277660e-02f, 2.738419634e-02f, 2.371373706e-02f, 2.053525026e-02f, 1.778279410e-02f, 1.539926526e-02f, 1.333521432e-02f, 1.154781985e-02f,
    1.000000000e-02f, 8.659643234e-03f, 7.498942093e-03f, 6.493816316e-03f, 5.623413252e-03f, 4.869675252e-03f, 4.216965034e-03f, 3.651741273e-03f,
    3.162277660e-03f, 2.738419634e-03f, 2.371373706e-03f, 2.053525026e-03f, 1.778279410e-03f, 1.539926526e-03f, 1.333521432e-03f, 1.154781985e-03f,
    1.000000000e-03f, 8.659643234e-04f, 7.498942093e-04f, 6.493816316e-04f, 5.623413252e-04f, 4.869675252e-04f, 4.216965034e-04f, 3.651741273e-04f,
    3.162277660e-04f, 2.738419634e-04f, 2.371373706e-04f, 2.053525026e-04f, 1.778279410e-04f, 1.539926526e-04f, 1.333521432e-04f, 1.154781985e-04f};

__device__ __forceinline__ void cs_angle(float ang, float& c, float& s) {
    const double a = (double)ang * 0.15915494309189535;
    const float f = (float)(a - floor(a));
    s = __builtin_amdgcn_sinf(f); c = __builtin_amdgcn_cosf(f);
}
__device__ __forceinline__ void rope1(int t, int i, float& c, float& s) { cs_angle((float)t * INV64[i], c, s); }
__device__ __forceinline__ void rope2(int t, int i, float& c, float& s) {
    const float p = (i < 32) ? (float)(t >> 6) : (float)(t & 63);
    cs_angle(p * INV64[2 * (i & 31)], c, s);
}
__device__ __forceinline__ int perm_pos(int g, int t) { const int sh = 2 * g; const int d = 1 << sh; return (t & (d - 1)) * (SEQ >> sh) + (t >> sh); }

__global__ void __launch_bounds__(256) k_cvt(const float* __restrict__ x, bf16_t* __restrict__ xb, size_t n8) {
    for (size_t i = (size_t)blockIdx.x * 256 + threadIdx.x; i < n8; i += (size_t)gridDim.x * 256) {
        const f32x4 a = *(const f32x4*)(x + i * 8), b = *(const f32x4*)(x + i * 8 + 4);
        u32x4 w; w.x = pk2(a.x, a.y); w.y = pk2(a.z, a.w); w.z = pk2(b.x, b.y); w.w = pk2(b.z, b.w);
        *(u32x4*)(xb + i * 8) = w;
    }
}
__global__ void __launch_bounds__(256) k_transpose(const float* __restrict__ src, bf16_t* __restrict__ dst, int K, int N, int rowblk, int roff, size_t sstride, size_t dstride) {
    __shared__ float tile[32][33];
    const float* s = src + (size_t)blockIdx.z * sstride; bf16_t* d = dst + (size_t)blockIdx.z * dstride;
    const int n0 = blockIdx.x * 32, k0 = blockIdx.y * 32, tx = threadIdx.x & 31, ty = threadIdx.x >> 5;
    for (int i = ty; i < 32; i += 8) tile[i][tx] = s[(size_t)(k0 + i) * N + n0 + tx];
    __syncthreads();
    for (int i = ty; i < 32; i += 8) { const int n = n0 + i; const int dr = (n >> 7) * rowblk + roff + (n & 127); d[(size_t)dr * K + k0 + tx] = f2bf(tile[tx][i]); }
}
__global__ void __launch_bounds__(256) k_ropetab(float2* rt1, float2* rt2) {
    const int i = blockIdx.x * 256 + threadIdx.x; const int t = i >> 6, c = i & 63; float cs, sn;
    rope1(t, c, cs, sn); rt1[i] = make_float2(cs, sn); rope2(t, c, cs, sn); rt2[i] = make_float2(cs, sn);
}
__device__ __forceinline__ void wave_gemm16x128(const bf16_t* arow, const bf16_t* bt, int ldb, int K, f32x4 (&acc)[8]) {
    const int lane = threadIdx.x & 63, fr = lane & 15, fq = lane >> 4;
    const bf16_t* ap = arow + fq * 8;
    const bf16_t* bp = bt + (size_t)fr * ldb + fq * 8;
    for (int k = 0; k < K; k += 32) {
        const bf16x8 a = *(const bf16x8*)(ap + k);
#pragma unroll
        for (int j = 0; j < 8; ++j) { const bf16x8 b = *(const bf16x8*)(bp + (size_t)j * 16 * ldb + k); acc[j] = __builtin_amdgcn_mfma_f32_16x16x32_bf16(a, b, acc[j], 0, 0, 0); }
    }
}
struct P1Args { const bf16_t* xb; const bf16_t* wint; const float* qg; const float* kg; bf16_t *qa, *ka, *va, *qb, *kb, *vb, *gates; };
__global__ void __launch_bounds__(256) k_proj(P1Args a) {
    const int wave = threadIdx.x >> 6, lane = threadIdx.x & 63, fr = lane & 15, fq = lane >> 4;
    const int ng = blockIdx.x, mt = blockIdx.y * 4 + wave;
    f32x4 acc[8];
#pragma unroll
    for (int j = 0; j < 8; ++j) acc[j] = (f32x4){0.f, 0.f, 0.f, 0.f};
    wave_gemm16x128(a.xb + (size_t)(mt * 16 + fr) * DM, a.wint + (size_t)ng * 128 * DM, DM, DM, acc);
#pragma unroll
    for (int r = 0; r < 4; ++r) {
        const int m = mt * 16 + fq * 4 + r, b = m >> 12, t = m & 4095;
        if (ng < 72) {
            const int which = ng / 24, hh = ng % 24, g = hh >> 3, h = hh & 7;
            bf16_t* base = (which == 0 ? a.qa : (which == 1 ? a.ka : a.va)) + ((size_t)((g * 2 + b) * 8 + h) * SEQ + perm_pos(g, t)) * HD;
#pragma unroll
            for (int j = 0; j < 4; ++j) { const int c = 16 * j + fr; float x1 = acc[j][r], x2 = acc[j + 4][r];
                if (which < 2) { float cs, sn; rope1(t, c, cs, sn); const float y1 = x1 * cs - x2 * sn, y2 = x2 * cs + x1 * sn; x1 = y1; x2 = y2; }
                base[c] = f2bf(x1); base[c + 64] = f2bf(x2); }
        } else if (ng < 96) {
            const int k = ng - 72;
            if (k < 20) {
                float ss = 0.f;
#pragma unroll
                for (int j = 0; j < 8; ++j) ss += acc[j][r] * acc[j][r];
                ss += __shfl_xor(ss, 1); ss += __shfl_xor(ss, 2); ss += __shfl_xor(ss, 4); ss += __shfl_xor(ss, 8);
                const float rinv = 1.0f / sqrtf(ss * (1.0f / 128.0f) + RMS_EPS);
                const float* gn = (k < 16) ? a.qg : a.kg;
                bf16_t* base = (k < 16) ? a.qb + ((size_t)(b * 16 + k) * SEQ + t) * HD : a.kb + ((size_t)(b * 4 + (k - 16)) * SEQ + t) * HD;
#pragma unroll
                for (int j = 0; j < 4; ++j) { const int c = 16 * j + fr; const float x1 = acc[j][r] * rinv * gn[c], x2 = acc[j + 4][r] * rinv * gn[c + 64];
                    float cs, sn; rope2(t, c, cs, sn); base[c] = f2bf(x1 * cs - x2 * sn); base[c + 64] = f2bf(x2 * cs + x1 * sn); }
            } else {
                bf16_t* base = a.vb + ((size_t)(b * 4 + (k - 20)) * SEQ + t) * HD;
#pragma unroll
                for (int j = 0; j < 8; ++j) base[16 * j + fr] = f2bf(acc[j][r]);
            }
        } else {
            bf16_t* base = a.gates + (size_t)m * 4096 + (ng - 96) * 128;
#pragma unroll
            for (int j = 0; j < 8; ++j) base[16 * j + fr] = f2bf(1.0f / (1.0f + __expf(-acc[j][r])));
        }
    }
}
struct P2Args { const bf16_t *q, *k, *v; bf16_t* o; float* lse; int mode; };
__global__ void __launch_bounds__(128) k_attn(P2Args a) {
    const int half = threadIdx.x & 1, qi = blockIdx.x * 64 + (threadIdx.x >> 1), sid = blockIdx.y;
    const bf16_t *Q, *K, *V; int k_lo, k_hi;
    if (a.mode == 0) { const int b = sid >> 4, hq = sid & 15; Q = a.q + (size_t)sid * SEQ * HD; K = a.k + (size_t)(b * 4 + (hq >> 2)) * SEQ * HD; V = a.v + (size_t)(b * 4 + (hq >> 2)) * SEQ * HD; k_lo = 0; k_hi = SEQ - 1; }
    else { const int g = sid >> 4; const int L = SEQ >> (2 * g); Q = a.q + (size_t)sid * SEQ * HD; K = a.k + (size_t)sid * SEQ * HD; V = a.v + (size_t)sid * SEQ * HD;
        const int r0 = (qi / L) * L, p = qi - r0; k_lo = r0 + (p - 64 > 0 ? p - 64 : 0); k_hi = r0 + (p + 64 < L - 1 ? p + 64 : L - 1); }
    float q[64], o[64];
    { const bf16_t* qp = Q + (size_t)qi * HD + half * 64;
#pragma unroll
      for (int d = 0; d < 64; ++d) { q[d] = bf2f(qp[d]) * SM_SCALE; o[d] = 0.f; } }
    float m = -1e30f, l = 0.f;
    for (int kk = k_lo; kk <= k_hi; ++kk) {
        const bf16_t* kp = K + (size_t)kk * HD + half * 64; const bf16_t* vp = V + (size_t)kk * HD + half * 64;
        float s = 0.f;
#pragma unroll
        for (int d = 0; d < 64; ++d) s += q[d] * bf2f(kp[d]);
        s += __shfl_xor(s, 1);
        const float mn = fmaxf(m, s), al = __expf(m - mn), p = __expf(s - mn);
        l = l * al + p; m = mn;
#pragma unroll
        for (int d = 0; d < 64; ++d) o[d] = o[d] * al + p * bf2f(vp[d]);
    }
    const float rl = 1.0f / l;
    if (a.mode == 0) { const int b = sid >> 4, hq = sid & 15; bf16_t* op = a.o + (size_t)(b * SEQ + qi) * 2048 + hq * HD + half * 64;
#pragma unroll
        for (int d = 0; d < 64; ++d) op[d] = f2bf(o[d] * rl); }
    else { const int g = sid >> 4, b = (sid >> 3) & 1, h = sid & 7; const int sh = 2 * g, L = SEQ >> sh; const int r = qi / L, p = qi - r * L, t = (p << sh) + r;
        const size_t mrow = (size_t)b * SEQ + t;
        bf16_t* op = a.o + ((size_t)g * NTOK + mrow) * 1024 + h * HD + half * 64;
#pragma unroll
        for (int d = 0; d < 64; ++d) op[d] = f2bf(o[d] * rl);
        if (half == 0) a.lse[((size_t)g * NTOK + mrow) * 8 + h] = m + __logf(l); }
}
__global__ void __launch_bounds__(256) k_merge(const bf16_t* __restrict__ oag, const float* __restrict__ lse, bf16_t* __restrict__ oa) {
    const size_t i = (size_t)blockIdx.x * 256 + threadIdx.x;
    const size_t m = i >> 10; const int c = (int)(i & 1023), h = c >> 7;
    const float l0 = lse[(0 * (size_t)NTOK + m) * 8 + h], l1 = lse[(1 * (size_t)NTOK + m) * 8 + h], l2 = lse[(2 * (size_t)NTOK + m) * 8 + h];
    const float mx = fmaxf(l0, fmaxf(l1, l2)); const float e0 = __expf(l0 - mx), e1 = __expf(l1 - mx), e2 = __expf(l2 - mx); const float inv = 1.0f / (e0 + e1 + e2);
    const float v = (e0 * bf2f(oag[(0 * (size_t)NTOK + m) * 1024 + c]) + e1 * bf2f(oag[(1 * (size_t)NTOK + m) * 1024 + c]) + e2 * bf2f(oag[(2 * (size_t)NTOK + m) * 1024 + c])) * inv;
    oa[i] = f2bf(v);
}
struct P3Args { const bf16_t* A; const bf16_t* Bt; int K; const bf16_t* gates; float* T; bf16_t* merged; const float* x; float* pre1; int mode; };
__global__ void __launch_bounds__(256) k_gemm3(P3Args a) {
    const int wave = threadIdx.x >> 6, lane = threadIdx.x & 63, fr = lane & 15, fq = lane >> 4;
    const int ng = blockIdx.x, mt = blockIdx.y * 4 + wave;
    f32x4 acc[8];
#pragma unroll
    for (int j = 0; j < 8; ++j) acc[j] = (f32x4){0.f, 0.f, 0.f, 0.f};
    wave_gemm16x128(a.A + (size_t)(mt * 16 + fr) * a.K, a.Bt + (size_t)ng * 128 * a.K, a.K, a.K, acc);
#pragma unroll
    for (int r = 0; r < 4; ++r) { const size_t m = (size_t)mt * 16 + fq * 4 + r;
#pragma unroll
        for (int j = 0; j < 8; ++j) { const int c = ng * 128 + 16 * j + fr; const size_t o = m * DM + c;
            if (a.mode == 0) a.T[o] = bf2f(a.gates[m * 4096 + c]) * acc[j][r];
            else if (a.mode == 1) a.merged[o] = f2bf(a.T[o] + bf2f(a.gates[m * 4096 + 2048 + c]) * acc[j][r]);
            else a.pre1[o] = ALPHA * a.x[o] + acc[j][r]; } }
}
struct RouteArgs { const float* g; const float* b; float* h1; bf16_t* h1b; const float* wg; const float* bg; const float* wr; const float* br; unsigned* cnt; int* tokidx; int* slot; };
__device__ __forceinline__ void ln1_route_row(const float* pre1, const RouteArgs& a, int m, int lane) {
    const f32x4* xr = (const f32x4*)(pre1 + (size_t)m * DM) + lane;
    f32x4 v[8]; float s = 0.f;
#pragma unroll
    for (int j = 0; j < 8; ++j) { v[j] = xr[64 * j]; s += (v[j].x + v[j].y) + (v[j].z + v[j].w); }
    const float mean = wave_sum(s) * (1.0f / DM); float s2 = 0.f;
#pragma unroll
    for (int j = 0; j < 8; ++j) { v[j] = v[j] - mean; s2 += (v[j].x * v[j].x + v[j].y * v[j].y) + (v[j].z * v[j].z + v[j].w * v[j].w); }
    const float rstd = 1.0f / sqrtf(wave_sum(s2) * (1.0f / DM) + LN_EPS);
    float gl[4] = {0.f, 0.f, 0.f, 0.f};
#pragma unroll
    for (int j = 0; j < 8; ++j) { const int c = 4 * lane + 256 * j; const f32x4 gg = *(const f32x4*)(a.g + c), bb = *(const f32x4*)(a.b + c);
        v[j] = v[j] * rstd * gg + bb;
        *(f32x4*)(a.h1 + (size_t)m * DM + c) = v[j];
        *(uint2*)(a.h1b + (size_t)m * DM + c) = make_uint2(pk2(v[j].x, v[j].y), pk2(v[j].z, v[j].w));
#pragma unroll
        for (int i = 0; i < 4; ++i) { const f32x4 w = *(const f32x4*)(a.wg + (size_t)(c + i) * 4); const float hv = v[j][i]; gl[0] += hv * w.x; gl[1] += hv * w.y; gl[2] += hv * w.z; gl[3] += hv * w.w; } }
#pragma unroll
    for (int i = 0; i < 4; ++i) gl[i] = wave_sum(gl[i]) + a.bg[i];
    int gi = 0; float gm = gl[0];
#pragma unroll
    for (int i = 1; i < 4; ++i) if (gl[i] > gm) { gm = gl[i]; gi = i; }
    float gs = 0.f;
#pragma unroll
    for (int i = 0; i < 4; ++i) gs += __expf(gl[i] - gm);
    const float ggate = 1.0f / gs;
    float el[8] = {0.f, 0.f, 0.f, 0.f, 0.f, 0.f, 0.f, 0.f};
#pragma unroll
    for (int j = 0; j < 8; ++j) { const int c = 4 * lane + 256 * j;
#pragma unroll
        for (int i = 0; i < 4; ++i) { const float* wp = a.wr + (size_t)(c + i) * 32 + gi * 8; const f32x4 w0 = *(const f32x4*)wp, w1 = *(const f32x4*)(wp + 4); const float hv = v[j][i];
            el[0] += hv * w0.x; el[1] += hv * w0.y; el[2] += hv * w0.z; el[3] += hv * w0.w; el[4] += hv * w1.x; el[5] += hv * w1.y; el[6] += hv * w1.z; el[7] += hv * w1.w; } }
#pragma unroll
    for (int i = 0; i < 8; ++i) el[i] = wave_sum(el[i]) + a.br[gi * 8 + i];
    int i1 = 0; float m1 = el[0];
#pragma unroll
    for (int i = 1; i < 8; ++i) if (el[i] > m1) { m1 = el[i]; i1 = i; }
    int i2 = -1; float m2 = -3.0e38f;
#pragma unroll
    for (int i = 0; i < 8; ++i) if (i != i1 && el[i] > m2) { m2 = el[i]; i2 = i; }
    const float e2 = __expf(m2 - m1); const float w1 = ggate / (1.0f + e2), w2 = ggate * e2 / (1.0f + e2);
    if (lane == 0) {
        const int ex1 = gi * 8 + i1, ex2 = gi * 8 + i2;
        const int p1 = (int)atomicAdd(a.cnt + ex1, 1u), p2 = (int)atomicAdd(a.cnt + ex2, 1u);
        a.tokidx[ex1 * ECAP + p1] = m; a.tokidx[ex2 * ECAP + p2] = m;
        int* sl = a.slot + (size_t)m * 6; sl[0] = ex1; sl[1] = ex2; sl[2] = p1; sl[3] = p2; ((float*)sl)[4] = w1; ((float*)sl)[5] = w2;
    }
}
__global__ void __launch_bounds__(256) k_ln1_route(const float* pre1, RouteArgs a) { ln1_route_row(pre1, a, blockIdx.x * 4 + (threadIdx.x >> 6), threadIdx.x & 63); }

__device__ __forceinline__ int row_start(const unsigned* cnt, int e) { int s = 0; for (int i = 0; i < e; ++i) s += ((int)cnt[i] + 255) & ~255; return s; }
struct P6Args { const bf16_t* h1b; const bf16_t* wgut; const bf16_t* wdt; const unsigned* cnt; const int* tokidx; bf16_t* act; bf16_t* y; };
__global__ void __launch_bounds__(256) k_moe_up(P6Args a) {
    const int wave = threadIdx.x >> 6, lane = threadIdx.x & 63, fr = lane & 15, fq = lane >> 4;
    const int R0 = blockIdx.y * 64;
    int e = 0, rs = 0;
    for (; e < NEXP; ++e) { const int n = ((int)a.cnt[e] + 255) & ~255; if (R0 < rs + n) break; rs += n; }
    if (e == NEXP) return;
    const int pos = R0 - rs + wave * 16 + fr; const int tok = pos < (int)a.cnt[e] ? a.tokidx[e * ECAP + pos] : 0;
    const int jb = blockIdx.x;
    f32x4 ag[8], au[8];
#pragma unroll
    for (int j = 0; j < 8; ++j) { ag[j] = (f32x4){0.f, 0.f, 0.f, 0.f}; au[j] = (f32x4){0.f, 0.f, 0.f, 0.f}; }
    const bf16_t* wb = a.wgut + ((size_t)e * 2048 + jb * 256) * DM;
    wave_gemm16x128(a.h1b + (size_t)tok * DM, wb, DM, DM, ag);
    wave_gemm16x128(a.h1b + (size_t)tok * DM, wb + (size_t)128 * DM, DM, DM, au);
#pragma unroll
    for (int r = 0; r < 4; ++r) { const size_t row = (size_t)R0 + wave * 16 + fq * 4 + r;
#pragma unroll
        for (int j = 0; j < 8; ++j) { const float g = ag[j][r], u = au[j][r]; a.act[row * FF + jb * 128 + 16 * j + fr] = f2bf(g / (1.0f + __expf(-g)) * u); } }
}
__global__ void __launch_bounds__(256) k_moe_down(P6Args a) {
    const int wave = threadIdx.x >> 6, lane = threadIdx.x & 63, fr = lane & 15, fq = lane >> 4;
    const int R0 = blockIdx.y * 64;
    int e = 0, rs = 0;
    for (; e < NEXP; ++e) { const int n = ((int)a.cnt[e] + 255) & ~255; if (R0 < rs + n) break; rs += n; }
    if (e == NEXP) return;
    f32x4 acc[8];
#pragma unroll
    for (int j = 0; j < 8; ++j) acc[j] = (f32x4){0.f, 0.f, 0.f, 0.f};
    wave_gemm16x128(a.act + ((size_t)R0 + wave * 16 + fr) * FF, a.wdt + ((size_t)e * 2048 + blockIdx.x * 128) * FF, FF, FF, acc);
#pragma unroll
    for (int r = 0; r < 4; ++r) { const size_t row = (size_t)R0 + wave * 16 + fq * 4 + r;
#pragma unroll
        for (int j = 0; j < 8; ++j) a.y[row * DM + blockIdx.x * 128 + 16 * j + fr] = f2bf(acc[j][r]); }
}
struct P8Args { const float* h1; const bf16_t* y; const unsigned* cnt; const int* slot; const float* g; const float* b; float* out; };
__device__ __forceinline__ void final_row(const P8Args& a, int m, int lane, size_t r1, size_t r2, float w1, float w2) {
    f32x4 v[8]; float s = 0.f;
#pragma unroll
    for (int j = 0; j < 8; ++j) { const int c = 4 * lane + 256 * j; const f32x4 hv = *(const f32x4*)(a.h1 + (size_t)m * DM + c);
        const uint2 ya = *(const uint2*)(a.y + r1 * DM + c), yb = *(const uint2*)(a.y + r2 * DM + c);
        f32x4 f; f.x = w1 * bflo(ya.x) + w2 * bflo(yb.x); f.y = w1 * bfhi(ya.x) + w2 * bfhi(yb.x); f.z = w1 * bflo(ya.y) + w2 * bflo(yb.y); f.w = w1 * bfhi(ya.y) + w2 * bfhi(yb.y);
        v[j] = hv * ALPHA + f; s += (v[j].x + v[j].y) + (v[j].z + v[j].w); }
    const float mean = wave_sum(s) * (1.0f / DM); float s2 = 0.f;
#pragma unroll
    for (int j = 0; j < 8; ++j) { v[j] = v[j] - mean; s2 += (v[j].x * v[j].x + v[j].y * v[j].y) + (v[j].z * v[j].z + v[j].w * v[j].w); }
    const float rstd = 1.0f / sqrtf(wave_sum(s2) * (1.0f / DM) + LN_EPS);
#pragma unroll
    for (int j = 0; j < 8; ++j) { const int c = 4 * lane + 256 * j; const f32x4 gg = *(const f32x4*)(a.g + c), bb = *(const f32x4*)(a.b + c);
        *(f32x4*)(a.out + (size_t)m * DM + c) = v[j] * rstd * gg + bb; }
}
__global__ void __launch_bounds__(256) k_final(P8Args a) {
    const int lane = threadIdx.x & 63, m = blockIdx.x * 4 + (threadIdx.x >> 6);
    const int* sl = a.slot + (size_t)m * 6; const int e1 = sl[0], e2 = sl[1], p1 = sl[2], p2 = sl[3]; const float w1 = ((const float*)sl)[4], w2 = ((const float*)sl)[5];
    final_row(a, m, lane, (size_t)row_start(a.cnt, e1) + p1, (size_t)row_start(a.cnt, e2) + p2, w1, w2);
}

namespace pg8 {
constexpr int BM = 256, BK = 64, HALF = 128, HTB = HALF * BK * 2  , STAGE_BYTES = 8 * HTB;
__device__ __forceinline__ int lds_byte(int r, int c) { const int st = (r >> 4) * 2 + (c >> 5), rr = r & 15, cc = c & 31, ob = rr * 64 + cc * 2; return st * 1024 + (ob ^ (((ob >> 9) & 1) << 5)); }
__device__ __forceinline__ void stage_rc(int b, int& R, int& C) { const int st = b / 1024, sb = b % 1024, swz = sb ^ (((sb >> 9) & 1) << 5); R = (st >> 1) * 16 + swz / 64; C = (st & 1) * 32 + (swz % 64) / 2; }

struct Unit { const char* A; const char* B; unsigned lda, ldb; int nt; int pm, pn, aux; const int* gidx; int gcnt; };
struct Voff { unsigned a[2][2], b[2][2]; };
__device__ __forceinline__ int brow_perm8(int h, int R) { return 128 * h + (R & ~31) + 8 * ((R >> 2) & 3) + 4 * ((R >> 4) & 1) + (R & 3); }
__device__ __forceinline__ int brow_rope(int h, int R) { return 128 * (R >> 6) + 64 * h + 32 * ((R >> 5) & 1) + 8 * ((R >> 2) & 3) + 4 * ((R >> 4) & 1) + (R & 3); }

template <class Epi> __device__ __forceinline__ void make_voff(const Unit& u, Voff& v, int tid) {
#pragma unroll
    for (int i = 0; i < 2; ++i) { int R, C; stage_rc(tid * 16 + i * 8192, R, C);
#pragma unroll
        for (int h = 0; h < 2; ++h) {
            int ra = h * HALF + R;
            if (u.gidx) ra = (ra < u.gcnt) ? u.gidx[ra] : 0;
            v.a[h][i] = (unsigned)ra * u.lda + (unsigned)C * 2u;
            v.b[h][i] = (unsigned)Epi::brow(h, R) * u.ldb + (unsigned)C * 2u;
        } }
}

template <class Epi, class Sched, bool ALIGN_EPI, bool SP2>
__device__ __forceinline__ void gemm_phase(LAS unsigned char* lds, LAS unsigned char* ex, const Sched& S, const Epi& E, int wid) {
    const int lane = lane_id(), tid = wid * 64 + lane, wr = wid >> 2, wc = wid & 3, fr = lane & 15, fq = lane >> 4;
    const unsigned ldsw = (unsigned)wid * 1024u;
    const int aoff = lds_byte(wr * 64 + fr, fq * 8), boff = lds_byte(wc * 32 + fr, fq * 8);
#define PG8_SA(b, h) (((b) * 2 + (h)) * HTB)
#define PG8_SB(b, h) ((4 + (b) * 2 + (h)) * HTB)
#define PG8_STAGE(bufoff, gbase, voff) do { _Pragma("unroll") for (int _i = 0; _i < 2; ++_i) \
        __builtin_amdgcn_global_load_lds((const unsigned*)((const char*)(gbase) + (voff)[_i]), (LAS unsigned*)(lds + (bufoff) + ldsw + _i * 8192), 16, 0, 0); } while (0)
#define PG8_LDA(dst, b, h) do { _Pragma("unroll") for (int m = 0; m < 4; ++m) _Pragma("unroll") for (int k = 0; k < 2; ++k) dst[m][k] = *(const LAS bf16x8*)(lds + PG8_SA(b, h) + aoff + m * 2048 + k * 1024); } while (0)
#define PG8_LDB(dst, b, h) do { _Pragma("unroll") for (int n = 0; n < 2; ++n) _Pragma("unroll") for (int k = 0; k < 2; ++k) dst[n][k] = *(const LAS bf16x8*)(lds + PG8_SB(b, h) + boff + n * 2048 + k * 1024); } while (0)
#define PG8_MMA(ai, bj, At, Bt) do { __builtin_amdgcn_s_setprio(1); _Pragma("unroll") for (int m = 0; m < 4; ++m) _Pragma("unroll") for (int n = 0; n < 2; ++n) _Pragma("unroll") for (int k = 0; k < 2; ++k) \
        acc[ai][bj][m][n] = __builtin_amdgcn_mfma_f32_16x16x32_bf16(Bt[n][k], At[m][k], acc[ai][bj][m][n], 0, 0, 0); __builtin_amdgcn_s_setprio(0); } while (0)
#define PG8_WAIT_V(n) asm volatile("s_waitcnt vmcnt(" #n ")" ::: "memory")
#define PG8_WAIT_L(n) asm volatile("s_waitcnt lgkmcnt(" #n ")" ::: "memory")
#define PG8_BAR __builtin_amdgcn_s_barrier()
#define PG8_SCHED __builtin_amdgcn_sched_barrier(0)
    Unit cur, nxt; int ui = 0;
    if (!S.next(0, cur)) return;
    Voff vo, nvo;
    make_voff<Epi>(cur, vo, tid);
    f32x4 acc[2][2][4][2];
#pragma unroll
    for (int a = 0; a < 2; ++a)
#pragma unroll
        for (int b = 0; b < 2; ++b)
#pragma unroll
            for (int m = 0; m < 4; ++m)
#pragma unroll
                for (int n = 0; n < 2; ++n) acc[a][b][m][n] = (f32x4){0.f, 0.f, 0.f, 0.f};
    bf16x8 At[4][2], B0[2][2], B1[2][2];
    const char* cA = cur.A; const char* cB = cur.B;
    const size_t kstep = (size_t)(BK * 2);
    if constexpr (SP2) {
        PG8_STAGE(PG8_SB(0, 0), cB, vo.b[0]); PG8_STAGE(PG8_SB(0, 1), cB, vo.b[1]); PG8_STAGE(PG8_SA(0, 0), cA, vo.a[0]); PG8_STAGE(PG8_SA(0, 1), cA, vo.a[1]);
        if (wr == 1) PG8_BAR;
        PG8_WAIT_V(2); PG8_BAR;
        PG8_STAGE(PG8_SB(1, 0), cB + kstep, vo.b[0]); PG8_STAGE(PG8_SA(1, 0), cA + kstep, vo.a[0]); PG8_STAGE(PG8_SB(1, 1), cB + kstep, vo.b[1]);
        PG8_WAIT_V(6); PG8_BAR;
    } else {
        PG8_STAGE(PG8_SB(0, 0), cB, vo.b[0]); PG8_STAGE(PG8_SA(0, 0), cA, vo.a[0]); PG8_STAGE(PG8_SB(0, 1), cB, vo.b[1]); PG8_STAGE(PG8_SA(0, 1), cA, vo.a[1]);
        if (wr == 1) PG8_BAR;
        PG8_WAIT_V(4); PG8_BAR;
        PG8_STAGE(PG8_SB(1, 0), cB + kstep, vo.b[0]); PG8_STAGE(PG8_SA(1, 0), cA + kstep, vo.a[0]); PG8_STAGE(PG8_SB(1, 1), cB + kstep, vo.b[1]);
        PG8_WAIT_V(6); PG8_BAR;
    }
    for (;;) {
        const bool has_next = S.next(ui + 1, nxt);
        if (has_next) make_voff<Epi>(nxt, nvo, tid); else nvo = vo;
        const char* nA = has_next ? nxt.A : cA; const char* nB = has_next ? nxt.B : cB;
        const int nt = cur.nt;
        for (int t = 0; t < nt; t += 2) {
            const bool last = (t == nt - 2);
            const char* a1 = cA + (size_t)(t + 1) * kstep;
            const char* a2 = last ? nA : cA + (size_t)(t + 2) * kstep; const char* b2 = last ? nB : cB + (size_t)(t + 2) * kstep;
            const char* a3 = a2 + kstep; const char* b3 = b2 + kstep;
            Voff w;
#pragma unroll
            for (int h = 0; h < 2; ++h)
#pragma unroll
                for (int i = 0; i < 2; ++i) { w.a[h][i] = last ? nvo.a[h][i] : vo.a[h][i]; w.b[h][i] = last ? nvo.b[h][i] : vo.b[h][i]; }
            if constexpr (SP2) {
            PG8_LDB(B0, 0, 0); PG8_LDB(B1, 0, 1); PG8_SCHED; PG8_LDA(At, 0, 0); PG8_STAGE(PG8_SA(1, 1), a1, vo.a[1]);
            PG8_WAIT_V(8); PG8_WAIT_L(0); PG8_BAR; PG8_MMA(0, 0, At, B0); PG8_MMA(0, 1, At, B1); PG8_BAR; PG8_SCHED;
            PG8_LDA(At, 0, 1); PG8_STAGE(PG8_SB(0, 0), b2, w.b[0]); PG8_STAGE(PG8_SB(0, 1), b2, w.b[1]); PG8_STAGE(PG8_SA(0, 0), a2, w.a[0]);
            PG8_WAIT_V(8); PG8_WAIT_L(0); PG8_BAR; PG8_MMA(1, 0, At, B0); PG8_MMA(1, 1, At, B1); PG8_BAR; PG8_SCHED;
            PG8_LDB(B0, 1, 0); PG8_LDB(B1, 1, 1); PG8_SCHED; PG8_LDA(At, 1, 0); PG8_STAGE(PG8_SA(0, 1), a2, w.a[1]);
            PG8_WAIT_V(8); PG8_WAIT_L(0); PG8_BAR; PG8_MMA(0, 0, At, B0); PG8_MMA(0, 1, At, B1); PG8_BAR; PG8_SCHED;
            PG8_LDA(At, 1, 1); PG8_STAGE(PG8_SB(1, 0), b3, w.b[0]); PG8_STAGE(PG8_SB(1, 1), b3, w.b[1]); PG8_STAGE(PG8_SA(1, 0), a3, w.a[0]);
            PG8_WAIT_V(8); PG8_WAIT_L(0); PG8_BAR; PG8_MMA(1, 0, At, B0); PG8_MMA(1, 1, At, B1); PG8_BAR; PG8_SCHED;
            } else {
            PG8_LDB(B0, 0, 0); PG8_SCHED; PG8_LDA(At, 0, 0); PG8_STAGE(PG8_SA(1, 1), a1, vo.a[1]);
            PG8_WAIT_L(8); PG8_BAR; PG8_WAIT_L(0); PG8_MMA(0, 0, At, B0); PG8_BAR; PG8_SCHED;
            PG8_LDB(B1, 0, 1); PG8_STAGE(PG8_SB(0, 0), b2, w.b[0]);
            PG8_BAR; PG8_WAIT_L(0); PG8_MMA(0, 1, At, B1); PG8_BAR;
            PG8_LDA(At, 0, 1); PG8_STAGE(PG8_SA(0, 0), a2, w.a[0]);
            PG8_BAR; PG8_WAIT_L(0); PG8_MMA(1, 0, At, B0); PG8_BAR; PG8_SCHED;
            PG8_STAGE(PG8_SB(0, 1), b2, w.b[1]);
            PG8_WAIT_V(6); PG8_BAR; PG8_MMA(1, 1, At, B1); PG8_BAR;
            PG8_LDB(B0, 1, 0); PG8_SCHED; PG8_LDA(At, 1, 0); PG8_STAGE(PG8_SA(0, 1), a2, w.a[1]);
            PG8_WAIT_L(8); PG8_BAR; PG8_WAIT_L(0); PG8_MMA(0, 0, At, B0); PG8_BAR; PG8_SCHED;
            PG8_LDB(B1, 1, 1); PG8_STAGE(PG8_SB(1, 0), b3, w.b[0]);
            PG8_BAR; PG8_WAIT_L(0); PG8_MMA(0, 1, At, B1); PG8_BAR;
            PG8_LDA(At, 1, 1); PG8_STAGE(PG8_SA(1, 0), a3, w.a[0]);
            PG8_BAR; PG8_WAIT_L(0); PG8_MMA(1, 0, At, B0); PG8_BAR; PG8_SCHED;
            PG8_STAGE(PG8_SB(1, 1), b3, w.b[1]);
            PG8_WAIT_V(6); PG8_BAR; PG8_MMA(1, 1, At, B1); PG8_BAR;
            }
        }
        if constexpr (ALIGN_EPI) { if (wr == 0) PG8_BAR; }
        E(acc, cur, wr, wc, fr, fq, ex);
        if (!has_next) break;
#pragma unroll
        for (int a = 0; a < 2; ++a)
#pragma unroll
            for (int b = 0; b < 2; ++b)
#pragma unroll
                for (int m = 0; m < 4; ++m)
#pragma unroll
                    for (int n = 0; n < 2; ++n) acc[a][b][m][n] = (f32x4){0.f, 0.f, 0.f, 0.f};
        cur = nxt; cA = nA; cB = nB; vo = nvo; ++ui;
        if constexpr (ALIGN_EPI) { if (wr == 1) PG8_BAR; }
    }
    PG8_WAIT_V(0);
    if constexpr (!ALIGN_EPI) { if (wr == 0) PG8_BAR; }
    PG8_BAR;
#undef PG8_SA
#undef PG8_SB
#undef PG8_STAGE
#undef PG8_LDA
#undef PG8_LDB
#undef PG8_MMA
#undef PG8_WAIT_V
#undef PG8_WAIT_L
#undef PG8_BAR
#undef PG8_SCHED
}

struct TileOrder {
    int nM, nN, nwg, G, c;
    __device__ void init(int M, int N, int G_, int c_) { nM = M / BM; nN = N / BM; nwg = nM * nN; G = G_; c = c_; }
    __device__ bool tile(int i, int& pm, int& pn) const {
        const long L = (long)i * G + c; if (L >= nwg) return false;
        int wgid = (int)L; { const int q = nwg / 8, r = nwg % 8, xcd = wgid % 8, off = wgid / 8; wgid = (xcd < r ? xcd * (q + 1) : r * (q + 1) + (xcd - r) * q) + off; }
        const int nig = 8 * nN, gid = wgid / nig, fm = gid * 8, gsz = (nM - fm) < 8 ? (nM - fm) : 8;
        pm = fm + ((wgid % nig) % gsz); pn = (wgid % nig) / gsz; return true;
    }
};
}

typedef float f32x2 __attribute__((ext_vector_type(2)));
#define ACC_T f32x4 (&acc)[2][2][4][2]

struct EpiProj {
    __device__ static __forceinline__ int brow(int h, int R) { return pg8::brow_rope(h, R); }
    unsigned char* ws; const float *qg, *kg;
    __device__ static __forceinline__ void rot4(const f32x4 x1, const f32x4 x2, const f32x4 t0, const f32x4 t1, f32x4& y1, f32x4& y2) {
        y1.x = x1.x * t0.x - x2.x * t0.y; y2.x = x2.x * t0.x + x1.x * t0.y;
        y1.y = x1.y * t0.z - x2.y * t0.w; y2.y = x2.y * t0.z + x1.y * t0.w;
        y1.z = x1.z * t1.x - x2.z * t1.y; y2.z = x2.z * t1.x + x1.z * t1.y;
        y1.w = x1.w * t1.z - x2.w * t1.w; y2.w = x2.w * t1.z + x1.w * t1.w;
    }
    __device__ static __forceinline__ void store8(bf16_t* dst, const f32x4 a, const f32x4 b) {
        u32x4 w; w.x = cvtpk(a.x, a.y); w.y = cvtpk(a.z, a.w); w.z = cvtpk(b.x, b.y); w.w = cvtpk(b.z, b.w); *(u32x4*)dst = w; }
    __device__ __forceinline__ void operator()(ACC_T, const pg8::Unit& u, int wr, int wc, int fr, int fq, LAS unsigned char* ex) const {
        const int ng = 2 * u.pn + (wc >> 1), c0 = 32 * (wc & 1) + 8 * fq;
        if (ng < 72) {
            const int which = ng / 24, hh = ng % 24, g = hh >> 3, h = hh & 7;
            bf16_t* buf = (bf16_t*)(ws + WS_QA + (size_t)which * (WS_KA - WS_QA));
            const float2* rt1 = (const float2*)(ws + WS_RT1);
#pragma unroll
            for (int ai = 0; ai < 2; ++ai)
#pragma unroll
                for (int m = 0; m < 4; ++m) {
                    const int mrow = u.pm * 256 + ai * 128 + wr * 64 + m * 16 + fr, b = mrow >> 12, t = mrow & 4095;
                    bf16_t* dst = buf + ((size_t)((g * 2 + b) * 8 + h) * SEQ + perm_pos(g, t)) * HD + c0;
                    f32x4 y1a = acc[ai][0][m][0], y1b = acc[ai][0][m][1], y2a = acc[ai][1][m][0], y2b = acc[ai][1][m][1];
                    if (which < 2) {
                        const f32x4* tp = (const f32x4*)(rt1 + (size_t)t * 64 + c0);
                        const f32x4 t0 = tp[0], t1 = tp[1], t2 = tp[2], t3 = tp[3];
                        rot4(acc[ai][0][m][0], acc[ai][1][m][0], t0, t1, y1a, y2a); rot4(acc[ai][0][m][1], acc[ai][1][m][1], t2, t3, y1b, y2b);
                    }
                    store8(dst, y1a, y1b); store8(dst + 64, y2a, y2b);
                }
        } else if (ng < 92) {
            const int k = ng - 72;
            LAS float* X = (LAS float*)ex;
#pragma unroll
            for (int ai = 0; ai < 2; ++ai)
#pragma unroll
                for (int m = 0; m < 4; ++m) { float s = 0.f;
#pragma unroll
                    for (int bj = 0; bj < 2; ++bj)
#pragma unroll
                        for (int n = 0; n < 2; ++n) { const f32x4 x = acc[ai][bj][m][n]; s += (x.x * x.x + x.y * x.y) + (x.z * x.z + x.w * x.w); }
                    s += __shfl_xor(s, 16); s += __shfl_xor(s, 32);
                    if (fq == 0) X[(ai * 128 + wr * 64 + m * 16 + fr) * 4 + wc] = s; }
            asm volatile("s_waitcnt lgkmcnt(0)" ::: "memory"); __builtin_amdgcn_s_barrier(); asm volatile("" ::: "memory");
            const float* gn = (k < 16) ? qg : kg; const float2* rt2 = (const float2*)(ws + WS_RT2);
            bf16_t* qb = (bf16_t*)(ws + WS_QB); bf16_t* kb = (bf16_t*)(ws + WS_KB);
            const f32x4 g1a = *(const f32x4*)(gn + c0), g1b = *(const f32x4*)(gn + c0 + 4), g2a = *(const f32x4*)(gn + 64 + c0), g2b = *(const f32x4*)(gn + 64 + c0 + 4);
#pragma unroll
            for (int ai = 0; ai < 2; ++ai)
#pragma unroll
                for (int m = 0; m < 4; ++m) {
                    const int r = ai * 128 + wr * 64 + m * 16 + fr;
                    const float ssum = X[r * 4 + (wc & 2)] + X[r * 4 + (wc & 2) + 1];
                    const int mrow = u.pm * 256 + r, b = mrow >> 12, t = mrow & 4095;
                    bf16_t* dst = ((k < 16) ? qb + ((size_t)(b * 16 + k) * SEQ + t) * HD : kb + ((size_t)(b * 4 + (k - 16)) * SEQ + t) * HD) + c0;
                    const float rinv = 1.0f / sqrtf(ssum * (1.0f / 128.0f) + RMS_EPS);
                    const f32x4* tp = (const f32x4*)(rt2 + (size_t)t * 64 + c0);
                    const f32x4 t0 = tp[0], t1 = tp[1], t2 = tp[2], t3 = tp[3];
                    f32x4 y1a, y1b, y2a, y2b;
                    rot4(acc[ai][0][m][0] * rinv * g1a, acc[ai][1][m][0] * rinv * g2a, t0, t1, y1a, y2a); rot4(acc[ai][0][m][1] * rinv * g1b, acc[ai][1][m][1] * rinv * g2b, t2, t3, y1b, y2b);
                    store8(dst, y1a, y1b); store8(dst + 64, y2a, y2b);
                }
        } else {
#pragma unroll
            for (int ai = 0; ai < 2; ++ai)
#pragma unroll
                for (int m = 0; m < 4; ++m) {
                    const int mrow = u.pm * 256 + ai * 128 + wr * 64 + m * 16 + fr, b = mrow >> 12, t = mrow & 4095;
                    bf16_t* dst = (ng < 96 ? (bf16_t*)(ws + WS_VB) + ((size_t)(b * 4 + (ng - 92)) * SEQ + t) * HD : (bf16_t*)(ws + WS_GATES) + (size_t)mrow * 4096 + (ng - 96) * 128) + c0;
                    f32x4 y1a = acc[ai][0][m][0], y1b = acc[ai][0][m][1], y2a = acc[ai][1][m][0], y2b = acc[ai][1][m][1];
                    if (ng >= 96) {
#pragma unroll
                        for (int q = 0; q < 4; ++q) { y1a[q] = __builtin_amdgcn_rcpf(1.0f + __expf(-y1a[q])); y1b[q] = __builtin_amdgcn_rcpf(1.0f + __expf(-y1b[q]));
                            y2a[q] = __builtin_amdgcn_rcpf(1.0f + __expf(-y2a[q])); y2b[q] = __builtin_amdgcn_rcpf(1.0f + __expf(-y2b[q])); } }
                    store8(dst, y1a, y1b); store8(dst + 64, y2a, y2b);
                }
        }
    }
};
struct ProjSched {
    pg8::TileOrder o; const char* ws;
    __device__ __forceinline__ bool next(int i, pg8::Unit& u) const { int pm, pn; if (!o.tile(i, pm, pn)) return false;
        u.A = ws + WS_XB + (size_t)pm * 256 * (DM * 2); u.B = ws + WS_WINT + (size_t)pn * 256 * (DM * 2); u.lda = DM * 2; u.ldb = DM * 2; u.nt = DM / 64; u.pm = pm; u.pn = pn; u.aux = 0; u.gidx = nullptr; u.gcnt = 0; return true; }
};

struct EpiMix {
    __device__ static __forceinline__ int brow(int h, int R) { return pg8::brow_perm8(h, R); }
    unsigned char* ws; const float* x;
    __device__ __forceinline__ void operator()(ACC_T, const pg8::Unit& u, int wr, int wc, int fr, int fq, LAS unsigned char* ex) const {
        const bf16_t* gates = (const bf16_t*)(ws + WS_GATES); float* T = (float*)(ws + WS_T); bf16_t* merged = (bf16_t*)(ws + WS_MERGED); float* pre1 = (float*)(ws + WS_PRE1);
#pragma unroll
        for (int ai = 0; ai < 2; ++ai)
#pragma unroll
            for (int m = 0; m < 4; ++m) { const size_t mrow = (size_t)u.pm * 256 + ai * 128 + wr * 64 + m * 16 + fr;
#pragma unroll
                for (int bj = 0; bj < 2; ++bj) { const int col = u.pn * 256 + bj * 128 + wc * 32 + 8 * fq; const size_t o = mrow * DM + col;
                    const f32x4 a0 = acc[ai][bj][m][0], a1 = acc[ai][bj][m][1];
                    if (u.aux == 2) {
                        const f32x4 x0 = *(const f32x4*)(x + o), x1 = *(const f32x4*)(x + o + 4);
                        *(f32x4*)(pre1 + o) = x0 * ALPHA + a0; *(f32x4*)(pre1 + o + 4) = x1 * ALPHA + a1;
                    } else {
                        const u32x4 gw = *(const u32x4*)(gates + mrow * 4096 + (u.aux ? 2048 : 0) + col);
                        f32x4 g0, g1; g0.x = bflo(gw.x); g0.y = bfhi(gw.x); g0.z = bflo(gw.y); g0.w = bfhi(gw.y); g1.x = bflo(gw.z); g1.y = bfhi(gw.z); g1.z = bflo(gw.w); g1.w = bfhi(gw.w);
                        if (u.aux == 0) { *(f32x4*)(T + o) = g0 * a0; *(f32x4*)(T + o + 4) = g1 * a1; }
                        else { const f32x4 t0 = *(const f32x4*)(T + o) + g0 * a0, t1 = *(const f32x4*)(T + o + 4) + g1 * a1;
                            u32x4 w; w.x = cvtpk(t0.x, t0.y); w.y = cvtpk(t0.z, t0.w); w.z = cvtpk(t1.x, t1.y); w.w = cvtpk(t1.z, t1.w); *(u32x4*)(merged + o) = w; }
                    } } }
    }
};
struct MixSched {
    int mode, c; const char* ws;
    __device__ __forceinline__ bool next(int i, pg8::Unit& u) const {
        if (c >= 256) return false;
        const int pm = c >> 3, pn = c & 7; u.pm = pm; u.pn = pn; u.gidx = nullptr; u.gcnt = 0;
        if (mode == 0) { if (i > 1) return false;
            if (i == 0) { u.A = ws + WS_OA + (size_t)pm * 256 * 2048; u.B = ws + WS_WAT + (size_t)pn * 256 * 2048; u.lda = 2048; u.ldb = 2048; u.nt = 16; u.aux = 0; }
            else { u.A = ws + WS_OB + (size_t)pm * 256 * 4096; u.B = ws + WS_WBT + (size_t)pn * 256 * 4096; u.lda = 4096; u.ldb = 4096; u.nt = 32; u.aux = 1; }
            return true; }
        if (i > 0) return false;
        u.A = ws + WS_MERGED + (size_t)pm * 256 * 4096; u.B = ws + WS_WOT + (size_t)pn * 256 * 4096; u.lda = 4096; u.ldb = 4096; u.nt = 32; u.aux = 2; return true;
    }
};

struct MoeSched {
    int G, vcu, down; unsigned cnt_l, tpe_l;
    const char* ws;
    __device__ __forceinline__ void init(const unsigned* cnt, int lane) {
        unsigned c = 0; if (lane < NEXP) c = __hip_atomic_load(cnt + lane, __ATOMIC_RELAXED, __HIP_MEMORY_SCOPE_AGENT);
        unsigned t = (c + 255u) >> 8, inc = t;
#pragma unroll
        for (int o = 1; o < 32; o <<= 1) { const unsigned v = __shfl_up(inc, o); if ((lane & 31) >= o) inc += v; }
        cnt_l = c; tpe_l = inc - t;
    }
    __device__ __forceinline__ bool next(int i, pg8::Unit& u) const {
        const int lane = lane_id();
        const int total = (int)__builtin_amdgcn_readfirstlane(__shfl(tpe_l + ((cnt_l + 255u) >> 8), 31));
        const int L = i * G + vcu; if (L >= total * 8) return false;
        const int tg = L >> 3;
        const unsigned long long mk = __ballot(lane < NEXP && (int)tpe_l <= tg && (cnt_l > 0u));
        const int e = 63 - __builtin_clzll(mk);
        const int tp = (int)__builtin_amdgcn_readfirstlane(__shfl(tpe_l, e)), ce = (int)__builtin_amdgcn_readfirstlane(__shfl(cnt_l, e));
        const int te = (ce + 255) >> 8, q = L - 8 * tp, j = q / te, mt = q - j * te;
        u.pm = tp + mt; u.pn = j; u.aux = e; u.nt = down ? 16 : 32;
        if (!down) { u.A = ws + WS_H1B; u.lda = DM * 2; u.gidx = (const int*)(ws + WS_TOKIDX) + (size_t)e * ECAP + 256 * mt; u.gcnt = ce - 256 * mt; u.B = ws + WS_WGUT + ((size_t)e * 2048 + j * 256) * (DM * 2); u.ldb = DM * 2; }
        else { u.A = ws + WS_ACT + (size_t)(tp + mt) * 256 * (FF * 2); u.lda = FF * 2; u.gidx = nullptr; u.gcnt = 0; u.B = ws + WS_WDT + ((size_t)e * 2048 + j * 256) * (FF * 2); u.ldb = FF * 2; }
        return true;
    }
};
struct EpiMoe {
    __device__ static __forceinline__ int brow(int h, int R) { return pg8::brow_perm8(h, R); }
    int down; unsigned char* ws;
    __device__ __forceinline__ void operator()(ACC_T, const pg8::Unit& u, int wr, int wc, int fr, int fq, LAS unsigned char* ex) const {
        bf16_t* act = (bf16_t*)(ws + WS_ACT); bf16_t* y = (bf16_t*)(ws + WS_Y);
#pragma unroll
        for (int ai = 0; ai < 2; ++ai)
#pragma unroll
            for (int m = 0; m < 4; ++m) { const size_t row = (size_t)u.pm * 256 + ai * 128 + wr * 64 + m * 16 + fr;
                if (!down) {
                    f32x4 v0, v1;
#pragma unroll
                    for (int q = 0; q < 4; ++q) { const float g0 = acc[ai][0][m][0][q], u0 = acc[ai][1][m][0][q], g1 = acc[ai][0][m][1][q], u1 = acc[ai][1][m][1][q];
                        v0[q] = g0 * __builtin_amdgcn_rcpf(1.0f + __expf(-g0)) * u0; v1[q] = g1 * __builtin_amdgcn_rcpf(1.0f + __expf(-g1)) * u1; }
                    u32x4 w; w.x = cvtpk(v0.x, v0.y); w.y = cvtpk(v0.z, v0.w); w.z = cvtpk(v1.x, v1.y); w.w = cvtpk(v1.z, v1.w);
                    *(u32x4*)(act + row * FF + u.pn * 128 + wc * 32 + 8 * fq) = w;
                } else {
#pragma unroll
                    for (int bj = 0; bj < 2; ++bj) { const f32x4 a0 = acc[ai][bj][m][0], a1 = acc[ai][bj][m][1];
                        u32x4 w; w.x = cvtpk(a0.x, a0.y); w.y = cvtpk(a0.z, a0.w); w.z = cvtpk(a1.x, a1.y); w.w = cvtpk(a1.z, a1.w);
                        *(u32x4*)(y + row * DM + u.pn * 256 + bj * 128 + wc * 32 + 8 * fq) = w; }
                } }
    }
};

namespace att {
constexpr int D = 128, NW = 8, QBLK = 32, KVBLK = 64;
constexpr float SCALE = SM_SCALE, THR = 8.f;
constexpr int SHM_V = KVBLK * D * 2, SHM_K = KVBLK * D * 2, SHM_ATTN = 2 * SHM_V + 2 * SHM_K + NW * 64 * 4;
#define KSWZ(row, colB) ((row) * 256 + ((colB) ^ (((row) & 7) << 4)))
#define SBAR() __builtin_amdgcn_sched_barrier(0)
__device__ __forceinline__ int crow(int r, int hi) { return (r & 3) + 8 * (r >> 2) + 4 * hi; }
template <bool BAND> __device__ __forceinline__ void partialSM(f32x16& p0, f32x16& p1, float& m_reg, float& mn, float& alpha, int dv, bool tv) {
    constexpr float C = SCALE * 1.4426950408889634f;
    if constexpr (BAND) {
#pragma unroll
        for (int r = 0; r < 16; ++r) { const int kx = (r & 3) + 8 * (r >> 2);
            if (!tv || (unsigned)(dv + kx) > 128u) p0[r] = -INFINITY;
            if (!tv || (unsigned)(dv + kx + 32) > 128u) p1[r] = -INFINITY; } }
    float pmax = p0[0];
#pragma unroll
    for (int r = 1; r < 16; ++r) pmax = fmaxf(pmax, p0[r]);
#pragma unroll
    for (int r = 0; r < 16; ++r) pmax = fmaxf(pmax, p1[r]);
    { auto rr = __builtin_amdgcn_permlane32_swap(__float_as_uint(pmax), __float_as_uint(pmax), false, false);
      pmax = fmaxf(__uint_as_float(rr[0]), __uint_as_float(rr[1])); }
    if (__builtin_expect(__all(pmax - m_reg <= THR / SCALE), 1)) { mn = m_reg; alpha = 1.f; }
    else { mn = fmaxf(m_reg, pmax); alpha = __builtin_amdgcn_exp2f((m_reg - mn) * C); m_reg = mn; }
    const float mnC = -mn * C;
#pragma unroll
    for (int r = 0; r < 16; ++r) p0[r] = fmaf(p0[r], C, mnC);
#pragma unroll
    for (int r = 0; r < 16; ++r) p1[r] = fmaf(p1[r], C, mnC);
#pragma unroll
    for (int r = 0; r < 16; ++r) p0[r] = __builtin_amdgcn_exp2f(p0[r]);
}
__device__ __forceinline__ void finishSM(f32x16& p0, f32x16& p1, float alpha, float& l_reg, bf16x8& pa0, bf16x8& pa1, bf16x8& pa2, bf16x8& pa3) {
#pragma unroll
    for (int r = 0; r < 16; ++r) p1[r] = __builtin_amdgcn_exp2f(p1[r]);
    float ps = 0;
#pragma unroll
    for (int r = 0; r < 16; ++r) ps += p0[r];
#pragma unroll
    for (int r = 0; r < 16; ++r) ps += p1[r];
    { auto rr = __builtin_amdgcn_permlane32_swap(__float_as_uint(ps), __float_as_uint(ps), false, false);
      ps = __uint_as_float(rr[0]) + __uint_as_float(rr[1]); }
    l_reg = l_reg * alpha + ps;
#define PK4(P, BASE, OUT) do { unsigned a0 = cvtpk(P[BASE + 0], P[BASE + 1]), a1 = cvtpk(P[BASE + 2], P[BASE + 3]);   \
    unsigned b0 = cvtpk(P[BASE + 4], P[BASE + 5]), b1 = cvtpk(P[BASE + 6], P[BASE + 7]);                              \
    auto r0 = __builtin_amdgcn_permlane32_swap(a0, b0, false, false); auto r1 = __builtin_amdgcn_permlane32_swap(a1, b1, false, false); \
    u32x4 w = {r0[0], r1[0], r0[1], r1[1]}; OUT = *reinterpret_cast<bf16x8*>(&w); } while (0)
    PK4(p0, 0, pa0); PK4(p0, 8, pa1); PK4(p1, 0, pa2); PK4(p1, 8, pa3);
#undef PK4
}
__device__ __forceinline__ void qkt(f32x16& p0, f32x16& p1, const LAS unsigned char* Ks, const bf16x8* qr, int r32, int hi) {
    p0 = f32x16{}; p1 = f32x16{};
#pragma unroll
    for (int d0 = 0; d0 < 8; ++d0) { const int cb = (d0 * 16 + hi * 8) * 2;
        const bf16x8 b0 = *(const LAS bf16x8*)(Ks + KSWZ(r32, cb));
        const bf16x8 b1 = *(const LAS bf16x8*)(Ks + KSWZ(32 + r32, cb));
        p0 = __builtin_amdgcn_mfma_f32_32x32x16_bf16(b0, qr[d0], p0, 0, 0, 0);
        p1 = __builtin_amdgcn_mfma_f32_32x32x16_bf16(b1, qr[d0], p1, 0, 0, 0); }
}
__device__ __forceinline__ int v_st(int k, int c) { const int kk = (k & ~0xC) | ((k & 4) << 1) | ((k & 8) >> 1); return ((kk >> 3) * 4 + (c >> 5)) * 512 + ((kk & 7) * 32 + (c & 31)) * 2; }
__device__ __forceinline__ int v_rd_base(int lane) { return ((lane & 3) << 3) | (((lane >> 2) & 3) << 6) | (((lane >> 4) & 1) << 5) | (((lane >> 5) & 1) << 8); }
constexpr int v_rd_off(int d0, int ks, int half) { return d0 * 512 + ks * 4096 + half * 2048; }
template <int OFF> __device__ __forceinline__ s16x4 tr_read(int vb) { s16x4 r; asm volatile("ds_read_b64_tr_b16 %0, %1 offset:%2" : "=&v"(r) : "v"(vb), "i"(OFF) : "memory"); return r; }
template <int D0> __device__ __forceinline__ void pv_one(f32x16& od, int vb, bf16x8 pa0, bf16x8 pa1, bf16x8 pa2, bf16x8 pa3) {
    const s16x4 l0 = tr_read<v_rd_off(D0, 0, 0)>(vb), h0 = tr_read<v_rd_off(D0, 0, 1)>(vb), l1 = tr_read<v_rd_off(D0, 1, 0)>(vb), h1 = tr_read<v_rd_off(D0, 1, 1)>(vb);
    const s16x4 l2 = tr_read<v_rd_off(D0, 2, 0)>(vb), h2 = tr_read<v_rd_off(D0, 2, 1)>(vb), l3 = tr_read<v_rd_off(D0, 3, 0)>(vb), h3 = tr_read<v_rd_off(D0, 3, 1)>(vb);
    asm volatile("s_waitcnt lgkmcnt(0)" ::: "memory"); SBAR();
#define PK(L, H) (bf16x8){L[0], L[1], L[2], L[3], H[0], H[1], H[2], H[3]}
    od = __builtin_amdgcn_mfma_f32_32x32x16_bf16(pa0, PK(l0, h0), od, 0, 0, 0);
    od = __builtin_amdgcn_mfma_f32_32x32x16_bf16(pa1, PK(l1, h1), od, 0, 0, 0);
    od = __builtin_amdgcn_mfma_f32_32x32x16_bf16(pa2, PK(l2, h2), od, 0, 0, 0);
    od = __builtin_amdgcn_mfma_f32_32x32x16_bf16(pa3, PK(l3, h3), od, 0, 0, 0);
#undef PK
}
__device__ __forceinline__ void pv_d0(f32x16* o, int vb, bf16x8 pa0, bf16x8 pa1, bf16x8 pa2, bf16x8 pa3) {
    pv_one<0>(o[0], vb, pa0, pa1, pa2, pa3); pv_one<1>(o[1], vb, pa0, pa1, pa2, pa3); pv_one<2>(o[2], vb, pa0, pa1, pa2, pa3); pv_one<3>(o[3], vb, pa0, pa1, pa2, pa3);
}
struct Unit { const bf16_t *Q, *K, *V; bf16_t* O; float* lse; int ldo, lse_stride, nt, kt0, klo, khi, q0; };
__device__ __forceinline__ void body(const Unit& u, LAS unsigned char* lds, int wid) {
    const int lane = lane_id(), tid = wid * 64 + lane,
        r32 = lane & 31, hi = lane >> 5;
    LAS unsigned char* V_lds = lds; LAS unsigned char* K_lds = lds + 2 * SHM_V;
    LAS float* ws = (LAS float*)(lds + 2 * SHM_V + 2 * SHM_K) + wid * 64; LAS float* li_l = ws; LAS float* al_l = ws + 32;
    float m_reg = -1e30f, l_reg = 0; f32x16 o[4] = {}; bf16x8 qr[8];
    const bf16_t* Qw = u.Q + (size_t)(wid * QBLK + r32) * D + hi * 8;
#pragma unroll
    for (int d0 = 0; d0 < 8; ++d0) qr[d0] = *(const bf16x8*)(Qw + d0 * 16);
    const int sr = tid >> 4, sc = (tid & 15) * 8, vst0 = v_st(sr, sc), vst1 = v_st(32 + sr, sc);
    const int vb0 = (int)(unsigned)(uintptr_t)V_lds + v_rd_base(lane);
    const bf16_t* Kh = u.K; const bf16_t* Vh = u.V;
    constexpr bool BAND = false; constexpr int SD = 1; const int dq = 0;
#define TVALID(j) true
    struct { bf16x8 vs0, vs1, ks0, ks1; } sr_[SD];
#define KROW(j) (BAND ? ((u.kt0 + 64 * (j)) < u.klo ? u.klo : ((u.kt0 + 64 * (j)) > u.khi - 64 ? u.khi - 64 : (u.kt0 + 64 * (j)))) : (u.kt0 + 64 * (j)))
#define SLOAD(i, j) do { const int k0_ = KROW(j); sr_[i].vs0 = *(const bf16x8*)(&Vh[(size_t)(k0_ + sr) * D + sc]); sr_[i].vs1 = *(const bf16x8*)(&Vh[(size_t)(k0_ + 32 + sr) * D + sc]); \
    sr_[i].ks0 = *(const bf16x8*)(&Kh[(size_t)(k0_ + sr) * D + sc]); sr_[i].ks1 = *(const bf16x8*)(&Kh[(size_t)(k0_ + 32 + sr) * D + sc]); } while (0)
#define SWRITE(b, i) do { *(LAS bf16x8*)(V_lds + (b) * SHM_V + vst0) = sr_[i].vs0; *(LAS bf16x8*)(V_lds + (b) * SHM_V + vst1) = sr_[i].vs1; const int kc = sc * 2; \
    *(LAS bf16x8*)(K_lds + (b) * SHM_K + KSWZ(sr, kc)) = sr_[i].ks0; *(LAS bf16x8*)(K_lds + (b) * SHM_K + KSWZ(32 + sr, kc)) = sr_[i].ks1; } while (0)
#define SWAIT() do { if constexpr (SD == 2) asm volatile("s_waitcnt vmcnt(4)" ::: "memory"); else asm volatile("s_waitcnt vmcnt(0)" ::: "memory"); } while (0)
#define RESC(a) do { if (__any((a) < 1.f)) { if (hi == 0) al_l[r32] = (a); asm volatile("s_waitcnt lgkmcnt(0)" ::: "memory"); \
    _Pragma("unroll") for (int d = 0; d < 4; ++d) _Pragma("unroll") for (int r = 0; r < 16; ++r) o[d][r] *= al_l[crow(r, hi)]; } } while (0)
    f32x16 pA0, pA1, pB0, pB1; float mnA, mnB, alA, alB; bf16x8 pa0, pa1, pa2, pa3; const int NT = u.nt;
    constexpr int SE = 0, SO = SD - 1;
    SLOAD(SE, 0); asm volatile("s_waitcnt vmcnt(0)" ::: "memory"); SWRITE(0, SE); __syncthreads();
    qkt(pA0, pA1, K_lds, qr, r32, hi); partialSM<BAND>(pA0, pA1, m_reg, mnA, alA, dq, TVALID(0));
    SLOAD(SO, 1); if constexpr (SD == 2) { if (2 < NT) SLOAD(SE, 2); }
    SWAIT(); SWRITE(1, SO); __syncthreads();
    for (int j = 1; j + 1 < NT; j += 2) {
        SBAR(); qkt(pB0, pB1, K_lds + SHM_K, qr, r32, hi);
        finishSM(pA0, pA1, alA, l_reg, pa0, pa1, pa2, pa3); SBAR();
        SLOAD(SO, j + SD); SBAR();
        pv_d0(o, vb0, pa0, pa1, pa2, pa3); partialSM<BAND>(pB0, pB1, m_reg, mnB, alB, dq + 64 * j, TVALID(j));
        __syncthreads(); SWAIT(); SWRITE(0, SE);
        RESC(alB); __syncthreads();
        SBAR(); qkt(pA0, pA1, K_lds, qr, r32, hi);
        finishSM(pB0, pB1, alB, l_reg, pa0, pa1, pa2, pa3); SBAR();
        if (SD == 1 || j + 3 < NT) SLOAD(SE, j + 1 + SD); SBAR();
        pv_d0(o, vb0 + SHM_V, pa0, pa1, pa2, pa3); partialSM<BAND>(pA0, pA1, m_reg, mnA, alA, dq + 64 * (j + 1), TVALID(j + 1));
        __syncthreads(); SWAIT(); SWRITE(1, SO);
        RESC(alA); __syncthreads();
    }
    SBAR(); qkt(pB0, pB1, K_lds + SHM_K, qr, r32, hi);
    finishSM(pA0, pA1, alA, l_reg, pa0, pa1, pa2, pa3); SBAR();
    pv_d0(o, vb0, pa0, pa1, pa2, pa3); partialSM<BAND>(pB0, pB1, m_reg, mnB, alB, dq + 64 * (NT - 1), TVALID(NT - 1));
    __syncthreads(); RESC(alB);
    finishSM(pB0, pB1, alB, l_reg, pa0, pa1, pa2, pa3); SBAR();
    pv_d0(o, vb0 + SHM_V, pa0, pa1, pa2, pa3);
    if (hi == 0) li_l[r32] = l_reg; asm volatile("s_waitcnt lgkmcnt(0)" ::: "memory");
    float rli[16];
#pragma unroll
    for (int r = 0; r < 16; ++r) rli[r] = __builtin_amdgcn_rcpf(li_l[crow(r, hi)]);
    bf16_t* Ow = u.O + (size_t)(wid * QBLK) * u.ldo;
#pragma unroll
    for (int r = 0; r < 16; ++r) { const int orow = crow(r, hi);
#pragma unroll
        for (int d0 = 0; d0 < 4; ++d0) Ow[(size_t)orow * u.ldo + d0 * 32 + r32] = f2bf(o[d0][r] * rli[r]); }
    if (u.lse && hi == 0) u.lse[(size_t)(wid * QBLK + r32) * u.lse_stride] = m_reg * SCALE + __logf(l_reg);
    __syncthreads();
#undef KROW
#undef TVALID
#undef SLOAD
#undef SWRITE
#undef SWAIT
#undef RESC
}

__device__ __forceinline__ void band_body(const Unit& u, LAS unsigned char* lds, int wid) {
    const int lane = lane_id(), tid = wid * 64 + lane, r32 = lane & 31, hi = lane >> 5;
    LAS unsigned char* V_lds = lds; LAS unsigned char* K_lds = lds + 2 * SHM_V;
    LAS float* ws = (LAS float*)(lds + 2 * SHM_V + 2 * SHM_K) + wid * 64; LAS float* li_l = ws; LAS float* al_l = ws + 32;
    float m_reg = -1e30f, l_reg = 0; f32x16 o[4] = {}; bf16x8 qr[8];
    const bf16_t* Qw = u.Q + (size_t)(wid * QBLK + r32) * D + hi * 8;
#pragma unroll
    for (int d0 = 0; d0 < 8; ++d0) qr[d0] = *(const bf16x8*)(Qw + d0 * 16);
    const int sr = tid >> 4, sc = (tid & 15) * 8, vst0 = v_st(sr, sc), vst1 = v_st(32 + sr, sc);
    const int vb0 = (int)(unsigned)(uintptr_t)V_lds + v_rd_base(lane);
    const bf16_t* Kh = u.K; const bf16_t* Vh = u.V;
    const int dq = u.kt0 - (u.q0 + wid * QBLK + r32) + 4 * hi + 64;
    bf16x8 vs0, vs1, ks0, ks1;
#define KROW(j) ((u.kt0 + 64 * (j)) < u.klo ? u.klo : ((u.kt0 + 64 * (j)) > u.khi - 64 ? u.khi - 64 : (u.kt0 + 64 * (j))))
#define TVALID(j) ((u.kt0 + 64 * (j)) >= u.klo && (u.kt0 + 64 * (j)) < u.khi)
#define SLOAD(j) do { const int k0_ = KROW(j); vs0 = *(const bf16x8*)(&Vh[(size_t)(k0_ + sr) * D + sc]); vs1 = *(const bf16x8*)(&Vh[(size_t)(k0_ + 32 + sr) * D + sc]); \
    ks0 = *(const bf16x8*)(&Kh[(size_t)(k0_ + sr) * D + sc]); ks1 = *(const bf16x8*)(&Kh[(size_t)(k0_ + 32 + sr) * D + sc]); } while (0)
#define SWRITE(b) do { *(LAS bf16x8*)(V_lds + (b) * SHM_V + vst0) = vs0; *(LAS bf16x8*)(V_lds + (b) * SHM_V + vst1) = vs1; const int kc = sc * 2; \
    *(LAS bf16x8*)(K_lds + (b) * SHM_K + KSWZ(sr, kc)) = ks0; *(LAS bf16x8*)(K_lds + (b) * SHM_K + KSWZ(32 + sr, kc)) = ks1; } while (0)
    const int NT = u.nt;
    SLOAD(0); asm volatile("s_waitcnt vmcnt(0)" ::: "memory"); SWRITE(0);
    if (1 < NT) SLOAD(1);
    __syncthreads();
    for (int j = 0; j < NT; ++j) {
        const int cur = j & 1;
        f32x16 p0, p1; float mn, al; bf16x8 pa0, pa1, pa2, pa3;
        qkt(p0, p1, K_lds + cur * SHM_K, qr, r32, hi);
        partialSM<true>(p0, p1, m_reg, mn, al, dq + 64 * j, TVALID(j));
        if (__any(al < 1.f)) { if (hi == 0) al_l[r32] = al; asm volatile("s_waitcnt lgkmcnt(0)" ::: "memory");
#pragma unroll
            for (int d = 0; d < 4; ++d)
#pragma unroll
                for (int r = 0; r < 16; ++r) o[d][r] *= al_l[crow(r, hi)]; }
        finishSM(p0, p1, al, l_reg, pa0, pa1, pa2, pa3); SBAR();
        if (j + 1 < NT) { asm volatile("s_waitcnt vmcnt(0)" ::: "memory"); SWRITE(cur ^ 1); }
        if (j + 2 < NT) SLOAD(j + 2);
        SBAR();
        pv_d0(o, vb0 + cur * SHM_V, pa0, pa1, pa2, pa3);
        __syncthreads();
    }
    if (hi == 0) li_l[r32] = l_reg; asm volatile("s_waitcnt lgkmcnt(0)" ::: "memory");
    float rli[16];
#pragma unroll
    for (int r = 0; r < 16; ++r) rli[r] = __builtin_amdgcn_rcpf(li_l[crow(r, hi)]);
    bf16_t* Ow = u.O + (size_t)(wid * QBLK) * u.ldo;
#pragma unroll
    for (int r = 0; r < 16; ++r) { const int orow = crow(r, hi);
#pragma unroll
        for (int d0 = 0; d0 < 4; ++d0) Ow[(size_t)orow * u.ldo + d0 * 32 + r32] = f2bf(o[d0][r] * rli[r]); }
    if (hi == 0) u.lse[(size_t)(wid * QBLK + r32) * u.lse_stride] = m_reg * SCALE + __logf(l_reg);
    __syncthreads();
#undef KROW
#undef TVALID
#undef SLOAD
#undef SWRITE
}
}

#define XB_TMO      128
#define XB_XCNT(j)  (256  + 64 * (j))
#define XB_XSUB(j)  (1280 + 64 * (j))
#define XB_XGEN(j)  (2304 + 64 * (j))
#define XB_TOP      3328
#define XB_TOPGEN   3392
#define XCD_BAR_WORDS 3456
#define XB_SPIN_CAP (1u << 20)
__device__ __forceinline__ unsigned xb_ld(unsigned* p)              { return __hip_atomic_load(p, __ATOMIC_RELAXED, __HIP_MEMORY_SCOPE_AGENT); }
__device__ __forceinline__ unsigned xb_add(unsigned* p, unsigned v) { return __hip_atomic_fetch_add(p, v, __ATOMIC_RELAXED, __HIP_MEMORY_SCOPE_AGENT); }
__device__ __forceinline__ unsigned xb_xcc_id() { return (unsigned)__builtin_amdgcn_s_getreg((3 << 11) | 20) & 0xFu; }
#define XB_SPIN(cond, bar) do { unsigned _sp = 0; while (cond) { __builtin_amdgcn_s_sleep(1); \
    if ((++_sp & 255u) == 0u) { if (xb_ld(&(bar)[XB_TMO])) break; if (_sp > XB_SPIN_CAP) { atomicAdd(&(bar)[XB_TMO], 1u); break; } } } } while (0)
__device__ __forceinline__ void xcd_barrier_post(unsigned* bar, bool leader) { if (leader) (void)xb_add(&bar[XB_XCNT(xb_xcc_id())], 1u); }
__device__ __forceinline__ void xcd_barrier_complete(unsigned* bar, unsigned x, unsigned G, unsigned& nloc, unsigned& nx) {
    unsigned sum, cnt, mine, sp = 0u;
    for (;;) {
        sum = 0u; cnt = 0u; mine = 0u;
#pragma unroll
        for (unsigned j = 0; j < 16; ++j) { const unsigned c = xb_ld(&bar[XB_XCNT(j)]); sum += c; cnt += (c > 0u) ? 1u : 0u; mine = (j == x) ? c : mine; }
        if (sum == G) break;
        __builtin_amdgcn_s_sleep(1);
        if ((++sp & 255u) == 0u) { if (xb_ld(&bar[XB_TMO])) break; if (sp > XB_SPIN_CAP) { atomicAdd(&bar[XB_TMO], 1u); break; } }
    }
    nloc = mine > 0u ? mine : 1u; nx = cnt > 0u ? cnt : 1u;
}
__device__ __forceinline__ void xcd_barrier(unsigned* bar, volatile LAS unsigned* st, unsigned G, bool leader) {
    asm volatile("s_waitcnt vmcnt(0)" ::: "memory");
    __syncthreads();
    if (leader) {
        __builtin_amdgcn_s_waitcnt(0);
        const unsigned x = xb_xcc_id();
        unsigned nloc = st[0], nx = st[1];
        if (nloc == 0u) { xcd_barrier_complete(bar, x, G, nloc, nx); st[0] = nloc; st[1] = nx; }
        const unsigned old = xb_add(&bar[XB_XSUB(x)], 1u);
        const unsigned gen = old / nloc;
        if (old + 1u == (gen + 1u) * nloc) {
            __builtin_amdgcn_fence(__ATOMIC_RELEASE, "agent");
            asm volatile("s_waitcnt vmcnt(0)" ::: "memory");
            const unsigned og = xb_add(&bar[XB_TOP], 1u);
            const unsigned tg = og / nx;
            if (og + 1u == (tg + 1u) * nx) xb_add(&bar[XB_TOPGEN], 1u);
            else XB_SPIN(xb_ld(&bar[XB_TOPGEN]) == tg, bar);
            __builtin_amdgcn_fence(__ATOMIC_ACQUIRE, "agent");
            xb_add(&bar[XB_XGEN(x)], 1u);
            asm volatile("s_waitcnt vmcnt(0)" ::: "memory");
        } else {
            XB_SPIN(xb_ld(&bar[XB_XGEN(x)]) == gen, bar);
            __builtin_amdgcn_fence(__ATOMIC_ACQUIRE, "agent");
            asm volatile("s_waitcnt vmcnt(0)" ::: "memory");
        }
    }
    __syncthreads();
}

constexpr int RING_BYTES = 131072, EX_OFF = RING_BYTES, MISC_OFF = EX_OFF + 4096, LDS_BYTES = 147456;
constexpr int NWAVES = 8;

struct Args {
    const float* in[18]; float* out; unsigned char* ws; int ph_lo, ph_hi; int use_bar, pad;
};

__device__ __forceinline__ void p0_transpose_item(const float* W, int K, int N, bf16_t* WT, int rowblk, int roff, LAS float* scr, int item, int lane) {
    const int nblk = N / 32, kb = item / nblk, nb = item % nblk, k0 = 64 * kb, n0 = 32 * nb;
#pragma unroll 8
    for (int i = 0; i < 32; ++i) { const int kk = 2 * i + (lane >> 5); scr[kk * 33 + (lane & 31)] = W[(size_t)(k0 + kk) * N + n0 + (lane & 31)]; }
    asm volatile("s_waitcnt lgkmcnt(0)" ::: "memory");
    const int c = lane & 7;
#pragma unroll
    for (int j = 0; j < 4; ++j) { const int nl = (lane >> 3) + 8 * j; const LAS float* s = scr + (8 * c) * 33 + nl; const int n = n0 + nl;
        u32x4 o; o.x = pk2(s[0 * 33], s[1 * 33]); o.y = pk2(s[2 * 33], s[3 * 33]); o.z = pk2(s[4 * 33], s[5 * 33]); o.w = pk2(s[6 * 33], s[7 * 33]);
        const int dr = (n >> 7) * rowblk + roff + (n & 127);
        *(u32x4*)(WT + (size_t)dr * K + k0 + 8 * c) = o; }
    asm volatile("s_waitcnt lgkmcnt(0)" ::: "memory");
}

__global__ void __launch_bounds__(NWAVES * 64, 2) mk_fwd(Args args) {
    extern __shared__ __attribute__((aligned(16))) unsigned char lds_raw[];
    LAS unsigned char* lds = (LAS unsigned char*)lds_raw;
    const int wave = __builtin_amdgcn_readfirstlane(threadIdx.x >> 6);
#define PHASE_IDS() const int lane = lane_id(), tid = wave * 64 + lane; (void)tid; const int gw = vcu * NWAVES + wave, NGW = G * NWAVES; (void)lane; (void)gw; (void)NGW
    const int G = gridDim.x, bx = blockIdx.x; const int vcu = (G % 8 == 0) ? (bx % 8) * (G / 8) + bx / 8 : bx;
    unsigned char* ws = args.ws;
    unsigned* ctl = (unsigned*)(ws + WS_CTL);
    if (threadIdx.x < 64) ((volatile LAS unsigned*)(lds + MISC_OFF))[threadIdx.x] = 0u;
    __syncthreads();
    if (args.use_bar) xcd_barrier_post((unsigned*)(args.ws + WS_CTL) + CW_BAR, wave == 0 && lane_id() == 0);
    if (args.use_bar == 12345) cooperative_groups::this_grid().sync();
#define GRID_BAR() do { if (args.use_bar) xcd_barrier((unsigned*)(args.ws + WS_CTL) + CW_BAR, (volatile LAS unsigned*)(lds + MISC_OFF) + 8, (unsigned)G, wave == 0 && lane_id() == 0); } while (0)
    const int lo = args.ph_lo, hi = args.ph_hi;
#ifndef MK_CMASK
#define MK_CMASK 0x1ff
#endif
#define IN(k) ((((MK_CMASK) >> (k)) & 1) && lo <= (k) && (k) < hi)
#define BOTH(k) (IN(k) && IN((k) + 1))

    if (IN(0)) {
        PHASE_IDS();
        const float* x = args.in[0];
        bf16_t* XB = (bf16_t*)(ws + WS_XB); bf16_t* WINT = (bf16_t*)(ws + WS_WINT); bf16_t* WAT = (bf16_t*)(ws + WS_WAT); bf16_t* WBT = (bf16_t*)(ws + WS_WBT); bf16_t* WOT = (bf16_t*)(ws + WS_WOT);
        bf16_t* WGUT = (bf16_t*)(ws + WS_WGUT); bf16_t* WDT = (bf16_t*)(ws + WS_WDT);
        LAS float* scr = (LAS float*)(lds + wave * 16384);
        constexpr int I_IN = (DM / 64) * (IN_COLS / 32), I_A = (1024 / 64) * (DM / 32), I_B = (DM / 64) * (DM / 32), I_O = I_B;
        constexpr int I_G = (DM / 64) * (FF / 32), I_D = (FF / 64) * (DM / 32);
        constexpr int NITEMS = I_IN + I_A + I_B + I_O + NEXP * (2 * I_G + I_D);
        for (int it = gw; it < NITEMS; it += NGW) {
            int r = it;
            if (r < I_IN) { p0_transpose_item(args.in[1], DM, IN_COLS, WINT, 128, 0, scr, r, lane); continue; } r -= I_IN;
            if (r < I_A) { p0_transpose_item(args.in[4], 1024, DM, WAT, 128, 0, scr, r, lane); continue; } r -= I_A;
            if (r < I_B) { p0_transpose_item(args.in[5], DM, DM, WBT, 128, 0, scr, r, lane); continue; } r -= I_B;
            if (r < I_O) { p0_transpose_item(args.in[6], DM, DM, WOT, 128, 0, scr, r, lane); continue; } r -= I_O;
            const int e = r / (2 * I_G + I_D); r -= e * (2 * I_G + I_D);
            if (r < I_G) { p0_transpose_item(args.in[13] + (size_t)e * DM * FF, DM, FF, WGUT + (size_t)e * 2048 * DM, 256, 0, scr, r, lane); continue; } r -= I_G;
            if (r < I_G) { p0_transpose_item(args.in[14] + (size_t)e * DM * FF, DM, FF, WGUT + (size_t)e * 2048 * DM, 256, 128, scr, r, lane); continue; } r -= I_G;
            p0_transpose_item(args.in[15] + (size_t)e * FF * DM, FF, DM, WDT + (size_t)e * DM * FF, 128, 0, scr, r, lane);
        }
        for (int m = gw; m < NTOK; m += NGW) {
            const f32x4* xr = (const f32x4*)(x + (size_t)m * DM) + lane; u32x2* o8 = (u32x2*)(XB + (size_t)m * DM) + lane;
#pragma unroll
            for (int j = 0; j < 8; ++j) { const f32x4 v = xr[64 * j]; u32x2 w; w.x = pk2(v.x, v.y); w.y = pk2(v.z, v.w); o8[64 * j] = w; }
        }
        { float2* rt1 = (float2*)(ws + WS_RT1); float2* rt2 = (float2*)(ws + WS_RT2);
          for (int i = (vcu * NWAVES * 64) + tid; i < SEQ * 64; i += G * NWAVES * 64) { const int t = i >> 6, c = i & 63; float cs, sn;
              rope1(t, c, cs, sn); rt1[i] = make_float2(cs, sn); rope2(t, c, cs, sn); rt2[i] = make_float2(cs, sn); } }
        if (BOTH(0)) GRID_BAR();
    }

    if (IN(1)) {
        EpiProj E; E.ws = ws; E.qg = args.in[2]; E.kg = args.in[3];
        ProjSched S; S.o.init(NTOK, IN_COLS, G, bx); S.ws = (const char*)ws;
        pg8::gemm_phase<EpiProj, ProjSched, PG8_ALIGN, PG8_SP2>(lds, lds + EX_OFF, S, E, wave);
        if (BOTH(1)) GRID_BAR();
    }

    if (IN(2)) {
        for (int i = 0; i < 2; ++i) {
            const int idx = bx + i * G; if (idx >= 512) break;
            const int bk = idx & 7, rest = idx >> 3, b = bk >> 2, kvh = bk & 3, hq = kvh * 4 + (rest & 3), qblk = rest >> 2;
            att::Unit u; u.Q = (const bf16_t*)(ws + WS_QB) + ((size_t)(b * 16 + hq) * SEQ + qblk * 256) * HD;
            u.K = (const bf16_t*)(ws + WS_KB) + (size_t)(b * 4 + kvh) * SEQ * HD; u.V = (const bf16_t*)(ws + WS_VB) + (size_t)(b * 4 + kvh) * SEQ * HD;
            u.O = (bf16_t*)(ws + WS_OB) + ((size_t)b * SEQ + qblk * 256) * 2048 + hq * HD; u.ldo = 2048; u.lse = nullptr; u.lse_stride = 0; u.nt = 64; u.kt0 = 0; u.klo = 0; u.khi = SEQ; u.q0 = 0;
            att::body(u, lds, wave);
        }
        for (int i = 0; i < 3; ++i) {
            const int idx = bx + i * G; if (idx >= 768) break;
            const int sid = idx >> 4, qblk = idx & 15, g = sid >> 4, b = (sid >> 3) & 1, h = sid & 7, sh = 2 * g, L = SEQ >> sh;
            const int P0 = qblk * 256, r = P0 / L, p0 = P0 - r * L;
            att::Unit u; u.Q = (const bf16_t*)(ws + WS_QA) + ((size_t)sid * SEQ + P0) * HD; u.K = (const bf16_t*)(ws + WS_KA) + (size_t)sid * SEQ * HD; u.V = (const bf16_t*)(ws + WS_VA) + (size_t)sid * SEQ * HD;
            const size_t tok0 = (size_t)b * SEQ + ((size_t)p0 << sh) + r;
            u.O = (bf16_t*)(ws + WS_OAG) + ((size_t)g * NTOK + tok0) * 1024 + h * HD; u.ldo = 1024 << sh;
            u.lse = (float*)(ws + WS_LSE) + ((size_t)g * NTOK + tok0) * 8 + h; u.lse_stride = 8 << sh;
            u.nt = 6; u.kt0 = P0 - 64; u.klo = r * L; u.khi = r * L + L; u.q0 = P0;
            att::band_body(u, lds, wave);
        }
        GRID_BAR();
        {
            PHASE_IDS();
            const bf16_t* oag = (const bf16_t*)(ws + WS_OAG); const float* lse = (const float*)(ws + WS_LSE); bf16_t* oa = (bf16_t*)(ws + WS_OA);
            for (int m = gw; m < NTOK; m += NGW) { const int c = lane * 16, h = lane >> 3;
                const float l0 = lse[(0 * (size_t)NTOK + m) * 8 + h], l1 = lse[(1 * (size_t)NTOK + m) * 8 + h], l2 = lse[(2 * (size_t)NTOK + m) * 8 + h];
                const float mx = fmaxf(l0, fmaxf(l1, l2)); float e0 = __expf(l0 - mx), e1 = __expf(l1 - mx), e2 = __expf(l2 - mx); const float inv = 1.0f / (e0 + e1 + e2); e0 *= inv; e1 *= inv; e2 *= inv;
#pragma unroll
                for (int q = 0; q < 2; ++q) { const u32x4 a = *(const u32x4*)(oag + (0 * (size_t)NTOK + m) * 1024 + c + 8 * q), bq = *(const u32x4*)(oag + (1 * (size_t)NTOK + m) * 1024 + c + 8 * q), cq = *(const u32x4*)(oag + (2 * (size_t)NTOK + m) * 1024 + c + 8 * q);
                    u32x4 w;
#pragma unroll
                    for (int k = 0; k < 4; ++k) w[k] = cvtpk(e0 * bflo(a[k]) + e1 * bflo(bq[k]) + e2 * bflo(cq[k]), e0 * bfhi(a[k]) + e1 * bfhi(bq[k]) + e2 * bfhi(cq[k]));
                    *(u32x4*)(oa + (size_t)m * 1024 + c + 8 * q) = w; } }
        }
        if (BOTH(2)) GRID_BAR();
    }

    if (IN(3) || IN(4)) {
        EpiMix E; E.ws = ws; E.x = args.in[0];
        MixSched S; S.c = vcu; S.ws = (const char*)ws;
        if (IN(3)) { S.mode = 0; pg8::gemm_phase<EpiMix, MixSched, false, PG8_SP2>(lds, lds + EX_OFF, S, E, wave); if (BOTH(3)) GRID_BAR(); }
        if (IN(4)) { S.mode = 1; pg8::gemm_phase<EpiMix, MixSched, false, PG8_SP2>(lds, lds + EX_OFF, S, E, wave); if (BOTH(4)) GRID_BAR(); }
    }

    if (IN(5)) {
        PHASE_IDS();
        RouteArgs ra; ra.g = args.in[7]; ra.b = args.in[8]; ra.h1 = (float*)(ws + WS_H1); ra.h1b = (bf16_t*)(ws + WS_H1B); ra.wg = args.in[9]; ra.bg = args.in[10]; ra.wr = args.in[11]; ra.br = args.in[12];
        ra.cnt = ctl + CW_CNT; ra.tokidx = (int*)(ws + WS_TOKIDX); ra.slot = (int*)(ws + WS_SLOT);
        for (int m = gw; m < NTOK; m += NGW) ln1_route_row((const float*)(ws + WS_PRE1), ra, m, lane_id());
        if (BOTH(5)) GRID_BAR();
    }

    if (IN(6) || IN(7)) {
        MoeSched S; S.G = G; S.vcu = vcu; S.ws = (const char*)ws;
        S.init(ctl + CW_CNT, lane_id());
        EpiMoe E; E.ws = ws;
        if (IN(6)) { S.down = 0; E.down = 0; pg8::gemm_phase<EpiMoe, MoeSched, PG8_ALIGN, PG8_SP2>(lds, lds + EX_OFF, S, E, wave); if (BOTH(6)) GRID_BAR(); }
        if (IN(7)) { S.down = 1; E.down = 1; pg8::gemm_phase<EpiMoe, MoeSched, PG8_ALIGN, PG8_SP2>(lds, lds + EX_OFF, S, E, wave); if (BOTH(7)) GRID_BAR(); }
    }

    if (IN(8)) {
        PHASE_IDS();
        P8Args pa; pa.h1 = (const float*)(ws + WS_H1); pa.y = (const bf16_t*)(ws + WS_Y); pa.cnt = ctl + CW_CNT; pa.slot = (const int*)(ws + WS_SLOT); pa.g = args.in[16]; pa.b = args.in[17]; pa.out = args.out;
        unsigned c = 0; if (lane < NEXP) c = __hip_atomic_load(ctl + CW_CNT + lane, __ATOMIC_RELAXED, __HIP_MEMORY_SCOPE_AGENT);
        unsigned t = (c + 255u) >> 8, inc = t;
#pragma unroll
        for (int o = 1; o < 32; o <<= 1) { const unsigned v = __shfl_up(inc, o); if ((lane & 31) >= o) inc += v; }
        const unsigned tpe = inc - t;
        for (int m = gw; m < NTOK; m += NGW) {
            const int* sl = pa.slot + (size_t)m * 6; const int e1 = sl[0], e2 = sl[1], p1 = sl[2], p2 = sl[3]; const float w1 = ((const float*)sl)[4], w2 = ((const float*)sl)[5];
            const size_t r1 = (size_t)__shfl(tpe, e1) * 256 + p1, r2 = (size_t)__shfl(tpe, e2) * 256 + p2;
            final_row(pa, m, lane_id(), r1, r2, w1, w2);
        }
    }
#undef IN
#undef BOTH
#undef GRID_BAR
}

extern "C" void kernel_launch(void* const* d_in, const int* in_sizes, int n_in, void* d_out, int out_size, void* d_ws, size_t ws_size, hipStream_t stream) {
    static int grid = 0;
    if (grid == 0) {
        if (n_in != 18 || in_sizes[0] != NTOK * DM || out_size != NTOK * DM || ws_size < WS_END) { fprintf(stderr, "kernel_launch: unexpected shapes (n_in %d, in0 %d, out %d, ws %zu)\n", n_in, n_in > 0 ? in_sizes[0] : -1, out_size, ws_size); grid = -1; return; }
        int dev = 0, cus = 0, per_cu = 0;
        if (hipGetDevice(&dev) != hipSuccess || hipDeviceGetAttribute(&cus, hipDeviceAttributeMultiprocessorCount, dev) != hipSuccess) { fprintf(stderr, "kernel_launch: device query failed\n"); grid = -1; return; }
        if (hipFuncSetAttribute((const void*)mk_fwd, hipFuncAttributeMaxDynamicSharedMemorySize, LDS_BYTES) != hipSuccess) { fprintf(stderr, "kernel_launch: hipFuncSetAttribute failed\n"); grid = -1; return; }
        if (hipOccupancyMaxActiveBlocksPerMultiprocessor(&per_cu, (const void*)mk_fwd, NWAVES * 64, LDS_BYTES) != hipSuccess || per_cu < 1) { fprintf(stderr, "kernel_launch: occupancy query says %d blocks per CU\n", per_cu); per_cu = 1; }
        (void)hipGetLastError();
        grid = cus * 1;
        fprintf(stderr, "kernel_launch: grid %d (cus %d, occupancy %d)\n", grid, cus, per_cu);
    }
    if (grid < 0) return;
    unsigned char* ws = (unsigned char*)d_ws;
    (void)hipMemsetAsync(ws + WS_CTL, 0, 1 * MiB, stream);
    Args a{};
    for (int i = 0; i < 18; ++i) a.in[i] = (const float*)d_in[i];
    a.out = (float*)d_out; a.ws = ws;
    const float* x = a.in[0];
    bf16_t* XB = (bf16_t*)(ws + WS_XB); bf16_t* WINT = (bf16_t*)(ws + WS_WINT); bf16_t* WAT = (bf16_t*)(ws + WS_WAT); bf16_t* WBT = (bf16_t*)(ws + WS_WBT); bf16_t* WOT = (bf16_t*)(ws + WS_WOT);
    bf16_t* WGUT = (bf16_t*)(ws + WS_WGUT); bf16_t* WDT = (bf16_t*)(ws + WS_WDT);
    unsigned* ctl = (unsigned*)(ws + WS_CTL);
    auto launch_mk = [&](int lo, int hi, int use_bar) {
        a.ph_lo = lo; a.ph_hi = hi; a.use_bar = use_bar;
        void* kargs[] = {&a};
        hipError_t e = hipLaunchCooperativeKernel((const void*)mk_fwd, dim3(grid), dim3(NWAVES * 64), kargs, LDS_BYTES, stream);
        if (e != hipSuccess) fprintf(stderr, "kernel_launch: cooperative launch failed: %s (grid %d)\n", hipGetErrorString(e), grid);
    };
    if (MK_ONE_LAUNCH && MK_FAST_MASK == 0x1ff) { launch_mk(0, NPHASE, 1); return; }
    for (int ph = 0; ph < NPHASE; ++ph) {
        if ((MK_FAST_MASK >> ph) & 1) { launch_mk(ph, ph + 1, (ph == 2) ? 1 : 0); continue; }
        switch (ph) {
        case 0:
            hipLaunchKernelGGL(k_cvt, dim3(2048), dim3(256), 0, stream, x, XB, (size_t)NTOK * DM / 8);
            hipLaunchKernelGGL(k_transpose, dim3(IN_COLS / 32, DM / 32, 1), dim3(256), 0, stream, a.in[1], WINT, DM, IN_COLS, 128, 0, (size_t)0, (size_t)0);
            hipLaunchKernelGGL(k_transpose, dim3(DM / 32, 1024 / 32, 1), dim3(256), 0, stream, a.in[4], WAT, 1024, DM, 128, 0, (size_t)0, (size_t)0);
            hipLaunchKernelGGL(k_transpose, dim3(DM / 32, DM / 32, 1), dim3(256), 0, stream, a.in[5], WBT, DM, DM, 128, 0, (size_t)0, (size_t)0);
            hipLaunchKernelGGL(k_transpose, dim3(DM / 32, DM / 32, 1), dim3(256), 0, stream, a.in[6], WOT, DM, DM, 128, 0, (size_t)0, (size_t)0);
            hipLaunchKernelGGL(k_transpose, dim3(FF / 32, DM / 32, NEXP), dim3(256), 0, stream, a.in[13], WGUT, DM, FF, 256, 0, (size_t)DM * FF, (size_t)2048 * DM);
            hipLaunchKernelGGL(k_transpose, dim3(FF / 32, DM / 32, NEXP), dim3(256), 0, stream, a.in[14], WGUT, DM, FF, 256, 128, (size_t)DM * FF, (size_t)2048 * DM);
            hipLaunchKernelGGL(k_transpose, dim3(DM / 32, FF / 32, NEXP), dim3(256), 0, stream, a.in[15], WDT, FF, DM, 128, 0, (size_t)FF * DM, (size_t)DM * FF);
            hipLaunchKernelGGL(k_ropetab, dim3(SEQ * 64 / 256), dim3(256), 0, stream, (float2*)(ws + WS_RT1), (float2*)(ws + WS_RT2));
            break;
        case 1: { P1Args p1{}; p1.xb = XB; p1.wint = WINT; p1.qg = a.in[2]; p1.kg = a.in[3]; p1.qa = (bf16_t*)(ws + WS_QA); p1.ka = (bf16_t*)(ws + WS_KA); p1.va = (bf16_t*)(ws + WS_VA);
            p1.qb = (bf16_t*)(ws + WS_QB); p1.kb = (bf16_t*)(ws + WS_KB); p1.vb = (bf16_t*)(ws + WS_VB); p1.gates = (bf16_t*)(ws + WS_GATES);
            hipLaunchKernelGGL(k_proj, dim3(IN_COLS / 128, NTOK / 64), dim3(256), 0, stream, p1); } break;
        case 2: { P2Args p2b{}; p2b.q = (bf16_t*)(ws + WS_QB); p2b.k = (bf16_t*)(ws + WS_KB); p2b.v = (bf16_t*)(ws + WS_VB); p2b.o = (bf16_t*)(ws + WS_OB); p2b.lse = nullptr; p2b.mode = 0;
            hipLaunchKernelGGL(k_attn, dim3(SEQ / 64, 32), dim3(128), 0, stream, p2b);
            P2Args p2a{}; p2a.q = (bf16_t*)(ws + WS_QA); p2a.k = (bf16_t*)(ws + WS_KA); p2a.v = (bf16_t*)(ws + WS_VA); p2a.o = (bf16_t*)(ws + WS_OAG); p2a.lse = (float*)(ws + WS_LSE); p2a.mode = 1;
            hipLaunchKernelGGL(k_attn, dim3(SEQ / 64, 48), dim3(128), 0, stream, p2a);
            hipLaunchKernelGGL(k_merge, dim3(NTOK * 1024 / 256), dim3(256), 0, stream, (const bf16_t*)(ws + WS_OAG), (const float*)(ws + WS_LSE), (bf16_t*)(ws + WS_OA)); } break;
        case 3: case 4: { P3Args p3{}; p3.gates = (bf16_t*)(ws + WS_GATES); p3.T = (float*)(ws + WS_T); p3.merged = (bf16_t*)(ws + WS_MERGED); p3.x = x; p3.pre1 = (float*)(ws + WS_PRE1);
            if (ph == 3) { p3.A = (bf16_t*)(ws + WS_OA); p3.Bt = WAT; p3.K = 1024; p3.mode = 0;
                hipLaunchKernelGGL(k_gemm3, dim3(DM / 128, NTOK / 64), dim3(256), 0, stream, p3);
                p3.A = (bf16_t*)(ws + WS_OB); p3.Bt = WBT; p3.K = 2048; p3.mode = 1;
                hipLaunchKernelGGL(k_gemm3, dim3(DM / 128, NTOK / 64), dim3(256), 0, stream, p3); }
            else { p3.A = p3.merged; p3.Bt = WOT; p3.K = 2048; p3.mode = 2; hipLaunchKernelGGL(k_gemm3, dim3(DM / 128, NTOK / 64), dim3(256), 0, stream, p3); } } break;
        case 5: { RouteArgs ra{}; ra.g = a.in[7]; ra.b = a.in[8]; ra.h1 = (float*)(ws + WS_H1); ra.h1b = (bf16_t*)(ws + WS_H1B); ra.wg = a.in[9]; ra.bg = a.in[10]; ra.wr = a.in[11]; ra.br = a.in[12];
            ra.cnt = ctl + CW_CNT; ra.tokidx = (int*)(ws + WS_TOKIDX); ra.slot = (int*)(ws + WS_SLOT);
            hipLaunchKernelGGL(k_ln1_route, dim3(NTOK / 4), dim3(256), 0, stream, (const float*)(ws + WS_PRE1), ra); } break;
        case 6: case 7: { P6Args p6{}; p6.h1b = (bf16_t*)(ws + WS_H1B); p6.wgut = WGUT; p6.wdt = WDT; p6.cnt = ctl + CW_CNT; p6.tokidx = (int*)(ws + WS_TOKIDX); p6.act = (bf16_t*)(ws + WS_ACT); p6.y = (bf16_t*)(ws + WS_Y);
            if (ph == 6) hipLaunchKernelGGL(k_moe_up, dim3(FF / 128, 24576 / 64), dim3(256), 0, stream, p6);
            else hipLaunchKernelGGL(k_moe_down, dim3(DM / 128, 24576 / 64), dim3(256), 0, stream, p6); } break;
        case 8: { P8Args p8{}; p8.h1 = (float*)(ws + WS_H1); p8.y = (bf16_t*)(ws + WS_Y); p8.cnt = ctl + CW_CNT; p8.slot = (int*)(ws + WS_SLOT); p8.g = a.in[16]; p8.b = a.in[17]; p8.out = (float*)d_out;
            hipLaunchKernelGGL(k_final, dim3(NTOK / 4), dim3(256), 0, stream, p8); } break;
        }
    }
}
```

```cpp
#include <hip/hip_runtime.h>
#include <hip/hip_cooperative_groups.h>
#include <cstdio>
#include <cstdint>

typedef unsigned short bf16_t;
typedef short bf16x8 __attribute__((ext_vector_type(8)));
typedef short s16x4 __attribute__((ext_vector_type(4)));
typedef float f32x4 __attribute__((ext_vector_type(4)));
typedef float f32x16 __attribute__((ext_vector_type(16)));
typedef unsigned u32x4 __attribute__((ext_vector_type(4)));
typedef unsigned u32x2 __attribute__((ext_vector_type(2)));
#define LAS __attribute__((address_space(3)))

#ifndef MK_FAST_MASK
#define MK_FAST_MASK 0x1ff
#endif
#ifndef MK_ONE_LAUNCH
#define MK_ONE_LAUNCH 1
#endif
#ifndef MK_EXTRA_PHASE
#define MK_EXTRA_PHASE -1
#endif
#ifndef MK_EXTRA_VAR
#define MK_EXTRA_VAR 0
#endif
#ifndef PG8_SP2
#define PG8_SP2 true
#endif
#ifndef PG8_ALIGN
#define PG8_ALIGN true
#endif

constexpr int NTOK = 8192, SEQ = 4096, DM = 2048, HD = 128;
constexpr int IN_COLS = 16384;
constexpr int NEXP = 32, FF = 1024;
constexpr float ALPHA = 1.189207115002721f;
constexpr float LN_EPS = 1e-5f, RMS_EPS = 1e-6f;
constexpr float SM_SCALE = 0.08838834764831845f;
constexpr int ECAP = 8192;
constexpr int NPHASE = 9;

constexpr size_t MiB = 1u << 20;
constexpr size_t WS_CTL = 0;
constexpr size_t WS_WGUT = 1 * MiB;
constexpr size_t WS_WDT = 257 * MiB;
constexpr size_t WS_WAT = 385 * MiB;
constexpr size_t WS_WBT = 389 * MiB;
constexpr size_t WS_WOT = 397 * MiB;
constexpr size_t WS_XB = 405 * MiB;
constexpr size_t WS_WINT = 437 * MiB;
constexpr size_t WS_QA = 501 * MiB;
constexpr size_t WS_KA = 549 * MiB;
constexpr size_t WS_VA = 597 * MiB;
constexpr size_t WS_QB = 645 * MiB;
constexpr size_t WS_KB = 677 * MiB;
constexpr size_t WS_VB = 685 * MiB;
constexpr size_t WS_GATES = 693 * MiB;
constexpr size_t WS_OAG = 757 * MiB;
constexpr size_t WS_LSE = 805 * MiB;
constexpr size_t WS_OA = 806 * MiB;
constexpr size_t WS_OB = 822 * MiB;
constexpr size_t WS_T = 405 * MiB;
constexpr size_t WS_MERGED = 469 * MiB;
constexpr size_t WS_PRE1 = 501 * MiB;
constexpr size_t WS_H1 = 565 * MiB;
constexpr size_t WS_H1B = 629 * MiB;
constexpr size_t WS_TOKIDX = 661 * MiB;
constexpr size_t WS_SLOT = 662 * MiB;
constexpr size_t WS_ACT = 693 * MiB;
constexpr size_t WS_Y = 757 * MiB;
constexpr size_t WS_RT1 = 854 * MiB;
constexpr size_t WS_RT2 = 856 * MiB;
constexpr size_t WS_WRT = 858 * MiB;
constexpr size_t WS_END = 859 * MiB;
constexpr int CW_CNT = 64;
constexpr int CW_BAR = 4096;

__device__ __forceinline__ float bf2f(bf16_t v) { return __uint_as_float(((unsigned)v) << 16); }
__device__ __forceinline__ bf16_t f2bf(float f) { unsigned u = __float_as_uint(f); u += 0x7fffu + ((u >> 16) & 1u); return (bf16_t)(u >> 16); }
__device__ __forceinline__ unsigned pk2(float lo, float hi) { return (unsigned)f2bf(lo) | ((unsigned)f2bf(hi) << 16); }
__device__ __forceinline__ unsigned cvtpk(float lo, float hi) { unsigned r; asm volatile("v_cvt_pk_bf16_f32 %0, %1, %2" : "=v"(r) : "v"(lo), "v"(hi)); return r; }
__device__ __forceinline__ float wave_sum(float v) {
#pragma unroll
    for (int o = 1; o < 64; o <<= 1) v += __shfl_xor(v, o);
    return v;
}
__device__ __forceinline__ int lane_id() { int l; asm volatile("v_mbcnt_lo_u32_b32 %0, -1, 0\n\tv_mbcnt_hi_u32_b32 %0, -1, %0" : "=v"(l)); return l; }
__device__ __forceinline__ float bflo(unsigned w) { return __uint_as_float(w << 16); }
__device__ __forceinline__ float bfhi(unsigned w) { return __uint_as_float(w & 0xffff0000u); }

__device__ const float INV64[64] = {
    1.000000000e+00f, 8.659643234e-01f, 7.498942093e-01f, 6.493816316e-01f, 5.623413252e-01f, 4.869675252e-01f, 4.216965034e-01f, 3.651741273e-01f,
    3.162277660e-01f, 2.738419634e-01f, 2.371373706e-01f, 2.053525026e-01f, 1.778279410e-01f, 1.539926526e-01f, 1.333521432e-01f, 1.154781985e-01f,
    1.000000000e-01f, 8.659643234e-02f, 7.498942093e-02f, 6.493816316e-02f, 5.623413252e-02f, 4.869675252e-02f, 4.216965034e-02f, 3.651741273e-02f,
    3.162277660e-02f, 2.738419634e-02f, 2.371373706e-02f, 2.053525026e-02f, 1.778279410e-02f, 1.539926526e-02f, 1.333521432e-02f, 1.154781985e-02f,
    1.000000000e-02f, 8.659643234e-03f, 7.498942093e-03f, 6.493816316e-03f, 5.623413252e-03f, 4.869675252e-03f, 4.216965034e-03f, 3.651741273e-03f,
    3.162277660e-03f, 2.738419634e-03f, 2.371373706e-03f, 2.053525026e-03f, 1.778279410e-03f, 1.539926526e-03f, 1.333521432e-03f, 1.154781985e-03f,
    1.000000000e-03f, 8.659643234e-04f, 7.498942093e-04f, 6.493816316e-04f, 5.623413252e-04f, 4.869675252e-04f, 4.216965034e-04f, 3.651741273e-04f,
    3.162277660e-04f, 2.738419634e-04f, 2.371373706e-04f, 2.053525026e-04f, 1.778279410e-04f, 1.539926526e-04f, 1.333521432e-04f, 1.154781985e-04f};

__device__ __forceinline__ void cs_angle(float ang, float& c, float& s) {
    const double a = (double)ang * 0.15915494309189535;
    const float f = (float)(a - floor(a));
    s = __builtin_amdgcn_sinf(f); c = __builtin_amdgcn_cosf(f);
}
__device__ __forceinline__ void rope1(int t, int i, float& c, float& s) { cs_angle((float)t * INV64[i], c, s); }
__device__ __forceinline__ void rope2(int t, int i, float& c, float& s) {
    const float p = (i < 32) ? (float)(t >> 6) : (float)(t & 63);
    cs_angle(p * INV64[2 * (i & 31)], c, s);
}
__device__ __forceinline__ int perm_pos(int g, int t) { const int sh = 2 * g; const int d = 1 << sh; return (t & (d - 1)) * (SEQ >> sh) + (t >> sh); }

__global__ void __launch_bounds__(256) k_cvt(const float* __restrict__ x, bf16_t* __restrict__ xb, size_t n8) {
    for (size_t i = (size_t)blockIdx.x * 256 + threadIdx.x; i < n8; i += (size_t)gridDim.x * 256) {
        const f32x4 a = *(const f32x4*)(x + i * 8), b = *(const f32x4*)(x + i * 8 + 4);
        u32x4 w; w.x = pk2(a.x, a.y); w.y = pk2(a.z, a.w); w.z = pk2(b.x, b.y); w.w = pk2(b.z, b.w);
        *(u32x4*)(xb + i * 8) = w;
    }
}
__global__ void __launch_bounds__(256) k_transpose(const float* __restrict__ src, bf16_t* __restrict__ dst, int K, int N, int rowblk, int roff, size_t sstride, size_t dstride) {
    __shared__ float tile[32][33];
    const float* s = src + (size_t)blockIdx.z * sstride; bf16_t* d = dst + (size_t)blockIdx.z * dstride;
    const int n0 = blockIdx.x * 32, k0 = blockIdx.y * 32, tx = threadIdx.x & 31, ty = threadIdx.x >> 5;
    for (int i = ty; i < 32; i += 8) tile[i][tx] = s[(size_t)(k0 + i) * N + n0 + tx];
    __syncthreads();
    for (int i = ty; i < 32; i += 8) { const int n = n0 + i; const int dr = (n >> 7) * rowblk + roff + (n & 127); d[(size_t)dr * K + k0 + tx] = f2bf(tile[tx][i]); }
}
__global__ void __launch_bounds__(256) k_ropetab(float2* rt1, float2* rt2) {
    const int i = blockIdx.x * 256 + threadIdx.x; const int t = i >> 6, c = i & 63; float cs, sn;
    rope1(t, c, cs, sn); rt1[i] = make_float2(cs, sn); rope2(t, c, cs, sn); rt2[i] = make_float2(cs, sn);
}
__device__ __forceinline__ void wave_gemm16x128(const bf16_t* arow, const bf16_t* bt, int ldb, int K, f32x4 (&acc)[8]) {
    const int lane = threadIdx.x & 63, fr = lane & 15, fq = lane >> 4;
    const bf16_t* ap = arow + fq * 8;
    const bf16_t* bp = bt + (size_t)fr * ldb + fq * 8;
    for (int k = 0; k < K; k += 32) {
        const bf16x8 a = *(const bf16x8*)(ap + k);
#pragma unroll
        for (int j = 0; j < 8; ++j) { const bf16x8 b = *(const bf16x8*)(bp + (size_t)j * 16 * ldb + k); acc[j] = __builtin_amdgcn_mfma_f32_16x16x32_bf16(a, b, acc[j], 0, 0, 0); }
    }
}
struct P1Args { const bf16_t* xb; const bf16_t* wint; const float* qg; const float* kg; bf16_t *qa, *ka, *va, *qb, *kb, *vb, *gates; };
__global__ void __launch_bounds__(256) k_proj(P1Args a) {
    const int wave = threadIdx.x >> 6, lane = threadIdx.x & 63, fr = lane & 15, fq = lane >> 4;
    const int ng = blockIdx.x, mt = blockIdx.y * 4 + wave;
    f32x4 acc[8];
#pragma unroll
    for (int j = 0; j < 8; ++j) acc[j] = (f32x4){0.f, 0.f, 0.f, 0.f};
    wave_gemm16x128(a.xb + (size_t)(mt * 16 + fr) * DM, a.wint + (size_t)ng * 128 * DM, DM, DM, acc);
#pragma unroll
    for (int r = 0; r < 4; ++r) {
        const int m = mt * 16 + fq * 4 + r, b = m >> 12, t = m & 4095;
        if (ng < 72) {
            const int which = ng / 24, hh = ng % 24, g = hh >> 3, h = hh & 7;
            bf16_t* base = (which == 0 ? a.qa : (which == 1 ? a.ka : a.va)) + ((size_t)((g * 2 + b) * 8 + h) * SEQ + perm_pos(g, t)) * HD;
#pragma unroll
            for (int j = 0; j < 4; ++j) { const int c = 16 * j + fr; float x1 = acc[j][r], x2 = acc[j + 4][r];
                if (which < 2) { float cs, sn; rope1(t, c, cs, sn); const float y1 = x1 * cs - x2 * sn, y2 = x2 * cs + x1 * sn; x1 = y1; x2 = y2; }
                base[c] = f2bf(x1); base[c + 64] = f2bf(x2); }
        } else if (ng < 96) {
            const int k = ng - 72;
            if (k < 20) {
                float ss = 0.f;
#pragma unroll
                for (int j = 0; j < 8; ++j) ss += acc[j][r] * acc[j][r];
                ss += __shfl_xor(ss, 1); ss += __shfl_xor(ss, 2); ss += __shfl_xor(ss, 4); ss += __shfl_xor(ss, 8);
                const float rinv = 1.0f / sqrtf(ss * (1.0f / 128.0f) + RMS_EPS);
                const float* gn = (k < 16) ? a.qg : a.kg;
                bf16_t* base = (k < 16) ? a.qb + ((size_t)(b * 16 + k) * SEQ + t) * HD : a.kb + ((size_t)(b * 4 + (k - 16)) * SEQ + t) * HD;
#pragma unroll
                for (int j = 0; j < 4; ++j) { const int c = 16 * j + fr; const float x1 = acc[j][r] * rinv * gn[c], x2 = acc[j + 4][r] * rinv * gn[c + 64];
                    float cs, sn; rope2(t, c, cs, sn); base[c] = f2bf(x1 * cs - x2 * sn); base[c + 64] = f2bf(x2 * cs + x1 * sn); }
            } else {
                bf16_t* base = a.vb + ((size_t)(b * 4 + (k - 20)) * SEQ + t) * HD;
#pragma unroll
                for (int j = 0; j < 8; ++j) base[16 * j + fr] = f2bf(acc[j][r]);
            }
        } else {
            bf16_t* base = a.gates + (size_t)m * 4096 + (ng - 96) * 128;
#pragma unroll
            for (int j = 0; j < 8; ++j) base[16 * j + fr] = f2bf(1.0f / (1.0f + __expf(-acc[j][r])));
        }
    }
}
struct P2Args { const bf16_t *q, *k, *v; bf16_t* o; float* lse; int mode; };
__global__ void __launch_bounds__(128) k_attn(P2Args a) {
    const int half = threadIdx.x & 1, qi = blockIdx.x * 64 + (threadIdx.x >> 1), sid = blockIdx.y;
    const bf16_t *Q, *K, *V; int k_lo, k_hi;
    if (a.mode == 0) { const int b = sid >> 4, hq = sid & 15; Q = a.q + (size_t)sid * SEQ * HD; K = a.k + (size_t)(b * 4 + (hq >> 2)) * SEQ * HD; V = a.v + (size_t)(b * 4 + (hq >> 2)) * SEQ * HD; k_lo = 0; k_hi = SEQ - 1; }
    else { const int g = sid >> 4; const int L = SEQ >> (2 * g); Q = a.q + (size_t)sid * SEQ * HD; K = a.k + (size_t)sid * SEQ * HD; V = a.v + (size_t)sid * SEQ * HD;
        const int r0 = (qi / L) * L, p = qi - r0; k_lo = r0 + (p - 64 > 0 ? p - 64 : 0); k_hi = r0 + (p + 64 < L - 1 ? p + 64 : L - 1); }
    float q[64], o[64];
    { const bf16_t* qp = Q + (size_t)qi * HD + half * 64;
#pragma unroll
      for (int d = 0; d < 64; ++d) { q[d] = bf2f(qp[d]) * SM_SCALE; o[d] = 0.f; } }
    float m = -1e30f, l = 0.f;
    for (int kk = k_lo; kk <= k_hi; ++kk) {
        const bf16_t* kp = K + (size_t)kk * HD + half * 64; const bf16_t* vp = V + (size_t)kk * HD + half * 64;
        float s = 0.f;
#pragma unroll
        for (int d = 0; d < 64; ++d) s += q[d] * bf2f(kp[d]);
        s += __shfl_xor(s, 1);
        const float mn = fmaxf(m, s), al = __expf(m - mn), p = __expf(s - mn);
        l = l * al + p; m = mn;
#pragma unroll
        for (int d = 0; d < 64; ++d) o[d] = o[d] * al + p * bf2f(vp[d]);
    }
    const float rl = 1.0f / l;
    if (a.mode == 0) { const int b = sid >> 4, hq = sid & 15; bf16_t* op = a.o + (size_t)(b * SEQ + qi) * 2048 + hq * HD + half * 64;
#pragma unroll
        for (int d = 0; d < 64; ++d) op[d] = f2bf(o[d] * rl); }
    else { const int g = sid >> 4, b = (sid >> 3) & 1, h = sid & 7; const int sh = 2 * g, L = SEQ >> sh; const int r = qi / L, p = qi - r * L, t = (p << sh) + r;
        const size_t mrow = (size_t)b * SEQ + t;
        bf16_t* op = a.o + ((size_t)g * NTOK + mrow) * 1024 + h * HD + half * 64;
#pragma unroll
        for (int d = 0; d < 64; ++d) op[d] = f2bf(o[d] * rl);
        if (half == 0) a.lse[((size_t)g * NTOK + mrow) * 8 + h] = m + __logf(l); }
}
__global__ void __launch_bounds__(256) k_merge(const bf16_t* __restrict__ oag, const float* __restrict__ lse, bf16_t* __restrict__ oa) {
    const size_t i = (size_t)blockIdx.x * 256 + threadIdx.x;
    const size_t m = i >> 10; const int c = (int)(i & 1023), h = c >> 7;
    const float l0 = lse[(0 * (size_t)NTOK + m) * 8 + h], l1 = lse[(1 * (size_t)NTOK + m) * 8 + h], l2 = lse[(2 * (size_t)NTOK + m) * 8 + h];
    const float mx = fmaxf(l0, fmaxf(l1, l2)); const float e0 = __expf(l0 - mx), e1 = __expf(l1 - mx), e2 = __expf(l2 - mx); const float inv = 1.0f / (e0 + e1 + e2);
    const float v = (e0 * bf2f(oag[(0 * (size_t)NTOK + m) * 1024 + c]) + e1 * bf2f(oag[(1 * (size_t)NTOK + m) * 1024 + c]) + e2 * bf2f(oag[(2 * (size_t)NTOK + m) * 1024 + c])) * inv;
    oa[i] = f2bf(v);
}
struct P3Args { const bf16_t* A; const bf16_t* Bt; int K; const bf16_t* gates; float* T; bf16_t* merged; const float* x; float* pre1; int mode; };
__global__ void __launch_bounds__(256) k_gemm3(P3Args a) {
    const int wave = threadIdx.x >> 6, lane = threadIdx.x & 63, fr = lane & 15, fq = lane >> 4;
    const int ng = blockIdx.x, mt = blockIdx.y * 4 + wave;
    f32x4 acc[8];
#pragma unroll
    for (int j = 0; j < 8; ++j) acc[j] = (f32x4){0.f, 0.f, 0.f, 0.f};
    wave_gemm16x128(a.A + (size_t)(mt * 16 + fr) * a.K, a.Bt + (size_t)ng * 128 * a.K, a.K, a.K, acc);
#pragma unroll
    for (int r = 0; r < 4; ++r) { const size_t m = (size_t)mt * 16 + fq * 4 + r;
#pragma unroll
        for (int j = 0; j < 8; ++j) { const int c = ng * 128 + 16 * j + fr; const size_t o = m * DM + c;
            if (a.mode == 0) a.T[o] = bf2f(a.gates[m * 4096 + c]) * acc[j][r];
            else if (a.mode == 1) a.merged[o] = f2bf(a.T[o] + bf2f(a.gates[m * 4096 + 2048 + c]) * acc[j][r]);
            else a.pre1[o] = ALPHA * a.x[o] + acc[j][r]; } }
}
struct RouteArgs { const float* g; const float* b; float* h1; bf16_t* h1b; const float* wg; const float* bg; const float* wr; const float* br; unsigned* cnt; int* tokidx; int* slot; const float* wt; };
__device__ __forceinline__ void ln1_route_row(const float* pre1, const RouteArgs& a, int m, int lane) {
    const f32x4* xr = (const f32x4*)(pre1 + (size_t)m * DM) + lane;
    f32x4 v[8]; float s = 0.f;
#pragma unroll
    for (int j = 0; j < 8; ++j) { v[j] = xr[64 * j]; s += (v[j].x + v[j].y) + (v[j].z + v[j].w); }
    const float mean = wave_sum(s) * (1.0f / DM); float s2 = 0.f;
#pragma unroll
    for (int j = 0; j < 8; ++j) { v[j] = v[j] - mean; s2 += (v[j].x * v[j].x + v[j].y * v[j].y) + (v[j].z * v[j].z + v[j].w * v[j].w); }
    const float rstd = 1.0f / sqrtf(wave_sum(s2) * (1.0f / DM) + LN_EPS);
    float gl[4] = {0.f, 0.f, 0.f, 0.f};
#pragma unroll
    for (int j = 0; j < 8; ++j) { const int c = 4 * lane + 256 * j; const f32x4 gg = *(const f32x4*)(a.g + c), bb = *(const f32x4*)(a.b + c);
        v[j] = v[j] * rstd * gg + bb;
        *(f32x4*)(a.h1 + (size_t)m * DM + c) = v[j];
        *(uint2*)(a.h1b + (size_t)m * DM + c) = make_uint2(pk2(v[j].x, v[j].y), pk2(v[j].z, v[j].w));
#pragma unroll
        for (int i = 0; i < 4; ++i) { const f32x4 w = *(const f32x4*)(a.wg + (size_t)(c + i) * 4); const float hv = v[j][i]; gl[0] += hv * w.x; gl[1] += hv * w.y; gl[2] += hv * w.z; gl[3] += hv * w.w; } }
#pragma unroll
    for (int i = 0; i < 4; ++i) gl[i] = wave_sum(gl[i]) + a.bg[i];
    int gi = 0; float gm = gl[0];
#pragma unroll
    for (int i = 1; i < 4; ++i) if (gl[i] > gm) { gm = gl[i]; gi = i; }
    float gs = 0.f;
#pragma unroll
    for (int i = 0; i < 4; ++i) gs += __expf(gl[i] - gm);
    const float ggate = 1.0f / gs;
    float el[8] = {0.f, 0.f, 0.f, 0.f, 0.f, 0.f, 0.f, 0.f};
#pragma unroll
    for (int j = 0; j < 8; ++j) { const int c = 4 * lane + 256 * j;
#pragma unroll
        for (int i = 0; i < 4; ++i) { const float* wp = a.wr + (size_t)(c + i) * 32 + gi * 8; const f32x4 w0 = *(const f32x4*)wp, w1 = *(const f32x4*)(wp + 4); const float hv = v[j][i];
            el[0] += hv * w0.x; el[1] += hv * w0.y; el[2] += hv * w0.z; el[3] += hv * w0.w; el[4] += hv * w1.x; el[5] += hv * w1.y; el[6] += hv * w1.z; el[7] += hv * w1.w; } }
#pragma unroll
    for (int i = 0; i < 8; ++i) el[i] = wave_sum(el[i]) + a.br[gi * 8 + i];
    int i1 = 0; float m1 = el[0];
#pragma unroll
    for (int i = 1; i < 8; ++i) if (el[i] > m1) { m1 = el[i]; i1 = i; }
    int i2 = -1; float m2 = -3.0e38f;
#pragma unroll
    for (int i = 0; i < 8; ++i) if (i != i1 && el[i] > m2) { m2 = el[i]; i2 = i; }
    const float e2 = __expf(m2 - m1); const float w1 = ggate / (1.0f + e2), w2 = ggate * e2 / (1.0f + e2);
    if (lane == 0) {
        const int ex1 = gi * 8 + i1, ex2 = gi * 8 + i2;
        const int p1 = (int)atomicAdd(a.cnt + ex1, 1u), p2 = (int)atomicAdd(a.cnt + ex2, 1u);
        a.tokidx[ex1 * ECAP + p1] = m; a.tokidx[ex2 * ECAP + p2] = m;
        int* sl = a.slot + (size_t)m * 6; sl[0] = ex1; sl[1] = ex2; sl[2] = p1; sl[3] = p2; ((float*)sl)[4] = w1; ((float*)sl)[5] = w2;
    }
}
template <int R, int VAR>
__device__ __forceinline__ void ln1_route_rows(const float* pre1, const RouteArgs& a, int m0, int ms, int lane, LAS unsigned* hist, LAS int* rinfo, int lr0, int lrs) {
    f32x4 v[R][8]; float s[R], s2[R];
#pragma unroll
    for (int i = 0; i < R; ++i) { const f32x4* xr = (const f32x4*)(pre1 + (size_t)(m0 + i * ms) * DM) + lane; s[i] = 0.f;
#pragma unroll
        for (int j = 0; j < 8; ++j) { v[i][j] = xr[64 * j]; s[i] += (v[i][j].x + v[i][j].y) + (v[i][j].z + v[i][j].w); } }
#pragma unroll
    for (int o = 1; o < 64; o <<= 1)
#pragma unroll
        for (int i = 0; i < R; ++i) s[i] += __shfl_xor(s[i], o);
#pragma unroll
    for (int i = 0; i < R; ++i) { const float mean = s[i] * (1.0f / DM); s2[i] = 0.f;
#pragma unroll
        for (int j = 0; j < 8; ++j) { v[i][j] = v[i][j] - mean; s2[i] += (v[i][j].x * v[i][j].x + v[i][j].y * v[i][j].y) + (v[i][j].z * v[i][j].z + v[i][j].w * v[i][j].w); } }
#pragma unroll
    for (int o = 1; o < 64; o <<= 1)
#pragma unroll
        for (int i = 0; i < R; ++i) s2[i] += __shfl_xor(s2[i], o);
#pragma unroll
    for (int j = 0; j < 8; ++j) { const int c = 4 * lane + 256 * j; const f32x4 gg = *(const f32x4*)(a.g + c), bb = *(const f32x4*)(a.b + c);
#pragma unroll
        for (int i = 0; i < R; ++i) { const float rstd = 1.0f / sqrtf(s2[i] * (1.0f / DM) + LN_EPS); const size_t o = (size_t)(m0 + i * ms) * DM + c;
            v[i][j] = v[i][j] * rstd * gg + bb;
            *(f32x4*)(a.h1 + o) = v[i][j];
            *(uint2*)(a.h1b + o) = make_uint2(pk2(v[i][j].x, v[i][j].y), pk2(v[i][j].z, v[i][j].w)); } }
    if constexpr (VAR == 51) return;
    float gl[R][4];
#pragma unroll
    for (int c = 0; c < 4; ++c) { const f32x4* wp = (const f32x4*)(a.wt + (size_t)c * DM) + lane;
#pragma unroll
        for (int i = 0; i < R; ++i) gl[i][c] = 0.f;
#pragma unroll
        for (int j = 0; j < 8; ++j) { const f32x4 w = wp[64 * j];
#pragma unroll
            for (int i = 0; i < R; ++i) gl[i][c] += (v[i][j].x * w.x + v[i][j].y * w.y) + (v[i][j].z * w.z + v[i][j].w * w.w); }
        if (c & 1) __builtin_amdgcn_sched_barrier(0); }
#pragma unroll
    for (int o = 1; o < 64; o <<= 1)
#pragma unroll
        for (int i = 0; i < R; ++i)
#pragma unroll
            for (int c = 0; c < 4; ++c) gl[i][c] += __shfl_xor(gl[i][c], o);
    int gi[R]; float ggate[R];
#pragma unroll
    for (int i = 0; i < R; ++i) { float g0 = gl[i][0] + a.bg[0], g1 = gl[i][1] + a.bg[1], g2 = gl[i][2] + a.bg[2], g3 = gl[i][3] + a.bg[3];
        int q = 0; float gm = g0; if (g1 > gm) { gm = g1; q = 1; } if (g2 > gm) { gm = g2; q = 2; } if (g3 > gm) { gm = g3; q = 3; }
        ggate[i] = 1.0f / (__expf(g0 - gm) + __expf(g1 - gm) + __expf(g2 - gm) + __expf(g3 - gm)); gi[i] = __builtin_amdgcn_readfirstlane(q); }
    float el[R][8];
#pragma unroll
    for (int c = 0; c < 8; ++c) {
#pragma unroll
        for (int i = 0; i < R; ++i) { const f32x4* wp = (const f32x4*)(a.wt + (size_t)(4 + gi[i] * 8 + c) * DM) + lane; float acc = 0.f;
#pragma unroll
            for (int j = 0; j < 8; ++j) { const f32x4 w = wp[64 * j]; acc += (v[i][j].x * w.x + v[i][j].y * w.y) + (v[i][j].z * w.z + v[i][j].w * w.w); }
            el[i][c] = acc; }
        __builtin_amdgcn_sched_barrier(0); }
#pragma unroll
    for (int o = 1; o < 64; o <<= 1)
#pragma unroll
        for (int i = 0; i < R; ++i)
#pragma unroll
            for (int c = 0; c < 8; ++c) el[i][c] += __shfl_xor(el[i][c], o);
#pragma unroll
    for (int i = 0; i < R; ++i) { const int m = m0 + i * ms;
        int i1 = 0; float m1 = el[i][0] + a.br[gi[i] * 8];
        float ev[8];
#pragma unroll
        for (int c = 0; c < 8; ++c) ev[c] = el[i][c] + a.br[gi[i] * 8 + c];
#pragma unroll
        for (int c = 1; c < 8; ++c) if (ev[c] > m1) { m1 = ev[c]; i1 = c; }
        int i2 = -1; float m2 = -3.0e38f;
#pragma unroll
        for (int c = 0; c < 8; ++c) if (c != i1 && ev[c] > m2) { m2 = ev[c]; i2 = c; }
        const float e2 = __expf(m2 - m1); const float w1 = ggate[i] / (1.0f + e2), w2 = ggate[i] * e2 / (1.0f + e2);
        if (lane == 0) {
            const int ex1 = gi[i] * 8 + i1, ex2 = gi[i] * 8 + i2;
            const int p1 = (int)__hip_atomic_fetch_add(hist + ex1, 1u, __ATOMIC_RELAXED, __HIP_MEMORY_SCOPE_WORKGROUP), p2 = (int)__hip_atomic_fetch_add(hist + ex2, 1u, __ATOMIC_RELAXED, __HIP_MEMORY_SCOPE_WORKGROUP);
            LAS int* ri = rinfo + (lr0 + i * lrs) * 8; ri[0] = ex1; ri[1] = ex2; ri[2] = p1; ri[3] = p2; ((LAS float*)ri)[4] = w1; ((LAS float*)ri)[5] = w2; ri[6] = m;
        } }
}
__global__ void __launch_bounds__(256) k_ln1_route(const float* pre1, RouteArgs a) { ln1_route_row(pre1, a, blockIdx.x * 4 + (threadIdx.x >> 6), threadIdx.x & 63); }

__device__ __forceinline__ int row_start(const unsigned* cnt, int e) { int s = 0; for (int i = 0; i < e; ++i) s += ((int)cnt[i] + 255) & ~255; return s; }
struct P6Args { const bf16_t* h1b; const bf16_t* wgut; const bf16_t* wdt; const unsigned* cnt; const int* tokidx; bf16_t* act; bf16_t* y; };
__global__ void __launch_bounds__(256) k_moe_up(P6Args a) {
    const int wave = threadIdx.x >> 6, lane = threadIdx.x & 63, fr = lane & 15, fq = lane >> 4;
    const int R0 = blockIdx.y * 64;
    int e = 0, rs = 0;
    for (; e < NEXP; ++e) { const int n = ((int)a.cnt[e] + 255) & ~255; if (R0 < rs + n) break; rs += n; }
    if (e == NEXP) return;
    const int pos = R0 - rs + wave * 16 + fr; const int tok = pos < (int)a.cnt[e] ? a.tokidx[e * ECAP + pos] : 0;
    const int jb = blockIdx.x;
    f32x4 ag[8], au[8];
#pragma unroll
    for (int j = 0; j < 8; ++j) { ag[j] = (f32x4){0.f, 0.f, 0.f, 0.f}; au[j] = (f32x4){0.f, 0.f, 0.f, 0.f}; }
    const bf16_t* wb = a.wgut + ((size_t)e * 2048 + jb * 256) * DM;
    wave_gemm16x128(a.h1b + (size_t)tok * DM, wb, DM, DM, ag);
    wave_gemm16x128(a.h1b + (size_t)tok * DM, wb + (size_t)128 * DM, DM, DM, au);
#pragma unroll
    for (int r = 0; r < 4; ++r) { const size_t row = (size_t)R0 + wave * 16 + fq * 4 + r;
#pragma unroll
        for (int j = 0; j < 8; ++j) { const float g = ag[j][r], u = au[j][r]; a.act[row * FF + jb * 128 + 16 * j + fr] = f2bf(g / (1.0f + __expf(-g)) * u); } }
}
__global__ void __launch_bounds__(256) k_moe_down(P6Args a) {
    const int wave = threadIdx.x >> 6, lane = threadIdx.x & 63, fr = lane & 15, fq = lane >> 4;
    const int R0 = blockIdx.y * 64;
    int e = 0, rs = 0;
    for (; e < NEXP; ++e) { const int n = ((int)a.cnt[e] + 255) & ~255; if (R0 < rs + n) break; rs += n; }
    if (e == NEXP) return;
    f32x4 acc[8];
#pragma unroll
    for (int j = 0; j < 8; ++j) acc[j] = (f32x4){0.f, 0.f, 0.f, 0.f};
    wave_gemm16x128(a.act + ((size_t)R0 + wave * 16 + fr) * FF, a.wdt + ((size_t)e * 2048 + blockIdx.x * 128) * FF, FF, FF, acc);
#pragma unroll
    for (int r = 0; r < 4; ++r) { const size_t row = (size_t)R0 + wave * 16 + fq * 4 + r;
#pragma unroll
        for (int j = 0; j < 8; ++j) a.y[row * DM + blockIdx.x * 128 + 16 * j + fr] = f2bf(acc[j][r]); }
}
struct P8Args { const float* h1; const bf16_t* y; const unsigned* cnt; const int* slot; const float* g; const float* b; float* out; };
__device__ __forceinline__ void final_row(const P8Args& a, int m, int lane, size_t r1, size_t r2, float w1, float w2) {
    f32x4 v[8]; float s = 0.f;
#pragma unroll
    for (int j = 0; j < 8; ++j) { const int c = 4 * lane + 256 * j; const f32x4 hv = *(const f32x4*)(a.h1 + (size_t)m * DM + c);
        const uint2 ya = *(const uint2*)(a.y + r1 * DM + c), yb = *(const uint2*)(a.y + r2 * DM + c);
        f32x4 f; f.x = w1 * bflo(ya.x) + w2 * bflo(yb.x); f.y = w1 * bfhi(ya.x) + w2 * bfhi(yb.x); f.z = w1 * bflo(ya.y) + w2 * bflo(yb.y); f.w = w1 * bfhi(ya.y) + w2 * bfhi(yb.y);
        v[j] = hv * ALPHA + f; s += (v[j].x + v[j].y) + (v[j].z + v[j].w); }
    const float mean = wave_sum(s) * (1.0f / DM); float s2 = 0.f;
#pragma unroll
    for (int j = 0; j < 8; ++j) { v[j] = v[j] - mean; s2 += (v[j].x * v[j].x + v[j].y * v[j].y) + (v[j].z * v[j].z + v[j].w * v[j].w); }
    const float rstd = 1.0f / sqrtf(wave_sum(s2) * (1.0f / DM) + LN_EPS);
#pragma unroll
    for (int j = 0; j < 8; ++j) { const int c = 4 * lane + 256 * j; const f32x4 gg = *(const f32x4*)(a.g + c), bb = *(const f32x4*)(a.b + c);
        *(f32x4*)(a.out + (size_t)m * DM + c) = v[j] * rstd * gg + bb; }
}
__global__ void __launch_bounds__(256) k_final(P8Args a) {
    const int lane = threadIdx.x & 63, m = blockIdx.x * 4 + (threadIdx.x >> 6);
    const int* sl = a.slot + (size_t)m * 6; const int e1 = sl[0], e2 = sl[1], p1 = sl[2], p2 = sl[3]; const float w1 = ((const float*)sl)[4], w2 = ((const float*)sl)[5];
    final_row(a, m, lane, (size_t)row_start(a.cnt, e1) + p1, (size_t)row_start(a.cnt, e2) + p2, w1, w2);
}

namespace pg8 {
constexpr int BM = 256, BK = 64, HALF = 128, HTB = HALF * BK * 2  , STAGE_BYTES = 8 * HTB;
__device__ __forceinline__ int lds_byte(int r, int c) { const int st = (r >> 4) * 2 + (c >> 5), rr = r & 15, cc = c & 31, ob = rr * 64 + cc * 2; return st * 1024 + (ob ^ (((ob >> 9) & 1) << 5)); }
__device__ __forceinline__ void stage_rc(int b, int& R, int& C) { const int st = b / 1024, sb = b % 1024, swz = sb ^ (((sb >> 9) & 1) << 5); R = (st >> 1) * 16 + swz / 64; C = (st & 1) * 32 + (swz % 64) / 2; }

struct Unit { const char* A; const char* B; unsigned lda, ldb; int nt; int pm, pn, aux; const int* gidx; int gcnt; };
struct Voff { unsigned a[2][2], b[2][2]; };
__device__ __forceinline__ int brow_perm8(int h, int R) { return 128 * h + (R & ~31) + 8 * ((R >> 2) & 3) + 4 * ((R >> 4) & 1) + (R & 3); }
__device__ __forceinline__ int brow_rope(int h, int R) { return 128 * (R >> 6) + 64 * h + 32 * ((R >> 5) & 1) + 8 * ((R >> 2) & 3) + 4 * ((R >> 4) & 1) + (R & 3); }

template <class Epi> __device__ __forceinline__ void make_voff(const Unit& u, Voff& v, int tid) {
#pragma unroll
    for (int i = 0; i < 2; ++i) { int R, C; stage_rc(tid * 16 + i * 8192, R, C);
#pragma unroll
        for (int h = 0; h < 2; ++h) {
            int ra = h * HALF + R;
            if (u.gidx) ra = (ra < u.gcnt) ? u.gidx[ra] : 0;
            v.a[h][i] = (unsigned)ra * u.lda + (unsigned)C * 2u;
            v.b[h][i] = (unsigned)Epi::brow(h, R) * u.ldb + (unsigned)C * 2u;
        } }
}

template <class Epi, class Sched, bool ALIGN_EPI, bool SP2>
__device__ __forceinline__ void gemm_phase(LAS unsigned char* lds, LAS unsigned char* ex, const Sched& S, const Epi& E, int wid) {
    const int lane = lane_id(), tid = wid * 64 + lane, wr = wid >> 2, wc = wid & 3, fr = lane & 15, fq = lane >> 4;
    const unsigned ldsw = (unsigned)wid * 1024u;
    const int aoff = lds_byte(wr * 64 + fr, fq * 8), boff = lds_byte(wc * 32 + fr, fq * 8);
#define PG8_SA(b, h) (((b) * 2 + (h)) * HTB)
#define PG8_SB(b, h) ((4 + (b) * 2 + (h)) * HTB)
#define PG8_STAGE(bufoff, gbase, voff) do { _Pragma("unroll") for (int _i = 0; _i < 2; ++_i) \
        __builtin_amdgcn_global_load_lds((const unsigned*)((const char*)(gbase) + (voff)[_i]), (LAS unsigned*)(lds + (bufoff) + ldsw + _i * 8192), 16, 0, 0); } while (0)
#define PG8_LDA(dst, b, h) do { _Pragma("unroll") for (int m = 0; m < 4; ++m) _Pragma("unroll") for (int k = 0; k < 2; ++k) dst[m][k] = *(const LAS bf16x8*)(lds + PG8_SA(b, h) + aoff + m * 2048 + k * 1024); } while (0)
#define PG8_LDB(dst, b, h) do { _Pragma("unroll") for (int n = 0; n < 2; ++n) _Pragma("unroll") for (int k = 0; k < 2; ++k) dst[n][k] = *(const LAS bf16x8*)(lds + PG8_SB(b, h) + boff + n * 2048 + k * 1024); } while (0)
#define PG8_MMA(ai, bj, At, Bt) do { __builtin_amdgcn_s_setprio(1); _Pragma("unroll") for (int m = 0; m < 4; ++m) _Pragma("unroll") for (int n = 0; n < 2; ++n) _Pragma("unroll") for (int k = 0; k < 2; ++k) \
        acc[ai][bj][m][n] = __builtin_amdgcn_mfma_f32_16x16x32_bf16(Bt[n][k], At[m][k], acc[ai][bj][m][n], 0, 0, 0); __builtin_amdgcn_s_setprio(0); } while (0)
#define PG8_WAIT_V(n) asm volatile("s_waitcnt vmcnt(" #n ")" ::: "memory")
#define PG8_WAIT_L(n) asm volatile("s_waitcnt lgkmcnt(" #n ")" ::: "memory")
#define PG8_BAR __builtin_amdgcn_s_barrier()
#define PG8_SCHED __builtin_amdgcn_sched_barrier(0)
    Unit cur, nxt; int ui = 0;
    if (!S.next(0, cur)) return;
    Voff vo, nvo;
    make_voff<Epi>(cur, vo, tid);
    f32x4 acc[2][2][4][2];
#pragma unroll
    for (int a = 0; a < 2; ++a)
#pragma unroll
        for (int b = 0; b < 2; ++b)
#pragma unroll
            for (int m = 0; m < 4; ++m)
#pragma unroll
                for (int n = 0; n < 2; ++n) acc[a][b][m][n] = (f32x4){0.f, 0.f, 0.f, 0.f};
    bf16x8 At[4][2], B0[2][2], B1[2][2];
    const char* cA = cur.A; const char* cB = cur.B;
    const size_t kstep = (size_t)(BK * 2);
    if constexpr (SP2) {
        PG8_STAGE(PG8_SB(0, 0), cB, vo.b[0]); PG8_STAGE(PG8_SB(0, 1), cB, vo.b[1]); PG8_STAGE(PG8_SA(0, 0), cA, vo.a[0]); PG8_STAGE(PG8_SA(0, 1), cA, vo.a[1]);
        if (wr == 1) PG8_BAR;
        PG8_WAIT_V(2); PG8_BAR;
        PG8_STAGE(PG8_SB(1, 0), cB + kstep, vo.b[0]); PG8_STAGE(PG8_SA(1, 0), cA + kstep, vo.a[0]); PG8_STAGE(PG8_SB(1, 1), cB + kstep, vo.b[1]);
        PG8_WAIT_V(6); PG8_BAR;
    } else {
        PG8_STAGE(PG8_SB(0, 0), cB, vo.b[0]); PG8_STAGE(PG8_SA(0, 0), cA, vo.a[0]); PG8_STAGE(PG8_SB(0, 1), cB, vo.b[1]); PG8_STAGE(PG8_SA(0, 1), cA, vo.a[1]);
        if (wr == 1) PG8_BAR;
        PG8_WAIT_V(4); PG8_BAR;
        PG8_STAGE(PG8_SB(1, 0), cB + kstep, vo.b[0]); PG8_STAGE(PG8_SA(1, 0), cA + kstep, vo.a[0]); PG8_STAGE(PG8_SB(1, 1), cB + kstep, vo.b[1]);
        PG8_WAIT_V(6); PG8_BAR;
    }
    for (;;) {
        const bool has_next = S.next(ui + 1, nxt);
        if (has_next) make_voff<Epi>(nxt, nvo, tid); else nvo = vo;
        const char* nA = has_next ? nxt.A : cA; const char* nB = has_next ? nxt.B : cB;
        const int nt = cur.nt;
        for (int t = 0; t < nt; t += 2) {
            const bool last = (t == nt - 2);
            const char* a1 = cA + (size_t)(t + 1) * kstep;
            const char* a2 = last ? nA : cA + (size_t)(t + 2) * kstep; const char* b2 = last ? nB : cB + (size_t)(t + 2) * kstep;
            const char* a3 = a2 + kstep; const char* b3 = b2 + kstep;
            Voff w;
#pragma unroll
            for (int h = 0; h < 2; ++h)
#pragma unroll
                for (int i = 0; i < 2; ++i) { w.a[h][i] = last ? nvo.a[h][i] : vo.a[h][i]; w.b[h][i] = last ? nvo.b[h][i] : vo.b[h][i]; }
            if constexpr (SP2) {
            PG8_LDB(B0, 0, 0); PG8_LDB(B1, 0, 1); PG8_SCHED; PG8_LDA(At, 0, 0); PG8_STAGE(PG8_SA(1, 1), a1, vo.a[1]);
            PG8_WAIT_V(8); PG8_WAIT_L(0); PG8_BAR; PG8_MMA(0, 0, At, B0); PG8_MMA(0, 1, At, B1); PG8_BAR; PG8_SCHED;
            PG8_LDA(At, 0, 1); PG8_STAGE(PG8_SB(0, 0), b2, w.b[0]); PG8_STAGE(PG8_SB(0, 1), b2, w.b[1]); PG8_STAGE(PG8_SA(0, 0), a2, w.a[0]);
            PG8_WAIT_V(8); PG8_WAIT_L(0); PG8_BAR; PG8_MMA(1, 0, At, B0); PG8_MMA(1, 1, At, B1); PG8_BAR; PG8_SCHED;
            PG8_LDB(B0, 1, 0); PG8_LDB(B1, 1, 1); PG8_SCHED; PG8_LDA(At, 1, 0); PG8_STAGE(PG8_SA(0, 1), a2, w.a[1]);
            PG8_WAIT_V(8); PG8_WAIT_L(0); PG8_BAR; PG8_MMA(0, 0, At, B0); PG8_MMA(0, 1, At, B1); PG8_BAR; PG8_SCHED;
            PG8_LDA(At, 1, 1); PG8_STAGE(PG8_SB(1, 0), b3, w.b[0]); PG8_STAGE(PG8_SB(1, 1), b3, w.b[1]); PG8_STAGE(PG8_SA(1, 0), a3, w.a[0]);
            PG8_WAIT_V(8); PG8_WAIT_L(0); PG8_BAR; PG8_MMA(1, 0, At, B0); PG8_MMA(1, 1, At, B1); PG8_BAR; PG8_SCHED;
            } else {
            PG8_LDB(B0, 0, 0); PG8_SCHED; PG8_LDA(At, 0, 0); PG8_STAGE(PG8_SA(1, 1), a1, vo.a[1]);
            PG8_WAIT_L(8); PG8_BAR; PG8_WAIT_L(0); PG8_MMA(0, 0, At, B0); PG8_BAR; PG8_SCHED;
            PG8_LDB(B1, 0, 1); PG8_STAGE(PG8_SB(0, 0), b2, w.b[0]);
            PG8_BAR; PG8_WAIT_L(0); PG8_MMA(0, 1, At, B1); PG8_BAR;
            PG8_LDA(At, 0, 1); PG8_STAGE(PG8_SA(0, 0), a2, w.a[0]);
            PG8_BAR; PG8_WAIT_L(0); PG8_MMA(1, 0, At, B0); PG8_BAR; PG8_SCHED;
            PG8_STAGE(PG8_SB(0, 1), b2, w.b[1]);
            PG8_WAIT_V(6); PG8_BAR; PG8_MMA(1, 1, At, B1); PG8_BAR;
            PG8_LDB(B0, 1, 0); PG8_SCHED; PG8_LDA(At, 1, 0); PG8_STAGE(PG8_SA(0, 1), a2, w.a[1]);
            PG8_WAIT_L(8); PG8_BAR; PG8_WAIT_L(0); PG8_MMA(0, 0, At, B0); PG8_BAR; PG8_SCHED;
            PG8_LDB(B1, 1, 1); PG8_STAGE(PG8_SB(1, 0), b3, w.b[0]);
            PG8_BAR; PG8_WAIT_L(0); PG8_MMA(0, 1, At, B1); PG8_BAR;
            PG8_LDA(At, 1, 1); PG8_STAGE(PG8_SA(1, 0), a3, w.a[0]);
            PG8_BAR; PG8_WAIT_L(0); PG8_MMA(1, 0, At, B0); PG8_BAR; PG8_SCHED;
            PG8_STAGE(PG8_SB(1, 1), b3, w.b[1]);
            PG8_WAIT_V(6); PG8_BAR; PG8_MMA(1, 1, At, B1); PG8_BAR;
            }
        }
        if constexpr (ALIGN_EPI) { if (wr == 0) PG8_BAR; }
        E(acc, cur, wr, wc, fr, fq, ex);
        if (!has_next) break;
#pragma unroll
        for (int a = 0; a < 2; ++a)
#pragma unroll
            for (int b = 0; b < 2; ++b)
#pragma unroll
                for (int m = 0; m < 4; ++m)
#pragma unroll
                    for (int n = 0; n < 2; ++n) acc[a][b][m][n] = (f32x4){0.f, 0.f, 0.f, 0.f};
        cur = nxt; cA = nA; cB = nB; vo = nvo; ++ui;
        if constexpr (ALIGN_EPI) { if (wr == 1) PG8_BAR; }
    }
    PG8_WAIT_V(0);
    if constexpr (!ALIGN_EPI) { if (wr == 0) PG8_BAR; }
    PG8_BAR;
#undef PG8_SA
#undef PG8_SB
#undef PG8_STAGE
#undef PG8_LDA
#undef PG8_LDB
#undef PG8_MMA
#undef PG8_WAIT_V
#undef PG8_WAIT_L
#undef PG8_BAR
#undef PG8_SCHED
}

struct TileOrder {
    int nM, nN, nwg, G, c;
    __device__ void init(int M, int N, int G_, int c_) { nM = M / BM; nN = N / BM; nwg = nM * nN; G = G_; c = c_; }
    __device__ bool tile(int i, int& pm, int& pn) const {
        const long L = (long)i * G + c; if (L >= nwg) return false;
        int wgid = (int)L; { const int q = nwg / 8, r = nwg % 8, xcd = wgid % 8, off = wgid / 8; wgid = (xcd < r ? xcd * (q + 1) : r * (q + 1) + (xcd - r) * q) + off; }
        const int nig = 8 * nN, gid = wgid / nig, fm = gid * 8, gsz = (nM - fm) < 8 ? (nM - fm) : 8;
        pm = fm + ((wgid % nig) % gsz); pn = (wgid % nig) / gsz; return true;
    }
};
}

typedef float f32x2 __attribute__((ext_vector_type(2)));
#define ACC_T f32x4 (&acc)[2][2][4][2]

struct EpiProj {
    __device__ static __forceinline__ int brow(int h, int R) { return pg8::brow_rope(h, R); }
    unsigned char* ws; const float *qg, *kg;
    __device__ static __forceinline__ void rot4(const f32x4 x1, const f32x4 x2, const f32x4 t0, const f32x4 t1, f32x4& y1, f32x4& y2) {
        y1.x = x1.x * t0.x - x2.x * t0.y; y2.x = x2.x * t0.x + x1.x * t0.y;
        y1.y = x1.y * t0.z - x2.y * t0.w; y2.y = x2.y * t0.z + x1.y * t0.w;
        y1.z = x1.z * t1.x - x2.z * t1.y; y2.z = x2.z * t1.x + x1.z * t1.y;
        y1.w = x1.w * t1.z - x2.w * t1.w; y2.w = x2.w * t1.z + x1.w * t1.w;
    }
    __device__ static __forceinline__ void store8(bf16_t* dst, const f32x4 a, const f32x4 b) {
        u32x4 w; w.x = cvtpk(a.x, a.y); w.y = cvtpk(a.z, a.w); w.z = cvtpk(b.x, b.y); w.w = cvtpk(b.z, b.w); *(u32x4*)dst = w; }
    __device__ __forceinline__ void operator()(ACC_T, const pg8::Unit& u, int wr, int wc, int fr, int fq, LAS unsigned char* ex) const {
        const int ng = 2 * u.pn + (wc >> 1), c0 = 32 * (wc & 1) + 8 * fq;
        if (ng < 72) {
            const int which = ng / 24, hh = ng % 24, g = hh >> 3, h = hh & 7;
            bf16_t* buf = (bf16_t*)(ws + WS_QA + (size_t)which * (WS_KA - WS_QA));
            const float2* rt1 = (const float2*)(ws + WS_RT1);
#pragma unroll
            for (int ai = 0; ai < 2; ++ai)
#pragma unroll
                for (int m = 0; m < 4; ++m) {
                    const int mrow = u.pm * 256 + ai * 128 + wr * 64 + m * 16 + fr, b = mrow >> 12, t = mrow & 4095;
                    bf16_t* dst = buf + ((size_t)((g * 2 + b) * 8 + h) * SEQ + perm_pos(g, t)) * HD + c0;
                    f32x4 y1a = acc[ai][0][m][0], y1b = acc[ai][0][m][1], y2a = acc[ai][1][m][0], y2b = acc[ai][1][m][1];
                    if (which < 2) {
                        const f32x4* tp = (const f32x4*)(rt1 + (size_t)t * 64 + c0);
                        const f32x4 t0 = tp[0], t1 = tp[1], t2 = tp[2], t3 = tp[3];
                        rot4(acc[ai][0][m][0], acc[ai][1][m][0], t0, t1, y1a, y2a); rot4(acc[ai][0][m][1], acc[ai][1][m][1], t2, t3, y1b, y2b);
                    }
                    store8(dst, y1a, y1b); store8(dst + 64, y2a, y2b);
                }
        } else if (ng < 92) {
            const int k = ng - 72;
            LAS float* X = (LAS float*)ex;
#pragma unroll
            for (int ai = 0; ai < 2; ++ai)
#pragma unroll
                for (int m = 0; m < 4; ++m) { float s = 0.f;
#pragma unroll
                    for (int bj = 0; bj < 2; ++bj)
#pragma unroll
                        for (int n = 0; n < 2; ++n) { const f32x4 x = acc[ai][bj][m][n]; s += (x.x * x.x + x.y * x.y) + (x.z * x.z + x.w * x.w); }
                    s += __shfl_xor(s, 16); s += __shfl_xor(s, 32);
                    if (fq == 0) X[(ai * 128 + wr * 64 + m * 16 + fr) * 4 + wc] = s; }
            asm volatile("s_waitcnt lgkmcnt(0)" ::: "memory"); __builtin_amdgcn_s_barrier(); asm volatile("" ::: "memory");
            const float* gn = (k < 16) ? qg : kg; const float2* rt2 = (const float2*)(ws + WS_RT2);
            bf16_t* qb = (bf16_t*)(ws + WS_QB); bf16_t* kb = (bf16_t*)(ws + WS_KB);
            const f32x4 g1a = *(const f32x4*)(gn + c0), g1b = *(const f32x4*)(gn + c0 + 4), g2a = *(const f32x4*)(gn + 64 + c0), g2b = *(const f32x4*)(gn + 64 + c0 + 4);
#pragma unroll
            for (int ai = 0; ai < 2; ++ai)
#pragma unroll
                for (int m = 0; m < 4; ++m) {
                    const int r = ai * 128 + wr * 64 + m * 16 + fr;
                    const float ssum = X[r * 4 + (wc & 2)] + X[r * 4 + (wc & 2) + 1];
                    const int mrow = u.pm * 256 + r, b = mrow >> 12, t = mrow & 4095;
                    bf16_t* dst = ((k < 16) ? qb + ((size_t)(b * 16 + k) * SEQ + t) * HD : kb + ((size_t)(b * 4 + (k - 16)) * SEQ + t) * HD) + c0;
                    const float rinv = 1.0f / sqrtf(ssum * (1.0f / 128.0f) + RMS_EPS);
                    const f32x4* tp = (const f32x4*)(rt2 + (size_t)t * 64 + c0);
                    const f32x4 t0 = tp[0], t1 = tp[1], t2 = tp[2], t3 = tp[3];
                    f32x4 y1a, y1b, y2a, y2b;
                    rot4(acc[ai][0][m][0] * rinv * g1a, acc[ai][1][m][0] * rinv * g2a, t0, t1, y1a, y2a); rot4(acc[ai][0][m][1] * rinv * g1b, acc[ai][1][m][1] * rinv * g2b, t2, t3, y1b, y2b);
                    store8(dst, y1a, y1b); store8(dst + 64, y2a, y2b);
                }
        } else {
#pragma unroll
            for (int ai = 0; ai < 2; ++ai)
#pragma unroll
                for (int m = 0; m < 4; ++m) {
                    const int mrow = u.pm * 256 + ai * 128 + wr * 64 + m * 16 + fr, b = mrow >> 12, t = mrow & 4095;
                    bf16_t* dst = (ng < 96 ? (bf16_t*)(ws + WS_VB) + ((size_t)(b * 4 + (ng - 92)) * SEQ + t) * HD : (bf16_t*)(ws + WS_GATES) + (size_t)mrow * 4096 + (ng - 96) * 128) + c0;
                    f32x4 y1a = acc[ai][0][m][0], y1b = acc[ai][0][m][1], y2a = acc[ai][1][m][0], y2b = acc[ai][1][m][1];
                    if (ng >= 96) {
#pragma unroll
                        for (int q = 0; q < 4; ++q) { y1a[q] = __builtin_amdgcn_rcpf(1.0f + __expf(-y1a[q])); y1b[q] = __builtin_amdgcn_rcpf(1.0f + __expf(-y1b[q]));
                            y2a[q] = __builtin_amdgcn_rcpf(1.0f + __expf(-y2a[q])); y2b[q] = __builtin_amdgcn_rcpf(1.0f + __expf(-y2b[q])); } }
                    store8(dst, y1a, y1b); store8(dst + 64, y2a, y2b);
                }
        }
    }
};
struct ProjSched {
    pg8::TileOrder o; const char* ws;
    __device__ __forceinline__ bool next(int i, pg8::Unit& u) const { int pm, pn; if (!o.tile(i, pm, pn)) return false;
        u.A = ws + WS_XB + (size_t)pm * 256 * (DM * 2); u.B = ws + WS_WINT + (size_t)pn * 256 * (DM * 2); u.lda = DM * 2; u.ldb = DM * 2; u.nt = DM / 64; u.pm = pm; u.pn = pn; u.aux = 0; u.gidx = nullptr; u.gcnt = 0; return true; }
};

struct EpiMix {
    __device__ static __forceinline__ int brow(int h, int R) { return pg8::brow_perm8(h, R); }
    unsigned char* ws; const float* x;
    __device__ __forceinline__ void operator()(ACC_T, const pg8::Unit& u, int wr, int wc, int fr, int fq, LAS unsigned char* ex) const {
        const bf16_t* gates = (const bf16_t*)(ws + WS_GATES); float* T = (float*)(ws + WS_T); bf16_t* merged = (bf16_t*)(ws + WS_MERGED); float* pre1 = (float*)(ws + WS_PRE1);
#pragma unroll
        for (int ai = 0; ai < 2; ++ai)
#pragma unroll
            for (int m = 0; m < 4; ++m) { const size_t mrow = (size_t)u.pm * 256 + ai * 128 + wr * 64 + m * 16 + fr;
#pragma unroll
                for (int bj = 0; bj < 2; ++bj) { const int col = u.pn * 256 + bj * 128 + wc * 32 + 8 * fq; const size_t o = mrow * DM + col;
                    const f32x4 a0 = acc[ai][bj][m][0], a1 = acc[ai][bj][m][1];
                    if (u.aux == 2) {
                        const f32x4 x0 = *(const f32x4*)(x + o), x1 = *(const f32x4*)(x + o + 4);
                        *(f32x4*)(pre1 + o) = x0 * ALPHA + a0; *(f32x4*)(pre1 + o + 4) = x1 * ALPHA + a1;
                    } else {
                        const u32x4 gw = *(const u32x4*)(gates + mrow * 4096 + (u.aux ? 2048 : 0) + col);
                        f32x4 g0, g1; g0.x = bflo(gw.x); g0.y = bfhi(gw.x); g0.z = bflo(gw.y); g0.w = bfhi(gw.y); g1.x = bflo(gw.z); g1.y = bfhi(gw.z); g1.z = bflo(gw.w); g1.w = bfhi(gw.w);
                        if (u.aux == 0) { *(f32x4*)(T + o) = g0 * a0; *(f32x4*)(T + o + 4) = g1 * a1; }
                        else { const f32x4 t0 = *(const f32x4*)(T + o) + g0 * a0, t1 = *(const f32x4*)(T + o + 4) + g1 * a1;
                            u32x4 w; w.x = cvtpk(t0.x, t0.y); w.y = cvtpk(t0.z, t0.w); w.z = cvtpk(t1.x, t1.y); w.w = cvtpk(t1.z, t1.w); *(u32x4*)(merged + o) = w; }
                    } } }
    }
};
struct MixSched {
    int mode, c; const char* ws;
    __device__ __forceinline__ bool next(int i, pg8::Unit& u) const {
        if (c >= 256) return false;
        const int pm = c >> 3, pn = c & 7; u.pm = pm; u.pn = pn; u.gidx = nullptr; u.gcnt = 0;
        if (mode == 0) { if (i > 1) return false;
            if (i == 0) { u.A = ws + WS_OA + (size_t)pm * 256 * 2048; u.B = ws + WS_WAT + (size_t)pn * 256 * 2048; u.lda = 2048; u.ldb = 2048; u.nt = 16; u.aux = 0; }
            else { u.A = ws + WS_OB + (size_t)pm * 256 * 4096; u.B = ws + WS_WBT + (size_t)pn * 256 * 4096; u.lda = 4096; u.ldb = 4096; u.nt = 32; u.aux = 1; }
            return true; }
        if (i > 0) return false;
        u.A = ws + WS_MERGED + (size_t)pm * 256 * 4096; u.B = ws + WS_WOT + (size_t)pn * 256 * 4096; u.lda = 4096; u.ldb = 4096; u.nt = 32; u.aux = 2; return true;
    }
};

struct MoeSched {
    int G, vcu, down; unsigned cnt_l, tpe_l;
    const char* ws;
    __device__ __forceinline__ void init(const unsigned* cnt, int lane) {
        unsigned c = 0; if (lane < NEXP) c = __hip_atomic_load(cnt + lane, __ATOMIC_RELAXED, __HIP_MEMORY_SCOPE_AGENT);
        unsigned t = (c + 255u) >> 8, inc = t;
#pragma unroll
        for (int o = 1; o < 32; o <<= 1) { const unsigned v = __shfl_up(inc, o); if ((lane & 31) >= o) inc += v; }
        cnt_l = c; tpe_l = inc - t;
    }
    __device__ __forceinline__ bool next(int i, pg8::Unit& u) const {
        const int lane = lane_id();
        const int total = (int)__builtin_amdgcn_readfirstlane(__shfl(tpe_l + ((cnt_l + 255u) >> 8), 31));
        const int L = i * G + vcu; if (L >= total * 8) return false;
        const int tg = L >> 3;
        const unsigned long long mk = __ballot(lane < NEXP && (int)tpe_l <= tg && (cnt_l > 0u));
        const int e = 63 - __builtin_clzll(mk);
        const int tp = (int)__builtin_amdgcn_readfirstlane(__shfl(tpe_l, e)), ce = (int)__builtin_amdgcn_readfirstlane(__shfl(cnt_l, e));
        const int te = (ce + 255) >> 8, q = L - 8 * tp, j = q / te, mt = q - j * te;
        u.pm = tp + mt; u.pn = j; u.aux = e; u.nt = down ? 16 : 32;
        if (!down) { u.A = ws + WS_H1B; u.lda = DM * 2; u.gidx = (const int*)(ws + WS_TOKIDX) + (size_t)e * ECAP + 256 * mt; u.gcnt = ce - 256 * mt; u.B = ws + WS_WGUT + ((size_t)e * 2048 + j * 256) * (DM * 2); u.ldb = DM * 2; }
        else { u.A = ws + WS_ACT + (size_t)(tp + mt) * 256 * (FF * 2); u.lda = FF * 2; u.gidx = nullptr; u.gcnt = 0; u.B = ws + WS_WDT + ((size_t)e * 2048 + j * 256) * (FF * 2); u.ldb = FF * 2; }
        return true;
    }
};
struct EpiMoe {
    __device__ static __forceinline__ int brow(int h, int R) { return pg8::brow_perm8(h, R); }
    int down; unsigned char* ws;
    __device__ __forceinline__ void operator()(ACC_T, const pg8::Unit& u, int wr, int wc, int fr, int fq, LAS unsigned char* ex) const {
        bf16_t* act = (bf16_t*)(ws + WS_ACT); bf16_t* y = (bf16_t*)(ws + WS_Y);
#pragma unroll
        for (int ai = 0; ai < 2; ++ai)
#pragma unroll
            for (int m = 0; m < 4; ++m) { const size_t row = (size_t)u.pm * 256 + ai * 128 + wr * 64 + m * 16 + fr;
                if (!down) {
                    f32x4 v0, v1;
#pragma unroll
                    for (int q = 0; q < 4; ++q) { const float g0 = acc[ai][0][m][0][q], u0 = acc[ai][1][m][0][q], g1 = acc[ai][0][m][1][q], u1 = acc[ai][1][m][1][q];
                        v0[q] = g0 * __builtin_amdgcn_rcpf(1.0f + __expf(-g0)) * u0; v1[q] = g1 * __builtin_amdgcn_rcpf(1.0f + __expf(-g1)) * u1; }
                    u32x4 w; w.x = cvtpk(v0.x, v0.y); w.y = cvtpk(v0.z, v0.w); w.z = cvtpk(v1.x, v1.y); w.w = cvtpk(v1.z, v1.w);
                    *(u32x4*)(act + row * FF + u.pn * 128 + wc * 32 + 8 * fq) = w;
                } else {
#pragma unroll
                    for (int bj = 0; bj < 2; ++bj) { const f32x4 a0 = acc[ai][bj][m][0], a1 = acc[ai][bj][m][1];
                        u32x4 w; w.x = cvtpk(a0.x, a0.y); w.y = cvtpk(a0.z, a0.w); w.z = cvtpk(a1.x, a1.y); w.w = cvtpk(a1.z, a1.w);
                        *(u32x4*)(y + row * DM + u.pn * 256 + bj * 128 + wc * 32 + 8 * fq) = w; }
                } }
    }
};

namespace att {
constexpr int D = 128, NW = 8, QBLK = 32, KVBLK = 64;
constexpr float SCALE = SM_SCALE, THR = 8.f;
constexpr int SHM_V = KVBLK * D * 2, SHM_K = KVBLK * D * 2, SHM_ATTN = 2 * SHM_V + 2 * SHM_K + NW * 64 * 4;
#define KSWZ(row, colB) ((row) * 256 + ((colB) ^ (((row) & 7) << 4)))
#define SBAR() __builtin_amdgcn_sched_barrier(0)
__device__ __forceinline__ int crow(int r, int hi) { return (r & 3) + 8 * (r >> 2) + 4 * hi; }
template <bool BAND> __device__ __forceinline__ void partialSM(f32x16& p0, f32x16& p1, float& m_reg, float& mn, float& alpha, int dv, bool tv) {
    constexpr float C = SCALE * 1.4426950408889634f;
    if constexpr (BAND) {
#pragma unroll
        for (int r = 0; r < 16; ++r) { const int kx = (r & 3) + 8 * (r >> 2);
            if (!tv || (unsigned)(dv + kx) > 128u) p0[r] = -INFINITY;
            if (!tv || (unsigned)(dv + kx + 32) > 128u) p1[r] = -INFINITY; } }
    float pmax = p0[0];
#pragma unroll
    for (int r = 1; r < 16; ++r) pmax = fmaxf(pmax, p0[r]);
#pragma unroll
    for (int r = 0; r < 16; ++r) pmax = fmaxf(pmax, p1[r]);
    { auto rr = __builtin_amdgcn_permlane32_swap(__float_as_uint(pmax), __float_as_uint(pmax), false, false);
      pmax = fmaxf(__uint_as_float(rr[0]), __uint_as_float(rr[1])); }
    if (__builtin_expect(__all(pmax - m_reg <= THR / SCALE), 1)) { mn = m_reg; alpha = 1.f; }
    else { mn = fmaxf(m_reg, pmax); alpha = __builtin_amdgcn_exp2f((m_reg - mn) * C); m_reg = mn; }
    const float mnC = -mn * C;
#pragma unroll
    for (int r = 0; r < 16; ++r) p0[r] = fmaf(p0[r], C, mnC);
#pragma unroll
    for (int r = 0; r < 16; ++r) p1[r] = fmaf(p1[r], C, mnC);
#pragma unroll
    for (int r = 0; r < 16; ++r) p0[r] = __builtin_amdgcn_exp2f(p0[r]);
}
__device__ __forceinline__ void finishSM(f32x16& p0, f32x16& p1, float alpha, float& l_reg, bf16x8& pa0, bf16x8& pa1, bf16x8& pa2, bf16x8& pa3) {
#pragma unroll
    for (int r = 0; r < 16; ++r) p1[r] = __builtin_amdgcn_exp2f(p1[r]);
    float ps = 0;
#pragma unroll
    for (int r = 0; r < 16; ++r) ps += p0[r];
#pragma unroll
    for (int r = 0; r < 16; ++r) ps += p1[r];
    { auto rr = __builtin_amdgcn_permlane32_swap(__float_as_uint(ps), __float_as_uint(ps), false, false);
      ps = __uint_as_float(rr[0]) + __uint_as_float(rr[1]); }
    l_reg = l_reg * alpha + ps;
#define PK4(P, BASE, OUT) do { unsigned a0 = cvtpk(P[BASE + 0], P[BASE + 1]), a1 = cvtpk(P[BASE + 2], P[BASE + 3]);   \
    unsigned b0 = cvtpk(P[BASE + 4], P[BASE + 5]), b1 = cvtpk(P[BASE + 6], P[BASE + 7]);                              \
    auto r0 = __builtin_amdgcn_permlane32_swap(a0, b0, false, false); auto r1 = __builtin_amdgcn_permlane32_swap(a1, b1, false, false); \
    u32x4 w = {r0[0], r1[0], r0[1], r1[1]}; OUT = *reinterpret_cast<bf16x8*>(&w); } while (0)
    PK4(p0, 0, pa0); PK4(p0, 8, pa1); PK4(p1, 0, pa2); PK4(p1, 8, pa3);
#undef PK4
}
__device__ __forceinline__ void qkt(f32x16& p0, f32x16& p1, const LAS unsigned char* Ks, const bf16x8* qr, int r32, int hi) {
    p0 = f32x16{}; p1 = f32x16{};
#pragma unroll
    for (int d0 = 0; d0 < 8; ++d0) { const int cb = (d0 * 16 + hi * 8) * 2;
        const bf16x8 b0 = *(const LAS bf16x8*)(Ks + KSWZ(r32, cb));
        const bf16x8 b1 = *(const LAS bf16x8*)(Ks + KSWZ(32 + r32, cb));
        p0 = __builtin_amdgcn_mfma_f32_32x32x16_bf16(b0, qr[d0], p0, 0, 0, 0);
        p1 = __builtin_amdgcn_mfma_f32_32x32x16_bf16(b1, qr[d0], p1, 0, 0, 0); }
}
__device__ __forceinline__ int v_st(int k, int c) { const int kk = (k & ~0xC) | ((k & 4) << 1) | ((k & 8) >> 1); return ((kk >> 3) * 4 + (c >> 5)) * 512 + ((kk & 7) * 32 + (c & 31)) * 2; }
__device__ __forceinline__ int v_rd_base(int lane) { return ((lane & 3) << 3) | (((lane >> 2) & 3) << 6) | (((lane >> 4) & 1) << 5) | (((lane >> 5) & 1) << 8); }
constexpr int v_rd_off(int d0, int ks, int half) { return d0 * 512 + ks * 4096 + half * 2048; }
template <int OFF> __device__ __forceinline__ s16x4 tr_read(int vb) { s16x4 r; asm volatile("ds_read_b64_tr_b16 %0, %1 offset:%2" : "=&v"(r) : "v"(vb), "i"(OFF) : "memory"); return r; }
template <int D0> __device__ __forceinline__ void pv_one(f32x16& od, int vb, bf16x8 pa0, bf16x8 pa1, bf16x8 pa2, bf16x8 pa3) {
    const s16x4 l0 = tr_read<v_rd_off(D0, 0, 0)>(vb), h0 = tr_read<v_rd_off(D0, 0, 1)>(vb), l1 = tr_read<v_rd_off(D0, 1, 0)>(vb), h1 = tr_read<v_rd_off(D0, 1, 1)>(vb);
    const s16x4 l2 = tr_read<v_rd_off(D0, 2, 0)>(vb), h2 = tr_read<v_rd_off(D0, 2, 1)>(vb), l3 = tr_read<v_rd_off(D0, 3, 0)>(vb), h3 = tr_read<v_rd_off(D0, 3, 1)>(vb);
    asm volatile("s_waitcnt lgkmcnt(0)" ::: "memory"); SBAR();
#define PK(L, H) (bf16x8){L[0], L[1], L[2], L[3], H[0], H[1], H[2], H[3]}
    od = __builtin_amdgcn_mfma_f32_32x32x16_bf16(pa0, PK(l0, h0), od, 0, 0, 0);
    od = __builtin_amdgcn_mfma_f32_32x32x16_bf16(pa1, PK(l1, h1), od, 0, 0, 0);
    od = __builtin_amdgcn_mfma_f32_32x32x16_bf16(pa2, PK(l2, h2), od, 0, 0, 0);
    od = __builtin_amdgcn_mfma_f32_32x32x16_bf16(pa3, PK(l3, h3), od, 0, 0, 0);
#undef PK
}
__device__ __forceinline__ void pv_d0(f32x16* o, int vb, bf16x8 pa0, bf16x8 pa1, bf16x8 pa2, bf16x8 pa3) {
    pv_one<0>(o[0], vb, pa0, pa1, pa2, pa3); pv_one<1>(o[1], vb, pa0, pa1, pa2, pa3); pv_one<2>(o[2], vb, pa0, pa1, pa2, pa3); pv_one<3>(o[3], vb, pa0, pa1, pa2, pa3);
}
struct Unit { const bf16_t *Q, *K, *V; bf16_t* O; float* lse; int ldo, lse_stride, nt, kt0, klo, khi, q0; };
__device__ __forceinline__ void body(const Unit& u, LAS unsigned char* lds, int wid) {
    const int lane = lane_id(), tid = wid * 64 + lane,
        r32 = lane & 31, hi = lane >> 5;
    LAS unsigned char* V_lds = lds; LAS unsigned char* K_lds = lds + 2 * SHM_V;
    LAS float* ws = (LAS float*)(lds + 2 * SHM_V + 2 * SHM_K) + wid * 64; LAS float* li_l = ws; LAS float* al_l = ws + 32;
    float m_reg = -1e30f, l_reg = 0; f32x16 o[4] = {}; bf16x8 qr[8];
    const bf16_t* Qw = u.Q + (size_t)(wid * QBLK + r32) * D + hi * 8;
#pragma unroll
    for (int d0 = 0; d0 < 8; ++d0) qr[d0] = *(const bf16x8*)(Qw + d0 * 16);
    const int sr = tid >> 4, sc = (tid & 15) * 8, vst0 = v_st(sr, sc), vst1 = v_st(32 + sr, sc);
    const int vb0 = (int)(unsigned)(uintptr_t)V_lds + v_rd_base(lane);
    const bf16_t* Kh = u.K; const bf16_t* Vh = u.V;
    constexpr bool BAND = false; constexpr int SD = 1; const int dq = 0;
#define TVALID(j) true
    struct { bf16x8 vs0, vs1, ks0, ks1; } sr_[SD];
#define KROW(j) (BAND ? ((u.kt0 + 64 * (j)) < u.klo ? u.klo : ((u.kt0 + 64 * (j)) > u.khi - 64 ? u.khi - 64 : (u.kt0 + 64 * (j)))) : (u.kt0 + 64 * (j)))
#define SLOAD(i, j) do { const int k0_ = KROW(j); sr_[i].vs0 = *(const bf16x8*)(&Vh[(size_t)(k0_ + sr) * D + sc]); sr_[i].vs1 = *(const bf16x8*)(&Vh[(size_t)(k0_ + 32 + sr) * D + sc]); \
    sr_[i].ks0 = *(const bf16x8*)(&Kh[(size_t)(k0_ + sr) * D + sc]); sr_[i].ks1 = *(const bf16x8*)(&Kh[(size_t)(k0_ + 32 + sr) * D + sc]); } while (0)
#define SWRITE(b, i) do { *(LAS bf16x8*)(V_lds + (b) * SHM_V + vst0) = sr_[i].vs0; *(LAS bf16x8*)(V_lds + (b) * SHM_V + vst1) = sr_[i].vs1; const int kc = sc * 2; \
    *(LAS bf16x8*)(K_lds + (b) * SHM_K + KSWZ(sr, kc)) = sr_[i].ks0; *(LAS bf16x8*)(K_lds + (b) * SHM_K + KSWZ(32 + sr, kc)) = sr_[i].ks1; } while (0)
#define SWAIT() do { if constexpr (SD == 2) asm volatile("s_waitcnt vmcnt(4)" ::: "memory"); else asm volatile("s_waitcnt vmcnt(0)" ::: "memory"); } while (0)
#define RESC(a) do { if (__any((a) < 1.f)) { if (hi == 0) al_l[r32] = (a); asm volatile("s_waitcnt lgkmcnt(0)" ::: "memory"); \
    _Pragma("unroll") for (int d = 0; d < 4; ++d) _Pragma("unroll") for (int r = 0; r < 16; ++r) o[d][r] *= al_l[crow(r, hi)]; } } while (0)
    f32x16 pA0, pA1, pB0, pB1; float mnA, mnB, alA, alB; bf16x8 pa0, pa1, pa2, pa3; const int NT = u.nt;
    constexpr int SE = 0, SO = SD - 1;
    SLOAD(SE, 0); asm volatile("s_waitcnt vmcnt(0)" ::: "memory"); SWRITE(0, SE); __syncthreads();
    qkt(pA0, pA1, K_lds, qr, r32, hi); partialSM<BAND>(pA0, pA1, m_reg, mnA, alA, dq, TVALID(0));
    SLOAD(SO, 1); if constexpr (SD == 2) { if (2 < NT) SLOAD(SE, 2); }
    SWAIT(); SWRITE(1, SO); __syncthreads();
    for (int j = 1; j + 1 < NT; j += 2) {
        SBAR(); qkt(pB0, pB1, K_lds + SHM_K, qr, r32, hi);
        finishSM(pA0, pA1, alA, l_reg, pa0, pa1, pa2, pa3); SBAR();
        SLOAD(SO, j + SD); SBAR();
        pv_d0(o, vb0, pa0, pa1, pa2, pa3); partialSM<BAND>(pB0, pB1, m_reg, mnB, alB, dq + 64 * j, TVALID(j));
        __syncthreads(); SWAIT(); SWRITE(0, SE);
        RESC(alB); __syncthreads();
        SBAR(); qkt(pA0, pA1, K_lds, qr, r32, hi);
        finishSM(pB0, pB1, alB, l_reg, pa0, pa1, pa2, pa3); SBAR();
        if (SD == 1 || j + 3 < NT) SLOAD(SE, j + 1 + SD); SBAR();
        pv_d0(o, vb0 + SHM_V, pa0, pa1, pa2, pa3); partialSM<BAND>(pA0, pA1, m_reg, mnA, alA, dq + 64 * (j + 1), TVALID(j + 1));
        __syncthreads(); SWAIT(); SWRITE(1, SO);
        RESC(alA); __syncthreads();
    }
    SBAR(); qkt(pB0, pB1, K_lds + SHM_K, qr, r32, hi);
    finishSM(pA0, pA1, alA, l_reg, pa0, pa1, pa2, pa3); SBAR();
    pv_d0(o, vb0, pa0, pa1, pa2, pa3); partialSM<BAND>(pB0, pB1, m_reg, mnB, alB, dq + 64 * (NT - 1), TVALID(NT - 1));
    __syncthreads(); RESC(alB);
    finishSM(pB0, pB1, alB, l_reg, pa0, pa1, pa2, pa3); SBAR();
    pv_d0(o, vb0 + SHM_V, pa0, pa1, pa2, pa3);
    if (hi == 0) li_l[r32] = l_reg; asm volatile("s_waitcnt lgkmcnt(0)" ::: "memory");
    float rli[16];
#pragma unroll
    for (int r = 0; r < 16; ++r) rli[r] = __builtin_amdgcn_rcpf(li_l[crow(r, hi)]);
    bf16_t* Ow = u.O + (size_t)(wid * QBLK) * u.ldo;
#pragma unroll
    for (int r = 0; r < 16; ++r) { const int orow = crow(r, hi);
#pragma unroll
        for (int d0 = 0; d0 < 4; ++d0) Ow[(size_t)orow * u.ldo + d0 * 32 + r32] = f2bf(o[d0][r] * rli[r]); }
    if (u.lse && hi == 0) u.lse[(size_t)(wid * QBLK + r32) * u.lse_stride] = m_reg * SCALE + __logf(l_reg);
    __syncthreads();
#undef KROW
#undef TVALID
#undef SLOAD
#undef SWRITE
#undef SWAIT
#undef RESC
}

__device__ __forceinline__ void band_body(const Unit& u, LAS unsigned char* lds, int wid) {
    const int lane = lane_id(), tid = wid * 64 + lane, r32 = lane & 31, hi = lane >> 5;
    LAS unsigned char* V_lds = lds; LAS unsigned char* K_lds = lds + 2 * SHM_V;
    LAS float* ws = (LAS float*)(lds + 2 * SHM_V + 2 * SHM_K) + wid * 64; LAS float* li_l = ws; LAS float* al_l = ws + 32;
    float m_reg = -1e30f, l_reg = 0; f32x16 o[4] = {}; bf16x8 qr[8];
    const bf16_t* Qw = u.Q + (size_t)(wid * QBLK + r32) * D + hi * 8;
#pragma unroll
    for (int d0 = 0; d0 < 8; ++d0) qr[d0] = *(const bf16x8*)(Qw + d0 * 16);
    const int sr = tid >> 4, sc = (tid & 15) * 8, vst0 = v_st(sr, sc), vst1 = v_st(32 + sr, sc);
    const int vb0 = (int)(unsigned)(uintptr_t)V_lds + v_rd_base(lane);
    const bf16_t* Kh = u.K; const bf16_t* Vh = u.V;
    const int dq = u.kt0 - (u.q0 + wid * QBLK + r32) + 4 * hi + 64;
    bf16x8 vs0, vs1, ks0, ks1;
#define KROW(j) ((u.kt0 + 64 * (j)) < u.klo ? u.klo : ((u.kt0 + 64 * (j)) > u.khi - 64 ? u.khi - 64 : (u.kt0 + 64 * (j))))
#define TVALID(j) ((u.kt0 + 64 * (j)) >= u.klo && (u.kt0 + 64 * (j)) < u.khi)
#define SLOAD(j) do { const int k0_ = KROW(j); vs0 = *(const bf16x8*)(&Vh[(size_t)(k0_ + sr) * D + sc]); vs1 = *(const bf16x8*)(&Vh[(size_t)(k0_ + 32 + sr) * D + sc]); \
    ks0 = *(const bf16x8*)(&Kh[(size_t)(k0_ + sr) * D + sc]); ks1 = *(const bf16x8*)(&Kh[(size_t)(k0_ + 32 + sr) * D + sc]); } while (0)
#define SWRITE(b) do { *(LAS bf16x8*)(V_lds + (b) * SHM_V + vst0) = vs0; *(LAS bf16x8*)(V_lds + (b) * SHM_V + vst1) = vs1; const int kc = sc * 2; \
    *(LAS bf16x8*)(K_lds + (b) * SHM_K + KSWZ(sr, kc)) = ks0; *(LAS bf16x8*)(K_lds + (b) * SHM_K + KSWZ(32 + sr, kc)) = ks1; } while (0)
    const int NT = u.nt;
    SLOAD(0); asm volatile("s_waitcnt vmcnt(0)" ::: "memory"); SWRITE(0);
    if (1 < NT) SLOAD(1);
    __syncthreads();
    for (int j = 0; j < NT; ++j) {
        const int cur = j & 1;
        f32x16 p0, p1; float mn, al; bf16x8 pa0, pa1, pa2, pa3;
        qkt(p0, p1, K_lds + cur * SHM_K, qr, r32, hi);
        partialSM<true>(p0, p1, m_reg, mn, al, dq + 64 * j, TVALID(j));
        if (__any(al < 1.f)) { if (hi == 0) al_l[r32] = al; asm volatile("s_waitcnt lgkmcnt(0)" ::: "memory");
#pragma unroll
            for (int d = 0; d < 4; ++d)
#pragma unroll
                for (int r = 0; r < 16; ++r) o[d][r] *= al_l[crow(r, hi)]; }
        finishSM(p0, p1, al, l_reg, pa0, pa1, pa2, pa3); SBAR();
        if (j + 1 < NT) { asm volatile("s_waitcnt vmcnt(0)" ::: "memory"); SWRITE(cur ^ 1); }
        if (j + 2 < NT) SLOAD(j + 2);
        SBAR();
        pv_d0(o, vb0 + cur * SHM_V, pa0, pa1, pa2, pa3);
        __syncthreads();
    }
    if (hi == 0) li_l[r32] = l_reg; asm volatile("s_waitcnt lgkmcnt(0)" ::: "memory");
    float rli[16];
#pragma unroll
    for (int r = 0; r < 16; ++r) rli[r] = __builtin_amdgcn_rcpf(li_l[crow(r, hi)]);
    bf16_t* Ow = u.O + (size_t)(wid * QBLK) * u.ldo;
#pragma unroll
    for (int r = 0; r < 16; ++r) { const int orow = crow(r, hi);
#pragma unroll
        for (int d0 = 0; d0 < 4; ++d0) Ow[(size_t)orow * u.ldo + d0 * 32 + r32] = f2bf(o[d0][r] * rli[r]); }
    if (hi == 0) u.lse[(size_t)(wid * QBLK + r32) * u.lse_stride] = m_reg * SCALE + __logf(l_reg);
    __syncthreads();
#undef KROW
#undef TVALID
#undef SLOAD
#undef SWRITE
}
}

#define XB_TMO      128
#define XB_XCNT(j)  (256  + 64 * (j))
#define XB_XSUB(j)  (1280 + 64 * (j))
#define XB_XGEN(j)  (2304 + 64 * (j))
#define XB_TOP      3328
#define XB_TOPGEN   3392
#define XCD_BAR_WORDS 3456
#define XB_SPIN_CAP (1u << 20)
__device__ __forceinline__ unsigned xb_ld(unsigned* p)              { return __hip_atomic_load(p, __ATOMIC_RELAXED, __HIP_MEMORY_SCOPE_AGENT); }
__device__ __forceinline__ unsigned xb_add(unsigned* p, unsigned v) { return __hip_atomic_fetch_add(p, v, __ATOMIC_RELAXED, __HIP_MEMORY_SCOPE_AGENT); }
__device__ __forceinline__ unsigned xb_xcc_id() { return (unsigned)__builtin_amdgcn_s_getreg((3 << 11) | 20) & 0xFu; }
#define XB_SPIN(cond, bar) do { unsigned _sp = 0; while (cond) { __builtin_amdgcn_s_sleep(1); \
    if ((++_sp & 255u) == 0u) { if (xb_ld(&(bar)[XB_TMO])) break; if (_sp > XB_SPIN_CAP) { atomicAdd(&(bar)[XB_TMO], 1u); break; } } } } while (0)
__device__ __forceinline__ void xcd_barrier_post(unsigned* bar, bool leader) { if (leader) (void)xb_add(&bar[XB_XCNT(xb_xcc_id())], 1u); }
__device__ __forceinline__ void xcd_barrier_complete(unsigned* bar, unsigned x, unsigned G, unsigned& nloc, unsigned& nx) {
    unsigned sum, cnt, mine, sp = 0u;
    for (;;) {
        sum = 0u; cnt = 0u; mine = 0u;
#pragma unroll
        for (unsigned j = 0; j < 16; ++j) { const unsigned c = xb_ld(&bar[XB_XCNT(j)]); sum += c; cnt += (c > 0u) ? 1u : 0u; mine = (j == x) ? c : mine; }
        if (sum == G) break;
        __builtin_amdgcn_s_sleep(1);
        if ((++sp & 255u) == 0u) { if (xb_ld(&bar[XB_TMO])) break; if (sp > XB_SPIN_CAP) { atomicAdd(&bar[XB_TMO], 1u); break; } }
    }
    nloc = mine > 0u ? mine : 1u; nx = cnt > 0u ? cnt : 1u;
}
__device__ __forceinline__ void xcd_barrier(unsigned* bar, volatile LAS unsigned* st, unsigned G, bool leader) {
    asm volatile("s_waitcnt vmcnt(0)" ::: "memory");
    __syncthreads();
    if (leader) {
        __builtin_amdgcn_s_waitcnt(0);
        const unsigned x = xb_xcc_id();
        unsigned nloc = st[0], nx = st[1];
        if (nloc == 0u) { xcd_barrier_complete(bar, x, G, nloc, nx); st[0] = nloc; st[1] = nx; }
        const unsigned old = xb_add(&bar[XB_XSUB(x)], 1u);
        const unsigned gen = old / nloc;
        if (old + 1u == (gen + 1u) * nloc) {
            __builtin_amdgcn_fence(__ATOMIC_RELEASE, "agent");
            asm volatile("s_waitcnt vmcnt(0)" ::: "memory");
            const unsigned og = xb_add(&bar[XB_TOP], 1u);
            const unsigned tg = og / nx;
            if (og + 1u == (tg + 1u) * nx) xb_add(&bar[XB_TOPGEN], 1u);
            else XB_SPIN(xb_ld(&bar[XB_TOPGEN]) == tg, bar);
            __builtin_amdgcn_fence(__ATOMIC_ACQUIRE, "agent");
            xb_add(&bar[XB_XGEN(x)], 1u);
            asm volatile("s_waitcnt vmcnt(0)" ::: "memory");
        } else {
            XB_SPIN(xb_ld(&bar[XB_XGEN(x)]) == gen, bar);
            __builtin_amdgcn_fence(__ATOMIC_ACQUIRE, "agent");
            asm volatile("s_waitcnt vmcnt(0)" ::: "memory");
        }
    }
    __syncthreads();
}

constexpr int RING_BYTES = 131072, EX_OFF = RING_BYTES, MISC_OFF = EX_OFF + 4096, LDS_BYTES = 147456;
constexpr int NWAVES = 8;

struct Args {
    const float* in[18]; float* out; unsigned char* ws; int ph_lo, ph_hi; int use_bar, bar_region;
};

__device__ __forceinline__ void p0_transpose_item(const float* W, int K, int N, bf16_t* WT, int rowblk, int roff, LAS float* scr, int item, int lane) {
    const int nblk = N / 32, kb = item / nblk, nb = item % nblk, k0 = 64 * kb, n0 = 32 * nb;
#pragma unroll 8
    for (int i = 0; i < 32; ++i) { const int kk = 2 * i + (lane >> 5); scr[kk * 33 + (lane & 31)] = W[(size_t)(k0 + kk) * N + n0 + (lane & 31)]; }
    asm volatile("s_waitcnt lgkmcnt(0)" ::: "memory");
    const int c = lane & 7;
#pragma unroll
    for (int j = 0; j < 4; ++j) { const int nl = (lane >> 3) + 8 * j; const LAS float* s = scr + (8 * c) * 33 + nl; const int n = n0 + nl;
        u32x4 o; o.x = pk2(s[0 * 33], s[1 * 33]); o.y = pk2(s[2 * 33], s[3 * 33]); o.z = pk2(s[4 * 33], s[5 * 33]); o.w = pk2(s[6 * 33], s[7 * 33]);
        const int dr = (n >> 7) * rowblk + roff + (n & 127);
        *(u32x4*)(WT + (size_t)dr * K + k0 + 8 * c) = o; }
    asm volatile("s_waitcnt lgkmcnt(0)" ::: "memory");
}

template <int VAR>
__global__ void __launch_bounds__(NWAVES * 64, 2) mk_fwd(Args args) {
    extern __shared__ __attribute__((aligned(16))) unsigned char lds_raw[];
    LAS unsigned char* lds = (LAS unsigned char*)lds_raw;
    const int wave = __builtin_amdgcn_readfirstlane(threadIdx.x >> 6);
#define PHASE_IDS() const int lane = lane_id(), tid = wave * 64 + lane; (void)tid; const int gw = vcu * NWAVES + wave, NGW = G * NWAVES; (void)lane; (void)gw; (void)NGW
    const int G = gridDim.x, bx = blockIdx.x; const int vcu = (G % 8 == 0) ? (bx % 8) * (G / 8) + bx / 8 : bx;
    unsigned char* ws = args.ws;
    unsigned* ctl = (unsigned*)(ws + WS_CTL);
    if (threadIdx.x < 64) ((volatile LAS unsigned*)(lds + MISC_OFF))[threadIdx.x] = 0u;
    __syncthreads();
    if (args.use_bar) xcd_barrier_post((unsigned*)(args.ws + WS_CTL) + CW_BAR + args.bar_region * XCD_BAR_WORDS, wave == 0 && lane_id() == 0);
    if (args.use_bar == 12345) cooperative_groups::this_grid().sync();
#define GRID_BAR() do { if (args.use_bar) xcd_barrier((unsigned*)(args.ws + WS_CTL) + CW_BAR + args.bar_region * XCD_BAR_WORDS, (volatile LAS unsigned*)(lds + MISC_OFF) + 8, (unsigned)G, wave == 0 && lane_id() == 0); } while (0)
    const int lo = args.ph_lo, hi = args.ph_hi;
#ifndef MK_CMASK
#define MK_CMASK 0x1ff
#endif
#define IN(k) ((((MK_CMASK) >> (k)) & 1) && lo <= (k) && (k) < hi)
#define BOTH(k) (IN(k) && IN((k) + 1))

    if (IN(0)) {
        PHASE_IDS();
        const float* x = args.in[0];
        bf16_t* XB = (bf16_t*)(ws + WS_XB); bf16_t* WINT = (bf16_t*)(ws + WS_WINT); bf16_t* WAT = (bf16_t*)(ws + WS_WAT); bf16_t* WBT = (bf16_t*)(ws + WS_WBT); bf16_t* WOT = (bf16_t*)(ws + WS_WOT);
        bf16_t* WGUT = (bf16_t*)(ws + WS_WGUT); bf16_t* WDT = (bf16_t*)(ws + WS_WDT);
        LAS float* scr = (LAS float*)(lds + wave * 16384);
        constexpr int I_IN = (DM / 64) * (IN_COLS / 32), I_A = (1024 / 64) * (DM / 32), I_B = (DM / 64) * (DM / 32), I_O = I_B;
        constexpr int I_G = (DM / 64) * (FF / 32), I_D = (FF / 64) * (DM / 32);
        constexpr int NITEMS = I_IN + I_A + I_B + I_O + NEXP * (2 * I_G + I_D);
        for (int it = gw; it < NITEMS; it += NGW) {
            int r = it;
            if (r < I_IN) { p0_transpose_item(args.in[1], DM, IN_COLS, WINT, 128, 0, scr, r, lane); continue; } r -= I_IN;
            if (r < I_A) { p0_transpose_item(args.in[4], 1024, DM, WAT, 128, 0, scr, r, lane); continue; } r -= I_A;
            if (r < I_B) { p0_transpose_item(args.in[5], DM, DM, WBT, 128, 0, scr, r, lane); continue; } r -= I_B;
            if (r < I_O) { p0_transpose_item(args.in[6], DM, DM, WOT, 128, 0, scr, r, lane); continue; } r -= I_O;
            const int e = r / (2 * I_G + I_D); r -= e * (2 * I_G + I_D);
            if (r < I_G) { p0_transpose_item(args.in[13] + (size_t)e * DM * FF, DM, FF, WGUT + (size_t)e * 2048 * DM, 256, 0, scr, r, lane); continue; } r -= I_G;
            if (r < I_G) { p0_transpose_item(args.in[14] + (size_t)e * DM * FF, DM, FF, WGUT + (size_t)e * 2048 * DM, 256, 128, scr, r, lane); continue; } r -= I_G;
            p0_transpose_item(args.in[15] + (size_t)e * FF * DM, FF, DM, WDT + (size_t)e * DM * FF, 128, 0, scr, r, lane);
        }
        for (int m = gw; m < NTOK; m += NGW) {
            const f32x4* xr = (const f32x4*)(x + (size_t)m * DM) + lane; u32x2* o8 = (u32x2*)(XB + (size_t)m * DM) + lane;
#pragma unroll
            for (int j = 0; j < 8; ++j) { const f32x4 v = xr[64 * j]; u32x2 w; w.x = pk2(v.x, v.y); w.y = pk2(v.z, v.w); o8[64 * j] = w; }
        }
        { float2* rt1 = (float2*)(ws + WS_RT1); float2* rt2 = (float2*)(ws + WS_RT2);
          for (int i = (vcu * NWAVES * 64) + tid; i < SEQ * 64; i += G * NWAVES * 64) { const int t = i >> 6, c = i & 63; float cs, sn;
              rope1(t, c, cs, sn); rt1[i] = make_float2(cs, sn); rope2(t, c, cs, sn); rt2[i] = make_float2(cs, sn); } }
        { float* wt = (float*)(ws + WS_WRT); const float* wgp = args.in[9]; const float* wrp = args.in[11];
          for (int i = (vcu * NWAVES * 64) + tid; i < 36 * DM; i += G * NWAVES * 64) { const int c = i >> 11, k = i & (DM - 1); wt[i] = (c < 4) ? wgp[(size_t)k * 4 + c] : wrp[(size_t)k * 32 + (c - 4)]; } }
        if (BOTH(0)) GRID_BAR();
    }

    if (IN(1)) {
        EpiProj E; E.ws = ws; E.qg = args.in[2]; E.kg = args.in[3];
        ProjSched S; S.o.init(NTOK, IN_COLS, G, bx); S.ws = (const char*)ws;
        pg8::gemm_phase<EpiProj, ProjSched, PG8_ALIGN, PG8_SP2>(lds, lds + EX_OFF, S, E, wave);
        if (BOTH(1)) GRID_BAR();
    }

    if (IN(2)) {
        for (int i = 0; i < 2; ++i) {
            const int idx = bx + i * G; if (idx >= 512) break;
            const int bk = idx & 7, rest = idx >> 3, b = bk >> 2, kvh = bk & 3, hq = kvh * 4 + (rest & 3), qblk = rest >> 2;
            att::Unit u; u.Q = (const bf16_t*)(ws + WS_QB) + ((size_t)(b * 16 + hq) * SEQ + qblk * 256) * HD;
            u.K = (const bf16_t*)(ws + WS_KB) + (size_t)(b * 4 + kvh) * SEQ * HD; u.V = (const bf16_t*)(ws + WS_VB) + (size_t)(b * 4 + kvh) * SEQ * HD;
            u.O = (bf16_t*)(ws + WS_OB) + ((size_t)b * SEQ + qblk * 256) * 2048 + hq * HD; u.ldo = 2048; u.lse = nullptr; u.lse_stride = 0; u.nt = 64; u.kt0 = 0; u.klo = 0; u.khi = SEQ; u.q0 = 0;
            att::body(u, lds, wave);
        }
        for (int i = 0; i < 3; ++i) {
            const int idx = bx + i * G; if (idx >= 768) break;
            const int sid = idx >> 4, qblk = idx & 15, g = sid >> 4, b = (sid >> 3) & 1, h = sid & 7, sh = 2 * g, L = SEQ >> sh;
            const int P0 = qblk * 256, r = P0 / L, p0 = P0 - r * L;
            att::Unit u; u.Q = (const bf16_t*)(ws + WS_QA) + ((size_t)sid * SEQ + P0) * HD; u.K = (const bf16_t*)(ws + WS_KA) + (size_t)sid * SEQ * HD; u.V = (const bf16_t*)(ws + WS_VA) + (size_t)sid * SEQ * HD;
            const size_t tok0 = (size_t)b * SEQ + ((size_t)p0 << sh) + r;
            u.O = (bf16_t*)(ws + WS_OAG) + ((size_t)g * NTOK + tok0) * 1024 + h * HD; u.ldo = 1024 << sh;
            u.lse = (float*)(ws + WS_LSE) + ((size_t)g * NTOK + tok0) * 8 + h; u.lse_stride = 8 << sh;
            u.nt = 6; u.kt0 = P0 - 64; u.klo = r * L; u.khi = r * L + L; u.q0 = P0;
            att::band_body(u, lds, wave);
        }
        GRID_BAR();
        {
            PHASE_IDS();
            const bf16_t* oag = (const bf16_t*)(ws + WS_OAG); const float* lse = (const float*)(ws + WS_LSE); bf16_t* oa = (bf16_t*)(ws + WS_OA);
            for (int m = gw; m < NTOK; m += NGW) { const int c = lane * 16, h = lane >> 3;
                const float l0 = lse[(0 * (size_t)NTOK + m) * 8 + h], l1 = lse[(1 * (size_t)NTOK + m) * 8 + h], l2 = lse[(2 * (size_t)NTOK + m) * 8 + h];
                const float mx = fmaxf(l0, fmaxf(l1, l2)); float e0 = __expf(l0 - mx), e1 = __expf(l1 - mx), e2 = __expf(l2 - mx); const float inv = 1.0f / (e0 + e1 + e2); e0 *= inv; e1 *= inv; e2 *= inv;
#pragma unroll
                for (int q = 0; q < 2; ++q) { const u32x4 a = *(const u32x4*)(oag + (0 * (size_t)NTOK + m) * 1024 + c + 8 * q), bq = *(const u32x4*)(oag + (1 * (size_t)NTOK + m) * 1024 + c + 8 * q), cq = *(const u32x4*)(oag + (2 * (size_t)NTOK + m) * 1024 + c + 8 * q);
                    u32x4 w;
#pragma unroll
                    for (int k = 0; k < 4; ++k) w[k] = cvtpk(e0 * bflo(a[k]) + e1 * bflo(bq[k]) + e2 * bflo(cq[k]), e0 * bfhi(a[k]) + e1 * bfhi(bq[k]) + e2 * bfhi(cq[k]));
                    *(u32x4*)(oa + (size_t)m * 1024 + c + 8 * q) = w; } }
        }
        if (BOTH(2)) GRID_BAR();
    }

    if (IN(3) || IN(4)) {
        EpiMix E; E.ws = ws; E.x = args.in[0];
        MixSched S; S.c = vcu; S.ws = (const char*)ws;
        if (IN(3)) { S.mode = 0; pg8::gemm_phase<EpiMix, MixSched, false, PG8_SP2>(lds, lds + EX_OFF, S, E, wave); if (BOTH(3)) GRID_BAR(); }
        if (IN(4)) { S.mode = 1; pg8::gemm_phase<EpiMix, MixSched, false, PG8_SP2>(lds, lds + EX_OFF, S, E, wave); if (BOTH(4)) GRID_BAR(); }
    }

    if (IN(5)) {
        PHASE_IDS();
        RouteArgs ra; ra.g = args.in[7]; ra.b = args.in[8]; ra.h1 = (float*)(ws + WS_H1); ra.h1b = (bf16_t*)(ws + WS_H1B); ra.wg = args.in[9]; ra.bg = args.in[10]; ra.wr = args.in[11]; ra.br = args.in[12];
        ra.cnt = ctl + CW_CNT; ra.tokidx = (int*)(ws + WS_TOKIDX); ra.slot = (int*)(ws + WS_SLOT); ra.wt = (const float*)(ws + WS_WRT);
        LAS unsigned* hist = (LAS unsigned*)lds; LAS unsigned* basev = hist + 32; LAS int* rinfo = (LAS int*)(lds + 256);
        if (tid < 64) hist[tid] = 0u;
        __syncthreads();
        static_assert(NTOK == 4 * 256 * NWAVES, "P5 assumes 4 rows per wave on a 256-workgroup grid");
#pragma unroll 1
        for (int ps = 0; ps < 2; ++ps) ln1_route_rows<2, VAR>((const float*)(ws + WS_PRE1), ra, gw + 2 * ps * NGW, NGW, lane_id(), hist, rinfo, wave * 4 + 2 * ps, 1);
        __syncthreads();
        if (tid < 32) { const unsigned h = hist[tid]; if (h) basev[tid] = atomicAdd(ra.cnt + tid, h); }
        __syncthreads();
        if (tid < 32) { const LAS int* ri = rinfo + tid * 8; const int ex1 = ri[0], ex2 = ri[1], m = ri[6]; const int p1 = (int)basev[ex1] + ri[2], p2 = (int)basev[ex2] + ri[3];
            ra.tokidx[ex1 * ECAP + p1] = m; ra.tokidx[ex2 * ECAP + p2] = m;
            int* sl = ra.slot + (size_t)m * 6; sl[0] = ex1; sl[1] = ex2; sl[2] = p1; sl[3] = p2; sl[4] = ri[4]; sl[5] = ri[5]; }
        if (BOTH(5)) GRID_BAR();
    }

    if (IN(6) || IN(7)) {
        MoeSched S; S.G = G; S.vcu = vcu; S.ws = (const char*)ws;
        S.init(ctl + CW_CNT, lane_id());
        EpiMoe E; E.ws = ws;
        if (IN(6)) { S.down = 0; E.down = 0; pg8::gemm_phase<EpiMoe, MoeSched, PG8_ALIGN, PG8_SP2>(lds, lds + EX_OFF, S, E, wave); if (BOTH(6)) GRID_BAR(); }
        if (IN(7)) { S.down = 1; E.down = 1; pg8::gemm_phase<EpiMoe, MoeSched, PG8_ALIGN, PG8_SP2>(lds, lds + EX_OFF, S, E, wave); if (BOTH(7)) GRID_BAR(); }
    }

    if (IN(8)) {
        PHASE_IDS();
        P8Args pa; pa.h1 = (const float*)(ws + WS_H1); pa.y = (const bf16_t*)(ws + WS_Y); pa.cnt = ctl + CW_CNT; pa.slot = (const int*)(ws + WS_SLOT); pa.g = args.in[16]; pa.b = args.in[17]; pa.out = args.out;
        unsigned c = 0; if (lane < NEXP) c = __hip_atomic_load(ctl + CW_CNT + lane, __ATOMIC_RELAXED, __HIP_MEMORY_SCOPE_AGENT);
        unsigned t = (c + 255u) >> 8, inc = t;
#pragma unroll
        for (int o = 1; o < 32; o <<= 1) { const unsigned v = __shfl_up(inc, o); if ((lane & 31) >= o) inc += v; }
        const unsigned tpe = inc - t;
        for (int m = gw; m < NTOK; m += NGW) {
            const int* sl = pa.slot + (size_t)m * 6; const int e1 = sl[0], e2 = sl[1], p1 = sl[2], p2 = sl[3]; const float w1 = ((const float*)sl)[4], w2 = ((const float*)sl)[5];
            const size_t r1 = (size_t)__shfl(tpe, e1) * 256 + p1, r2 = (size_t)__shfl(tpe, e2) * 256 + p2;
            final_row(pa, m, lane_id(), r1, r2, w1, w2);
        }
    }
#undef IN
#undef BOTH
#undef GRID_BAR
}

extern "C" void kernel_launch(void* const* d_in, const int* in_sizes, int n_in, void* d_out, int out_size, void* d_ws, size_t ws_size, hipStream_t stream) {
    static int grid = 0;
    if (grid == 0) {
        if (n_in != 18 || in_sizes[0] != NTOK * DM || out_size != NTOK * DM || ws_size < WS_END) { fprintf(stderr, "kernel_launch: unexpected shapes (n_in %d, in0 %d, out %d, ws %zu)\n", n_in, n_in > 0 ? in_sizes[0] : -1, out_size, ws_size); grid = -1; return; }
        int dev = 0, cus = 0, per_cu = 0;
        if (hipGetDevice(&dev) != hipSuccess || hipDeviceGetAttribute(&cus, hipDeviceAttributeMultiprocessorCount, dev) != hipSuccess) { fprintf(stderr, "kernel_launch: device query failed\n"); grid = -1; return; }
        if (hipFuncSetAttribute((const void*)mk_fwd<0>, hipFuncAttributeMaxDynamicSharedMemorySize, LDS_BYTES) != hipSuccess || hipFuncSetAttribute((const void*)mk_fwd<MK_EXTRA_VAR>, hipFuncAttributeMaxDynamicSharedMemorySize, LDS_BYTES) != hipSuccess) { fprintf(stderr, "kernel_launch: hipFuncSetAttribute failed\n"); grid = -1; return; }
        if (hipOccupancyMaxActiveBlocksPerMultiprocessor(&per_cu, (const void*)mk_fwd<0>, NWAVES * 64, LDS_BYTES) != hipSuccess || per_cu < 1) { fprintf(stderr, "kernel_launch: occupancy query says %d blocks per CU\n", per_cu); per_cu = 1; }
        (void)hipGetLastError();
        grid = cus * 1;
        fprintf(stderr, "kernel_launch: grid %d (cus %d, occupancy %d)\n", grid, cus, per_cu);
    }
    if (grid < 0) return;
    unsigned char* ws = (unsigned char*)d_ws;
    (void)hipMemsetAsync(ws + WS_CTL, 0, 1 * MiB, stream);
    Args a{};
    for (int i = 0; i < 18; ++i) a.in[i] = (const float*)d_in[i];
    a.out = (float*)d_out; a.ws = ws;
    const float* x = a.in[0];
    bf16_t* XB = (bf16_t*)(ws + WS_XB); bf16_t* WINT = (bf16_t*)(ws + WS_WINT); bf16_t* WAT = (bf16_t*)(ws + WS_WAT); bf16_t* WBT = (bf16_t*)(ws + WS_WBT); bf16_t* WOT = (bf16_t*)(ws + WS_WOT);
    bf16_t* WGUT = (bf16_t*)(ws + WS_WGUT); bf16_t* WDT = (bf16_t*)(ws + WS_WDT);
    unsigned* ctl = (unsigned*)(ws + WS_CTL);
    auto launch_mk = [&](int lo, int hi, int use_bar, bool extra = false) {
        a.ph_lo = lo; a.ph_hi = hi; a.use_bar = use_bar;
        void* kargs[] = {&a};
        hipError_t e = hipLaunchCooperativeKernel(extra ? (const void*)mk_fwd<MK_EXTRA_VAR> : (const void*)mk_fwd<0>, dim3(grid), dim3(NWAVES * 64), kargs, LDS_BYTES, stream);
        if (e != hipSuccess) fprintf(stderr, "kernel_launch: cooperative launch failed: %s (grid %d)\n", hipGetErrorString(e), grid);
    };
    if (MK_ONE_LAUNCH && MK_FAST_MASK == 0x1ff) { launch_mk(0, NPHASE, 1);
        if (MK_EXTRA_PHASE >= 0) { a.bar_region = 1; launch_mk(MK_EXTRA_PHASE, MK_EXTRA_PHASE + 1, 1, true); }
        return; }
    for (int ph = 0; ph < NPHASE; ++ph) {
        if ((MK_FAST_MASK >> ph) & 1) { launch_mk(ph, ph + 1, (ph == 2) ? 1 : 0); continue; }
        switch (ph) {
        case 0:
            hipLaunchKernelGGL(k_cvt, dim3(2048), dim3(256), 0, stream, x, XB, (size_t)NTOK * DM / 8);
            hipLaunchKernelGGL(k_transpose, dim3(IN_COLS / 32, DM / 32, 1), dim3(256), 0, stream, a.in[1], WINT, DM, IN_COLS, 128, 0, (size_t)0, (size_t)0);
            hipLaunchKernelGGL(k_transpose, dim3(DM / 32, 1024 / 32, 1), dim3(256), 0, stream, a.in[4], WAT, 1024, DM, 128, 0, (size_t)0, (size_t)0);
            hipLaunchKernelGGL(k_transpose, dim3(DM / 32, DM / 32, 1), dim3(256), 0, stream, a.in[5], WBT, DM, DM, 128, 0, (size_t)0, (size_t)0);
            hipLaunchKernelGGL(k_transpose, dim3(DM / 32, DM / 32, 1), dim3(256), 0, stream, a.in[6], WOT, DM, DM, 128, 0, (size_t)0, (size_t)0);
            hipLaunchKernelGGL(k_transpose, dim3(FF / 32, DM / 32, NEXP), dim3(256), 0, stream, a.in[13], WGUT, DM, FF, 256, 0, (size_t)DM * FF, (size_t)2048 * DM);
            hipLaunchKernelGGL(k_transpose, dim3(FF / 32, DM / 32, NEXP), dim3(256), 0, stream, a.in[14], WGUT, DM, FF, 256, 128, (size_t)DM * FF, (size_t)2048 * DM);
            hipLaunchKernelGGL(k_transpose, dim3(DM / 32, FF / 32, NEXP), dim3(256), 0, stream, a.in[15], WDT, FF, DM, 128, 0, (size_t)FF * DM, (size_t)DM * FF);
            hipLaunchKernelGGL(k_ropetab, dim3(SEQ * 64 / 256), dim3(256), 0, stream, (float2*)(ws + WS_RT1), (float2*)(ws + WS_RT2));
            break;
        case 1: { P1Args p1{}; p1.xb = XB; p1.wint = WINT; p1.qg = a.in[2]; p1.kg = a.in[3]; p1.qa = (bf16_t*)(ws + WS_QA); p1.ka = (bf16_t*)(ws + WS_KA); p1.va = (bf16_t*)(ws + WS_VA);
            p1.qb = (bf16_t*)(ws + WS_QB); p1.kb = (bf16_t*)(ws + WS_KB); p1.vb = (bf16_t*)(ws + WS_VB); p1.gates = (bf16_t*)(ws + WS_GATES);
            hipLaunchKernelGGL(k_proj, dim3(IN_COLS / 128, NTOK / 64), dim3(256), 0, stream, p1); } break;
        case 2: { P2Args p2b{}; p2b.q = (bf16_t*)(ws + WS_QB); p2b.k = (bf16_t*)(ws + WS_KB); p2b.v = (bf16_t*)(ws + WS_VB); p2b.o = (bf16_t*)(ws + WS_OB); p2b.lse = nullptr; p2b.mode = 0;
            hipLaunchKernelGGL(k_attn, dim3(SEQ / 64, 32), dim3(128), 0, stream, p2b);
            P2Args p2a{}; p2a.q = (bf16_t*)(ws + WS_QA); p2a.k = (bf16_t*)(ws + WS_KA); p2a.v = (bf16_t*)(ws + WS_VA); p2a.o = (bf16_t*)(ws + WS_OAG); p2a.lse = (float*)(ws + WS_LSE); p2a.mode = 1;
            hipLaunchKernelGGL(k_attn, dim3(SEQ / 64, 48), dim3(128), 0, stream, p2a);
            hipLaunchKernelGGL(k_merge, dim3(NTOK * 1024 / 256), dim3(256), 0, stream, (const bf16_t*)(ws + WS_OAG), (const float*)(ws + WS_LSE), (bf16_t*)(ws + WS_OA)); } break;
        case 3: case 4: { P3Args p3{}; p3.gates = (bf16_t*)(ws + WS_GATES); p3.T = (float*)(ws + WS_T); p3.merged = (bf16_t*)(ws + WS_MERGED); p3.x = x; p3.pre1 = (float*)(ws + WS_PRE1);
            if (ph == 3) { p3.A = (bf16_t*)(ws + WS_OA); p3.Bt = WAT; p3.K = 1024; p3.mode = 0;
                hipLaunchKernelGGL(k_gemm3, dim3(DM / 128, NTOK / 64), dim3(256), 0, stream, p3);
                p3.A = (bf16_t*)(ws + WS_OB); p3.Bt = WBT; p3.K = 2048; p3.mode = 1;
                hipLaunchKernelGGL(k_gemm3, dim3(DM / 128, NTOK / 64), dim3(256), 0, stream, p3); }
            else { p3.A = p3.merged; p3.Bt = WOT; p3.K = 2048; p3.mode = 2; hipLaunchKernelGGL(k_gemm3, dim3(DM / 128, NTOK / 64), dim3(256), 0, stream, p3); } } break;
        case 5: { RouteArgs ra{}; ra.g = a.in[7]; ra.b = a.in[8]; ra.h1 = (float*)(ws + WS_H1); ra.h1b = (bf16_t*)(ws + WS_H1B); ra.wg = a.in[9]; ra.bg = a.in[10]; ra.wr = a.in[11]; ra.br = a.in[12];
            ra.cnt = ctl + CW_CNT; ra.tokidx = (int*)(ws + WS_TOKIDX); ra.slot = (int*)(ws + WS_SLOT);
            hipLaunchKernelGGL(k_ln1_route, dim3(NTOK / 4), dim3(256), 0, stream, (const float*)(ws + WS_PRE1), ra); } break;
        case 6: case 7: { P6Args p6{}; p6.h1b = (bf16_t*)(ws + WS_H1B); p6.wgut = WGUT; p6.wdt = WDT; p6.cnt = ctl + CW_CNT; p6.tokidx = (int*)(ws + WS_TOKIDX); p6.act = (bf16_t*)(ws + WS_ACT); p6.y = (bf16_t*)(ws + WS_Y);
            if (ph == 6) hipLaunchKernelGGL(k_moe_up, dim3(FF / 128, 24576 / 64), dim3(256), 0, stream, p6);
            else hipLaunchKernelGGL(k_moe_down, dim3(DM / 128, 24576 / 64), dim3(256), 0, stream, p6); } break;
        case 8: { P8Args p8{}; p8.h1 = (float*)(ws + WS_H1); p8.y = (bf16_t*)(ws + WS_Y); p8.cnt = ctl + CW_CNT; p8.slot = (int*)(ws + WS_SLOT); p8.g = a.in[16]; p8.b = a.in[17]; p8.out = (float*)d_out;
            hipLaunchKernelGGL(k_final, dim3(NTOK / 4), dim3(256), 0, stream, p8); } break;
        }
    }
}
```

```cpp
#include <hip/hip_runtime.h>
#include <hip/hip_cooperative_groups.h>
#include <cstdio>
#include <cstdint>

typedef unsigned short bf16_t;
typedef short bf16x8 __attribute__((ext_vector_type(8)));
typedef short s16x4 __attribute__((ext_vector_type(4)));
typedef float f32x4 __attribute__((ext_vector_type(4)));
typedef float f32x16 __attribute__((ext_vector_type(16)));
typedef unsigned u32x4 __attribute__((ext_vector_type(4)));
typedef unsigned u32x2 __attribute__((ext_vector_type(2)));
#define LAS __attribute__((address_space(3)))

#ifndef MK_FAST_MASK
#define MK_FAST_MASK 0x1ff
#endif
#ifndef MK_ONE_LAUNCH
#define MK_ONE_LAUNCH 1
#endif
#ifndef MK_EXTRA_PHASE
#define MK_EXTRA_PHASE -1
#endif
#ifndef MK_EXTRA_VAR
#define MK_EXTRA_VAR 0
#endif
#ifndef PG8_SP2
#define PG8_SP2 true
#endif
#ifndef PG8_ALIGN
#define PG8_ALIGN true
#endif

constexpr int NTOK = 8192, SEQ = 4096, DM = 2048, HD = 128;
constexpr int IN_COLS = 16384;
constexpr int NEXP = 32, FF = 1024;
constexpr float ALPHA = 1.189207115002721f;
constexpr float LN_EPS = 1e-5f, RMS_EPS = 1e-6f;
constexpr float SM_SCALE = 0.08838834764831845f;
constexpr int ECAP = 8192;
constexpr int NPHASE = 9;

constexpr size_t MiB = 1u << 20;
constexpr size_t WS_CTL = 0;
constexpr size_t WS_WGUT = 1 * MiB;
constexpr size_t WS_WDT = 257 * MiB;
constexpr size_t WS_WAT = 385 * MiB;
constexpr size_t WS_WBT = 389 * MiB;
constexpr size_t WS_WOT = 397 * MiB;
constexpr size_t WS_XB = 405 * MiB;
constexpr size_t WS_WINT = 437 * MiB;
constexpr size_t WS_QA = 501 * MiB;
constexpr size_t WS_KA = 549 * MiB;
constexpr size_t WS_VA = 597 * MiB;
constexpr size_t WS_QB = 645 * MiB;
constexpr size_t WS_KB = 677 * MiB;
constexpr size_t WS_VB = 685 * MiB;
constexpr size_t WS_GATES = 693 * MiB;
constexpr size_t WS_OAG = 757 * MiB;
constexpr size_t WS_LSE = 805 * MiB;
constexpr size_t WS_OA = 806 * MiB;
constexpr size_t WS_OB = 822 * MiB;
constexpr size_t WS_T = 405 * MiB;
constexpr size_t WS_MERGED = 469 * MiB;
constexpr size_t WS_PRE1 = 501 * MiB;
constexpr size_t WS_H1 = 565 * MiB;
constexpr size_t WS_H1B = 629 * MiB;
constexpr size_t WS_TOKIDX = 661 * MiB;
constexpr size_t WS_SLOT = 662 * MiB;
constexpr size_t WS_ACT = 693 * MiB;
constexpr size_t WS_Y = 757 * MiB;
constexpr size_t WS_RT1 = 854 * MiB;
constexpr size_t WS_RT2 = 856 * MiB;
constexpr size_t WS_WRT = 858 * MiB;
constexpr size_t WS_END = 859 * MiB;
constexpr int CW_CNT = 64;
constexpr int CW_BAR = 4096;

__device__ __forceinline__ float bf2f(bf16_t v) { return __uint_as_float(((unsigned)v) << 16); }
__device__ __forceinline__ bf16_t f2bf(float f) { unsigned u = __float_as_uint(f); u += 0x7fffu + ((u >> 16) & 1u); return (bf16_t)(u >> 16); }
__device__ __forceinline__ unsigned pk2(float lo, float hi) { return (unsigned)f2bf(lo) | ((unsigned)f2bf(hi) << 16); }
__device__ __forceinline__ unsigned cvtpk(float lo, float hi) { unsigned r; asm volatile("v_cvt_pk_bf16_f32 %0, %1, %2" : "=v"(r) : "v"(lo), "v"(hi)); return r; }
__device__ __forceinline__ float wave_sum(float v) {
#pragma unroll
    for (int o = 1; o < 64; o <<= 1) v += __shfl_xor(v, o);
    return v;
}
__device__ __forceinline__ int lane_id() { int l; asm volatile("v_mbcnt_lo_u32_b32 %0, -1, 0\n\tv_mbcnt_hi_u32_b32 %0, -1, %0" : "=v"(l)); return l; }
__device__ __forceinline__ float bflo(unsigned w) { return __uint_as_float(w << 16); }
__device__ __forceinline__ float bfhi(unsigned w) { return __uint_as_float(w & 0xffff0000u); }

__device__ const float INV64[64] = {
    1.000000000e+00f, 8.659643234e-01f, 7.498942093e-01f, 6.493816316e-01f, 5.623413252e-01f, 4.869675252e-01f, 4.216965034e-01f, 3.651741273e-01f,
    3.162277660e-01f, 2.738419634e-01f, 2.371373706e-01f, 2.053525026e-01f, 1.778279410e-01f, 1.539926526e-01f, 1.333521432e-01f, 1.154781985e-01f,
    1.000000000e-01f, 8.659643234e-02f, 7.498942093e-02f, 6.493816316e-02f, 5.623413252e-02f, 4.869675252e-02f, 4.216965034e-02f, 3.651741273e-02f,
    3.162277660e-02f, 2.738419634e-02f, 2.371373706e-02f, 2.053525026e-02f, 1.778279410e-02f, 1.539926526e-02f, 1.333521432e-02f, 1.154781985e-02f,
    1.000000000e-02f, 8.659643234e-03f, 7.498942093e-03f, 6.493816316e-03f, 5.623413252e-03f, 4.869675252e-03f, 4.216965034e-03f, 3.651741273e-03f,
    3.162277660e-03f, 2.738419634e-03f, 2.371373706e-03f, 2.053525026e-03f, 1.778279410e-03f, 1.539926526e-03f, 1.333521432e-03f, 1.154781985e-03f,
    1.000000000e-03f, 8.659643234e-04f, 7.498942093e-04f, 6.493816316e-04f, 5.623413252e-04f, 4.869675252e-04f, 4.216965034e-04f, 3.651741273e-04f,
    3.162277660e-04f, 2.738419634e-04f, 2.371373706e-04f, 2.053525026e-04f, 1.778279410e-04f, 1.539926526e-04f, 1.333521432e-04f, 1.154781985e-04f};

__device__ __forceinline__ void cs_angle(float ang, float& c, float& s) {
    const double a = (double)ang * 0.15915494309189535;
    const float f = (float)(a - floor(a));
    s = __builtin_amdgcn_sinf(f); c = __builtin_amdgcn_cosf(f);
}
__device__ __forceinline__ void rope1(int t, int i, float& c, float& s) { cs_angle((float)t * INV64[i], c, s); }
__device__ __forceinline__ void rope2(int t, int i, float& c, float& s) {
    const float p = (i < 32) ? (float)(t >> 6) : (float)(t & 63);
    cs_angle(p * INV64[2 * (i & 31)], c, s);
}
__device__ __forceinline__ int perm_pos(int g, int t) { const int sh = 2 * g; const int d = 1 << sh; return (t & (d - 1)) * (SEQ >> sh) + (t >> sh); }

__global__ void __launch_bounds__(256) k_cvt(const float* __restrict__ x, bf16_t* __restrict__ xb, size_t n8) {
    for (size_t i = (size_t)blockIdx.x * 256 + threadIdx.x; i < n8; i += (size_t)gridDim.x * 256) {
        const f32x4 a = *(const f32x4*)(x + i * 8), b = *(const f32x4*)(x + i * 8 + 4);
        u32x4 w; w.x = pk2(a.x, a.y); w.y = pk2(a.z, a.w); w.z = pk2(b.x, b.y); w.w = pk2(b.z, b.w);
        *(u32x4*)(xb + i * 8) = w;
    }
}
__global__ void __launch_bounds__(256) k_transpose(const float* __restrict__ src, bf16_t* __restrict__ dst, int K, int N, int rowblk, int roff, size_t sstride, size_t dstride) {
    __shared__ float tile[32][33];
    const float* s = src + (size_t)blockIdx.z * sstride; bf16_t* d = dst + (size_t)blockIdx.z * dstride;
    const int n0 = blockIdx.x * 32, k0 = blockIdx.y * 32, tx = threadIdx.x & 31, ty = threadIdx.x >> 5;
    for (int i = ty; i < 32; i += 8) tile[i][tx] = s[(size_t)(k0 + i) * N + n0 + tx];
    __syncthreads();
    for (int i = ty; i < 32; i += 8) { const int n = n0 + i; const int dr = (n >> 7) * rowblk + roff + (n & 127); d[(size_t)dr * K + k0 + tx] = f2bf(tile[tx][i]); }
}
__global__ void __launch_bounds__(256) k_ropetab(float2* rt1, float2* rt2) {
    const int i = blockIdx.x * 256 + threadIdx.x; const int t = i >> 6, c = i & 63; float cs, sn;
    rope1(t, c, cs, sn); rt1[i] = make_float2(cs, sn); rope2(t, c, cs, sn); rt2[i] = make_float2(cs, sn);
}
__device__ __forceinline__ void wave_gemm16x128(const bf16_t* arow, const bf16_t* bt, int ldb, int K, f32x4 (&acc)[8]) {
    const int lane = threadIdx.x & 63, fr = lane & 15, fq = lane >> 4;
    const bf16_t* ap = arow + fq * 8;
    const bf16_t* bp = bt + (size_t)fr * ldb + fq * 8;
    for (int k = 0; k < K; k += 32) {
        const bf16x8 a = *(const bf16x8*)(ap + k);
#pragma unroll
        for (int j = 0; j < 8; ++j) { const bf16x8 b = *(const bf16x8*)(bp + (size_t)j * 16 * ldb + k); acc[j] = __builtin_amdgcn_mfma_f32_16x16x32_bf16(a, b, acc[j], 0, 0, 0); }
    }
}
struct P1Args { const bf16_t* xb; const bf16_t* wint; const float* qg; const float* kg; bf16_t *qa, *ka, *va, *qb, *kb, *vb, *gates; };
__global__ void __launch_bounds__(256) k_proj(P1Args a) {
    const int wave = threadIdx.x >> 6, lane = threadIdx.x & 63, fr = lane & 15, fq = lane >> 4;
    const int ng = blockIdx.x, mt = blockIdx.y * 4 + wave;
    f32x4 acc[8];
#pragma unroll
    for (int j = 0; j < 8; ++j) acc[j] = (f32x4){0.f, 0.f, 0.f, 0.f};
    wave_gemm16x128(a.xb + (size_t)(mt * 16 + fr) * DM, a.wint + (size_t)ng * 128 * DM, DM, DM, acc);
#pragma unroll
    for (int r = 0; r < 4; ++r) {
        const int m = mt * 16 + fq * 4 + r, b = m >> 12, t = m & 4095;
        if (ng < 72) {
            const int which = ng / 24, hh = ng % 24, g = hh >> 3, h = hh & 7;
            bf16_t* base = (which == 0 ? a.qa : (which == 1 ? a.ka : a.va)) + ((size_t)((g * 2 + b) * 8 + h) * SEQ + perm_pos(g, t)) * HD;
#pragma unroll
            for (int j = 0; j < 4; ++j) { const int c = 16 * j + fr; float x1 = acc[j][r], x2 = acc[j + 4][r];
                if (which < 2) { float cs, sn; rope1(t, c, cs, sn); const float y1 = x1 * cs - x2 * sn, y2 = x2 * cs + x1 * sn; x1 = y1; x2 = y2; }
                base[c] = f2bf(x1); base[c + 64] = f2bf(x2); }
        } else if (ng < 96) {
            const int k = ng - 72;
            if (k < 20) {
                float ss = 0.f;
#pragma unroll
                for (int j = 0; j < 8; ++j) ss += acc[j][r] * acc[j][r];
                ss += __shfl_xor(ss, 1); ss += __shfl_xor(ss, 2); ss += __shfl_xor(ss, 4); ss += __shfl_xor(ss, 8);
                const float rinv = 1.0f / sqrtf(ss * (1.0f / 128.0f) + RMS_EPS);
                const float* gn = (k < 16) ? a.qg : a.kg;
                bf16_t* base = (k < 16) ? a.qb + ((size_t)(b * 16 + k) * SEQ + t) * HD : a.kb + ((size_t)(b * 4 + (k - 16)) * SEQ + t) * HD;
#pragma unroll
                for (int j = 0; j < 4; ++j) { const int c = 16 * j + fr; const float x1 = acc[j][r] * rinv * gn[c], x2 = acc[j + 4][r] * rinv * gn[c + 64];
                    float cs, sn; rope2(t, c, cs, sn); base[c] = f2bf(x1 * cs - x2 * sn); base[c + 64] = f2bf(x2 * cs + x1 * sn); }
            } else {
                bf16_t* base = a.vb + ((size_t)(b * 4 + (k - 20)) * SEQ + t) * HD;
#pragma unroll
                for (int j = 0; j < 8; ++j) base[16 * j + fr] = f2bf(acc[j][r]);
            }
        } else {
            bf16_t* base = a.gates + (size_t)m * 4096 + (ng - 96) * 128;
#pragma unroll
            for (int j = 0; j < 8; ++j) base[16 * j + fr] = f2bf(1.0f / (1.0f + __expf(-acc[j][r])));
        }
    }
}
struct P2Args { const bf16_t *q, *k, *v; bf16_t* o; float* lse; int mode; };
__global__ void __launch_bounds__(128) k_attn(P2Args a) {
    const int half = threadIdx.x & 1, qi = blockIdx.x * 64 + (threadIdx.x >> 1), sid = blockIdx.y;
    const bf16_t *Q, *K, *V; int k_lo, k_hi;
    if (a.mode == 0) { const int b = sid >> 4, hq = sid & 15; Q = a.q + (size_t)sid * SEQ * HD; K = a.k + (size_t)(b * 4 + (hq >> 2)) * SEQ * HD; V = a.v + (size_t)(b * 4 + (hq >> 2)) * SEQ * HD; k_lo = 0; k_hi = SEQ - 1; }
    else { const int g = sid >> 4; const int L = SEQ >> (2 * g); Q = a.q + (size_t)sid * SEQ * HD; K = a.k + (size_t)sid * SEQ * HD; V = a.v + (size_t)sid * SEQ * HD;
        const int r0 = (qi / L) * L, p = qi - r0; k_lo = r0 + (p - 64 > 0 ? p - 64 : 0); k_hi = r0 + (p + 64 < L - 1 ? p + 64 : L - 1); }
    float q[64], o[64];
    { const bf16_t* qp = Q + (size_t)qi * HD + half * 64;
#pragma unroll
      for (int d = 0; d < 64; ++d) { q[d] = bf2f(qp[d]) * SM_SCALE; o[d] = 0.f; } }
    float m = -1e30f, l = 0.f;
    for (int kk = k_lo; kk <= k_hi; ++kk) {
        const bf16_t* kp = K + (size_t)kk * HD + half * 64; const bf16_t* vp = V + (size_t)kk * HD + half * 64;
        float s = 0.f;
#pragma unroll
        for (int d = 0; d < 64; ++d) s += q[d] * bf2f(kp[d]);
        s += __shfl_xor(s, 1);
        const float mn = fmaxf(m, s), al = __expf(m - mn), p = __expf(s - mn);
        l = l * al + p; m = mn;
#pragma unroll
        for (int d = 0; d < 64; ++d) o[d] = o[d] * al + p * bf2f(vp[d]);
    }
    const float rl = 1.0f / l;
    if (a.mode == 0) { const int b = sid >> 4, hq = sid & 15; bf16_t* op = a.o + (size_t)(b * SEQ + qi) * 2048 + hq * HD + half * 64;
#pragma unroll
        for (int d = 0; d < 64; ++d) op[d] = f2bf(o[d] * rl); }
    else { const int g = sid >> 4, b = (sid >> 3) & 1, h = sid & 7; const int sh = 2 * g, L = SEQ >> sh; const int r = qi / L, p = qi - r * L, t = (p << sh) + r;
        const size_t mrow = (size_t)b * SEQ + t;
        bf16_t* op = a.o + ((size_t)g * NTOK + mrow) * 1024 + h * HD + half * 64;
#pragma unroll
        for (int d = 0; d < 64; ++d) op[d] = f2bf(o[d] * rl);
        if (half == 0) a.lse[((size_t)g * NTOK + mrow) * 8 + h] = m + __logf(l); }
}
__global__ void __launch_bounds__(256) k_merge(const bf16_t* __restrict__ oag, const float* __restrict__ lse, bf16_t* __restrict__ oa) {
    const size_t i = (size_t)blockIdx.x * 256 + threadIdx.x;
    const size_t m = i >> 10; const int c = (int)(i & 1023), h = c >> 7;
    const float l0 = lse[(0 * (size_t)NTOK + m) * 8 + h], l1 = lse[(1 * (size_t)NTOK + m) * 8 + h], l2 = lse[(2 * (size_t)NTOK + m) * 8 + h];
    const float mx = fmaxf(l0, fmaxf(l1, l2)); const float e0 = __expf(l0 - mx), e1 = __expf(l1 - mx), e2 = __expf(l2 - mx); const float inv = 1.0f / (e0 + e1 + e2);
    const float v = (e0 * bf2f(oag[(0 * (size_t)NTOK + m) * 1024 + c]) + e1 * bf2f(oag[(1 * (size_t)NTOK + m) * 1024 + c]) + e2 * bf2f(oag[(2 * (size_t)NTOK + m) * 1024 + c])) * inv;
    oa[i] = f2bf(v);
}
struct P3Args { const bf16_t* A; const bf16_t* Bt; int K; const bf16_t* gates; float* T; bf16_t* merged; const float* x; float* pre1; int mode; };
__global__ void __launch_bounds__(256) k_gemm3(P3Args a) {
    const int wave = threadIdx.x >> 6, lane = threadIdx.x & 63, fr = lane & 15, fq = lane >> 4;
    const int ng = blockIdx.x, mt = blockIdx.y * 4 + wave;
    f32x4 acc[8];
#pragma unroll
    for (int j = 0; j < 8; ++j) acc[j] = (f32x4){0.f, 0.f, 0.f, 0.f};
    wave_gemm16x128(a.A + (size_t)(mt * 16 + fr) * a.K, a.Bt + (size_t)ng * 128 * a.K, a.K, a.K, acc);
#pragma unroll
    for (int r = 0; r < 4; ++r) { const size_t m = (size_t)mt * 16 + fq * 4 + r;
#pragma unroll
        for (int j = 0; j < 8; ++j) { const int c = ng * 128 + 16 * j + fr; const size_t o = m * DM + c;
            if (a.mode == 0) a.T[o] = bf2f(a.gates[m * 4096 + c]) * acc[j][r];
            else if (a.mode == 1) a.merged[o] = f2bf(a.T[o] + bf2f(a.gates[m * 4096 + 2048 + c]) * acc[j][r]);
            else a.pre1[o] = ALPHA * a.x[o] + acc[j][r]; } }
}
struct RouteArgs { const float* g; const float* b; float* h1; bf16_t* h1b; const float* wg; const float* bg; const float* wr; const float* br; unsigned* cnt; int* tokidx; int* slot; const float* wt; };
__device__ __forceinline__ void ln1_route_row(const float* pre1, const RouteArgs& a, int m, int lane) {
    const f32x4* xr = (const f32x4*)(pre1 + (size_t)m * DM) + lane;
    f32x4 v[8]; float s = 0.f;
#pragma unroll
    for (int j = 0; j < 8; ++j) { v[j] = xr[64 * j]; s += (v[j].x + v[j].y) + (v[j].z + v[j].w); }
    const float mean = wave_sum(s) * (1.0f / DM); float s2 = 0.f;
#pragma unroll
    for (int j = 0; j < 8; ++j) { v[j] = v[j] - mean; s2 += (v[j].x * v[j].x + v[j].y * v[j].y) + (v[j].z * v[j].z + v[j].w * v[j].w); }
    const float rstd = 1.0f / sqrtf(wave_sum(s2) * (1.0f / DM) + LN_EPS);
    float gl[4] = {0.f, 0.f, 0.f, 0.f};
#pragma unroll
    for (int j = 0; j < 8; ++j) { const int c = 4 * lane + 256 * j; const f32x4 gg = *(const f32x4*)(a.g + c), bb = *(const f32x4*)(a.b + c);
        v[j] = v[j] * rstd * gg + bb;
        *(f32x4*)(a.h1 + (size_t)m * DM + c) = v[j];
        *(uint2*)(a.h1b + (size_t)m * DM + c) = make_uint2(pk2(v[j].x, v[j].y), pk2(v[j].z, v[j].w));
#pragma unroll
        for (int i = 0; i < 4; ++i) { const f32x4 w = *(const f32x4*)(a.wg + (size_t)(c + i) * 4); const float hv = v[j][i]; gl[0] += hv * w.x; gl[1] += hv * w.y; gl[2] += hv * w.z; gl[3] += hv * w.w; } }
#pragma unroll
    for (int i = 0; i < 4; ++i) gl[i] = wave_sum(gl[i]) + a.bg[i];
    int gi = 0; float gm = gl[0];
#pragma unroll
    for (int i = 1; i < 4; ++i) if (gl[i] > gm) { gm = gl[i]; gi = i; }
    float gs = 0.f;
#pragma unroll
    for (int i = 0; i < 4; ++i) gs += __expf(gl[i] - gm);
    const float ggate = 1.0f / gs;
    float el[8] = {0.f, 0.f, 0.f, 0.f, 0.f, 0.f, 0.f, 0.f};
#pragma unroll
    for (int j = 0; j < 8; ++j) { const int c = 4 * lane + 256 * j;
#pragma unroll
        for (int i = 0; i < 4; ++i) { const float* wp = a.wr + (size_t)(c + i) * 32 + gi * 8; const f32x4 w0 = *(const f32x4*)wp, w1 = *(const f32x4*)(wp + 4); const float hv = v[j][i];
            el[0] += hv * w0.x; el[1] += hv * w0.y; el[2] += hv * w0.z; el[3] += hv * w0.w; el[4] += hv * w1.x; el[5] += hv * w1.y; el[6] += hv * w1.z; el[7] += hv * w1.w; } }
#pragma unroll
    for (int i = 0; i < 8; ++i) el[i] = wave_sum(el[i]) + a.br[gi * 8 + i];
    int i1 = 0; float m1 = el[0];
#pragma unroll
    for (int i = 1; i < 8; ++i) if (el[i] > m1) { m1 = el[i]; i1 = i; }
    int i2 = -1; float m2 = -3.0e38f;
#pragma unroll
    for (int i = 0; i < 8; ++i) if (i != i1 && el[i] > m2) { m2 = el[i]; i2 = i; }
    const float e2 = __expf(m2 - m1); const float w1 = ggate / (1.0f + e2), w2 = ggate * e2 / (1.0f + e2);
    if (lane == 0) {
        const int ex1 = gi * 8 + i1, ex2 = gi * 8 + i2;
        const int p1 = (int)atomicAdd(a.cnt + ex1, 1u), p2 = (int)atomicAdd(a.cnt + ex2, 1u);
        a.tokidx[ex1 * ECAP + p1] = m; a.tokidx[ex2 * ECAP + p2] = m;
        int* sl = a.slot + (size_t)m * 6; sl[0] = ex1; sl[1] = ex2; sl[2] = p1; sl[3] = p2; ((float*)sl)[4] = w1; ((float*)sl)[5] = w2;
    }
}
template <int R, int VAR>
__device__ __forceinline__ void ln1_route_rows(const float* pre1, const RouteArgs& a, int m0, int ms, int lane, LAS unsigned* hist, LAS int* rinfo, int lr0, int lrs) {
    f32x4 v[R][8]; float s[R], s2[R];
#pragma unroll
    for (int i = 0; i < R; ++i) { const f32x4* xr = (const f32x4*)(pre1 + (size_t)(m0 + i * ms) * DM) + lane; s[i] = 0.f;
#pragma unroll
        for (int j = 0; j < 8; ++j) { v[i][j] = xr[64 * j]; s[i] += (v[i][j].x + v[i][j].y) + (v[i][j].z + v[i][j].w); } }
#pragma unroll
    for (int o = 1; o < 64; o <<= 1)
#pragma unroll
        for (int i = 0; i < R; ++i) s[i] += __shfl_xor(s[i], o);
#pragma unroll
    for (int i = 0; i < R; ++i) { const float mean = s[i] * (1.0f / DM); s2[i] = 0.f;
#pragma unroll
        for (int j = 0; j < 8; ++j) { v[i][j] = v[i][j] - mean; s2[i] += (v[i][j].x * v[i][j].x + v[i][j].y * v[i][j].y) + (v[i][j].z * v[i][j].z + v[i][j].w * v[i][j].w); } }
#pragma unroll
    for (int o = 1; o < 64; o <<= 1)
#pragma unroll
        for (int i = 0; i < R; ++i) s2[i] += __shfl_xor(s2[i], o);
#pragma unroll
    for (int j = 0; j < 8; ++j) { const int c = 4 * lane + 256 * j; const f32x4 gg = *(const f32x4*)(a.g + c), bb = *(const f32x4*)(a.b + c);
#pragma unroll
        for (int i = 0; i < R; ++i) { const float rstd = 1.0f / sqrtf(s2[i] * (1.0f / DM) + LN_EPS); const size_t o = (size_t)(m0 + i * ms) * DM + c;
            v[i][j] = v[i][j] * rstd * gg + bb;
            *(f32x4*)(a.h1 + o) = v[i][j];
            *(uint2*)(a.h1b + o) = make_uint2(pk2(v[i][j].x, v[i][j].y), pk2(v[i][j].z, v[i][j].w)); } }
    if constexpr (VAR == 51) return;
    float gl[R][4];
#pragma unroll
    for (int c = 0; c < 4; ++c) { const f32x4* wp = (const f32x4*)(a.wt + (size_t)c * DM) + lane;
#pragma unroll
        for (int i = 0; i < R; ++i) gl[i][c] = 0.f;
#pragma unroll
        for (int j = 0; j < 8; ++j) { const f32x4 w = wp[64 * j];
#pragma unroll
            for (int i = 0; i < R; ++i) gl[i][c] += (v[i][j].x * w.x + v[i][j].y * w.y) + (v[i][j].z * w.z + v[i][j].w * w.w); }
        if (c & 1) __builtin_amdgcn_sched_barrier(0); }
#pragma unroll
    for (int o = 1; o < 64; o <<= 1)
#pragma unroll
        for (int i = 0; i < R; ++i)
#pragma unroll
            for (int c = 0; c < 4; ++c) gl[i][c] += __shfl_xor(gl[i][c], o);
    int gi[R]; float ggate[R];
#pragma unroll
    for (int i = 0; i < R; ++i) { float g0 = gl[i][0] + a.bg[0], g1 = gl[i][1] + a.bg[1], g2 = gl[i][2] + a.bg[2], g3 = gl[i][3] + a.bg[3];
        int q = 0; float gm = g0; if (g1 > gm) { gm = g1; q = 1; } if (g2 > gm) { gm = g2; q = 2; } if (g3 > gm) { gm = g3; q = 3; }
        ggate[i] = 1.0f / (__expf(g0 - gm) + __expf(g1 - gm) + __expf(g2 - gm) + __expf(g3 - gm)); gi[i] = __builtin_amdgcn_readfirstlane(q); }
    float el[R][8];
#pragma unroll
    for (int c = 0; c < 8; ++c) {
#pragma unroll
        for (int i = 0; i < R; ++i) { const f32x4* wp = (const f32x4*)(a.wt + (size_t)(4 + gi[i] * 8 + c) * DM) + lane; float acc = 0.f;
#pragma unroll
            for (int j = 0; j < 8; ++j) { const f32x4 w = wp[64 * j]; acc += (v[i][j].x * w.x + v[i][j].y * w.y) + (v[i][j].z * w.z + v[i][j].w * w.w); }
            el[i][c] = acc; }
        __builtin_amdgcn_sched_barrier(0); }
#pragma unroll
    for (int o = 1; o < 64; o <<= 1)
#pragma unroll
        for (int i = 0; i < R; ++i)
#pragma unroll
            for (int c = 0; c < 8; ++c) el[i][c] += __shfl_xor(el[i][c], o);
#pragma unroll
    for (int i = 0; i < R; ++i) { const int m = m0 + i * ms;
        int i1 = 0; float m1 = el[i][0] + a.br[gi[i] * 8];
        float ev[8];
#pragma unroll
        for (int c = 0; c < 8; ++c) ev[c] = el[i][c] + a.br[gi[i] * 8 + c];
#pragma unroll
        for (int c = 1; c < 8; ++c) if (ev[c] > m1) { m1 = ev[c]; i1 = c; }
        int i2 = -1; float m2 = -3.0e38f;
#pragma unroll
        for (int c = 0; c < 8; ++c) if (c != i1 && ev[c] > m2) { m2 = ev[c]; i2 = c; }
        const float e2 = __expf(m2 - m1); const float w1 = ggate[i] / (1.0f + e2), w2 = ggate[i] * e2 / (1.0f + e2);
        if (lane == 0) {
            const int ex1 = gi[i] * 8 + i1, ex2 = gi[i] * 8 + i2;
            const int p1 = (int)__hip_atomic_fetch_add(hist + ex1, 1u, __ATOMIC_RELAXED, __HIP_MEMORY_SCOPE_WORKGROUP), p2 = (int)__hip_atomic_fetch_add(hist + ex2, 1u, __ATOMIC_RELAXED, __HIP_MEMORY_SCOPE_WORKGROUP);
            LAS int* ri = rinfo + (lr0 + i * lrs) * 8; ri[0] = ex1; ri[1] = ex2; ri[2] = p1; ri[3] = p2; ((LAS float*)ri)[4] = w1; ((LAS float*)ri)[5] = w2; ri[6] = m;
        } }
}
__global__ void __launch_bounds__(256) k_ln1_route(const float* pre1, RouteArgs a) { ln1_route_row(pre1, a, blockIdx.x * 4 + (threadIdx.x >> 6), threadIdx.x & 63); }

__device__ __forceinline__ int row_start(const unsigned* cnt, int e) { int s = 0; for (int i = 0; i < e; ++i) s += ((int)cnt[i] + 255) & ~255; return s; }
struct P6Args { const bf16_t* h1b; const bf16_t* wgut; const bf16_t* wdt; const unsigned* cnt; const int* tokidx; bf16_t* act; bf16_t* y; };
__global__ void __launch_bounds__(256) k_moe_up(P6Args a) {
    const int wave = threadIdx.x >> 6, lane = threadIdx.x & 63, fr = lane & 15, fq = lane >> 4;
    const int R0 = blockIdx.y * 64;
    int e = 0, rs = 0;
    for (; e < NEXP; ++e) { const int n = ((int)a.cnt[e] + 255) & ~255; if (R0 < rs + n) break; rs += n; }
    if (e == NEXP) return;
    const int pos = R0 - rs + wave * 16 + fr; const int tok = pos < (int)a.cnt[e] ? a.tokidx[e * ECAP + pos] : 0;
    const int jb = blockIdx.x;
    f32x4 ag[8], au[8];
#pragma unroll
    for (int j = 0; j < 8; ++j) { ag[j] = (f32x4){0.f, 0.f, 0.f, 0.f}; au[j] = (f32x4){0.f, 0.f, 0.f, 0.f}; }
    const bf16_t* wb = a.wgut + ((size_t)e * 2048 + jb * 256) * DM;
    wave_gemm16x128(a.h1b + (size_t)tok * DM, wb, DM, DM, ag);
    wave_gemm16x128(a.h1b + (size_t)tok * DM, wb + (size_t)128 * DM, DM, DM, au);
#pragma unroll
    for (int r = 0; r < 4; ++r) { const size_t row = (size_t)R0 + wave * 16 + fq * 4 + r;
#pragma unroll
        for (int j = 0; j < 8; ++j) { const float g = ag[j][r], u = au[j][r]; a.act[row * FF + jb * 128 + 16 * j + fr] = f2bf(g / (1.0f + __expf(-g)) * u); } }
}
__global__ void __launch_bounds__(256) k_moe_down(P6Args a) {
    const int wave = threadIdx.x >> 6, lane = threadIdx.x & 63, fr = lane & 15, fq = lane >> 4;
    const int R0 = blockIdx.y * 64;
    int e = 0, rs = 0;
    for (; e < NEXP; ++e) { const int n = ((int)a.cnt[e] + 255) & ~255; if (R0 < rs + n) break; rs += n; }
    if (e == NEXP) return;
    f32x4 acc[8];
#pragma unroll
    for (int j = 0; j < 8; ++j) acc[j] = (f32x4){0.f, 0.f, 0.f, 0.f};
    wave_gemm16x128(a.act + ((size_t)R0 + wave * 16 + fr) * FF, a.wdt + ((size_t)e * 2048 + blockIdx.x * 128) * FF, FF, FF, acc);
#pragma unroll
    for (int r = 0; r < 4; ++r) { const size_t row = (size_t)R0 + wave * 16 + fq * 4 + r;
#pragma unroll
        for (int j = 0; j < 8; ++j) a.y[row * DM + blockIdx.x * 128 + 16 * j + fr] = f2bf(acc[j][r]); }
}
struct P8Args { const float* h1; const bf16_t* y; const unsigned* cnt; const int* slot; const float* g; const float* b; float* out; };
__device__ __forceinline__ void final_row(const P8Args& a, int m, int lane, size_t r1, size_t r2, float w1, float w2) {
    f32x4 v[8]; float s = 0.f;
#pragma unroll
    for (int j = 0; j < 8; ++j) { const int c = 4 * lane + 256 * j; const f32x4 hv = *(const f32x4*)(a.h1 + (size_t)m * DM + c);
        const uint2 ya = *(const uint2*)(a.y + r1 * DM + c), yb = *(const uint2*)(a.y + r2 * DM + c);
        f32x4 f; f.x = w1 * bflo(ya.x) + w2 * bflo(yb.x); f.y = w1 * bfhi(ya.x) + w2 * bfhi(yb.x); f.z = w1 * bflo(ya.y) + w2 * bflo(yb.y); f.w = w1 * bfhi(ya.y) + w2 * bfhi(yb.y);
        v[j] = hv * ALPHA + f; s += (v[j].x + v[j].y) + (v[j].z + v[j].w); }
    const float mean = wave_sum(s) * (1.0f / DM); float s2 = 0.f;
#pragma unroll
    for (int j = 0; j < 8; ++j) { v[j] = v[j] - mean; s2 += (v[j].x * v[j].x + v[j].y * v[j].y) + (v[j].z * v[j].z + v[j].w * v[j].w); }
    const float rstd = 1.0f / sqrtf(wave_sum(s2) * (1.0f / DM) + LN_EPS);
#pragma unroll
    for (int j = 0; j < 8; ++j) { const int c = 4 * lane + 256 * j; const f32x4 gg = *(const f32x4*)(a.g + c), bb = *(const f32x4*)(a.b + c);
        *(f32x4*)(a.out + (size_t)m * DM + c) = v[j] * rstd * gg + bb; }
}
__global__ void __launch_bounds__(256) k_final(P8Args a) {
    const int lane = threadIdx.x & 63, m = blockIdx.x * 4 + (threadIdx.x >> 6);
    const int* sl = a.slot + (size_t)m * 6; const int e1 = sl[0], e2 = sl[1], p1 = sl[2], p2 = sl[3]; const float w1 = ((const float*)sl)[4], w2 = ((const float*)sl)[5];
    final_row(a, m, lane, (size_t)row_start(a.cnt, e1) + p1, (size_t)row_start(a.cnt, e2) + p2, w1, w2);
}

namespace pg8 {
constexpr int BM = 256, BK = 64, HALF = 128, HTB = HALF * BK * 2  , STAGE_BYTES = 8 * HTB;
__device__ __forceinline__ int lds_byte(int r, int c) { const int st = (r >> 4) * 2 + (c >> 5), rr = r & 15, cc = c & 31, ob = rr * 64 + cc * 2; return st * 1024 + (ob ^ (((ob >> 9) & 1) << 5)); }
__device__ __forceinline__ void stage_rc(int b, int& R, int& C) { const int st = b / 1024, sb = b % 1024, swz = sb ^ (((sb >> 9) & 1) << 5); R = (st >> 1) * 16 + swz / 64; C = (st & 1) * 32 + (swz % 64) / 2; }

struct Unit { const char* A; const char* B; unsigned lda, ldb; int nt; int pm, pn, aux; const int* gidx; int gcnt; };
struct Voff { unsigned a[2][2], b[2][2]; };
__device__ __forceinline__ int brow_perm8(int h, int R) { return 128 * h + (R & ~31) + 8 * ((R >> 2) & 3) + 4 * ((R >> 4) & 1) + (R & 3); }
__device__ __forceinline__ int brow_rope(int h, int R) { return 128 * (R >> 6) + 64 * h + 32 * ((R >> 5) & 1) + 8 * ((R >> 2) & 3) + 4 * ((R >> 4) & 1) + (R & 3); }

template <class Epi> __device__ __forceinline__ void make_voff(const Unit& u, Voff& v, int tid) {
#pragma unroll
    for (int i = 0; i < 2; ++i) { int R, C; stage_rc(tid * 16 + i * 8192, R, C);
#pragma unroll
        for (int h = 0; h < 2; ++h) {
            int ra = h * HALF + R;
            if (u.gidx) ra = (ra < u.gcnt) ? u.gidx[ra] : 0;
            v.a[h][i] = (unsigned)ra * u.lda + (unsigned)C * 2u;
            v.b[h][i] = (unsigned)Epi::brow(h, R) * u.ldb + (unsigned)C * 2u;
        } }
}

template <class Epi, class Sched, bool ALIGN_EPI, bool SP2>
__device__ __forceinline__ void gemm_phase(LAS unsigned char* lds, LAS unsigned char* ex, const Sched& S, const Epi& E, int wid) {
    const int lane = lane_id(), tid = wid * 64 + lane, wr = wid >> 2, wc = wid & 3, fr = lane & 15, fq = lane >> 4;
    const unsigned ldsw = (unsigned)wid * 1024u;
    const int aoff = lds_byte(wr * 64 + fr, fq * 8), boff = lds_byte(wc * 32 + fr, fq * 8);
#define PG8_SA(b, h) (((b) * 2 + (h)) * HTB)
#define PG8_SB(b, h) ((4 + (b) * 2 + (h)) * HTB)
#define PG8_STAGE(bufoff, gbase, voff) do { _Pragma("unroll") for (int _i = 0; _i < 2; ++_i) \
        __builtin_amdgcn_global_load_lds((const unsigned*)((const char*)(gbase) + (voff)[_i]), (LAS unsigned*)(lds + (bufoff) + ldsw + _i * 8192), 16, 0, 0); } while (0)
#define PG8_LDA(dst, b, h) do { _Pragma("unroll") for (int m = 0; m < 4; ++m) _Pragma("unroll") for (int k = 0; k < 2; ++k) dst[m][k] = *(const LAS bf16x8*)(lds + PG8_SA(b, h) + aoff + m * 2048 + k * 1024); } while (0)
#define PG8_LDB(dst, b, h) do { _Pragma("unroll") for (int n = 0; n < 2; ++n) _Pragma("unroll") for (int k = 0; k < 2; ++k) dst[n][k] = *(const LAS bf16x8*)(lds + PG8_SB(b, h) + boff + n * 2048 + k * 1024); } while (0)
#define PG8_MMA(ai, bj, At, Bt) do { __builtin_amdgcn_s_setprio(1); _Pragma("unroll") for (int m = 0; m < 4; ++m) _Pragma("unroll") for (int n = 0; n < 2; ++n) _Pragma("unroll") for (int k = 0; k < 2; ++k) \
        acc[ai][bj][m][n] = __builtin_amdgcn_mfma_f32_16x16x32_bf16(Bt[n][k], At[m][k], acc[ai][bj][m][n], 0, 0, 0); __builtin_amdgcn_s_setprio(0); } while (0)
#define PG8_WAIT_V(n) asm volatile("s_waitcnt vmcnt(" #n ")" ::: "memory")
#define PG8_WAIT_L(n) asm volatile("s_waitcnt lgkmcnt(" #n ")" ::: "memory")
#define PG8_BAR __builtin_amdgcn_s_barrier()
#define PG8_SCHED __builtin_amdgcn_sched_barrier(0)
    Unit cur, nxt; int ui = 0;
    if (!S.next(0, cur)) return;
    Voff vo, nvo;
    make_voff<Epi>(cur, vo, tid);
    f32x4 acc[2][2][4][2];
#pragma unroll
    for (int a = 0; a < 2; ++a)
#pragma unroll
        for (int b = 0; b < 2; ++b)
#pragma unroll
            for (int m = 0; m < 4; ++m)
#pragma unroll
                for (int n = 0; n < 2; ++n) acc[a][b][m][n] = (f32x4){0.f, 0.f, 0.f, 0.f};
    bf16x8 At[4][2], B0[2][2], B1[2][2];
    const char* cA = cur.A; const char* cB = cur.B;
    const size_t kstep = (size_t)(BK * 2);
    if constexpr (SP2) {
        PG8_STAGE(PG8_SB(0, 0), cB, vo.b[0]); PG8_STAGE(PG8_SB(0, 1), cB, vo.b[1]); PG8_STAGE(PG8_SA(0, 0), cA, vo.a[0]); PG8_STAGE(PG8_SA(0, 1), cA, vo.a[1]);
        if (wr == 1) PG8_BAR;
        PG8_WAIT_V(2); PG8_BAR;
        PG8_STAGE(PG8_SB(1, 0), cB + kstep, vo.b[0]); PG8_STAGE(PG8_SA(1, 0), cA + kstep, vo.a[0]); PG8_STAGE(PG8_SB(1, 1), cB + kstep, vo.b[1]);
        PG8_WAIT_V(6); PG8_BAR;
    } else {
        PG8_STAGE(PG8_SB(0, 0), cB, vo.b[0]); PG8_STAGE(PG8_SA(0, 0), cA, vo.a[0]); PG8_STAGE(PG8_SB(0, 1), cB, vo.b[1]); PG8_STAGE(PG8_SA(0, 1), cA, vo.a[1]);
        if (wr == 1) PG8_BAR;
        PG8_WAIT_V(4); PG8_BAR;
        PG8_STAGE(PG8_SB(1, 0), cB + kstep, vo.b[0]); PG8_STAGE(PG8_SA(1, 0), cA + kstep, vo.a[0]); PG8_STAGE(PG8_SB(1, 1), cB + kstep, vo.b[1]);
        PG8_WAIT_V(6); PG8_BAR;
    }
    for (;;) {
        const bool has_next = S.next(ui + 1, nxt);
        if (has_next) make_voff<Epi>(nxt, nvo, tid); else nvo = vo;
        const char* nA = has_next ? nxt.A : cA; const char* nB = has_next ? nxt.B : cB;
        const int nt = cur.nt;
        for (int t = 0; t < nt; t += 2) {
            const bool last = (t == nt - 2);
            const char* a1 = cA + (size_t)(t + 1) * kstep;
            const char* a2 = last ? nA : cA + (size_t)(t + 2) * kstep; const char* b2 = last ? nB : cB + (size_t)(t + 2) * kstep;
            const char* a3 = a2 + kstep; const char* b3 = b2 + kstep;
            Voff w;
#pragma unroll
            for (int h = 0; h < 2; ++h)
#pragma unroll
                for (int i = 0; i < 2; ++i) { w.a[h][i] = last ? nvo.a[h][i] : vo.a[h][i]; w.b[h][i] = last ? nvo.b[h][i] : vo.b[h][i]; }
            if constexpr (SP2) {
            PG8_LDB(B0, 0, 0); PG8_LDB(B1, 0, 1); PG8_SCHED; PG8_LDA(At, 0, 0); PG8_STAGE(PG8_SA(1, 1), a1, vo.a[1]);
            PG8_WAIT_V(8); PG8_WAIT_L(0); PG8_BAR; PG8_MMA(0, 0, At, B0); PG8_MMA(0, 1, At, B1); PG8_BAR; PG8_SCHED;
            PG8_LDA(At, 0, 1); PG8_STAGE(PG8_SB(0, 0), b2, w.b[0]); PG8_STAGE(PG8_SB(0, 1), b2, w.b[1]); PG8_STAGE(PG8_SA(0, 0), a2, w.a[0]);
            PG8_WAIT_V(8); PG8_WAIT_L(0); PG8_BAR; PG8_MMA(1, 0, At, B0); PG8_MMA(1, 1, At, B1); PG8_BAR; PG8_SCHED;
            PG8_LDB(B0, 1, 0); PG8_LDB(B1, 1, 1); PG8_SCHED; PG8_LDA(At, 1, 0); PG8_STAGE(PG8_SA(0, 1), a2, w.a[1]);
            PG8_WAIT_V(8); PG8_WAIT_L(0); PG8_BAR; PG8_MMA(0, 0, At, B0); PG8_MMA(0, 1, At, B1); PG8_BAR; PG8_SCHED;
            PG8_LDA(At, 1, 1); PG8_STAGE(PG8_SB(1, 0), b3, w.b[0]); PG8_STAGE(PG8_SB(1, 1), b3, w.b[1]); PG8_STAGE(PG8_SA(1, 0), a3, w.a[0]);
            PG8_WAIT_V(8); PG8_WAIT_L(0); PG8_BAR; PG8_MMA(1, 0, At, B0); PG8_MMA(1, 1, At, B1); PG8_BAR; PG8_SCHED;
            } else {
            PG8_LDB(B0, 0, 0); PG8_SCHED; PG8_LDA(At, 0, 0); PG8_STAGE(PG8_SA(1, 1), a1, vo.a[1]);
            PG8_WAIT_L(8); PG8_BAR; PG8_WAIT_L(0); PG8_MMA(0, 0, At, B0); PG8_BAR; PG8_SCHED;
            PG8_LDB(B1, 0, 1); PG8_STAGE(PG8_SB(0, 0), b2, w.b[0]);
            PG8_BAR; PG8_WAIT_L(0); PG8_MMA(0, 1, At, B1); PG8_BAR;
            PG8_LDA(At, 0, 1); PG8_STAGE(PG8_SA(0, 0), a2, w.a[0]);
            PG8_BAR; PG8_WAIT_L(0); PG8_MMA(1, 0, At, B0); PG8_BAR; PG8_SCHED;
            PG8_STAGE(PG8_SB(0, 1), b2, w.b[1]);
            PG8_WAIT_V(6); PG8_BAR; PG8_MMA(1, 1, At, B1); PG8_BAR;
            PG8_LDB(B0, 1, 0); PG8_SCHED; PG8_LDA(At, 1, 0); PG8_STAGE(PG8_SA(0, 1), a2, w.a[1]);
            PG8_WAIT_L(8); PG8_BAR; PG8_WAIT_L(0); PG8_MMA(0, 0, At, B0); PG8_BAR; PG8_SCHED;
            PG8_LDB(B1, 1, 1); PG8_STAGE(PG8_SB(1, 0), b3, w.b[0]);
            PG8_BAR; PG8_WAIT_L(0); PG8_MMA(0, 1, At, B1); PG8_BAR;
            PG8_LDA(At, 1, 1); PG8_STAGE(PG8_SA(1, 0), a3, w.a[0]);
            PG8_BAR; PG8_WAIT_L(0); PG8_MMA(1, 0, At, B0); PG8_BAR; PG8_SCHED;
            PG8_STAGE(PG8_SB(1, 1), b3, w.b[1]);
            PG8_WAIT_V(6); PG8_BAR; PG8_MMA(1, 1, At, B1); PG8_BAR;
            }
        }
        if constexpr (ALIGN_EPI) { if (wr == 0) PG8_BAR; }
        E(acc, cur, wr, wc, fr, fq, ex);
        if (!has_next) break;
#pragma unroll
        for (int a = 0; a < 2; ++a)
#pragma unroll
            for (int b = 0; b < 2; ++b)
#pragma unroll
                for (int m = 0; m < 4; ++m)
#pragma unroll
                    for (int n = 0; n < 2; ++n) acc[a][b][m][n] = (f32x4){0.f, 0.f, 0.f, 0.f};
        cur = nxt; cA = nA; cB = nB; vo = nvo; ++ui;
        if constexpr (ALIGN_EPI) { if (wr == 1) PG8_BAR; }
    }
    PG8_WAIT_V(0);
    if constexpr (!ALIGN_EPI) { if (wr == 0) PG8_BAR; }
    PG8_BAR;
#undef PG8_SA
#undef PG8_SB
#undef PG8_STAGE
#undef PG8_LDA
#undef PG8_LDB
#undef PG8_MMA
#undef PG8_WAIT_V
#undef PG8_WAIT_L
#undef PG8_BAR
#undef PG8_SCHED
}

struct TileOrder {
    int nM, nN, nwg, G, c;
    __device__ void init(int M, int N, int G_, int c_) { nM = M / BM; nN = N / BM; nwg = nM * nN; G = G_; c = c_; }
    __device__ bool tile(int i, int& pm, int& pn) const {
        const long L = (long)i * G + c; if (L >= nwg) return false;
        int wgid = (int)L; { const int q = nwg / 8, r = nwg % 8, xcd = wgid % 8, off = wgid / 8; wgid = (xcd < r ? xcd * (q + 1) : r * (q + 1) + (xcd - r) * q) + off; }
        const int nig = 8 * nN, gid = wgid / nig, fm = gid * 8, gsz = (nM - fm) < 8 ? (nM - fm) : 8;
        pm = fm + ((wgid % nig) % gsz); pn = (wgid % nig) / gsz; return true;
    }
};
}

typedef float f32x2 __attribute__((ext_vector_type(2)));
#define ACC_T f32x4 (&acc)[2][2][4][2]

struct EpiProj {
    __device__ static __forceinline__ int brow(int h, int R) { return pg8::brow_rope(h, R); }
    unsigned char* ws; const float *qg, *kg;
    __device__ static __forceinline__ void rot4(const f32x4 x1, const f32x4 x2, const f32x4 t0, const f32x4 t1, f32x4& y1, f32x4& y2) {
        y1.x = x1.x * t0.x - x2.x * t0.y; y2.x = x2.x * t0.x + x1.x * t0.y;
        y1.y = x1.y * t0.z - x2.y * t0.w; y2.y = x2.y * t0.z + x1.y * t0.w;
        y1.z = x1.z * t1.x - x2.z * t1.y; y2.z = x2.z * t1.x + x1.z * t1.y;
        y1.w = x1.w * t1.z - x2.w * t1.w; y2.w = x2.w * t1.z + x1.w * t1.w;
    }
    __device__ static __forceinline__ void store8(bf16_t* dst, const f32x4 a, const f32x4 b) {
        u32x4 w; w.x = cvtpk(a.x, a.y); w.y = cvtpk(a.z, a.w); w.z = cvtpk(b.x, b.y); w.w = cvtpk(b.z, b.w); *(u32x4*)dst = w; }
    __device__ __forceinline__ void operator()(ACC_T, const pg8::Unit& u, int wr, int wc, int fr, int fq, LAS unsigned char* ex) const {
        const int ng = 2 * u.pn + (wc >> 1), c0 = 32 * (wc & 1) + 8 * fq;
        if (ng < 72) {
            const int which = ng / 24, hh = ng % 24, g = hh >> 3, h = hh & 7;
            bf16_t* buf = (bf16_t*)(ws + WS_QA + (size_t)which * (WS_KA - WS_QA));
            const float2* rt1 = (const float2*)(ws + WS_RT1);
#pragma unroll
            for (int ai = 0; ai < 2; ++ai)
#pragma unroll
                for (int m = 0; m < 4; ++m) {
                    const int mrow = u.pm * 256 + ai * 128 + wr * 64 + m * 16 + fr, b = mrow >> 12, t = mrow & 4095;
                    bf16_t* dst = buf + ((size_t)((g * 2 + b) * 8 + h) * SEQ + perm_pos(g, t)) * HD + c0;
                    f32x4 y1a = acc[ai][0][m][0], y1b = acc[ai][0][m][1], y2a = acc[ai][1][m][0], y2b = acc[ai][1][m][1];
                    if (which < 2) {
                        const f32x4* tp = (const f32x4*)(rt1 + (size_t)t * 64 + c0);
                        const f32x4 t0 = tp[0], t1 = tp[1], t2 = tp[2], t3 = tp[3];
                        rot4(acc[ai][0][m][0], acc[ai][1][m][0], t0, t1, y1a, y2a); rot4(acc[ai][0][m][1], acc[ai][1][m][1], t2, t3, y1b, y2b);
                    }
                    store8(dst, y1a, y1b); store8(dst + 64, y2a, y2b);
                }
        } else if (ng < 92) {
            const int k = ng - 72;
            LAS float* X = (LAS float*)ex;
#pragma unroll
            for (int ai = 0; ai < 2; ++ai)
#pragma unroll
                for (int m = 0; m < 4; ++m) { float s = 0.f;
#pragma unroll
                    for (int bj = 0; bj < 2; ++bj)
#pragma unroll
                        for (int n = 0; n < 2; ++n) { const f32x4 x = acc[ai][bj][m][n]; s += (x.x * x.x + x.y * x.y) + (x.z * x.z + x.w * x.w); }
                    s += __shfl_xor(s, 16); s += __shfl_xor(s, 32);
                    if (fq == 0) X[(ai * 128 + wr * 64 + m * 16 + fr) * 4 + wc] = s; }
            asm volatile("s_waitcnt lgkmcnt(0)" ::: "memory"); __builtin_amdgcn_s_barrier(); asm volatile("" ::: "memory");
            const float* gn = (k < 16) ? qg : kg; const float2* rt2 = (const float2*)(ws + WS_RT2);
            bf16_t* qb = (bf16_t*)(ws + WS_QB); bf16_t* kb = (bf16_t*)(ws + WS_KB);
            const f32x4 g1a = *(const f32x4*)(gn + c0), g1b = *(const f32x4*)(gn + c0 + 4), g2a = *(const f32x4*)(gn + 64 + c0), g2b = *(const f32x4*)(gn + 64 + c0 + 4);
#pragma unroll
            for (int ai = 0; ai < 2; ++ai)
#pragma unroll
                for (int m = 0; m < 4; ++m) {
                    const int r = ai * 128 + wr * 64 + m * 16 + fr;
                    const float ssum = X[r * 4 + (wc & 2)] + X[r * 4 + (wc & 2) + 1];
                    const int mrow = u.pm * 256 + r, b = mrow >> 12, t = mrow & 4095;
                    bf16_t* dst = ((k < 16) ? qb + ((size_t)(b * 16 + k) * SEQ + t) * HD : kb + ((size_t)(b * 4 + (k - 16)) * SEQ + t) * HD) + c0;
                    const float rinv = 1.0f / sqrtf(ssum * (1.0f / 128.0f) + RMS_EPS);
                    const f32x4* tp = (const f32x4*)(rt2 + (size_t)t * 64 + c0);
                    const f32x4 t0 = tp[0], t1 = tp[1], t2 = tp[2], t3 = tp[3];
                    f32x4 y1a, y1b, y2a, y2b;
                    rot4(acc[ai][0][m][0] * rinv * g1a, acc[ai][1][m][0] * rinv * g2a, t0, t1, y1a, y2a); rot4(acc[ai][0][m][1] * rinv * g1b, acc[ai][1][m][1] * rinv * g2b, t2, t3, y1b, y2b);
                    store8(dst, y1a, y1b); store8(dst + 64, y2a, y2b);
                }
        } else {
#pragma unroll
            for (int ai = 0; ai < 2; ++ai)
#pragma unroll
                for (int m = 0; m < 4; ++m) {
                    const int mrow = u.pm * 256 + ai * 128 + wr * 64 + m * 16 + fr, b = mrow >> 12, t = mrow & 4095;
                    bf16_t* dst = (ng < 96 ? (bf16_t*)(ws + WS_VB) + ((size_t)(b * 4 + (ng - 92)) * SEQ + t) * HD : (bf16_t*)(ws + WS_GATES) + (size_t)mrow * 4096 + (ng - 96) * 128) + c0;
                    f32x4 y1a = acc[ai][0][m][0], y1b = acc[ai][0][m][1], y2a = acc[ai][1][m][0], y2b = acc[ai][1][m][1];
                    if (ng >= 96) {
#pragma unroll
                        for (int q = 0; q < 4; ++q) { y1a[q] = __builtin_amdgcn_rcpf(1.0f + __expf(-y1a[q])); y1b[q] = __builtin_amdgcn_rcpf(1.0f + __expf(-y1b[q]));
                            y2a[q] = __builtin_amdgcn_rcpf(1.0f + __expf(-y2a[q])); y2b[q] = __builtin_amdgcn_rcpf(1.0f + __expf(-y2b[q])); } }
                    store8(dst, y1a, y1b); store8(dst + 64, y2a, y2b);
                }
        }
    }
};
struct ProjSched {
    pg8::TileOrder o; const char* ws;
    __device__ __forceinline__ bool next(int i, pg8::Unit& u) const { int pm, pn; if (!o.tile(i, pm, pn)) return false;
        u.A = ws + WS_XB + (size_t)pm * 256 * (DM * 2); u.B = ws + WS_WINT + (size_t)pn * 256 * (DM * 2); u.lda = DM * 2; u.ldb = DM * 2; u.nt = DM / 64; u.pm = pm; u.pn = pn; u.aux = 0; u.gidx = nullptr; u.gcnt = 0; return true; }
};

struct EpiMix {
    __device__ static __forceinline__ int brow(int h, int R) { return pg8::brow_perm8(h, R); }
    unsigned char* ws; const float* x;
    __device__ __forceinline__ void operator()(ACC_T, const pg8::Unit& u, int wr, int wc, int fr, int fq, LAS unsigned char* ex) const {
        const bf16_t* gates = (const bf16_t*)(ws + WS_GATES); float* T = (float*)(ws + WS_T); bf16_t* merged = (bf16_t*)(ws + WS_MERGED); float* pre1 = (float*)(ws + WS_PRE1);
#pragma unroll
        for (int ai = 0; ai < 2; ++ai)
#pragma unroll
            for (int m = 0; m < 4; ++m) { const size_t mrow = (size_t)u.pm * 256 + ai * 128 + wr * 64 + m * 16 + fr;
#pragma unroll
                for (int bj = 0; bj < 2; ++bj) { const int col = u.pn * 256 + bj * 128 + wc * 32 + 8 * fq; const size_t o = mrow * DM + col;
                    const f32x4 a0 = acc[ai][bj][m][0], a1 = acc[ai][bj][m][1];
                    if (u.aux == 2) {
                        const f32x4 x0 = *(const f32x4*)(x + o), x1 = *(const f32x4*)(x + o + 4);
                        *(f32x4*)(pre1 + o) = x0 * ALPHA + a0; *(f32x4*)(pre1 + o + 4) = x1 * ALPHA + a1;
                    } else {
                        const u32x4 gw = *(const u32x4*)(gates + mrow * 4096 + (u.aux ? 2048 : 0) + col);
                        f32x4 g0, g1; g0.x = bflo(gw.x); g0.y = bfhi(gw.x); g0.z = bflo(gw.y); g0.w = bfhi(gw.y); g1.x = bflo(gw.z); g1.y = bfhi(gw.z); g1.z = bflo(gw.w); g1.w = bfhi(gw.w);
                        if (u.aux == 0) { *(f32x4*)(T + o) = g0 * a0; *(f32x4*)(T + o + 4) = g1 * a1; }
                        else { const f32x4 t0 = *(const f32x4*)(T + o) + g0 * a0, t1 = *(const f32x4*)(T + o + 4) + g1 * a1;
                            u32x4 w; w.x = cvtpk(t0.x, t0.y); w.y = cvtpk(t0.z, t0.w); w.z = cvtpk(t1.x, t1.y); w.w = cvtpk(t1.z, t1.w); *(u32x4*)(merged + o) = w; }
                    } } }
    }
};
struct MixSched {
    int mode, c; const char* ws;
    __device__ __forceinline__ bool next(int i, pg8::Unit& u) const {
        if (c >= 256) return false;
        const int pm = c >> 3, pn = c & 7; u.pm = pm; u.pn = pn; u.gidx = nullptr; u.gcnt = 0;
        if (mode == 0) { if (i > 1) return false;
            if (i == 0) { u.A = ws + WS_OA + (size_t)pm * 256 * 2048; u.B = ws + WS_WAT + (size_t)pn * 256 * 2048; u.lda = 2048; u.ldb = 2048; u.nt = 16; u.aux = 0; }
            else { u.A = ws + WS_OB + (size_t)pm * 256 * 4096; u.B = ws + WS_WBT + (size_t)pn * 256 * 4096; u.lda = 4096; u.ldb = 4096; u.nt = 32; u.aux = 1; }
            return true; }
        if (i > 0) return false;
        u.A = ws + WS_MERGED + (size_t)pm * 256 * 4096; u.B = ws + WS_WOT + (size_t)pn * 256 * 4096; u.lda = 4096; u.ldb = 4096; u.nt = 32; u.aux = 2; return true;
    }
};

struct MoeSched {
    int G, vcu, down; unsigned cnt_l, tpe_l;
    const char* ws;
    __device__ __forceinline__ void init(const unsigned* cnt, int lane) {
        unsigned c = 0; if (lane < NEXP) c = __hip_atomic_load(cnt + lane, __ATOMIC_RELAXED, __HIP_MEMORY_SCOPE_AGENT);
        unsigned t = (c + 255u) >> 8, inc = t;
#pragma unroll
        for (int o = 1; o < 32; o <<= 1) { const unsigned v = __shfl_up(inc, o); if ((lane & 31) >= o) inc += v; }
        cnt_l = c; tpe_l = inc - t;
    }
    __device__ __forceinline__ bool next(int i, pg8::Unit& u) const {
        const int lane = lane_id();
        const int total = (int)__builtin_amdgcn_readfirstlane(__shfl(tpe_l + ((cnt_l + 255u) >> 8), 31));
        const int L = i * G + vcu; if (L >= total * 8) return false;
        const int tg = L >> 3;
        const unsigned long long mk = __ballot(lane < NEXP && (int)tpe_l <= tg && (cnt_l > 0u));
        const int e = 63 - __builtin_clzll(mk);
        const int tp = (int)__builtin_amdgcn_readfirstlane(__shfl(tpe_l, e)), ce = (int)__builtin_amdgcn_readfirstlane(__shfl(cnt_l, e));
        const int te = (ce + 255) >> 8, q = L - 8 * tp, j = q / te, mt = q - j * te;
        u.pm = tp + mt; u.pn = j; u.aux = e; u.nt = down ? 16 : 32;
        if (!down) { u.A = ws + WS_H1B; u.lda = DM * 2; u.gidx = (const int*)(ws + WS_TOKIDX) + (size_t)e * ECAP + 256 * mt; u.gcnt = ce - 256 * mt; u.B = ws + WS_WGUT + ((size_t)e * 2048 + j * 256) * (DM * 2); u.ldb = DM * 2; }
        else { u.A = ws + WS_ACT + (size_t)(tp + mt) * 256 * (FF * 2); u.lda = FF * 2; u.gidx = nullptr; u.gcnt = 0; u.B = ws + WS_WDT + ((size_t)e * 2048 + j * 256) * (FF * 2); u.ldb = FF * 2; }
        return true;
    }
};
struct EpiMoe {
    __device__ static __forceinline__ int brow(int h, int R) { return pg8::brow_perm8(h, R); }
    int down; unsigned char* ws;
    __device__ __forceinline__ void operator()(ACC_T, const pg8::Unit& u, int wr, int wc, int fr, int fq, LAS unsigned char* ex) const {
        bf16_t* act = (bf16_t*)(ws + WS_ACT); bf16_t* y = (bf16_t*)(ws + WS_Y);
#pragma unroll
        for (int ai = 0; ai < 2; ++ai)
#pragma unroll
            for (int m = 0; m < 4; ++m) { const size_t row = (size_t)u.pm * 256 + ai * 128 + wr * 64 + m * 16 + fr;
                if (!down) {
                    f32x4 v0, v1;
#pragma unroll
                    for (int q = 0; q < 4; ++q) { const float g0 = acc[ai][0][m][0][q], u0 = acc[ai][1][m][0][q], g1 = acc[ai][0][m][1][q], u1 = acc[ai][1][m][1][q];
                        v0[q] = g0 * __builtin_amdgcn_rcpf(1.0f + __expf(-g0)) * u0; v1[q] = g1 * __builtin_amdgcn_rcpf(1.0f + __expf(-g1)) * u1; }
                    u32x4 w; w.x = cvtpk(v0.x, v0.y); w.y = cvtpk(v0.z, v0.w); w.z = cvtpk(v1.x, v1.y); w.w = cvtpk(v1.z, v1.w);
                    *(u32x4*)(act + row * FF + u.pn * 128 + wc * 32 + 8 * fq) = w;
                } else {
#pragma unroll
                    for (int bj = 0; bj < 2; ++bj) { const f32x4 a0 = acc[ai][bj][m][0], a1 = acc[ai][bj][m][1];
                        u32x4 w; w.x = cvtpk(a0.x, a0.y); w.y = cvtpk(a0.z, a0.w); w.z = cvtpk(a1.x, a1.y); w.w = cvtpk(a1.z, a1.w);
                        *(u32x4*)(y + row * DM + u.pn * 256 + bj * 128 + wc * 32 + 8 * fq) = w; }
                } }
    }
};


namespace mg {
constexpr int HTB = 16384, ABUF = 2 * HTB, BBUF = 64 * 256, B_OFF = 3 * ABUF;
struct Unit { const char* A; unsigned lda; const int* gidx; int gcnt; const float* B0; const float* B1; unsigned ldbf; int nt, up, pm, pn; };
typedef short v4i16_t __attribute__((ext_vector_type(4)));
template <int OFF> __device__ __forceinline__ s16x4 vtr(int addr) { s16x4 r; asm volatile("ds_read_b64_tr_b16 %0, %1 offset:%2" : "=&v"(r) : "v"(addr), "i"(OFF) : "memory"); return r; }
#define MG_ACC_T f32x4 (&acc)[2][4][2]

template <class Sched, class Epi>
__device__ __forceinline__ void gemm_phase(LAS unsigned char* lds, const Sched& S, const Epi& E, int wid) {
    const int lane = lane_id(), tid = wid * 64 + lane, wr = wid >> 2, wc = wid & 3, fr = lane & 15, fq = lane >> 4;
    const unsigned ldsw = (unsigned)wid * 1024u;
    const int aoff = pg8::lds_byte(wr * 64 + fr, fq * 8);
    const int n4 = tid & 31, kr = tid >> 5;
    const int tq = (lane & 15) >> 2, tp = lane & 3, tf = tq | ((fq & 1) << 2);
    const int ldsa = (int)(unsigned)(uintptr_t)lds;
    const int tb0 = B_OFF + (8 * fq + tq) * 256 + (((2 * wc) ^ tf) * 32) + 8 * tp, tb1 = B_OFF + (8 * fq + tq) * 256 + (((2 * wc + 1) ^ tf) * 32) + 8 * tp;
    const int wfk = (kr & 3) | (((kr >> 3) & 1) << 2);
#define MG_STAGE_A(slot, tt) do { _Pragma("unroll") for (int h_ = 0; h_ < 2; ++h_) _Pragma("unroll") for (int i_ = 0; i_ < 2; ++i_) \
        __builtin_amdgcn_global_load_lds((const unsigned*)(u.A + (size_t)(tt) * 128 + voffA[h_][i_]), (LAS unsigned*)(lds + (slot) * ABUF + h_ * HTB + ldsw + i_ * 8192), 16, 0, 0); } while (0)
#define MG_LOADB(R, tt) do { const float* p_ = bp + (size_t)(tt) * 64 * u.ldbf; \
        asm volatile("global_load_dwordx4 %0, %1, off" : "=v"(R##0) : "v"(p_) : "memory"); \
        asm volatile("global_load_dwordx4 %0, %1, off" : "=v"(R##1) : "v"(p_ + (size_t)16 * u.ldbf) : "memory"); \
        asm volatile("global_load_dwordx4 %0, %1, off" : "=v"(R##2) : "v"(p_ + (size_t)32 * u.ldbf) : "memory"); \
        asm volatile("global_load_dwordx4 %0, %1, off" : "=v"(R##3) : "v"(p_ + (size_t)48 * u.ldbf) : "memory"); } while (0)
#define MG_WAITB(R, N) asm volatile("s_waitcnt vmcnt(" #N ")" : "+v"(R##0), "+v"(R##1), "+v"(R##2), "+v"(R##3) :: "memory")
#define MG_PK(v) (u32x2){cvtpk((v).x, (v).y), cvtpk((v).z, (v).w)}
#define MG_WRITEB(R, slot) do { LAS unsigned char* w_ = lds + B_OFF + (slot) * BBUF + wa; \
        *(LAS u32x2*)(w_) = MG_PK(R##0); *(LAS u32x2*)(w_ + 4096) = MG_PK(R##1); *(LAS u32x2*)(w_ + 8192) = MG_PK(R##2); *(LAS u32x2*)(w_ + 12288) = MG_PK(R##3); } while (0)
#define MG_WAITV(N) asm volatile("s_waitcnt vmcnt(" #N ")" ::: "memory")
#define MG_ITER(t, R) do { const int t_ = (t); \
        if (t_ + 2 < nt) MG_STAGE_A((t_ + 2) % 3, t_ + 2); \
        if (t_ + 1 < nt) { \
            if (t_ == 0) MG_WAITB(R, 12); else if (t_ == 1 || t_ + 3 == nt) MG_WAITB(R, 16); else if (t_ + 2 == nt) MG_WAITB(R, 8); else MG_WAITB(R, 20); \
            MG_WRITEB(R, (t_ + 1) & 1); } \
        if (t_ + 4 < nt) MG_LOADB(R, t_ + 4); \
        { const int as_ = (t_ % 3) * ABUF, ba0_ = ldsa + (t_ & 1) * BBUF + tb0, ba1_ = ldsa + (t_ & 1) * BBUF + tb1; bf16x8 Bf[2][2], At[4][2]; \
          { const s16x4 l0 = vtr<0>(ba0_), h0 = vtr<1024>(ba0_), l1 = vtr<0>(ba1_), h1 = vtr<1024>(ba1_), l2 = vtr<8192>(ba0_), h2 = vtr<9216>(ba0_), l3 = vtr<8192>(ba1_), h3 = vtr<9216>(ba1_); \
            _Pragma("unroll") for (int m = 0; m < 4; ++m) _Pragma("unroll") for (int k = 0; k < 2; ++k) At[m][k] = *(const LAS bf16x8*)(lds + as_ + aoff + m * 2048 + k * 1024); \
            asm volatile("s_waitcnt lgkmcnt(0)" ::: "memory"); __builtin_amdgcn_sched_barrier(0); \
            Bf[0][0] = (bf16x8){l0[0], l0[1], l0[2], l0[3], h0[0], h0[1], h0[2], h0[3]}; Bf[1][0] = (bf16x8){l1[0], l1[1], l1[2], l1[3], h1[0], h1[1], h1[2], h1[3]}; \
            Bf[0][1] = (bf16x8){l2[0], l2[1], l2[2], l2[3], h2[0], h2[1], h2[2], h2[3]}; Bf[1][1] = (bf16x8){l3[0], l3[1], l3[2], l3[3], h3[0], h3[1], h3[2], h3[3]}; } \
          _Pragma("unroll") for (int ai = 0; ai < 2; ++ai) { \
              if (ai == 1) { _Pragma("unroll") for (int m = 0; m < 4; ++m) _Pragma("unroll") for (int k = 0; k < 2; ++k) At[m][k] = *(const LAS bf16x8*)(lds + as_ + HTB + aoff + m * 2048 + k * 1024); } \
              __builtin_amdgcn_s_setprio(1); \
              _Pragma("unroll") for (int m = 0; m < 4; ++m) _Pragma("unroll") for (int nn = 0; nn < 2; ++nn) _Pragma("unroll") for (int k = 0; k < 2; ++k) \
                  acc[ai][m][nn] = __builtin_amdgcn_mfma_f32_16x16x32_bf16(Bf[nn][k], At[m][k], acc[ai][m][nn], 0, 0, 0); \
              __builtin_amdgcn_s_setprio(0); } } \
        if (t_ + 5 <= nt) MG_WAITV(12); else if (t_ + 4 == nt) MG_WAITV(8); else if (t_ + 3 == nt) MG_WAITV(4); else if (t_ + 2 == nt) MG_WAITV(0); \
        asm volatile("s_waitcnt lgkmcnt(0)" ::: "memory"); __builtin_amdgcn_s_barrier(); asm volatile("" ::: "memory"); } while (0)

    Unit u;
    for (int ui = 0; S.next(ui, u); ++ui) {
        const int nt = u.nt;
        unsigned voffA[2][2];
#pragma unroll
        for (int i = 0; i < 2; ++i) { int R, C; pg8::stage_rc(tid * 16 + i * 8192, R, C);
#pragma unroll
            for (int h = 0; h < 2; ++h) { int ra = h * 128 + R; if (u.gidx) ra = (ra < u.gcnt) ? u.gidx[ra] : 0; voffA[h][i] = (unsigned)ra * u.lda + (unsigned)C * 2u; } }
        const float* bp = (n4 < 16 ? u.B0 + 4 * n4 : u.B1 + 4 * (n4 - 16)) + (size_t)kr * u.ldbf;
        const int P = u.up ? (32 * ((n4 & 15) >> 2) + 16 * (n4 >> 4) + 4 * (n4 & 3)) : (32 * (n4 >> 3) + 16 * (n4 & 1) + 4 * ((n4 & 7) >> 1));
        const int wa = kr * 256 + (((P >> 4) ^ wfk) * 32) + (P & 15) * 2;
        f32x4 acc[2][4][2];
#pragma unroll
        for (int a = 0; a < 2; ++a)
#pragma unroll
            for (int m = 0; m < 4; ++m)
#pragma unroll
                for (int n = 0; n < 2; ++n) acc[a][m][n] = (f32x4){0.f, 0.f, 0.f, 0.f};
        f32x4 Ra0, Ra1, Ra2, Ra3, Rb0, Rb1, Rb2, Rb3, Rc0, Rc1, Rc2, Rc3;
        MG_STAGE_A(0, 0); MG_STAGE_A(1, 1);
        MG_LOADB(Ra, 0); MG_LOADB(Rb, 1); MG_LOADB(Rc, 2);
        MG_WAITB(Ra, 8); MG_WRITEB(Ra, 0);
        MG_LOADB(Ra, 3);
        asm volatile("s_waitcnt lgkmcnt(0)" ::: "memory"); __builtin_amdgcn_s_barrier(); asm volatile("" ::: "memory");
        for (int t = 0; t < nt; t += 3) {
            MG_ITER(t, Rb);
            if (t + 1 < nt) MG_ITER(t + 1, Rc);
            if (t + 2 < nt) MG_ITER(t + 2, Ra);
        }
        E(acc, u, wr, wc, fr, fq);
    }
#undef MG_STAGE_A
#undef MG_LOADB
#undef MG_WAITB
#undef MG_PK
#undef MG_WRITEB
#undef MG_WAITV
#undef MG_ITER
}
}

struct MoeSched2 {
    int G, vcu, down; unsigned cnt_l, tpe_l; const char* ws; const float *wgate, *wup, *wdown;
    __device__ __forceinline__ void init(const unsigned* cnt, int lane) {
        unsigned c = 0; if (lane < NEXP) c = __hip_atomic_load(cnt + lane, __ATOMIC_RELAXED, __HIP_MEMORY_SCOPE_AGENT);
        unsigned t = (c + 255u) >> 8, inc = t;
#pragma unroll
        for (int o = 1; o < 32; o <<= 1) { const unsigned v = __shfl_up(inc, o); if ((lane & 31) >= o) inc += v; }
        cnt_l = c; tpe_l = inc - t;
    }
    __device__ __forceinline__ bool next(int i, mg::Unit& u) const {
        const int lane = lane_id();
        const int total = (int)__builtin_amdgcn_readfirstlane(__shfl(tpe_l + ((cnt_l + 255u) >> 8), 31));
        const int L = i * G + vcu; if (L >= total * 16) return false;
        const int tg = L >> 4;
        const unsigned long long mk = __ballot(lane < NEXP && (int)tpe_l <= tg && (cnt_l > 0u));
        const int e = 63 - __builtin_clzll(mk);
        const int tp = (int)__builtin_amdgcn_readfirstlane(__shfl(tpe_l, e)), ce = (int)__builtin_amdgcn_readfirstlane(__shfl(cnt_l, e));
        const int te = (ce + 255) >> 8, q = L - 16 * tp, j = q / te, mt = q - j * te;
        u.pm = tp + mt; u.pn = j; u.up = down ? 0 : 1; u.nt = down ? 16 : 32;
        if (!down) { u.A = ws + WS_H1B; u.lda = DM * 2; u.gidx = (const int*)(ws + WS_TOKIDX) + (size_t)e * ECAP + 256 * mt; u.gcnt = ce - 256 * mt;
            u.B0 = wgate + (size_t)e * DM * FF + j * 64; u.B1 = wup + (size_t)e * DM * FF + j * 64; u.ldbf = FF; }
        else { u.A = ws + WS_ACT + (size_t)(tp + mt) * 256 * (FF * 2); u.lda = FF * 2; u.gidx = nullptr; u.gcnt = 0;
            u.B0 = wdown + (size_t)e * FF * DM + j * 128; u.B1 = u.B0 + 64; u.ldbf = DM; }
        return true;
    }
};
struct EpiMoe2 {
    int down; unsigned char* ws;
    __device__ __forceinline__ void operator()(f32x4 (&acc)[2][4][2], const mg::Unit& u, int wr, int wc, int fr, int fq) const {
        bf16_t* act = (bf16_t*)(ws + WS_ACT); bf16_t* y = (bf16_t*)(ws + WS_Y);
#pragma unroll
        for (int ai = 0; ai < 2; ++ai)
#pragma unroll
            for (int m = 0; m < 4; ++m) { const size_t row = (size_t)u.pm * 256 + ai * 128 + wr * 64 + m * 16 + fr;
                if (!down) { f32x4 v;
#pragma unroll
                    for (int q = 0; q < 4; ++q) { const float g = acc[ai][m][0][q], up = acc[ai][m][1][q]; v[q] = g * __builtin_amdgcn_rcpf(1.0f + __expf(-g)) * up; }
                    u32x2 w; w.x = cvtpk(v.x, v.y); w.y = cvtpk(v.z, v.w);
                    *(u32x2*)(act + row * FF + u.pn * 64 + wc * 16 + 4 * fq) = w;
                } else { const f32x4 a0 = acc[ai][m][0], a1 = acc[ai][m][1];
                    u32x4 w; w.x = cvtpk(a0.x, a0.y); w.y = cvtpk(a0.z, a0.w); w.z = cvtpk(a1.x, a1.y); w.w = cvtpk(a1.z, a1.w);
                    *(u32x4*)(y + row * DM + u.pn * 128 + wc * 32 + 8 * fq) = w; } }
    }
};

namespace att {
constexpr int D = 128, NW = 8, QBLK = 32, KVBLK = 64;
constexpr float SCALE = SM_SCALE, THR = 8.f;
constexpr int SHM_V = KVBLK * D * 2, SHM_K = KVBLK * D * 2, SHM_ATTN = 2 * SHM_V + 2 * SHM_K + NW * 64 * 4;
#define KSWZ(row, colB) ((row) * 256 + ((colB) ^ (((row) & 7) << 4)))
#define SBAR() __builtin_amdgcn_sched_barrier(0)
__device__ __forceinline__ int crow(int r, int hi) { return (r & 3) + 8 * (r >> 2) + 4 * hi; }
template <bool BAND> __device__ __forceinline__ void partialSM(f32x16& p0, f32x16& p1, float& m_reg, float& mn, float& alpha, int dv, bool tv) {
    constexpr float C = SCALE * 1.4426950408889634f;
    if constexpr (BAND) {
#pragma unroll
        for (int r = 0; r < 16; ++r) { const int kx = (r & 3) + 8 * (r >> 2);
            if (!tv || (unsigned)(dv + kx) > 128u) p0[r] = -INFINITY;
            if (!tv || (unsigned)(dv + kx + 32) > 128u) p1[r] = -INFINITY; } }
    float pmax = p0[0];
#pragma unroll
    for (int r = 1; r < 16; ++r) pmax = fmaxf(pmax, p0[r]);
#pragma unroll
    for (int r = 0; r < 16; ++r) pmax = fmaxf(pmax, p1[r]);
    { auto rr = __builtin_amdgcn_permlane32_swap(__float_as_uint(pmax), __float_as_uint(pmax), false, false);
      pmax = fmaxf(__uint_as_float(rr[0]), __uint_as_float(rr[1])); }
    if (__builtin_expect(__all(pmax - m_reg <= THR / SCALE), 1)) { mn = m_reg; alpha = 1.f; }
    else { mn = fmaxf(m_reg, pmax); alpha = __builtin_amdgcn_exp2f((m_reg - mn) * C); m_reg = mn; }
    const float mnC = -mn * C;
#pragma unroll
    for (int r = 0; r < 16; ++r) p0[r] = fmaf(p0[r], C, mnC);
#pragma unroll
    for (int r = 0; r < 16; ++r) p1[r] = fmaf(p1[r], C, mnC);
#pragma unroll
    for (int r = 0; r < 16; ++r) p0[r] = __builtin_amdgcn_exp2f(p0[r]);
}
__device__ __forceinline__ void finishSM(f32x16& p0, f32x16& p1, float alpha, float& l_reg, bf16x8& pa0, bf16x8& pa1, bf16x8& pa2, bf16x8& pa3) {
#pragma unroll
    for (int r = 0; r < 16; ++r) p1[r] = __builtin_amdgcn_exp2f(p1[r]);
    float ps = 0;
#pragma unroll
    for (int r = 0; r < 16; ++r) ps += p0[r];
#pragma unroll
    for (int r = 0; r < 16; ++r) ps += p1[r];
    { auto rr = __builtin_amdgcn_permlane32_swap(__float_as_uint(ps), __float_as_uint(ps), false, false);
      ps = __uint_as_float(rr[0]) + __uint_as_float(rr[1]); }
    l_reg = l_reg * alpha + ps;
#define PK4(P, BASE, OUT) do { unsigned a0 = cvtpk(P[BASE + 0], P[BASE + 1]), a1 = cvtpk(P[BASE + 2], P[BASE + 3]);   \
    unsigned b0 = cvtpk(P[BASE + 4], P[BASE + 5]), b1 = cvtpk(P[BASE + 6], P[BASE + 7]);                              \
    auto r0 = __builtin_amdgcn_permlane32_swap(a0, b0, false, false); auto r1 = __builtin_amdgcn_permlane32_swap(a1, b1, false, false); \
    u32x4 w = {r0[0], r1[0], r0[1], r1[1]}; OUT = *reinterpret_cast<bf16x8*>(&w); } while (0)
    PK4(p0, 0, pa0); PK4(p0, 8, pa1); PK4(p1, 0, pa2); PK4(p1, 8, pa3);
#undef PK4
}
__device__ __forceinline__ void qkt(f32x16& p0, f32x16& p1, const LAS unsigned char* Ks, const bf16x8* qr, int r32, int hi) {
    p0 = f32x16{}; p1 = f32x16{};
#pragma unroll
    for (int d0 = 0; d0 < 8; ++d0) { const int cb = (d0 * 16 + hi * 8) * 2;
        const bf16x8 b0 = *(const LAS bf16x8*)(Ks + KSWZ(r32, cb));
        const bf16x8 b1 = *(const LAS bf16x8*)(Ks + KSWZ(32 + r32, cb));
        p0 = __builtin_amdgcn_mfma_f32_32x32x16_bf16(b0, qr[d0], p0, 0, 0, 0);
        p1 = __builtin_amdgcn_mfma_f32_32x32x16_bf16(b1, qr[d0], p1, 0, 0, 0); }
}
__device__ __forceinline__ int v_st(int k, int c) { const int kk = (k & ~0xC) | ((k & 4) << 1) | ((k & 8) >> 1); return ((kk >> 3) * 4 + (c >> 5)) * 512 + ((kk & 7) * 32 + (c & 31)) * 2; }
__device__ __forceinline__ int v_rd_base(int lane) { return ((lane & 3) << 3) | (((lane >> 2) & 3) << 6) | (((lane >> 4) & 1) << 5) | (((lane >> 5) & 1) << 8); }
constexpr int v_rd_off(int d0, int ks, int half) { return d0 * 512 + ks * 4096 + half * 2048; }
template <int OFF> __device__ __forceinline__ s16x4 tr_read(int vb) { s16x4 r; asm volatile("ds_read_b64_tr_b16 %0, %1 offset:%2" : "=&v"(r) : "v"(vb), "i"(OFF) : "memory"); return r; }
template <int D0> __device__ __forceinline__ void pv_one(f32x16& od, int vb, bf16x8 pa0, bf16x8 pa1, bf16x8 pa2, bf16x8 pa3) {
    const s16x4 l0 = tr_read<v_rd_off(D0, 0, 0)>(vb), h0 = tr_read<v_rd_off(D0, 0, 1)>(vb), l1 = tr_read<v_rd_off(D0, 1, 0)>(vb), h1 = tr_read<v_rd_off(D0, 1, 1)>(vb);
    const s16x4 l2 = tr_read<v_rd_off(D0, 2, 0)>(vb), h2 = tr_read<v_rd_off(D0, 2, 1)>(vb), l3 = tr_read<v_rd_off(D0, 3, 0)>(vb), h3 = tr_read<v_rd_off(D0, 3, 1)>(vb);
    asm volatile("s_waitcnt lgkmcnt(0)" ::: "memory"); SBAR();
#define PK(L, H) (bf16x8){L[0], L[1], L[2], L[3], H[0], H[1], H[2], H[3]}
    od = __builtin_amdgcn_mfma_f32_32x32x16_bf16(pa0, PK(l0, h0), od, 0, 0, 0);
    od = __builtin_amdgcn_mfma_f32_32x32x16_bf16(pa1, PK(l1, h1), od, 0, 0, 0);
    od = __builtin_amdgcn_mfma_f32_32x32x16_bf16(pa2, PK(l2, h2), od, 0, 0, 0);
    od = __builtin_amdgcn_mfma_f32_32x32x16_bf16(pa3, PK(l3, h3), od, 0, 0, 0);
#undef PK
}
__device__ __forceinline__ void pv_d0(f32x16* o, int vb, bf16x8 pa0, bf16x8 pa1, bf16x8 pa2, bf16x8 pa3) {
    pv_one<0>(o[0], vb, pa0, pa1, pa2, pa3); pv_one<1>(o[1], vb, pa0, pa1, pa2, pa3); pv_one<2>(o[2], vb, pa0, pa1, pa2, pa3); pv_one<3>(o[3], vb, pa0, pa1, pa2, pa3);
}
struct Unit { const bf16_t *Q, *K, *V; bf16_t* O; float* lse; int ldo, lse_stride, nt, kt0, klo, khi, q0; };
__device__ __forceinline__ void body(const Unit& u, LAS unsigned char* lds, int wid) {
    const int lane = lane_id(), tid = wid * 64 + lane,
        r32 = lane & 31, hi = lane >> 5;
    LAS unsigned char* V_lds = lds; LAS unsigned char* K_lds = lds + 2 * SHM_V;
    LAS float* ws = (LAS float*)(lds + 2 * SHM_V + 2 * SHM_K) + wid * 64; LAS float* li_l = ws; LAS float* al_l = ws + 32;
    float m_reg = -1e30f, l_reg = 0; f32x16 o[4] = {}; bf16x8 qr[8];
    const bf16_t* Qw = u.Q + (size_t)(wid * QBLK + r32) * D + hi * 8;
#pragma unroll
    for (int d0 = 0; d0 < 8; ++d0) qr[d0] = *(const bf16x8*)(Qw + d0 * 16);
    const int sr = tid >> 4, sc = (tid & 15) * 8, vst0 = v_st(sr, sc), vst1 = v_st(32 + sr, sc);
    const int vb0 = (int)(unsigned)(uintptr_t)V_lds + v_rd_base(lane);
    const bf16_t* Kh = u.K; const bf16_t* Vh = u.V;
    constexpr bool BAND = false; constexpr int SD = 1; const int dq = 0;
#define TVALID(j) true
    struct { bf16x8 vs0, vs1, ks0, ks1; } sr_[SD];
#define KROW(j) (BAND ? ((u.kt0 + 64 * (j)) < u.klo ? u.klo : ((u.kt0 + 64 * (j)) > u.khi - 64 ? u.khi - 64 : (u.kt0 + 64 * (j)))) : (u.kt0 + 64 * (j)))
#define SLOAD(i, j) do { const int k0_ = KROW(j); sr_[i].vs0 = *(const bf16x8*)(&Vh[(size_t)(k0_ + sr) * D + sc]); sr_[i].vs1 = *(const bf16x8*)(&Vh[(size_t)(k0_ + 32 + sr) * D + sc]); \
    sr_[i].ks0 = *(const bf16x8*)(&Kh[(size_t)(k0_ + sr) * D + sc]); sr_[i].ks1 = *(const bf16x8*)(&Kh[(size_t)(k0_ + 32 + sr) * D + sc]); } while (0)
#define SWRITE(b, i) do { *(LAS bf16x8*)(V_lds + (b) * SHM_V + vst0) = sr_[i].vs0; *(LAS bf16x8*)(V_lds + (b) * SHM_V + vst1) = sr_[i].vs1; const int kc = sc * 2; \
    *(LAS bf16x8*)(K_lds + (b) * SHM_K + KSWZ(sr, kc)) = sr_[i].ks0; *(LAS bf16x8*)(K_lds + (b) * SHM_K + KSWZ(32 + sr, kc)) = sr_[i].ks1; } while (0)
#define SWAIT() do { if constexpr (SD == 2) asm volatile("s_waitcnt vmcnt(4)" ::: "memory"); else asm volatile("s_waitcnt vmcnt(0)" ::: "memory"); } while (0)
#define RESC(a) do { if (__any((a) < 1.f)) { if (hi == 0) al_l[r32] = (a); asm volatile("s_waitcnt lgkmcnt(0)" ::: "memory"); \
    _Pragma("unroll") for (int d = 0; d < 4; ++d) _Pragma("unroll") for (int r = 0; r < 16; ++r) o[d][r] *= al_l[crow(r, hi)]; } } while (0)
    f32x16 pA0, pA1, pB0, pB1; float mnA, mnB, alA, alB; bf16x8 pa0, pa1, pa2, pa3; const int NT = u.nt;
    constexpr int SE = 0, SO = SD - 1;
    SLOAD(SE, 0); asm volatile("s_waitcnt vmcnt(0)" ::: "memory"); SWRITE(0, SE); __syncthreads();
    qkt(pA0, pA1, K_lds, qr, r32, hi); partialSM<BAND>(pA0, pA1, m_reg, mnA, alA, dq, TVALID(0));
    SLOAD(SO, 1); if constexpr (SD == 2) { if (2 < NT) SLOAD(SE, 2); }
    SWAIT(); SWRITE(1, SO); __syncthreads();
    for (int j = 1; j + 1 < NT; j += 2) {
        SBAR(); qkt(pB0, pB1, K_lds + SHM_K, qr, r32, hi);
        finishSM(pA0, pA1, alA, l_reg, pa0, pa1, pa2, pa3); SBAR();
        SLOAD(SO, j + SD); SBAR();
        pv_d0(o, vb0, pa0, pa1, pa2, pa3); partialSM<BAND>(pB0, pB1, m_reg, mnB, alB, dq + 64 * j, TVALID(j));
        __syncthreads(); SWAIT(); SWRITE(0, SE);
        RESC(alB); __syncthreads();
        SBAR(); qkt(pA0, pA1, K_lds, qr, r32, hi);
        finishSM(pB0, pB1, alB, l_reg, pa0, pa1, pa2, pa3); SBAR();
        if (SD == 1 || j + 3 < NT) SLOAD(SE, j + 1 + SD); SBAR();
        pv_d0(o, vb0 + SHM_V, pa0, pa1, pa2, pa3); partialSM<BAND>(pA0, pA1, m_reg, mnA, alA, dq + 64 * (j + 1), TVALID(j + 1));
        __syncthreads(); SWAIT(); SWRITE(1, SO);
        RESC(alA); __syncthreads();
    }
    SBAR(); qkt(pB0, pB1, K_lds + SHM_K, qr, r32, hi);
    finishSM(pA0, pA1, alA, l_reg, pa0, pa1, pa2, pa3); SBAR();
    pv_d0(o, vb0, pa0, pa1, pa2, pa3); partialSM<BAND>(pB0, pB1, m_reg, mnB, alB, dq + 64 * (NT - 1), TVALID(NT - 1));
    __syncthreads(); RESC(alB);
    finishSM(pB0, pB1, alB, l_reg, pa0, pa1, pa2, pa3); SBAR();
    pv_d0(o, vb0 + SHM_V, pa0, pa1, pa2, pa3);
    if (hi == 0) li_l[r32] = l_reg; asm volatile("s_waitcnt lgkmcnt(0)" ::: "memory");
    float rli[16];
#pragma unroll
    for (int r = 0; r < 16; ++r) rli[r] = __builtin_amdgcn_rcpf(li_l[crow(r, hi)]);
    bf16_t* Ow = u.O + (size_t)(wid * QBLK) * u.ldo;
#pragma unroll
    for (int r = 0; r < 16; ++r) { const int orow = crow(r, hi);
#pragma unroll
        for (int d0 = 0; d0 < 4; ++d0) Ow[(size_t)orow * u.ldo + d0 * 32 + r32] = f2bf(o[d0][r] * rli[r]); }
    if (u.lse && hi == 0) u.lse[(size_t)(wid * QBLK + r32) * u.lse_stride] = m_reg * SCALE + __logf(l_reg);
    __syncthreads();
#undef KROW
#undef TVALID
#undef SLOAD
#undef SWRITE
#undef SWAIT
#undef RESC
}

__device__ __forceinline__ void band_body(const Unit& u, LAS unsigned char* lds, int wid) {
    const int lane = lane_id(), tid = wid * 64 + lane, r32 = lane & 31, hi = lane >> 5;
    LAS unsigned char* V_lds = lds; LAS unsigned char* K_lds = lds + 2 * SHM_V;
    LAS float* ws = (LAS float*)(lds + 2 * SHM_V + 2 * SHM_K) + wid * 64; LAS float* li_l = ws; LAS float* al_l = ws + 32;
    float m_reg = -1e30f, l_reg = 0; f32x16 o[4] = {}; bf16x8 qr[8];
    const bf16_t* Qw = u.Q + (size_t)(wid * QBLK + r32) * D + hi * 8;
#pragma unroll
    for (int d0 = 0; d0 < 8; ++d0) qr[d0] = *(const bf16x8*)(Qw + d0 * 16);
    const int sr = tid >> 4, sc = (tid & 15) * 8, vst0 = v_st(sr, sc), vst1 = v_st(32 + sr, sc);
    const int vb0 = (int)(unsigned)(uintptr_t)V_lds + v_rd_base(lane);
    const bf16_t* Kh = u.K; const bf16_t* Vh = u.V;
    const int dq = u.kt0 - (u.q0 + wid * QBLK + r32) + 4 * hi + 64;
    bf16x8 A_vs0, A_vs1, A_ks0, A_ks1, B_vs0, B_vs1, B_ks0, B_ks1, C_vs0, C_vs1, C_ks0, C_ks1;
#define KROW(j) ((u.kt0 + 64 * (j)) < u.klo ? u.klo : ((u.kt0 + 64 * (j)) > u.khi - 64 ? u.khi - 64 : (u.kt0 + 64 * (j))))
#define TVALID(j) ((u.kt0 + 64 * (j)) >= u.klo && (u.kt0 + 64 * (j)) < u.khi)
#define SLOAD(S, j) do { const int k0_ = KROW(j); S##vs0 = *(const bf16x8*)(&Vh[(size_t)(k0_ + sr) * D + sc]); S##vs1 = *(const bf16x8*)(&Vh[(size_t)(k0_ + 32 + sr) * D + sc]); \
    S##ks0 = *(const bf16x8*)(&Kh[(size_t)(k0_ + sr) * D + sc]); S##ks1 = *(const bf16x8*)(&Kh[(size_t)(k0_ + 32 + sr) * D + sc]); } while (0)
#define SWRITE(b, S) do { *(LAS bf16x8*)(V_lds + (b) * SHM_V + vst0) = S##vs0; *(LAS bf16x8*)(V_lds + (b) * SHM_V + vst1) = S##vs1; const int kc = sc * 2; \
    *(LAS bf16x8*)(K_lds + (b) * SHM_K + KSWZ(sr, kc)) = S##ks0; *(LAS bf16x8*)(K_lds + (b) * SHM_K + KSWZ(32 + sr, kc)) = S##ks1; } while (0)
    const int ja = (wid >> 1), jb = (wid >> 1) + 2;
#define BAND_ITER(j, STAGE) do { const int cur = (j) & 1; const bool act = ((j) >= ja) && ((j) <= jb); bf16x8 pa0, pa1, pa2, pa3; \
        if (act) { f32x16 p0, p1; float mn, al; \
            qkt(p0, p1, K_lds + cur * SHM_K, qr, r32, hi); \
            partialSM<true>(p0, p1, m_reg, mn, al, dq + 64 * (j), TVALID(j)); \
            if (__any(al < 1.f)) { if (hi == 0) al_l[r32] = al; asm volatile("s_waitcnt lgkmcnt(0)" ::: "memory"); \
                _Pragma("unroll") for (int d = 0; d < 4; ++d) _Pragma("unroll") for (int r = 0; r < 16; ++r) o[d][r] *= al_l[crow(r, hi)]; } \
            finishSM(p0, p1, al, l_reg, pa0, pa1, pa2, pa3); SBAR(); } \
        STAGE; SBAR(); \
        if (act) pv_d0(o, vb0 + cur * SHM_V, pa0, pa1, pa2, pa3); \
        __syncthreads(); } while (0)
    SLOAD(A_, 0); SLOAD(B_, 1); SLOAD(C_, 2);
    SWRITE(0, A_); SLOAD(A_, 3);
    __syncthreads();
    BAND_ITER(0, SWRITE(1, B_); SLOAD(B_, 4));
    BAND_ITER(1, SWRITE(0, C_); SLOAD(C_, 5));
    BAND_ITER(2, SWRITE(1, A_));
    BAND_ITER(3, SWRITE(0, B_));
    BAND_ITER(4, SWRITE(1, C_));
    BAND_ITER(5, (void)0);
#undef BAND_ITER
    if (hi == 0) li_l[r32] = l_reg; asm volatile("s_waitcnt lgkmcnt(0)" ::: "memory");
    float rli[16];
#pragma unroll
    for (int r = 0; r < 16; ++r) rli[r] = __builtin_amdgcn_rcpf(li_l[crow(r, hi)]);
    bf16_t* Ow = u.O + (size_t)(wid * QBLK) * u.ldo;
#pragma unroll
    for (int r = 0; r < 16; ++r) { const int orow = crow(r, hi);
#pragma unroll
        for (int d0 = 0; d0 < 4; ++d0) Ow[(size_t)orow * u.ldo + d0 * 32 + r32] = f2bf(o[d0][r] * rli[r]); }
    if (hi == 0) u.lse[(size_t)(wid * QBLK + r32) * u.lse_stride] = m_reg * SCALE + __logf(l_reg);
    __syncthreads();
#undef KROW
#undef TVALID
#undef SLOAD
#undef SWRITE
}
}

#define XB_TMO      128
#define XB_XCNT(j)  (256  + 64 * (j))
#define XB_XSUB(j)  (1280 + 64 * (j))
#define XB_XGEN(j)  (2304 + 64 * (j))
#define XB_TOP      3328
#define XB_TOPGEN   3392
#define XCD_BAR_WORDS 3456
#define XB_SPIN_CAP (1u << 20)
__device__ __forceinline__ unsigned xb_ld(unsigned* p)              { return __hip_atomic_load(p, __ATOMIC_RELAXED, __HIP_MEMORY_SCOPE_AGENT); }
__device__ __forceinline__ unsigned xb_add(unsigned* p, unsigned v) { return __hip_atomic_fetch_add(p, v, __ATOMIC_RELAXED, __HIP_MEMORY_SCOPE_AGENT); }
__device__ __forceinline__ unsigned xb_xcc_id() { return (unsigned)__builtin_amdgcn_s_getreg((3 << 11) | 20) & 0xFu; }
#define XB_SPIN(cond, bar) do { unsigned _sp = 0; while (cond) { __builtin_amdgcn_s_sleep(1); \
    if ((++_sp & 255u) == 0u) { if (xb_ld(&(bar)[XB_TMO])) break; if (_sp > XB_SPIN_CAP) { atomicAdd(&(bar)[XB_TMO], 1u); break; } } } } while (0)
__device__ __forceinline__ void xcd_barrier_post(unsigned* bar, bool leader) { if (leader) (void)xb_add(&bar[XB_XCNT(xb_xcc_id())], 1u); }
__device__ __forceinline__ void xcd_barrier_complete(unsigned* bar, unsigned x, unsigned G, unsigned& nloc, unsigned& nx) {
    unsigned sum, cnt, mine, sp = 0u;
    for (;;) {
        sum = 0u; cnt = 0u; mine = 0u;
#pragma unroll
        for (unsigned j = 0; j < 16; ++j) { const unsigned c = xb_ld(&bar[XB_XCNT(j)]); sum += c; cnt += (c > 0u) ? 1u : 0u; mine = (j == x) ? c : mine; }
        if (sum == G) break;
        __builtin_amdgcn_s_sleep(1);
        if ((++sp & 255u) == 0u) { if (xb_ld(&bar[XB_TMO])) break; if (sp > XB_SPIN_CAP) { atomicAdd(&bar[XB_TMO], 1u); break; } }
    }
    nloc = mine > 0u ? mine : 1u; nx = cnt > 0u ? cnt : 1u;
}
__device__ __forceinline__ void xcd_barrier(unsigned* bar, volatile LAS unsigned* st, unsigned G, bool leader) {
    asm volatile("s_waitcnt vmcnt(0)" ::: "memory");
    __syncthreads();
    if (leader) {
        __builtin_amdgcn_s_waitcnt(0);
        const unsigned x = xb_xcc_id();
        unsigned nloc = st[0], nx = st[1];
        if (nloc == 0u) { xcd_barrier_complete(bar, x, G, nloc, nx); st[0] = nloc; st[1] = nx; }
        const unsigned old = xb_add(&bar[XB_XSUB(x)], 1u);
        const unsigned gen = old / nloc;
        if (old + 1u == (gen + 1u) * nloc) {
            __builtin_amdgcn_fence(__ATOMIC_RELEASE, "agent");
            asm volatile("s_waitcnt vmcnt(0)" ::: "memory");
            const unsigned og = xb_add(&bar[XB_TOP], 1u);
            const unsigned tg = og / nx;
            if (og + 1u == (tg + 1u) * nx) xb_add(&bar[XB_TOPGEN], 1u);
            else XB_SPIN(xb_ld(&bar[XB_TOPGEN]) == tg, bar);
            __builtin_amdgcn_fence(__ATOMIC_ACQUIRE, "agent");
            xb_add(&bar[XB_XGEN(x)], 1u);
            asm volatile("s_waitcnt vmcnt(0)" ::: "memory");
        } else {
            XB_SPIN(xb_ld(&bar[XB_XGEN(x)]) == gen, bar);
            __builtin_amdgcn_fence(__ATOMIC_ACQUIRE, "agent");
            asm volatile("s_waitcnt vmcnt(0)" ::: "memory");
        }
    }
    __syncthreads();
}

constexpr int RING_BYTES = 131072, EX_OFF = RING_BYTES, MISC_OFF = EX_OFF + 4096, LDS_BYTES = 147456;
constexpr int NWAVES = 8;

struct Args {
    const float* in[18]; float* out; unsigned char* ws; int ph_lo, ph_hi; int use_bar, bar_region;
};

__device__ __forceinline__ void p0_transpose_item(const float* W, int K, int N, bf16_t* WT, int rowblk, int roff, LAS float* scr, int item, int lane) {
    const int nblk = N / 32, kb = item / nblk, nb = item % nblk, k0 = 64 * kb, n0 = 32 * nb;
#pragma unroll 8
    for (int i = 0; i < 32; ++i) { const int kk = 2 * i + (lane >> 5); scr[kk * 33 + (lane & 31)] = W[(size_t)(k0 + kk) * N + n0 + (lane & 31)]; }
    asm volatile("s_waitcnt lgkmcnt(0)" ::: "memory");
    const int c = lane & 7;
#pragma unroll
    for (int j = 0; j < 4; ++j) { const int nl = (lane >> 3) + 8 * j; const LAS float* s = scr + (8 * c) * 33 + nl; const int n = n0 + nl;
        u32x4 o; o.x = pk2(s[0 * 33], s[1 * 33]); o.y = pk2(s[2 * 33], s[3 * 33]); o.z = pk2(s[4 * 33], s[5 * 33]); o.w = pk2(s[6 * 33], s[7 * 33]);
        const int dr = (n >> 7) * rowblk + roff + (n & 127);
        *(u32x4*)(WT + (size_t)dr * K + k0 + 8 * c) = o; }
    asm volatile("s_waitcnt lgkmcnt(0)" ::: "memory");
}

template <int VAR>
__global__ void __launch_bounds__(NWAVES * 64, 2) mk_fwd(Args args) {
    extern __shared__ __attribute__((aligned(16))) unsigned char lds_raw[];
    LAS unsigned char* lds = (LAS unsigned char*)lds_raw;
    const int wave = __builtin_amdgcn_readfirstlane(threadIdx.x >> 6);
#define PHASE_IDS() const int lane = lane_id(), tid = wave * 64 + lane; (void)tid; const int gw = vcu * NWAVES + wave, NGW = G * NWAVES; (void)lane; (void)gw; (void)NGW
    const int G = gridDim.x, bx = blockIdx.x; const int vcu = (G % 8 == 0) ? (bx % 8) * (G / 8) + bx / 8 : bx;
    unsigned char* ws = args.ws;
    unsigned* ctl = (unsigned*)(ws + WS_CTL);
    if (threadIdx.x < 64) ((volatile LAS unsigned*)(lds + MISC_OFF))[threadIdx.x] = 0u;
    __syncthreads();
    if (args.use_bar) xcd_barrier_post((unsigned*)(args.ws + WS_CTL) + CW_BAR + args.bar_region * XCD_BAR_WORDS, wave == 0 && lane_id() == 0);
    if (args.use_bar == 12345) cooperative_groups::this_grid().sync();
#define GRID_BAR() do { if (args.use_bar) xcd_barrier((unsigned*)(args.ws + WS_CTL) + CW_BAR + args.bar_region * XCD_BAR_WORDS, (volatile LAS unsigned*)(lds + MISC_OFF) + 8, (unsigned)G, wave == 0 && lane_id() == 0); } while (0)
    const int lo = args.ph_lo, hi = args.ph_hi;
#ifndef MK_CMASK
#define MK_CMASK 0x1ff
#endif
#define IN(k) ((((MK_CMASK) >> (k)) & 1) && lo <= (k) && (k) < hi)
#define BOTH(k) (IN(k) && IN((k) + 1))

    if (IN(0)) {
        PHASE_IDS();
        const float* x = args.in[0];
        bf16_t* XB = (bf16_t*)(ws + WS_XB); bf16_t* WINT = (bf16_t*)(ws + WS_WINT); bf16_t* WAT = (bf16_t*)(ws + WS_WAT); bf16_t* WBT = (bf16_t*)(ws + WS_WBT); bf16_t* WOT = (bf16_t*)(ws + WS_WOT);
        bf16_t* WGUT = (bf16_t*)(ws + WS_WGUT); bf16_t* WDT = (bf16_t*)(ws + WS_WDT);
        LAS float* scr = (LAS float*)(lds + wave * 16384);
        constexpr int I_IN = (DM / 64) * (IN_COLS / 32), I_A = (1024 / 64) * (DM / 32), I_B = (DM / 64) * (DM / 32), I_O = I_B;
        constexpr int I_G = (DM / 64) * (FF / 32), I_D = (FF / 64) * (DM / 32);
        constexpr int NITEMS = I_IN + I_A + I_B + I_O + NEXP * (2 * I_G + I_D);
        for (int it = gw; it < I_IN + I_A + I_B + I_O; it += NGW) {
            int r = it;
            if (r < I_IN) { p0_transpose_item(args.in[1], DM, IN_COLS, WINT, 128, 0, scr, r, lane); continue; } r -= I_IN;
            if (r < I_A) { p0_transpose_item(args.in[4], 1024, DM, WAT, 128, 0, scr, r, lane); continue; } r -= I_A;
            if (r < I_B) { p0_transpose_item(args.in[5], DM, DM, WBT, 128, 0, scr, r, lane); continue; } r -= I_B;
            if (r < I_O) { p0_transpose_item(args.in[6], DM, DM, WOT, 128, 0, scr, r, lane); continue; } r -= I_O;
            const int e = r / (2 * I_G + I_D); r -= e * (2 * I_G + I_D);
            if (r < I_G) { p0_transpose_item(args.in[13] + (size_t)e * DM * FF, DM, FF, WGUT + (size_t)e * 2048 * DM, 256, 0, scr, r, lane); continue; } r -= I_G;
            if (r < I_G) { p0_transpose_item(args.in[14] + (size_t)e * DM * FF, DM, FF, WGUT + (size_t)e * 2048 * DM, 256, 128, scr, r, lane); continue; } r -= I_G;
            p0_transpose_item(args.in[15] + (size_t)e * FF * DM, FF, DM, WDT + (size_t)e * DM * FF, 128, 0, scr, r, lane);
        }
        for (int m = gw; m < NTOK; m += NGW) {
            const f32x4* xr = (const f32x4*)(x + (size_t)m * DM) + lane; u32x2* o8 = (u32x2*)(XB + (size_t)m * DM) + lane;
#pragma unroll
            for (int j = 0; j < 8; ++j) { const f32x4 v = xr[64 * j]; u32x2 w; w.x = pk2(v.x, v.y); w.y = pk2(v.z, v.w); o8[64 * j] = w; }
        }
        { float2* rt1 = (float2*)(ws + WS_RT1); float2* rt2 = (float2*)(ws + WS_RT2);
          for (int i = (vcu * NWAVES * 64) + tid; i < SEQ * 64; i += G * NWAVES * 64) { const int t = i >> 6, c = i & 63; float cs, sn;
              rope1(t, c, cs, sn); rt1[i] = make_float2(cs, sn); rope2(t, c, cs, sn); rt2[i] = make_float2(cs, sn); } }
        { float* wt = (float*)(ws + WS_WRT); const float* wgp = args.in[9]; const float* wrp = args.in[11];
          for (int i = (vcu * NWAVES * 64) + tid; i < 36 * DM; i += G * NWAVES * 64) { const int c = i >> 11, k = i & (DM - 1); wt[i] = (c < 4) ? wgp[(size_t)k * 4 + c] : wrp[(size_t)k * 32 + (c - 4)]; } }
        if (BOTH(0)) GRID_BAR();
    }

    if (IN(1)) {
        EpiProj E; E.ws = ws; E.qg = args.in[2]; E.kg = args.in[3];
        ProjSched S; S.o.init(NTOK, IN_COLS, G, bx); S.ws = (const char*)ws;
        pg8::gemm_phase<EpiProj, ProjSched, PG8_ALIGN, PG8_SP2>(lds, lds + EX_OFF, S, E, wave);
        if (BOTH(1)) GRID_BAR();
    }

    if (IN(2)) {
        if (VAR != 22) for (int i = 0; i < 2; ++i) {
            const int idx = bx + i * G; if (idx >= 512) break;
            const int bk = idx & 7, rest = idx >> 3, b = bk >> 2, kvh = bk & 3, hq = kvh * 4 + (rest & 3), qblk = rest >> 2;
            att::Unit u; u.Q = (const bf16_t*)(ws + WS_QB) + ((size_t)(b * 16 + hq) * SEQ + qblk * 256) * HD;
            u.K = (const bf16_t*)(ws + WS_KB) + (size_t)(b * 4 + kvh) * SEQ * HD; u.V = (const bf16_t*)(ws + WS_VB) + (size_t)(b * 4 + kvh) * SEQ * HD;
            u.O = (bf16_t*)(ws + WS_OB) + ((size_t)b * SEQ + qblk * 256) * 2048 + hq * HD; u.ldo = 2048; u.lse = nullptr; u.lse_stride = 0; u.nt = 64; u.kt0 = 0; u.klo = 0; u.khi = SEQ; u.q0 = 0;
            att::body(u, lds, wave);
        }
        if (VAR != 21) for (int i = 0; i < 3; ++i) {
            const int idx = bx + i * G; if (idx >= 768) break;
            const int sid = idx >> 4, qblk = idx & 15, g = sid >> 4, b = (sid >> 3) & 1, h = sid & 7, sh = 2 * g, L = SEQ >> sh;
            const int P0 = qblk * 256, r = P0 / L, p0 = P0 - r * L;
            att::Unit u; u.Q = (const bf16_t*)(ws + WS_QA) + ((size_t)sid * SEQ + P0) * HD; u.K = (const bf16_t*)(ws + WS_KA) + (size_t)sid * SEQ * HD; u.V = (const bf16_t*)(ws + WS_VA) + (size_t)sid * SEQ * HD;
            const size_t tok0 = (size_t)b * SEQ + ((size_t)p0 << sh) + r;
            u.O = (bf16_t*)(ws + WS_OAG) + ((size_t)g * NTOK + tok0) * 1024 + h * HD; u.ldo = 1024 << sh;
            u.lse = (float*)(ws + WS_LSE) + ((size_t)g * NTOK + tok0) * 8 + h; u.lse_stride = 8 << sh;
            u.nt = 6; u.kt0 = P0 - 64; u.klo = r * L; u.khi = r * L + L; u.q0 = P0;
            att::band_body(u, lds, wave);
        }
        GRID_BAR();
        {
            PHASE_IDS();
            const bf16_t* oag = (const bf16_t*)(ws + WS_OAG); const float* lse = (const float*)(ws + WS_LSE); bf16_t* oa = (bf16_t*)(ws + WS_OA);
            for (int m = gw; m < NTOK; m += NGW) { const int c = lane * 16, h = lane >> 3;
                const float l0 = lse[(0 * (size_t)NTOK + m) * 8 + h], l1 = lse[(1 * (size_t)NTOK + m) * 8 + h], l2 = lse[(2 * (size_t)NTOK + m) * 8 + h];
                const float mx = fmaxf(l0, fmaxf(l1, l2)); float e0 = __expf(l0 - mx), e1 = __expf(l1 - mx), e2 = __expf(l2 - mx); const float inv = 1.0f / (e0 + e1 + e2); e0 *= inv; e1 *= inv; e2 *= inv;
#pragma unroll
                for (int q = 0; q < 2; ++q) { const u32x4 a = *(const u32x4*)(oag + (0 * (size_t)NTOK + m) * 1024 + c + 8 * q), bq = *(const u32x4*)(oag + (1 * (size_t)NTOK + m) * 1024 + c + 8 * q), cq = *(const u32x4*)(oag + (2 * (size_t)NTOK + m) * 1024 + c + 8 * q);
                    u32x4 w;
#pragma unroll
                    for (int k = 0; k < 4; ++k) w[k] = cvtpk(e0 * bflo(a[k]) + e1 * bflo(bq[k]) + e2 * bflo(cq[k]), e0 * bfhi(a[k]) + e1 * bfhi(bq[k]) + e2 * bfhi(cq[k]));
                    *(u32x4*)(oa + (size_t)m * 1024 + c + 8 * q) = w; } }
        }
        if (BOTH(2)) GRID_BAR();
    }

    if (IN(3) || IN(4)) {
        EpiMix E; E.ws = ws; E.x = args.in[0];
        MixSched S; S.c = vcu; S.ws = (const char*)ws;
        if (IN(3)) { S.mode = 0; pg8::gemm_phase<EpiMix, MixSched, false, PG8_SP2>(lds, lds + EX_OFF, S, E, wave); if (BOTH(3)) GRID_BAR(); }
        if (IN(4)) { S.mode = 1; pg8::gemm_phase<EpiMix, MixSched, false, PG8_SP2>(lds, lds + EX_OFF, S, E, wave); if (BOTH(4)) GRID_BAR(); }
    }

    if (IN(5)) {
        PHASE_IDS();
        RouteArgs ra; ra.g = args.in[7]; ra.b = args.in[8]; ra.h1 = (float*)(ws + WS_H1); ra.h1b = (bf16_t*)(ws + WS_H1B); ra.wg = args.in[9]; ra.bg = args.in[10]; ra.wr = args.in[11]; ra.br = args.in[12];
        ra.cnt = ctl + CW_CNT; ra.tokidx = (int*)(ws + WS_TOKIDX); ra.slot = (int*)(ws + WS_SLOT); ra.wt = (const float*)(ws + WS_WRT);
        LAS unsigned* hist = (LAS unsigned*)lds; LAS unsigned* basev = hist + 32; LAS int* rinfo = (LAS int*)(lds + 256);
        if (tid < 64) hist[tid] = 0u;
        __syncthreads();
        static_assert(NTOK == 4 * 256 * NWAVES, "P5 assumes 4 rows per wave on a 256-workgroup grid");
#pragma unroll 1
        for (int ps = 0; ps < 2; ++ps) ln1_route_rows<2, VAR>((const float*)(ws + WS_PRE1), ra, gw + 2 * ps * NGW, NGW, lane_id(), hist, rinfo, wave * 4 + 2 * ps, 1);
        __syncthreads();
        if (tid < 32) { const unsigned h = hist[tid]; if (h) basev[tid] = atomicAdd(ra.cnt + tid, h); }
        __syncthreads();
        if (tid < 32) { const LAS int* ri = rinfo + tid * 8; const int ex1 = ri[0], ex2 = ri[1], m = ri[6]; const int p1 = (int)basev[ex1] + ri[2], p2 = (int)basev[ex2] + ri[3];
            ra.tokidx[ex1 * ECAP + p1] = m; ra.tokidx[ex2 * ECAP + p2] = m;
            int* sl = ra.slot + (size_t)m * 6; sl[0] = ex1; sl[1] = ex2; sl[2] = p1; sl[3] = p2; sl[4] = ri[4]; sl[5] = ri[5]; }
        if (BOTH(5)) GRID_BAR();
    }

    if (IN(6) || IN(7)) {
        MoeSched2 S; S.G = G; S.vcu = vcu; S.ws = (const char*)ws; S.wgate = args.in[13]; S.wup = args.in[14]; S.wdown = args.in[15];
        S.init(ctl + CW_CNT, lane_id());
        EpiMoe2 E; E.ws = ws;
        if (IN(6)) { S.down = 0; E.down = 0; mg::gemm_phase<MoeSched2, EpiMoe2>(lds, S, E, wave); if (BOTH(6)) GRID_BAR(); }
        if (IN(7)) { S.down = 1; E.down = 1; mg::gemm_phase<MoeSched2, EpiMoe2>(lds, S, E, wave); if (BOTH(7)) GRID_BAR(); }
    }

    if (IN(8)) {
        PHASE_IDS();
        P8Args pa; pa.h1 = (const float*)(ws + WS_H1); pa.y = (const bf16_t*)(ws + WS_Y); pa.cnt = ctl + CW_CNT; pa.slot = (const int*)(ws + WS_SLOT); pa.g = args.in[16]; pa.b = args.in[17]; pa.out = args.out;
        unsigned c = 0; if (lane < NEXP) c = __hip_atomic_load(ctl + CW_CNT + lane, __ATOMIC_RELAXED, __HIP_MEMORY_SCOPE_AGENT);
        unsigned t = (c + 255u) >> 8, inc = t;
#pragma unroll
        for (int o = 1; o < 32; o <<= 1) { const unsigned v = __shfl_up(inc, o); if ((lane & 31) >= o) inc += v; }
        const unsigned tpe = inc - t;
        for (int m = gw; m < NTOK; m += NGW) {
            const int* sl = pa.slot + (size_t)m * 6; const int e1 = sl[0], e2 = sl[1], p1 = sl[2], p2 = sl[3]; const float w1 = ((const float*)sl)[4], w2 = ((const float*)sl)[5];
            const size_t r1 = (size_t)__shfl(tpe, e1) * 256 + p1, r2 = (size_t)__shfl(tpe, e2) * 256 + p2;
            final_row(pa, m, lane_id(), r1, r2, w1, w2);
        }
    }
#undef IN
#undef BOTH
#undef GRID_BAR
}

extern "C" void kernel_launch(void* const* d_in, const int* in_sizes, int n_in, void* d_out, int out_size, void* d_ws, size_t ws_size, hipStream_t stream) {
    static int grid = 0;
    if (grid == 0) {
        if (n_in != 18 || in_sizes[0] != NTOK * DM || out_size != NTOK * DM || ws_size < WS_END) { fprintf(stderr, "kernel_launch: unexpected shapes (n_in %d, in0 %d, out %d, ws %zu)\n", n_in, n_in > 0 ? in_sizes[0] : -1, out_size, ws_size); grid = -1; return; }
        int dev = 0, cus = 0, per_cu = 0;
        if (hipGetDevice(&dev) != hipSuccess || hipDeviceGetAttribute(&cus, hipDeviceAttributeMultiprocessorCount, dev) != hipSuccess) { fprintf(stderr, "kernel_launch: device query failed\n"); grid = -1; return; }
        if (hipFuncSetAttribute((const void*)mk_fwd<0>, hipFuncAttributeMaxDynamicSharedMemorySize, LDS_BYTES) != hipSuccess || hipFuncSetAttribute((const void*)mk_fwd<MK_EXTRA_VAR>, hipFuncAttributeMaxDynamicSharedMemorySize, LDS_BYTES) != hipSuccess) { fprintf(stderr, "kernel_launch: hipFuncSetAttribute failed\n"); grid = -1; return; }
        if (hipOccupancyMaxActiveBlocksPerMultiprocessor(&per_cu, (const void*)mk_fwd<0>, NWAVES * 64, LDS_BYTES) != hipSuccess || per_cu < 1) { fprintf(stderr, "kernel_launch: occupancy query says %d blocks per CU\n", per_cu); per_cu = 1; }
        (void)hipGetLastError();
        grid = cus * 1;
        fprintf(stderr, "kernel_launch: grid %d (cus %d, occupancy %d)\n", grid, cus, per_cu);
    }
    if (grid < 0) return;
    unsigned char* ws = (unsigned char*)d_ws;
    (void)hipMemsetAsync(ws + WS_CTL, 0, 1 * MiB, stream);
    Args a{};
    for (int i = 0; i < 18; ++i) a.in[i] = (const float*)d_in[i];
    a.out = (float*)d_out; a.ws = ws;
    const float* x = a.in[0];
    bf16_t* XB = (bf16_t*)(ws + WS_XB); bf16_t* WINT = (bf16_t*)(ws + WS_WINT); bf16_t* WAT = (bf16_t*)(ws + WS_WAT); bf16_t* WBT = (bf16_t*)(ws + WS_WBT); bf16_t* WOT = (bf16_t*)(ws + WS_WOT);
    bf16_t* WGUT = (bf16_t*)(ws + WS_WGUT); bf16_t* WDT = (bf16_t*)(ws + WS_WDT);
    unsigned* ctl = (unsigned*)(ws + WS_CTL);
    auto launch_mk = [&](int lo, int hi, int use_bar, bool extra = false) {
        a.ph_lo = lo; a.ph_hi = hi; a.use_bar = use_bar;
        void* kargs[] = {&a};
        hipError_t e = hipLaunchCooperativeKernel(extra ? (const void*)mk_fwd<MK_EXTRA_VAR> : (const void*)mk_fwd<0>, dim3(grid), dim3(NWAVES * 64), kargs, LDS_BYTES, stream);
        if (e != hipSuccess) fprintf(stderr, "kernel_launch: cooperative launch failed: %s (grid %d)\n", hipGetErrorString(e), grid);
    };
    if (MK_ONE_LAUNCH && MK_FAST_MASK == 0x1ff) { launch_mk(0, NPHASE, 1);
        if (MK_EXTRA_PHASE >= 0) { a.bar_region = 1; launch_mk(MK_EXTRA_PHASE, MK_EXTRA_PHASE + 1, 1, true); }
        return; }
    for (int ph = 0; ph < NPHASE; ++ph) {
        if ((MK_FAST_MASK >> ph) & 1) { launch_mk(ph, ph + 1, (ph == 2) ? 1 : 0); continue; }
        switch (ph) {
        case 0:
            hipLaunchKernelGGL(k_cvt, dim3(2048), dim3(256), 0, stream, x, XB, (size_t)NTOK * DM / 8);
            hipLaunchKernelGGL(k_transpose, dim3(IN_COLS / 32, DM / 32, 1), dim3(256), 0, stream, a.in[1], WINT, DM, IN_COLS, 128, 0, (size_t)0, (size_t)0);
            hipLaunchKernelGGL(k_transpose, dim3(DM / 32, 1024 / 32, 1), dim3(256), 0, stream, a.in[4], WAT, 1024, DM, 128, 0, (size_t)0, (size_t)0);
            hipLaunchKernelGGL(k_transpose, dim3(DM / 32, DM / 32, 1), dim3(256), 0, stream, a.in[5], WBT, DM, DM, 128, 0, (size_t)0, (size_t)0);
            hipLaunchKernelGGL(k_transpose, dim3(DM / 32, DM / 32, 1), dim3(256), 0, stream, a.in[6], WOT, DM, DM, 128, 0, (size_t)0, (size_t)0);
            hipLaunchKernelGGL(k_transpose, dim3(FF / 32, DM / 32, NEXP), dim3(256), 0, stream, a.in[13], WGUT, DM, FF, 256, 0, (size_t)DM * FF, (size_t)2048 * DM);
            hipLaunchKernelGGL(k_transpose, dim3(FF / 32, DM / 32, NEXP), dim3(256), 0, stream, a.in[14], WGUT, DM, FF, 256, 128, (size_t)DM * FF, (size_t)2048 * DM);
            hipLaunchKernelGGL(k_transpose, dim3(DM / 32, FF / 32, NEXP), dim3(256), 0, stream, a.in[15], WDT, FF, DM, 128, 0, (size_t)FF * DM, (size_t)DM * FF);
            hipLaunchKernelGGL(k_ropetab, dim3(SEQ * 64 / 256), dim3(256), 0, stream, (float2*)(ws + WS_RT1), (float2*)(ws + WS_RT2));
            break;
        case 1: { P1Args p1{}; p1.xb = XB; p1.wint = WINT; p1.qg = a.in[2]; p1.kg = a.in[3]; p1.qa = (bf16_t*)(ws + WS_QA); p1.ka = (bf16_t*)(ws + WS_KA); p1.va = (bf16_t*)(ws + WS_VA);
            p1.qb = (bf16_t*)(ws + WS_QB); p1.kb = (bf16_t*)(ws + WS_KB); p1.vb = (bf16_t*)(ws + WS_VB); p1.gates = (bf16_t*)(ws + WS_GATES);
            hipLaunchKernelGGL(k_proj, dim3(IN_COLS / 128, NTOK / 64), dim3(256), 0, stream, p1); } break;
        case 2: { P2Args p2b{}; p2b.q = (bf16_t*)(ws + WS_QB); p2b.k = (bf16_t*)(ws + WS_KB); p2b.v = (bf16_t*)(ws + WS_VB); p2b.o = (bf16_t*)(ws + WS_OB); p2b.lse = nullptr; p2b.mode = 0;
            hipLaunchKernelGGL(k_attn, dim3(SEQ / 64, 32), dim3(128), 0, stream, p2b);
            P2Args p2a{}; p2a.q = (bf16_t*)(ws + WS_QA); p2a.k = (bf16_t*)(ws + WS_KA); p2a.v = (bf16_t*)(ws + WS_VA); p2a.o = (bf16_t*)(ws + WS_OAG); p2a.lse = (float*)(ws + WS_LSE); p2a.mode = 1;
            hipLaunchKernelGGL(k_attn, dim3(SEQ / 64, 48), dim3(128), 0, stream, p2a);
            hipLaunchKernelGGL(k_merge, dim3(NTOK * 1024 / 256), dim3(256), 0, stream, (const bf16_t*)(ws + WS_OAG), (const float*)(ws + WS_LSE), (bf16_t*)(ws + WS_OA)); } break;
        case 3: case 4: { P3Args p3{}; p3.gates = (bf16_t*)(ws + WS_GATES); p3.T = (float*)(ws + WS_T); p3.merged = (bf16_t*)(ws + WS_MERGED); p3.x = x; p3.pre1 = (float*)(ws + WS_PRE1);
            if (ph == 3) { p3.A = (bf16_t*)(ws + WS_OA); p3.Bt = WAT; p3.K = 1024; p3.mode = 0;
                hipLaunchKernelGGL(k_gemm3, dim3(DM / 128, NTOK / 64), dim3(256), 0, stream, p3);
                p3.A = (bf16_t*)(ws + WS_OB); p3.Bt = WBT; p3.K = 2048; p3.mode = 1;
                hipLaunchKernelGGL(k_gemm3, dim3(DM / 128, NTOK / 64), dim3(256), 0, stream, p3); }
            else { p3.A = p3.merged; p3.Bt = WOT; p3.K = 2048; p3.mode = 2; hipLaunchKernelGGL(k_gemm3, dim3(DM / 128, NTOK / 64), dim3(256), 0, stream, p3); } } break;
        case 5: { RouteArgs ra{}; ra.g = a.in[7]; ra.b = a.in[8]; ra.h1 = (float*)(ws + WS_H1); ra.h1b = (bf16_t*)(ws + WS_H1B); ra.wg = a.in[9]; ra.bg = a.in[10]; ra.wr = a.in[11]; ra.br = a.in[12];
            ra.cnt = ctl + CW_CNT; ra.tokidx = (int*)(ws + WS_TOKIDX); ra.slot = (int*)(ws + WS_SLOT);
            hipLaunchKernelGGL(k_ln1_route, dim3(NTOK / 4), dim3(256), 0, stream, (const float*)(ws + WS_PRE1), ra); } break;
        case 6: case 7: { P6Args p6{}; p6.h1b = (bf16_t*)(ws + WS_H1B); p6.wgut = WGUT; p6.wdt = WDT; p6.cnt = ctl + CW_CNT; p6.tokidx = (int*)(ws + WS_TOKIDX); p6.act = (bf16_t*)(ws + WS_ACT); p6.y = (bf16_t*)(ws + WS_Y);
            if (ph == 6) hipLaunchKernelGGL(k_moe_up, dim3(FF / 128, 24576 / 64), dim3(256), 0, stream, p6);
            else hipLaunchKernelGGL(k_moe_down, dim3(DM / 128, 24576 / 64), dim3(256), 0, stream, p6); } break;
        case 8: { P8Args p8{}; p8.h1 = (float*)(ws + WS_H1); p8.y = (bf16_t*)(ws + WS_Y); p8.cnt = ctl + CW_CNT; p8.slot = (int*)(ws + WS_SLOT); p8.g = a.in[16]; p8.b = a.in[17]; p8.out = (float*)d_out;
            hipLaunchKernelGGL(k_final, dim3(NTOK / 4), dim3(256), 0, stream, p8); } break;
        }
    }
}
```

```cpp
#include <hip/hip_runtime.h>
#include <hip/hip_cooperative_groups.h>
#include <cstdio>
#include <cstdint>

typedef unsigned short bf16_t;
typedef short bf16x8 __attribute__((ext_vector_type(8)));
typedef short s16x4 __attribute__((ext_vector_type(4)));
typedef float f32x4 __attribute__((ext_vector_type(4)));
typedef float f32x16 __attribute__((ext_vector_type(16)));
typedef unsigned u32x4 __attribute__((ext_vector_type(4)));
typedef unsigned u32x2 __attribute__((ext_vector_type(2)));
#define LAS __attribute__((address_space(3)))

#ifndef MK_FAST_MASK
#define MK_FAST_MASK 0x1ff
#endif
#ifndef MK_ONE_LAUNCH
#define MK_ONE_LAUNCH 1
#endif
#ifndef MK_EXTRA_PHASE
#define MK_EXTRA_PHASE -1
#endif
#ifndef MK_EXTRA_VAR
#define MK_EXTRA_VAR 0
#endif
#ifndef PG8_SP2
#define PG8_SP2 true
#endif
#ifndef PG8_ALIGN
#define PG8_ALIGN true
#endif

constexpr int NTOK = 8192, SEQ = 4096, DM = 2048, HD = 128;
constexpr int IN_COLS = 16384;
constexpr int NEXP = 32, FF = 1024;
constexpr float ALPHA = 1.189207115002721f;
constexpr float LN_EPS = 1e-5f, RMS_EPS = 1e-6f;
constexpr float SM_SCALE = 0.08838834764831845f;
constexpr int ECAP = 8192;
constexpr int NPHASE = 9;

constexpr size_t MiB = 1u << 20;
constexpr size_t WS_CTL = 0;
constexpr size_t WS_WGUT = 1 * MiB;
constexpr size_t WS_WDT = 257 * MiB;
constexpr size_t WS_WAT = 385 * MiB;
constexpr size_t WS_WBT = 389 * MiB;
constexpr size_t WS_WOT = 397 * MiB;
constexpr size_t WS_XB = 405 * MiB;
constexpr size_t WS_WINT = 437 * MiB;
constexpr size_t WS_QA = 501 * MiB;
constexpr size_t WS_KA = 549 * MiB;
constexpr size_t WS_VA = 597 * MiB;
constexpr size_t WS_QB = 645 * MiB;
constexpr size_t WS_KB = 677 * MiB;
constexpr size_t WS_VB = 685 * MiB;
constexpr size_t WS_GATES = 693 * MiB;
constexpr size_t WS_OAG = 757 * MiB;
constexpr size_t WS_LSE = 805 * MiB;
constexpr size_t WS_OA = 806 * MiB;
constexpr size_t WS_OB = 822 * MiB;
constexpr size_t WS_T = 405 * MiB;
constexpr size_t WS_MERGED = 469 * MiB;
constexpr size_t WS_PRE1 = 501 * MiB;
constexpr size_t WS_H1 = 565 * MiB;
constexpr size_t WS_H1B = 629 * MiB;
constexpr size_t WS_TOKIDX = 661 * MiB;
constexpr size_t WS_SLOT = 662 * MiB;
constexpr size_t WS_ACT = 693 * MiB;
constexpr size_t WS_Y = 757 * MiB;
constexpr size_t WS_RT1 = 854 * MiB;
constexpr size_t WS_RT2 = 856 * MiB;
constexpr size_t WS_WRT = 858 * MiB;
constexpr size_t WS_END = 859 * MiB;
constexpr int CW_CNT = 64;
constexpr int CW_BAR = 4096;
constexpr int CW_WGST = 65536;

__device__ __forceinline__ float bf2f(bf16_t v) { return __uint_as_float(((unsigned)v) << 16); }
__device__ __forceinline__ bf16_t f2bf(float f) { unsigned u = __float_as_uint(f); u += 0x7fffu + ((u >> 16) & 1u); return (bf16_t)(u >> 16); }
__device__ __forceinline__ unsigned pk2(float lo, float hi) { return (unsigned)f2bf(lo) | ((unsigned)f2bf(hi) << 16); }
__device__ __forceinline__ unsigned cvtpk(float lo, float hi) { unsigned r; asm volatile("v_cvt_pk_bf16_f32 %0, %1, %2" : "=v"(r) : "v"(lo), "v"(hi)); return r; }
__device__ __forceinline__ float wave_sum(float v) {
#pragma unroll
    for (int o = 1; o < 64; o <<= 1) v += __shfl_xor(v, o);
    return v;
}
__device__ __forceinline__ int lane_id() { int l; asm volatile("v_mbcnt_lo_u32_b32 %0, -1, 0\n\tv_mbcnt_hi_u32_b32 %0, -1, %0" : "=v"(l)); return l; }
__device__ __forceinline__ float bflo(unsigned w) { return __uint_as_float(w << 16); }
__device__ __forceinline__ float bfhi(unsigned w) { return __uint_as_float(w & 0xffff0000u); }

__device__ const float INV64[64] = {
    1.000000000e+00f, 8.659643234e-01f, 7.498942093e-01f, 6.493816316e-01f, 5.623413252e-01f, 4.869675252e-01f, 4.216965034e-01f, 3.651741273e-01f,
    3.162277660e-01f, 2.738419634e-01f, 2.371373706e-01f, 2.053525026e-01f, 1.778279410e-01f, 1.539926526e-01f, 1.333521432e-01f, 1.154781985e-01f,
    1.000000000e-01f, 8.659643234e-02f, 7.498942093e-02f, 6.493816316e-02f, 5.623413252e-02f, 4.869675252e-02f, 4.216965034e-02f, 3.651741273e-02f,
    3.162277660e-02f, 2.738419634e-02f, 2.371373706e-02f, 2.053525026e-02f, 1.778279410e-02f, 1.539926526e-02f, 1.333521432e-02f, 1.154781985e-02f,
    1.000000000e-02f, 8.659643234e-03f, 7.498942093e-03f, 6.493816316e-03f, 5.623413252e-03f, 4.869675252e-03f, 4.216965034e-03f, 3.651741273e-03f,
    3.162277660e-03f, 2.738419634e-03f, 2.371373706e-03f, 2.053525026e-03f, 1.778279410e-03f, 1.539926526e-03f, 1.333521432e-03f, 1.154781985e-03f,
    1.000000000e-03f, 8.659643234e-04f, 7.498942093e-04f, 6.493816316e-04f, 5.623413252e-04f, 4.869675252e-04f, 4.216965034e-04f, 3.651741273e-04f,
    3.162277660e-04f, 2.738419634e-04f, 2.371373706e-04f, 2.053525026e-04f, 1.778279410e-04f, 1.539926526e-04f, 1.333521432e-04f, 1.154781985e-04f};

__device__ __forceinline__ void cs_angle(float ang, float& c, float& s) {
    const double a = (double)ang * 0.15915494309189535;
    const float f = (float)(a - floor(a));
    s = __builtin_amdgcn_sinf(f); c = __builtin_amdgcn_cosf(f);
}
__device__ __forceinline__ void rope1(int t, int i, float& c, float& s) { cs_angle((float)t * INV64[i], c, s); }
__device__ __forceinline__ void rope2(int t, int i, float& c, float& s) {
    const float p = (i < 32) ? (float)(t >> 6) : (float)(t & 63);
    cs_angle(p * INV64[2 * (i & 31)], c, s);
}
__device__ __forceinline__ int perm_pos(int g, int t) { const int sh = 2 * g; const int d = 1 << sh; return (t & (d - 1)) * (SEQ >> sh) + (t >> sh); }

__global__ void __launch_bounds__(256) k_cvt(const float* __restrict__ x, bf16_t* __restrict__ xb, size_t n8) {
    for (size_t i = (size_t)blockIdx.x * 256 + threadIdx.x; i < n8; i += (size_t)gridDim.x * 256) {
        const f32x4 a = *(const f32x4*)(x + i * 8), b = *(const f32x4*)(x + i * 8 + 4);
        u32x4 w; w.x = pk2(a.x, a.y); w.y = pk2(a.z, a.w); w.z = pk2(b.x, b.y); w.w = pk2(b.z, b.w);
        *(u32x4*)(xb + i * 8) = w;
    }
}
__global__ void __launch_bounds__(256) k_transpose(const float* __restrict__ src, bf16_t* __restrict__ dst, int K, int N, int rowblk, int roff, size_t sstride, size_t dstride) {
    __shared__ float tile[32][33];
    const float* s = src + (size_t)blockIdx.z * sstride; bf16_t* d = dst + (size_t)blockIdx.z * dstride;
    const int n0 = blockIdx.x * 32, k0 = blockIdx.y * 32, tx = threadIdx.x & 31, ty = threadIdx.x >> 5;
    for (int i = ty; i < 32; i += 8) tile[i][tx] = s[(size_t)(k0 + i) * N + n0 + tx];
    __syncthreads();
    for (int i = ty; i < 32; i += 8) { const int n = n0 + i; const int dr = (n >> 7) * rowblk + roff + (n & 127); d[(size_t)dr * K + k0 + tx] = f2bf(tile[tx][i]); }
}
__global__ void __launch_bounds__(256) k_ropetab(float2* rt1, float2* rt2) {
    const int i = blockIdx.x * 256 + threadIdx.x; const int t = i >> 6, c = i & 63; float cs, sn;
    rope1(t, c, cs, sn); rt1[i] = make_float2(cs, sn); rope2(t, c, cs, sn); rt2[i] = make_float2(cs, sn);
}
__device__ __forceinline__ void wave_gemm16x128(const bf16_t* arow, const bf16_t* bt, int ldb, int K, f32x4 (&acc)[8]) {
    const int lane = threadIdx.x & 63, fr = lane & 15, fq = lane >> 4;
    const bf16_t* ap = arow + fq * 8;
    const bf16_t* bp = bt + (size_t)fr * ldb + fq * 8;
    for (int k = 0; k < K; k += 32) {
        const bf16x8 a = *(const bf16x8*)(ap + k);
#pragma unroll
        for (int j = 0; j < 8; ++j) { const bf16x8 b = *(const bf16x8*)(bp + (size_t)j * 16 * ldb + k); acc[j] = __builtin_amdgcn_mfma_f32_16x16x32_bf16(a, b, acc[j], 0, 0, 0); }
    }
}
struct P1Args { const bf16_t* xb; const bf16_t* wint; const float* qg; const float* kg; bf16_t *qa, *ka, *va, *qb, *kb, *vb, *gates; };
__global__ void __launch_bounds__(256) k_proj(P1Args a) {
    const int wave = threadIdx.x >> 6, lane = threadIdx.x & 63, fr = lane & 15, fq = lane >> 4;
    const int ng = blockIdx.x, mt = blockIdx.y * 4 + wave;
    f32x4 acc[8];
#pragma unroll
    for (int j = 0; j < 8; ++j) acc[j] = (f32x4){0.f, 0.f, 0.f, 0.f};
    wave_gemm16x128(a.xb + (size_t)(mt * 16 + fr) * DM, a.wint + (size_t)ng * 128 * DM, DM, DM, acc);
#pragma unroll
    for (int r = 0; r < 4; ++r) {
        const int m = mt * 16 + fq * 4 + r, b = m >> 12, t = m & 4095;
        if (ng < 72) {
            const int which = ng / 24, hh = ng % 24, g = hh >> 3, h = hh & 7;
            bf16_t* base = (which == 0 ? a.qa : (which == 1 ? a.ka : a.va)) + ((size_t)((g * 2 + b) * 8 + h) * SEQ + perm_pos(g, t)) * HD;
#pragma unroll
            for (int j = 0; j < 4; ++j) { const int c = 16 * j + fr; float x1 = acc[j][r], x2 = acc[j + 4][r];
                if (which < 2) { float cs, sn; rope1(t, c, cs, sn); const float y1 = x1 * cs - x2 * sn, y2 = x2 * cs + x1 * sn; x1 = y1; x2 = y2; }
                base[c] = f2bf(x1); base[c + 64] = f2bf(x2); }
        } else if (ng < 96) {
            const int k = ng - 72;
            if (k < 20) {
                float ss = 0.f;
#pragma unroll
                for (int j = 0; j < 8; ++j) ss += acc[j][r] * acc[j][r];
                ss += __shfl_xor(ss, 1); ss += __shfl_xor(ss, 2); ss += __shfl_xor(ss, 4); ss += __shfl_xor(ss, 8);
                const float rinv = 1.0f / sqrtf(ss * (1.0f / 128.0f) + RMS_EPS);
                const float* gn = (k < 16) ? a.qg : a.kg;
                bf16_t* base = (k < 16) ? a.qb + ((size_t)(b * 16 + k) * SEQ + t) * HD : a.kb + ((size_t)(b * 4 + (k - 16)) * SEQ + t) * HD;
#pragma unroll
                for (int j = 0; j < 4; ++j) { const int c = 16 * j + fr; const float x1 = acc[j][r] * rinv * gn[c], x2 = acc[j + 4][r] * rinv * gn[c + 64];
                    float cs, sn; rope2(t, c, cs, sn); base[c] = f2bf(x1 * cs - x2 * sn); base[c + 64] = f2bf(x2 * cs + x1 * sn); }
            } else {
                bf16_t* base = a.vb + ((size_t)(b * 4 + (k - 20)) * SEQ + t) * HD;
#pragma unroll
                for (int j = 0; j < 8; ++j) base[16 * j + fr] = f2bf(acc[j][r]);
            }
        } else {
            bf16_t* base = a.gates + (size_t)m * 4096 + (ng - 96) * 128;
#pragma unroll
            for (int j = 0; j < 8; ++j) base[16 * j + fr] = f2bf(1.0f / (1.0f + __expf(-acc[j][r])));
        }
    }
}
struct P2Args { const bf16_t *q, *k, *v; bf16_t* o; float* lse; int mode; };
__global__ void __launch_bounds__(128) k_attn(P2Args a) {
    const int half = threadIdx.x & 1, qi = blockIdx.x * 64 + (threadIdx.x >> 1), sid = blockIdx.y;
    const bf16_t *Q, *K, *V; int k_lo, k_hi;
    if (a.mode == 0) { const int b = sid >> 4, hq = sid & 15; Q = a.q + (size_t)sid * SEQ * HD; K = a.k + (size_t)(b * 4 + (hq >> 2)) * SEQ * HD; V = a.v + (size_t)(b * 4 + (hq >> 2)) * SEQ * HD; k_lo = 0; k_hi = SEQ - 1; }
    else { const int g = sid >> 4; const int L = SEQ >> (2 * g); Q = a.q + (size_t)sid * SEQ * HD; K = a.k + (size_t)sid * SEQ * HD; V = a.v + (size_t)sid * SEQ * HD;
        const int r0 = (qi / L) * L, p = qi - r0; k_lo = r0 + (p - 64 > 0 ? p - 64 : 0); k_hi = r0 + (p + 64 < L - 1 ? p + 64 : L - 1); }
    float q[64], o[64];
    { const bf16_t* qp = Q + (size_t)qi * HD + half * 64;
#pragma unroll
      for (int d = 0; d < 64; ++d) { q[d] = bf2f(qp[d]) * SM_SCALE; o[d] = 0.f; } }
    float m = -1e30f, l = 0.f;
    for (int kk = k_lo; kk <= k_hi; ++kk) {
        const bf16_t* kp = K + (size_t)kk * HD + half * 64; const bf16_t* vp = V + (size_t)kk * HD + half * 64;
        float s = 0.f;
#pragma unroll
        for (int d = 0; d < 64; ++d) s += q[d] * bf2f(kp[d]);
        s += __shfl_xor(s, 1);
        const float mn = fmaxf(m, s), al = __expf(m - mn), p = __expf(s - mn);
        l = l * al + p; m = mn;
#pragma unroll
        for (int d = 0; d < 64; ++d) o[d] = o[d] * al + p * bf2f(vp[d]);
    }
    const float rl = 1.0f / l;
    if (a.mode == 0) { const int b = sid >> 4, hq = sid & 15; bf16_t* op = a.o + (size_t)(b * SEQ + qi) * 2048 + hq * HD + half * 64;
#pragma unroll
        for (int d = 0; d < 64; ++d) op[d] = f2bf(o[d] * rl); }
    else { const int g = sid >> 4, b = (sid >> 3) & 1, h = sid & 7; const int sh = 2 * g, L = SEQ >> sh; const int r = qi / L, p = qi - r * L, t = (p << sh) + r;
        const size_t mrow = (size_t)b * SEQ + t;
        bf16_t* op = a.o + ((size_t)g * NTOK + mrow) * 1024 + h * HD + half * 64;
#pragma unroll
        for (int d = 0; d < 64; ++d) op[d] = f2bf(o[d] * rl);
        if (half == 0) a.lse[((size_t)g * NTOK + mrow) * 8 + h] = m + __logf(l); }
}
__global__ void __launch_bounds__(256) k_merge(const bf16_t* __restrict__ oag, const float* __restrict__ lse, bf16_t* __restrict__ oa) {
    const size_t i = (size_t)blockIdx.x * 256 + threadIdx.x;
    const size_t m = i >> 10; const int c = (int)(i & 1023), h = c >> 7;
    const float l0 = lse[(0 * (size_t)NTOK + m) * 8 + h], l1 = lse[(1 * (size_t)NTOK + m) * 8 + h], l2 = lse[(2 * (size_t)NTOK + m) * 8 + h];
    const float mx = fmaxf(l0, fmaxf(l1, l2)); const float e0 = __expf(l0 - mx), e1 = __expf(l1 - mx), e2 = __expf(l2 - mx); const float inv = 1.0f / (e0 + e1 + e2);
    const float v = (e0 * bf2f(oag[(0 * (size_t)NTOK + m) * 1024 + c]) + e1 * bf2f(oag[(1 * (size_t)NTOK + m) * 1024 + c]) + e2 * bf2f(oag[(2 * (size_t)NTOK + m) * 1024 + c])) * inv;
    oa[i] = f2bf(v);
}
struct P3Args { const bf16_t* A; const bf16_t* Bt; int K; const bf16_t* gates; float* T; bf16_t* merged; const float* x; float* pre1; int mode; };
__global__ void __launch_bounds__(256) k_gemm3(P3Args a) {
    const int wave = threadIdx.x >> 6, lane = threadIdx.x & 63, fr = lane & 15, fq = lane >> 4;
    const int ng = blockIdx.x, mt = blockIdx.y * 4 + wave;
    f32x4 acc[8];
#pragma unroll
    for (int j = 0; j < 8; ++j) acc[j] = (f32x4){0.f, 0.f, 0.f, 0.f};
    wave_gemm16x128(a.A + (size_t)(mt * 16 + fr) * a.K, a.Bt + (size_t)ng * 128 * a.K, a.K, a.K, acc);
#pragma unroll
    for (int r = 0; r < 4; ++r) { const size_t m = (size_t)mt * 16 + fq * 4 + r;
#pragma unroll
        for (int j = 0; j < 8; ++j) { const int c = ng * 128 + 16 * j + fr; const size_t o = m * DM + c;
            if (a.mode == 0) a.T[o] = bf2f(a.gates[m * 4096 + c]) * acc[j][r];
            else if (a.mode == 1) a.merged[o] = f2bf(a.T[o] + bf2f(a.gates[m * 4096 + 2048 + c]) * acc[j][r]);
            else a.pre1[o] = ALPHA * a.x[o] + acc[j][r]; } }
}
struct RouteArgs { const float* g; const float* b; float* h1; bf16_t* h1b; const float* wg; const float* bg; const float* wr; const float* br; unsigned* cnt; int* tokidx; int* slot; const float* wt; };
__device__ __forceinline__ void ln1_route_row(const float* pre1, const RouteArgs& a, int m, int lane) {
    const f32x4* xr = (const f32x4*)(pre1 + (size_t)m * DM) + lane;
    f32x4 v[8]; float s = 0.f;
#pragma unroll
    for (int j = 0; j < 8; ++j) { v[j] = xr[64 * j]; s += (v[j].x + v[j].y) + (v[j].z + v[j].w); }
    const float mean = wave_sum(s) * (1.0f / DM); float s2 = 0.f;
#pragma unroll
    for (int j = 0; j < 8; ++j) { v[j] = v[j] - mean; s2 += (v[j].x * v[j].x + v[j].y * v[j].y) + (v[j].z * v[j].z + v[j].w * v[j].w); }
    const float rstd = 1.0f / sqrtf(wave_sum(s2) * (1.0f / DM) + LN_EPS);
    float gl[4] = {0.f, 0.f, 0.f, 0.f};
#pragma unroll
    for (int j = 0; j < 8; ++j) { const int c = 4 * lane + 256 * j; const f32x4 gg = *(const f32x4*)(a.g + c), bb = *(const f32x4*)(a.b + c);
        v[j] = v[j] * rstd * gg + bb;
        *(f32x4*)(a.h1 + (size_t)m * DM + c) = v[j];
        *(uint2*)(a.h1b + (size_t)m * DM + c) = make_uint2(pk2(v[j].x, v[j].y), pk2(v[j].z, v[j].w));
#pragma unroll
        for (int i = 0; i < 4; ++i) { const f32x4 w = *(const f32x4*)(a.wg + (size_t)(c + i) * 4); const float hv = v[j][i]; gl[0] += hv * w.x; gl[1] += hv * w.y; gl[2] += hv * w.z; gl[3] += hv * w.w; } }
#pragma unroll
    for (int i = 0; i < 4; ++i) gl[i] = wave_sum(gl[i]) + a.bg[i];
    int gi = 0; float gm = gl[0];
#pragma unroll
    for (int i = 1; i < 4; ++i) if (gl[i] > gm) { gm = gl[i]; gi = i; }
    float gs = 0.f;
#pragma unroll
    for (int i = 0; i < 4; ++i) gs += __expf(gl[i] - gm);
    const float ggate = 1.0f / gs;
    float el[8] = {0.f, 0.f, 0.f, 0.f, 0.f, 0.f, 0.f, 0.f};
#pragma unroll
    for (int j = 0; j < 8; ++j) { const int c = 4 * lane + 256 * j;
#pragma unroll
        for (int i = 0; i < 4; ++i) { const float* wp = a.wr + (size_t)(c + i) * 32 + gi * 8; const f32x4 w0 = *(const f32x4*)wp, w1 = *(const f32x4*)(wp + 4); const float hv = v[j][i];
            el[0] += hv * w0.x; el[1] += hv * w0.y; el[2] += hv * w0.z; el[3] += hv * w0.w; el[4] += hv * w1.x; el[5] += hv * w1.y; el[6] += hv * w1.z; el[7] += hv * w1.w; } }
#pragma unroll
    for (int i = 0; i < 8; ++i) el[i] = wave_sum(el[i]) + a.br[gi * 8 + i];
    int i1 = 0; float m1 = el[0];
#pragma unroll
    for (int i = 1; i < 8; ++i) if (el[i] > m1) { m1 = el[i]; i1 = i; }
    int i2 = -1; float m2 = -3.0e38f;
#pragma unroll
    for (int i = 0; i < 8; ++i) if (i != i1 && el[i] > m2) { m2 = el[i]; i2 = i; }
    const float e2 = __expf(m2 - m1); const float w1 = ggate / (1.0f + e2), w2 = ggate * e2 / (1.0f + e2);
    if (lane == 0) {
        const int ex1 = gi * 8 + i1, ex2 = gi * 8 + i2;
        const int p1 = (int)atomicAdd(a.cnt + ex1, 1u), p2 = (int)atomicAdd(a.cnt + ex2, 1u);
        a.tokidx[ex1 * ECAP + p1] = m; a.tokidx[ex2 * ECAP + p2] = m;
        int* sl = a.slot + (size_t)m * 6; sl[0] = ex1; sl[1] = ex2; sl[2] = p1; sl[3] = p2; ((float*)sl)[4] = w1; ((float*)sl)[5] = w2;
    }
}
template <int R, int VAR>
__device__ __forceinline__ void ln1_route_rows(const float* pre1, const RouteArgs& a, int m0, int ms, int lane, LAS unsigned* hist, LAS int* rinfo, int lr0, int lrs) {
    f32x4 v[R][8]; float s[R], s2[R];
#pragma unroll
    for (int i = 0; i < R; ++i) { const f32x4* xr = (const f32x4*)(pre1 + (size_t)(m0 + i * ms) * DM) + lane; s[i] = 0.f;
#pragma unroll
        for (int j = 0; j < 8; ++j) { v[i][j] = xr[64 * j]; s[i] += (v[i][j].x + v[i][j].y) + (v[i][j].z + v[i][j].w); } }
#pragma unroll
    for (int o = 1; o < 64; o <<= 1)
#pragma unroll
        for (int i = 0; i < R; ++i) s[i] += __shfl_xor(s[i], o);
#pragma unroll
    for (int i = 0; i < R; ++i) { const float mean = s[i] * (1.0f / DM); s2[i] = 0.f;
#pragma unroll
        for (int j = 0; j < 8; ++j) { v[i][j] = v[i][j] - mean; s2[i] += (v[i][j].x * v[i][j].x + v[i][j].y * v[i][j].y) + (v[i][j].z * v[i][j].z + v[i][j].w * v[i][j].w); } }
#pragma unroll
    for (int o = 1; o < 64; o <<= 1)
#pragma unroll
        for (int i = 0; i < R; ++i) s2[i] += __shfl_xor(s2[i], o);
#pragma unroll
    for (int j = 0; j < 8; ++j) { const int c = 4 * lane + 256 * j; const f32x4 gg = *(const f32x4*)(a.g + c), bb = *(const f32x4*)(a.b + c);
#pragma unroll
        for (int i = 0; i < R; ++i) { const float rstd = 1.0f / sqrtf(s2[i] * (1.0f / DM) + LN_EPS); const size_t o = (size_t)(m0 + i * ms) * DM + c;
            v[i][j] = v[i][j] * rstd * gg + bb;
            *(f32x4*)(a.h1 + o) = v[i][j];
            *(uint2*)(a.h1b + o) = make_uint2(pk2(v[i][j].x, v[i][j].y), pk2(v[i][j].z, v[i][j].w)); } }
    if constexpr (VAR == 51) return;
    float gl[R][4];
#pragma unroll
    for (int c = 0; c < 4; ++c) { const f32x4* wp = (const f32x4*)(a.wt + (size_t)c * DM) + lane;
#pragma unroll
        for (int i = 0; i < R; ++i) gl[i][c] = 0.f;
#pragma unroll
        for (int j = 0; j < 8; ++j) { const f32x4 w = wp[64 * j];
#pragma unroll
            for (int i = 0; i < R; ++i) gl[i][c] += (v[i][j].x * w.x + v[i][j].y * w.y) + (v[i][j].z * w.z + v[i][j].w * w.w); }
        if (c & 1) __builtin_amdgcn_sched_barrier(0); }
#pragma unroll
    for (int o = 1; o < 64; o <<= 1)
#pragma unroll
        for (int i = 0; i < R; ++i)
#pragma unroll
            for (int c = 0; c < 4; ++c) gl[i][c] += __shfl_xor(gl[i][c], o);
    int gi[R]; float ggate[R];
#pragma unroll
    for (int i = 0; i < R; ++i) { float g0 = gl[i][0] + a.bg[0], g1 = gl[i][1] + a.bg[1], g2 = gl[i][2] + a.bg[2], g3 = gl[i][3] + a.bg[3];
        int q = 0; float gm = g0; if (g1 > gm) { gm = g1; q = 1; } if (g2 > gm) { gm = g2; q = 2; } if (g3 > gm) { gm = g3; q = 3; }
        ggate[i] = 1.0f / (__expf(g0 - gm) + __expf(g1 - gm) + __expf(g2 - gm) + __expf(g3 - gm)); gi[i] = __builtin_amdgcn_readfirstlane(q); }
    float el[R][8];
#pragma unroll
    for (int c = 0; c < 8; ++c) {
#pragma unroll
        for (int i = 0; i < R; ++i) { const f32x4* wp = (const f32x4*)(a.wt + (size_t)(4 + gi[i] * 8 + c) * DM) + lane; float acc = 0.f;
#pragma unroll
            for (int j = 0; j < 8; ++j) { const f32x4 w = wp[64 * j]; acc += (v[i][j].x * w.x + v[i][j].y * w.y) + (v[i][j].z * w.z + v[i][j].w * w.w); }
            el[i][c] = acc; }
        __builtin_amdgcn_sched_barrier(0); }
#pragma unroll
    for (int o = 1; o < 64; o <<= 1)
#pragma unroll
        for (int i = 0; i < R; ++i)
#pragma unroll
            for (int c = 0; c < 8; ++c) el[i][c] += __shfl_xor(el[i][c], o);
#pragma unroll
    for (int i = 0; i < R; ++i) { const int m = m0 + i * ms;
        int i1 = 0; float m1 = el[i][0] + a.br[gi[i] * 8];
        float ev[8];
#pragma unroll
        for (int c = 0; c < 8; ++c) ev[c] = el[i][c] + a.br[gi[i] * 8 + c];
#pragma unroll
        for (int c = 1; c < 8; ++c) if (ev[c] > m1) { m1 = ev[c]; i1 = c; }
        int i2 = -1; float m2 = -3.0e38f;
#pragma unroll
        for (int c = 0; c < 8; ++c) if (c != i1 && ev[c] > m2) { m2 = ev[c]; i2 = c; }
        const float e2 = __expf(m2 - m1); const float w1 = ggate[i] / (1.0f + e2), w2 = ggate[i] * e2 / (1.0f + e2);
        if (lane == 0) {
            const int ex1 = gi[i] * 8 + i1, ex2 = gi[i] * 8 + i2;
            const int p1 = (int)__hip_atomic_fetch_add(hist + ex1, 1u, __ATOMIC_RELAXED, __HIP_MEMORY_SCOPE_WORKGROUP), p2 = (int)__hip_atomic_fetch_add(hist + ex2, 1u, __ATOMIC_RELAXED, __HIP_MEMORY_SCOPE_WORKGROUP);
            LAS int* ri = rinfo + (lr0 + i * lrs) * 8; ri[0] = ex1; ri[1] = ex2; ri[2] = p1; ri[3] = p2; ((LAS float*)ri)[4] = w1; ((LAS float*)ri)[5] = w2; ri[6] = m;
        } }
}
__global__ void __launch_bounds__(256) k_ln1_route(const float* pre1, RouteArgs a) { ln1_route_row(pre1, a, blockIdx.x * 4 + (threadIdx.x >> 6), threadIdx.x & 63); }

__device__ __forceinline__ int row_start(const unsigned* cnt, int e) { int s = 0; for (int i = 0; i < e; ++i) s += ((int)cnt[i] + 255) & ~255; return s; }
struct P6Args { const bf16_t* h1b; const bf16_t* wgut; const bf16_t* wdt; const unsigned* cnt; const int* tokidx; bf16_t* act; bf16_t* y; };
__global__ void __launch_bounds__(256) k_moe_up(P6Args a) {
    const int wave = threadIdx.x >> 6, lane = threadIdx.x & 63, fr = lane & 15, fq = lane >> 4;
    const int R0 = blockIdx.y * 64;
    int e = 0, rs = 0;
    for (; e < NEXP; ++e) { const int n = ((int)a.cnt[e] + 255) & ~255; if (R0 < rs + n) break; rs += n; }
    if (e == NEXP) return;
    const int pos = R0 - rs + wave * 16 + fr; const int tok = pos < (int)a.cnt[e] ? a.tokidx[e * ECAP + pos] : 0;
    const int jb = blockIdx.x;
    f32x4 ag[8], au[8];
#pragma unroll
    for (int j = 0; j < 8; ++j) { ag[j] = (f32x4){0.f, 0.f, 0.f, 0.f}; au[j] = (f32x4){0.f, 0.f, 0.f, 0.f}; }
    const bf16_t* wb = a.wgut + ((size_t)e * 2048 + jb * 256) * DM;
    wave_gemm16x128(a.h1b + (size_t)tok * DM, wb, DM, DM, ag);
    wave_gemm16x128(a.h1b + (size_t)tok * DM, wb + (size_t)128 * DM, DM, DM, au);
#pragma unroll
    for (int r = 0; r < 4; ++r) { const size_t row = (size_t)R0 + wave * 16 + fq * 4 + r;
#pragma unroll
        for (int j = 0; j < 8; ++j) { const float g = ag[j][r], u = au[j][r]; a.act[row * FF + jb * 128 + 16 * j + fr] = f2bf(g / (1.0f + __expf(-g)) * u); } }
}
__global__ void __launch_bounds__(256) k_moe_down(P6Args a) {
    const int wave = threadIdx.x >> 6, lane = threadIdx.x & 63, fr = lane & 15, fq = lane >> 4;
    const int R0 = blockIdx.y * 64;
    int e = 0, rs = 0;
    for (; e < NEXP; ++e) { const int n = ((int)a.cnt[e] + 255) & ~255; if (R0 < rs + n) break; rs += n; }
    if (e == NEXP) return;
    f32x4 acc[8];
#pragma unroll
    for (int j = 0; j < 8; ++j) acc[j] = (f32x4){0.f, 0.f, 0.f, 0.f};
    wave_gemm16x128(a.act + ((size_t)R0 + wave * 16 + fr) * FF, a.wdt + ((size_t)e * 2048 + blockIdx.x * 128) * FF, FF, FF, acc);
#pragma unroll
    for (int r = 0; r < 4; ++r) { const size_t row = (size_t)R0 + wave * 16 + fq * 4 + r;
#pragma unroll
        for (int j = 0; j < 8; ++j) a.y[row * DM + blockIdx.x * 128 + 16 * j + fr] = f2bf(acc[j][r]); }
}
struct P8Args { const float* h1; const bf16_t* y; const unsigned* cnt; const int* slot; const float* g; const float* b; float* out; };
__device__ __forceinline__ void final_row(const P8Args& a, int m, int lane, size_t r1, size_t r2, float w1, float w2) {
    f32x4 v[8]; float s = 0.f;
#pragma unroll
    for (int j = 0; j < 8; ++j) { const int c = 4 * lane + 256 * j; const f32x4 hv = *(const f32x4*)(a.h1 + (size_t)m * DM + c);
        const uint2 ya = *(const uint2*)(a.y + r1 * DM + c), yb = *(const uint2*)(a.y + r2 * DM + c);
        f32x4 f; f.x = w1 * bflo(ya.x) + w2 * bflo(yb.x); f.y = w1 * bfhi(ya.x) + w2 * bfhi(yb.x); f.z = w1 * bflo(ya.y) + w2 * bflo(yb.y); f.w = w1 * bfhi(ya.y) + w2 * bfhi(yb.y);
        v[j] = hv * ALPHA + f; s += (v[j].x + v[j].y) + (v[j].z + v[j].w); }
    const float mean = wave_sum(s) * (1.0f / DM); float s2 = 0.f;
#pragma unroll
    for (int j = 0; j < 8; ++j) { v[j] = v[j] - mean; s2 += (v[j].x * v[j].x + v[j].y * v[j].y) + (v[j].z * v[j].z + v[j].w * v[j].w); }
    const float rstd = 1.0f / sqrtf(wave_sum(s2) * (1.0f / DM) + LN_EPS);
#pragma unroll
    for (int j = 0; j < 8; ++j) { const int c = 4 * lane + 256 * j; const f32x4 gg = *(const f32x4*)(a.g + c), bb = *(const f32x4*)(a.b + c);
        *(f32x4*)(a.out + (size_t)m * DM + c) = v[j] * rstd * gg + bb; }
}
__global__ void __launch_bounds__(256) k_final(P8Args a) {
    const int lane = threadIdx.x & 63, m = blockIdx.x * 4 + (threadIdx.x >> 6);
    const int* sl = a.slot + (size_t)m * 6; const int e1 = sl[0], e2 = sl[1], p1 = sl[2], p2 = sl[3]; const float w1 = ((const float*)sl)[4], w2 = ((const float*)sl)[5];
    final_row(a, m, lane, (size_t)row_start(a.cnt, e1) + p1, (size_t)row_start(a.cnt, e2) + p2, w1, w2);
}

namespace pg8 {
constexpr int BM = 256, BK = 64, HALF = 128, HTB = HALF * BK * 2  , STAGE_BYTES = 8 * HTB;
__device__ __forceinline__ int lds_byte(int r, int c) { const int st = (r >> 4) * 2 + (c >> 5), rr = r & 15, cc = c & 31, ob = rr * 64 + cc * 2; return st * 1024 + (ob ^ (((ob >> 9) & 1) << 5)); }
__device__ __forceinline__ void stage_rc(int b, int& R, int& C) { const int st = b / 1024, sb = b % 1024, swz = sb ^ (((sb >> 9) & 1) << 5); R = (st >> 1) * 16 + swz / 64; C = (st & 1) * 32 + (swz % 64) / 2; }

struct Unit { const char* A; const char* B; unsigned lda, ldb; int nt; int pm, pn, aux; const int* gidx; int gcnt; };
struct Voff { unsigned a[2][2], b[2][2]; };
__device__ __forceinline__ int brow_perm8(int h, int R) { return 128 * h + (R & ~31) + 8 * ((R >> 2) & 3) + 4 * ((R >> 4) & 1) + (R & 3); }
__device__ __forceinline__ int brow_rope(int h, int R) { return 128 * (R >> 6) + 64 * h + 32 * ((R >> 5) & 1) + 8 * ((R >> 2) & 3) + 4 * ((R >> 4) & 1) + (R & 3); }

template <class Epi> __device__ __forceinline__ void make_voff(const Unit& u, Voff& v, int tid) {
#pragma unroll
    for (int i = 0; i < 2; ++i) { int R, C; stage_rc(tid * 16 + i * 8192, R, C);
#pragma unroll
        for (int h = 0; h < 2; ++h) {
            int ra = h * HALF + R;
            if (u.gidx) ra = (ra < u.gcnt) ? u.gidx[ra] : 0;
            v.a[h][i] = (unsigned)ra * u.lda + (unsigned)C * 2u;
            v.b[h][i] = (unsigned)Epi::brow(h, R) * u.ldb + (unsigned)C * 2u;
        } }
}

template <class Epi, class Sched, bool ALIGN_EPI, bool SP2>
__device__ __forceinline__ void gemm_phase(LAS unsigned char* lds, LAS unsigned char* ex, const Sched& S, const Epi& E, int wid) {
    const int lane = lane_id(), tid = wid * 64 + lane, wr = wid >> 2, wc = wid & 3, fr = lane & 15, fq = lane >> 4;
    const unsigned ldsw = (unsigned)wid * 1024u;
    const int aoff = lds_byte(wr * 64 + fr, fq * 8), boff = lds_byte(wc * 32 + fr, fq * 8);
#define PG8_SA(b, h) (((b) * 2 + (h)) * HTB)
#define PG8_SB(b, h) ((4 + (b) * 2 + (h)) * HTB)
#define PG8_STAGE(bufoff, gbase, voff) do { _Pragma("unroll") for (int _i = 0; _i < 2; ++_i) \
        __builtin_amdgcn_global_load_lds((const unsigned*)((const char*)(gbase) + (voff)[_i]), (LAS unsigned*)(lds + (bufoff) + ldsw + _i * 8192), 16, 0, 0); } while (0)
#define PG8_LDA(dst, b, h) do { _Pragma("unroll") for (int m = 0; m < 4; ++m) _Pragma("unroll") for (int k = 0; k < 2; ++k) dst[m][k] = *(const LAS bf16x8*)(lds + PG8_SA(b, h) + aoff + m * 2048 + k * 1024); } while (0)
#define PG8_LDB(dst, b, h) do { _Pragma("unroll") for (int n = 0; n < 2; ++n) _Pragma("unroll") for (int k = 0; k < 2; ++k) dst[n][k] = *(const LAS bf16x8*)(lds + PG8_SB(b, h) + boff + n * 2048 + k * 1024); } while (0)
#define PG8_MMA(ai, bj, At, Bt) do { __builtin_amdgcn_s_setprio(1); _Pragma("unroll") for (int m = 0; m < 4; ++m) _Pragma("unroll") for (int n = 0; n < 2; ++n) _Pragma("unroll") for (int k = 0; k < 2; ++k) \
        acc[ai][bj][m][n] = __builtin_amdgcn_mfma_f32_16x16x32_bf16(Bt[n][k], At[m][k], acc[ai][bj][m][n], 0, 0, 0); __builtin_amdgcn_s_setprio(0); } while (0)
#define PG8_WAIT_V(n) asm volatile("s_waitcnt vmcnt(" #n ")" ::: "memory")
#define PG8_WAIT_L(n) asm volatile("s_waitcnt lgkmcnt(" #n ")" ::: "memory")
#define PG8_BAR __builtin_amdgcn_s_barrier()
#define PG8_SCHED __builtin_amdgcn_sched_barrier(0)
    Unit cur, nxt; int ui = 0;
    if (!S.next(0, cur)) return;
    Voff vo, nvo;
    make_voff<Epi>(cur, vo, tid);
    f32x4 acc[2][2][4][2];
#pragma unroll
    for (int a = 0; a < 2; ++a)
#pragma unroll
        for (int b = 0; b < 2; ++b)
#pragma unroll
            for (int m = 0; m < 4; ++m)
#pragma unroll
                for (int n = 0; n < 2; ++n) acc[a][b][m][n] = (f32x4){0.f, 0.f, 0.f, 0.f};
    bf16x8 At[4][2], B0[2][2], B1[2][2];
    const char* cA = cur.A; const char* cB = cur.B;
    const size_t kstep = (size_t)(BK * 2);
    if constexpr (SP2) {
        PG8_STAGE(PG8_SB(0, 0), cB, vo.b[0]); PG8_STAGE(PG8_SB(0, 1), cB, vo.b[1]); PG8_STAGE(PG8_SA(0, 0), cA, vo.a[0]); PG8_STAGE(PG8_SA(0, 1), cA, vo.a[1]);
        if (wr == 1) PG8_BAR;
        PG8_WAIT_V(2); PG8_BAR;
        PG8_STAGE(PG8_SB(1, 0), cB + kstep, vo.b[0]); PG8_STAGE(PG8_SA(1, 0), cA + kstep, vo.a[0]); PG8_STAGE(PG8_SB(1, 1), cB + kstep, vo.b[1]);
        PG8_WAIT_V(6); PG8_BAR;
    } else {
        PG8_STAGE(PG8_SB(0, 0), cB, vo.b[0]); PG8_STAGE(PG8_SA(0, 0), cA, vo.a[0]); PG8_STAGE(PG8_SB(0, 1), cB, vo.b[1]); PG8_STAGE(PG8_SA(0, 1), cA, vo.a[1]);
        if (wr == 1) PG8_BAR;
        PG8_WAIT_V(4); PG8_BAR;
        PG8_STAGE(PG8_SB(1, 0), cB + kstep, vo.b[0]); PG8_STAGE(PG8_SA(1, 0), cA + kstep, vo.a[0]); PG8_STAGE(PG8_SB(1, 1), cB + kstep, vo.b[1]);
        PG8_WAIT_V(6); PG8_BAR;
    }
    for (;;) {
        const bool has_next = S.next(ui + 1, nxt);
        if (has_next) make_voff<Epi>(nxt, nvo, tid); else nvo = vo;
        const char* nA = has_next ? nxt.A : cA; const char* nB = has_next ? nxt.B : cB;
        const int nt = cur.nt;
        for (int t = 0; t < nt; t += 2) {
            const bool last = (t == nt - 2);
            const char* a1 = cA + (size_t)(t + 1) * kstep;
            const char* a2 = last ? nA : cA + (size_t)(t + 2) * kstep; const char* b2 = last ? nB : cB + (size_t)(t + 2) * kstep;
            const char* a3 = a2 + kstep; const char* b3 = b2 + kstep;
            Voff w;
#pragma unroll
            for (int h = 0; h < 2; ++h)
#pragma unroll
                for (int i = 0; i < 2; ++i) { w.a[h][i] = last ? nvo.a[h][i] : vo.a[h][i]; w.b[h][i] = last ? nvo.b[h][i] : vo.b[h][i]; }
            if constexpr (SP2) {
            PG8_LDB(B0, 0, 0); PG8_LDB(B1, 0, 1); PG8_SCHED; PG8_LDA(At, 0, 0); PG8_STAGE(PG8_SA(1, 1), a1, vo.a[1]);
            PG8_WAIT_V(8); PG8_WAIT_L(0); PG8_BAR; PG8_MMA(0, 0, At, B0); PG8_MMA(0, 1, At, B1); PG8_BAR; PG8_SCHED;
            PG8_LDA(At, 0, 1); PG8_STAGE(PG8_SB(0, 0), b2, w.b[0]); PG8_STAGE(PG8_SB(0, 1), b2, w.b[1]); PG8_STAGE(PG8_SA(0, 0), a2, w.a[0]);
            PG8_WAIT_V(8); PG8_WAIT_L(0); PG8_BAR; PG8_MMA(1, 0, At, B0); PG8_MMA(1, 1, At, B1); PG8_BAR; PG8_SCHED;
            PG8_LDB(B0, 1, 0); PG8_LDB(B1, 1, 1); PG8_SCHED; PG8_LDA(At, 1, 0); PG8_STAGE(PG8_SA(0, 1), a2, w.a[1]);
            PG8_WAIT_V(8); PG8_WAIT_L(0); PG8_BAR; PG8_MMA(0, 0, At, B0); PG8_MMA(0, 1, At, B1); PG8_BAR; PG8_SCHED;
            PG8_LDA(At, 1, 1); PG8_STAGE(PG8_SB(1, 0), b3, w.b[0]); PG8_STAGE(PG8_SB(1, 1), b3, w.b[1]); PG8_STAGE(PG8_SA(1, 0), a3, w.a[0]);
            PG8_WAIT_V(8); PG8_WAIT_L(0); PG8_BAR; PG8_MMA(1, 0, At, B0); PG8_MMA(1, 1, At, B1); PG8_BAR; PG8_SCHED;
            } else {
            PG8_LDB(B0, 0, 0); PG8_SCHED; PG8_LDA(At, 0, 0); PG8_STAGE(PG8_SA(1, 1), a1, vo.a[1]);
            PG8_WAIT_L(8); PG8_BAR; PG8_WAIT_L(0); PG8_MMA(0, 0, At, B0); PG8_BAR; PG8_SCHED;
            PG8_LDB(B1, 0, 1); PG8_STAGE(PG8_SB(0, 0), b2, w.b[0]);
            PG8_BAR; PG8_WAIT_L(0); PG8_MMA(0, 1, At, B1); PG8_BAR;
            PG8_LDA(At, 0, 1); PG8_STAGE(PG8_SA(0, 0), a2, w.a[0]);
            PG8_BAR; PG8_WAIT_L(0); PG8_MMA(1, 0, At, B0); PG8_BAR; PG8_SCHED;
            PG8_STAGE(PG8_SB(0, 1), b2, w.b[1]);
            PG8_WAIT_V(6); PG8_BAR; PG8_MMA(1, 1, At, B1); PG8_BAR;
            PG8_LDB(B0, 1, 0); PG8_SCHED; PG8_LDA(At, 1, 0); PG8_STAGE(PG8_SA(0, 1), a2, w.a[1]);
            PG8_WAIT_L(8); PG8_BAR; PG8_WAIT_L(0); PG8_MMA(0, 0, At, B0); PG8_BAR; PG8_SCHED;
            PG8_LDB(B1, 1, 1); PG8_STAGE(PG8_SB(1, 0), b3, w.b[0]);
            PG8_BAR; PG8_WAIT_L(0); PG8_MMA(0, 1, At, B1); PG8_BAR;
            PG8_LDA(At, 1, 1); PG8_STAGE(PG8_SA(1, 0), a3, w.a[0]);
            PG8_BAR; PG8_WAIT_L(0); PG8_MMA(1, 0, At, B0); PG8_BAR; PG8_SCHED;
            PG8_STAGE(PG8_SB(1, 1), b3, w.b[1]);
            PG8_WAIT_V(6); PG8_BAR; PG8_MMA(1, 1, At, B1); PG8_BAR;
            }
        }
        if constexpr (ALIGN_EPI) { if (wr == 0) PG8_BAR; }
        E(acc, cur, wr, wc, fr, fq, ex);
        if (!has_next) break;
#pragma unroll
        for (int a = 0; a < 2; ++a)
#pragma unroll
            for (int b = 0; b < 2; ++b)
#pragma unroll
                for (int m = 0; m < 4; ++m)
#pragma unroll
                    for (int n = 0; n < 2; ++n) acc[a][b][m][n] = (f32x4){0.f, 0.f, 0.f, 0.f};
        cur = nxt; cA = nA; cB = nB; vo = nvo; ++ui;
        if constexpr (ALIGN_EPI) { if (wr == 1) PG8_BAR; }
    }
    PG8_WAIT_V(0);
    if constexpr (!ALIGN_EPI) { if (wr == 0) PG8_BAR; }
    PG8_BAR;
#undef PG8_SA
#undef PG8_SB
#undef PG8_STAGE
#undef PG8_LDA
#undef PG8_LDB
#undef PG8_MMA
#undef PG8_WAIT_V
#undef PG8_WAIT_L
#undef PG8_BAR
#undef PG8_SCHED
}

struct TileOrder {
    int nM, nN, nwg, G, c;
    __device__ void init(int M, int N, int G_, int c_) { nM = M / BM; nN = N / BM; nwg = nM * nN; G = G_; c = c_; }
    __device__ bool tile(int i, int& pm, int& pn) const {
        const long L = (long)i * G + c; if (L >= nwg) return false;
        int wgid = (int)L; { const int q = nwg / 8, r = nwg % 8, xcd = wgid % 8, off = wgid / 8; wgid = (xcd < r ? xcd * (q + 1) : r * (q + 1) + (xcd - r) * q) + off; }
        const int nig = 8 * nN, gid = wgid / nig, fm = gid * 8, gsz = (nM - fm) < 8 ? (nM - fm) : 8;
        pm = fm + ((wgid % nig) % gsz); pn = (wgid % nig) / gsz; return true;
    }
};
}

typedef float f32x2 __attribute__((ext_vector_type(2)));
#define ACC_T f32x4 (&acc)[2][2][4][2]

struct EpiProj {
    __device__ static __forceinline__ int brow(int h, int R) { return pg8::brow_rope(h, R); }
    unsigned char* ws; const float *qg, *kg;
    __device__ static __forceinline__ void rot4(const f32x4 x1, const f32x4 x2, const f32x4 t0, const f32x4 t1, f32x4& y1, f32x4& y2) {
        y1.x = x1.x * t0.x - x2.x * t0.y; y2.x = x2.x * t0.x + x1.x * t0.y;
        y1.y = x1.y * t0.z - x2.y * t0.w; y2.y = x2.y * t0.z + x1.y * t0.w;
        y1.z = x1.z * t1.x - x2.z * t1.y; y2.z = x2.z * t1.x + x1.z * t1.y;
        y1.w = x1.w * t1.z - x2.w * t1.w; y2.w = x2.w * t1.z + x1.w * t1.w;
    }
    __device__ static __forceinline__ void store8(bf16_t* dst, const f32x4 a, const f32x4 b) {
        u32x4 w; w.x = cvtpk(a.x, a.y); w.y = cvtpk(a.z, a.w); w.z = cvtpk(b.x, b.y); w.w = cvtpk(b.z, b.w); *(u32x4*)dst = w; }
    __device__ __forceinline__ void operator()(ACC_T, const pg8::Unit& u, int wr, int wc, int fr, int fq, LAS unsigned char* ex) const {
        const int ng = 2 * u.pn + (wc >> 1), c0 = 32 * (wc & 1) + 8 * fq;
        if (ng < 72) {
            const int which = ng / 24, hh = ng % 24, g = hh >> 3, h = hh & 7;
            bf16_t* buf = (bf16_t*)(ws + WS_QA + (size_t)which * (WS_KA - WS_QA));
            const float2* rt1 = (const float2*)(ws + WS_RT1);
#pragma unroll
            for (int ai = 0; ai < 2; ++ai)
#pragma unroll
                for (int m = 0; m < 4; ++m) {
                    const int mrow = u.pm * 256 + ai * 128 + wr * 64 + m * 16 + fr, b = mrow >> 12, t = mrow & 4095;
                    bf16_t* dst = buf + ((size_t)((g * 2 + b) * 8 + h) * SEQ + perm_pos(g, t)) * HD + c0;
                    f32x4 y1a = acc[ai][0][m][0], y1b = acc[ai][0][m][1], y2a = acc[ai][1][m][0], y2b = acc[ai][1][m][1];
                    if (which < 2) {
                        const f32x4* tp = (const f32x4*)(rt1 + (size_t)t * 64 + c0);
                        const f32x4 t0 = tp[0], t1 = tp[1], t2 = tp[2], t3 = tp[3];
                        rot4(acc[ai][0][m][0], acc[ai][1][m][0], t0, t1, y1a, y2a); rot4(acc[ai][0][m][1], acc[ai][1][m][1], t2, t3, y1b, y2b);
                    }
                    store8(dst, y1a, y1b); store8(dst + 64, y2a, y2b);
                }
        } else if (ng < 92) {
            const int k = ng - 72;
            LAS float* X = (LAS float*)ex;
#pragma unroll
            for (int ai = 0; ai < 2; ++ai)
#pragma unroll
                for (int m = 0; m < 4; ++m) { float s = 0.f;
#pragma unroll
                    for (int bj = 0; bj < 2; ++bj)
#pragma unroll
                        for (int n = 0; n < 2; ++n) { const f32x4 x = acc[ai][bj][m][n]; s += (x.x * x.x + x.y * x.y) + (x.z * x.z + x.w * x.w); }
                    s += __shfl_xor(s, 16); s += __shfl_xor(s, 32);
                    if (fq == 0) X[(ai * 128 + wr * 64 + m * 16 + fr) * 4 + wc] = s; }
            asm volatile("s_waitcnt lgkmcnt(0)" ::: "memory"); __builtin_amdgcn_s_barrier(); asm volatile("" ::: "memory");
            const float* gn = (k < 16) ? qg : kg; const float2* rt2 = (const float2*)(ws + WS_RT2);
            bf16_t* qb = (bf16_t*)(ws + WS_QB); bf16_t* kb = (bf16_t*)(ws + WS_KB);
            const f32x4 g1a = *(const f32x4*)(gn + c0), g1b = *(const f32x4*)(gn + c0 + 4), g2a = *(const f32x4*)(gn + 64 + c0), g2b = *(const f32x4*)(gn + 64 + c0 + 4);
#pragma unroll
            for (int ai = 0; ai < 2; ++ai)
#pragma unroll
                for (int m = 0; m < 4; ++m) {
                    const int r = ai * 128 + wr * 64 + m * 16 + fr;
                    const float ssum = X[r * 4 + (wc & 2)] + X[r * 4 + (wc & 2) + 1];
                    const int mrow = u.pm * 256 + r, b = mrow >> 12, t = mrow & 4095;
                    bf16_t* dst = ((k < 16) ? qb + ((size_t)(b * 16 + k) * SEQ + t) * HD : kb + ((size_t)(b * 4 + (k - 16)) * SEQ + t) * HD) + c0;
                    const float rinv = 1.0f / sqrtf(ssum * (1.0f / 128.0f) + RMS_EPS);
                    const f32x4* tp = (const f32x4*)(rt2 + (size_t)t * 64 + c0);
                    const f32x4 t0 = tp[0], t1 = tp[1], t2 = tp[2], t3 = tp[3];
                    f32x4 y1a, y1b, y2a, y2b;
                    rot4(acc[ai][0][m][0] * rinv * g1a, acc[ai][1][m][0] * rinv * g2a, t0, t1, y1a, y2a); rot4(acc[ai][0][m][1] * rinv * g1b, acc[ai][1][m][1] * rinv * g2b, t2, t3, y1b, y2b);
                    store8(dst, y1a, y1b); store8(dst + 64, y2a, y2b);
                }
        } else {
#pragma unroll
            for (int ai = 0; ai < 2; ++ai)
#pragma unroll
                for (int m = 0; m < 4; ++m) {
                    const int mrow = u.pm * 256 + ai * 128 + wr * 64 + m * 16 + fr, b = mrow >> 12, t = mrow & 4095;
                    bf16_t* dst = (ng < 96 ? (bf16_t*)(ws + WS_VB) + ((size_t)(b * 4 + (ng - 92)) * SEQ + t) * HD : (bf16_t*)(ws + WS_GATES) + (size_t)mrow * 4096 + (ng - 96) * 128) + c0;
                    f32x4 y1a = acc[ai][0][m][0], y1b = acc[ai][0][m][1], y2a = acc[ai][1][m][0], y2b = acc[ai][1][m][1];
                    if (ng >= 96) {
#pragma unroll
                        for (int q = 0; q < 4; ++q) { y1a[q] = __builtin_amdgcn_rcpf(1.0f + __expf(-y1a[q])); y1b[q] = __builtin_amdgcn_rcpf(1.0f + __expf(-y1b[q]));
                            y2a[q] = __builtin_amdgcn_rcpf(1.0f + __expf(-y2a[q])); y2b[q] = __builtin_amdgcn_rcpf(1.0f + __expf(-y2b[q])); } }
                    store8(dst, y1a, y1b); store8(dst + 64, y2a, y2b);
                }
        }
    }
};
struct ProjSched {
    pg8::TileOrder o; const char* ws;
    __device__ __forceinline__ bool next(int i, pg8::Unit& u) const { int pm, pn; if (!o.tile(i, pm, pn)) return false;
        u.A = ws + WS_XB + (size_t)pm * 256 * (DM * 2); u.B = ws + WS_WINT + (size_t)pn * 256 * (DM * 2); u.lda = DM * 2; u.ldb = DM * 2; u.nt = DM / 64; u.pm = pm; u.pn = pn; u.aux = 0; u.gidx = nullptr; u.gcnt = 0; return true; }
};

struct EpiMix {
    __device__ static __forceinline__ int brow(int h, int R) { return pg8::brow_perm8(h, R); }
    unsigned char* ws; const float* x;
    __device__ __forceinline__ void operator()(ACC_T, const pg8::Unit& u, int wr, int wc, int fr, int fq, LAS unsigned char* ex) const {
        const bf16_t* gates = (const bf16_t*)(ws + WS_GATES); float* T = (float*)(ws + WS_T); bf16_t* merged = (bf16_t*)(ws + WS_MERGED); float* pre1 = (float*)(ws + WS_PRE1);
#pragma unroll
        for (int ai = 0; ai < 2; ++ai)
#pragma unroll
            for (int m = 0; m < 4; ++m) { const size_t mrow = (size_t)u.pm * 256 + ai * 128 + wr * 64 + m * 16 + fr;
#pragma unroll
                for (int bj = 0; bj < 2; ++bj) { const int col = u.pn * 256 + bj * 128 + wc * 32 + 8 * fq; const size_t o = mrow * DM + col;
                    const f32x4 a0 = acc[ai][bj][m][0], a1 = acc[ai][bj][m][1];
                    if (u.aux == 2) {
                        const f32x4 x0 = *(const f32x4*)(x + o), x1 = *(const f32x4*)(x + o + 4);
                        *(f32x4*)(pre1 + o) = x0 * ALPHA + a0; *(f32x4*)(pre1 + o + 4) = x1 * ALPHA + a1;
                    } else {
                        const u32x4 gw = *(const u32x4*)(gates + mrow * 4096 + (u.aux ? 2048 : 0) + col);
                        f32x4 g0, g1; g0.x = bflo(gw.x); g0.y = bfhi(gw.x); g0.z = bflo(gw.y); g0.w = bfhi(gw.y); g1.x = bflo(gw.z); g1.y = bfhi(gw.z); g1.z = bflo(gw.w); g1.w = bfhi(gw.w);
                        if (u.aux == 0) { *(f32x4*)(T + o) = g0 * a0; *(f32x4*)(T + o + 4) = g1 * a1; }
                        else { const f32x4 t0 = *(const f32x4*)(T + o) + g0 * a0, t1 = *(const f32x4*)(T + o + 4) + g1 * a1;
                            u32x4 w; w.x = cvtpk(t0.x, t0.y); w.y = cvtpk(t0.z, t0.w); w.z = cvtpk(t1.x, t1.y); w.w = cvtpk(t1.z, t1.w); *(u32x4*)(merged + o) = w; }
                    } } }
    }
};
struct MixSched {
    int mode, c; const char* ws;
    __device__ __forceinline__ bool next(int i, pg8::Unit& u) const {
        if (c >= 256) return false;
        const int pm = c >> 3, pn = c & 7; u.pm = pm; u.pn = pn; u.gidx = nullptr; u.gcnt = 0;
        if (mode == 0) { if (i > 1) return false;
            if (i == 0) { u.A = ws + WS_OA + (size_t)pm * 256 * 2048; u.B = ws + WS_WAT + (size_t)pn * 256 * 2048; u.lda = 2048; u.ldb = 2048; u.nt = 16; u.aux = 0; }
            else { u.A = ws + WS_OB + (size_t)pm * 256 * 4096; u.B = ws + WS_WBT + (size_t)pn * 256 * 4096; u.lda = 4096; u.ldb = 4096; u.nt = 32; u.aux = 1; }
            return true; }
        if (i > 0) return false;
        u.A = ws + WS_MERGED + (size_t)pm * 256 * 4096; u.B = ws + WS_WOT + (size_t)pn * 256 * 4096; u.lda = 4096; u.ldb = 4096; u.nt = 32; u.aux = 2; return true;
    }
};

struct MoeSched {
    int G, vcu, down; unsigned cnt_l, tpe_l;
    const char* ws;
    __device__ __forceinline__ void init(const unsigned* cnt, int lane) {
        unsigned c = 0; if (lane < NEXP) c = __hip_atomic_load(cnt + lane, __ATOMIC_RELAXED, __HIP_MEMORY_SCOPE_AGENT);
        unsigned t = (c + 255u) >> 8, inc = t;
#pragma unroll
        for (int o = 1; o < 32; o <<= 1) { const unsigned v = __shfl_up(inc, o); if ((lane & 31) >= o) inc += v; }
        cnt_l = c; tpe_l = inc - t;
    }
    __device__ __forceinline__ bool next(int i, pg8::Unit& u) const {
        const int lane = lane_id();
        const int total = (int)__builtin_amdgcn_readfirstlane(__shfl(tpe_l + ((cnt_l + 255u) >> 8), 31));
        const int L = i * G + vcu; if (L >= total * 8) return false;
        const int tg = L >> 3;
        const unsigned long long mk = __ballot(lane < NEXP && (int)tpe_l <= tg && (cnt_l > 0u));
        const int e = 63 - __builtin_clzll(mk);
        const int tp = (int)__builtin_amdgcn_readfirstlane(__shfl(tpe_l, e)), ce = (int)__builtin_amdgcn_readfirstlane(__shfl(cnt_l, e));
        const int te = (ce + 255) >> 8, q = L - 8 * tp, j = q / te, mt = q - j * te;
        u.pm = tp + mt; u.pn = j; u.aux = e; u.nt = down ? 16 : 32;
        if (!down) { u.A = ws + WS_H1B; u.lda = DM * 2; u.gidx = (const int*)(ws + WS_TOKIDX) + (size_t)e * ECAP + 256 * mt; u.gcnt = ce - 256 * mt; u.B = ws + WS_WGUT + ((size_t)e * 2048 + j * 256) * (DM * 2); u.ldb = DM * 2; }
        else { u.A = ws + WS_ACT + (size_t)(tp + mt) * 256 * (FF * 2); u.lda = FF * 2; u.gidx = nullptr; u.gcnt = 0; u.B = ws + WS_WDT + ((size_t)e * 2048 + j * 256) * (FF * 2); u.ldb = FF * 2; }
        return true;
    }
};
struct EpiMoe {
    __device__ static __forceinline__ int brow(int h, int R) { return pg8::brow_perm8(h, R); }
    int down; unsigned char* ws;
    __device__ __forceinline__ void operator()(ACC_T, const pg8::Unit& u, int wr, int wc, int fr, int fq, LAS unsigned char* ex) const {
        bf16_t* act = (bf16_t*)(ws + WS_ACT); bf16_t* y = (bf16_t*)(ws + WS_Y);
#pragma unroll
        for (int ai = 0; ai < 2; ++ai)
#pragma unroll
            for (int m = 0; m < 4; ++m) { const size_t row = (size_t)u.pm * 256 + ai * 128 + wr * 64 + m * 16 + fr;
                if (!down) {
                    f32x4 v0, v1;
#pragma unroll
                    for (int q = 0; q < 4; ++q) { const float g0 = acc[ai][0][m][0][q], u0 = acc[ai][1][m][0][q], g1 = acc[ai][0][m][1][q], u1 = acc[ai][1][m][1][q];
                        v0[q] = g0 * __builtin_amdgcn_rcpf(1.0f + __expf(-g0)) * u0; v1[q] = g1 * __builtin_amdgcn_rcpf(1.0f + __expf(-g1)) * u1; }
                    u32x4 w; w.x = cvtpk(v0.x, v0.y); w.y = cvtpk(v0.z, v0.w); w.z = cvtpk(v1.x, v1.y); w.w = cvtpk(v1.z, v1.w);
                    *(u32x4*)(act + row * FF + u.pn * 128 + wc * 32 + 8 * fq) = w;
                } else {
#pragma unroll
                    for (int bj = 0; bj < 2; ++bj) { const f32x4 a0 = acc[ai][bj][m][0], a1 = acc[ai][bj][m][1];
                        u32x4 w; w.x = cvtpk(a0.x, a0.y); w.y = cvtpk(a0.z, a0.w); w.z = cvtpk(a1.x, a1.y); w.w = cvtpk(a1.z, a1.w);
                        *(u32x4*)(y + row * DM + u.pn * 256 + bj * 128 + wc * 32 + 8 * fq) = w; }
                } }
    }
};


namespace mg {
constexpr int HTB = 16384, ABUF = 2 * HTB, BBUF = 64 * 256, B_OFF = 4 * ABUF;
struct Unit { const char* A; unsigned lda; const int* gidx; int gcnt; const float* B0; const float* B1; unsigned ldbf; int nt, up, pm, pn; };
template <int OFF> __device__ __forceinline__ s16x4 vtr(int addr) { s16x4 r; asm volatile("ds_read_b64_tr_b16 %0, %1 offset:%2" : "=&v"(r) : "v"(addr), "i"(OFF) : "memory"); return r; }

template <class Sched, class Epi, int XV>
__device__ __forceinline__ void gemm_phase(LAS unsigned char* lds, const Sched& S, const Epi& E, int wid) {
    const int lane = lane_id(), tid = wid * 64 + lane, wr = wid >> 2, wc = wid & 3, fr = lane & 15, fq = lane >> 4;
    const unsigned ldsw = (unsigned)wid * 1024u;
    const int aoff = pg8::lds_byte(wr * 64 + fr, fq * 8);
    const int n4 = tid & 31, kr = tid >> 5;
    const int tq = (lane & 15) >> 2, tp = lane & 3, tf = tq | ((fq & 1) << 2);
    const int ldsa = (int)(unsigned)(uintptr_t)lds;
    const int tb0 = B_OFF + (8 * fq + tq) * 256 + (((2 * wc) ^ tf) * 32) + 8 * tp, tb1 = B_OFF + (8 * fq + tq) * 256 + (((2 * wc + 1) ^ tf) * 32) + 8 * tp;
    const int wfk = (kr & 3) | (((kr >> 3) & 1) << 2);
#define MG_STAGE_A(slot, tt) do { _Pragma("unroll") for (int h_ = 0; h_ < 2; ++h_) _Pragma("unroll") for (int i_ = 0; i_ < 2; ++i_) \
        __builtin_amdgcn_global_load_lds((const unsigned*)(u.A + (size_t)(tt) * 128 + voffA[h_][i_]), (LAS unsigned*)(lds + (slot) * ABUF + h_ * HTB + ldsw + i_ * 8192), 16, 0, 0); } while (0)
#define MG_LOADB(R, tt) do { const float* p_ = bp + (size_t)(tt) * 64 * u.ldbf; \
        asm volatile("global_load_dwordx4 %0, %1, off" : "=v"(R##0) : "v"(p_) : "memory"); \
        asm volatile("global_load_dwordx4 %0, %1, off" : "=v"(R##1) : "v"(p_ + (size_t)16 * u.ldbf) : "memory"); \
        asm volatile("global_load_dwordx4 %0, %1, off" : "=v"(R##2) : "v"(p_ + (size_t)32 * u.ldbf) : "memory"); \
        asm volatile("global_load_dwordx4 %0, %1, off" : "=v"(R##3) : "v"(p_ + (size_t)48 * u.ldbf) : "memory"); } while (0)
#define MG_WAITB(R, N) asm volatile("s_waitcnt vmcnt(" #N ")" : "+v"(R##0), "+v"(R##1), "+v"(R##2), "+v"(R##3) :: "memory")
#define MG_PK(v) (u32x2){cvtpk((v).x, (v).y), cvtpk((v).z, (v).w)}
#define MG_WRITEB(R, slot) do { LAS unsigned char* w_ = lds + B_OFF + (slot) * BBUF + wa; \
        *(LAS u32x2*)(w_) = MG_PK(R##0); *(LAS u32x2*)(w_ + 4096) = MG_PK(R##1); *(LAS u32x2*)(w_ + 8192) = MG_PK(R##2); *(LAS u32x2*)(w_ + 12288) = MG_PK(R##3); } while (0)
#define MG_WAITV(N) asm volatile("s_waitcnt vmcnt(" #N ")" ::: "memory")
#define MG_BAR() do { asm volatile("" ::: "memory"); __builtin_amdgcn_s_barrier(); asm volatile("" ::: "memory"); } while (0)
#define MG_ITER(t, R) do { const int t_ = (t); \
        if (t_ + 1 < nt) { \
            if (t_ == 0 || t_ + 2 == nt) MG_WAITB(R, 4); else if (t_ == 1) MG_WAITB(R, 8); else MG_WAITB(R, 12); \
            MG_WRITEB(R, (t_ + 1) & 1); } \
        if (t_ + 3 < nt) { MG_LOADB(R, t_ + 3); MG_STAGE_A((t_ + 3) & 3, t_ + 3); } \
        const int as_ = (t_ & 3) * ABUF, ba0_ = ldsa + (t_ & 1) * BBUF + tb0, ba1_ = ldsa + (t_ & 1) * BBUF + tb1; bf16x8 Bf[2][2], At0[4][2], At1[4][2]; \
        { const s16x4 l0 = vtr<0>(ba0_), h0 = vtr<1024>(ba0_), l1 = vtr<0>(ba1_), h1 = vtr<1024>(ba1_), l2 = vtr<8192>(ba0_), h2 = vtr<9216>(ba0_), l3 = vtr<8192>(ba1_), h3 = vtr<9216>(ba1_); \
          _Pragma("unroll") for (int m = 0; m < 4; ++m) _Pragma("unroll") for (int k = 0; k < 2; ++k) At0[m][k] = *(const LAS bf16x8*)(lds + as_ + aoff + m * 2048 + k * 1024); \
          _Pragma("unroll") for (int m = 0; m < 4; ++m) _Pragma("unroll") for (int k = 0; k < 2; ++k) At1[m][k] = *(const LAS bf16x8*)(lds + as_ + HTB + aoff + m * 2048 + k * 1024); \
          if (t_ + 4 <= nt) MG_WAITV(16); else if (t_ + 3 == nt) MG_WAITV(8); else if (t_ + 2 == nt) MG_WAITV(0); \
          asm volatile("s_waitcnt lgkmcnt(0)" ::: "memory"); __builtin_amdgcn_sched_barrier(0); \
          Bf[0][0] = (bf16x8){l0[0], l0[1], l0[2], l0[3], h0[0], h0[1], h0[2], h0[3]}; Bf[1][0] = (bf16x8){l1[0], l1[1], l1[2], l1[3], h1[0], h1[1], h1[2], h1[3]}; \
          Bf[0][1] = (bf16x8){l2[0], l2[1], l2[2], l2[3], h2[0], h2[1], h2[2], h2[3]}; Bf[1][1] = (bf16x8){l3[0], l3[1], l3[2], l3[3], h3[0], h3[1], h3[2], h3[3]}; } \
        MG_BAR(); \
        __builtin_amdgcn_s_setprio(1); \
        _Pragma("unroll") for (int m = 0; m < 4; ++m) _Pragma("unroll") for (int nn = 0; nn < 2; ++nn) _Pragma("unroll") for (int k = 0; k < 2; ++k) \
            { if (XV != 64) acc[0][m][nn] = __builtin_amdgcn_mfma_f32_16x16x32_bf16(Bf[nn][k], At0[m][k], acc[0][m][nn], 0, 0, 0); else { asm volatile("" :: "v"(Bf[nn][k]), "v"(At0[m][k])); } } \
        _Pragma("unroll") for (int m = 0; m < 4; ++m) _Pragma("unroll") for (int nn = 0; nn < 2; ++nn) _Pragma("unroll") for (int k = 0; k < 2; ++k) \
            { if (XV != 64) acc[1][m][nn] = __builtin_amdgcn_mfma_f32_16x16x32_bf16(Bf[nn][k], At1[m][k], acc[1][m][nn], 0, 0, 0); else { asm volatile("" :: "v"(Bf[nn][k]), "v"(At1[m][k])); } } \
        __builtin_amdgcn_s_setprio(0); \
        MG_BAR(); } while (0)

    Unit u;
    for (int ui = 0; S.next(ui, u); ++ui) {
        const int nt = u.nt;
        unsigned voffA[2][2];
#pragma unroll
        for (int i = 0; i < 2; ++i) { int R, C; pg8::stage_rc(tid * 16 + i * 8192, R, C);
#pragma unroll
            for (int h = 0; h < 2; ++h) { int ra = h * 128 + R; if (u.gidx) ra = (ra < u.gcnt) ? u.gidx[ra] : 0; voffA[h][i] = (unsigned)ra * u.lda + (unsigned)C * 2u; } }
        const float* bp = (n4 < 16 ? u.B0 + 4 * n4 : u.B1 + 4 * (n4 - 16)) + (size_t)kr * u.ldbf;
        const int P = u.up ? (32 * ((n4 & 15) >> 2) + 16 * (n4 >> 4) + 4 * (n4 & 3)) : (32 * (n4 >> 3) + 16 * (n4 & 1) + 4 * ((n4 & 7) >> 1));
        const int wa = kr * 256 + (((P >> 4) ^ wfk) * 32) + (P & 15) * 2;
        f32x4 acc[2][4][2];
#pragma unroll
        for (int a = 0; a < 2; ++a)
#pragma unroll
            for (int m = 0; m < 4; ++m)
#pragma unroll
                for (int n = 0; n < 2; ++n) acc[a][m][n] = (f32x4){0.f, 0.f, 0.f, 0.f};
        f32x4 Ra0 = {}, Ra1 = {}, Ra2 = {}, Ra3 = {}, Rb0 = {}, Rb1 = {}, Rb2 = {}, Rb3 = {};
        MG_STAGE_A(0, 0); MG_STAGE_A(1, 1); MG_STAGE_A(2, 2);
        MG_LOADB(Ra, 0); MG_LOADB(Rb, 1);
        MG_WAITB(Ra, 4); MG_WRITEB(Ra, 0);
        MG_LOADB(Ra, 2);
        asm volatile("s_waitcnt lgkmcnt(0)" ::: "memory");
        if (wr == 1) MG_BAR();
        MG_BAR();
        for (int t = 0; t < nt; t += 2) {
            MG_ITER(t, Rb);
            MG_ITER(t + 1, Ra);
        }
        if (wr == 0) MG_BAR();
        E(acc, u, wid);
    }
#undef MG_STAGE_A
#undef MG_LOADB
#undef MG_WAITB
#undef MG_PK
#undef MG_WRITEB
#undef MG_WAITV
#undef MG_BAR
#undef MG_ITER
}
}

struct MoeSched2 {
    int G, vcu, down, var; unsigned cnt_l, tpe_l; const char* ws; const float *wgate, *wup, *wdown;
    __device__ __forceinline__ void init(const unsigned* cnt, int lane) {
        unsigned c = 0; if (lane < NEXP) c = __hip_atomic_load(cnt + lane, __ATOMIC_RELAXED, __HIP_MEMORY_SCOPE_AGENT);
        unsigned t = (c + 255u) >> 8, inc = t;
#pragma unroll
        for (int o = 1; o < 32; o <<= 1) { const unsigned v = __shfl_up(inc, o); if ((lane & 31) >= o) inc += v; }
        cnt_l = c; tpe_l = inc - t;
    }
    __device__ __forceinline__ bool next(int i, mg::Unit& u) const {
        const int lane = lane_id();
        const int total = (int)__builtin_amdgcn_readfirstlane(__shfl(tpe_l + ((cnt_l + 255u) >> 8), 31));
        const int L = i * G + vcu; if (L >= total * 16) return false;
        const int tg = L >> 4;
        const unsigned long long mk = __ballot(lane < NEXP && (int)tpe_l <= tg && (cnt_l > 0u));
        const int e = 63 - __builtin_clzll(mk);
        const int tp = (int)__builtin_amdgcn_readfirstlane(__shfl(tpe_l, e)), ce = (int)__builtin_amdgcn_readfirstlane(__shfl(cnt_l, e));
        const int te = (ce + 255) >> 8, q = L - 16 * tp, j = q / te, mt = q - j * te;
        u.pm = tp + mt; u.pn = j; u.up = down ? 0 : 1; u.nt = down ? 16 : 32;
        if (!down) { u.A = ws + WS_H1B; u.lda = DM * 2; u.gidx = (const int*)(ws + WS_TOKIDX) + (size_t)e * ECAP + 256 * mt; u.gcnt = ce - 256 * mt;
            u.B0 = wgate + (size_t)e * DM * FF + j * 64; u.B1 = wup + (size_t)e * DM * FF + j * 64; u.ldbf = FF;
            if (var == 61) { u.B0 = wgate; u.B1 = wup; }
            if (var == 65) { u.gidx = nullptr; u.A = ws + WS_H1B + (size_t)((tp + mt) & 31) * 256 * (DM * 2); } }
        else { u.A = ws + WS_ACT + (size_t)(tp + mt) * 256 * (FF * 2); u.lda = FF * 2; u.gidx = nullptr; u.gcnt = 0;
            u.B0 = wdown + (size_t)e * FF * DM + j * 128; u.B1 = u.B0 + 64; u.ldbf = DM; }
        return true;
    }
};
struct EpiMoe2 {
    int down; unsigned char* ws;
    __device__ __forceinline__ void operator()(f32x4 (&acc)[2][4][2], const mg::Unit& u, int wid) const {
        const int lane = lane_id(), wr = wid >> 2, wc = wid & 3, fr = lane & 15, fq = lane >> 4;
        bf16_t* act = (bf16_t*)(ws + WS_ACT); bf16_t* y = (bf16_t*)(ws + WS_Y);
#pragma unroll
        for (int ai = 0; ai < 2; ++ai)
#pragma unroll
            for (int m = 0; m < 4; ++m) { const size_t row = (size_t)u.pm * 256 + ai * 128 + wr * 64 + m * 16 + fr;
                if (!down) { f32x4 v;
#pragma unroll
                    for (int q = 0; q < 4; ++q) { const float g = acc[ai][m][0][q], up = acc[ai][m][1][q]; v[q] = g * __builtin_amdgcn_rcpf(1.0f + __expf(-g)) * up; }
                    u32x2 w; w.x = cvtpk(v.x, v.y); w.y = cvtpk(v.z, v.w);
                    *(u32x2*)(act + row * FF + u.pn * 64 + wc * 16 + 4 * fq) = w;
                } else { const f32x4 a0 = acc[ai][m][0], a1 = acc[ai][m][1];
                    u32x4 w; w.x = cvtpk(a0.x, a0.y); w.y = cvtpk(a0.z, a0.w); w.z = cvtpk(a1.x, a1.y); w.w = cvtpk(a1.z, a1.w);
                    *(u32x4*)(y + row * DM + u.pn * 128 + wc * 32 + 8 * fq) = w; } }
    }
};

namespace att {
constexpr int D = 128, NW = 8, QBLK = 32, KVBLK = 64;
constexpr float SCALE = SM_SCALE, THR = 8.f;
constexpr int SHM_V = KVBLK * D * 2, SHM_K = KVBLK * D * 2, SHM_ATTN = 2 * SHM_V + 2 * SHM_K + NW * 64 * 4;
#define KSWZ(row, colB) ((row) * 256 + ((colB) ^ (((row) & 7) << 4)))
#define SBAR() __builtin_amdgcn_sched_barrier(0)
__device__ __forceinline__ int crow(int r, int hi) { return (r & 3) + 8 * (r >> 2) + 4 * hi; }
template <bool BAND> __device__ __forceinline__ void partialSM(f32x16& p0, f32x16& p1, float& m_reg, float& mn, float& alpha, int dv, bool tv) {
    constexpr float C = SCALE * 1.4426950408889634f;
    if constexpr (BAND) {
#pragma unroll
        for (int r = 0; r < 16; ++r) { const int kx = (r & 3) + 8 * (r >> 2);
            if (!tv || (unsigned)(dv + kx) > 128u) p0[r] = -INFINITY;
            if (!tv || (unsigned)(dv + kx + 32) > 128u) p1[r] = -INFINITY; } }
    float pmax = p0[0];
#pragma unroll
    for (int r = 1; r < 16; ++r) pmax = fmaxf(pmax, p0[r]);
#pragma unroll
    for (int r = 0; r < 16; ++r) pmax = fmaxf(pmax, p1[r]);
    { auto rr = __builtin_amdgcn_permlane32_swap(__float_as_uint(pmax), __float_as_uint(pmax), false, false);
      pmax = fmaxf(__uint_as_float(rr[0]), __uint_as_float(rr[1])); }
    if (__builtin_expect(__all(pmax - m_reg <= THR / SCALE), 1)) { mn = m_reg; alpha = 1.f; }
    else { mn = fmaxf(m_reg, pmax); alpha = __builtin_amdgcn_exp2f((m_reg - mn) * C); m_reg = mn; }
    const float mnC = -mn * C;
#pragma unroll
    for (int r = 0; r < 16; ++r) p0[r] = fmaf(p0[r], C, mnC);
#pragma unroll
    for (int r = 0; r < 16; ++r) p1[r] = fmaf(p1[r], C, mnC);
#pragma unroll
    for (int r = 0; r < 16; ++r) p0[r] = __builtin_amdgcn_exp2f(p0[r]);
}
__device__ __forceinline__ void finishSM(f32x16& p0, f32x16& p1, float alpha, float& l_reg, bf16x8& pa0, bf16x8& pa1, bf16x8& pa2, bf16x8& pa3) {
#pragma unroll
    for (int r = 0; r < 16; ++r) p1[r] = __builtin_amdgcn_exp2f(p1[r]);
    float ps = 0;
#pragma unroll
    for (int r = 0; r < 16; ++r) ps += p0[r];
#pragma unroll
    for (int r = 0; r < 16; ++r) ps += p1[r];
    { auto rr = __builtin_amdgcn_permlane32_swap(__float_as_uint(ps), __float_as_uint(ps), false, false);
      ps = __uint_as_float(rr[0]) + __uint_as_float(rr[1]); }
    l_reg = l_reg * alpha + ps;
#define PK4(P, BASE, OUT) do { unsigned a0 = cvtpk(P[BASE + 0], P[BASE + 1]), a1 = cvtpk(P[BASE + 2], P[BASE + 3]);   \
    unsigned b0 = cvtpk(P[BASE + 4], P[BASE + 5]), b1 = cvtpk(P[BASE + 6], P[BASE + 7]);                              \
    auto r0 = __builtin_amdgcn_permlane32_swap(a0, b0, false, false); auto r1 = __builtin_amdgcn_permlane32_swap(a1, b1, false, false); \
    u32x4 w = {r0[0], r1[0], r0[1], r1[1]}; OUT = *reinterpret_cast<bf16x8*>(&w); } while (0)
    PK4(p0, 0, pa0); PK4(p0, 8, pa1); PK4(p1, 0, pa2); PK4(p1, 8, pa3);
#undef PK4
}
__device__ __forceinline__ void qkt(f32x16& p0, f32x16& p1, const LAS unsigned char* Ks, const bf16x8* qr, int r32, int hi) {
    p0 = f32x16{}; p1 = f32x16{};
#pragma unroll
    for (int d0 = 0; d0 < 8; ++d0) { const int cb = (d0 * 16 + hi * 8) * 2;
        const bf16x8 b0 = *(const LAS bf16x8*)(Ks + KSWZ(r32, cb));
        const bf16x8 b1 = *(const LAS bf16x8*)(Ks + KSWZ(32 + r32, cb));
        p0 = __builtin_amdgcn_mfma_f32_32x32x16_bf16(b0, qr[d0], p0, 0, 0, 0);
        p1 = __builtin_amdgcn_mfma_f32_32x32x16_bf16(b1, qr[d0], p1, 0, 0, 0); }
}
__device__ __forceinline__ int v_st(int k, int c) { const int kk = (k & ~0xC) | ((k & 4) << 1) | ((k & 8) >> 1); return ((kk >> 3) * 4 + (c >> 5)) * 512 + ((kk & 7) * 32 + (c & 31)) * 2; }
__device__ __forceinline__ int v_rd_base(int lane) { return ((lane & 3) << 3) | (((lane >> 2) & 3) << 6) | (((lane >> 4) & 1) << 5) | (((lane >> 5) & 1) << 8); }
constexpr int v_rd_off(int d0, int ks, int half) { return d0 * 512 + ks * 4096 + half * 2048; }
template <int OFF> __device__ __forceinline__ s16x4 tr_read(int vb) { s16x4 r; asm volatile("ds_read_b64_tr_b16 %0, %1 offset:%2" : "=&v"(r) : "v"(vb), "i"(OFF) : "memory"); return r; }
template <int D0> __device__ __forceinline__ void pv_one(f32x16& od, int vb, bf16x8 pa0, bf16x8 pa1, bf16x8 pa2, bf16x8 pa3) {
    const s16x4 l0 = tr_read<v_rd_off(D0, 0, 0)>(vb), h0 = tr_read<v_rd_off(D0, 0, 1)>(vb), l1 = tr_read<v_rd_off(D0, 1, 0)>(vb), h1 = tr_read<v_rd_off(D0, 1, 1)>(vb);
    const s16x4 l2 = tr_read<v_rd_off(D0, 2, 0)>(vb), h2 = tr_read<v_rd_off(D0, 2, 1)>(vb), l3 = tr_read<v_rd_off(D0, 3, 0)>(vb), h3 = tr_read<v_rd_off(D0, 3, 1)>(vb);
    asm volatile("s_waitcnt lgkmcnt(0)" ::: "memory"); SBAR();
#define PK(L, H) (bf16x8){L[0], L[1], L[2], L[3], H[0], H[1], H[2], H[3]}
    od = __builtin_amdgcn_mfma_f32_32x32x16_bf16(pa0, PK(l0, h0), od, 0, 0, 0);
    od = __builtin_amdgcn_mfma_f32_32x32x16_bf16(pa1, PK(l1, h1), od, 0, 0, 0);
    od = __builtin_amdgcn_mfma_f32_32x32x16_bf16(pa2, PK(l2, h2), od, 0, 0, 0);
    od = __builtin_amdgcn_mfma_f32_32x32x16_bf16(pa3, PK(l3, h3), od, 0, 0, 0);
#undef PK
}
__device__ __forceinline__ void pv_d0(f32x16* o, int vb, bf16x8 pa0, bf16x8 pa1, bf16x8 pa2, bf16x8 pa3) {
    pv_one<0>(o[0], vb, pa0, pa1, pa2, pa3); pv_one<1>(o[1], vb, pa0, pa1, pa2, pa3); pv_one<2>(o[2], vb, pa0, pa1, pa2, pa3); pv_one<3>(o[3], vb, pa0, pa1, pa2, pa3);
}
struct Unit { const bf16_t *Q, *K, *V; bf16_t* O; float* lse; int ldo, lse_stride, nt, kt0, klo, khi, q0; };
__device__ __forceinline__ void body(const Unit& u, LAS unsigned char* lds, int wid) {
    const int lane = lane_id(), tid = wid * 64 + lane,
        r32 = lane & 31, hi = lane >> 5;
    LAS unsigned char* V_lds = lds; LAS unsigned char* K_lds = lds + 2 * SHM_V;
    LAS float* ws = (LAS float*)(lds + 2 * SHM_V + 2 * SHM_K) + wid * 64; LAS float* li_l = ws; LAS float* al_l = ws + 32;
    float m_reg = -1e30f, l_reg = 0; f32x16 o[4] = {}; bf16x8 qr[8];
    const bf16_t* Qw = u.Q + (size_t)(wid * QBLK + r32) * D + hi * 8;
#pragma unroll
    for (int d0 = 0; d0 < 8; ++d0) qr[d0] = *(const bf16x8*)(Qw + d0 * 16);
    const int sr = tid >> 4, sc = (tid & 15) * 8, vst0 = v_st(sr, sc), vst1 = v_st(32 + sr, sc);
    const int vb0 = (int)(unsigned)(uintptr_t)V_lds + v_rd_base(lane);
    const bf16_t* Kh = u.K; const bf16_t* Vh = u.V;
    constexpr bool BAND = false; constexpr int SD = 1; const int dq = 0;
#define TVALID(j) true
    struct { bf16x8 vs0, vs1, ks0, ks1; } sr_[SD];
#define KROW(j) (BAND ? ((u.kt0 + 64 * (j)) < u.klo ? u.klo : ((u.kt0 + 64 * (j)) > u.khi - 64 ? u.khi - 64 : (u.kt0 + 64 * (j)))) : (u.kt0 + 64 * (j)))
#define SLOAD(i, j) do { const int k0_ = KROW(j); sr_[i].vs0 = *(const bf16x8*)(&Vh[(size_t)(k0_ + sr) * D + sc]); sr_[i].vs1 = *(const bf16x8*)(&Vh[(size_t)(k0_ + 32 + sr) * D + sc]); \
    sr_[i].ks0 = *(const bf16x8*)(&Kh[(size_t)(k0_ + sr) * D + sc]); sr_[i].ks1 = *(const bf16x8*)(&Kh[(size_t)(k0_ + 32 + sr) * D + sc]); } while (0)
#define SWRITE(b, i) do { *(LAS bf16x8*)(V_lds + (b) * SHM_V + vst0) = sr_[i].vs0; *(LAS bf16x8*)(V_lds + (b) * SHM_V + vst1) = sr_[i].vs1; const int kc = sc * 2; \
    *(LAS bf16x8*)(K_lds + (b) * SHM_K + KSWZ(sr, kc)) = sr_[i].ks0; *(LAS bf16x8*)(K_lds + (b) * SHM_K + KSWZ(32 + sr, kc)) = sr_[i].ks1; } while (0)
#define SWAIT() do { if constexpr (SD == 2) asm volatile("s_waitcnt vmcnt(4)" ::: "memory"); else asm volatile("s_waitcnt vmcnt(0)" ::: "memory"); } while (0)
#define RESC(a) do { if (__any((a) < 1.f)) { if (hi == 0) al_l[r32] = (a); asm volatile("s_waitcnt lgkmcnt(0)" ::: "memory"); \
    _Pragma("unroll") for (int d = 0; d < 4; ++d) _Pragma("unroll") for (int r = 0; r < 16; ++r) o[d][r] *= al_l[crow(r, hi)]; } } while (0)
    f32x16 pA0, pA1, pB0, pB1; float mnA, mnB, alA, alB; bf16x8 pa0, pa1, pa2, pa3; const int NT = u.nt;
    constexpr int SE = 0, SO = SD - 1;
    SLOAD(SE, 0); asm volatile("s_waitcnt vmcnt(0)" ::: "memory"); SWRITE(0, SE); __syncthreads();
    qkt(pA0, pA1, K_lds, qr, r32, hi); partialSM<BAND>(pA0, pA1, m_reg, mnA, alA, dq, TVALID(0));
    SLOAD(SO, 1); if constexpr (SD == 2) { if (2 < NT) SLOAD(SE, 2); }
    SWAIT(); SWRITE(1, SO); __syncthreads();
    for (int j = 1; j + 1 < NT; j += 2) {
        SBAR(); qkt(pB0, pB1, K_lds + SHM_K, qr, r32, hi);
        finishSM(pA0, pA1, alA, l_reg, pa0, pa1, pa2, pa3); SBAR();
        SLOAD(SO, j + SD); SBAR();
        pv_d0(o, vb0, pa0, pa1, pa2, pa3); partialSM<BAND>(pB0, pB1, m_reg, mnB, alB, dq + 64 * j, TVALID(j));
        __syncthreads(); SWAIT(); SWRITE(0, SE);
        RESC(alB); __syncthreads();
        SBAR(); qkt(pA0, pA1, K_lds, qr, r32, hi);
        finishSM(pB0, pB1, alB, l_reg, pa0, pa1, pa2, pa3); SBAR();
        if (SD == 1 || j + 3 < NT) SLOAD(SE, j + 1 + SD); SBAR();
        pv_d0(o, vb0 + SHM_V, pa0, pa1, pa2, pa3); partialSM<BAND>(pA0, pA1, m_reg, mnA, alA, dq + 64 * (j + 1), TVALID(j + 1));
        __syncthreads(); SWAIT(); SWRITE(1, SO);
        RESC(alA); __syncthreads();
    }
    SBAR(); qkt(pB0, pB1, K_lds + SHM_K, qr, r32, hi);
    finishSM(pA0, pA1, alA, l_reg, pa0, pa1, pa2, pa3); SBAR();
    pv_d0(o, vb0, pa0, pa1, pa2, pa3); partialSM<BAND>(pB0, pB1, m_reg, mnB, alB, dq + 64 * (NT - 1), TVALID(NT - 1));
    __syncthreads(); RESC(alB);
    finishSM(pB0, pB1, alB, l_reg, pa0, pa1, pa2, pa3); SBAR();
    pv_d0(o, vb0 + SHM_V, pa0, pa1, pa2, pa3);
    if (hi == 0) li_l[r32] = l_reg; asm volatile("s_waitcnt lgkmcnt(0)" ::: "memory");
    float rli[16];
#pragma unroll
    for (int r = 0; r < 16; ++r) rli[r] = __builtin_amdgcn_rcpf(li_l[crow(r, hi)]);
    bf16_t* Ow = u.O + (size_t)(wid * QBLK) * u.ldo;
#pragma unroll
    for (int r = 0; r < 16; ++r) { const int orow = crow(r, hi);
#pragma unroll
        for (int d0 = 0; d0 < 4; ++d0) Ow[(size_t)orow * u.ldo + d0 * 32 + r32] = f2bf(o[d0][r] * rli[r]); }
    if (u.lse && hi == 0) u.lse[(size_t)(wid * QBLK + r32) * u.lse_stride] = m_reg * SCALE + __logf(l_reg);
    __syncthreads();
#undef KROW
#undef TVALID
#undef SLOAD
#undef SWRITE
#undef SWAIT
#undef RESC
}

__device__ __forceinline__ void band_body(const Unit& u, LAS unsigned char* lds, int wid) {
    const int lane = lane_id(), tid = wid * 64 + lane, r32 = lane & 31, hi = lane >> 5;
    LAS unsigned char* V_lds = lds; LAS unsigned char* K_lds = lds + 2 * SHM_V;
    LAS float* ws = (LAS float*)(lds + 2 * SHM_V + 2 * SHM_K) + wid * 64; LAS float* li_l = ws; LAS float* al_l = ws + 32;
    float m_reg = -1e30f, l_reg = 0; f32x16 o[4] = {}; bf16x8 qr[8];
    const bf16_t* Qw = u.Q + (size_t)(wid * QBLK + r32) * D + hi * 8;
#pragma unroll
    for (int d0 = 0; d0 < 8; ++d0) qr[d0] = *(const bf16x8*)(Qw + d0 * 16);
    const int sr = tid >> 4, sc = (tid & 15) * 8, vst0 = v_st(sr, sc), vst1 = v_st(32 + sr, sc);
    const int vb0 = (int)(unsigned)(uintptr_t)V_lds + v_rd_base(lane);
    const bf16_t* Kh = u.K; const bf16_t* Vh = u.V;
    const int dq = u.kt0 - (u.q0 + wid * QBLK + r32) + 4 * hi + 64;
    bf16x8 A_vs0, A_vs1, A_ks0, A_ks1, B_vs0, B_vs1, B_ks0, B_ks1, C_vs0, C_vs1, C_ks0, C_ks1;
#define KROW(j) ((u.kt0 + 64 * (j)) < u.klo ? u.klo : ((u.kt0 + 64 * (j)) > u.khi - 64 ? u.khi - 64 : (u.kt0 + 64 * (j))))
#define TVALID(j) ((u.kt0 + 64 * (j)) >= u.klo && (u.kt0 + 64 * (j)) < u.khi)
#define SLOAD(S, j) do { const int k0_ = KROW(j); S##vs0 = *(const bf16x8*)(&Vh[(size_t)(k0_ + sr) * D + sc]); S##vs1 = *(const bf16x8*)(&Vh[(size_t)(k0_ + 32 + sr) * D + sc]); \
    S##ks0 = *(const bf16x8*)(&Kh[(size_t)(k0_ + sr) * D + sc]); S##ks1 = *(const bf16x8*)(&Kh[(size_t)(k0_ + 32 + sr) * D + sc]); } while (0)
#define SWRITE(b, S) do { *(LAS bf16x8*)(V_lds + (b) * SHM_V + vst0) = S##vs0; *(LAS bf16x8*)(V_lds + (b) * SHM_V + vst1) = S##vs1; const int kc = sc * 2; \
    *(LAS bf16x8*)(K_lds + (b) * SHM_K + KSWZ(sr, kc)) = S##ks0; *(LAS bf16x8*)(K_lds + (b) * SHM_K + KSWZ(32 + sr, kc)) = S##ks1; } while (0)
    const int ja = (wid >> 1), jb = (wid >> 1) + 2;
#define BAND_ITER(j, STAGE) do { const int cur = (j) & 1; const bool act = ((j) >= ja) && ((j) <= jb); bf16x8 pa0, pa1, pa2, pa3; \
        if (act) { f32x16 p0, p1; float mn, al; \
            qkt(p0, p1, K_lds + cur * SHM_K, qr, r32, hi); \
            partialSM<true>(p0, p1, m_reg, mn, al, dq + 64 * (j), TVALID(j)); \
            if (__any(al < 1.f)) { if (hi == 0) al_l[r32] = al; asm volatile("s_waitcnt lgkmcnt(0)" ::: "memory"); \
                _Pragma("unroll") for (int d = 0; d < 4; ++d) _Pragma("unroll") for (int r = 0; r < 16; ++r) o[d][r] *= al_l[crow(r, hi)]; } \
            finishSM(p0, p1, al, l_reg, pa0, pa1, pa2, pa3); SBAR(); } \
        STAGE; SBAR(); \
        if (act) pv_d0(o, vb0 + cur * SHM_V, pa0, pa1, pa2, pa3); \
        __syncthreads(); } while (0)
    SLOAD(A_, 0); SLOAD(B_, 1); SLOAD(C_, 2);
    SWRITE(0, A_); SLOAD(A_, 3);
    __syncthreads();
    BAND_ITER(0, SWRITE(1, B_); SLOAD(B_, 4));
    BAND_ITER(1, SWRITE(0, C_); SLOAD(C_, 5));
    BAND_ITER(2, SWRITE(1, A_));
    BAND_ITER(3, SWRITE(0, B_));
    BAND_ITER(4, SWRITE(1, C_));
    BAND_ITER(5, (void)0);
#undef BAND_ITER
    if (hi == 0) li_l[r32] = l_reg; asm volatile("s_waitcnt lgkmcnt(0)" ::: "memory");
    float rli[16];
#pragma unroll
    for (int r = 0; r < 16; ++r) rli[r] = __builtin_amdgcn_rcpf(li_l[crow(r, hi)]);
    bf16_t* Ow = u.O + (size_t)(wid * QBLK) * u.ldo;
#pragma unroll
    for (int r = 0; r < 16; ++r) { const int orow = crow(r, hi);
#pragma unroll
        for (int d0 = 0; d0 < 4; ++d0) Ow[(size_t)orow * u.ldo + d0 * 32 + r32] = f2bf(o[d0][r] * rli[r]); }
    if (hi == 0) u.lse[(size_t)(wid * QBLK + r32) * u.lse_stride] = m_reg * SCALE + __logf(l_reg);
    __syncthreads();
#undef KROW
#undef TVALID
#undef SLOAD
#undef SWRITE
}
}

#define XB_TMO      128
#define XB_XCNT(j)  (256  + 64 * (j))
#define XB_XSUB(j)  (1280 + 64 * (j))
#define XB_XGEN(j)  (2304 + 64 * (j))
#define XB_TOP      3328
#define XB_TOPGEN   3392
#define XCD_BAR_WORDS 3456
#define XB_SPIN_CAP (1u << 20)
__device__ __forceinline__ unsigned xb_ld(unsigned* p)              { return __hip_atomic_load(p, __ATOMIC_RELAXED, __HIP_MEMORY_SCOPE_AGENT); }
__device__ __forceinline__ unsigned xb_add(unsigned* p, unsigned v) { return __hip_atomic_fetch_add(p, v, __ATOMIC_RELAXED, __HIP_MEMORY_SCOPE_AGENT); }
__device__ __forceinline__ unsigned xb_xcc_id() { return (unsigned)__builtin_amdgcn_s_getreg((3 << 11) | 20) & 0xFu; }
#define XB_SPIN(cond, bar) do { unsigned _sp = 0; while (cond) { __builtin_amdgcn_s_sleep(1); \
    if ((++_sp & 255u) == 0u) { if (xb_ld(&(bar)[XB_TMO])) break; if (_sp > XB_SPIN_CAP) { atomicAdd(&(bar)[XB_TMO], 1u); break; } } } } while (0)
__device__ __forceinline__ void xcd_barrier_post(unsigned* bar, bool leader) { if (leader) (void)xb_add(&bar[XB_XCNT(xb_xcc_id())], 1u); }
__device__ __forceinline__ void xcd_barrier_complete(unsigned* bar, unsigned x, unsigned G, unsigned& nloc, unsigned& nx) {
    unsigned sum, cnt, mine, sp = 0u;
    for (;;) {
        sum = 0u; cnt = 0u; mine = 0u;
#pragma unroll
        for (unsigned j = 0; j < 16; ++j) { const unsigned c = xb_ld(&bar[XB_XCNT(j)]); sum += c; cnt += (c > 0u) ? 1u : 0u; mine = (j == x) ? c : mine; }
        if (sum == G) break;
        __builtin_amdgcn_s_sleep(1);
        if ((++sp & 255u) == 0u) { if (xb_ld(&bar[XB_TMO])) break; if (sp > XB_SPIN_CAP) { atomicAdd(&bar[XB_TMO], 1u); break; } }
    }
    nloc = mine > 0u ? mine : 1u; nx = cnt > 0u ? cnt : 1u;
}
__device__ __forceinline__ void xcd_barrier(unsigned* bar, unsigned* st, unsigned G, bool leader) {
    asm volatile("s_waitcnt vmcnt(0)" ::: "memory");
    __syncthreads();
    if (leader) {
        __builtin_amdgcn_s_waitcnt(0);
        const unsigned x = xb_xcc_id();
        unsigned nloc = xb_ld(st), nx = xb_ld(st + 1);
        if (nloc == 0u) { xcd_barrier_complete(bar, x, G, nloc, nx); __hip_atomic_store(st, nloc, __ATOMIC_RELAXED, __HIP_MEMORY_SCOPE_AGENT); __hip_atomic_store(st + 1, nx, __ATOMIC_RELAXED, __HIP_MEMORY_SCOPE_AGENT); }
        const unsigned old = xb_add(&bar[XB_XSUB(x)], 1u);
        const unsigned gen = old / nloc;
        if (old + 1u == (gen + 1u) * nloc) {
            __builtin_amdgcn_fence(__ATOMIC_RELEASE, "agent");
            asm volatile("s_waitcnt vmcnt(0)" ::: "memory");
            const unsigned og = xb_add(&bar[XB_TOP], 1u);
            const unsigned tg = og / nx;
            if (og + 1u == (tg + 1u) * nx) xb_add(&bar[XB_TOPGEN], 1u);
            else XB_SPIN(xb_ld(&bar[XB_TOPGEN]) == tg, bar);
            __builtin_amdgcn_fence(__ATOMIC_ACQUIRE, "agent");
            xb_add(&bar[XB_XGEN(x)], 1u);
            asm volatile("s_waitcnt vmcnt(0)" ::: "memory");
        } else {
            XB_SPIN(xb_ld(&bar[XB_XGEN(x)]) == gen, bar);
            __builtin_amdgcn_fence(__ATOMIC_ACQUIRE, "agent");
            asm volatile("s_waitcnt vmcnt(0)" ::: "memory");
        }
    }
    __syncthreads();
}

constexpr int RING_BYTES = 131072, EX_OFF = RING_BYTES, LDS_BYTES = 163840;
constexpr int NWAVES = 8;

struct Args {
    const float* in[18]; float* out; unsigned char* ws; int ph_lo, ph_hi; int use_bar, bar_region;
};

__device__ __forceinline__ void p0_transpose_item(const float* W, int K, int N, bf16_t* WT, int rowblk, int roff, LAS float* scr, int item, int lane) {
    const int nblk = N / 32, kb = item / nblk, nb = item % nblk, k0 = 64 * kb, n0 = 32 * nb;
#pragma unroll 8
    for (int i = 0; i < 32; ++i) { const int kk = 2 * i + (lane >> 5); scr[kk * 33 + (lane & 31)] = W[(size_t)(k0 + kk) * N + n0 + (lane & 31)]; }
    asm volatile("s_waitcnt lgkmcnt(0)" ::: "memory");
    const int c = lane & 7;
#pragma unroll
    for (int j = 0; j < 4; ++j) { const int nl = (lane >> 3) + 8 * j; const LAS float* s = scr + (8 * c) * 33 + nl; const int n = n0 + nl;
        u32x4 o; o.x = pk2(s[0 * 33], s[1 * 33]); o.y = pk2(s[2 * 33], s[3 * 33]); o.z = pk2(s[4 * 33], s[5 * 33]); o.w = pk2(s[6 * 33], s[7 * 33]);
        const int dr = (n >> 7) * rowblk + roff + (n & 127);
        *(u32x4*)(WT + (size_t)dr * K + k0 + 8 * c) = o; }
    asm volatile("s_waitcnt lgkmcnt(0)" ::: "memory");
}

template <int VAR>
__global__ void __launch_bounds__(NWAVES * 64, 2) mk_fwd(Args args) {
    extern __shared__ __attribute__((aligned(16))) unsigned char lds_raw[];
    LAS unsigned char* lds = (LAS unsigned char*)lds_raw;
    const int wave = __builtin_amdgcn_readfirstlane(threadIdx.x >> 6);
#define PHASE_IDS() const int lane = lane_id(), tid = wave * 64 + lane; (void)tid; const int gw = vcu * NWAVES + wave, NGW = G * NWAVES; (void)lane; (void)gw; (void)NGW
    const int G = gridDim.x, bx = blockIdx.x; const int vcu = (G % 8 == 0) ? (bx % 8) * (G / 8) + bx / 8 : bx;
    unsigned char* ws = args.ws;
    unsigned* ctl = (unsigned*)(ws + WS_CTL);
    if (args.use_bar) xcd_barrier_post((unsigned*)(args.ws + WS_CTL) + CW_BAR + args.bar_region * XCD_BAR_WORDS, wave == 0 && lane_id() == 0);
    if (args.use_bar == 12345) cooperative_groups::this_grid().sync();
#define GRID_BAR() do { if (args.use_bar) xcd_barrier((unsigned*)(args.ws + WS_CTL) + CW_BAR + args.bar_region * XCD_BAR_WORDS, (unsigned*)(args.ws + WS_CTL) + CW_WGST + args.bar_region * 32768 + 64 * (int)blockIdx.x, (unsigned)G, wave == 0 && lane_id() == 0); } while (0)
    const int lo = args.ph_lo, hi = args.ph_hi;
#ifndef MK_CMASK
#define MK_CMASK 0x1ff
#endif
#define IN(k) ((((MK_CMASK) >> (k)) & 1) && lo <= (k) && (k) < hi)
#define BOTH(k) (IN(k) && IN((k) + 1))

    if (IN(0)) {
        PHASE_IDS();
        const float* x = args.in[0];
        bf16_t* XB = (bf16_t*)(ws + WS_XB); bf16_t* WINT = (bf16_t*)(ws + WS_WINT); bf16_t* WAT = (bf16_t*)(ws + WS_WAT); bf16_t* WBT = (bf16_t*)(ws + WS_WBT); bf16_t* WOT = (bf16_t*)(ws + WS_WOT);
        bf16_t* WGUT = (bf16_t*)(ws + WS_WGUT); bf16_t* WDT = (bf16_t*)(ws + WS_WDT);
        LAS float* scr = (LAS float*)(lds + wave * 16384);
        constexpr int I_IN = (DM / 64) * (IN_COLS / 32), I_A = (1024 / 64) * (DM / 32), I_B = (DM / 64) * (DM / 32), I_O = I_B;
        constexpr int I_G = (DM / 64) * (FF / 32), I_D = (FF / 64) * (DM / 32);
        constexpr int NITEMS = I_IN + I_A + I_B + I_O + NEXP * (2 * I_G + I_D);
        for (int it = gw; it < I_IN + I_A + I_B + I_O; it += NGW) {
            int r = it;
            if (r < I_IN) { p0_transpose_item(args.in[1], DM, IN_COLS, WINT, 128, 0, scr, r, lane); continue; } r -= I_IN;
            if (r < I_A) { p0_transpose_item(args.in[4], 1024, DM, WAT, 128, 0, scr, r, lane); continue; } r -= I_A;
            if (r < I_B) { p0_transpose_item(args.in[5], DM, DM, WBT, 128, 0, scr, r, lane); continue; } r -= I_B;
            if (r < I_O) { p0_transpose_item(args.in[6], DM, DM, WOT, 128, 0, scr, r, lane); continue; } r -= I_O;
            const int e = r / (2 * I_G + I_D); r -= e * (2 * I_G + I_D);
            if (r < I_G) { p0_transpose_item(args.in[13] + (size_t)e * DM * FF, DM, FF, WGUT + (size_t)e * 2048 * DM, 256, 0, scr, r, lane); continue; } r -= I_G;
            if (r < I_G) { p0_transpose_item(args.in[14] + (size_t)e * DM * FF, DM, FF, WGUT + (size_t)e * 2048 * DM, 256, 128, scr, r, lane); continue; } r -= I_G;
            p0_transpose_item(args.in[15] + (size_t)e * FF * DM, FF, DM, WDT + (size_t)e * DM * FF, 128, 0, scr, r, lane);
        }
        for (int m = gw; m < NTOK; m += NGW) {
            const f32x4* xr = (const f32x4*)(x + (size_t)m * DM) + lane; u32x2* o8 = (u32x2*)(XB + (size_t)m * DM) + lane;
#pragma unroll
            for (int j = 0; j < 8; ++j) { const f32x4 v = xr[64 * j]; u32x2 w; w.x = pk2(v.x, v.y); w.y = pk2(v.z, v.w); o8[64 * j] = w; }
        }
        { float2* rt1 = (float2*)(ws + WS_RT1); float2* rt2 = (float2*)(ws + WS_RT2);
          for (int i = (vcu * NWAVES * 64) + tid; i < SEQ * 64; i += G * NWAVES * 64) { const int t = i >> 6, c = i & 63; float cs, sn;
              rope1(t, c, cs, sn); rt1[i] = make_float2(cs, sn); rope2(t, c, cs, sn); rt2[i] = make_float2(cs, sn); } }
        { float* wt = (float*)(ws + WS_WRT); const float* wgp = args.in[9]; const float* wrp = args.in[11];
          for (int i = (vcu * NWAVES * 64) + tid; i < 36 * DM; i += G * NWAVES * 64) { const int c = i >> 11, k = i & (DM - 1); wt[i] = (c < 4) ? wgp[(size_t)k * 4 + c] : wrp[(size_t)k * 32 + (c - 4)]; } }
        if (BOTH(0)) GRID_BAR();
    }

    if (IN(1)) {
        EpiProj E; E.ws = ws; E.qg = args.in[2]; E.kg = args.in[3];
        ProjSched S; S.o.init(NTOK, IN_COLS, G, bx); S.ws = (const char*)ws;
        pg8::gemm_phase<EpiProj, ProjSched, PG8_ALIGN, PG8_SP2>(lds, lds + EX_OFF, S, E, wave);
        if (BOTH(1)) GRID_BAR();
    }

    if (IN(2)) {
        if (VAR != 22) for (int i = 0; i < 2; ++i) {
            const int idx = bx + i * G; if (idx >= 512) break;
            const int bk = idx & 7, rest = idx >> 3, b = bk >> 2, kvh = bk & 3, hq = kvh * 4 + (rest & 3), qblk = rest >> 2;
            att::Unit u; u.Q = (const bf16_t*)(ws + WS_QB) + ((size_t)(b * 16 + hq) * SEQ + qblk * 256) * HD;
            u.K = (const bf16_t*)(ws + WS_KB) + (size_t)(b * 4 + kvh) * SEQ * HD; u.V = (const bf16_t*)(ws + WS_VB) + (size_t)(b * 4 + kvh) * SEQ * HD;
            u.O = (bf16_t*)(ws + WS_OB) + ((size_t)b * SEQ + qblk * 256) * 2048 + hq * HD; u.ldo = 2048; u.lse = nullptr; u.lse_stride = 0; u.nt = 64; u.kt0 = 0; u.klo = 0; u.khi = SEQ; u.q0 = 0;
            att::body(u, lds, wave);
        }
        if (VAR != 21) for (int i = 0; i < 3; ++i) {
            const int idx = bx + i * G; if (idx >= 768) break;
            const int sid = idx >> 4, qblk = idx & 15, g = sid >> 4, b = (sid >> 3) & 1, h = sid & 7, sh = 2 * g, L = SEQ >> sh;
            const int P0 = qblk * 256, r = P0 / L, p0 = P0 - r * L;
            att::Unit u; u.Q = (const bf16_t*)(ws + WS_QA) + ((size_t)sid * SEQ + P0) * HD; u.K = (const bf16_t*)(ws + WS_KA) + (size_t)sid * SEQ * HD; u.V = (const bf16_t*)(ws + WS_VA) + (size_t)sid * SEQ * HD;
            const size_t tok0 = (size_t)b * SEQ + ((size_t)p0 << sh) + r;
            u.O = (bf16_t*)(ws + WS_OAG) + ((size_t)g * NTOK + tok0) * 1024 + h * HD; u.ldo = 1024 << sh;
            u.lse = (float*)(ws + WS_LSE) + ((size_t)g * NTOK + tok0) * 8 + h; u.lse_stride = 8 << sh;
            u.nt = 6; u.kt0 = P0 - 64; u.klo = r * L; u.khi = r * L + L; u.q0 = P0;
            att::band_body(u, lds, wave);
        }
        GRID_BAR();
        {
            PHASE_IDS();
            const bf16_t* oag = (const bf16_t*)(ws + WS_OAG); const float* lse = (const float*)(ws + WS_LSE); bf16_t* oa = (bf16_t*)(ws + WS_OA);
            for (int m = gw; m < NTOK; m += NGW) { const int c = lane * 16, h = lane >> 3;
                const float l0 = lse[(0 * (size_t)NTOK + m) * 8 + h], l1 = lse[(1 * (size_t)NTOK + m) * 8 + h], l2 = lse[(2 * (size_t)NTOK + m) * 8 + h];
                const float mx = fmaxf(l0, fmaxf(l1, l2)); float e0 = __expf(l0 - mx), e1 = __expf(l1 - mx), e2 = __expf(l2 - mx); const float inv = 1.0f / (e0 + e1 + e2); e0 *= inv; e1 *= inv; e2 *= inv;
#pragma unroll
                for (int q = 0; q < 2; ++q) { const u32x4 a = *(const u32x4*)(oag + (0 * (size_t)NTOK + m) * 1024 + c + 8 * q), bq = *(const u32x4*)(oag + (1 * (size_t)NTOK + m) * 1024 + c + 8 * q), cq = *(const u32x4*)(oag + (2 * (size_t)NTOK + m) * 1024 + c + 8 * q);
                    u32x4 w;
#pragma unroll
                    for (int k = 0; k < 4; ++k) w[k] = cvtpk(e0 * bflo(a[k]) + e1 * bflo(bq[k]) + e2 * bflo(cq[k]), e0 * bfhi(a[k]) + e1 * bfhi(bq[k]) + e2 * bfhi(cq[k]));
                    *(u32x4*)(oa + (size_t)m * 1024 + c + 8 * q) = w; } }
        }
        if (BOTH(2)) GRID_BAR();
    }

    if (IN(3) || IN(4)) {
        EpiMix E; E.ws = ws; E.x = args.in[0];
        MixSched S; S.c = vcu; S.ws = (const char*)ws;
        if (IN(3)) { S.mode = 0; pg8::gemm_phase<EpiMix, MixSched, false, PG8_SP2>(lds, lds + EX_OFF, S, E, wave); if (BOTH(3)) GRID_BAR(); }
        if (IN(4)) { S.mode = 1; pg8::gemm_phase<EpiMix, MixSched, false, PG8_SP2>(lds, lds + EX_OFF, S, E, wave); if (BOTH(4)) GRID_BAR(); }
    }

    if (IN(5)) {
        PHASE_IDS();
        RouteArgs ra; ra.g = args.in[7]; ra.b = args.in[8]; ra.h1 = (float*)(ws + WS_H1); ra.h1b = (bf16_t*)(ws + WS_H1B); ra.wg = args.in[9]; ra.bg = args.in[10]; ra.wr = args.in[11]; ra.br = args.in[12];
        ra.cnt = ctl + CW_CNT; ra.tokidx = (int*)(ws + WS_TOKIDX); ra.slot = (int*)(ws + WS_SLOT); ra.wt = (const float*)(ws + WS_WRT);
        LAS unsigned* hist = (LAS unsigned*)lds; LAS unsigned* basev = hist + 32; LAS int* rinfo = (LAS int*)(lds + 256);
        if (tid < 64) hist[tid] = 0u;
        __syncthreads();
        static_assert(NTOK == 4 * 256 * NWAVES, "P5 assumes 4 rows per wave on a 256-workgroup grid");
#pragma unroll 1
        for (int ps = 0; ps < 2; ++ps) ln1_route_rows<2, VAR>((const float*)(ws + WS_PRE1), ra, gw + 2 * ps * NGW, NGW, lane_id(), hist, rinfo, wave * 4 + 2 * ps, 1);
        __syncthreads();
        if (tid < 32) { const unsigned h = hist[tid]; if (h) basev[tid] = atomicAdd(ra.cnt + tid, h); }
        __syncthreads();
        if (tid < 32) { const LAS int* ri = rinfo + tid * 8; const int ex1 = ri[0], ex2 = ri[1], m = ri[6]; const int p1 = (int)basev[ex1] + ri[2], p2 = (int)basev[ex2] + ri[3];
            ra.tokidx[ex1 * ECAP + p1] = m; ra.tokidx[ex2 * ECAP + p2] = m;
            int* sl = ra.slot + (size_t)m * 6; sl[0] = ex1; sl[1] = ex2; sl[2] = p1; sl[3] = p2; sl[4] = ri[4]; sl[5] = ri[5]; }
        if (BOTH(5)) GRID_BAR();
    }

    if (IN(6) || IN(7)) {
        MoeSched2 S; S.var = VAR; S.G = G; S.vcu = vcu; S.ws = (const char*)ws; S.wgate = args.in[13]; S.wup = args.in[14]; S.wdown = args.in[15];
        S.init(ctl + CW_CNT, lane_id());
        EpiMoe2 E; E.ws = ws;
        if (IN(6)) { S.down = 0; E.down = 0; mg::gemm_phase<MoeSched2, EpiMoe2, VAR>(lds, S, E, wave); if (BOTH(6)) GRID_BAR(); }
        if (IN(7)) { S.down = 1; E.down = 1; mg::gemm_phase<MoeSched2, EpiMoe2, VAR>(lds, S, E, wave); if (BOTH(7)) GRID_BAR(); }
    }

    if (IN(8)) {
        PHASE_IDS();
        P8Args pa; pa.h1 = (const float*)(ws + WS_H1); pa.y = (const bf16_t*)(ws + WS_Y); pa.cnt = ctl + CW_CNT; pa.slot = (const int*)(ws + WS_SLOT); pa.g = args.in[16]; pa.b = args.in[17]; pa.out = args.out;
        unsigned c = 0; if (lane < NEXP) c = __hip_atomic_load(ctl + CW_CNT + lane, __ATOMIC_RELAXED, __HIP_MEMORY_SCOPE_AGENT);
        unsigned t = (c + 255u) >> 8, inc = t;
#pragma unroll
        for (int o = 1; o < 32; o <<= 1) { const unsigned v = __shfl_up(inc, o); if ((lane & 31) >= o) inc += v; }
        const unsigned tpe = inc - t;
        for (int m = gw; m < NTOK; m += NGW) {
            const int* sl = pa.slot + (size_t)m * 6; const int e1 = sl[0], e2 = sl[1], p1 = sl[2], p2 = sl[3]; const float w1 = ((const float*)sl)[4], w2 = ((const float*)sl)[5];
            const size_t r1 = (size_t)__shfl(tpe, e1) * 256 + p1, r2 = (size_t)__shfl(tpe, e2) * 256 + p2;
            final_row(pa, m, lane_id(), r1, r2, w1, w2);
        }
    }
#undef IN
#undef BOTH
#undef GRID_BAR
}

extern "C" void kernel_launch(void* const* d_in, const int* in_sizes, int n_in, void* d_out, int out_size, void* d_ws, size_t ws_size, hipStream_t stream) {
    static int grid = 0;
    if (grid == 0) {
        if (n_in != 18 || in_sizes[0] != NTOK * DM || out_size != NTOK * DM || ws_size < WS_END) { fprintf(stderr, "kernel_launch: unexpected shapes (n_in %d, in0 %d, out %d, ws %zu)\n", n_in, n_in > 0 ? in_sizes[0] : -1, out_size, ws_size); grid = -1; return; }
        int dev = 0, cus = 0, per_cu = 0;
        if (hipGetDevice(&dev) != hipSuccess || hipDeviceGetAttribute(&cus, hipDeviceAttributeMultiprocessorCount, dev) != hipSuccess) { fprintf(stderr, "kernel_launch: device query failed\n"); grid = -1; return; }
        if (hipFuncSetAttribute((const void*)mk_fwd<0>, hipFuncAttributeMaxDynamicSharedMemorySize, LDS_BYTES) != hipSuccess || hipFuncSetAttribute((const void*)mk_fwd<MK_EXTRA_VAR>, hipFuncAttributeMaxDynamicSharedMemorySize, LDS_BYTES) != hipSuccess) { fprintf(stderr, "kernel_launch: hipFuncSetAttribute failed\n"); grid = -1; return; }
        if (hipOccupancyMaxActiveBlocksPerMultiprocessor(&per_cu, (const void*)mk_fwd<0>, NWAVES * 64, LDS_BYTES) != hipSuccess || per_cu < 1) { fprintf(stderr, "kernel_launch: occupancy query says %d blocks per CU\n", per_cu); per_cu = 1; }
        (void)hipGetLastError();
        grid = cus * 1;
        fprintf(stderr, "kernel_launch: grid %d (cus %d, occupancy %d)\n", grid, cus, per_cu);
    }
    if (grid < 0) return;
    unsigned char* ws = (unsigned char*)d_ws;
    (void)hipMemsetAsync(ws + WS_CTL, 0, 1 * MiB, stream);
    Args a{};
    for (int i = 0; i < 18; ++i) a.in[i] = (const float*)d_in[i];
    a.out = (float*)d_out; a.ws = ws;
    const float* x = a.in[0];
    bf16_t* XB = (bf16_t*)(ws + WS_XB); bf16_t* WINT = (bf16_t*)(ws + WS_WINT); bf16_t* WAT = (bf16_t*)(ws + WS_WAT); bf16_t* WBT = (bf16_t*)(ws + WS_WBT); bf16_t* WOT = (bf16_t*)(ws + WS_WOT);
    bf16_t* WGUT = (bf16_t*)(ws + WS_WGUT); bf16_t* WDT = (bf16_t*)(ws + WS_WDT);
    unsigned* ctl = (unsigned*)(ws + WS_CTL);
    auto launch_mk = [&](int lo, int hi, int use_bar, bool extra = false) {
        a.ph_lo = lo; a.ph_hi = hi; a.use_bar = use_bar;
        void* kargs[] = {&a};
        hipError_t e = hipLaunchCooperativeKernel(extra ? (const void*)mk_fwd<MK_EXTRA_VAR> : (const void*)mk_fwd<0>, dim3(grid), dim3(NWAVES * 64), kargs, LDS_BYTES, stream);
        if (e != hipSuccess) fprintf(stderr, "kernel_launch: cooperative launch failed: %s (grid %d)\n", hipGetErrorString(e), grid);
    };
    if (MK_ONE_LAUNCH && MK_FAST_MASK == 0x1ff) { launch_mk(0, NPHASE, 1);
        if (MK_EXTRA_PHASE >= 0) { a.bar_region = 1; launch_mk(MK_EXTRA_PHASE, MK_EXTRA_PHASE + 1, 1, true); }
        return; }
    for (int ph = 0; ph < NPHASE; ++ph) {
        if ((MK_FAST_MASK >> ph) & 1) { launch_mk(ph, ph + 1, (ph == 2) ? 1 : 0); continue; }
        switch (ph) {
        case 0:
            hipLaunchKernelGGL(k_cvt, dim3(2048), dim3(256), 0, stream, x, XB, (size_t)NTOK * DM / 8);
            hipLaunchKernelGGL(k_transpose, dim3(IN_COLS / 32, DM / 32, 1), dim3(256), 0, stream, a.in[1], WINT, DM, IN_COLS, 128, 0, (size_t)0, (size_t)0);
            hipLaunchKernelGGL(k_transpose, dim3(DM / 32, 1024 / 32, 1), dim3(256), 0, stream, a.in[4], WAT, 1024, DM, 128, 0, (size_t)0, (size_t)0);
            hipLaunchKernelGGL(k_transpose, dim3(DM / 32, DM / 32, 1), dim3(256), 0, stream, a.in[5], WBT, DM, DM, 128, 0, (size_t)0, (size_t)0);
            hipLaunchKernelGGL(k_transpose, dim3(DM / 32, DM / 32, 1), dim3(256), 0, stream, a.in[6], WOT, DM, DM, 128, 0, (size_t)0, (size_t)0);
            hipLaunchKernelGGL(k_transpose, dim3(FF / 32, DM / 32, NEXP), dim3(256), 0, stream, a.in[13], WGUT, DM, FF, 256, 0, (size_t)DM * FF, (size_t)2048 * DM);
            hipLaunchKernelGGL(k_transpose, dim3(FF / 32, DM / 32, NEXP), dim3(256), 0, stream, a.in[14], WGUT, DM, FF, 256, 128, (size_t)DM * FF, (size_t)2048 * DM);
            hipLaunchKernelGGL(k_transpose, dim3(DM / 32, FF / 32, NEXP), dim3(256), 0, stream, a.in[15], WDT, FF, DM, 128, 0, (size_t)FF * DM, (size_t)DM * FF);
            hipLaunchKernelGGL(k_ropetab, dim3(SEQ * 64 / 256), dim3(256), 0, stream, (float2*)(ws + WS_RT1), (float2*)(ws + WS_RT2));
            break;
        case 1: { P1Args p1{}; p1.xb = XB; p1.wint = WINT; p1.qg = a.in[2]; p1.kg = a.in[3]; p1.qa = (bf16_t*)(ws + WS_QA); p1.ka = (bf16_t*)(ws + WS_KA); p1.va = (bf16_t*)(ws + WS_VA);
            p1.qb = (bf16_t*)(ws + WS_QB); p1.kb = (bf16_t*)(ws + WS_KB); p1.vb = (bf16_t*)(ws + WS_VB); p1.gates = (bf16_t*)(ws + WS_GATES);
            hipLaunchKernelGGL(k_proj, dim3(IN_COLS / 128, NTOK / 64), dim3(256), 0, stream, p1); } break;
        case 2: { P2Args p2b{}; p2b.q = (bf16_t*)(ws + WS_QB); p2b.k = (bf16_t*)(ws + WS_KB); p2b.v = (bf16_t*)(ws + WS_VB); p2b.o = (bf16_t*)(ws + WS_OB); p2b.lse = nullptr; p2b.mode = 0;
            hipLaunchKernelGGL(k_attn, dim3(SEQ / 64, 32), dim3(128), 0, stream, p2b);
            P2Args p2a{}; p2a.q = (bf16_t*)(ws + WS_QA); p2a.k = (bf16_t*)(ws + WS_KA); p2a.v = (bf16_t*)(ws + WS_VA); p2a.o = (bf16_t*)(ws + WS_OAG); p2a.lse = (float*)(ws + WS_LSE); p2a.mode = 1;
            hipLaunchKernelGGL(k_attn, dim3(SEQ / 64, 48), dim3(128), 0, stream, p2a);
            hipLaunchKernelGGL(k_merge, dim3(NTOK * 1024 / 256), dim3(256), 0, stream, (const bf16_t*)(ws + WS_OAG), (const float*)(ws + WS_LSE), (bf16_t*)(ws + WS_OA)); } break;
        case 3: case 4: { P3Args p3{}; p3.gates = (bf16_t*)(ws + WS_GATES); p3.T = (float*)(ws + WS_T); p3.merged = (bf16_t*)(ws + WS_MERGED); p3.x = x; p3.pre1 = (float*)(ws + WS_PRE1);
            if (ph == 3) { p3.A = (bf16_t*)(ws + WS_OA); p3.Bt = WAT; p3.K = 1024; p3.mode = 0;
                hipLaunchKernelGGL(k_gemm3, dim3(DM / 128, NTOK / 64), dim3(256), 0, stream, p3);
                p3.A = (bf16_t*)(ws + WS_OB); p3.Bt = WBT; p3.K = 2048; p3.mode = 1;
                hipLaunchKernelGGL(k_gemm3, dim3(DM / 128, NTOK / 64), dim3(256), 0, stream, p3); }
            else { p3.A = p3.merged; p3.Bt = WOT; p3.K = 2048; p3.mode = 2; hipLaunchKernelGGL(k_gemm3, dim3(DM / 128, NTOK / 64), dim3(256), 0, stream, p3); } } break;
        case 5: { RouteArgs ra{}; ra.g = a.in[7]; ra.b = a.in[8]; ra.h1 = (float*)(ws + WS_H1); ra.h1b = (bf16_t*)(ws + WS_H1B); ra.wg = a.in[9]; ra.bg = a.in[10]; ra.wr = a.in[11]; ra.br = a.in[12];
            ra.cnt = ctl + CW_CNT; ra.tokidx = (int*)(ws + WS_TOKIDX); ra.slot = (int*)(ws + WS_SLOT);
            hipLaunchKernelGGL(k_ln1_route, dim3(NTOK / 4), dim3(256), 0, stream, (const float*)(ws + WS_PRE1), ra); } break;
        case 6: case 7: { P6Args p6{}; p6.h1b = (bf16_t*)(ws + WS_H1B); p6.wgut = WGUT; p6.wdt = WDT; p6.cnt = ctl + CW_CNT; p6.tokidx = (int*)(ws + WS_TOKIDX); p6.act = (bf16_t*)(ws + WS_ACT); p6.y = (bf16_t*)(ws + WS_Y);
            if (ph == 6) hipLaunchKernelGGL(k_moe_up, dim3(FF / 128, 24576 / 64), dim3(256), 0, stream, p6);
            else hipLaunchKernelGGL(k_moe_down, dim3(DM / 128, 24576 / 64), dim3(256), 0, stream, p6); } break;
        case 8: { P8Args p8{}; p8.h1 = (float*)(ws + WS_H1); p8.y = (bf16_t*)(ws + WS_Y); p8.cnt = ctl + CW_CNT; p8.slot = (int*)(ws + WS_SLOT); p8.g = a.in[16]; p8.b = a.in[17]; p8.out = (float*)d_out;
            hipLaunchKernelGGL(k_final, dim3(NTOK / 4), dim3(256), 0, stream, p8); } break;
        }
    }
}
```

```cpp
#include <hip/hip_runtime.h>
#include <hip/hip_cooperative_groups.h>
#include <cstdio>
#include <cstdint>

typedef unsigned short bf16_t;
typedef short bf16x8 __attribute__((ext_vector_type(8)));
typedef short s16x4 __attribute__((ext_vector_type(4)));
typedef float f32x4 __attribute__((ext_vector_type(4)));
typedef float f32x16 __attribute__((ext_vector_type(16)));
typedef unsigned u32x4 __attribute__((ext_vector_type(4)));
typedef unsigned u32x2 __attribute__((ext_vector_type(2)));
#define LAS __attribute__((address_space(3)))

#ifndef MK_FAST_MASK
#define MK_FAST_MASK 0x1ff
#endif
#ifndef MK_ONE_LAUNCH
#define MK_ONE_LAUNCH 1
#endif
#ifndef MK_EXTRA_PHASE
#define MK_EXTRA_PHASE -1
#endif
#ifndef MK_EXTRA_VAR
#define MK_EXTRA_VAR 0
#endif
#ifndef PG8_SP2
#define PG8_SP2 true
#endif
#ifndef PG8_ALIGN
#define PG8_ALIGN true
#endif

constexpr int NTOK = 8192, SEQ = 4096, DM = 2048, HD = 128;
constexpr int IN_COLS = 16384;
constexpr int NEXP = 32, FF = 1024;
constexpr float ALPHA = 1.189207115002721f;
constexpr float LN_EPS = 1e-5f, RMS_EPS = 1e-6f;
constexpr float SM_SCALE = 0.08838834764831845f;
constexpr int ECAP = 8192;
constexpr int NPHASE = 9;

constexpr size_t MiB = 1u << 20;
constexpr size_t WS_CTL = 0;
constexpr size_t WS_WGUT = 1 * MiB;
constexpr size_t WS_WDT = 257 * MiB;
constexpr size_t WS_WAT = 385 * MiB;
constexpr size_t WS_WBT = 389 * MiB;
constexpr size_t WS_WOT = 397 * MiB;
constexpr size_t WS_XB = 405 * MiB;
constexpr size_t WS_WINT = 437 * MiB;
constexpr size_t WS_QA = 501 * MiB;
constexpr size_t WS_KA = 549 * MiB;
constexpr size_t WS_VA = 597 * MiB;
constexpr size_t WS_QB = 645 * MiB;
constexpr size_t WS_KB = 677 * MiB;
constexpr size_t WS_VB = 685 * MiB;
constexpr size_t WS_GATES = 693 * MiB;
constexpr size_t WS_OAG = 757 * MiB;
constexpr size_t WS_LSE = 805 * MiB;
constexpr size_t WS_OA = 806 * MiB;
constexpr size_t WS_OB = 822 * MiB;
constexpr size_t WS_T = 405 * MiB;
constexpr size_t WS_MERGED = 469 * MiB;
constexpr size_t WS_PRE1 = 501 * MiB;
constexpr size_t WS_H1 = 565 * MiB;
constexpr size_t WS_H1B = 629 * MiB;
constexpr size_t WS_TOKIDX = 661 * MiB;
constexpr size_t WS_LNST = 663 * MiB;
constexpr size_t WS_SLOT = 662 * MiB;
constexpr size_t WS_ACT = 693 * MiB;
constexpr size_t WS_Y = 757 * MiB;
constexpr size_t WS_RT1 = 854 * MiB;
constexpr size_t WS_RT2 = 856 * MiB;
constexpr size_t WS_WRT = 858 * MiB;
constexpr size_t WS_END = 859 * MiB;
constexpr int CW_CNT = 64;
constexpr int CW_BAR = 4096;
constexpr int CW_WGST = 65536;

__device__ __forceinline__ float bf2f(bf16_t v) { return __uint_as_float(((unsigned)v) << 16); }
__device__ __forceinline__ bf16_t f2bf(float f) { unsigned u = __float_as_uint(f); u += 0x7fffu + ((u >> 16) & 1u); return (bf16_t)(u >> 16); }
__device__ __forceinline__ unsigned pk2(float lo, float hi) { return (unsigned)f2bf(lo) | ((unsigned)f2bf(hi) << 16); }
__device__ __forceinline__ unsigned cvtpk(float lo, float hi) { unsigned r; asm volatile("v_cvt_pk_bf16_f32 %0, %1, %2" : "=v"(r) : "v"(lo), "v"(hi)); return r; }
__device__ __forceinline__ float wave_sum(float v) {
#pragma unroll
    for (int o = 1; o < 64; o <<= 1) v += __shfl_xor(v, o);
    return v;
}
__device__ __forceinline__ int lane_id() { int l; asm volatile("v_mbcnt_lo_u32_b32 %0, -1, 0\n\tv_mbcnt_hi_u32_b32 %0, -1, %0" : "=v"(l)); return l; }
__device__ __forceinline__ float bflo(unsigned w) { return __uint_as_float(w << 16); }
__device__ __forceinline__ float bfhi(unsigned w) { return __uint_as_float(w & 0xffff0000u); }

__device__ const float INV64[64] = {
    1.000000000e+00f, 8.659643234e-01f, 7.498942093e-01f, 6.493816316e-01f, 5.623413252e-01f, 4.869675252e-01f, 4.216965034e-01f, 3.651741273e-01f,
    3.162277660e-01f, 2.738419634e-01f, 2.371373706e-01f, 2.053525026e-01f, 1.778279410e-01f, 1.539926526e-01f, 1.333521432e-01f, 1.154781985e-01f,
    1.000000000e-01f, 8.659643234e-02f, 7.498942093e-02f, 6.493816316e-02f, 5.623413252e-02f, 4.869675252e-02f, 4.216965034e-02f, 3.651741273e-02f,
    3.162277660e-02f, 2.738419634e-02f, 2.371373706e-02f, 2.053525026e-02f, 1.778279410e-02f, 1.539926526e-02f, 1.333521432e-02f, 1.154781985e-02f,
    1.000000000e-02f, 8.659643234e-03f, 7.498942093e-03f, 6.493816316e-03f, 5.623413252e-03f, 4.869675252e-03f, 4.216965034e-03f, 3.651741273e-03f,
    3.162277660e-03f, 2.738419634e-03f, 2.371373706e-03f, 2.053525026e-03f, 1.778279410e-03f, 1.539926526e-03f, 1.333521432e-03f, 1.154781985e-03f,
    1.000000000e-03f, 8.659643234e-04f, 7.498942093e-04f, 6.493816316e-04f, 5.623413252e-04f, 4.869675252e-04f, 4.216965034e-04f, 3.651741273e-04f,
    3.162277660e-04f, 2.738419634e-04f, 2.371373706e-04f, 2.053525026e-04f, 1.778279410e-04f, 1.539926526e-04f, 1.333521432e-04f, 1.154781985e-04f};

__device__ __forceinline__ void cs_angle(float ang, float& c, float& s) {
    const double a = (double)ang * 0.15915494309189535;
    const float f = (float)(a - floor(a));
    s = __builtin_amdgcn_sinf(f); c = __builtin_amdgcn_cosf(f);
}
__device__ __forceinline__ void rope1(int t, int i, float& c, float& s) { cs_angle((float)t * INV64[i], c, s); }
__device__ __forceinline__ void rope2(int t, int i, float& c, float& s) {
    const float p = (i < 32) ? (float)(t >> 6) : (float)(t & 63);
    cs_angle(p * INV64[2 * (i & 31)], c, s);
}
__device__ __forceinline__ int perm_pos(int g, int t) { const int sh = 2 * g; const int d = 1 << sh; return (t & (d - 1)) * (SEQ >> sh) + (t >> sh); }

__global__ void __launch_bounds__(256) k_cvt(const float* __restrict__ x, bf16_t* __restrict__ xb, size_t n8) {
    for (size_t i = (size_t)blockIdx.x * 256 + threadIdx.x; i < n8; i += (size_t)gridDim.x * 256) {
        const f32x4 a = *(const f32x4*)(x + i * 8), b = *(const f32x4*)(x + i * 8 + 4);
        u32x4 w; w.x = pk2(a.x, a.y); w.y = pk2(a.z, a.w); w.z = pk2(b.x, b.y); w.w = pk2(b.z, b.w);
        *(u32x4*)(xb + i * 8) = w;
    }
}
__global__ void __launch_bounds__(256) k_transpose(const float* __restrict__ src, bf16_t* __restrict__ dst, int K, int N, int rowblk, int roff, size_t sstride, size_t dstride) {
    __shared__ float tile[32][33];
    const float* s = src + (size_t)blockIdx.z * sstride; bf16_t* d = dst + (size_t)blockIdx.z * dstride;
    const int n0 = blockIdx.x * 32, k0 = blockIdx.y * 32, tx = threadIdx.x & 31, ty = threadIdx.x >> 5;
    for (int i = ty; i < 32; i += 8) tile[i][tx] = s[(size_t)(k0 + i) * N + n0 + tx];
    __syncthreads();
    for (int i = ty; i < 32; i += 8) { const int n = n0 + i; const int dr = (n >> 7) * rowblk + roff + (n & 127); d[(size_t)dr * K + k0 + tx] = f2bf(tile[tx][i]); }
}
__global__ void __launch_bounds__(256) k_ropetab(float2* rt1, float2* rt2) {
    const int i = blockIdx.x * 256 + threadIdx.x; const int t = i >> 6, c = i & 63; float cs, sn;
    rope1(t, c, cs, sn); rt1[i] = make_float2(cs, sn); rope2(t, c, cs, sn); rt2[i] = make_float2(cs, sn);
}
__device__ __forceinline__ void wave_gemm16x128(const bf16_t* arow, const bf16_t* bt, int ldb, int K, f32x4 (&acc)[8]) {
    const int lane = threadIdx.x & 63, fr = lane & 15, fq = lane >> 4;
    const bf16_t* ap = arow + fq * 8;
    const bf16_t* bp = bt + (size_t)fr * ldb + fq * 8;
    for (int k = 0; k < K; k += 32) {
        const bf16x8 a = *(const bf16x8*)(ap + k);
#pragma unroll
        for (int j = 0; j < 8; ++j) { const bf16x8 b = *(const bf16x8*)(bp + (size_t)j * 16 * ldb + k); acc[j] = __builtin_amdgcn_mfma_f32_16x16x32_bf16(a, b, acc[j], 0, 0, 0); }
    }
}
struct P1Args { const bf16_t* xb; const bf16_t* wint; const float* qg; const float* kg; bf16_t *qa, *ka, *va, *qb, *kb, *vb, *gates; };
__global__ void __launch_bounds__(256) k_proj(P1Args a) {
    const int wave = threadIdx.x >> 6, lane = threadIdx.x & 63, fr = lane & 15, fq = lane >> 4;
    const int ng = blockIdx.x, mt = blockIdx.y * 4 + wave;
    f32x4 acc[8];
#pragma unroll
    for (int j = 0; j < 8; ++j) acc[j] = (f32x4){0.f, 0.f, 0.f, 0.f};
    wave_gemm16x128(a.xb + (size_t)(mt * 16 + fr) * DM, a.wint + (size_t)ng * 128 * DM, DM, DM, acc);
#pragma unroll
    for (int r = 0; r < 4; ++r) {
        const int m = mt * 16 + fq * 4 + r, b = m >> 12, t = m & 4095;
        if (ng < 72) {
            const int which = ng / 24, hh = ng % 24, g = hh >> 3, h = hh & 7;
            bf16_t* base = (which == 0 ? a.qa : (which == 1 ? a.ka : a.va)) + ((size_t)((g * 2 + b) * 8 + h) * SEQ + perm_pos(g, t)) * HD;
#pragma unroll
            for (int j = 0; j < 4; ++j) { const int c = 16 * j + fr; float x1 = acc[j][r], x2 = acc[j + 4][r];
                if (which < 2) { float cs, sn; rope1(t, c, cs, sn); const float y1 = x1 * cs - x2 * sn, y2 = x2 * cs + x1 * sn; x1 = y1; x2 = y2; }
                base[c] = f2bf(x1); base[c + 64] = f2bf(x2); }
        } else if (ng < 96) {
            const int k = ng - 72;
            if (k < 20) {
                float ss = 0.f;
#pragma unroll
                for (int j = 0; j < 8; ++j) ss += acc[j][r] * acc[j][r];
                ss += __shfl_xor(ss, 1); ss += __shfl_xor(ss, 2); ss += __shfl_xor(ss, 4); ss += __shfl_xor(ss, 8);
                const float rinv = 1.0f / sqrtf(ss * (1.0f / 128.0f) + RMS_EPS);
                const float* gn = (k < 16) ? a.qg : a.kg;
                bf16_t* base = (k < 16) ? a.qb + ((size_t)(b * 16 + k) * SEQ + t) * HD : a.kb + ((size_t)(b * 4 + (k - 16)) * SEQ + t) * HD;
#pragma unroll
                for (int j = 0; j < 4; ++j) { const int c = 16 * j + fr; const float x1 = acc[j][r] * rinv * gn[c], x2 = acc[j + 4][r] * rinv * gn[c + 64];
                    float cs, sn; rope2(t, c, cs, sn); base[c] = f2bf(x1 * cs - x2 * sn); base[c + 64] = f2bf(x2 * cs + x1 * sn); }
            } else {
                bf16_t* base = a.vb + ((size_t)(b * 4 + (k - 20)) * SEQ + t) * HD;
#pragma unroll
                for (int j = 0; j < 8; ++j) base[16 * j + fr] = f2bf(acc[j][r]);
            }
        } else {
            bf16_t* base = a.gates + (size_t)m * 4096 + (ng - 96) * 128;
#pragma unroll
            for (int j = 0; j < 8; ++j) base[16 * j + fr] = f2bf(1.0f / (1.0f + __expf(-acc[j][r])));
        }
    }
}
struct P2Args { const bf16_t *q, *k, *v; bf16_t* o; float* lse; int mode; };
__global__ void __launch_bounds__(128) k_attn(P2Args a) {
    const int half = threadIdx.x & 1, qi = blockIdx.x * 64 + (threadIdx.x >> 1), sid = blockIdx.y;
    const bf16_t *Q, *K, *V; int k_lo, k_hi;
    if (a.mode == 0) { const int b = sid >> 4, hq = sid & 15; Q = a.q + (size_t)sid * SEQ * HD; K = a.k + (size_t)(b * 4 + (hq >> 2)) * SEQ * HD; V = a.v + (size_t)(b * 4 + (hq >> 2)) * SEQ * HD; k_lo = 0; k_hi = SEQ - 1; }
    else { const int g = sid >> 4; const int L = SEQ >> (2 * g); Q = a.q + (size_t)sid * SEQ * HD; K = a.k + (size_t)sid * SEQ * HD; V = a.v + (size_t)sid * SEQ * HD;
        const int r0 = (qi / L) * L, p = qi - r0; k_lo = r0 + (p - 64 > 0 ? p - 64 : 0); k_hi = r0 + (p + 64 < L - 1 ? p + 64 : L - 1); }
    float q[64], o[64];
    { const bf16_t* qp = Q + (size_t)qi * HD + half * 64;
#pragma unroll
      for (int d = 0; d < 64; ++d) { q[d] = bf2f(qp[d]) * SM_SCALE; o[d] = 0.f; } }
    float m = -1e30f, l = 0.f;
    for (int kk = k_lo; kk <= k_hi; ++kk) {
        const bf16_t* kp = K + (size_t)kk * HD + half * 64; const bf16_t* vp = V + (size_t)kk * HD + half * 64;
        float s = 0.f;
#pragma unroll
        for (int d = 0; d < 64; ++d) s += q[d] * bf2f(kp[d]);
        s += __shfl_xor(s, 1);
        const float mn = fmaxf(m, s), al = __expf(m - mn), p = __expf(s - mn);
        l = l * al + p; m = mn;
#pragma unroll
        for (int d = 0; d < 64; ++d) o[d] = o[d] * al + p * bf2f(vp[d]);
    }
    const float rl = 1.0f / l;
    if (a.mode == 0) { const int b = sid >> 4, hq = sid & 15; bf16_t* op = a.o + (size_t)(b * SEQ + qi) * 2048 + hq * HD + half * 64;
#pragma unroll
        for (int d = 0; d < 64; ++d) op[d] = f2bf(o[d] * rl); }
    else { const int g = sid >> 4, b = (sid >> 3) & 1, h = sid & 7; const int sh = 2 * g, L = SEQ >> sh; const int r = qi / L, p = qi - r * L, t = (p << sh) + r;
        const size_t mrow = (size_t)b * SEQ + t;
        bf16_t* op = a.o + ((size_t)g * NTOK + mrow) * 1024 + h * HD + half * 64;
#pragma unroll
        for (int d = 0; d < 64; ++d) op[d] = f2bf(o[d] * rl);
        if (half == 0) a.lse[((size_t)g * NTOK + mrow) * 8 + h] = m + __logf(l); }
}
__global__ void __launch_bounds__(256) k_merge(const bf16_t* __restrict__ oag, const float* __restrict__ lse, bf16_t* __restrict__ oa) {
    const size_t i = (size_t)blockIdx.x * 256 + threadIdx.x;
    const size_t m = i >> 10; const int c = (int)(i & 1023), h = c >> 7;
    const float l0 = lse[(0 * (size_t)NTOK + m) * 8 + h], l1 = lse[(1 * (size_t)NTOK + m) * 8 + h], l2 = lse[(2 * (size_t)NTOK + m) * 8 + h];
    const float mx = fmaxf(l0, fmaxf(l1, l2)); const float e0 = __expf(l0 - mx), e1 = __expf(l1 - mx), e2 = __expf(l2 - mx); const float inv = 1.0f / (e0 + e1 + e2);
    const float v = (e0 * bf2f(oag[(0 * (size_t)NTOK + m) * 1024 + c]) + e1 * bf2f(oag[(1 * (size_t)NTOK + m) * 1024 + c]) + e2 * bf2f(oag[(2 * (size_t)NTOK + m) * 1024 + c])) * inv;
    oa[i] = f2bf(v);
}
struct P3Args { const bf16_t* A; const bf16_t* Bt; int K; const bf16_t* gates; float* T; bf16_t* merged; const float* x; float* pre1; int mode; };
__global__ void __launch_bounds__(256) k_gemm3(P3Args a) {
    const int wave = threadIdx.x >> 6, lane = threadIdx.x & 63, fr = lane & 15, fq = lane >> 4;
    const int ng = blockIdx.x, mt = blockIdx.y * 4 + wave;
    f32x4 acc[8];
#pragma unroll
    for (int j = 0; j < 8; ++j) acc[j] = (f32x4){0.f, 0.f, 0.f, 0.f};
    wave_gemm16x128(a.A + (size_t)(mt * 16 + fr) * a.K, a.Bt + (size_t)ng * 128 * a.K, a.K, a.K, acc);
#pragma unroll
    for (int r = 0; r < 4; ++r) { const size_t m = (size_t)mt * 16 + fq * 4 + r;
#pragma unroll
        for (int j = 0; j < 8; ++j) { const int c = ng * 128 + 16 * j + fr; const size_t o = m * DM + c;
            if (a.mode == 0) a.T[o] = bf2f(a.gates[m * 4096 + c]) * acc[j][r];
            else if (a.mode == 1) a.merged[o] = f2bf(a.T[o] + bf2f(a.gates[m * 4096 + 2048 + c]) * acc[j][r]);
            else a.pre1[o] = ALPHA * a.x[o] + acc[j][r]; } }
}
struct RouteArgs { const float* g; const float* b; float* h1; bf16_t* h1b; const float* wg; const float* bg; const float* wr; const float* br; unsigned* cnt; int* tokidx; int* slot; const float* wt; float2* lnst; };
__device__ __forceinline__ void ln1_route_row(const float* pre1, const RouteArgs& a, int m, int lane) {
    const f32x4* xr = (const f32x4*)(pre1 + (size_t)m * DM) + lane;
    f32x4 v[8]; float s = 0.f;
#pragma unroll
    for (int j = 0; j < 8; ++j) { v[j] = xr[64 * j]; s += (v[j].x + v[j].y) + (v[j].z + v[j].w); }
    const float mean = wave_sum(s) * (1.0f / DM); float s2 = 0.f;
#pragma unroll
    for (int j = 0; j < 8; ++j) { v[j] = v[j] - mean; s2 += (v[j].x * v[j].x + v[j].y * v[j].y) + (v[j].z * v[j].z + v[j].w * v[j].w); }
    const float rstd = 1.0f / sqrtf(wave_sum(s2) * (1.0f / DM) + LN_EPS);
    float gl[4] = {0.f, 0.f, 0.f, 0.f};
#pragma unroll
    for (int j = 0; j < 8; ++j) { const int c = 4 * lane + 256 * j; const f32x4 gg = *(const f32x4*)(a.g + c), bb = *(const f32x4*)(a.b + c);
        v[j] = v[j] * rstd * gg + bb;
        *(f32x4*)(a.h1 + (size_t)m * DM + c) = v[j];
        *(uint2*)(a.h1b + (size_t)m * DM + c) = make_uint2(pk2(v[j].x, v[j].y), pk2(v[j].z, v[j].w));
#pragma unroll
        for (int i = 0; i < 4; ++i) { const f32x4 w = *(const f32x4*)(a.wg + (size_t)(c + i) * 4); const float hv = v[j][i]; gl[0] += hv * w.x; gl[1] += hv * w.y; gl[2] += hv * w.z; gl[3] += hv * w.w; } }
#pragma unroll
    for (int i = 0; i < 4; ++i) gl[i] = wave_sum(gl[i]) + a.bg[i];
    int gi = 0; float gm = gl[0];
#pragma unroll
    for (int i = 1; i < 4; ++i) if (gl[i] > gm) { gm = gl[i]; gi = i; }
    float gs = 0.f;
#pragma unroll
    for (int i = 0; i < 4; ++i) gs += __expf(gl[i] - gm);
    const float ggate = 1.0f / gs;
    float el[8] = {0.f, 0.f, 0.f, 0.f, 0.f, 0.f, 0.f, 0.f};
#pragma unroll
    for (int j = 0; j < 8; ++j) { const int c = 4 * lane + 256 * j;
#pragma unroll
        for (int i = 0; i < 4; ++i) { const float* wp = a.wr + (size_t)(c + i) * 32 + gi * 8; const f32x4 w0 = *(const f32x4*)wp, w1 = *(const f32x4*)(wp + 4); const float hv = v[j][i];
            el[0] += hv * w0.x; el[1] += hv * w0.y; el[2] += hv * w0.z; el[3] += hv * w0.w; el[4] += hv * w1.x; el[5] += hv * w1.y; el[6] += hv * w1.z; el[7] += hv * w1.w; } }
#pragma unroll
    for (int i = 0; i < 8; ++i) el[i] = wave_sum(el[i]) + a.br[gi * 8 + i];
    int i1 = 0; float m1 = el[0];
#pragma unroll
    for (int i = 1; i < 8; ++i) if (el[i] > m1) { m1 = el[i]; i1 = i; }
    int i2 = -1; float m2 = -3.0e38f;
#pragma unroll
    for (int i = 0; i < 8; ++i) if (i != i1 && el[i] > m2) { m2 = el[i]; i2 = i; }
    const float e2 = __expf(m2 - m1); const float w1 = ggate / (1.0f + e2), w2 = ggate * e2 / (1.0f + e2);
    if (lane == 0) {
        const int ex1 = gi * 8 + i1, ex2 = gi * 8 + i2;
        const int p1 = (int)atomicAdd(a.cnt + ex1, 1u), p2 = (int)atomicAdd(a.cnt + ex2, 1u);
        a.tokidx[ex1 * ECAP + p1] = m; a.tokidx[ex2 * ECAP + p2] = m;
        int* sl = a.slot + (size_t)m * 6; sl[0] = ex1; sl[1] = ex2; sl[2] = p1; sl[3] = p2; ((float*)sl)[4] = w1; ((float*)sl)[5] = w2;
    }
}
template <int R, int VAR>
__device__ __forceinline__ void ln1_route_rows(const float* pre1, const RouteArgs& a, int m0, int ms, int lane, LAS unsigned* hist, LAS int* rinfo, int lr0, int lrs) {
    f32x4 v[R][8]; float s[R], s2[R];
#pragma unroll
    for (int i = 0; i < R; ++i) { const f32x4* xr = (const f32x4*)(pre1 + (size_t)(m0 + i * ms) * DM) + lane; s[i] = 0.f;
#pragma unroll
        for (int j = 0; j < 8; ++j) { v[i][j] = xr[64 * j]; s[i] += (v[i][j].x + v[i][j].y) + (v[i][j].z + v[i][j].w); } }
#pragma unroll
    for (int o = 1; o < 64; o <<= 1)
#pragma unroll
        for (int i = 0; i < R; ++i) s[i] += __shfl_xor(s[i], o);
#pragma unroll
    for (int i = 0; i < R; ++i) { const float mean = s[i] * (1.0f / DM); s2[i] = 0.f;
#pragma unroll
        for (int j = 0; j < 8; ++j) { v[i][j] = v[i][j] - mean; s2[i] += (v[i][j].x * v[i][j].x + v[i][j].y * v[i][j].y) + (v[i][j].z * v[i][j].z + v[i][j].w * v[i][j].w); } }
#pragma unroll
    for (int o = 1; o < 64; o <<= 1)
#pragma unroll
        for (int i = 0; i < R; ++i) s2[i] += __shfl_xor(s2[i], o);
#pragma unroll
    for (int j = 0; j < 8; ++j) { const int c = 4 * lane + 256 * j; const f32x4 gg = *(const f32x4*)(a.g + c), bb = *(const f32x4*)(a.b + c);
#pragma unroll
        for (int i = 0; i < R; ++i) { const float rstd = 1.0f / sqrtf(s2[i] * (1.0f / DM) + LN_EPS); const size_t o = (size_t)(m0 + i * ms) * DM + c;
            v[i][j] = v[i][j] * rstd * gg + bb;
            if (j == 0 && lane == 0) a.lnst[m0 + i * ms] = make_float2(s[i] * (1.0f / DM), rstd);
            *(uint2*)(a.h1b + o) = make_uint2(pk2(v[i][j].x, v[i][j].y), pk2(v[i][j].z, v[i][j].w)); } }
    if constexpr (VAR == 51) return;
    float gl[R][4];
#pragma unroll
    for (int c = 0; c < 4; ++c) { const f32x4* wp = (const f32x4*)(a.wt + (size_t)c * DM) + lane;
#pragma unroll
        for (int i = 0; i < R; ++i) gl[i][c] = 0.f;
#pragma unroll
        for (int j = 0; j < 8; ++j) { const f32x4 w = wp[64 * j];
#pragma unroll
            for (int i = 0; i < R; ++i) gl[i][c] += (v[i][j].x * w.x + v[i][j].y * w.y) + (v[i][j].z * w.z + v[i][j].w * w.w); }
        if (c & 1) __builtin_amdgcn_sched_barrier(0); }
#pragma unroll
    for (int o = 1; o < 64; o <<= 1)
#pragma unroll
        for (int i = 0; i < R; ++i)
#pragma unroll
            for (int c = 0; c < 4; ++c) gl[i][c] += __shfl_xor(gl[i][c], o);
    int gi[R]; float ggate[R];
#pragma unroll
    for (int i = 0; i < R; ++i) { float g0 = gl[i][0] + a.bg[0], g1 = gl[i][1] + a.bg[1], g2 = gl[i][2] + a.bg[2], g3 = gl[i][3] + a.bg[3];
        int q = 0; float gm = g0; if (g1 > gm) { gm = g1; q = 1; } if (g2 > gm) { gm = g2; q = 2; } if (g3 > gm) { gm = g3; q = 3; }
        ggate[i] = 1.0f / (__expf(g0 - gm) + __expf(g1 - gm) + __expf(g2 - gm) + __expf(g3 - gm)); gi[i] = __builtin_amdgcn_readfirstlane(q); }
    float el[R][8];
#pragma unroll
    for (int c = 0; c < 8; ++c) {
#pragma unroll
        for (int i = 0; i < R; ++i) { const f32x4* wp = (const f32x4*)(a.wt + (size_t)(4 + gi[i] * 8 + c) * DM) + lane; float acc = 0.f;
#pragma unroll
            for (int j = 0; j < 8; ++j) { const f32x4 w = wp[64 * j]; acc += (v[i][j].x * w.x + v[i][j].y * w.y) + (v[i][j].z * w.z + v[i][j].w * w.w); }
            el[i][c] = acc; }
        __builtin_amdgcn_sched_barrier(0); }
#pragma unroll
    for (int o = 1; o < 64; o <<= 1)
#pragma unroll
        for (int i = 0; i < R; ++i)
#pragma unroll
            for (int c = 0; c < 8; ++c) el[i][c] += __shfl_xor(el[i][c], o);
#pragma unroll
    for (int i = 0; i < R; ++i) { const int m = m0 + i * ms;
        int i1 = 0; float m1 = el[i][0] + a.br[gi[i] * 8];
        float ev[8];
#pragma unroll
        for (int c = 0; c < 8; ++c) ev[c] = el[i][c] + a.br[gi[i] * 8 + c];
#pragma unroll
        for (int c = 1; c < 8; ++c) if (ev[c] > m1) { m1 = ev[c]; i1 = c; }
        int i2 = -1; float m2 = -3.0e38f;
#pragma unroll
        for (int c = 0; c < 8; ++c) if (c != i1 && ev[c] > m2) { m2 = ev[c]; i2 = c; }
        const float e2 = __expf(m2 - m1); const float w1 = ggate[i] / (1.0f + e2), w2 = ggate[i] * e2 / (1.0f + e2);
        if (lane == 0) {
            const int ex1 = gi[i] * 8 + i1, ex2 = gi[i] * 8 + i2;
            const int p1 = (int)__hip_atomic_fetch_add(hist + ex1, 1u, __ATOMIC_RELAXED, __HIP_MEMORY_SCOPE_WORKGROUP), p2 = (int)__hip_atomic_fetch_add(hist + ex2, 1u, __ATOMIC_RELAXED, __HIP_MEMORY_SCOPE_WORKGROUP);
            LAS int* ri = rinfo + (lr0 + i * lrs) * 8; ri[0] = ex1; ri[1] = ex2; ri[2] = p1; ri[3] = p2; ((LAS float*)ri)[4] = w1; ((LAS float*)ri)[5] = w2; ri[6] = m;
        } }
}
__global__ void __launch_bounds__(256) k_ln1_route(const float* pre1, RouteArgs a) { ln1_route_row(pre1, a, blockIdx.x * 4 + (threadIdx.x >> 6), threadIdx.x & 63); }

__device__ __forceinline__ int row_start(const unsigned* cnt, int e) { int s = 0; for (int i = 0; i < e; ++i) s += ((int)cnt[i] + 255) & ~255; return s; }
struct P6Args { const bf16_t* h1b; const bf16_t* wgut; const bf16_t* wdt; const unsigned* cnt; const int* tokidx; bf16_t* act; bf16_t* y; };
__global__ void __launch_bounds__(256) k_moe_up(P6Args a) {
    const int wave = threadIdx.x >> 6, lane = threadIdx.x & 63, fr = lane & 15, fq = lane >> 4;
    const int R0 = blockIdx.y * 64;
    int e = 0, rs = 0;
    for (; e < NEXP; ++e) { const int n = ((int)a.cnt[e] + 255) & ~255; if (R0 < rs + n) break; rs += n; }
    if (e == NEXP) return;
    const int pos = R0 - rs + wave * 16 + fr; const int tok = pos < (int)a.cnt[e] ? a.tokidx[e * ECAP + pos] : 0;
    const int jb = blockIdx.x;
    f32x4 ag[8], au[8];
#pragma unroll
    for (int j = 0; j < 8; ++j) { ag[j] = (f32x4){0.f, 0.f, 0.f, 0.f}; au[j] = (f32x4){0.f, 0.f, 0.f, 0.f}; }
    const bf16_t* wb = a.wgut + ((size_t)e * 2048 + jb * 256) * DM;
    wave_gemm16x128(a.h1b + (size_t)tok * DM, wb, DM, DM, ag);
    wave_gemm16x128(a.h1b + (size_t)tok * DM, wb + (size_t)128 * DM, DM, DM, au);
#pragma unroll
    for (int r = 0; r < 4; ++r) { const size_t row = (size_t)R0 + wave * 16 + fq * 4 + r;
#pragma unroll
        for (int j = 0; j < 8; ++j) { const float g = ag[j][r], u = au[j][r]; a.act[row * FF + jb * 128 + 16 * j + fr] = f2bf(g / (1.0f + __expf(-g)) * u); } }
}
__global__ void __launch_bounds__(256) k_moe_down(P6Args a) {
    const int wave = threadIdx.x >> 6, lane = threadIdx.x & 63, fr = lane & 15, fq = lane >> 4;
    const int R0 = blockIdx.y * 64;
    int e = 0, rs = 0;
    for (; e < NEXP; ++e) { const int n = ((int)a.cnt[e] + 255) & ~255; if (R0 < rs + n) break; rs += n; }
    if (e == NEXP) return;
    f32x4 acc[8];
#pragma unroll
    for (int j = 0; j < 8; ++j) acc[j] = (f32x4){0.f, 0.f, 0.f, 0.f};
    wave_gemm16x128(a.act + ((size_t)R0 + wave * 16 + fr) * FF, a.wdt + ((size_t)e * 2048 + blockIdx.x * 128) * FF, FF, FF, acc);
#pragma unroll
    for (int r = 0; r < 4; ++r) { const size_t row = (size_t)R0 + wave * 16 + fq * 4 + r;
#pragma unroll
        for (int j = 0; j < 8; ++j) a.y[row * DM + blockIdx.x * 128 + 16 * j + fr] = f2bf(acc[j][r]); }
}
struct P8Args { const float* h1; const bf16_t* y; const unsigned* cnt; const int* slot; const float* g; const float* b; float* out; };
__device__ __forceinline__ void final_row(const P8Args& a, int m, int lane, size_t r1, size_t r2, float w1, float w2) {
    f32x4 v[8]; float s = 0.f;
#pragma unroll
    for (int j = 0; j < 8; ++j) { const int c = 4 * lane + 256 * j; const f32x4 hv = *(const f32x4*)(a.h1 + (size_t)m * DM + c);
        const uint2 ya = *(const uint2*)(a.y + r1 * DM + c), yb = *(const uint2*)(a.y + r2 * DM + c);
        f32x4 f; f.x = w1 * bflo(ya.x) + w2 * bflo(yb.x); f.y = w1 * bfhi(ya.x) + w2 * bfhi(yb.x); f.z = w1 * bflo(ya.y) + w2 * bflo(yb.y); f.w = w1 * bfhi(ya.y) + w2 * bfhi(yb.y);
        v[j] = hv * ALPHA + f; s += (v[j].x + v[j].y) + (v[j].z + v[j].w); }
    const float mean = wave_sum(s) * (1.0f / DM); float s2 = 0.f;
#pragma unroll
    for (int j = 0; j < 8; ++j) { v[j] = v[j] - mean; s2 += (v[j].x * v[j].x + v[j].y * v[j].y) + (v[j].z * v[j].z + v[j].w * v[j].w); }
    const float rstd = 1.0f / sqrtf(wave_sum(s2) * (1.0f / DM) + LN_EPS);
#pragma unroll
    for (int j = 0; j < 8; ++j) { const int c = 4 * lane + 256 * j; const f32x4 gg = *(const f32x4*)(a.g + c), bb = *(const f32x4*)(a.b + c);
        *(f32x4*)(a.out + (size_t)m * DM + c) = v[j] * rstd * gg + bb; }
}
__device__ __forceinline__ void final_row_t(const P8Args& a, const float* pre1, const float2* lnst, const float* g1, const float* b1, int m, int lane, size_t r1, size_t r2, float w1, float w2) {
    f32x4 v[8]; float s = 0.f; const float2 st = lnst[m];
#pragma unroll
    for (int j = 0; j < 8; ++j) { const int c = 4 * lane + 256 * j; const f32x4 pv = *(const f32x4*)(pre1 + (size_t)m * DM + c);
        const f32x4 hv = (pv - st.x) * st.y * *(const f32x4*)(g1 + c) + *(const f32x4*)(b1 + c);
        const uint2 ya = *(const uint2*)(a.y + r1 * DM + c), yb = *(const uint2*)(a.y + r2 * DM + c);
        f32x4 f; f.x = w1 * bflo(ya.x) + w2 * bflo(yb.x); f.y = w1 * bfhi(ya.x) + w2 * bfhi(yb.x); f.z = w1 * bflo(ya.y) + w2 * bflo(yb.y); f.w = w1 * bfhi(ya.y) + w2 * bfhi(yb.y);
        v[j] = hv * ALPHA + f; s += (v[j].x + v[j].y) + (v[j].z + v[j].w); }
    const float mean = wave_sum(s) * (1.0f / DM); float s2 = 0.f;
#pragma unroll
    for (int j = 0; j < 8; ++j) { v[j] = v[j] - mean; s2 += (v[j].x * v[j].x + v[j].y * v[j].y) + (v[j].z * v[j].z + v[j].w * v[j].w); }
    const float rstd = 1.0f / sqrtf(wave_sum(s2) * (1.0f / DM) + LN_EPS);
#pragma unroll
    for (int j = 0; j < 8; ++j) { const int c = 4 * lane + 256 * j; const f32x4 gg = *(const f32x4*)(a.g + c), bb = *(const f32x4*)(a.b + c);
        *(f32x4*)(a.out + (size_t)m * DM + c) = v[j] * rstd * gg + bb; }
}
__global__ void __launch_bounds__(256) k_final(P8Args a) {
    const int lane = threadIdx.x & 63, m = blockIdx.x * 4 + (threadIdx.x >> 6);
    const int* sl = a.slot + (size_t)m * 6; const int e1 = sl[0], e2 = sl[1], p1 = sl[2], p2 = sl[3]; const float w1 = ((const float*)sl)[4], w2 = ((const float*)sl)[5];
    final_row(a, m, lane, (size_t)row_start(a.cnt, e1) + p1, (size_t)row_start(a.cnt, e2) + p2, w1, w2);
}

namespace pg8 {
constexpr int BM = 256, BK = 64, HALF = 128, HTB = HALF * BK * 2  , STAGE_BYTES = 8 * HTB;
__device__ __forceinline__ int lds_byte(int r, int c) { const int st = (r >> 4) * 2 + (c >> 5), rr = r & 15, cc = c & 31, ob = rr * 64 + cc * 2; return st * 1024 + (ob ^ (((ob >> 9) & 1) << 5)); }
__device__ __forceinline__ void stage_rc(int b, int& R, int& C) { const int st = b / 1024, sb = b % 1024, swz = sb ^ (((sb >> 9) & 1) << 5); R = (st >> 1) * 16 + swz / 64; C = (st & 1) * 32 + (swz % 64) / 2; }

struct Unit { const char* A; const char* B; unsigned lda, ldb; int nt; int pm, pn, aux; const int* gidx; int gcnt; };
struct Voff { unsigned a[2][2], b[2][2]; };
__device__ __forceinline__ int brow_perm8(int h, int R) { return 128 * h + (R & ~31) + 8 * ((R >> 2) & 3) + 4 * ((R >> 4) & 1) + (R & 3); }
__device__ __forceinline__ int brow_rope(int h, int R) { return 128 * (R >> 6) + 64 * h + 32 * ((R >> 5) & 1) + 8 * ((R >> 2) & 3) + 4 * ((R >> 4) & 1) + (R & 3); }

template <class Epi> __device__ __forceinline__ void make_voff(const Unit& u, Voff& v, int tid) {
#pragma unroll
    for (int i = 0; i < 2; ++i) { int R, C; stage_rc(tid * 16 + i * 8192, R, C);
#pragma unroll
        for (int h = 0; h < 2; ++h) {
            int ra = h * HALF + R;
            if (u.gidx) ra = (ra < u.gcnt) ? u.gidx[ra] : 0;
            v.a[h][i] = (unsigned)ra * u.lda + (unsigned)C * 2u;
            v.b[h][i] = (unsigned)Epi::brow(h, R) * u.ldb + (unsigned)C * 2u;
        } }
}

template <class Epi, class Sched, bool ALIGN_EPI, bool SP2>
__device__ __forceinline__ void gemm_phase(LAS unsigned char* lds, LAS unsigned char* ex, const Sched& S, const Epi& E, int wid) {
    const int lane = lane_id(), tid = wid * 64 + lane, wr = wid >> 2, wc = wid & 3, fr = lane & 15, fq = lane >> 4;
    const unsigned ldsw = (unsigned)wid * 1024u;
    const int aoff = lds_byte(wr * 64 + fr, fq * 8), boff = lds_byte(wc * 32 + fr, fq * 8);
#define PG8_SA(b, h) (((b) * 2 + (h)) * HTB)
#define PG8_SB(b, h) ((4 + (b) * 2 + (h)) * HTB)
#define PG8_STAGE(bufoff, gbase, voff) do { _Pragma("unroll") for (int _i = 0; _i < 2; ++_i) \
        __builtin_amdgcn_global_load_lds((const unsigned*)((const char*)(gbase) + (voff)[_i]), (LAS unsigned*)(lds + (bufoff) + ldsw + _i * 8192), 16, 0, 0); } while (0)
#define PG8_LDA(dst, b, h) do { _Pragma("unroll") for (int m = 0; m < 4; ++m) _Pragma("unroll") for (int k = 0; k < 2; ++k) dst[m][k] = *(const LAS bf16x8*)(lds + PG8_SA(b, h) + aoff + m * 2048 + k * 1024); } while (0)
#define PG8_LDB(dst, b, h) do { _Pragma("unroll") for (int n = 0; n < 2; ++n) _Pragma("unroll") for (int k = 0; k < 2; ++k) dst[n][k] = *(const LAS bf16x8*)(lds + PG8_SB(b, h) + boff + n * 2048 + k * 1024); } while (0)
#define PG8_MMA(ai, bj, At, Bt) do { __builtin_amdgcn_s_setprio(1); _Pragma("unroll") for (int m = 0; m < 4; ++m) _Pragma("unroll") for (int n = 0; n < 2; ++n) _Pragma("unroll") for (int k = 0; k < 2; ++k) \
        acc[ai][bj][m][n] = __builtin_amdgcn_mfma_f32_16x16x32_bf16(Bt[n][k], At[m][k], acc[ai][bj][m][n], 0, 0, 0); __builtin_amdgcn_s_setprio(0); } while (0)
#define PG8_WAIT_V(n) asm volatile("s_waitcnt vmcnt(" #n ")" ::: "memory")
#define PG8_WAIT_L(n) asm volatile("s_waitcnt lgkmcnt(" #n ")" ::: "memory")
#define PG8_BAR __builtin_amdgcn_s_barrier()
#define PG8_SCHED __builtin_amdgcn_sched_barrier(0)
    Unit cur, nxt; int ui = 0;
    if (!S.next(0, cur)) return;
    Voff vo, nvo;
    make_voff<Epi>(cur, vo, tid);
    f32x4 acc[2][2][4][2];
#pragma unroll
    for (int a = 0; a < 2; ++a)
#pragma unroll
        for (int b = 0; b < 2; ++b)
#pragma unroll
            for (int m = 0; m < 4; ++m)
#pragma unroll
                for (int n = 0; n < 2; ++n) acc[a][b][m][n] = (f32x4){0.f, 0.f, 0.f, 0.f};
    bf16x8 At[4][2], B0[2][2], B1[2][2];
    const char* cA = cur.A; const char* cB = cur.B;
    const size_t kstep = (size_t)(BK * 2);
    if constexpr (SP2) {
        PG8_STAGE(PG8_SB(0, 0), cB, vo.b[0]); PG8_STAGE(PG8_SB(0, 1), cB, vo.b[1]); PG8_STAGE(PG8_SA(0, 0), cA, vo.a[0]); PG8_STAGE(PG8_SA(0, 1), cA, vo.a[1]);
        if (wr == 1) PG8_BAR;
        PG8_WAIT_V(2); PG8_BAR;
        PG8_STAGE(PG8_SB(1, 0), cB + kstep, vo.b[0]); PG8_STAGE(PG8_SA(1, 0), cA + kstep, vo.a[0]); PG8_STAGE(PG8_SB(1, 1), cB + kstep, vo.b[1]);
        PG8_WAIT_V(6); PG8_BAR;
    } else {
        PG8_STAGE(PG8_SB(0, 0), cB, vo.b[0]); PG8_STAGE(PG8_SA(0, 0), cA, vo.a[0]); PG8_STAGE(PG8_SB(0, 1), cB, vo.b[1]); PG8_STAGE(PG8_SA(0, 1), cA, vo.a[1]);
        if (wr == 1) PG8_BAR;
        PG8_WAIT_V(4); PG8_BAR;
        PG8_STAGE(PG8_SB(1, 0), cB + kstep, vo.b[0]); PG8_STAGE(PG8_SA(1, 0), cA + kstep, vo.a[0]); PG8_STAGE(PG8_SB(1, 1), cB + kstep, vo.b[1]);
        PG8_WAIT_V(6); PG8_BAR;
    }
    for (;;) {
        const bool has_next = S.next(ui + 1, nxt);
        if (has_next) make_voff<Epi>(nxt, nvo, tid); else nvo = vo;
        const char* nA = has_next ? nxt.A : cA; const char* nB = has_next ? nxt.B : cB;
        const int nt = cur.nt;
        for (int t = 0; t < nt; t += 2) {
            const bool last = (t == nt - 2);
            const char* a1 = cA + (size_t)(t + 1) * kstep;
            const char* a2 = last ? nA : cA + (size_t)(t + 2) * kstep; const char* b2 = last ? nB : cB + (size_t)(t + 2) * kstep;
            const char* a3 = a2 + kstep; const char* b3 = b2 + kstep;
            Voff w;
#pragma unroll
            for (int h = 0; h < 2; ++h)
#pragma unroll
                for (int i = 0; i < 2; ++i) { w.a[h][i] = last ? nvo.a[h][i] : vo.a[h][i]; w.b[h][i] = last ? nvo.b[h][i] : vo.b[h][i]; }
            if constexpr (SP2) {
            PG8_LDB(B0, 0, 0); PG8_LDB(B1, 0, 1); PG8_SCHED; PG8_LDA(At, 0, 0); PG8_STAGE(PG8_SA(1, 1), a1, vo.a[1]);
            PG8_WAIT_V(8); PG8_WAIT_L(0); PG8_BAR; PG8_MMA(0, 0, At, B0); PG8_MMA(0, 1, At, B1); PG8_BAR; PG8_SCHED;
            PG8_LDA(At, 0, 1); PG8_STAGE(PG8_SB(0, 0), b2, w.b[0]); PG8_STAGE(PG8_SB(0, 1), b2, w.b[1]); PG8_STAGE(PG8_SA(0, 0), a2, w.a[0]);
            PG8_WAIT_V(8); PG8_WAIT_L(0); PG8_BAR; PG8_MMA(1, 0, At, B0); PG8_MMA(1, 1, At, B1); PG8_BAR; PG8_SCHED;
            PG8_LDB(B0, 1, 0); PG8_LDB(B1, 1, 1); PG8_SCHED; PG8_LDA(At, 1, 0); PG8_STAGE(PG8_SA(0, 1), a2, w.a[1]);
            PG8_WAIT_V(8); PG8_WAIT_L(0); PG8_BAR; PG8_MMA(0, 0, At, B0); PG8_MMA(0, 1, At, B1); PG8_BAR; PG8_SCHED;
            PG8_LDA(At, 1, 1); PG8_STAGE(PG8_SB(1, 0), b3, w.b[0]); PG8_STAGE(PG8_SB(1, 1), b3, w.b[1]); PG8_STAGE(PG8_SA(1, 0), a3, w.a[0]);
            PG8_WAIT_V(8); PG8_WAIT_L(0); PG8_BAR; PG8_MMA(1, 0, At, B0); PG8_MMA(1, 1, At, B1); PG8_BAR; PG8_SCHED;
            } else {
            PG8_LDB(B0, 0, 0); PG8_SCHED; PG8_LDA(At, 0, 0); PG8_STAGE(PG8_SA(1, 1), a1, vo.a[1]);
            PG8_WAIT_L(8); PG8_BAR; PG8_WAIT_L(0); PG8_MMA(0, 0, At, B0); PG8_BAR; PG8_SCHED;
            PG8_LDB(B1, 0, 1); PG8_STAGE(PG8_SB(0, 0), b2, w.b[0]);
            PG8_BAR; PG8_WAIT_L(0); PG8_MMA(0, 1, At, B1); PG8_BAR;
            PG8_LDA(At, 0, 1); PG8_STAGE(PG8_SA(0, 0), a2, w.a[0]);
            PG8_BAR; PG8_WAIT_L(0); PG8_MMA(1, 0, At, B0); PG8_BAR; PG8_SCHED;
            PG8_STAGE(PG8_SB(0, 1), b2, w.b[1]);
            PG8_WAIT_V(6); PG8_BAR; PG8_MMA(1, 1, At, B1); PG8_BAR;
            PG8_LDB(B0, 1, 0); PG8_SCHED; PG8_LDA(At, 1, 0); PG8_STAGE(PG8_SA(0, 1), a2, w.a[1]);
            PG8_WAIT_L(8); PG8_BAR; PG8_WAIT_L(0); PG8_MMA(0, 0, At, B0); PG8_BAR; PG8_SCHED;
            PG8_LDB(B1, 1, 1); PG8_STAGE(PG8_SB(1, 0), b3, w.b[0]);
            PG8_BAR; PG8_WAIT_L(0); PG8_MMA(0, 1, At, B1); PG8_BAR;
            PG8_LDA(At, 1, 1); PG8_STAGE(PG8_SA(1, 0), a3, w.a[0]);
            PG8_BAR; PG8_WAIT_L(0); PG8_MMA(1, 0, At, B0); PG8_BAR; PG8_SCHED;
            PG8_STAGE(PG8_SB(1, 1), b3, w.b[1]);
            PG8_WAIT_V(6); PG8_BAR; PG8_MMA(1, 1, At, B1); PG8_BAR;
            }
        }
        if constexpr (ALIGN_EPI) { if (wr == 0) PG8_BAR; }
        E(acc, cur, wr, wc, fr, fq, ex);
        if (!has_next) break;
        if (!(cur.aux & 256)) {
#pragma unroll
        for (int a = 0; a < 2; ++a)
#pragma unroll
            for (int b = 0; b < 2; ++b)
#pragma unroll
                for (int m = 0; m < 4; ++m)
#pragma unroll
                    for (int n = 0; n < 2; ++n) acc[a][b][m][n] = (f32x4){0.f, 0.f, 0.f, 0.f};
        }
        cur = nxt; cA = nA; cB = nB; vo = nvo; ++ui;
        if constexpr (ALIGN_EPI) { if (wr == 1) PG8_BAR; }
    }
    PG8_WAIT_V(0);
    if constexpr (!ALIGN_EPI) { if (wr == 0) PG8_BAR; }
    PG8_BAR;
#undef PG8_SA
#undef PG8_SB
#undef PG8_STAGE
#undef PG8_LDA
#undef PG8_LDB
#undef PG8_MMA
#undef PG8_WAIT_V
#undef PG8_WAIT_L
#undef PG8_BAR
#undef PG8_SCHED
}

struct TileOrder {
    int nM, nN, nwg, G, c;
    __device__ void init(int M, int N, int G_, int c_) { nM = M / BM; nN = N / BM; nwg = nM * nN; G = G_; c = c_; }
    __device__ bool tile(int i, int& pm, int& pn) const {
        const long L = (long)i * G + c; if (L >= nwg) return false;
        int wgid = (int)L; { const int q = nwg / 8, r = nwg % 8, xcd = wgid % 8, off = wgid / 8; wgid = (xcd < r ? xcd * (q + 1) : r * (q + 1) + (xcd - r) * q) + off; }
        const int nig = 8 * nN, gid = wgid / nig, fm = gid * 8, gsz = (nM - fm) < 8 ? (nM - fm) : 8;
        pm = fm + ((wgid % nig) % gsz); pn = (wgid % nig) / gsz; return true;
    }
};
}

typedef float f32x2 __attribute__((ext_vector_type(2)));
#define ACC_T f32x4 (&acc)[2][2][4][2]

struct EpiProj {
    __device__ static __forceinline__ int brow(int h, int R) { return pg8::brow_rope(h, R); }
    unsigned char* ws; const float *qg, *kg;
    __device__ static __forceinline__ void rot4(const f32x4 x1, const f32x4 x2, const f32x4 t0, const f32x4 t1, f32x4& y1, f32x4& y2) {
        y1.x = x1.x * t0.x - x2.x * t0.y; y2.x = x2.x * t0.x + x1.x * t0.y;
        y1.y = x1.y * t0.z - x2.y * t0.w; y2.y = x2.y * t0.z + x1.y * t0.w;
        y1.z = x1.z * t1.x - x2.z * t1.y; y2.z = x2.z * t1.x + x1.z * t1.y;
        y1.w = x1.w * t1.z - x2.w * t1.w; y2.w = x2.w * t1.z + x1.w * t1.w;
    }
    __device__ static __forceinline__ void store8(bf16_t* dst, const f32x4 a, const f32x4 b) {
        u32x4 w; w.x = cvtpk(a.x, a.y); w.y = cvtpk(a.z, a.w); w.z = cvtpk(b.x, b.y); w.w = cvtpk(b.z, b.w); *(u32x4*)dst = w; }
    __device__ __forceinline__ void operator()(ACC_T, const pg8::Unit& u, int wr, int wc, int fr, int fq, LAS unsigned char* ex) const {
        const int ng = 2 * u.pn + (wc >> 1), c0 = 32 * (wc & 1) + 8 * fq;
        if (ng < 72) {
            const int which = ng / 24, hh = ng % 24, g = hh >> 3, h = hh & 7;
            bf16_t* buf = (bf16_t*)(ws + WS_QA + (size_t)which * (WS_KA - WS_QA));
            const float2* rt1 = (const float2*)(ws + WS_RT1);
#pragma unroll
            for (int ai = 0; ai < 2; ++ai)
#pragma unroll
                for (int m = 0; m < 4; ++m) {
                    const int mrow = u.pm * 256 + ai * 128 + wr * 64 + m * 16 + fr, b = mrow >> 12, t = mrow & 4095;
                    bf16_t* dst = buf + ((size_t)((g * 2 + b) * 8 + h) * SEQ + perm_pos(g, t)) * HD + c0;
                    f32x4 y1a = acc[ai][0][m][0], y1b = acc[ai][0][m][1], y2a = acc[ai][1][m][0], y2b = acc[ai][1][m][1];
                    if (which < 2) {
                        const f32x4* tp = (const f32x4*)(rt1 + (size_t)t * 64 + c0);
                        const f32x4 t0 = tp[0], t1 = tp[1], t2 = tp[2], t3 = tp[3];
                        rot4(acc[ai][0][m][0], acc[ai][1][m][0], t0, t1, y1a, y2a); rot4(acc[ai][0][m][1], acc[ai][1][m][1], t2, t3, y1b, y2b);
                    }
                    store8(dst, y1a, y1b); store8(dst + 64, y2a, y2b);
                }
        } else if (ng < 92) {
            const int k = ng - 72;
            LAS float* X = (LAS float*)ex;
#pragma unroll
            for (int ai = 0; ai < 2; ++ai)
#pragma unroll
                for (int m = 0; m < 4; ++m) { float s = 0.f;
#pragma unroll
                    for (int bj = 0; bj < 2; ++bj)
#pragma unroll
                        for (int n = 0; n < 2; ++n) { const f32x4 x = acc[ai][bj][m][n]; s += (x.x * x.x + x.y * x.y) + (x.z * x.z + x.w * x.w); }
                    s += __shfl_xor(s, 16); s += __shfl_xor(s, 32);
                    if (fq == 0) X[(ai * 128 + wr * 64 + m * 16 + fr) * 4 + wc] = s; }
            asm volatile("s_waitcnt lgkmcnt(0)" ::: "memory"); __builtin_amdgcn_s_barrier(); asm volatile("" ::: "memory");
            const float* gn = (k < 16) ? qg : kg; const float2* rt2 = (const float2*)(ws + WS_RT2);
            bf16_t* qb = (bf16_t*)(ws + WS_QB); bf16_t* kb = (bf16_t*)(ws + WS_KB);
            const f32x4 g1a = *(const f32x4*)(gn + c0), g1b = *(const f32x4*)(gn + c0 + 4), g2a = *(const f32x4*)(gn + 64 + c0), g2b = *(const f32x4*)(gn + 64 + c0 + 4);
#pragma unroll
            for (int ai = 0; ai < 2; ++ai)
#pragma unroll
                for (int m = 0; m < 4; ++m) {
                    const int r = ai * 128 + wr * 64 + m * 16 + fr;
                    const float ssum = X[r * 4 + (wc & 2)] + X[r * 4 + (wc & 2) + 1];
                    const int mrow = u.pm * 256 + r, b = mrow >> 12, t = mrow & 4095;
                    bf16_t* dst = ((k < 16) ? qb + ((size_t)(b * 16 + k) * SEQ + t) * HD : kb + ((size_t)(b * 4 + (k - 16)) * SEQ + t) * HD) + c0;
                    const float rinv = 1.0f / sqrtf(ssum * (1.0f / 128.0f) + RMS_EPS);
                    const f32x4* tp = (const f32x4*)(rt2 + (size_t)t * 64 + c0);
                    const f32x4 t0 = tp[0], t1 = tp[1], t2 = tp[2], t3 = tp[3];
                    f32x4 y1a, y1b, y2a, y2b;
                    rot4(acc[ai][0][m][0] * rinv * g1a, acc[ai][1][m][0] * rinv * g2a, t0, t1, y1a, y2a); rot4(acc[ai][0][m][1] * rinv * g1b, acc[ai][1][m][1] * rinv * g2b, t2, t3, y1b, y2b);
                    store8(dst, y1a, y1b); store8(dst + 64, y2a, y2b);
                }
        } else {
#pragma unroll
            for (int ai = 0; ai < 2; ++ai)
#pragma unroll
                for (int m = 0; m < 4; ++m) {
                    const int mrow = u.pm * 256 + ai * 128 + wr * 64 + m * 16 + fr, b = mrow >> 12, t = mrow & 4095;
                    bf16_t* dst = (ng < 96 ? (bf16_t*)(ws + WS_VB) + ((size_t)(b * 4 + (ng - 92)) * SEQ + t) * HD : (bf16_t*)(ws + WS_GATES) + (size_t)mrow * 4096 + (ng - 96) * 128) + c0;
                    f32x4 y1a = acc[ai][0][m][0], y1b = acc[ai][0][m][1], y2a = acc[ai][1][m][0], y2b = acc[ai][1][m][1];
                    if (ng >= 96) {
#pragma unroll
                        for (int q = 0; q < 4; ++q) { y1a[q] = __builtin_amdgcn_rcpf(1.0f + __expf(-y1a[q])); y1b[q] = __builtin_amdgcn_rcpf(1.0f + __expf(-y1b[q]));
                            y2a[q] = __builtin_amdgcn_rcpf(1.0f + __expf(-y2a[q])); y2b[q] = __builtin_amdgcn_rcpf(1.0f + __expf(-y2b[q])); } }
                    store8(dst, y1a, y1b); store8(dst + 64, y2a, y2b);
                }
        }
    }
};
struct ProjSched {
    pg8::TileOrder o; const char* ws;
    __device__ __forceinline__ bool next(int i, pg8::Unit& u) const { int pm, pn; if (!o.tile(i, pm, pn)) return false;
        u.A = ws + WS_XB + (size_t)pm * 256 * (DM * 2); u.B = ws + WS_WINT + (size_t)pn * 256 * (DM * 2); u.lda = DM * 2; u.ldb = DM * 2; u.nt = DM / 64; u.pm = pm; u.pn = pn; u.aux = 0; u.gidx = nullptr; u.gcnt = 0; return true; }
};

struct EpiMix {
    __device__ static __forceinline__ int brow(int h, int R) { return pg8::brow_perm8(h, R); }
    unsigned char* ws; const float* x;
    __device__ static __forceinline__ void unpack8(const u32x4 gw, f32x4& lo, f32x4& hi) { lo.x = bflo(gw.x); lo.y = bfhi(gw.x); lo.z = bflo(gw.y); lo.w = bfhi(gw.y); hi.x = bflo(gw.z); hi.y = bfhi(gw.z); hi.z = bflo(gw.w); hi.w = bfhi(gw.w); }
    __device__ __forceinline__ void operator()(f32x4 (&acc)[2][2][4][2], const pg8::Unit& u, int wr, int wc, int fr, int fq, LAS unsigned char* ex) const {
        const bf16_t* gates = (const bf16_t*)(ws + WS_GATES); bf16_t* merged = (bf16_t*)(ws + WS_MERGED); float* pre1 = (float*)(ws + WS_PRE1);
        { const int lane = lane_id(); fr = lane & 15; fq = lane >> 4; }
        const int mode = u.aux & 255; constexpr float GMIN = 8.673617379884035e-19f;
#pragma unroll
        for (int ai = 0; ai < 2; ++ai)
#pragma unroll
            for (int m = 0; m < 4; ++m) { const size_t mrow = (size_t)u.pm * 256 + ai * 128 + wr * 64 + m * 16 + fr;
#pragma unroll
                for (int bj = 0; bj < 2; ++bj) { const int col = u.pn * 256 + bj * 128 + wc * 32 + 8 * fq; const size_t o = mrow * DM + col;
                    if (mode == 2) {
                        const f32x4 x0 = *(const f32x4*)(x + o), x1 = *(const f32x4*)(x + o + 4);
                        *(f32x4*)(pre1 + o) = x0 * ALPHA + acc[ai][bj][m][0]; *(f32x4*)(pre1 + o + 4) = x1 * ALPHA + acc[ai][bj][m][1];
                    } else {
                        f32x4 g0a, g0b; unpack8(*(const u32x4*)(gates + mrow * 4096 + col), g0a, g0b);
#pragma unroll
                        for (int q = 0; q < 4; ++q) { g0a[q] = fmaxf(g0a[q], GMIN); g0b[q] = fmaxf(g0b[q], GMIN); }
                        if (mode == 1) { f32x4 g1a, g1b; unpack8(*(const u32x4*)(gates + mrow * 4096 + 2048 + col), g1a, g1b);
#pragma unroll
                            for (int q = 0; q < 4; ++q) { acc[ai][bj][m][0][q] *= g1a[q] * __builtin_amdgcn_rcpf(g0a[q]); acc[ai][bj][m][1][q] *= g1b[q] * __builtin_amdgcn_rcpf(g0b[q]); }
                        } else { const f32x4 t0 = g0a * acc[ai][bj][m][0], t1 = g0b * acc[ai][bj][m][1];
                            u32x4 w; w.x = cvtpk(t0.x, t0.y); w.y = cvtpk(t0.z, t0.w); w.z = cvtpk(t1.x, t1.y); w.w = cvtpk(t1.z, t1.w); *(u32x4*)(merged + o) = w; }
                    } } }
    }
};
struct MixSched {
    int mode, c; const char* ws;
    __device__ __forceinline__ bool next(int i, pg8::Unit& u) const {
        if (c >= 256) return false;
        const int pm = c >> 3, pn = c & 7; u.pm = pm; u.pn = pn; u.gidx = nullptr; u.gcnt = 0;
        if (mode == 0) { if (i > 1) return false;
            if (i == 1) { u.A = ws + WS_OA + (size_t)pm * 256 * 2048; u.B = ws + WS_WAT + (size_t)pn * 256 * 2048; u.lda = 2048; u.ldb = 2048; u.nt = 16; u.aux = 0; }
            else { u.A = ws + WS_OB + (size_t)pm * 256 * 4096; u.B = ws + WS_WBT + (size_t)pn * 256 * 4096; u.lda = 4096; u.ldb = 4096; u.nt = 32; u.aux = 1 | 256; }
            return true; }
        if (i > 0) return false;
        u.A = ws + WS_MERGED + (size_t)pm * 256 * 4096; u.B = ws + WS_WOT + (size_t)pn * 256 * 4096; u.lda = 4096; u.ldb = 4096; u.nt = 32; u.aux = 2; return true;
    }
};

struct MoeSched {
    int G, vcu, down; unsigned cnt_l, tpe_l;
    const char* ws;
    __device__ __forceinline__ void init(const unsigned* cnt, int lane) {
        unsigned c = 0; if (lane < NEXP) c = __hip_atomic_load(cnt + lane, __ATOMIC_RELAXED, __HIP_MEMORY_SCOPE_AGENT);
        unsigned t = (c + 255u) >> 8, inc = t;
#pragma unroll
        for (int o = 1; o < 32; o <<= 1) { const unsigned v = __shfl_up(inc, o); if ((lane & 31) >= o) inc += v; }
        cnt_l = c; tpe_l = inc - t;
    }
    __device__ __forceinline__ bool next(int i, pg8::Unit& u) const {
        const int lane = lane_id();
        const int total = (int)__builtin_amdgcn_readfirstlane(__shfl(tpe_l + ((cnt_l + 255u) >> 8), 31));
        const int L = i * G + vcu; if (L >= total * 8) return false;
        const int tg = L >> 3;
        const unsigned long long mk = __ballot(lane < NEXP && (int)tpe_l <= tg && (cnt_l > 0u));
        const int e = 63 - __builtin_clzll(mk);
        const int tp = (int)__builtin_amdgcn_readfirstlane(__shfl(tpe_l, e)), ce = (int)__builtin_amdgcn_readfirstlane(__shfl(cnt_l, e));
        const int te = (ce + 255) >> 8, q = L - 8 * tp, j = q / te, mt = q - j * te;
        u.pm = tp + mt; u.pn = j; u.aux = e; u.nt = down ? 16 : 32;
        if (!down) { u.A = ws + WS_H1B; u.lda = DM * 2; u.gidx = (const int*)(ws + WS_TOKIDX) + (size_t)e * ECAP + 256 * mt; u.gcnt = ce - 256 * mt; u.B = ws + WS_WGUT + ((size_t)e * 2048 + j * 256) * (DM * 2); u.ldb = DM * 2; }
        else { u.A = ws + WS_ACT + (size_t)(tp + mt) * 256 * (FF * 2); u.lda = FF * 2; u.gidx = nullptr; u.gcnt = 0; u.B = ws + WS_WDT + ((size_t)e * 2048 + j * 256) * (FF * 2); u.ldb = FF * 2; }
        return true;
    }
};
struct EpiMoe {
    __device__ static __forceinline__ int brow(int h, int R) { return pg8::brow_perm8(h, R); }
    int down; unsigned char* ws;
    __device__ __forceinline__ void operator()(ACC_T, const pg8::Unit& u, int wr, int wc, int fr, int fq, LAS unsigned char* ex) const {
        bf16_t* act = (bf16_t*)(ws + WS_ACT); bf16_t* y = (bf16_t*)(ws + WS_Y);
#pragma unroll
        for (int ai = 0; ai < 2; ++ai)
#pragma unroll
            for (int m = 0; m < 4; ++m) { const size_t row = (size_t)u.pm * 256 + ai * 128 + wr * 64 + m * 16 + fr;
                if (!down) {
                    f32x4 v0, v1;
#pragma unroll
                    for (int q = 0; q < 4; ++q) { const float g0 = acc[ai][0][m][0][q], u0 = acc[ai][1][m][0][q], g1 = acc[ai][0][m][1][q], u1 = acc[ai][1][m][1][q];
                        v0[q] = g0 * __builtin_amdgcn_rcpf(1.0f + __expf(-g0)) * u0; v1[q] = g1 * __builtin_amdgcn_rcpf(1.0f + __expf(-g1)) * u1; }
                    u32x4 w; w.x = cvtpk(v0.x, v0.y); w.y = cvtpk(v0.z, v0.w); w.z = cvtpk(v1.x, v1.y); w.w = cvtpk(v1.z, v1.w);
                    *(u32x4*)(act + row * FF + u.pn * 128 + wc * 32 + 8 * fq) = w;
                } else {
#pragma unroll
                    for (int bj = 0; bj < 2; ++bj) { const f32x4 a0 = acc[ai][bj][m][0], a1 = acc[ai][bj][m][1];
                        u32x4 w; w.x = cvtpk(a0.x, a0.y); w.y = cvtpk(a0.z, a0.w); w.z = cvtpk(a1.x, a1.y); w.w = cvtpk(a1.z, a1.w);
                        *(u32x4*)(y + row * DM + u.pn * 256 + bj * 128 + wc * 32 + 8 * fq) = w; }
                } }
    }
};


namespace mg {
constexpr int HTB = 16384, ABUF = 2 * HTB, BBUF = 64 * 256, B_OFF = 4 * ABUF;
struct Unit { const char* A; unsigned lda; const int* gidx; int gcnt; const float* B0; const float* B1; unsigned ldbf; int nt, up, pm, pn; };
template <int OFF> __device__ __forceinline__ s16x4 vtr(int addr) { s16x4 r; asm volatile("ds_read_b64_tr_b16 %0, %1 offset:%2" : "=&v"(r) : "v"(addr), "i"(OFF) : "memory"); return r; }

template <class Sched, class Epi, int XV>
__device__ __forceinline__ void gemm_phase(LAS unsigned char* lds, const Sched& S, const Epi& E, int wid) {
    const int lane = lane_id(), tid = wid * 64 + lane, wr = wid >> 2, wc = wid & 3, fr = lane & 15, fq = lane >> 4;
    const unsigned ldsw = (unsigned)wid * 1024u;
    const int aoff = pg8::lds_byte(wr * 64 + fr, fq * 8);
    const int n4 = tid & 31, kr = tid >> 5;
    const int tq = (lane & 15) >> 2, tp = lane & 3, tf = tq | ((fq & 1) << 2);
    const int ldsa = (int)(unsigned)(uintptr_t)lds;
    const int tb0 = B_OFF + (8 * fq + tq) * 256 + (((2 * wc) ^ tf) * 32) + 8 * tp, tb1 = B_OFF + (8 * fq + tq) * 256 + (((2 * wc + 1) ^ tf) * 32) + 8 * tp;
    const int wfk = (kr & 3) | (((kr >> 3) & 1) << 2);
#define MG_STAGE_A(slot, tt) do { _Pragma("unroll") for (int h_ = 0; h_ < 2; ++h_) _Pragma("unroll") for (int i_ = 0; i_ < 2; ++i_) \
        __builtin_amdgcn_global_load_lds((const unsigned*)(u.A + (size_t)(tt) * 128 + voffA[h_][i_]), (LAS unsigned*)(lds + (slot) * ABUF + h_ * HTB + ldsw + i_ * 8192), 16, 0, 0); } while (0)
#define MG_LOADB(R, tt) do { const float* p_ = bp + (size_t)(tt) * 64 * u.ldbf; \
        asm volatile("global_load_dwordx4 %0, %1, off" : "=v"(R##0) : "v"(p_) : "memory"); \
        asm volatile("global_load_dwordx4 %0, %1, off" : "=v"(R##1) : "v"(p_ + (size_t)16 * u.ldbf) : "memory"); \
        asm volatile("global_load_dwordx4 %0, %1, off" : "=v"(R##2) : "v"(p_ + (size_t)32 * u.ldbf) : "memory"); \
        asm volatile("global_load_dwordx4 %0, %1, off" : "=v"(R##3) : "v"(p_ + (size_t)48 * u.ldbf) : "memory"); } while (0)
#define MG_WAITB(R, N) asm volatile("s_waitcnt vmcnt(" #N ")" : "+v"(R##0), "+v"(R##1), "+v"(R##2), "+v"(R##3) :: "memory")
#define MG_PK(v) (u32x2){cvtpk((v).x, (v).y), cvtpk((v).z, (v).w)}
#define MG_WRITEB(R, slot) do { LAS unsigned char* w_ = lds + B_OFF + (slot) * BBUF + wa; \
        *(LAS u32x2*)(w_) = MG_PK(R##0); *(LAS u32x2*)(w_ + 4096) = MG_PK(R##1); *(LAS u32x2*)(w_ + 8192) = MG_PK(R##2); *(LAS u32x2*)(w_ + 12288) = MG_PK(R##3); } while (0)
#define MG_WAITV(N) asm volatile("s_waitcnt vmcnt(" #N ")" ::: "memory")
#define MG_BAR() do { asm volatile("" ::: "memory"); __builtin_amdgcn_s_barrier(); asm volatile("" ::: "memory"); } while (0)
#define MG_ITER(t, R) do { const int t_ = (t); \
        if (t_ + 1 < nt) { \
            if (t_ == 0 || t_ + 2 == nt) MG_WAITB(R, 4); else if (t_ == 1) MG_WAITB(R, 8); else MG_WAITB(R, 12); \
            MG_WRITEB(R, (t_ + 1) & 1); } \
        if (t_ + 3 < nt) { MG_LOADB(R, t_ + 3); MG_STAGE_A((t_ + 3) & 3, t_ + 3); } \
        const int as_ = (t_ & 3) * ABUF, ba0_ = ldsa + (t_ & 1) * BBUF + tb0, ba1_ = ldsa + (t_ & 1) * BBUF + tb1; bf16x8 Bf[2][2], At0[4][2], At1[4][2]; \
        { const s16x4 l0 = vtr<0>(ba0_), h0 = vtr<1024>(ba0_), l1 = vtr<0>(ba1_), h1 = vtr<1024>(ba1_), l2 = vtr<8192>(ba0_), h2 = vtr<9216>(ba0_), l3 = vtr<8192>(ba1_), h3 = vtr<9216>(ba1_); \
          _Pragma("unroll") for (int m = 0; m < 4; ++m) _Pragma("unroll") for (int k = 0; k < 2; ++k) At0[m][k] = *(const LAS bf16x8*)(lds + as_ + aoff + m * 2048 + k * 1024); \
          _Pragma("unroll") for (int m = 0; m < 4; ++m) _Pragma("unroll") for (int k = 0; k < 2; ++k) At1[m][k] = *(const LAS bf16x8*)(lds + as_ + HTB + aoff + m * 2048 + k * 1024); \
          if (t_ + 4 <= nt) MG_WAITV(16); else if (t_ + 3 == nt) MG_WAITV(8); else if (t_ + 2 == nt) MG_WAITV(0); \
          asm volatile("s_waitcnt lgkmcnt(0)" ::: "memory"); __builtin_amdgcn_sched_barrier(0); \
          Bf[0][0] = (bf16x8){l0[0], l0[1], l0[2], l0[3], h0[0], h0[1], h0[2], h0[3]}; Bf[1][0] = (bf16x8){l1[0], l1[1], l1[2], l1[3], h1[0], h1[1], h1[2], h1[3]}; \
          Bf[0][1] = (bf16x8){l2[0], l2[1], l2[2], l2[3], h2[0], h2[1], h2[2], h2[3]}; Bf[1][1] = (bf16x8){l3[0], l3[1], l3[2], l3[3], h3[0], h3[1], h3[2], h3[3]}; } \
        MG_BAR(); \
        __builtin_amdgcn_s_setprio(1); \
        _Pragma("unroll") for (int m = 0; m < 4; ++m) _Pragma("unroll") for (int nn = 0; nn < 2; ++nn) _Pragma("unroll") for (int k = 0; k < 2; ++k) \
            { if (XV != 64) acc[0][m][nn] = __builtin_amdgcn_mfma_f32_16x16x32_bf16(Bf[nn][k], At0[m][k], acc[0][m][nn], 0, 0, 0); else { asm volatile("" :: "v"(Bf[nn][k]), "v"(At0[m][k])); } } \
        _Pragma("unroll") for (int m = 0; m < 4; ++m) _Pragma("unroll") for (int nn = 0; nn < 2; ++nn) _Pragma("unroll") for (int k = 0; k < 2; ++k) \
            { if (XV != 64) acc[1][m][nn] = __builtin_amdgcn_mfma_f32_16x16x32_bf16(Bf[nn][k], At1[m][k], acc[1][m][nn], 0, 0, 0); else { asm volatile("" :: "v"(Bf[nn][k]), "v"(At1[m][k])); } } \
        __builtin_amdgcn_s_setprio(0); \
        MG_BAR(); } while (0)

    Unit u;
    for (int ui = 0; S.next(ui, u); ++ui) {
        const int nt = u.nt;
        unsigned voffA[2][2];
#pragma unroll
        for (int i = 0; i < 2; ++i) { int R, C; pg8::stage_rc(tid * 16 + i * 8192, R, C);
#pragma unroll
            for (int h = 0; h < 2; ++h) { int ra = h * 128 + R; if (u.gidx) ra = (ra < u.gcnt) ? u.gidx[ra] : 0; voffA[h][i] = (unsigned)ra * u.lda + (unsigned)C * 2u; } }
        const float* bp = (n4 < 16 ? u.B0 + 4 * n4 : u.B1 + 4 * (n4 - 16)) + (size_t)kr * u.ldbf;
        const int P = u.up ? (32 * ((n4 & 15) >> 2) + 16 * (n4 >> 4) + 4 * (n4 & 3)) : (32 * (n4 >> 3) + 16 * (n4 & 1) + 4 * ((n4 & 7) >> 1));
        const int wa = kr * 256 + (((P >> 4) ^ wfk) * 32) + (P & 15) * 2;
        f32x4 acc[2][4][2];
#pragma unroll
        for (int a = 0; a < 2; ++a)
#pragma unroll
            for (int m = 0; m < 4; ++m)
#pragma unroll
                for (int n = 0; n < 2; ++n) acc[a][m][n] = (f32x4){0.f, 0.f, 0.f, 0.f};
        f32x4 Ra0 = {}, Ra1 = {}, Ra2 = {}, Ra3 = {}, Rb0 = {}, Rb1 = {}, Rb2 = {}, Rb3 = {};
        MG_STAGE_A(0, 0); MG_STAGE_A(1, 1); MG_STAGE_A(2, 2);
        MG_LOADB(Ra, 0); MG_LOADB(Rb, 1);
        MG_WAITB(Ra, 4); MG_WRITEB(Ra, 0);
        MG_LOADB(Ra, 2);
        asm volatile("s_waitcnt lgkmcnt(0)" ::: "memory");
        if (wr == 1) MG_BAR();
        MG_BAR();
        for (int t = 0; t < nt; t += 2) {
            MG_ITER(t, Rb);
            MG_ITER(t + 1, Ra);
        }
        if (wr == 0) MG_BAR();
        E(acc, u, wid);
    }
#undef MG_STAGE_A
#undef MG_LOADB
#undef MG_WAITB
#undef MG_PK
#undef MG_WRITEB
#undef MG_WAITV
#undef MG_BAR
#undef MG_ITER
}
}

struct MoeSched2 {
    int G, vcu, down, var; unsigned cnt_l, tpe_l; const char* ws; const float *wgate, *wup, *wdown;
    __device__ __forceinline__ void init(const unsigned* cnt, int lane) {
        unsigned c = 0; if (lane < NEXP) c = __hip_atomic_load(cnt + lane, __ATOMIC_RELAXED, __HIP_MEMORY_SCOPE_AGENT);
        unsigned t = (c + 255u) >> 8, inc = t;
#pragma unroll
        for (int o = 1; o < 32; o <<= 1) { const unsigned v = __shfl_up(inc, o); if ((lane & 31) >= o) inc += v; }
        cnt_l = c; tpe_l = inc - t;
    }
    __device__ __forceinline__ bool next(int i, mg::Unit& u) const {
        const int lane = lane_id();
        const int total = (int)__builtin_amdgcn_readfirstlane(__shfl(tpe_l + ((cnt_l + 255u) >> 8), 31));
        const int L = i * G + vcu; if (L >= total * 16) return false;
        const int tg = L >> 4;
        const unsigned long long mk = __ballot(lane < NEXP && (int)tpe_l <= tg && (cnt_l > 0u));
        const int e = 63 - __builtin_clzll(mk);
        const int tp = (int)__builtin_amdgcn_readfirstlane(__shfl(tpe_l, e)), ce = (int)__builtin_amdgcn_readfirstlane(__shfl(cnt_l, e));
        const int te = (ce + 255) >> 8, q = L - 16 * tp, j = q / te, mt = q - j * te;
        u.pm = tp + mt; u.pn = j; u.up = down ? 0 : 1; u.nt = down ? 16 : 32;
        if (!down) { u.A = ws + WS_H1B; u.lda = DM * 2; u.gidx = (const int*)(ws + WS_TOKIDX) + (size_t)e * ECAP + 256 * mt; u.gcnt = ce - 256 * mt;
            u.B0 = wgate + (size_t)e * DM * FF + j * 64; u.B1 = wup + (size_t)e * DM * FF + j * 64; u.ldbf = FF;
            if (var == 61) { u.B0 = wgate; u.B1 = wup; }
            if (var == 65) { u.gidx = nullptr; u.A = ws + WS_H1B + (size_t)((tp + mt) & 31) * 256 * (DM * 2); } }
        else { u.A = ws + WS_ACT + (size_t)(tp + mt) * 256 * (FF * 2); u.lda = FF * 2; u.gidx = nullptr; u.gcnt = 0;
            u.B0 = wdown + (size_t)e * FF * DM + j * 128; u.B1 = u.B0 + 64; u.ldbf = DM; }
        return true;
    }
};
struct EpiMoe2 {
    int down; unsigned char* ws;
    __device__ __forceinline__ void operator()(f32x4 (&acc)[2][4][2], const mg::Unit& u, int wid) const {
        const int lane = lane_id(), wr = wid >> 2, wc = wid & 3, fr = lane & 15, fq = lane >> 4;
        bf16_t* act = (bf16_t*)(ws + WS_ACT); bf16_t* y = (bf16_t*)(ws + WS_Y);
#pragma unroll
        for (int ai = 0; ai < 2; ++ai)
#pragma unroll
            for (int m = 0; m < 4; ++m) { const size_t row = (size_t)u.pm * 256 + ai * 128 + wr * 64 + m * 16 + fr;
                if (!down) { f32x4 v;
#pragma unroll
                    for (int q = 0; q < 4; ++q) { const float g = acc[ai][m][0][q], up = acc[ai][m][1][q]; v[q] = g * __builtin_amdgcn_rcpf(1.0f + __expf(-g)) * up; }
                    u32x2 w; w.x = cvtpk(v.x, v.y); w.y = cvtpk(v.z, v.w);
                    *(u32x2*)(act + row * FF + u.pn * 64 + wc * 16 + 4 * fq) = w;
                } else { const f32x4 a0 = acc[ai][m][0], a1 = acc[ai][m][1];
                    u32x4 w; w.x = cvtpk(a0.x, a0.y); w.y = cvtpk(a0.z, a0.w); w.z = cvtpk(a1.x, a1.y); w.w = cvtpk(a1.z, a1.w);
                    *(u32x4*)(y + row * DM + u.pn * 128 + wc * 32 + 8 * fq) = w; } }
    }
};

namespace att {
constexpr int D = 128, NW = 8, QBLK = 32, KVBLK = 64;
constexpr float SCALE = SM_SCALE, THR = 8.f;
constexpr int SHM_V = KVBLK * D * 2, SHM_K = KVBLK * D * 2, SHM_ATTN = 2 * SHM_V + 2 * SHM_K + NW * 64 * 4;
#define KSWZ(row, colB) ((row) * 256 + ((colB) ^ (((row) & 7) << 4)))
#define SBAR() __builtin_amdgcn_sched_barrier(0)
__device__ __forceinline__ int crow(int r, int hi) { return (r & 3) + 8 * (r >> 2) + 4 * hi; }
template <bool BAND> __device__ __forceinline__ void partialSM(f32x16& p0, f32x16& p1, float& m_reg, float& mn, float& alpha, int dv, bool tv) {
    constexpr float C = SCALE * 1.4426950408889634f;
    if constexpr (BAND) {
#pragma unroll
        for (int r = 0; r < 16; ++r) { const int kx = (r & 3) + 8 * (r >> 2);
            if (!tv || (unsigned)(dv + kx) > 128u) p0[r] = -INFINITY;
            if (!tv || (unsigned)(dv + kx + 32) > 128u) p1[r] = -INFINITY; } }
    float pmax = p0[0];
#pragma unroll
    for (int r = 1; r < 16; ++r) pmax = fmaxf(pmax, p0[r]);
#pragma unroll
    for (int r = 0; r < 16; ++r) pmax = fmaxf(pmax, p1[r]);
    { auto rr = __builtin_amdgcn_permlane32_swap(__float_as_uint(pmax), __float_as_uint(pmax), false, false);
      pmax = fmaxf(__uint_as_float(rr[0]), __uint_as_float(rr[1])); }
    if (__builtin_expect(__all(pmax - m_reg <= THR / SCALE), 1)) { mn = m_reg; alpha = 1.f; }
    else { mn = fmaxf(m_reg, pmax); alpha = __builtin_amdgcn_exp2f((m_reg - mn) * C); m_reg = mn; }
    const float mnC = -mn * C;
#pragma unroll
    for (int r = 0; r < 16; ++r) p0[r] = fmaf(p0[r], C, mnC);
#pragma unroll
    for (int r = 0; r < 16; ++r) p1[r] = fmaf(p1[r], C, mnC);
#pragma unroll
    for (int r = 0; r < 16; ++r) p0[r] = __builtin_amdgcn_exp2f(p0[r]);
}
__device__ __forceinline__ void finishSM(f32x16& p0, f32x16& p1, float alpha, float& l_reg, bf16x8& pa0, bf16x8& pa1, bf16x8& pa2, bf16x8& pa3) {
#pragma unroll
    for (int r = 0; r < 16; ++r) p1[r] = __builtin_amdgcn_exp2f(p1[r]);
    float ps = 0;
#pragma unroll
    for (int r = 0; r < 16; ++r) ps += p0[r];
#pragma unroll
    for (int r = 0; r < 16; ++r) ps += p1[r];
    { auto rr = __builtin_amdgcn_permlane32_swap(__float_as_uint(ps), __float_as_uint(ps), false, false);
      ps = __uint_as_float(rr[0]) + __uint_as_float(rr[1]); }
    l_reg = l_reg * alpha + ps;
#define PK4(P, BASE, OUT) do { unsigned a0 = cvtpk(P[BASE + 0], P[BASE + 1]), a1 = cvtpk(P[BASE + 2], P[BASE + 3]);   \
    unsigned b0 = cvtpk(P[BASE + 4], P[BASE + 5]), b1 = cvtpk(P[BASE + 6], P[BASE + 7]);                              \
    auto r0 = __builtin_amdgcn_permlane32_swap(a0, b0, false, false); auto r1 = __builtin_amdgcn_permlane32_swap(a1, b1, false, false); \
    u32x4 w = {r0[0], r1[0], r0[1], r1[1]}; OUT = *reinterpret_cast<bf16x8*>(&w); } while (0)
    PK4(p0, 0, pa0); PK4(p0, 8, pa1); PK4(p1, 0, pa2); PK4(p1, 8, pa3);
#undef PK4
}
__device__ __forceinline__ void qkt(f32x16& p0, f32x16& p1, const LAS unsigned char* Ks, const bf16x8* qr, int r32, int hi) {
    p0 = f32x16{}; p1 = f32x16{};
#pragma unroll
    for (int d0 = 0; d0 < 8; ++d0) { const int cb = (d0 * 16 + hi * 8) * 2;
        const bf16x8 b0 = *(const LAS bf16x8*)(Ks + KSWZ(r32, cb));
        const bf16x8 b1 = *(const LAS bf16x8*)(Ks + KSWZ(32 + r32, cb));
        p0 = __builtin_amdgcn_mfma_f32_32x32x16_bf16(b0, qr[d0], p0, 0, 0, 0);
        p1 = __builtin_amdgcn_mfma_f32_32x32x16_bf16(b1, qr[d0], p1, 0, 0, 0); }
}
__device__ __forceinline__ int v_st(int k, int c) { const int kk = (k & ~0xC) | ((k & 4) << 1) | ((k & 8) >> 1); return ((kk >> 3) * 4 + (c >> 5)) * 512 + ((kk & 7) * 32 + (c & 31)) * 2; }
__device__ __forceinline__ int v_rd_base(int lane) { return ((lane & 3) << 3) | (((lane >> 2) & 3) << 6) | (((lane >> 4) & 1) << 5) | (((lane >> 5) & 1) << 8); }
constexpr int v_rd_off(int d0, int ks, int half) { return d0 * 512 + ks * 4096 + half * 2048; }
template <int OFF> __device__ __forceinline__ s16x4 tr_read(int vb) { s16x4 r; asm volatile("ds_read_b64_tr_b16 %0, %1 offset:%2" : "=&v"(r) : "v"(vb), "i"(OFF) : "memory"); return r; }
template <int D0> __device__ __forceinline__ void pv_one(f32x16& od, int vb, bf16x8 pa0, bf16x8 pa1, bf16x8 pa2, bf16x8 pa3) {
    const s16x4 l0 = tr_read<v_rd_off(D0, 0, 0)>(vb), h0 = tr_read<v_rd_off(D0, 0, 1)>(vb), l1 = tr_read<v_rd_off(D0, 1, 0)>(vb), h1 = tr_read<v_rd_off(D0, 1, 1)>(vb);
    const s16x4 l2 = tr_read<v_rd_off(D0, 2, 0)>(vb), h2 = tr_read<v_rd_off(D0, 2, 1)>(vb), l3 = tr_read<v_rd_off(D0, 3, 0)>(vb), h3 = tr_read<v_rd_off(D0, 3, 1)>(vb);
    asm volatile("s_waitcnt lgkmcnt(0)" ::: "memory"); SBAR();
#define PK(L, H) (bf16x8){L[0], L[1], L[2], L[3], H[0], H[1], H[2], H[3]}
    od = __builtin_amdgcn_mfma_f32_32x32x16_bf16(pa0, PK(l0, h0), od, 0, 0, 0);
    od = __builtin_amdgcn_mfma_f32_32x32x16_bf16(pa1, PK(l1, h1), od, 0, 0, 0);
    od = __builtin_amdgcn_mfma_f32_32x32x16_bf16(pa2, PK(l2, h2), od, 0, 0, 0);
    od = __builtin_amdgcn_mfma_f32_32x32x16_bf16(pa3, PK(l3, h3), od, 0, 0, 0);
#undef PK
}
__device__ __forceinline__ void pv_d0(f32x16* o, int vb, bf16x8 pa0, bf16x8 pa1, bf16x8 pa2, bf16x8 pa3) {
    pv_one<0>(o[0], vb, pa0, pa1, pa2, pa3); pv_one<1>(o[1], vb, pa0, pa1, pa2, pa3); pv_one<2>(o[2], vb, pa0, pa1, pa2, pa3); pv_one<3>(o[3], vb, pa0, pa1, pa2, pa3);
}
struct Unit { const bf16_t *Q, *K, *V; bf16_t* O; float* lse; int ldo, lse_stride, nt, kt0, klo, khi, q0; };
__device__ __forceinline__ void body(const Unit& u, LAS unsigned char* lds, int wid) {
    const int lane = lane_id(), tid = wid * 64 + lane,
        r32 = lane & 31, hi = lane >> 5;
    LAS unsigned char* V_lds = lds; LAS unsigned char* K_lds = lds + 2 * SHM_V;
    LAS float* ws = (LAS float*)(lds + 2 * SHM_V + 2 * SHM_K) + wid * 64; LAS float* li_l = ws; LAS float* al_l = ws + 32;
    float m_reg = -1e30f, l_reg = 0; f32x16 o[4] = {}; bf16x8 qr[8];
    const bf16_t* Qw = u.Q + (size_t)(wid * QBLK + r32) * D + hi * 8;
#pragma unroll
    for (int d0 = 0; d0 < 8; ++d0) qr[d0] = *(const bf16x8*)(Qw + d0 * 16);
    const int sr = tid >> 4, sc = (tid & 15) * 8, vst0 = v_st(sr, sc), vst1 = v_st(32 + sr, sc);
    const int vb0 = (int)(unsigned)(uintptr_t)V_lds + v_rd_base(lane);
    const bf16_t* Kh = u.K; const bf16_t* Vh = u.V;
    constexpr bool BAND = false; constexpr int SD = 1; const int dq = 0;
#define TVALID(j) true
    struct { bf16x8 vs0, vs1, ks0, ks1; } sr_[SD];
#define KROW(j) (BAND ? ((u.kt0 + 64 * (j)) < u.klo ? u.klo : ((u.kt0 + 64 * (j)) > u.khi - 64 ? u.khi - 64 : (u.kt0 + 64 * (j)))) : (u.kt0 + 64 * (j)))
#define SLOAD(i, j) do { const int k0_ = KROW(j); sr_[i].vs0 = *(const bf16x8*)(&Vh[(size_t)(k0_ + sr) * D + sc]); sr_[i].vs1 = *(const bf16x8*)(&Vh[(size_t)(k0_ + 32 + sr) * D + sc]); \
    sr_[i].ks0 = *(const bf16x8*)(&Kh[(size_t)(k0_ + sr) * D + sc]); sr_[i].ks1 = *(const bf16x8*)(&Kh[(size_t)(k0_ + 32 + sr) * D + sc]); } while (0)
#define SWRITE(b, i) do { *(LAS bf16x8*)(V_lds + (b) * SHM_V + vst0) = sr_[i].vs0; *(LAS bf16x8*)(V_lds + (b) * SHM_V + vst1) = sr_[i].vs1; const int kc = sc * 2; \
    *(LAS bf16x8*)(K_lds + (b) * SHM_K + KSWZ(sr, kc)) = sr_[i].ks0; *(LAS bf16x8*)(K_lds + (b) * SHM_K + KSWZ(32 + sr, kc)) = sr_[i].ks1; } while (0)
#define SWAIT() do { if constexpr (SD == 2) asm volatile("s_waitcnt vmcnt(4)" ::: "memory"); else asm volatile("s_waitcnt vmcnt(0)" ::: "memory"); } while (0)
#define RESC(a) do { if (__any((a) < 1.f)) { if (hi == 0) al_l[r32] = (a); asm volatile("s_waitcnt lgkmcnt(0)" ::: "memory"); \
    _Pragma("unroll") for (int d = 0; d < 4; ++d) _Pragma("unroll") for (int r = 0; r < 16; ++r) o[d][r] *= al_l[crow(r, hi)]; } } while (0)
    f32x16 pA0, pA1, pB0, pB1; float mnA, mnB, alA, alB; bf16x8 pa0, pa1, pa2, pa3; const int NT = u.nt;
    constexpr int SE = 0, SO = SD - 1;
    SLOAD(SE, 0); asm volatile("s_waitcnt vmcnt(0)" ::: "memory"); SWRITE(0, SE); __syncthreads();
    qkt(pA0, pA1, K_lds, qr, r32, hi); partialSM<BAND>(pA0, pA1, m_reg, mnA, alA, dq, TVALID(0));
    SLOAD(SO, 1); if constexpr (SD == 2) { if (2 < NT) SLOAD(SE, 2); }
    SWAIT(); SWRITE(1, SO); __syncthreads();
    for (int j = 1; j + 1 < NT; j += 2) {
        SBAR(); qkt(pB0, pB1, K_lds + SHM_K, qr, r32, hi);
        finishSM(pA0, pA1, alA, l_reg, pa0, pa1, pa2, pa3); SBAR();
        SLOAD(SO, j + SD); SBAR();
        pv_d0(o, vb0, pa0, pa1, pa2, pa3); partialSM<BAND>(pB0, pB1, m_reg, mnB, alB, dq + 64 * j, TVALID(j));
        __syncthreads(); SWAIT(); SWRITE(0, SE);
        RESC(alB); __syncthreads();
        SBAR(); qkt(pA0, pA1, K_lds, qr, r32, hi);
        finishSM(pB0, pB1, alB, l_reg, pa0, pa1, pa2, pa3); SBAR();
        if (SD == 1 || j + 3 < NT) SLOAD(SE, j + 1 + SD); SBAR();
        pv_d0(o, vb0 + SHM_V, pa0, pa1, pa2, pa3); partialSM<BAND>(pA0, pA1, m_reg, mnA, alA, dq + 64 * (j + 1), TVALID(j + 1));
        __syncthreads(); SWAIT(); SWRITE(1, SO);
        RESC(alA); __syncthreads();
    }
    SBAR(); qkt(pB0, pB1, K_lds + SHM_K, qr, r32, hi);
    finishSM(pA0, pA1, alA, l_reg, pa0, pa1, pa2, pa3); SBAR();
    pv_d0(o, vb0, pa0, pa1, pa2, pa3); partialSM<BAND>(pB0, pB1, m_reg, mnB, alB, dq + 64 * (NT - 1), TVALID(NT - 1));
    __syncthreads(); RESC(alB);
    finishSM(pB0, pB1, alB, l_reg, pa0, pa1, pa2, pa3); SBAR();
    pv_d0(o, vb0 + SHM_V, pa0, pa1, pa2, pa3);
    if (hi == 0) li_l[r32] = l_reg; asm volatile("s_waitcnt lgkmcnt(0)" ::: "memory");
    float rli[16];
#pragma unroll
    for (int r = 0; r < 16; ++r) rli[r] = __builtin_amdgcn_rcpf(li_l[crow(r, hi)]);
    {
        LAS unsigned char* ot = lds + SHM_ATTN + 1024 + wid * 8192;
#pragma unroll
        for (int r = 0; r < 16; ++r) { const int orow = crow(r, hi);
#pragma unroll
            for (int d0 = 0; d0 < 4; ++d0) *(LAS bf16_t*)(ot + orow * 256 + (d0 * 32 + r32) * 2) = f2bf(o[d0][r] * rli[r]); }
        asm volatile("s_waitcnt lgkmcnt(0)" ::: "memory");
        bf16_t* Ow = u.O + (size_t)(wid * QBLK) * u.ldo;
#pragma unroll
        for (int q = 0; q < 8; ++q) { const int orow = q * 4 + (lane >> 4), oc = (lane & 15) * 8;
            *(u32x4*)(Ow + (size_t)orow * u.ldo + oc) = *(const LAS u32x4*)(ot + orow * 256 + oc * 2); }
    }
    if (u.lse && hi == 0) u.lse[(size_t)(wid * QBLK + r32) * u.lse_stride] = m_reg * SCALE + __logf(l_reg);
    __syncthreads();
#undef KROW
#undef TVALID
#undef SLOAD
#undef SWRITE
#undef SWAIT
#undef RESC
}

__device__ __forceinline__ void band_body(const Unit& u, LAS unsigned char* lds, int wid) {
    const int lane = lane_id(), tid = wid * 64 + lane, r32 = lane & 31, hi = lane >> 5;
    LAS unsigned char* V_lds = lds; LAS unsigned char* K_lds = lds + 2 * SHM_V;
    LAS float* ws = (LAS float*)(lds + 2 * SHM_V + 2 * SHM_K) + wid * 64; LAS float* li_l = ws; LAS float* al_l = ws + 32;
    float m_reg = -1e30f, l_reg = 0; f32x16 o[4] = {}; bf16x8 qr[8];
    const bf16_t* Qw = u.Q + (size_t)(wid * QBLK + r32) * D + hi * 8;
#pragma unroll
    for (int d0 = 0; d0 < 8; ++d0) qr[d0] = *(const bf16x8*)(Qw + d0 * 16);
    const int sr = tid >> 4, sc = (tid & 15) * 8, vst0 = v_st(sr, sc), vst1 = v_st(32 + sr, sc);
    const int vb0 = (int)(unsigned)(uintptr_t)V_lds + v_rd_base(lane);
    const bf16_t* Kh = u.K; const bf16_t* Vh = u.V;
    const int dq = u.kt0 - (u.q0 + wid * QBLK + r32) + 4 * hi + 64;
    bf16x8 A_vs0, A_vs1, A_ks0, A_ks1, B_vs0, B_vs1, B_ks0, B_ks1, C_vs0, C_vs1, C_ks0, C_ks1;
#define KROW(j) ((u.kt0 + 64 * (j)) < u.klo ? u.klo : ((u.kt0 + 64 * (j)) > u.khi - 64 ? u.khi - 64 : (u.kt0 + 64 * (j))))
#define TVALID(j) ((u.kt0 + 64 * (j)) >= u.klo && (u.kt0 + 64 * (j)) < u.khi)
#define SLOAD(S, j) do { const int k0_ = KROW(j); S##vs0 = *(const bf16x8*)(&Vh[(size_t)(k0_ + sr) * D + sc]); S##vs1 = *(const bf16x8*)(&Vh[(size_t)(k0_ + 32 + sr) * D + sc]); \
    S##ks0 = *(const bf16x8*)(&Kh[(size_t)(k0_ + sr) * D + sc]); S##ks1 = *(const bf16x8*)(&Kh[(size_t)(k0_ + 32 + sr) * D + sc]); } while (0)
#define SWRITE(b, S) do { *(LAS bf16x8*)(V_lds + (b) * SHM_V + vst0) = S##vs0; *(LAS bf16x8*)(V_lds + (b) * SHM_V + vst1) = S##vs1; const int kc = sc * 2; \
    *(LAS bf16x8*)(K_lds + (b) * SHM_K + KSWZ(sr, kc)) = S##ks0; *(LAS bf16x8*)(K_lds + (b) * SHM_K + KSWZ(32 + sr, kc)) = S##ks1; } while (0)
    const int ja = (wid >> 1), jb = (wid >> 1) + 2;
#define BAND_ITER(j, STAGE) do { const int cur = (j) & 1; const bool act = ((j) >= ja) && ((j) <= jb); bf16x8 pa0, pa1, pa2, pa3; \
        if (act) { f32x16 p0, p1; float mn, al; \
            qkt(p0, p1, K_lds + cur * SHM_K, qr, r32, hi); \
            partialSM<true>(p0, p1, m_reg, mn, al, dq + 64 * (j), TVALID(j)); \
            if (__any(al < 1.f)) { if (hi == 0) al_l[r32] = al; asm volatile("s_waitcnt lgkmcnt(0)" ::: "memory"); \
                _Pragma("unroll") for (int d = 0; d < 4; ++d) _Pragma("unroll") for (int r = 0; r < 16; ++r) o[d][r] *= al_l[crow(r, hi)]; } \
            finishSM(p0, p1, al, l_reg, pa0, pa1, pa2, pa3); SBAR(); } \
        STAGE; SBAR(); \
        if (act) pv_d0(o, vb0 + cur * SHM_V, pa0, pa1, pa2, pa3); \
        __syncthreads(); } while (0)
    SLOAD(A_, 0); SLOAD(B_, 1); SLOAD(C_, 2);
    SWRITE(0, A_); SLOAD(A_, 3);
    __syncthreads();
    BAND_ITER(0, SWRITE(1, B_); SLOAD(B_, 4));
    BAND_ITER(1, SWRITE(0, C_); SLOAD(C_, 5));
    BAND_ITER(2, SWRITE(1, A_));
    BAND_ITER(3, SWRITE(0, B_));
    BAND_ITER(4, SWRITE(1, C_));
    BAND_ITER(5, (void)0);
#undef BAND_ITER
    if (hi == 0) li_l[r32] = l_reg; asm volatile("s_waitcnt lgkmcnt(0)" ::: "memory");
    float rli[16];
#pragma unroll
    for (int r = 0; r < 16; ++r) rli[r] = __builtin_amdgcn_rcpf(li_l[crow(r, hi)]);
    {
        LAS unsigned char* ot = lds + SHM_ATTN + 1024 + wid * 8192;
#pragma unroll
        for (int r = 0; r < 16; ++r) { const int orow = crow(r, hi);
#pragma unroll
            for (int d0 = 0; d0 < 4; ++d0) *(LAS bf16_t*)(ot + orow * 256 + (d0 * 32 + r32) * 2) = f2bf(o[d0][r] * rli[r]); }
        asm volatile("s_waitcnt lgkmcnt(0)" ::: "memory");
        bf16_t* Ow = u.O + (size_t)(wid * QBLK) * u.ldo;
#pragma unroll
        for (int q = 0; q < 8; ++q) { const int orow = q * 4 + (lane >> 4), oc = (lane & 15) * 8;
            *(u32x4*)(Ow + (size_t)orow * u.ldo + oc) = *(const LAS u32x4*)(ot + orow * 256 + oc * 2); }
    }
    if (hi == 0) u.lse[(size_t)(wid * QBLK + r32) * u.lse_stride] = m_reg * SCALE + __logf(l_reg);
    __syncthreads();
#undef KROW
#undef TVALID
#undef SLOAD
#undef SWRITE
}
}

#define XB_TMO      128
#define XB_XCNT(j)  (256  + 64 * (j))
#define XB_XSUB(j)  (1280 + 64 * (j))
#define XB_XGEN(j)  (2304 + 64 * (j))
#define XB_TOP      3328
#define XB_TOPGEN   3392
#define XCD_BAR_WORDS 3456
#define XB_SPIN_CAP (1u << 20)
__device__ __forceinline__ unsigned xb_ld(unsigned* p)              { return __hip_atomic_load(p, __ATOMIC_RELAXED, __HIP_MEMORY_SCOPE_AGENT); }
__device__ __forceinline__ unsigned xb_add(unsigned* p, unsigned v) { return __hip_atomic_fetch_add(p, v, __ATOMIC_RELAXED, __HIP_MEMORY_SCOPE_AGENT); }
__device__ __forceinline__ unsigned xb_xcc_id() { return (unsigned)__builtin_amdgcn_s_getreg((3 << 11) | 20) & 0xFu; }
#define XB_SPIN(cond, bar) do { unsigned _sp = 0; while (cond) { __builtin_amdgcn_s_sleep(1); \
    if ((++_sp & 255u) == 0u) { if (xb_ld(&(bar)[XB_TMO])) break; if (_sp > XB_SPIN_CAP) { atomicAdd(&(bar)[XB_TMO], 1u); break; } } } } while (0)
__device__ __forceinline__ void xcd_barrier_post(unsigned* bar, bool leader) { if (leader) (void)xb_add(&bar[XB_XCNT(xb_xcc_id())], 1u); }
__device__ __forceinline__ void xcd_barrier_complete(unsigned* bar, unsigned x, unsigned G, unsigned& nloc, unsigned& nx) {
    unsigned sum, cnt, mine, sp = 0u;
    for (;;) {
        sum = 0u; cnt = 0u; mine = 0u;
#pragma unroll
        for (unsigned j = 0; j < 16; ++j) { const unsigned c = xb_ld(&bar[XB_XCNT(j)]); sum += c; cnt += (c > 0u) ? 1u : 0u; mine = (j == x) ? c : mine; }
        if (sum == G) break;
        __builtin_amdgcn_s_sleep(1);
        if ((++sp & 255u) == 0u) { if (xb_ld(&bar[XB_TMO])) break; if (sp > XB_SPIN_CAP) { atomicAdd(&bar[XB_TMO], 1u); break; } }
    }
    nloc = mine > 0u ? mine : 1u; nx = cnt > 0u ? cnt : 1u;
}
__device__ __forceinline__ void xcd_barrier(unsigned* bar, unsigned* st, unsigned G, bool leader) {
    asm volatile("s_waitcnt vmcnt(0)" ::: "memory");
    __syncthreads();
    if (leader) {
        __builtin_amdgcn_s_waitcnt(0);
        const unsigned x = xb_xcc_id();
        unsigned nloc = xb_ld(st), nx = xb_ld(st + 1);
        if (nloc == 0u) { xcd_barrier_complete(bar, x, G, nloc, nx); __hip_atomic_store(st, nloc, __ATOMIC_RELAXED, __HIP_MEMORY_SCOPE_AGENT); __hip_atomic_store(st + 1, nx, __ATOMIC_RELAXED, __HIP_MEMORY_SCOPE_AGENT); }
        const unsigned old = xb_add(&bar[XB_XSUB(x)], 1u);
        const unsigned gen = old / nloc;
        if (old + 1u == (gen + 1u) * nloc) {
            __builtin_amdgcn_fence(__ATOMIC_RELEASE, "agent");
            asm volatile("s_waitcnt vmcnt(0)" ::: "memory");
            const unsigned og = xb_add(&bar[XB_TOP], 1u);
            const unsigned tg = og / nx;
            if (og + 1u == (tg + 1u) * nx) xb_add(&bar[XB_TOPGEN], 1u);
            else XB_SPIN(xb_ld(&bar[XB_TOPGEN]) == tg, bar);
            __builtin_amdgcn_fence(__ATOMIC_ACQUIRE, "agent");
            xb_add(&bar[XB_XGEN(x)], 1u);
            asm volatile("s_waitcnt vmcnt(0)" ::: "memory");
        } else {
            XB_SPIN(xb_ld(&bar[XB_XGEN(x)]) == gen, bar);
            __builtin_amdgcn_fence(__ATOMIC_ACQUIRE, "agent");
            asm volatile("s_waitcnt vmcnt(0)" ::: "memory");
        }
    }
    __syncthreads();
}

constexpr int RING_BYTES = 131072, EX_OFF = RING_BYTES, LDS_BYTES = 163840;
constexpr int NWAVES = 8;

struct Args {
    const float* in[18]; float* out; unsigned char* ws; int ph_lo, ph_hi; int use_bar, bar_region;
};

__device__ __forceinline__ void p0_transpose_item(const float* W, int K, int N, bf16_t* WT, int rowblk, int roff, LAS float* scr, int item, int lane) {
    const int nblk = N / 32, kb = item / nblk, nb = item % nblk, k0 = 64 * kb, n0 = 32 * nb;
#pragma unroll 8
    for (int i = 0; i < 32; ++i) { const int kk = 2 * i + (lane >> 5); scr[kk * 33 + (lane & 31)] = W[(size_t)(k0 + kk) * N + n0 + (lane & 31)]; }
    asm volatile("s_waitcnt lgkmcnt(0)" ::: "memory");
    const int c = lane & 7;
#pragma unroll
    for (int j = 0; j < 4; ++j) { const int nl = (lane >> 3) + 8 * j; const LAS float* s = scr + (8 * c) * 33 + nl; const int n = n0 + nl;
        u32x4 o; o.x = pk2(s[0 * 33], s[1 * 33]); o.y = pk2(s[2 * 33], s[3 * 33]); o.z = pk2(s[4 * 33], s[5 * 33]); o.w = pk2(s[6 * 33], s[7 * 33]);
        const int dr = (n >> 7) * rowblk + roff + (n & 127);
        *(u32x4*)(WT + (size_t)dr * K + k0 + 8 * c) = o; }
    asm volatile("s_waitcnt lgkmcnt(0)" ::: "memory");
}

template <int VAR>
__global__ void __launch_bounds__(NWAVES * 64, 2) mk_fwd(Args args) {
    extern __shared__ __attribute__((aligned(16))) unsigned char lds_raw[];
    LAS unsigned char* lds = (LAS unsigned char*)lds_raw;
    const int wave = __builtin_amdgcn_readfirstlane(threadIdx.x >> 6);
#define PHASE_IDS() const int lane = lane_id(), tid = wave * 64 + lane; (void)tid; const int gw = vcu * NWAVES + wave, NGW = G * NWAVES; (void)lane; (void)gw; (void)NGW
    const int G = gridDim.x, bx = blockIdx.x; const int vcu = (G % 8 == 0) ? (bx % 8) * (G / 8) + bx / 8 : bx;
    unsigned char* ws = args.ws;
    unsigned* ctl = (unsigned*)(ws + WS_CTL);
    if (args.use_bar) xcd_barrier_post((unsigned*)(args.ws + WS_CTL) + CW_BAR + args.bar_region * XCD_BAR_WORDS, wave == 0 && lane_id() == 0);
    if (args.use_bar == 12345) cooperative_groups::this_grid().sync();
#define GRID_BAR() do { if (args.use_bar) xcd_barrier((unsigned*)(args.ws + WS_CTL) + CW_BAR + args.bar_region * XCD_BAR_WORDS, (unsigned*)(args.ws + WS_CTL) + CW_WGST + args.bar_region * 32768 + 64 * (int)blockIdx.x, (unsigned)G, wave == 0 && lane_id() == 0); } while (0)
    const int lo = args.ph_lo, hi = args.ph_hi;
#ifndef MK_CMASK
#define MK_CMASK 0x1ff
#endif
#define IN(k) ((((MK_CMASK) >> (k)) & 1) && lo <= (k) && (k) < hi)
#define BOTH(k) (IN(k) && IN((k) + 1))

    if (IN(0)) {
        PHASE_IDS();
        const float* x = args.in[0];
        bf16_t* XB = (bf16_t*)(ws + WS_XB); bf16_t* WINT = (bf16_t*)(ws + WS_WINT); bf16_t* WAT = (bf16_t*)(ws + WS_WAT); bf16_t* WBT = (bf16_t*)(ws + WS_WBT); bf16_t* WOT = (bf16_t*)(ws + WS_WOT);
        bf16_t* WGUT = (bf16_t*)(ws + WS_WGUT); bf16_t* WDT = (bf16_t*)(ws + WS_WDT);
        LAS float* scr = (LAS float*)(lds + wave * 16384);
        constexpr int I_IN = (DM / 64) * (IN_COLS / 32), I_A = (1024 / 64) * (DM / 32), I_B = (DM / 64) * (DM / 32), I_O = I_B;
        constexpr int I_G = (DM / 64) * (FF / 32), I_D = (FF / 64) * (DM / 32);
        constexpr int NITEMS = I_IN + I_A + I_B + I_O + NEXP * (2 * I_G + I_D);
        for (int it = gw; it < I_IN + I_A + I_B + I_O; it += NGW) {
            int r = it;
            if (r < I_IN) { p0_transpose_item(args.in[1], DM, IN_COLS, WINT, 128, 0, scr, r, lane); continue; } r -= I_IN;
            if (r < I_A) { p0_transpose_item(args.in[4], 1024, DM, WAT, 128, 0, scr, r, lane); continue; } r -= I_A;
            if (r < I_B) { p0_transpose_item(args.in[5], DM, DM, WBT, 128, 0, scr, r, lane); continue; } r -= I_B;
            if (r < I_O) { p0_transpose_item(args.in[6], DM, DM, WOT, 128, 0, scr, r, lane); continue; } r -= I_O;
            const int e = r / (2 * I_G + I_D); r -= e * (2 * I_G + I_D);
            if (r < I_G) { p0_transpose_item(args.in[13] + (size_t)e * DM * FF, DM, FF, WGUT + (size_t)e * 2048 * DM, 256, 0, scr, r, lane); continue; } r -= I_G;
            if (r < I_G) { p0_transpose_item(args.in[14] + (size_t)e * DM * FF, DM, FF, WGUT + (size_t)e * 2048 * DM, 256, 128, scr, r, lane); continue; } r -= I_G;
            p0_transpose_item(args.in[15] + (size_t)e * FF * DM, FF, DM, WDT + (size_t)e * DM * FF, 128, 0, scr, r, lane);
        }
        for (int m = gw; m < NTOK; m += NGW) {
            const f32x4* xr = (const f32x4*)(x + (size_t)m * DM) + lane; u32x2* o8 = (u32x2*)(XB + (size_t)m * DM) + lane;
#pragma unroll
            for (int j = 0; j < 8; ++j) { const f32x4 v = xr[64 * j]; u32x2 w; w.x = pk2(v.x, v.y); w.y = pk2(v.z, v.w); o8[64 * j] = w; }
        }
        { float2* rt1 = (float2*)(ws + WS_RT1); float2* rt2 = (float2*)(ws + WS_RT2);
          for (int i = (vcu * NWAVES * 64) + tid; i < SEQ * 64; i += G * NWAVES * 64) { const int t = i >> 6, c = i & 63; float cs, sn;
              rope1(t, c, cs, sn); rt1[i] = make_float2(cs, sn); rope2(t, c, cs, sn); rt2[i] = make_float2(cs, sn); } }
        { float* wt = (float*)(ws + WS_WRT); const float* wgp = args.in[9]; const float* wrp = args.in[11];
          for (int i = (vcu * NWAVES * 64) + tid; i < 36 * DM; i += G * NWAVES * 64) { const int c = i >> 11, k = i & (DM - 1); wt[i] = (c < 4) ? wgp[(size_t)k * 4 + c] : wrp[(size_t)k * 32 + (c - 4)]; } }
        if (BOTH(0)) GRID_BAR();
    }

    if (IN(1)) {
        EpiProj E; E.ws = ws; E.qg = args.in[2]; E.kg = args.in[3];
        ProjSched S; S.o.init(NTOK, IN_COLS, G, bx); S.ws = (const char*)ws;
        pg8::gemm_phase<EpiProj, ProjSched, PG8_ALIGN, PG8_SP2>(lds, lds + EX_OFF, S, E, wave);
        if (BOTH(1)) GRID_BAR();
    }

    if (IN(2)) {
        if (VAR != 22) for (int i = 0; i < 2; ++i) {
            const int idx = bx + i * G; if (idx >= 512) break;
            const int bk = idx & 7, rest = idx >> 3, b = bk >> 2, kvh = bk & 3, hq = kvh * 4 + (rest & 3), qblk = rest >> 2;
            att::Unit u; u.Q = (const bf16_t*)(ws + WS_QB) + ((size_t)(b * 16 + hq) * SEQ + qblk * 256) * HD;
            u.K = (const bf16_t*)(ws + WS_KB) + (size_t)(b * 4 + kvh) * SEQ * HD; u.V = (const bf16_t*)(ws + WS_VB) + (size_t)(b * 4 + kvh) * SEQ * HD;
            u.O = (bf16_t*)(ws + WS_OB) + ((size_t)b * SEQ + qblk * 256) * 2048 + hq * HD; u.ldo = 2048; u.lse = nullptr; u.lse_stride = 0; u.nt = 64; u.kt0 = 0; u.klo = 0; u.khi = SEQ; u.q0 = 0;
            att::body(u, lds, wave);
        }
        if (VAR != 21) for (int i = 0; i < 3; ++i) {
            const int idx = bx + i * G; if (idx >= 768) break;
            const int sid = idx >> 4, qblk = idx & 15, g = sid >> 4, b = (sid >> 3) & 1, h = sid & 7, sh = 2 * g, L = SEQ >> sh;
            const int P0 = qblk * 256, r = P0 / L, p0 = P0 - r * L;
            att::Unit u; u.Q = (const bf16_t*)(ws + WS_QA) + ((size_t)sid * SEQ + P0) * HD; u.K = (const bf16_t*)(ws + WS_KA) + (size_t)sid * SEQ * HD; u.V = (const bf16_t*)(ws + WS_VA) + (size_t)sid * SEQ * HD;
            const size_t tok0 = (size_t)b * SEQ + ((size_t)p0 << sh) + r;
            u.O = (bf16_t*)(ws + WS_OAG) + ((size_t)g * NTOK + tok0) * 1024 + h * HD; u.ldo = 1024 << sh;
            u.lse = (float*)(ws + WS_LSE) + ((size_t)g * NTOK + tok0) * 8 + h; u.lse_stride = 8 << sh;
            u.nt = 6; u.kt0 = P0 - 64; u.klo = r * L; u.khi = r * L + L; u.q0 = P0;
            att::band_body(u, lds, wave);
        }
        GRID_BAR();
        {
            PHASE_IDS();
            const bf16_t* oag = (const bf16_t*)(ws + WS_OAG); const float* lse = (const float*)(ws + WS_LSE); bf16_t* oa = (bf16_t*)(ws + WS_OA);
            for (int m = gw; m < NTOK; m += NGW) { const int c = lane * 16, h = lane >> 3;
                const float l0 = lse[(0 * (size_t)NTOK + m) * 8 + h], l1 = lse[(1 * (size_t)NTOK + m) * 8 + h], l2 = lse[(2 * (size_t)NTOK + m) * 8 + h];
                const float mx = fmaxf(l0, fmaxf(l1, l2)); float e0 = __expf(l0 - mx), e1 = __expf(l1 - mx), e2 = __expf(l2 - mx); const float inv = 1.0f / (e0 + e1 + e2); e0 *= inv; e1 *= inv; e2 *= inv;
#pragma unroll
                for (int q = 0; q < 2; ++q) { const u32x4 a = *(const u32x4*)(oag + (0 * (size_t)NTOK + m) * 1024 + c + 8 * q), bq = *(const u32x4*)(oag + (1 * (size_t)NTOK + m) * 1024 + c + 8 * q), cq = *(const u32x4*)(oag + (2 * (size_t)NTOK + m) * 1024 + c + 8 * q);
                    u32x4 w;
#pragma unroll
                    for (int k = 0; k < 4; ++k) w[k] = cvtpk(e0 * bflo(a[k]) + e1 * bflo(bq[k]) + e2 * bflo(cq[k]), e0 * bfhi(a[k]) + e1 * bfhi(bq[k]) + e2 * bfhi(cq[k]));
                    *(u32x4*)(oa + (size_t)m * 1024 + c + 8 * q) = w; } }
        }
        if (BOTH(2)) GRID_BAR();
    }

    if (IN(3) || IN(4)) {
        EpiMix E; E.ws = ws; E.x = args.in[0];
        MixSched S; S.c = vcu; S.ws = (const char*)ws;
        if (IN(3)) { S.mode = 0; pg8::gemm_phase<EpiMix, MixSched, false, PG8_SP2>(lds, lds + EX_OFF, S, E, wave); if (BOTH(3)) GRID_BAR(); }
        if (IN(4)) { S.mode = 1; pg8::gemm_phase<EpiMix, MixSched, false, PG8_SP2>(lds, lds + EX_OFF, S, E, wave); if (BOTH(4)) GRID_BAR(); }
    }

    if (IN(5)) {
        PHASE_IDS();
        RouteArgs ra; ra.g = args.in[7]; ra.b = args.in[8]; ra.h1 = (float*)(ws + WS_H1); ra.h1b = (bf16_t*)(ws + WS_H1B); ra.wg = args.in[9]; ra.bg = args.in[10]; ra.wr = args.in[11]; ra.br = args.in[12];
        ra.cnt = ctl + CW_CNT; ra.tokidx = (int*)(ws + WS_TOKIDX); ra.slot = (int*)(ws + WS_SLOT); ra.wt = (const float*)(ws + WS_WRT); ra.lnst = (float2*)(ws + WS_LNST);
        LAS unsigned* hist = (LAS unsigned*)lds; LAS unsigned* basev = hist + 32; LAS int* rinfo = (LAS int*)(lds + 256);
        if (tid < 64) hist[tid] = 0u;
        __syncthreads();
        static_assert(NTOK == 4 * 256 * NWAVES, "P5 assumes 4 rows per wave on a 256-workgroup grid");
#pragma unroll 1
        for (int ps = 0; ps < 2; ++ps) ln1_route_rows<2, VAR>((const float*)(ws + WS_PRE1), ra, gw + 2 * ps * NGW, NGW, lane_id(), hist, rinfo, wave * 4 + 2 * ps, 1);
        __syncthreads();
        if (tid < 32) { const unsigned h = hist[tid]; if (h) basev[tid] = atomicAdd(ra.cnt + tid, h); }
        __syncthreads();
        if (tid < 32) { const LAS int* ri = rinfo + tid * 8; const int ex1 = ri[0], ex2 = ri[1], m = ri[6]; const int p1 = (int)basev[ex1] + ri[2], p2 = (int)basev[ex2] + ri[3];
            ra.tokidx[ex1 * ECAP + p1] = m; ra.tokidx[ex2 * ECAP + p2] = m;
            int* sl = ra.slot + (size_t)m * 6; sl[0] = ex1; sl[1] = ex2; sl[2] = p1; sl[3] = p2; sl[4] = ri[4]; sl[5] = ri[5]; }
        if (BOTH(5)) GRID_BAR();
    }

    if (IN(6) || IN(7)) {
        MoeSched2 S; S.var = VAR; S.G = G; S.vcu = vcu; S.ws = (const char*)ws; S.wgate = args.in[13]; S.wup = args.in[14]; S.wdown = args.in[15];
        S.init(ctl + CW_CNT, lane_id());
        EpiMoe2 E; E.ws = ws;
        if (IN(6)) { S.down = 0; E.down = 0; mg::gemm_phase<MoeSched2, EpiMoe2, VAR>(lds, S, E, wave); if (BOTH(6)) GRID_BAR(); }
        if (IN(7)) { S.down = 1; E.down = 1; mg::gemm_phase<MoeSched2, EpiMoe2, VAR>(lds, S, E, wave); if (BOTH(7)) GRID_BAR(); }
    }

    if (IN(8)) {
        PHASE_IDS();
        P8Args pa; pa.h1 = (const float*)(ws + WS_H1); pa.y = (const bf16_t*)(ws + WS_Y); pa.cnt = ctl + CW_CNT; pa.slot = (const int*)(ws + WS_SLOT); pa.g = args.in[16]; pa.b = args.in[17]; pa.out = args.out;
        unsigned c = 0; if (lane < NEXP) c = __hip_atomic_load(ctl + CW_CNT + lane, __ATOMIC_RELAXED, __HIP_MEMORY_SCOPE_AGENT);
        unsigned t = (c + 255u) >> 8, inc = t;
#pragma unroll
        for (int o = 1; o < 32; o <<= 1) { const unsigned v = __shfl_up(inc, o); if ((lane & 31) >= o) inc += v; }
        const unsigned tpe = inc - t;
        for (int m = gw; m < NTOK; m += NGW) {
            const int* sl = pa.slot + (size_t)m * 6; const int e1 = sl[0], e2 = sl[1], p1 = sl[2], p2 = sl[3]; const float w1 = ((const float*)sl)[4], w2 = ((const float*)sl)[5];
            const size_t r1 = (size_t)__shfl(tpe, e1) * 256 + p1, r2 = (size_t)__shfl(tpe, e2) * 256 + p2;
            final_row_t(pa, (const float*)(ws + WS_PRE1), (const float2*)(ws + WS_LNST), args.in[7], args.in[8], m, lane_id(), r1, r2, w1, w2);
        }
    }
#undef IN
#undef BOTH
#undef GRID_BAR
}

extern "C" void kernel_launch(void* const* d_in, const int* in_sizes, int n_in, void* d_out, int out_size, void* d_ws, size_t ws_size, hipStream_t stream) {
    static int grid = 0;
    if (grid == 0) {
        if (n_in != 18 || in_sizes[0] != NTOK * DM || out_size != NTOK * DM || ws_size < WS_END) { fprintf(stderr, "kernel_launch: unexpected shapes (n_in %d, in0 %d, out %d, ws %zu)\n", n_in, n_in > 0 ? in_sizes[0] : -1, out_size, ws_size); grid = -1; return; }
        int dev = 0, cus = 0, per_cu = 0;
        if (hipGetDevice(&dev) != hipSuccess || hipDeviceGetAttribute(&cus, hipDeviceAttributeMultiprocessorCount, dev) != hipSuccess) { fprintf(stderr, "kernel_launch: device query failed\n"); grid = -1; return; }
        if (hipFuncSetAttribute((const void*)mk_fwd<0>, hipFuncAttributeMaxDynamicSharedMemorySize, LDS_BYTES) != hipSuccess || hipFuncSetAttribute((const void*)mk_fwd<MK_EXTRA_VAR>, hipFuncAttributeMaxDynamicSharedMemorySize, LDS_BYTES) != hipSuccess) { fprintf(stderr, "kernel_launch: hipFuncSetAttribute failed\n"); grid = -1; return; }
        if (hipOccupancyMaxActiveBlocksPerMultiprocessor(&per_cu, (const void*)mk_fwd<0>, NWAVES * 64, LDS_BYTES) != hipSuccess || per_cu < 1) { fprintf(stderr, "kernel_launch: occupancy query says %d blocks per CU\n", per_cu); per_cu = 1; }
        (void)hipGetLastError();
        grid = cus * 1;
        fprintf(stderr, "kernel_launch: grid %d (cus %d, occupancy %d)\n", grid, cus, per_cu);
    }
    if (grid < 0) return;
    unsigned char* ws = (unsigned char*)d_ws;
    (void)hipMemsetAsync(ws + WS_CTL, 0, 1 * MiB, stream);
    Args a{};
    for (int i = 0; i < 18; ++i) a.in[i] = (const float*)d_in[i];
    a.out = (float*)d_out; a.ws = ws;
    const float* x = a.in[0];
    bf16_t* XB = (bf16_t*)(ws + WS_XB); bf16_t* WINT = (bf16_t*)(ws + WS_WINT); bf16_t* WAT = (bf16_t*)(ws + WS_WAT); bf16_t* WBT = (bf16_t*)(ws + WS_WBT); bf16_t* WOT = (bf16_t*)(ws + WS_WOT);
    bf16_t* WGUT = (bf16_t*)(ws + WS_WGUT); bf16_t* WDT = (bf16_t*)(ws + WS_WDT);
    unsigned* ctl = (unsigned*)(ws + WS_CTL);
    auto launch_mk = [&](int lo, int hi, int use_bar, bool extra = false) {
        a.ph_lo = lo; a.ph_hi = hi; a.use_bar = use_bar;
        void* kargs[] = {&a};
        hipError_t e = hipLaunchCooperativeKernel(extra ? (const void*)mk_fwd<MK_EXTRA_VAR> : (const void*)mk_fwd<0>, dim3(grid), dim3(NWAVES * 64), kargs, LDS_BYTES, stream);
        if (e != hipSuccess) fprintf(stderr, "kernel_launch: cooperative launch failed: %s (grid %d)\n", hipGetErrorString(e), grid);
    };
    if (MK_ONE_LAUNCH && MK_FAST_MASK == 0x1ff) { launch_mk(0, NPHASE, 1);
        if (MK_EXTRA_PHASE >= 0) { a.bar_region = 1; launch_mk(MK_EXTRA_PHASE, MK_EXTRA_PHASE + 1, 1, true); }
        return; }
    for (int ph = 0; ph < NPHASE; ++ph) {
        if ((MK_FAST_MASK >> ph) & 1) { launch_mk(ph, ph + 1, (ph == 2) ? 1 : 0); continue; }
        switch (ph) {
        case 0:
            hipLaunchKernelGGL(k_cvt, dim3(2048), dim3(256), 0, stream, x, XB, (size_t)NTOK * DM / 8);
            hipLaunchKernelGGL(k_transpose, dim3(IN_COLS / 32, DM / 32, 1), dim3(256), 0, stream, a.in[1], WINT, DM, IN_COLS, 128, 0, (size_t)0, (size_t)0);
            hipLaunchKernelGGL(k_transpose, dim3(DM / 32, 1024 / 32, 1), dim3(256), 0, stream, a.in[4], WAT, 1024, DM, 128, 0, (size_t)0, (size_t)0);
            hipLaunchKernelGGL(k_transpose, dim3(DM / 32, DM / 32, 1), dim3(256), 0, stream, a.in[5], WBT, DM, DM, 128, 0, (size_t)0, (size_t)0);
            hipLaunchKernelGGL(k_transpose, dim3(DM / 32, DM / 32, 1), dim3(256), 0, stream, a.in[6], WOT, DM, DM, 128, 0, (size_t)0, (size_t)0);
            hipLaunchKernelGGL(k_transpose, dim3(FF / 32, DM / 32, NEXP), dim3(256), 0, stream, a.in[13], WGUT, DM, FF, 256, 0, (size_t)DM * FF, (size_t)2048 * DM);
            hipLaunchKernelGGL(k_transpose, dim3(FF / 32, DM / 32, NEXP), dim3(256), 0, stream, a.in[14], WGUT, DM, FF, 256, 128, (size_t)DM * FF, (size_t)2048 * DM);
            hipLaunchKernelGGL(k_transpose, dim3(DM / 32, FF / 32, NEXP), dim3(256), 0, stream, a.in[15], WDT, FF, DM, 128, 0, (size_t)FF * DM, (size_t)DM * FF);
            hipLaunchKernelGGL(k_ropetab, dim3(SEQ * 64 / 256), dim3(256), 0, stream, (float2*)(ws + WS_RT1), (float2*)(ws + WS_RT2));
            break;
        case 1: { P1Args p1{}; p1.xb = XB; p1.wint = WINT; p1.qg = a.in[2]; p1.kg = a.in[3]; p1.qa = (bf16_t*)(ws + WS_QA); p1.ka = (bf16_t*)(ws + WS_KA); p1.va = (bf16_t*)(ws + WS_VA);
            p1.qb = (bf16_t*)(ws + WS_QB); p1.kb = (bf16_t*)(ws + WS_KB); p1.vb = (bf16_t*)(ws + WS_VB); p1.gates = (bf16_t*)(ws + WS_GATES);
            hipLaunchKernelGGL(k_proj, dim3(IN_COLS / 128, NTOK / 64), dim3(256), 0, stream, p1); } break;
        case 2: { P2Args p2b{}; p2b.q = (bf16_t*)(ws + WS_QB); p2b.k = (bf16_t*)(ws + WS_KB); p2b.v = (bf16_t*)(ws + WS_VB); p2b.o = (bf16_t*)(ws + WS_OB); p2b.lse = nullptr; p2b.mode = 0;
            hipLaunchKernelGGL(k_attn, dim3(SEQ / 64, 32), dim3(128), 0, stream, p2b);
            P2Args p2a{}; p2a.q = (bf16_t*)(ws + WS_QA); p2a.k = (bf16_t*)(ws + WS_KA); p2a.v = (bf16_t*)(ws + WS_VA); p2a.o = (bf16_t*)(ws + WS_OAG); p2a.lse = (float*)(ws + WS_LSE); p2a.mode = 1;
            hipLaunchKernelGGL(k_attn, dim3(SEQ / 64, 48), dim3(128), 0, stream, p2a);
            hipLaunchKernelGGL(k_merge, dim3(NTOK * 1024 / 256), dim3(256), 0, stream, (const bf16_t*)(ws + WS_OAG), (const float*)(ws + WS_LSE), (bf16_t*)(ws + WS_OA)); } break;
        case 3: case 4: { P3Args p3{}; p3.gates = (bf16_t*)(ws + WS_GATES); p3.T = (float*)(ws + WS_T); p3.merged = (bf16_t*)(ws + WS_MERGED); p3.x = x; p3.pre1 = (float*)(ws + WS_PRE1);
            if (ph == 3) { p3.A = (bf16_t*)(ws + WS_OA); p3.Bt = WAT; p3.K = 1024; p3.mode = 0;
                hipLaunchKernelGGL(k_gemm3, dim3(DM / 128, NTOK / 64), dim3(256), 0, stream, p3);
                p3.A = (bf16_t*)(ws + WS_OB); p3.Bt = WBT; p3.K = 2048; p3.mode = 1;
                hipLaunchKernelGGL(k_gemm3, dim3(DM / 128, NTOK / 64), dim3(256), 0, stream, p3); }
            else { p3.A = p3.merged; p3.Bt = WOT; p3.K = 2048; p3.mode = 2; hipLaunchKernelGGL(k_gemm3, dim3(DM / 128, NTOK / 64), dim3(256), 0, stream, p3); } } break;
        case 5: { RouteArgs ra{}; ra.g = a.in[7]; ra.b = a.in[8]; ra.h1 = (float*)(ws + WS_H1); ra.h1b = (bf16_t*)(ws + WS_H1B); ra.wg = a.in[9]; ra.bg = a.in[10]; ra.wr = a.in[11]; ra.br = a.in[12];
            ra.cnt = ctl + CW_CNT; ra.tokidx = (int*)(ws + WS_TOKIDX); ra.slot = (int*)(ws + WS_SLOT);
            hipLaunchKernelGGL(k_ln1_route, dim3(NTOK / 4), dim3(256), 0, stream, (const float*)(ws + WS_PRE1), ra); } break;
        case 6: case 7: { P6Args p6{}; p6.h1b = (bf16_t*)(ws + WS_H1B); p6.wgut = WGUT; p6.wdt = WDT; p6.cnt = ctl + CW_CNT; p6.tokidx = (int*)(ws + WS_TOKIDX); p6.act = (bf16_t*)(ws + WS_ACT); p6.y = (bf16_t*)(ws + WS_Y);
            if (ph == 6) hipLaunchKernelGGL(k_moe_up, dim3(FF / 128, 24576 / 64), dim3(256), 0, stream, p6);
            else hipLaunchKernelGGL(k_moe_down, dim3(DM / 128, 24576 / 64), dim3(256), 0, stream, p6); } break;
        case 8: { P8Args p8{}; p8.h1 = (float*)(ws + WS_H1); p8.y = (bf16_t*)(ws + WS_Y); p8.cnt = ctl + CW_CNT; p8.slot = (int*)(ws + WS_SLOT); p8.g = a.in[16]; p8.b = a.in[17]; p8.out = (float*)d_out;
            hipLaunchKernelGGL(k_final, dim3(NTOK / 4), dim3(256), 0, stream, p8); } break;
        }
    }
}
```

```cpp
#include <hip/hip_runtime.h>
#include <hip/hip_cooperative_groups.h>
#include <cstdio>
#include <cstdint>

typedef unsigned short bf16_t;
typedef short bf16x8 __attribute__((ext_vector_type(8)));
typedef short s16x4 __attribute__((ext_vector_type(4)));
typedef float f32x4 __attribute__((ext_vector_type(4)));
typedef float f32x16 __attribute__((ext_vector_type(16)));
typedef unsigned u32x4 __attribute__((ext_vector_type(4)));
typedef unsigned u32x2 __attribute__((ext_vector_type(2)));
#define LAS __attribute__((address_space(3)))

#ifndef MK_FAST_MASK
#define MK_FAST_MASK 0x1ff
#endif
#ifndef MK_ONE_LAUNCH
#define MK_ONE_LAUNCH 1
#endif
#ifndef MK_EXTRA_PHASE
#define MK_EXTRA_PHASE -1
#endif
#ifndef MK_EXTRA_VAR
#define MK_EXTRA_VAR 0
#endif
#ifndef PG8_SP2
#define PG8_SP2 true
#endif
#ifndef PG8_ALIGN
#define PG8_ALIGN true
#endif

constexpr int NTOK = 8192, SEQ = 4096, DM = 2048, HD = 128;
constexpr int IN_COLS = 16384;
constexpr int NEXP = 32, FF = 1024;
constexpr float ALPHA = 1.189207115002721f;
constexpr float LN_EPS = 1e-5f, RMS_EPS = 1e-6f;
constexpr float SM_SCALE = 0.08838834764831845f;
constexpr int ECAP = 8192;
constexpr int NPHASE = 9;

constexpr size_t MiB = 1u << 20;
constexpr size_t WS_CTL = 0;
constexpr size_t WS_WGUT = 1 * MiB;
constexpr size_t WS_WDT = 257 * MiB;
constexpr size_t WS_WAT = 385 * MiB;
constexpr size_t WS_WBT = 389 * MiB;
constexpr size_t WS_WOT = 397 * MiB;
constexpr size_t WS_XB = 405 * MiB;
constexpr size_t WS_WINT = 437 * MiB;
constexpr size_t WS_QA = 501 * MiB;
constexpr size_t WS_KA = 549 * MiB;
constexpr size_t WS_VA = 597 * MiB;
constexpr size_t WS_QB = 645 * MiB;
constexpr size_t WS_KB = 677 * MiB;
constexpr size_t WS_VB = 685 * MiB;
constexpr size_t WS_GATES = 693 * MiB;
constexpr size_t WS_OAG = 757 * MiB;
constexpr size_t WS_LSE = 805 * MiB;
constexpr size_t WS_OA = 806 * MiB;
constexpr size_t WS_OB = 822 * MiB;
constexpr size_t WS_T = 405 * MiB;
constexpr size_t WS_MERGED = 469 * MiB;
constexpr size_t WS_PRE1 = 501 * MiB;
constexpr size_t WS_H1 = 565 * MiB;
constexpr size_t WS_H1B = 629 * MiB;
constexpr size_t WS_TOKIDX = 661 * MiB;
constexpr size_t WS_LNST = 663 * MiB;
constexpr size_t WS_SLOT = 662 * MiB;
constexpr size_t WS_ACT = 693 * MiB;
constexpr size_t WS_Y = 757 * MiB;
constexpr size_t WS_RT1 = 854 * MiB;
constexpr size_t WS_RT2 = 856 * MiB;
constexpr size_t WS_WRT = 858 * MiB;
constexpr size_t WS_END = 859 * MiB;
constexpr int CW_CNT = 64;
constexpr int CW_BAR = 4096;
constexpr int CW_WGST = 65536;

__device__ __forceinline__ float bf2f(bf16_t v) { return __uint_as_float(((unsigned)v) << 16); }
__device__ __forceinline__ bf16_t f2bf(float f) { unsigned u = __float_as_uint(f); u += 0x7fffu + ((u >> 16) & 1u); return (bf16_t)(u >> 16); }
__device__ __forceinline__ unsigned pk2(float lo, float hi) { return (unsigned)f2bf(lo) | ((unsigned)f2bf(hi) << 16); }
__device__ __forceinline__ unsigned cvtpk(float lo, float hi) { unsigned r; asm volatile("v_cvt_pk_bf16_f32 %0, %1, %2" : "=v"(r) : "v"(lo), "v"(hi)); return r; }
__device__ __forceinline__ float wave_sum(float v) {
#pragma unroll
    for (int o = 1; o < 64; o <<= 1) v += __shfl_xor(v, o);
    return v;
}
__device__ __forceinline__ int lane_id() { int l; asm volatile("v_mbcnt_lo_u32_b32 %0, -1, 0\n\tv_mbcnt_hi_u32_b32 %0, -1, %0" : "=v"(l)); return l; }
__device__ __forceinline__ float bflo(unsigned w) { return __uint_as_float(w << 16); }
__device__ __forceinline__ float bfhi(unsigned w) { return __uint_as_float(w & 0xffff0000u); }

__device__ const float INV64[64] = {
    1.000000000e+00f, 8.659643234e-01f, 7.498942093e-01f, 6.493816316e-01f, 5.623413252e-01f, 4.869675252e-01f, 4.216965034e-01f, 3.651741273e-01f,
    3.162277660e-01f, 2.738419634e-01f, 2.371373706e-01f, 2.053525026e-01f, 1.778279410e-01f, 1.539926526e-01f, 1.333521432e-01f, 1.154781985e-01f,
    1.000000000e-01f, 8.659643234e-02f, 7.498942093e-02f, 6.493816316e-02f, 5.623413252e-02f, 4.869675252e-02f, 4.216965034e-02f, 3.651741273e-02f,
    3.162277660e-02f, 2.738419634e-02f, 2.371373706e-02f, 2.053525026e-02f, 1.778279410e-02f, 1.539926526e-02f, 1.333521432e-02f, 1.154781985e-02f,
    1.000000000e-02f, 8.659643234e-03f, 7.498942093e-03f, 6.493816316e-03f, 5.623413252e-03f, 4.869675252e-03f, 4.216965034e-03f, 3.651741273e-03f,
    3.162277660e-03f, 2.738419634e-03f, 2.371373706e-03f, 2.053525026e-03f, 1.778279410e-03f, 1.539926526e-03f, 1.333521432e-03f, 1.154781985e-03f,
    1.000000000e-03f, 8.659643234e-04f, 7.498942093e-04f, 6.493816316e-04f, 5.623413252e-04f, 4.869675252e-04f, 4.216965034e-04f, 3.651741273e-04f,
    3.162277660e-04f, 2.738419634e-04f, 2.371373706e-04f, 2.053525026e-04f, 1.778279410e-04f, 1.539926526e-04f, 1.333521432e-04f, 1.154781985e-04f};

__device__ __forceinline__ void cs_angle(float ang, float& c, float& s) {
    const double a = (double)ang * 0.15915494309189535;
    const float f = (float)(a - floor(a));
    s = __builtin_amdgcn_sinf(f); c = __builtin_amdgcn_cosf(f);
}
__device__ __forceinline__ void rope1(int t, int i, float& c, float& s) { cs_angle((float)t * INV64[i], c, s); }
__device__ __forceinline__ void rope2(int t, int i, float& c, float& s) {
    const float p = (i < 32) ? (float)(t >> 6) : (float)(t & 63);
    cs_angle(p * INV64[2 * (i & 31)], c, s);
}
__device__ __forceinline__ int perm_pos(int g, int t) { const int sh = 2 * g; const int d = 1 << sh; return (t & (d - 1)) * (SEQ >> sh) + (t >> sh); }

__global__ void __launch_bounds__(256) k_cvt(const float* __restrict__ x, bf16_t* __restrict__ xb, size_t n8) {
    for (size_t i = (size_t)blockIdx.x * 256 + threadIdx.x; i < n8; i += (size_t)gridDim.x * 256) {
        const f32x4 a = *(const f32x4*)(x + i * 8), b = *(const f32x4*)(x + i * 8 + 4);
        u32x4 w; w.x = pk2(a.x, a.y); w.y = pk2(a.z, a.w); w.z = pk2(b.x, b.y); w.w = pk2(b.z, b.w);
        *(u32x4*)(xb + i * 8) = w;
    }
}
__global__ void __launch_bounds__(256) k_transpose(const float* __restrict__ src, bf16_t* __restrict__ dst, int K, int N, int rowblk, int roff, size_t sstride, size_t dstride) {
    __shared__ float tile[32][33];
    const float* s = src + (size_t)blockIdx.z * sstride; bf16_t* d = dst + (size_t)blockIdx.z * dstride;
    const int n0 = blockIdx.x * 32, k0 = blockIdx.y * 32, tx = threadIdx.x & 31, ty = threadIdx.x >> 5;
    for (int i = ty; i < 32; i += 8) tile[i][tx] = s[(size_t)(k0 + i) * N + n0 + tx];
    __syncthreads();
    for (int i = ty; i < 32; i += 8) { const int n = n0 + i; const int dr = (n >> 7) * rowblk + roff + (n & 127); d[(size_t)dr * K + k0 + tx] = f2bf(tile[tx][i]); }
}
__global__ void __launch_bounds__(256) k_ropetab(float2* rt1, float2* rt2) {
    const int i = blockIdx.x * 256 + threadIdx.x; const int t = i >> 6, c = i & 63; float cs, sn;
    rope1(t, c, cs, sn); rt1[i] = make_float2(cs, sn); rope2(t, c, cs, sn); rt2[i] = make_float2(cs, sn);
}
__device__ __forceinline__ void wave_gemm16x128(const bf16_t* arow, const bf16_t* bt, int ldb, int K, f32x4 (&acc)[8]) {
    const int lane = threadIdx.x & 63, fr = lane & 15, fq = lane >> 4;
    const bf16_t* ap = arow + fq * 8;
    const bf16_t* bp = bt + (size_t)fr * ldb + fq * 8;
    for (int k = 0; k < K; k += 32) {
        const bf16x8 a = *(const bf16x8*)(ap + k);
#pragma unroll
        for (int j = 0; j < 8; ++j) { const bf16x8 b = *(const bf16x8*)(bp + (size_t)j * 16 * ldb + k); acc[j] = __builtin_amdgcn_mfma_f32_16x16x32_bf16(a, b, acc[j], 0, 0, 0); }
    }
}
struct P1Args { const bf16_t* xb; const bf16_t* wint; const float* qg; const float* kg; bf16_t *qa, *ka, *va, *qb, *kb, *vb, *gates; };
__global__ void __launch_bounds__(256) k_proj(P1Args a) {
    const int wave = threadIdx.x >> 6, lane = threadIdx.x & 63, fr = lane & 15, fq = lane >> 4;
    const int ng = blockIdx.x, mt = blockIdx.y * 4 + wave;
    f32x4 acc[8];
#pragma unroll
    for (int j = 0; j < 8; ++j) acc[j] = (f32x4){0.f, 0.f, 0.f, 0.f};
    wave_gemm16x128(a.xb + (size_t)(mt * 16 + fr) * DM, a.wint + (size_t)ng * 128 * DM, DM, DM, acc);
#pragma unroll
    for (int r = 0; r < 4; ++r) {
        const int m = mt * 16 + fq * 4 + r, b = m >> 12, t = m & 4095;
        if (ng < 72) {
            const int which = ng / 24, hh = ng % 24, g = hh >> 3, h = hh & 7;
            bf16_t* base = (which == 0 ? a.qa : (which == 1 ? a.ka : a.va)) + ((size_t)((g * 2 + b) * 8 + h) * SEQ + perm_pos(g, t)) * HD;
#pragma unroll
            for (int j = 0; j < 4; ++j) { const int c = 16 * j + fr; float x1 = acc[j][r], x2 = acc[j + 4][r];
                if (which < 2) { float cs, sn; rope1(t, c, cs, sn); const float y1 = x1 * cs - x2 * sn, y2 = x2 * cs + x1 * sn; x1 = y1; x2 = y2; }
                base[c] = f2bf(x1); base[c + 64] = f2bf(x2); }
        } else if (ng < 96) {
            const int k = ng - 72;
            if (k < 20) {
                float ss = 0.f;
#pragma unroll
                for (int j = 0; j < 8; ++j) ss += acc[j][r] * acc[j][r];
                ss += __shfl_xor(ss, 1); ss += __shfl_xor(ss, 2); ss += __shfl_xor(ss, 4); ss += __shfl_xor(ss, 8);
                const float rinv = 1.0f / sqrtf(ss * (1.0f / 128.0f) + RMS_EPS);
                const float* gn = (k < 16) ? a.qg : a.kg;
                bf16_t* base = (k < 16) ? a.qb + ((size_t)(b * 16 + k) * SEQ + t) * HD : a.kb + ((size_t)(b * 4 + (k - 16)) * SEQ + t) * HD;
#pragma unroll
                for (int j = 0; j < 4; ++j) { const int c = 16 * j + fr; const float x1 = acc[j][r] * rinv * gn[c], x2 = acc[j + 4][r] * rinv * gn[c + 64];
                    float cs, sn; rope2(t, c, cs, sn); base[c] = f2bf(x1 * cs - x2 * sn); base[c + 64] = f2bf(x2 * cs + x1 * sn); }
            } else {
                bf16_t* base = a.vb + ((size_t)(b * 4 + (k - 20)) * SEQ + t) * HD;
#pragma unroll
                for (int j = 0; j < 8; ++j) base[16 * j + fr] = f2bf(acc[j][r]);
            }
        } else {
            bf16_t* base = a.gates + (size_t)m * 4096 + (ng - 96) * 128;
#pragma unroll
            for (int j = 0; j < 8; ++j) base[16 * j + fr] = f2bf(1.0f / (1.0f + __expf(-acc[j][r])));
        }
    }
}
struct P2Args { const bf16_t *q, *k, *v; bf16_t* o; float* lse; int mode; };
__global__ void __launch_bounds__(128) k_attn(P2Args a) {
    const int half = threadIdx.x & 1, qi = blockIdx.x * 64 + (threadIdx.x >> 1), sid = blockIdx.y;
    const bf16_t *Q, *K, *V; int k_lo, k_hi;
    if (a.mode == 0) { const int b = sid >> 4, hq = sid & 15; Q = a.q + (size_t)sid * SEQ * HD; K = a.k + (size_t)(b * 4 + (hq >> 2)) * SEQ * HD; V = a.v + (size_t)(b * 4 + (hq >> 2)) * SEQ * HD; k_lo = 0; k_hi = SEQ - 1; }
    else { const int g = sid >> 4; const int L = SEQ >> (2 * g); Q = a.q + (size_t)sid * SEQ * HD; K = a.k + (size_t)sid * SEQ * HD; V = a.v + (size_t)sid * SEQ * HD;
        const int r0 = (qi / L) * L, p = qi - r0; k_lo = r0 + (p - 64 > 0 ? p - 64 : 0); k_hi = r0 + (p + 64 < L - 1 ? p + 64 : L - 1); }
    float q[64], o[64];
    { const bf16_t* qp = Q + (size_t)qi * HD + half * 64;
#pragma unroll
      for (int d = 0; d < 64; ++d) { q[d] = bf2f(qp[d]) * SM_SCALE; o[d] = 0.f; } }
    float m = -1e30f, l = 0.f;
    for (int kk = k_lo; kk <= k_hi; ++kk) {
        const bf16_t* kp = K + (size_t)kk * HD + half * 64; const bf16_t* vp = V + (size_t)kk * HD + half * 64;
        float s = 0.f;
#pragma unroll
        for (int d = 0; d < 64; ++d) s += q[d] * bf2f(kp[d]);
        s += __shfl_xor(s, 1);
        const float mn = fmaxf(m, s), al = __expf(m - mn), p = __expf(s - mn);
        l = l * al + p; m = mn;
#pragma unroll
        for (int d = 0; d < 64; ++d) o[d] = o[d] * al + p * bf2f(vp[d]);
    }
    const float rl = 1.0f / l;
    if (a.mode == 0) { const int b = sid >> 4, hq = sid & 15; bf16_t* op = a.o + (size_t)(b * SEQ + qi) * 2048 + hq * HD + half * 64;
#pragma unroll
        for (int d = 0; d < 64; ++d) op[d] = f2bf(o[d] * rl); }
    else { const int g = sid >> 4, b = (sid >> 3) & 1, h = sid & 7; const int sh = 2 * g, L = SEQ >> sh; const int r = qi / L, p = qi - r * L, t = (p << sh) + r;
        const size_t mrow = (size_t)b * SEQ + t;
        bf16_t* op = a.o + ((size_t)g * NTOK + mrow) * 1024 + h * HD + half * 64;
#pragma unroll
        for (int d = 0; d < 64; ++d) op[d] = f2bf(o[d] * rl);
        if (half == 0) a.lse[((size_t)g * NTOK + mrow) * 8 + h] = m + __logf(l); }
}
__global__ void __launch_bounds__(256) k_merge(const bf16_t* __restrict__ oag, const float* __restrict__ lse, bf16_t* __restrict__ oa) {
    const size_t i = (size_t)blockIdx.x * 256 + threadIdx.x;
    const size_t m = i >> 10; const int c = (int)(i & 1023), h = c >> 7;
    const float l0 = lse[(0 * (size_t)NTOK + m) * 8 + h], l1 = lse[(1 * (size_t)NTOK + m) * 8 + h], l2 = lse[(2 * (size_t)NTOK + m) * 8 + h];
    const float mx = fmaxf(l0, fmaxf(l1, l2)); const float e0 = __expf(l0 - mx), e1 = __expf(l1 - mx), e2 = __expf(l2 - mx); const float inv = 1.0f / (e0 + e1 + e2);
    const float v = (e0 * bf2f(oag[(0 * (size_t)NTOK + m) * 1024 + c]) + e1 * bf2f(oag[(1 * (size_t)NTOK + m) * 1024 + c]) + e2 * bf2f(oag[(2 * (size_t)NTOK + m) * 1024 + c])) * inv;
    oa[i] = f2bf(v);
}
struct P3Args { const bf16_t* A; const bf16_t* Bt; int K; const bf16_t* gates; float* T; bf16_t* merged; const float* x; float* pre1; int mode; };
__global__ void __launch_bounds__(256) k_gemm3(P3Args a) {
    const int wave = threadIdx.x >> 6, lane = threadIdx.x & 63, fr = lane & 15, fq = lane >> 4;
    const int ng = blockIdx.x, mt = blockIdx.y * 4 + wave;
    f32x4 acc[8];
#pragma unroll
    for (int j = 0; j < 8; ++j) acc[j] = (f32x4){0.f, 0.f, 0.f, 0.f};
    wave_gemm16x128(a.A + (size_t)(mt * 16 + fr) * a.K, a.Bt + (size_t)ng * 128 * a.K, a.K, a.K, acc);
#pragma unroll
    for (int r = 0; r < 4; ++r) { const size_t m = (size_t)mt * 16 + fq * 4 + r;
#pragma unroll
        for (int j = 0; j < 8; ++j) { const int c = ng * 128 + 16 * j + fr; const size_t o = m * DM + c;
            if (a.mode == 0) a.T[o] = bf2f(a.gates[m * 4096 + c]) * acc[j][r];
            else if (a.mode == 1) a.merged[o] = f2bf(a.T[o] + bf2f(a.gates[m * 4096 + 2048 + c]) * acc[j][r]);
            else a.pre1[o] = ALPHA * a.x[o] + acc[j][r]; } }
}
struct RouteArgs { const float* g; const float* b; float* h1; bf16_t* h1b; const float* wg; const float* bg; const float* wr; const float* br; unsigned* cnt; int* tokidx; int* slot; const float* wt; float2* lnst; };
__device__ __forceinline__ void ln1_route_row(const float* pre1, const RouteArgs& a, int m, int lane) {
    const f32x4* xr = (const f32x4*)(pre1 + (size_t)m * DM) + lane;
    f32x4 v[8]; float s = 0.f;
#pragma unroll
    for (int j = 0; j < 8; ++j) { v[j] = xr[64 * j]; s += (v[j].x + v[j].y) + (v[j].z + v[j].w); }
    const float mean = wave_sum(s) * (1.0f / DM); float s2 = 0.f;
#pragma unroll
    for (int j = 0; j < 8; ++j) { v[j] = v[j] - mean; s2 += (v[j].x * v[j].x + v[j].y * v[j].y) + (v[j].z * v[j].z + v[j].w * v[j].w); }
    const float rstd = 1.0f / sqrtf(wave_sum(s2) * (1.0f / DM) + LN_EPS);
    float gl[4] = {0.f, 0.f, 0.f, 0.f};
#pragma unroll
    for (int j = 0; j < 8; ++j) { const int c = 4 * lane + 256 * j; const f32x4 gg = *(const f32x4*)(a.g + c), bb = *(const f32x4*)(a.b + c);
        v[j] = v[j] * rstd * gg + bb;
        *(f32x4*)(a.h1 + (size_t)m * DM + c) = v[j];
        *(uint2*)(a.h1b + (size_t)m * DM + c) = make_uint2(pk2(v[j].x, v[j].y), pk2(v[j].z, v[j].w));
#pragma unroll
        for (int i = 0; i < 4; ++i) { const f32x4 w = *(const f32x4*)(a.wg + (size_t)(c + i) * 4); const float hv = v[j][i]; gl[0] += hv * w.x; gl[1] += hv * w.y; gl[2] += hv * w.z; gl[3] += hv * w.w; } }
#pragma unroll
    for (int i = 0; i < 4; ++i) gl[i] = wave_sum(gl[i]) + a.bg[i];
    int gi = 0; float gm = gl[0];
#pragma unroll
    for (int i = 1; i < 4; ++i) if (gl[i] > gm) { gm = gl[i]; gi = i; }
    float gs = 0.f;
#pragma unroll
    for (int i = 0; i < 4; ++i) gs += __expf(gl[i] - gm);
    const float ggate = 1.0f / gs;
    float el[8] = {0.f, 0.f, 0.f, 0.f, 0.f, 0.f, 0.f, 0.f};
#pragma unroll
    for (int j = 0; j < 8; ++j) { const int c = 4 * lane + 256 * j;
#pragma unroll
        for (int i = 0; i < 4; ++i) { const float* wp = a.wr + (size_t)(c + i) * 32 + gi * 8; const f32x4 w0 = *(const f32x4*)wp, w1 = *(const f32x4*)(wp + 4); const float hv = v[j][i];
            el[0] += hv * w0.x; el[1] += hv * w0.y; el[2] += hv * w0.z; el[3] += hv * w0.w; el[4] += hv * w1.x; el[5] += hv * w1.y; el[6] += hv * w1.z; el[7] += hv * w1.w; } }
#pragma unroll
    for (int i = 0; i < 8; ++i) el[i] = wave_sum(el[i]) + a.br[gi * 8 + i];
    int i1 = 0; float m1 = el[0];
#pragma unroll
    for (int i = 1; i < 8; ++i) if (el[i] > m1) { m1 = el[i]; i1 = i; }
    int i2 = -1; float m2 = -3.0e38f;
#pragma unroll
    for (int i = 0; i < 8; ++i) if (i != i1 && el[i] > m2) { m2 = el[i]; i2 = i; }
    const float e2 = __expf(m2 - m1); const float w1 = ggate / (1.0f + e2), w2 = ggate * e2 / (1.0f + e2);
    if (lane == 0) {
        const int ex1 = gi * 8 + i1, ex2 = gi * 8 + i2;
        const int p1 = (int)atomicAdd(a.cnt + ex1, 1u), p2 = (int)atomicAdd(a.cnt + ex2, 1u);
        a.tokidx[ex1 * ECAP + p1] = m; a.tokidx[ex2 * ECAP + p2] = m;
        int* sl = a.slot + (size_t)m * 6; sl[0] = ex1; sl[1] = ex2; sl[2] = p1; sl[3] = p2; ((float*)sl)[4] = w1; ((float*)sl)[5] = w2;
    }
}
template <int R, int VAR>
__device__ __forceinline__ void ln1_route_rows(const float* pre1, const RouteArgs& a, int m0, int ms, int lane, LAS unsigned* hist, LAS int* rinfo, int lr0, int lrs) {
    f32x4 v[R][8]; float s[R], s2[R];
#pragma unroll
    for (int i = 0; i < R; ++i) { const f32x4* xr = (const f32x4*)(pre1 + (size_t)(m0 + i * ms) * DM) + lane; s[i] = 0.f;
#pragma unroll
        for (int j = 0; j < 8; ++j) { v[i][j] = xr[64 * j]; s[i] += (v[i][j].x + v[i][j].y) + (v[i][j].z + v[i][j].w); } }
#pragma unroll
    for (int o = 1; o < 64; o <<= 1)
#pragma unroll
        for (int i = 0; i < R; ++i) s[i] += __shfl_xor(s[i], o);
#pragma unroll
    for (int i = 0; i < R; ++i) { const float mean = s[i] * (1.0f / DM); s2[i] = 0.f;
#pragma unroll
        for (int j = 0; j < 8; ++j) { v[i][j] = v[i][j] - mean; s2[i] += (v[i][j].x * v[i][j].x + v[i][j].y * v[i][j].y) + (v[i][j].z * v[i][j].z + v[i][j].w * v[i][j].w); } }
#pragma unroll
    for (int o = 1; o < 64; o <<= 1)
#pragma unroll
        for (int i = 0; i < R; ++i) s2[i] += __shfl_xor(s2[i], o);
#pragma unroll
    for (int j = 0; j < 8; ++j) { const int c = 4 * lane + 256 * j; const f32x4 gg = *(const f32x4*)(a.g + c), bb = *(const f32x4*)(a.b + c);
#pragma unroll
        for (int i = 0; i < R; ++i) { const float rstd = 1.0f / sqrtf(s2[i] * (1.0f / DM) + LN_EPS); const size_t o = (size_t)(m0 + i * ms) * DM + c;
            v[i][j] = v[i][j] * rstd * gg + bb;
            if (j == 0 && lane == 0) a.lnst[m0 + i * ms] = make_float2(s[i] * (1.0f / DM), rstd);
            *(uint2*)(a.h1b + o) = make_uint2(pk2(v[i][j].x, v[i][j].y), pk2(v[i][j].z, v[i][j].w)); } }
    if constexpr (VAR == 51) return;
    float gl[R][4];
#pragma unroll
    for (int c = 0; c < 4; ++c) { const f32x4* wp = (const f32x4*)(a.wt + (size_t)c * DM) + lane;
#pragma unroll
        for (int i = 0; i < R; ++i) gl[i][c] = 0.f;
#pragma unroll
        for (int j = 0; j < 8; ++j) { const f32x4 w = wp[64 * j];
#pragma unroll
            for (int i = 0; i < R; ++i) gl[i][c] += (v[i][j].x * w.x + v[i][j].y * w.y) + (v[i][j].z * w.z + v[i][j].w * w.w); }
        if (c & 1) __builtin_amdgcn_sched_barrier(0); }
#pragma unroll
    for (int o = 1; o < 64; o <<= 1)
#pragma unroll
        for (int i = 0; i < R; ++i)
#pragma unroll
            for (int c = 0; c < 4; ++c) gl[i][c] += __shfl_xor(gl[i][c], o);
    int gi[R]; float ggate[R];
#pragma unroll
    for (int i = 0; i < R; ++i) { float g0 = gl[i][0] + a.bg[0], g1 = gl[i][1] + a.bg[1], g2 = gl[i][2] + a.bg[2], g3 = gl[i][3] + a.bg[3];
        int q = 0; float gm = g0; if (g1 > gm) { gm = g1; q = 1; } if (g2 > gm) { gm = g2; q = 2; } if (g3 > gm) { gm = g3; q = 3; }
        ggate[i] = 1.0f / (__expf(g0 - gm) + __expf(g1 - gm) + __expf(g2 - gm) + __expf(g3 - gm)); gi[i] = __builtin_amdgcn_readfirstlane(q); }
    float el[R][8];
#pragma unroll
    for (int c = 0; c < 8; ++c) {
#pragma unroll
        for (int i = 0; i < R; ++i) { const f32x4* wp = (const f32x4*)(a.wt + (size_t)(4 + gi[i] * 8 + c) * DM) + lane; float acc = 0.f;
#pragma unroll
            for (int j = 0; j < 8; ++j) { const f32x4 w = wp[64 * j]; acc += (v[i][j].x * w.x + v[i][j].y * w.y) + (v[i][j].z * w.z + v[i][j].w * w.w); }
            el[i][c] = acc; }
        __builtin_amdgcn_sched_barrier(0); }
#pragma unroll
    for (int o = 1; o < 64; o <<= 1)
#pragma unroll
        for (int i = 0; i < R; ++i)
#pragma unroll
            for (int c = 0; c < 8; ++c) el[i][c] += __shfl_xor(el[i][c], o);
#pragma unroll
    for (int i = 0; i < R; ++i) { const int m = m0 + i * ms;
        int i1 = 0; float m1 = el[i][0] + a.br[gi[i] * 8];
        float ev[8];
#pragma unroll
        for (int c = 0; c < 8; ++c) ev[c] = el[i][c] + a.br[gi[i] * 8 + c];
#pragma unroll
        for (int c = 1; c < 8; ++c) if (ev[c] > m1) { m1 = ev[c]; i1 = c; }
        int i2 = -1; float m2 = -3.0e38f;
#pragma unroll
        for (int c = 0; c < 8; ++c) if (c != i1 && ev[c] > m2) { m2 = ev[c]; i2 = c; }
        const float e2 = __expf(m2 - m1); const float w1 = ggate[i] / (1.0f + e2), w2 = ggate[i] * e2 / (1.0f + e2);
        if (lane == 0) {
            const int ex1 = gi[i] * 8 + i1, ex2 = gi[i] * 8 + i2;
            const int p1 = (int)__hip_atomic_fetch_add(hist + ex1, 1u, __ATOMIC_RELAXED, __HIP_MEMORY_SCOPE_WORKGROUP), p2 = (int)__hip_atomic_fetch_add(hist + ex2, 1u, __ATOMIC_RELAXED, __HIP_MEMORY_SCOPE_WORKGROUP);
            LAS int* ri = rinfo + (lr0 + i * lrs) * 8; ri[0] = ex1; ri[1] = ex2; ri[2] = p1; ri[3] = p2; ((LAS float*)ri)[4] = w1; ((LAS float*)ri)[5] = w2; ri[6] = m;
        } }
}
__global__ void __launch_bounds__(256) k_ln1_route(const float* pre1, RouteArgs a) { ln1_route_row(pre1, a, blockIdx.x * 4 + (threadIdx.x >> 6), threadIdx.x & 63); }

__device__ __forceinline__ int row_start(const unsigned* cnt, int e) { int s = 0; for (int i = 0; i < e; ++i) s += ((int)cnt[i] + 255) & ~255; return s; }
struct P6Args { const bf16_t* h1b; const bf16_t* wgut; const bf16_t* wdt; const unsigned* cnt; const int* tokidx; bf16_t* act; bf16_t* y; };
__global__ void __launch_bounds__(256) k_moe_up(P6Args a) {
    const int wave = threadIdx.x >> 6, lane = threadIdx.x & 63, fr = lane & 15, fq = lane >> 4;
    const int R0 = blockIdx.y * 64;
    int e = 0, rs = 0;
    for (; e < NEXP; ++e) { const int n = ((int)a.cnt[e] + 255) & ~255; if (R0 < rs + n) break; rs += n; }
    if (e == NEXP) return;
    const int pos = R0 - rs + wave * 16 + fr; const int tok = pos < (int)a.cnt[e] ? a.tokidx[e * ECAP + pos] : 0;
    const int jb = blockIdx.x;
    f32x4 ag[8], au[8];
#pragma unroll
    for (int j = 0; j < 8; ++j) { ag[j] = (f32x4){0.f, 0.f, 0.f, 0.f}; au[j] = (f32x4){0.f, 0.f, 0.f, 0.f}; }
    const bf16_t* wb = a.wgut + ((size_t)e * 2048 + jb * 256) * DM;
    wave_gemm16x128(a.h1b + (size_t)tok * DM, wb, DM, DM, ag);
    wave_gemm16x128(a.h1b + (size_t)tok * DM, wb + (size_t)128 * DM, DM, DM, au);
#pragma unroll
    for (int r = 0; r < 4; ++r) { const size_t row = (size_t)R0 + wave * 16 + fq * 4 + r;
#pragma unroll
        for (int j = 0; j < 8; ++j) { const float g = ag[j][r], u = au[j][r]; a.act[row * FF + jb * 128 + 16 * j + fr] = f2bf(g / (1.0f + __expf(-g)) * u); } }
}
__global__ void __launch_bounds__(256) k_moe_down(P6Args a) {
    const int wave = threadIdx.x >> 6, lane = threadIdx.x & 63, fr = lane & 15, fq = lane >> 4;
    const int R0 = blockIdx.y * 64;
    int e = 0, rs = 0;
    for (; e < NEXP; ++e) { const int n = ((int)a.cnt[e] + 255) & ~255; if (R0 < rs + n) break; rs += n; }
    if (e == NEXP) return;
    f32x4 acc[8];
#pragma unroll
    for (int j = 0; j < 8; ++j) acc[j] = (f32x4){0.f, 0.f, 0.f, 0.f};
    wave_gemm16x128(a.act + ((size_t)R0 + wave * 16 + fr) * FF, a.wdt + ((size_t)e * 2048 + blockIdx.x * 128) * FF, FF, FF, acc);
#pragma unroll
    for (int r = 0; r < 4; ++r) { const size_t row = (size_t)R0 + wave * 16 + fq * 4 + r;
#pragma unroll
        for (int j = 0; j < 8; ++j) a.y[row * DM + blockIdx.x * 128 + 16 * j + fr] = f2bf(acc[j][r]); }
}
struct P8Args { const float* h1; const bf16_t* y; const unsigned* cnt; const int* slot; const float* g; const float* b; float* out; };
__device__ __forceinline__ void final_row(const P8Args& a, int m, int lane, size_t r1, size_t r2, float w1, float w2) {
    f32x4 v[8]; float s = 0.f;
#pragma unroll
    for (int j = 0; j < 8; ++j) { const int c = 4 * lane + 256 * j; const f32x4 hv = *(const f32x4*)(a.h1 + (size_t)m * DM + c);
        const uint2 ya = *(const uint2*)(a.y + r1 * DM + c), yb = *(const uint2*)(a.y + r2 * DM + c);
        f32x4 f; f.x = w1 * bflo(ya.x) + w2 * bflo(yb.x); f.y = w1 * bfhi(ya.x) + w2 * bfhi(yb.x); f.z = w1 * bflo(ya.y) + w2 * bflo(yb.y); f.w = w1 * bfhi(ya.y) + w2 * bfhi(yb.y);
        v[j] = hv * ALPHA + f; s += (v[j].x + v[j].y) + (v[j].z + v[j].w); }
    const float mean = wave_sum(s) * (1.0f / DM); float s2 = 0.f;
#pragma unroll
    for (int j = 0; j < 8; ++j) { v[j] = v[j] - mean; s2 += (v[j].x * v[j].x + v[j].y * v[j].y) + (v[j].z * v[j].z + v[j].w * v[j].w); }
    const float rstd = 1.0f / sqrtf(wave_sum(s2) * (1.0f / DM) + LN_EPS);
#pragma unroll
    for (int j = 0; j < 8; ++j) { const int c = 4 * lane + 256 * j; const f32x4 gg = *(const f32x4*)(a.g + c), bb = *(const f32x4*)(a.b + c);
        *(f32x4*)(a.out + (size_t)m * DM + c) = v[j] * rstd * gg + bb; }
}
__device__ __forceinline__ void final_row_t(const P8Args& a, const float* pre1, const float2* lnst, const float* g1, const float* b1, int m, int lane, size_t r1, size_t r2, float w1, float w2) {
    f32x4 v[8]; float s = 0.f; const float2 st = lnst[m];
#pragma unroll
    for (int j = 0; j < 8; ++j) { const int c = 4 * lane + 256 * j; const f32x4 pv = *(const f32x4*)(pre1 + (size_t)m * DM + c);
        const f32x4 hv = (pv - st.x) * st.y * *(const f32x4*)(g1 + c) + *(const f32x4*)(b1 + c);
        const uint2 ya = *(const uint2*)(a.y + r1 * DM + c), yb = *(const uint2*)(a.y + r2 * DM + c);
        f32x4 f; f.x = w1 * bflo(ya.x) + w2 * bflo(yb.x); f.y = w1 * bfhi(ya.x) + w2 * bfhi(yb.x); f.z = w1 * bflo(ya.y) + w2 * bflo(yb.y); f.w = w1 * bfhi(ya.y) + w2 * bfhi(yb.y);
        v[j] = hv * ALPHA + f; s += (v[j].x + v[j].y) + (v[j].z + v[j].w); }
    const float mean = wave_sum(s) * (1.0f / DM); float s2 = 0.f;
#pragma unroll
    for (int j = 0; j < 8; ++j) { v[j] = v[j] - mean; s2 += (v[j].x * v[j].x + v[j].y * v[j].y) + (v[j].z * v[j].z + v[j].w * v[j].w); }
    const float rstd = 1.0f / sqrtf(wave_sum(s2) * (1.0f / DM) + LN_EPS);
#pragma unroll
    for (int j = 0; j < 8; ++j) { const int c = 4 * lane + 256 * j; const f32x4 gg = *(const f32x4*)(a.g + c), bb = *(const f32x4*)(a.b + c);
        *(f32x4*)(a.out + (size_t)m * DM + c) = v[j] * rstd * gg + bb; }
}
__global__ void __launch_bounds__(256) k_final(P8Args a) {
    const int lane = threadIdx.x & 63, m = blockIdx.x * 4 + (threadIdx.x >> 6);
    const int* sl = a.slot + (size_t)m * 6; const int e1 = sl[0], e2 = sl[1], p1 = sl[2], p2 = sl[3]; const float w1 = ((const float*)sl)[4], w2 = ((const float*)sl)[5];
    final_row(a, m, lane, (size_t)row_start(a.cnt, e1) + p1, (size_t)row_start(a.cnt, e2) + p2, w1, w2);
}

namespace pg8 {
constexpr int BM = 256, BK = 64, HALF = 128, HTB = HALF * BK * 2  , STAGE_BYTES = 8 * HTB;
__device__ __forceinline__ int lds_byte(int r, int c) { const int st = (r >> 4) * 2 + (c >> 5), rr = r & 15, cc = c & 31, ob = rr * 64 + cc * 2; return st * 1024 + (ob ^ (((ob >> 9) & 1) << 5)); }
__device__ __forceinline__ void stage_rc(int b, int& R, int& C) { const int st = b / 1024, sb = b % 1024, swz = sb ^ (((sb >> 9) & 1) << 5); R = (st >> 1) * 16 + swz / 64; C = (st & 1) * 32 + (swz % 64) / 2; }

struct Unit { const char* A; const char* B; unsigned lda, ldb; int nt; int pm, pn, aux; const int* gidx; int gcnt; };
struct Voff { unsigned a[2][2], b[2][2]; };
__device__ __forceinline__ int brow_perm8(int h, int R) { return 128 * h + (R & ~31) + 8 * ((R >> 2) & 3) + 4 * ((R >> 4) & 1) + (R & 3); }
__device__ __forceinline__ int brow_rope(int h, int R) { return 128 * (R >> 6) + 64 * h + 32 * ((R >> 5) & 1) + 8 * ((R >> 2) & 3) + 4 * ((R >> 4) & 1) + (R & 3); }

template <class Epi> __device__ __forceinline__ void make_voff(const Unit& u, Voff& v, int tid) {
#pragma unroll
    for (int i = 0; i < 2; ++i) { int R, C; stage_rc(tid * 16 + i * 8192, R, C);
#pragma unroll
        for (int h = 0; h < 2; ++h) {
            int ra = h * HALF + R;
            if (u.gidx) ra = (ra < u.gcnt) ? u.gidx[ra] : 0;
            v.a[h][i] = (unsigned)ra * u.lda + (unsigned)C * 2u;
            v.b[h][i] = (unsigned)Epi::brow(h, R) * u.ldb + (unsigned)C * 2u;
        } }
}

template <class Epi, class Sched, bool ALIGN_EPI, bool SP2>
__device__ __forceinline__ void gemm_phase(LAS unsigned char* lds, LAS unsigned char* ex, const Sched& S, const Epi& E, int wid) {
    const int lane = lane_id(), tid = wid * 64 + lane, wr = wid >> 2, wc = wid & 3, fr = lane & 15, fq = lane >> 4;
    const unsigned ldsw = (unsigned)wid * 1024u;
    const int aoff = lds_byte(wr * 64 + fr, fq * 8), boff = lds_byte(wc * 32 + fr, fq * 8);
#define PG8_SA(b, h) (((b) * 2 + (h)) * HTB)
#define PG8_SB(b, h) ((4 + (b) * 2 + (h)) * HTB)
#define PG8_STAGE(bufoff, gbase, voff) do { _Pragma("unroll") for (int _i = 0; _i < 2; ++_i) \
        __builtin_amdgcn_global_load_lds((const unsigned*)((const char*)(gbase) + (voff)[_i]), (LAS unsigned*)(lds + (bufoff) + ldsw + _i * 8192), 16, 0, 0); } while (0)
#define PG8_LDA(dst, b, h) do { _Pragma("unroll") for (int m = 0; m < 4; ++m) _Pragma("unroll") for (int k = 0; k < 2; ++k) dst[m][k] = *(const LAS bf16x8*)(lds + PG8_SA(b, h) + aoff + m * 2048 + k * 1024); } while (0)
#define PG8_LDB(dst, b, h) do { _Pragma("unroll") for (int n = 0; n < 2; ++n) _Pragma("unroll") for (int k = 0; k < 2; ++k) dst[n][k] = *(const LAS bf16x8*)(lds + PG8_SB(b, h) + boff + n * 2048 + k * 1024); } while (0)
#define PG8_MMA(ai, bj, At, Bt) do { __builtin_amdgcn_s_setprio(1); _Pragma("unroll") for (int m = 0; m < 4; ++m) _Pragma("unroll") for (int n = 0; n < 2; ++n) _Pragma("unroll") for (int k = 0; k < 2; ++k) \
        acc[ai][bj][m][n] = __builtin_amdgcn_mfma_f32_16x16x32_bf16(Bt[n][k], At[m][k], acc[ai][bj][m][n], 0, 0, 0); __builtin_amdgcn_s_setprio(0); } while (0)
#define PG8_WAIT_V(n) asm volatile("s_waitcnt vmcnt(" #n ")" ::: "memory")
#define PG8_WAIT_L(n) asm volatile("s_waitcnt lgkmcnt(" #n ")" ::: "memory")
#define PG8_BAR __builtin_amdgcn_s_barrier()
#define PG8_SCHED __builtin_amdgcn_sched_barrier(0)
    Unit cur, nxt; int ui = 0;
    if (!S.next(0, cur)) return;
    Voff vo, nvo;
    make_voff<Epi>(cur, vo, tid);
    f32x4 acc[2][2][4][2];
#pragma unroll
    for (int a = 0; a < 2; ++a)
#pragma unroll
        for (int b = 0; b < 2; ++b)
#pragma unroll
            for (int m = 0; m < 4; ++m)
#pragma unroll
                for (int n = 0; n < 2; ++n) acc[a][b][m][n] = (f32x4){0.f, 0.f, 0.f, 0.f};
    bf16x8 At[4][2], B0[2][2], B1[2][2];
    const char* cA = cur.A; const char* cB = cur.B;
    const size_t kstep = (size_t)(BK * 2);
    if constexpr (SP2) {
        PG8_STAGE(PG8_SB(0, 0), cB, vo.b[0]); PG8_STAGE(PG8_SB(0, 1), cB, vo.b[1]); PG8_STAGE(PG8_SA(0, 0), cA, vo.a[0]); PG8_STAGE(PG8_SA(0, 1), cA, vo.a[1]);
        if (wr == 1) PG8_BAR;
        PG8_WAIT_V(2); PG8_BAR;
        PG8_STAGE(PG8_SB(1, 0), cB + kstep, vo.b[0]); PG8_STAGE(PG8_SA(1, 0), cA + kstep, vo.a[0]); PG8_STAGE(PG8_SB(1, 1), cB + kstep, vo.b[1]);
        PG8_WAIT_V(6); PG8_BAR;
    } else {
        PG8_STAGE(PG8_SB(0, 0), cB, vo.b[0]); PG8_STAGE(PG8_SA(0, 0), cA, vo.a[0]); PG8_STAGE(PG8_SB(0, 1), cB, vo.b[1]); PG8_STAGE(PG8_SA(0, 1), cA, vo.a[1]);
        if (wr == 1) PG8_BAR;
        PG8_WAIT_V(4); PG8_BAR;
        PG8_STAGE(PG8_SB(1, 0), cB + kstep, vo.b[0]); PG8_STAGE(PG8_SA(1, 0), cA + kstep, vo.a[0]); PG8_STAGE(PG8_SB(1, 1), cB + kstep, vo.b[1]);
        PG8_WAIT_V(6); PG8_BAR;
    }
    for (;;) {
        const bool has_next = S.next(ui + 1, nxt);
        if (has_next) make_voff<Epi>(nxt, nvo, tid); else nvo = vo;
        const char* nA = has_next ? nxt.A : cA; const char* nB = has_next ? nxt.B : cB;
        const int nt = cur.nt;
        for (int t = 0; t < nt; t += 2) {
            const bool last = (t == nt - 2);
            const char* a1 = cA + (size_t)(t + 1) * kstep;
            const char* a2 = last ? nA : cA + (size_t)(t + 2) * kstep; const char* b2 = last ? nB : cB + (size_t)(t + 2) * kstep;
            const char* a3 = a2 + kstep; const char* b3 = b2 + kstep;
            Voff w;
#pragma unroll
            for (int h = 0; h < 2; ++h)
#pragma unroll
                for (int i = 0; i < 2; ++i) { w.a[h][i] = last ? nvo.a[h][i] : vo.a[h][i]; w.b[h][i] = last ? nvo.b[h][i] : vo.b[h][i]; }
            if constexpr (SP2) {
            PG8_LDB(B0, 0, 0); PG8_LDB(B1, 0, 1); PG8_SCHED; PG8_LDA(At, 0, 0); PG8_STAGE(PG8_SA(1, 1), a1, vo.a[1]);
            PG8_WAIT_V(8); PG8_WAIT_L(0); PG8_BAR; PG8_MMA(0, 0, At, B0); PG8_MMA(0, 1, At, B1); PG8_BAR; PG8_SCHED;
            PG8_LDA(At, 0, 1); PG8_STAGE(PG8_SB(0, 0), b2, w.b[0]); PG8_STAGE(PG8_SB(0, 1), b2, w.b[1]); PG8_STAGE(PG8_SA(0, 0), a2, w.a[0]);
            PG8_WAIT_V(8); PG8_WAIT_L(0); PG8_BAR; PG8_MMA(1, 0, At, B0); PG8_MMA(1, 1, At, B1); PG8_BAR; PG8_SCHED;
            PG8_LDB(B0, 1, 0); PG8_LDB(B1, 1, 1); PG8_SCHED; PG8_LDA(At, 1, 0); PG8_STAGE(PG8_SA(0, 1), a2, w.a[1]);
            PG8_WAIT_V(8); PG8_WAIT_L(0); PG8_BAR; PG8_MMA(0, 0, At, B0); PG8_MMA(0, 1, At, B1); PG8_BAR; PG8_SCHED;
            PG8_LDA(At, 1, 1); PG8_STAGE(PG8_SB(1, 0), b3, w.b[0]); PG8_STAGE(PG8_SB(1, 1), b3, w.b[1]); PG8_STAGE(PG8_SA(1, 0), a3, w.a[0]);
            PG8_WAIT_V(8); PG8_WAIT_L(0); PG8_BAR; PG8_MMA(1, 0, At, B0); PG8_MMA(1, 1, At, B1); PG8_BAR; PG8_SCHED;
            } else {
            PG8_LDB(B0, 0, 0); PG8_SCHED; PG8_LDA(At, 0, 0); PG8_STAGE(PG8_SA(1, 1), a1, vo.a[1]);
            PG8_WAIT_L(8); PG8_BAR; PG8_WAIT_L(0); PG8_MMA(0, 0, At, B0); PG8_BAR; PG8_SCHED;
            PG8_LDB(B1, 0, 1); PG8_STAGE(PG8_SB(0, 0), b2, w.b[0]);
            PG8_BAR; PG8_WAIT_L(0); PG8_MMA(0, 1, At, B1); PG8_BAR;
            PG8_LDA(At, 0, 1); PG8_STAGE(PG8_SA(0, 0), a2, w.a[0]);
            PG8_BAR; PG8_WAIT_L(0); PG8_MMA(1, 0, At, B0); PG8_BAR; PG8_SCHED;
            PG8_STAGE(PG8_SB(0, 1), b2, w.b[1]);
            PG8_WAIT_V(6); PG8_BAR; PG8_MMA(1, 1, At, B1); PG8_BAR;
            PG8_LDB(B0, 1, 0); PG8_SCHED; PG8_LDA(At, 1, 0); PG8_STAGE(PG8_SA(0, 1), a2, w.a[1]);
            PG8_WAIT_L(8); PG8_BAR; PG8_WAIT_L(0); PG8_MMA(0, 0, At, B0); PG8_BAR; PG8_SCHED;
            PG8_LDB(B1, 1, 1); PG8_STAGE(PG8_SB(1, 0), b3, w.b[0]);
            PG8_BAR; PG8_WAIT_L(0); PG8_MMA(0, 1, At, B1); PG8_BAR;
            PG8_LDA(At, 1, 1); PG8_STAGE(PG8_SA(1, 0), a3, w.a[0]);
            PG8_BAR; PG8_WAIT_L(0); PG8_MMA(1, 0, At, B0); PG8_BAR; PG8_SCHED;
            PG8_STAGE(PG8_SB(1, 1), b3, w.b[1]);
            PG8_WAIT_V(6); PG8_BAR; PG8_MMA(1, 1, At, B1); PG8_BAR;
            }
        }
        if constexpr (ALIGN_EPI) { if (wr == 0) PG8_BAR; }
        E(acc, cur, wr, wc, fr, fq, ex);
        if (!has_next) break;
        if (!(cur.aux & 256)) {
#pragma unroll
        for (int a = 0; a < 2; ++a)
#pragma unroll
            for (int b = 0; b < 2; ++b)
#pragma unroll
                for (int m = 0; m < 4; ++m)
#pragma unroll
                    for (int n = 0; n < 2; ++n) acc[a][b][m][n] = (f32x4){0.f, 0.f, 0.f, 0.f};
        }
        cur = nxt; cA = nA; cB = nB; vo = nvo; ++ui;
        if constexpr (ALIGN_EPI) { if (wr == 1) PG8_BAR; }
    }
    PG8_WAIT_V(0);
    if constexpr (!ALIGN_EPI) { if (wr == 0) PG8_BAR; }
    PG8_BAR;
#undef PG8_SA
#undef PG8_SB
#undef PG8_STAGE
#undef PG8_LDA
#undef PG8_LDB
#undef PG8_MMA
#undef PG8_WAIT_V
#undef PG8_WAIT_L
#undef PG8_BAR
#undef PG8_SCHED
}

struct TileOrder {
    int nM, nN, nwg, G, c;
    __device__ void init(int M, int N, int G_, int c_) { nM = M / BM; nN = N / BM; nwg = nM * nN; G = G_; c = c_; }
    __device__ bool tile(int i, int& pm, int& pn) const {
        const long L = (long)i * G + c; if (L >= nwg) return false;
        int wgid = (int)L; { const int q = nwg / 8, r = nwg % 8, xcd = wgid % 8, off = wgid / 8; wgid = (xcd < r ? xcd * (q + 1) : r * (q + 1) + (xcd - r) * q) + off; }
        const int nig = 8 * nN, gid = wgid / nig, fm = gid * 8, gsz = (nM - fm) < 8 ? (nM - fm) : 8;
        pm = fm + ((wgid % nig) % gsz); pn = (wgid % nig) / gsz; return true;
    }
};
}

typedef float f32x2 __attribute__((ext_vector_type(2)));
#define ACC_T f32x4 (&acc)[2][2][4][2]

struct EpiProj {
    __device__ static __forceinline__ int brow(int h, int R) { return pg8::brow_rope(h, R); }
    unsigned char* ws; const float *qg, *kg;
    __device__ static __forceinline__ void rot4(const f32x4 x1, const f32x4 x2, const f32x4 t0, const f32x4 t1, f32x4& y1, f32x4& y2) {
        y1.x = x1.x * t0.x - x2.x * t0.y; y2.x = x2.x * t0.x + x1.x * t0.y;
        y1.y = x1.y * t0.z - x2.y * t0.w; y2.y = x2.y * t0.z + x1.y * t0.w;
        y1.z = x1.z * t1.x - x2.z * t1.y; y2.z = x2.z * t1.x + x1.z * t1.y;
        y1.w = x1.w * t1.z - x2.w * t1.w; y2.w = x2.w * t1.z + x1.w * t1.w;
    }
    __device__ static __forceinline__ void store8(bf16_t* dst, const f32x4 a, const f32x4 b) {
        u32x4 w; w.x = cvtpk(a.x, a.y); w.y = cvtpk(a.z, a.w); w.z = cvtpk(b.x, b.y); w.w = cvtpk(b.z, b.w); *(u32x4*)dst = w; }
    __device__ __forceinline__ void operator()(ACC_T, const pg8::Unit& u, int wr, int wc, int fr, int fq, LAS unsigned char* ex) const {
        const int ng = 2 * u.pn + (wc >> 1), c0 = 32 * (wc & 1) + 8 * fq;
        if (ng < 72) {
            const int which = ng / 24, hh = ng % 24, g = hh >> 3, h = hh & 7;
            bf16_t* buf = (bf16_t*)(ws + WS_QA + (size_t)which * (WS_KA - WS_QA));
            const float2* rt1 = (const float2*)(ws + WS_RT1);
#pragma unroll
            for (int ai = 0; ai < 2; ++ai)
#pragma unroll
                for (int m = 0; m < 4; ++m) {
                    const int mrow = u.pm * 256 + ai * 128 + wr * 64 + m * 16 + fr, b = mrow >> 12, t = mrow & 4095;
                    bf16_t* dst = buf + ((size_t)((g * 2 + b) * 8 + h) * SEQ + perm_pos(g, t)) * HD + c0;
                    f32x4 y1a = acc[ai][0][m][0], y1b = acc[ai][0][m][1], y2a = acc[ai][1][m][0], y2b = acc[ai][1][m][1];
                    if (which < 2) {
                        const f32x4* tp = (const f32x4*)(rt1 + (size_t)t * 64 + c0);
                        const f32x4 t0 = tp[0], t1 = tp[1], t2 = tp[2], t3 = tp[3];
                        rot4(acc[ai][0][m][0], acc[ai][1][m][0], t0, t1, y1a, y2a); rot4(acc[ai][0][m][1], acc[ai][1][m][1], t2, t3, y1b, y2b);
                    }
                    store8(dst, y1a, y1b); store8(dst + 64, y2a, y2b);
                }
        } else if (ng < 92) {
            const int k = ng - 72;
            LAS float* X = (LAS float*)ex;
#pragma unroll
            for (int ai = 0; ai < 2; ++ai)
#pragma unroll
                for (int m = 0; m < 4; ++m) { float s = 0.f;
#pragma unroll
                    for (int bj = 0; bj < 2; ++bj)
#pragma unroll
                        for (int n = 0; n < 2; ++n) { const f32x4 x = acc[ai][bj][m][n]; s += (x.x * x.x + x.y * x.y) + (x.z * x.z + x.w * x.w); }
                    s += __shfl_xor(s, 16); s += __shfl_xor(s, 32);
                    if (fq == 0) X[(ai * 128 + wr * 64 + m * 16 + fr) * 4 + wc] = s; }
            asm volatile("s_waitcnt lgkmcnt(0)" ::: "memory"); __builtin_amdgcn_s_barrier(); asm volatile("" ::: "memory");
            const float* gn = (k < 16) ? qg : kg; const float2* rt2 = (const float2*)(ws + WS_RT2);
            bf16_t* qb = (bf16_t*)(ws + WS_QB); bf16_t* kb = (bf16_t*)(ws + WS_KB);
            const f32x4 g1a = *(const f32x4*)(gn + c0), g1b = *(const f32x4*)(gn + c0 + 4), g2a = *(const f32x4*)(gn + 64 + c0), g2b = *(const f32x4*)(gn + 64 + c0 + 4);
#pragma unroll
            for (int ai = 0; ai < 2; ++ai)
#pragma unroll
                for (int m = 0; m < 4; ++m) {
                    const int r = ai * 128 + wr * 64 + m * 16 + fr;
                    const float ssum = X[r * 4 + (wc & 2)] + X[r * 4 + (wc & 2) + 1];
                    const int mrow = u.pm * 256 + r, b = mrow >> 12, t = mrow & 4095;
                    bf16_t* dst = ((k < 16) ? qb + ((size_t)(b * 16 + k) * SEQ + t) * HD : kb + ((size_t)(b * 4 + (k - 16)) * SEQ + t) * HD) + c0;
                    const float rinv = 1.0f / sqrtf(ssum * (1.0f / 128.0f) + RMS_EPS);
                    const f32x4* tp = (const f32x4*)(rt2 + (size_t)t * 64 + c0);
                    const f32x4 t0 = tp[0], t1 = tp[1], t2 = tp[2], t3 = tp[3];
                    f32x4 y1a, y1b, y2a, y2b;
                    rot4(acc[ai][0][m][0] * rinv * g1a, acc[ai][1][m][0] * rinv * g2a, t0, t1, y1a, y2a); rot4(acc[ai][0][m][1] * rinv * g1b, acc[ai][1][m][1] * rinv * g2b, t2, t3, y1b, y2b);
                    store8(dst, y1a, y1b); store8(dst + 64, y2a, y2b);
                }
        } else {
#pragma unroll
            for (int ai = 0; ai < 2; ++ai)
#pragma unroll
                for (int m = 0; m < 4; ++m) {
                    const int mrow = u.pm * 256 + ai * 128 + wr * 64 + m * 16 + fr, b = mrow >> 12, t = mrow & 4095;
                    bf16_t* dst = (ng < 96 ? (bf16_t*)(ws + WS_VB) + ((size_t)(b * 4 + (ng - 92)) * SEQ + t) * HD : (bf16_t*)(ws + WS_GATES) + (size_t)mrow * 4096 + (ng - 96) * 128) + c0;
                    f32x4 y1a = acc[ai][0][m][0], y1b = acc[ai][0][m][1], y2a = acc[ai][1][m][0], y2b = acc[ai][1][m][1];
                    if (ng >= 96) {
#pragma unroll
                        for (int q = 0; q < 4; ++q) { y1a[q] = __builtin_amdgcn_rcpf(1.0f + __expf(-y1a[q])); y1b[q] = __builtin_amdgcn_rcpf(1.0f + __expf(-y1b[q]));
                            y2a[q] = __builtin_amdgcn_rcpf(1.0f + __expf(-y2a[q])); y2b[q] = __builtin_amdgcn_rcpf(1.0f + __expf(-y2b[q])); } }
                    store8(dst, y1a, y1b); store8(dst + 64, y2a, y2b);
                }
        }
    }
};
struct ProjSched {
    pg8::TileOrder o; const char* ws;
    __device__ __forceinline__ bool next(int i, pg8::Unit& u) const { int pm, pn; if (!o.tile(i, pm, pn)) return false;
        u.A = ws + WS_XB + (size_t)pm * 256 * (DM * 2); u.B = ws + WS_WINT + (size_t)pn * 256 * (DM * 2); u.lda = DM * 2; u.ldb = DM * 2; u.nt = DM / 64; u.pm = pm; u.pn = pn; u.aux = 0; u.gidx = nullptr; u.gcnt = 0; return true; }
};

struct EpiMix {
    __device__ static __forceinline__ int brow(int h, int R) { return pg8::brow_perm8(h, R); }
    unsigned char* ws; const float* x;
    __device__ static __forceinline__ void unpack8(const u32x4 gw, f32x4& lo, f32x4& hi) { lo.x = bflo(gw.x); lo.y = bfhi(gw.x); lo.z = bflo(gw.y); lo.w = bfhi(gw.y); hi.x = bflo(gw.z); hi.y = bfhi(gw.z); hi.z = bflo(gw.w); hi.w = bfhi(gw.w); }
    __device__ __forceinline__ void operator()(f32x4 (&acc)[2][2][4][2], const pg8::Unit& u, int wr, int wc, int fr, int fq, LAS unsigned char* ex) const {
        const bf16_t* gates = (const bf16_t*)(ws + WS_GATES); bf16_t* merged = (bf16_t*)(ws + WS_MERGED); float* pre1 = (float*)(ws + WS_PRE1);
        { const int lane = lane_id(); fr = lane & 15; fq = lane >> 4; }
        const int mode = u.aux & 255; constexpr float GMIN = 8.673617379884035e-19f;
#pragma unroll
        for (int ai = 0; ai < 2; ++ai)
#pragma unroll
            for (int m = 0; m < 4; ++m) { const size_t mrow = (size_t)u.pm * 256 + ai * 128 + wr * 64 + m * 16 + fr;
#pragma unroll
                for (int bj = 0; bj < 2; ++bj) { const int col = u.pn * 256 + bj * 128 + wc * 32 + 8 * fq; const size_t o = mrow * DM + col;
                    if (mode == 2) {
                        const f32x4 x0 = *(const f32x4*)(x + o), x1 = *(const f32x4*)(x + o + 4);
                        *(f32x4*)(pre1 + o) = x0 * ALPHA + acc[ai][bj][m][0]; *(f32x4*)(pre1 + o + 4) = x1 * ALPHA + acc[ai][bj][m][1];
                    } else {
                        f32x4 g0a, g0b; unpack8(*(const u32x4*)(gates + mrow * 4096 + col), g0a, g0b);
#pragma unroll
                        for (int q = 0; q < 4; ++q) { g0a[q] = fmaxf(g0a[q], GMIN); g0b[q] = fmaxf(g0b[q], GMIN); }
                        if (mode == 1) { f32x4 g1a, g1b; unpack8(*(const u32x4*)(gates + mrow * 4096 + 2048 + col), g1a, g1b);
#pragma unroll
                            for (int q = 0; q < 4; ++q) { acc[ai][bj][m][0][q] *= g1a[q] * __builtin_amdgcn_rcpf(g0a[q]); acc[ai][bj][m][1][q] *= g1b[q] * __builtin_amdgcn_rcpf(g0b[q]); }
                        } else { const f32x4 t0 = g0a * acc[ai][bj][m][0], t1 = g0b * acc[ai][bj][m][1];
                            u32x4 w; w.x = cvtpk(t0.x, t0.y); w.y = cvtpk(t0.z, t0.w); w.z = cvtpk(t1.x, t1.y); w.w = cvtpk(t1.z, t1.w); *(u32x4*)(merged + o) = w; }
                    } } }
    }
};
struct MixSched {
    int mode, c; const char* ws;
    __device__ __forceinline__ bool next(int i, pg8::Unit& u) const {
        if (c >= 256) return false;
        const int pm = c >> 3, pn = c & 7; u.pm = pm; u.pn = pn; u.gidx = nullptr; u.gcnt = 0;
        if (mode == 0) { if (i > 1) return false;
            if (i == 1) { u.A = ws + WS_OA + (size_t)pm * 256 * 2048; u.B = ws + WS_WAT + (size_t)pn * 256 * 2048; u.lda = 2048; u.ldb = 2048; u.nt = 16; u.aux = 0; }
            else { u.A = ws + WS_OB + (size_t)pm * 256 * 4096; u.B = ws + WS_WBT + (size_t)pn * 256 * 4096; u.lda = 4096; u.ldb = 4096; u.nt = 32; u.aux = 1 | 256; }
            return true; }
        if (i > 0) return false;
        u.A = ws + WS_MERGED + (size_t)pm * 256 * 4096; u.B = ws + WS_WOT + (size_t)pn * 256 * 4096; u.lda = 4096; u.ldb = 4096; u.nt = 32; u.aux = 2; return true;
    }
};

struct MoeSched {
    int G, vcu, down; unsigned cnt_l, tpe_l;
    const char* ws;
    __device__ __forceinline__ void init(const unsigned* cnt, int lane) {
        unsigned c = 0; if (lane < NEXP) c = __hip_atomic_load(cnt + lane, __ATOMIC_RELAXED, __HIP_MEMORY_SCOPE_AGENT);
        unsigned t = (c + 255u) >> 8, inc = t;
#pragma unroll
        for (int o = 1; o < 32; o <<= 1) { const unsigned v = __shfl_up(inc, o); if ((lane & 31) >= o) inc += v; }
        cnt_l = c; tpe_l = inc - t;
    }
    __device__ __forceinline__ bool next(int i, pg8::Unit& u) const {
        const int lane = lane_id();
        const int total = (int)__builtin_amdgcn_readfirstlane(__shfl(tpe_l + ((cnt_l + 255u) >> 8), 31));
        const int L = i * G + vcu; if (L >= total * 8) return false;
        const int tg = L >> 3;
        const unsigned long long mk = __ballot(lane < NEXP && (int)tpe_l <= tg && (cnt_l > 0u));
        const int e = 63 - __builtin_clzll(mk);
        const int tp = (int)__builtin_amdgcn_readfirstlane(__shfl(tpe_l, e)), ce = (int)__builtin_amdgcn_readfirstlane(__shfl(cnt_l, e));
        const int te = (ce + 255) >> 8, q = L - 8 * tp, j = q / te, mt = q - j * te;
        u.pm = tp + mt; u.pn = j; u.aux = e; u.nt = down ? 16 : 32;
        if (!down) { u.A = ws + WS_H1B; u.lda = DM * 2; u.gidx = (const int*)(ws + WS_TOKIDX) + (size_t)e * ECAP + 256 * mt; u.gcnt = ce - 256 * mt; u.B = ws + WS_WGUT + ((size_t)e * 2048 + j * 256) * (DM * 2); u.ldb = DM * 2; }
        else { u.A = ws + WS_ACT + (size_t)(tp + mt) * 256 * (FF * 2); u.lda = FF * 2; u.gidx = nullptr; u.gcnt = 0; u.B = ws + WS_WDT + ((size_t)e * 2048 + j * 256) * (FF * 2); u.ldb = FF * 2; }
        return true;
    }
};
struct EpiMoe {
    __device__ static __forceinline__ int brow(int h, int R) { return pg8::brow_perm8(h, R); }
    int down; unsigned char* ws;
    __device__ __forceinline__ void operator()(ACC_T, const pg8::Unit& u, int wr, int wc, int fr, int fq, LAS unsigned char* ex) const {
        bf16_t* act = (bf16_t*)(ws + WS_ACT); bf16_t* y = (bf16_t*)(ws + WS_Y);
#pragma unroll
        for (int ai = 0; ai < 2; ++ai)
#pragma unroll
            for (int m = 0; m < 4; ++m) { const size_t row = (size_t)u.pm * 256 + ai * 128 + wr * 64 + m * 16 + fr;
                if (!down) {
                    f32x4 v0, v1;
#pragma unroll
                    for (int q = 0; q < 4; ++q) { const float g0 = acc[ai][0][m][0][q], u0 = acc[ai][1][m][0][q], g1 = acc[ai][0][m][1][q], u1 = acc[ai][1][m][1][q];
                        v0[q] = g0 * __builtin_amdgcn_rcpf(1.0f + __expf(-g0)) * u0; v1[q] = g1 * __builtin_amdgcn_rcpf(1.0f + __expf(-g1)) * u1; }
                    u32x4 w; w.x = cvtpk(v0.x, v0.y); w.y = cvtpk(v0.z, v0.w); w.z = cvtpk(v1.x, v1.y); w.w = cvtpk(v1.z, v1.w);
                    *(u32x4*)(act + row * FF + u.pn * 128 + wc * 32 + 8 * fq) = w;
                } else {
#pragma unroll
                    for (int bj = 0; bj < 2; ++bj) { const f32x4 a0 = acc[ai][bj][m][0], a1 = acc[ai][bj][m][1];
                        u32x4 w; w.x = cvtpk(a0.x, a0.y); w.y = cvtpk(a0.z, a0.w); w.z = cvtpk(a1.x, a1.y); w.w = cvtpk(a1.z, a1.w);
                        *(u32x4*)(y + row * DM + u.pn * 256 + bj * 128 + wc * 32 + 8 * fq) = w; }
                } }
    }
};


namespace mg {
constexpr int HTB = 16384, ABUF = 2 * HTB, BBUF = 64 * 256, B_OFF = 4 * ABUF;
struct Unit { const char* A; unsigned lda; const int* gidx; int gcnt; const float* B0; const float* B1; unsigned ldbf; int nt, up, pm, pn; };
template <int OFF> __device__ __forceinline__ s16x4 vtr(int addr) { s16x4 r; asm volatile("ds_read_b64_tr_b16 %0, %1 offset:%2" : "=&v"(r) : "v"(addr), "i"(OFF) : "memory"); return r; }

template <class Sched, class Epi, int XV>
__device__ __forceinline__ void gemm_phase(LAS unsigned char* lds, const Sched& S, const Epi& E, int wid) {
    const int lane = lane_id(), tid = wid * 64 + lane, wr = wid >> 2, wc = wid & 3, fr = lane & 15, fq = lane >> 4;
    const unsigned ldsw = (unsigned)wid * 1024u;
    const int aoff = pg8::lds_byte(wr * 64 + fr, fq * 8);
    const int n4 = tid & 31, kr = tid >> 5;
    const int tq = (lane & 15) >> 2, tp = lane & 3, tf = tq | ((fq & 1) << 2);
    const int ldsa = (int)(unsigned)(uintptr_t)lds;
    const int tb0 = B_OFF + (8 * fq + tq) * 256 + (((2 * wc) ^ tf) * 32) + 8 * tp, tb1 = B_OFF + (8 * fq + tq) * 256 + (((2 * wc + 1) ^ tf) * 32) + 8 * tp;
    const int wfk = (kr & 3) | (((kr >> 3) & 1) << 2);
#define MG_STAGE_A(slot, tt) do { _Pragma("unroll") for (int h_ = 0; h_ < 2; ++h_) _Pragma("unroll") for (int i_ = 0; i_ < 2; ++i_) \
        __builtin_amdgcn_global_load_lds((const unsigned*)(u.A + (size_t)(tt) * 128 + voffA[h_][i_]), (LAS unsigned*)(lds + (slot) * ABUF + h_ * HTB + ldsw + i_ * 8192), 16, 0, 0); } while (0)
#define MG_LOADB(R, tt) do { const float* p_ = bp + (size_t)(tt) * 64 * u.ldbf; \
        asm volatile("global_load_dwordx4 %0, %1, off" : "=v"(R##0) : "v"(p_) : "memory"); \
        asm volatile("global_load_dwordx4 %0, %1, off" : "=v"(R##1) : "v"(p_ + (size_t)16 * u.ldbf) : "memory"); \
        asm volatile("global_load_dwordx4 %0, %1, off" : "=v"(R##2) : "v"(p_ + (size_t)32 * u.ldbf) : "memory"); \
        asm volatile("global_load_dwordx4 %0, %1, off" : "=v"(R##3) : "v"(p_ + (size_t)48 * u.ldbf) : "memory"); } while (0)
#define MG_WAITB(R, N) asm volatile("s_waitcnt vmcnt(" #N ")" : "+v"(R##0), "+v"(R##1), "+v"(R##2), "+v"(R##3) :: "memory")
#define MG_PK(v) (u32x2){cvtpk((v).x, (v).y), cvtpk((v).z, (v).w)}
#define MG_WRITEB(R, slot) do { LAS unsigned char* w_ = lds + B_OFF + (slot) * BBUF + wa; \
        *(LAS u32x2*)(w_) = MG_PK(R##0); *(LAS u32x2*)(w_ + 4096) = MG_PK(R##1); *(LAS u32x2*)(w_ + 8192) = MG_PK(R##2); *(LAS u32x2*)(w_ + 12288) = MG_PK(R##3); } while (0)
#define MG_WAITV(N) asm volatile("s_waitcnt vmcnt(" #N ")" ::: "memory")
#define MG_BAR() do { asm volatile("" ::: "memory"); __builtin_amdgcn_s_barrier(); asm volatile("" ::: "memory"); } while (0)
#define MG_ITER(t, R) do { const int t_ = (t); \
        if (t_ + 1 < nt) { \
            if (t_ == 0 || t_ + 2 == nt) MG_WAITB(R, 4); else if (t_ == 1) MG_WAITB(R, 8); else MG_WAITB(R, 12); \
            MG_WRITEB(R, (t_ + 1) & 1); } \
        if (t_ + 3 < nt) { MG_LOADB(R, t_ + 3); MG_STAGE_A((t_ + 3) & 3, t_ + 3); } \
        const int as_ = (t_ & 3) * ABUF, ba0_ = ldsa + (t_ & 1) * BBUF + tb0, ba1_ = ldsa + (t_ & 1) * BBUF + tb1; bf16x8 Bf[2][2], At0[4][2], At1[4][2]; \
        { const s16x4 l0 = vtr<0>(ba0_), h0 = vtr<1024>(ba0_), l1 = vtr<0>(ba1_), h1 = vtr<1024>(ba1_), l2 = vtr<8192>(ba0_), h2 = vtr<9216>(ba0_), l3 = vtr<8192>(ba1_), h3 = vtr<9216>(ba1_); \
          _Pragma("unroll") for (int m = 0; m < 4; ++m) _Pragma("unroll") for (int k = 0; k < 2; ++k) At0[m][k] = *(const LAS bf16x8*)(lds + as_ + aoff + m * 2048 + k * 1024); \
          _Pragma("unroll") for (int m = 0; m < 4; ++m) _Pragma("unroll") for (int k = 0; k < 2; ++k) At1[m][k] = *(const LAS bf16x8*)(lds + as_ + HTB + aoff + m * 2048 + k * 1024); \
          if (t_ + 4 <= nt) MG_WAITV(16); else if (t_ + 3 == nt) MG_WAITV(8); else if (t_ + 2 == nt) MG_WAITV(0); \
          asm volatile("s_waitcnt lgkmcnt(0)" ::: "memory"); __builtin_amdgcn_sched_barrier(0); \
          Bf[0][0] = (bf16x8){l0[0], l0[1], l0[2], l0[3], h0[0], h0[1], h0[2], h0[3]}; Bf[1][0] = (bf16x8){l1[0], l1[1], l1[2], l1[3], h1[0], h1[1], h1[2], h1[3]}; \
          Bf[0][1] = (bf16x8){l2[0], l2[1], l2[2], l2[3], h2[0], h2[1], h2[2], h2[3]}; Bf[1][1] = (bf16x8){l3[0], l3[1], l3[2], l3[3], h3[0], h3[1], h3[2], h3[3]}; } \
        MG_BAR(); \
        __builtin_amdgcn_s_setprio(1); \
        _Pragma("unroll") for (int m = 0; m < 4; ++m) _Pragma("unroll") for (int nn = 0; nn < 2; ++nn) _Pragma("unroll") for (int k = 0; k < 2; ++k) \
            { if (XV != 64) acc[0][m][nn] = __builtin_amdgcn_mfma_f32_16x16x32_bf16(Bf[nn][k], At0[m][k], acc[0][m][nn], 0, 0, 0); else { asm volatile("" :: "v"(Bf[nn][k]), "v"(At0[m][k])); } } \
        _Pragma("unroll") for (int m = 0; m < 4; ++m) _Pragma("unroll") for (int nn = 0; nn < 2; ++nn) _Pragma("unroll") for (int k = 0; k < 2; ++k) \
            { if (XV != 64) acc[1][m][nn] = __builtin_amdgcn_mfma_f32_16x16x32_bf16(Bf[nn][k], At1[m][k], acc[1][m][nn], 0, 0, 0); else { asm volatile("" :: "v"(Bf[nn][k]), "v"(At1[m][k])); } } \
        __builtin_amdgcn_s_setprio(0); \
        MG_BAR(); } while (0)

    Unit u;
    for (int ui = 0; S.next(ui, u); ++ui) {
        const int nt = u.nt;
        unsigned voffA[2][2];
#pragma unroll
        for (int i = 0; i < 2; ++i) { int R, C; pg8::stage_rc(tid * 16 + i * 8192, R, C);
#pragma unroll
            for (int h = 0; h < 2; ++h) { int ra = h * 128 + R; if (u.gidx) ra = (ra < u.gcnt) ? u.gidx[ra] : 0; voffA[h][i] = (unsigned)ra * u.lda + (unsigned)C * 2u; } }
        const float* bp = (n4 < 16 ? u.B0 + 4 * n4 : u.B1 + 4 * (n4 - 16)) + (size_t)kr * u.ldbf;
        const int P = u.up ? (32 * ((n4 & 15) >> 2) + 16 * (n4 >> 4) + 4 * (n4 & 3)) : (32 * (n4 >> 3) + 16 * (n4 & 1) + 4 * ((n4 & 7) >> 1));
        const int wa = kr * 256 + (((P >> 4) ^ wfk) * 32) + (P & 15) * 2;
        f32x4 acc[2][4][2];
#pragma unroll
        for (int a = 0; a < 2; ++a)
#pragma unroll
            for (int m = 0; m < 4; ++m)
#pragma unroll
                for (int n = 0; n < 2; ++n) acc[a][m][n] = (f32x4){0.f, 0.f, 0.f, 0.f};
        f32x4 Ra0 = {}, Ra1 = {}, Ra2 = {}, Ra3 = {}, Rb0 = {}, Rb1 = {}, Rb2 = {}, Rb3 = {};
        MG_STAGE_A(0, 0); MG_STAGE_A(1, 1); MG_STAGE_A(2, 2);
        MG_LOADB(Ra, 0); MG_LOADB(Rb, 1);
        MG_WAITB(Ra, 4); MG_WRITEB(Ra, 0);
        MG_LOADB(Ra, 2);
        asm volatile("s_waitcnt lgkmcnt(0)" ::: "memory");
        if (wr == 1) MG_BAR();
        MG_BAR();
        for (int t = 0; t < nt; t += 2) {
            MG_ITER(t, Rb);
            MG_ITER(t + 1, Ra);
        }
        if (wr == 0) MG_BAR();
        E(acc, u, wid);
    }
#undef MG_STAGE_A
#undef MG_LOADB
#undef MG_WAITB
#undef MG_PK
#undef MG_WRITEB
#undef MG_WAITV
#undef MG_BAR
#undef MG_ITER
}
}

struct MoeSched2 {
    int G, vcu, down, var; unsigned cnt_l, tpe_l; const char* ws; const float *wgate, *wup, *wdown;
    __device__ __forceinline__ void init(const unsigned* cnt, int lane) {
        unsigned c = 0; if (lane < NEXP) c = __hip_atomic_load(cnt + lane, __ATOMIC_RELAXED, __HIP_MEMORY_SCOPE_AGENT);
        unsigned t = (c + 255u) >> 8, inc = t;
#pragma unroll
        for (int o = 1; o < 32; o <<= 1) { const unsigned v = __shfl_up(inc, o); if ((lane & 31) >= o) inc += v; }
        cnt_l = c; tpe_l = inc - t;
    }
    __device__ __forceinline__ bool next(int i, mg::Unit& u) const {
        const int lane = lane_id();
        const int total = (int)__builtin_amdgcn_readfirstlane(__shfl(tpe_l + ((cnt_l + 255u) >> 8), 31));
        const int L = i * G + vcu; if (L >= total * 16) return false;
        const int tg = L >> 4;
        const unsigned long long mk = __ballot(lane < NEXP && (int)tpe_l <= tg && (cnt_l > 0u));
        const int e = 63 - __builtin_clzll(mk);
        const int tp = (int)__builtin_amdgcn_readfirstlane(__shfl(tpe_l, e)), ce = (int)__builtin_amdgcn_readfirstlane(__shfl(cnt_l, e));
        const int te = (ce + 255) >> 8, q = L - 16 * tp, j = q / te, mt = q - j * te;
        u.pm = tp + mt; u.pn = j; u.up = down ? 0 : 1; u.nt = down ? 16 : 32;
        if (!down) { u.A = ws + WS_H1B; u.lda = DM * 2; u.gidx = (const int*)(ws + WS_TOKIDX) + (size_t)e * ECAP + 256 * mt; u.gcnt = ce - 256 * mt;
            u.B0 = wgate + (size_t)e * DM * FF + j * 64; u.B1 = wup + (size_t)e * DM * FF + j * 64; u.ldbf = FF;
            if (var == 61) { u.B0 = wgate; u.B1 = wup; }
            if (var == 65) { u.gidx = nullptr; u.A = ws + WS_H1B + (size_t)((tp + mt) & 31) * 256 * (DM * 2); } }
        else { u.A = ws + WS_ACT + (size_t)(tp + mt) * 256 * (FF * 2); u.lda = FF * 2; u.gidx = nullptr; u.gcnt = 0;
            u.B0 = wdown + (size_t)e * FF * DM + j * 128; u.B1 = u.B0 + 64; u.ldbf = DM; }
        return true;
    }
};
struct EpiMoe2 {
    int down; unsigned char* ws;
    __device__ __forceinline__ void operator()(f32x4 (&acc)[2][4][2], const mg::Unit& u, int wid) const {
        const int lane = lane_id(), wr = wid >> 2, wc = wid & 3, fr = lane & 15, fq = lane >> 4;
        bf16_t* act = (bf16_t*)(ws + WS_ACT); bf16_t* y = (bf16_t*)(ws + WS_Y);
#pragma unroll
        for (int ai = 0; ai < 2; ++ai)
#pragma unroll
            for (int m = 0; m < 4; ++m) { const size_t row = (size_t)u.pm * 256 + ai * 128 + wr * 64 + m * 16 + fr;
                if (!down) { f32x4 v;
#pragma unroll
                    for (int q = 0; q < 4; ++q) { const float g = acc[ai][m][0][q], up = acc[ai][m][1][q]; v[q] = g * __builtin_amdgcn_rcpf(1.0f + __expf(-g)) * up; }
                    u32x2 w; w.x = cvtpk(v.x, v.y); w.y = cvtpk(v.z, v.w);
                    *(u32x2*)(act + row * FF + u.pn * 64 + wc * 16 + 4 * fq) = w;
                } else { const f32x4 a0 = acc[ai][m][0], a1 = acc[ai][m][1];
                    u32x4 w; w.x = cvtpk(a0.x, a0.y); w.y = cvtpk(a0.z, a0.w); w.z = cvtpk(a1.x, a1.y); w.w = cvtpk(a1.z, a1.w);
                    *(u32x4*)(y + row * DM + u.pn * 128 + wc * 32 + 8 * fq) = w; } }
    }
};

namespace att {
constexpr int D = 128, NW = 8, QBLK = 32, KVBLK = 64;
constexpr float SCALE = SM_SCALE, THR = 8.f;
constexpr int SHM_V = KVBLK * D * 2, SHM_K = KVBLK * D * 2, SHM_ATTN = 2 * SHM_V + 2 * SHM_K + NW * 64 * 4;
#define KSWZ(row, colB) ((row) * 256 + ((colB) ^ (((row) & 7) << 4)))
#define SBAR() __builtin_amdgcn_sched_barrier(0)
__device__ __forceinline__ int crow(int r, int hi) { return (r & 3) + 8 * (r >> 2) + 4 * hi; }
template <bool BAND> __device__ __forceinline__ void partialSM(f32x16& p0, f32x16& p1, float& m_reg, float& mn, float& alpha, int dv, bool tv) {
    constexpr float C = SCALE * 1.4426950408889634f;
    if constexpr (BAND) {
#pragma unroll
        for (int r = 0; r < 16; ++r) { const int kx = (r & 3) + 8 * (r >> 2);
            if (!tv || (unsigned)(dv + kx) > 128u) p0[r] = -INFINITY;
            if (!tv || (unsigned)(dv + kx + 32) > 128u) p1[r] = -INFINITY; } }
    float pmax = p0[0];
#pragma unroll
    for (int r = 1; r < 16; ++r) pmax = fmaxf(pmax, p0[r]);
#pragma unroll
    for (int r = 0; r < 16; ++r) pmax = fmaxf(pmax, p1[r]);
    { auto rr = __builtin_amdgcn_permlane32_swap(__float_as_uint(pmax), __float_as_uint(pmax), false, false);
      pmax = fmaxf(__uint_as_float(rr[0]), __uint_as_float(rr[1])); }
    if (__builtin_expect(__all(pmax - m_reg <= THR / SCALE), 1)) { mn = m_reg; alpha = 1.f; }
    else { mn = fmaxf(m_reg, pmax); alpha = __builtin_amdgcn_exp2f((m_reg - mn) * C); m_reg = mn; }
    const float mnC = -mn * C;
#pragma unroll
    for (int r = 0; r < 16; ++r) p0[r] = fmaf(p0[r], C, mnC);
#pragma unroll
    for (int r = 0; r < 16; ++r) p1[r] = fmaf(p1[r], C, mnC);
#pragma unroll
    for (int r = 0; r < 16; ++r) p0[r] = __builtin_amdgcn_exp2f(p0[r]);
}
__device__ __forceinline__ void finishSM(f32x16& p0, f32x16& p1, float alpha, float& l_reg, bf16x8& pa0, bf16x8& pa1, bf16x8& pa2, bf16x8& pa3) {
#pragma unroll
    for (int r = 0; r < 16; ++r) p1[r] = __builtin_amdgcn_exp2f(p1[r]);
    float ps = 0;
#pragma unroll
    for (int r = 0; r < 16; ++r) ps += p0[r];
#pragma unroll
    for (int r = 0; r < 16; ++r) ps += p1[r];
    { auto rr = __builtin_amdgcn_permlane32_swap(__float_as_uint(ps), __float_as_uint(ps), false, false);
      ps = __uint_as_float(rr[0]) + __uint_as_float(rr[1]); }
    l_reg = l_reg * alpha + ps;
#define PK4(P, BASE, OUT) do { unsigned a0 = cvtpk(P[BASE + 0], P[BASE + 1]), a1 = cvtpk(P[BASE + 2], P[BASE + 3]);   \
    unsigned b0 = cvtpk(P[BASE + 4], P[BASE + 5]), b1 = cvtpk(P[BASE + 6], P[BASE + 7]);                              \
    auto r0 = __builtin_amdgcn_permlane32_swap(a0, b0, false, false); auto r1 = __builtin_amdgcn_permlane32_swap(a1, b1, false, false); \
    u32x4 w = {r0[0], r1[0], r0[1], r1[1]}; OUT = *reinterpret_cast<bf16x8*>(&w); } while (0)
    PK4(p0, 0, pa0); PK4(p0, 8, pa1); PK4(p1, 0, pa2); PK4(p1, 8, pa3);
#undef PK4
}
__device__ __forceinline__ void qkt(f32x16& p0, f32x16& p1, const LAS unsigned char* Ks, const bf16x8* qr, int r32, int hi) {
    p0 = f32x16{}; p1 = f32x16{};
#pragma unroll
    for (int d0 = 0; d0 < 8; ++d0) { const int cb = (d0 * 16 + hi * 8) * 2;
        const bf16x8 b0 = *(const LAS bf16x8*)(Ks + KSWZ(r32, cb));
        const bf16x8 b1 = *(const LAS bf16x8*)(Ks + KSWZ(32 + r32, cb));
        p0 = __builtin_amdgcn_mfma_f32_32x32x16_bf16(b0, qr[d0], p0, 0, 0, 0);
        p1 = __builtin_amdgcn_mfma_f32_32x32x16_bf16(b1, qr[d0], p1, 0, 0, 0); }
}
__device__ __forceinline__ int v_st(int k, int c) { const int kk = (k & ~0xC) | ((k & 4) << 1) | ((k & 8) >> 1); return ((kk >> 3) * 4 + (c >> 5)) * 512 + ((kk & 7) * 32 + (c & 31)) * 2; }
__device__ __forceinline__ int v_rd_base(int lane) { return ((lane & 3) << 3) | (((lane >> 2) & 3) << 6) | (((lane >> 4) & 1) << 5) | (((lane >> 5) & 1) << 8); }
constexpr int v_rd_off(int d0, int ks, int half) { return d0 * 512 + ks * 4096 + half * 2048; }
template <int OFF> __device__ __forceinline__ s16x4 tr_read(int vb) { s16x4 r; asm volatile("ds_read_b64_tr_b16 %0, %1 offset:%2" : "=&v"(r) : "v"(vb), "i"(OFF) : "memory"); return r; }
template <int D0> __device__ __forceinline__ void pv_one(f32x16& od, int vb, bf16x8 pa0, bf16x8 pa1, bf16x8 pa2, bf16x8 pa3) {
    const s16x4 l0 = tr_read<v_rd_off(D0, 0, 0)>(vb), h0 = tr_read<v_rd_off(D0, 0, 1)>(vb), l1 = tr_read<v_rd_off(D0, 1, 0)>(vb), h1 = tr_read<v_rd_off(D0, 1, 1)>(vb);
    const s16x4 l2 = tr_read<v_rd_off(D0, 2, 0)>(vb), h2 = tr_read<v_rd_off(D0, 2, 1)>(vb), l3 = tr_read<v_rd_off(D0, 3, 0)>(vb), h3 = tr_read<v_rd_off(D0, 3, 1)>(vb);
    asm volatile("s_waitcnt lgkmcnt(0)" ::: "memory"); SBAR();
#define PK(L, H) (bf16x8){L[0], L[1], L[2], L[3], H[0], H[1], H[2], H[3]}
    od = __builtin_amdgcn_mfma_f32_32x32x16_bf16(pa0, PK(l0, h0), od, 0, 0, 0);
    od = __builtin_amdgcn_mfma_f32_32x32x16_bf16(pa1, PK(l1, h1), od, 0, 0, 0);
    od = __builtin_amdgcn_mfma_f32_32x32x16_bf16(pa2, PK(l2, h2), od, 0, 0, 0);
    od = __builtin_amdgcn_mfma_f32_32x32x16_bf16(pa3, PK(l3, h3), od, 0, 0, 0);
#undef PK
}
__device__ __forceinline__ void pv_d0(f32x16* o, int vb, bf16x8 pa0, bf16x8 pa1, bf16x8 pa2, bf16x8 pa3) {
    pv_one<0>(o[0], vb, pa0, pa1, pa2, pa3); pv_one<1>(o[1], vb, pa0, pa1, pa2, pa3); pv_one<2>(o[2], vb, pa0, pa1, pa2, pa3); pv_one<3>(o[3], vb, pa0, pa1, pa2, pa3);
}
struct Unit { const bf16_t *Q, *K, *V; bf16_t* O; float* lse; int ldo, lse_stride, nt, kt0, klo, khi, q0; };
__device__ __forceinline__ void body(const Unit& u, LAS unsigned char* lds, int wid) {
    const int lane = lane_id(), tid = wid * 64 + lane,
        r32 = lane & 31, hi = lane >> 5;
    LAS unsigned char* V_lds = lds; LAS unsigned char* K_lds = lds + 3 * SHM_V;
    LAS float* ws = (LAS float*)(lds + 3 * SHM_V + 3 * SHM_K) + wid * 64; LAS float* li_l = ws; LAS float* al_l = ws + 32;
    float m_reg = -1e30f, l_reg = 0; f32x16 o[4] = {}; bf16x8 qr[8];
    const bf16_t* Qw = u.Q + (size_t)(wid * QBLK + r32) * D + hi * 8;
#pragma unroll
    for (int d0 = 0; d0 < 8; ++d0) qr[d0] = *(const bf16x8*)(Qw + d0 * 16);
    const int sr = tid >> 4, sc = (tid & 15) * 8, vst0 = v_st(sr, sc), vst1 = v_st(32 + sr, sc);
    const int vb0 = (int)(unsigned)(uintptr_t)V_lds + v_rd_base(lane);
    const bf16_t* Kh = u.K; const bf16_t* Vh = u.V;
    constexpr bool BAND = false; constexpr int SD = 1; const int dq = 0;
#define TVALID(j) true
    struct { bf16x8 vs0, vs1, ks0, ks1; } sr_[SD];
#define KROW(j) (BAND ? ((u.kt0 + 64 * (j)) < u.klo ? u.klo : ((u.kt0 + 64 * (j)) > u.khi - 64 ? u.khi - 64 : (u.kt0 + 64 * (j)))) : (u.kt0 + 64 * (j)))
#define SLOAD(i, j) do { const int k0_ = KROW(j); sr_[i].vs0 = *(const bf16x8*)(&Vh[(size_t)(k0_ + sr) * D + sc]); sr_[i].vs1 = *(const bf16x8*)(&Vh[(size_t)(k0_ + 32 + sr) * D + sc]); \
    sr_[i].ks0 = *(const bf16x8*)(&Kh[(size_t)(k0_ + sr) * D + sc]); sr_[i].ks1 = *(const bf16x8*)(&Kh[(size_t)(k0_ + 32 + sr) * D + sc]); } while (0)
#define SWRITE(b, i) do { *(LAS bf16x8*)(V_lds + (b) * SHM_V + vst0) = sr_[i].vs0; *(LAS bf16x8*)(V_lds + (b) * SHM_V + vst1) = sr_[i].vs1; const int kc = sc * 2; \
    *(LAS bf16x8*)(K_lds + (b) * SHM_K + KSWZ(sr, kc)) = sr_[i].ks0; *(LAS bf16x8*)(K_lds + (b) * SHM_K + KSWZ(32 + sr, kc)) = sr_[i].ks1; } while (0)
#define SWRITE_AT(ob, i) do { *(LAS bf16x8*)(V_lds + (ob) + vst0) = sr_[i].vs0; *(LAS bf16x8*)(V_lds + (ob) + vst1) = sr_[i].vs1; const int kc = sc * 2; \
    *(LAS bf16x8*)(K_lds + (ob) + KSWZ(sr, kc)) = sr_[i].ks0; *(LAS bf16x8*)(K_lds + (ob) + KSWZ(32 + sr, kc)) = sr_[i].ks1; } while (0)
#define SWAIT() do { if constexpr (SD == 2) asm volatile("s_waitcnt vmcnt(4)" ::: "memory"); else asm volatile("s_waitcnt vmcnt(0)" ::: "memory"); } while (0)
#define RESC(a) do { if (__any((a) < 1.f)) { if (hi == 0) al_l[r32] = (a); asm volatile("s_waitcnt lgkmcnt(0)" ::: "memory"); \
    _Pragma("unroll") for (int d = 0; d < 4; ++d) _Pragma("unroll") for (int r = 0; r < 16; ++r) o[d][r] *= al_l[crow(r, hi)]; } } while (0)
    f32x16 pA0, pA1, pB0, pB1; float mnA, mnB, alA, alB; bf16x8 pa0, pa1, pa2, pa3; const int NT = u.nt;
    constexpr int SE = 0, SO = SD - 1;
    SLOAD(SE, 0); asm volatile("s_waitcnt vmcnt(0)" ::: "memory"); SWRITE(0, SE); __syncthreads();
    qkt(pA0, pA1, K_lds, qr, r32, hi); partialSM<BAND>(pA0, pA1, m_reg, mnA, alA, dq, TVALID(0));
    SLOAD(SO, 1); if constexpr (SD == 2) { if (2 < NT) SLOAD(SE, 2); }
    SWAIT(); SWRITE(1, SO); __syncthreads();
    int ob0 = 0, ob1 = SHM_V, ob2 = 2 * SHM_V;
    for (int j = 1; j + 1 < NT; j += 2) {
        SBAR(); qkt(pB0, pB1, K_lds + ob1, qr, r32, hi);
        finishSM(pA0, pA1, alA, l_reg, pa0, pa1, pa2, pa3); SBAR();
        SLOAD(SO, j + SD); SBAR();
        pv_d0(o, vb0 + ob0, pa0, pa1, pa2, pa3); partialSM<BAND>(pB0, pB1, m_reg, mnB, alB, dq + 64 * j, TVALID(j));
        SWAIT(); SWRITE_AT(ob2, SE);
        RESC(alB); __syncthreads();
        SBAR(); qkt(pA0, pA1, K_lds + ob2, qr, r32, hi);
        finishSM(pB0, pB1, alB, l_reg, pa0, pa1, pa2, pa3); SBAR();
        if (SD == 1 || j + 3 < NT) SLOAD(SE, j + 1 + SD); SBAR();
        pv_d0(o, vb0 + ob1, pa0, pa1, pa2, pa3); partialSM<BAND>(pA0, pA1, m_reg, mnA, alA, dq + 64 * (j + 1), TVALID(j + 1));
        SWAIT(); SWRITE_AT(ob0, SO);
        RESC(alA); __syncthreads();
        { const int t_ = ob0; ob0 = ob2; ob2 = ob1; ob1 = t_; }
    }
    SBAR(); qkt(pB0, pB1, K_lds + ob1, qr, r32, hi);
    finishSM(pA0, pA1, alA, l_reg, pa0, pa1, pa2, pa3); SBAR();
    pv_d0(o, vb0 + ob0, pa0, pa1, pa2, pa3); partialSM<BAND>(pB0, pB1, m_reg, mnB, alB, dq + 64 * (NT - 1), TVALID(NT - 1));
    RESC(alB);
    finishSM(pB0, pB1, alB, l_reg, pa0, pa1, pa2, pa3); SBAR();
    pv_d0(o, vb0 + ob1, pa0, pa1, pa2, pa3);
    __syncthreads();
    if (hi == 0) li_l[r32] = l_reg; asm volatile("s_waitcnt lgkmcnt(0)" ::: "memory");
    float rli[16];
#pragma unroll
    for (int r = 0; r < 16; ++r) rli[r] = __builtin_amdgcn_rcpf(li_l[crow(r, hi)]);
    {
        LAS unsigned char* ot = lds + wid * 8192;
#pragma unroll
        for (int r = 0; r < 16; ++r) { const int orow = crow(r, hi);
#pragma unroll
            for (int d0 = 0; d0 < 4; ++d0) *(LAS bf16_t*)(ot + orow * 256 + (d0 * 32 + r32) * 2) = f2bf(o[d0][r] * rli[r]); }
        asm volatile("s_waitcnt lgkmcnt(0)" ::: "memory");
        bf16_t* Ow = u.O + (size_t)(wid * QBLK) * u.ldo;
#pragma unroll
        for (int q = 0; q < 8; ++q) { const int orow = q * 4 + (lane >> 4), oc = (lane & 15) * 8;
            *(u32x4*)(Ow + (size_t)orow * u.ldo + oc) = *(const LAS u32x4*)(ot + orow * 256 + oc * 2); }
    }
    if (u.lse && hi == 0) u.lse[(size_t)(wid * QBLK + r32) * u.lse_stride] = m_reg * SCALE + __logf(l_reg);
    __syncthreads();
#undef KROW
#undef TVALID
#undef SLOAD
#undef SWRITE
#undef SWRITE_AT
#undef SWAIT
#undef RESC
}

__device__ __forceinline__ void band_body(const Unit& u, LAS unsigned char* lds, int wid) {
    const int lane = lane_id(), tid = wid * 64 + lane, r32 = lane & 31, hi = lane >> 5;
    LAS unsigned char* V_lds = lds; LAS unsigned char* K_lds = lds + 2 * SHM_V;
    LAS float* ws = (LAS float*)(lds + 2 * SHM_V + 2 * SHM_K) + wid * 64; LAS float* li_l = ws; LAS float* al_l = ws + 32;
    float m_reg = -1e30f, l_reg = 0; f32x16 o[4] = {}; bf16x8 qr[8];
    const bf16_t* Qw = u.Q + (size_t)(wid * QBLK + r32) * D + hi * 8;
#pragma unroll
    for (int d0 = 0; d0 < 8; ++d0) qr[d0] = *(const bf16x8*)(Qw + d0 * 16);
    const int sr = tid >> 4, sc = (tid & 15) * 8, vst0 = v_st(sr, sc), vst1 = v_st(32 + sr, sc);
    const int vb0 = (int)(unsigned)(uintptr_t)V_lds + v_rd_base(lane);
    const bf16_t* Kh = u.K; const bf16_t* Vh = u.V;
    const int dq = u.kt0 - (u.q0 + wid * QBLK + r32) + 4 * hi + 64;
    bf16x8 A_vs0, A_vs1, A_ks0, A_ks1, B_vs0, B_vs1, B_ks0, B_ks1, C_vs0, C_vs1, C_ks0, C_ks1;
#define KROW(j) ((u.kt0 + 64 * (j)) < u.klo ? u.klo : ((u.kt0 + 64 * (j)) > u.khi - 64 ? u.khi - 64 : (u.kt0 + 64 * (j))))
#define TVALID(j) ((u.kt0 + 64 * (j)) >= u.klo && (u.kt0 + 64 * (j)) < u.khi)
#define SLOAD(S, j) do { const int k0_ = KROW(j); S##vs0 = *(const bf16x8*)(&Vh[(size_t)(k0_ + sr) * D + sc]); S##vs1 = *(const bf16x8*)(&Vh[(size_t)(k0_ + 32 + sr) * D + sc]); \
    S##ks0 = *(const bf16x8*)(&Kh[(size_t)(k0_ + sr) * D + sc]); S##ks1 = *(const bf16x8*)(&Kh[(size_t)(k0_ + 32 + sr) * D + sc]); } while (0)
#define SWRITE(b, S) do { *(LAS bf16x8*)(V_lds + (b) * SHM_V + vst0) = S##vs0; *(LAS bf16x8*)(V_lds + (b) * SHM_V + vst1) = S##vs1; const int kc = sc * 2; \
    *(LAS bf16x8*)(K_lds + (b) * SHM_K + KSWZ(sr, kc)) = S##ks0; *(LAS bf16x8*)(K_lds + (b) * SHM_K + KSWZ(32 + sr, kc)) = S##ks1; } while (0)
    const int ja = (wid >> 1), jb = (wid >> 1) + 2;
#define BAND_ITER(j, STAGE) do { const int cur = (j) & 1; const bool act = ((j) >= ja) && ((j) <= jb); bf16x8 pa0, pa1, pa2, pa3; \
        if (act) { f32x16 p0, p1; float mn, al; \
            qkt(p0, p1, K_lds + cur * SHM_K, qr, r32, hi); \
            partialSM<true>(p0, p1, m_reg, mn, al, dq + 64 * (j), TVALID(j)); \
            if (__any(al < 1.f)) { if (hi == 0) al_l[r32] = al; asm volatile("s_waitcnt lgkmcnt(0)" ::: "memory"); \
                _Pragma("unroll") for (int d = 0; d < 4; ++d) _Pragma("unroll") for (int r = 0; r < 16; ++r) o[d][r] *= al_l[crow(r, hi)]; } \
            finishSM(p0, p1, al, l_reg, pa0, pa1, pa2, pa3); SBAR(); } \
        STAGE; SBAR(); \
        if (act) pv_d0(o, vb0 + cur * SHM_V, pa0, pa1, pa2, pa3); \
        __syncthreads(); } while (0)
    SLOAD(A_, 0); SLOAD(B_, 1); SLOAD(C_, 2);
    SWRITE(0, A_); SLOAD(A_, 3);
    __syncthreads();
    BAND_ITER(0, SWRITE(1, B_); SLOAD(B_, 4));
    BAND_ITER(1, SWRITE(0, C_); SLOAD(C_, 5));
    BAND_ITER(2, SWRITE(1, A_));
    BAND_ITER(3, SWRITE(0, B_));
    BAND_ITER(4, SWRITE(1, C_));
    BAND_ITER(5, (void)0);
#undef BAND_ITER
    if (hi == 0) li_l[r32] = l_reg; asm volatile("s_waitcnt lgkmcnt(0)" ::: "memory");
    float rli[16];
#pragma unroll
    for (int r = 0; r < 16; ++r) rli[r] = __builtin_amdgcn_rcpf(li_l[crow(r, hi)]);
    {
        LAS unsigned char* ot = lds + SHM_ATTN + 1024 + wid * 8192;
#pragma unroll
        for (int r = 0; r < 16; ++r) { const int orow = crow(r, hi);
#pragma unroll
            for (int d0 = 0; d0 < 4; ++d0) *(LAS bf16_t*)(ot + orow * 256 + (d0 * 32 + r32) * 2) = f2bf(o[d0][r] * rli[r]); }
        asm volatile("s_waitcnt lgkmcnt(0)" ::: "memory");
        bf16_t* Ow = u.O + (size_t)(wid * QBLK) * u.ldo;
#pragma unroll
        for (int q = 0; q < 8; ++q) { const int orow = q * 4 + (lane >> 4), oc = (lane & 15) * 8;
            *(u32x4*)(Ow + (size_t)orow * u.ldo + oc) = *(const LAS u32x4*)(ot + orow * 256 + oc * 2); }
    }
    if (hi == 0) u.lse[(size_t)(wid * QBLK + r32) * u.lse_stride] = m_reg * SCALE + __logf(l_reg);
    __syncthreads();
#undef KROW
#undef TVALID
#undef SLOAD
#undef SWRITE
}
}

#define XB_TMO      128
#define XB_XCNT(j)  (256  + 64 * (j))
#define XB_XSUB(j)  (1280 + 64 * (j))
#define XB_XGEN(j)  (2304 + 64 * (j))
#define XB_TOP      3328
#define XB_TOPGEN   3392
#define XCD_BAR_WORDS 3456
#define XB_SPIN_CAP (1u << 20)
__device__ __forceinline__ unsigned xb_ld(unsigned* p)              { return __hip_atomic_load(p, __ATOMIC_RELAXED, __HIP_MEMORY_SCOPE_AGENT); }
__device__ __forceinline__ unsigned xb_add(unsigned* p, unsigned v) { return __hip_atomic_fetch_add(p, v, __ATOMIC_RELAXED, __HIP_MEMORY_SCOPE_AGENT); }
__device__ __forceinline__ unsigned xb_xcc_id() { return (unsigned)__builtin_amdgcn_s_getreg((3 << 11) | 20) & 0xFu; }
#define XB_SPIN(cond, bar) do { unsigned _sp = 0; while (cond) { __builtin_amdgcn_s_sleep(1); \
    if ((++_sp & 255u) == 0u) { if (xb_ld(&(bar)[XB_TMO])) break; if (_sp > XB_SPIN_CAP) { atomicAdd(&(bar)[XB_TMO], 1u); break; } } } } while (0)
__device__ __forceinline__ void xcd_barrier_post(unsigned* bar, bool leader) { if (leader) (void)xb_add(&bar[XB_XCNT(xb_xcc_id())], 1u); }
__device__ __forceinline__ void xcd_barrier_complete(unsigned* bar, unsigned x, unsigned G, unsigned& nloc, unsigned& nx) {
    unsigned sum, cnt, mine, sp = 0u;
    for (;;) {
        sum = 0u; cnt = 0u; mine = 0u;
#pragma unroll
        for (unsigned j = 0; j < 16; ++j) { const unsigned c = xb_ld(&bar[XB_XCNT(j)]); sum += c; cnt += (c > 0u) ? 1u : 0u; mine = (j == x) ? c : mine; }
        if (sum == G) break;
        __builtin_amdgcn_s_sleep(1);
        if ((++sp & 255u) == 0u) { if (xb_ld(&bar[XB_TMO])) break; if (sp > XB_SPIN_CAP) { atomicAdd(&bar[XB_TMO], 1u); break; } }
    }
    nloc = mine > 0u ? mine : 1u; nx = cnt > 0u ? cnt : 1u;
}
__device__ __forceinline__ void xcd_barrier(unsigned* bar, unsigned* st, unsigned G, bool leader) {
    asm volatile("s_waitcnt vmcnt(0)" ::: "memory");
    __syncthreads();
    if (leader) {
        __builtin_amdgcn_s_waitcnt(0);
        const unsigned x = xb_xcc_id();
        unsigned nloc = xb_ld(st), nx = xb_ld(st + 1);
        if (nloc == 0u) { xcd_barrier_complete(bar, x, G, nloc, nx); __hip_atomic_store(st, nloc, __ATOMIC_RELAXED, __HIP_MEMORY_SCOPE_AGENT); __hip_atomic_store(st + 1, nx, __ATOMIC_RELAXED, __HIP_MEMORY_SCOPE_AGENT); }
        const unsigned old = xb_add(&bar[XB_XSUB(x)], 1u);
        const unsigned gen = old / nloc;
        if (old + 1u == (gen + 1u) * nloc) {
            __builtin_amdgcn_fence(__ATOMIC_RELEASE, "agent");
            asm volatile("s_waitcnt vmcnt(0)" ::: "memory");
            const unsigned og = xb_add(&bar[XB_TOP], 1u);
            const unsigned tg = og / nx;
            if (og + 1u == (tg + 1u) * nx) xb_add(&bar[XB_TOPGEN], 1u);
            else XB_SPIN(xb_ld(&bar[XB_TOPGEN]) == tg, bar);
            __builtin_amdgcn_fence(__ATOMIC_ACQUIRE, "agent");
            xb_add(&bar[XB_XGEN(x)], 1u);
            asm volatile("s_waitcnt vmcnt(0)" ::: "memory");
        } else {
            XB_SPIN(xb_ld(&bar[XB_XGEN(x)]) == gen, bar);
            __builtin_amdgcn_fence(__ATOMIC_ACQUIRE, "agent");
            asm volatile("s_waitcnt vmcnt(0)" ::: "memory");
        }
    }
    __syncthreads();
}

constexpr int RING_BYTES = 131072, EX_OFF = RING_BYTES, LDS_BYTES = 163840;
constexpr int NWAVES = 8;

struct Args {
    const float* in[18]; float* out; unsigned char* ws; int ph_lo, ph_hi; int use_bar, bar_region;
};

__device__ __forceinline__ void p0_transpose_item(const float* W, int K, int N, bf16_t* WT, int rowblk, int roff, LAS float* scr, int item, int lane) {
    const int nblk = N / 32, kb = item / nblk, nb = item % nblk, k0 = 64 * kb, n0 = 32 * nb;
#pragma unroll 8
    for (int i = 0; i < 32; ++i) { const int kk = 2 * i + (lane >> 5); scr[kk * 33 + (lane & 31)] = W[(size_t)(k0 + kk) * N + n0 + (lane & 31)]; }
    asm volatile("s_waitcnt lgkmcnt(0)" ::: "memory");
    const int c = lane & 7;
#pragma unroll
    for (int j = 0; j < 4; ++j) { const int nl = (lane >> 3) + 8 * j; const LAS float* s = scr + (8 * c) * 33 + nl; const int n = n0 + nl;
        u32x4 o; o.x = pk2(s[0 * 33], s[1 * 33]); o.y = pk2(s[2 * 33], s[3 * 33]); o.z = pk2(s[4 * 33], s[5 * 33]); o.w = pk2(s[6 * 33], s[7 * 33]);
        const int dr = (n >> 7) * rowblk + roff + (n & 127);
        *(u32x4*)(WT + (size_t)dr * K + k0 + 8 * c) = o; }
    asm volatile("s_waitcnt lgkmcnt(0)" ::: "memory");
}

template <int VAR>
__global__ void __launch_bounds__(NWAVES * 64, 2) mk_fwd(Args args) {
    extern __shared__ __attribute__((aligned(16))) unsigned char lds_raw[];
    LAS unsigned char* lds = (LAS unsigned char*)lds_raw;
    const int wave = __builtin_amdgcn_readfirstlane(threadIdx.x >> 6);
#define PHASE_IDS() const int lane = lane_id(), tid = wave * 64 + lane; (void)tid; const int gw = vcu * NWAVES + wave, NGW = G * NWAVES; (void)lane; (void)gw; (void)NGW
    const int G = gridDim.x, bx = blockIdx.x; const int vcu = (G % 8 == 0) ? (bx % 8) * (G / 8) + bx / 8 : bx;
    unsigned char* ws = args.ws;
    unsigned* ctl = (unsigned*)(ws + WS_CTL);
    if (args.use_bar) xcd_barrier_post((unsigned*)(args.ws + WS_CTL) + CW_BAR + args.bar_region * XCD_BAR_WORDS, wave == 0 && lane_id() == 0);
    if (args.use_bar == 12345) cooperative_groups::this_grid().sync();
#define GRID_BAR() do { if (args.use_bar) xcd_barrier((unsigned*)(args.ws + WS_CTL) + CW_BAR + args.bar_region * XCD_BAR_WORDS, (unsigned*)(args.ws + WS_CTL) + CW_WGST + args.bar_region * 32768 + 64 * (int)blockIdx.x, (unsigned)G, wave == 0 && lane_id() == 0); } while (0)
    const int lo = args.ph_lo, hi = args.ph_hi;
#ifndef MK_CMASK
#define MK_CMASK 0x1ff
#endif
#define IN(k) ((((MK_CMASK) >> (k)) & 1) && lo <= (k) && (k) < hi)
#define BOTH(k) (IN(k) && IN((k) + 1))

    if (IN(0)) {
        PHASE_IDS();
        const float* x = args.in[0];
        bf16_t* XB = (bf16_t*)(ws + WS_XB); bf16_t* WINT = (bf16_t*)(ws + WS_WINT); bf16_t* WAT = (bf16_t*)(ws + WS_WAT); bf16_t* WBT = (bf16_t*)(ws + WS_WBT); bf16_t* WOT = (bf16_t*)(ws + WS_WOT);
        bf16_t* WGUT = (bf16_t*)(ws + WS_WGUT); bf16_t* WDT = (bf16_t*)(ws + WS_WDT);
        LAS float* scr = (LAS float*)(lds + wave * 16384);
        constexpr int I_IN = (DM / 64) * (IN_COLS / 32), I_A = (1024 / 64) * (DM / 32), I_B = (DM / 64) * (DM / 32), I_O = I_B;
        constexpr int I_G = (DM / 64) * (FF / 32), I_D = (FF / 64) * (DM / 32);
        constexpr int NITEMS = I_IN + I_A + I_B + I_O + NEXP * (2 * I_G + I_D);
        for (int it = gw; it < I_IN + I_A + I_B + I_O; it += NGW) {
            int r = it;
            if (r < I_IN) { p0_transpose_item(args.in[1], DM, IN_COLS, WINT, 128, 0, scr, r, lane); continue; } r -= I_IN;
            if (r < I_A) { p0_transpose_item(args.in[4], 1024, DM, WAT, 128, 0, scr, r, lane); continue; } r -= I_A;
            if (r < I_B) { p0_transpose_item(args.in[5], DM, DM, WBT, 128, 0, scr, r, lane); continue; } r -= I_B;
            if (r < I_O) { p0_transpose_item(args.in[6], DM, DM, WOT, 128, 0, scr, r, lane); continue; } r -= I_O;
            const int e = r / (2 * I_G + I_D); r -= e * (2 * I_G + I_D);
            if (r < I_G) { p0_transpose_item(args.in[13] + (size_t)e * DM * FF, DM, FF, WGUT + (size_t)e * 2048 * DM, 256, 0, scr, r, lane); continue; } r -= I_G;
            if (r < I_G) { p0_transpose_item(args.in[14] + (size_t)e * DM * FF, DM, FF, WGUT + (size_t)e * 2048 * DM, 256, 128, scr, r, lane); continue; } r -= I_G;
            p0_transpose_item(args.in[15] + (size_t)e * FF * DM, FF, DM, WDT + (size_t)e * DM * FF, 128, 0, scr, r, lane);
        }
        for (int m = gw; m < NTOK; m += NGW) {
            const f32x4* xr = (const f32x4*)(x + (size_t)m * DM) + lane; u32x2* o8 = (u32x2*)(XB + (size_t)m * DM) + lane;
#pragma unroll
            for (int j = 0; j < 8; ++j) { const f32x4 v = xr[64 * j]; u32x2 w; w.x = pk2(v.x, v.y); w.y = pk2(v.z, v.w); o8[64 * j] = w; }
        }
        { float2* rt1 = (float2*)(ws + WS_RT1); float2* rt2 = (float2*)(ws + WS_RT2);
          for (int i = (vcu * NWAVES * 64) + tid; i < SEQ * 64; i += G * NWAVES * 64) { const int t = i >> 6, c = i & 63; float cs, sn;
              rope1(t, c, cs, sn); rt1[i] = make_float2(cs, sn); rope2(t, c, cs, sn); rt2[i] = make_float2(cs, sn); } }
        { float* wt = (float*)(ws + WS_WRT); const float* wgp = args.in[9]; const float* wrp = args.in[11];
          for (int i = (vcu * NWAVES * 64) + tid; i < 36 * DM; i += G * NWAVES * 64) { const int c = i >> 11, k = i & (DM - 1); wt[i] = (c < 4) ? wgp[(size_t)k * 4 + c] : wrp[(size_t)k * 32 + (c - 4)]; } }
        if (BOTH(0)) GRID_BAR();
    }

    if (IN(1)) {
        EpiProj E; E.ws = ws; E.qg = args.in[2]; E.kg = args.in[3];
        ProjSched S; S.o.init(NTOK, IN_COLS, G, bx); S.ws = (const char*)ws;
        pg8::gemm_phase<EpiProj, ProjSched, PG8_ALIGN, PG8_SP2>(lds, lds + EX_OFF, S, E, wave);
        if (BOTH(1)) GRID_BAR();
    }

    if (IN(2)) {
        if (VAR != 22) for (int i = 0; i < 2; ++i) {
            const int idx = bx + i * G; if (idx >= 512) break;
            const int bk = idx & 7, rest = idx >> 3, b = bk >> 2, kvh = bk & 3, hq = kvh * 4 + (rest & 3), qblk = rest >> 2;
            att::Unit u; u.Q = (const bf16_t*)(ws + WS_QB) + ((size_t)(b * 16 + hq) * SEQ + qblk * 256) * HD;
            u.K = (const bf16_t*)(ws + WS_KB) + (size_t)(b * 4 + kvh) * SEQ * HD; u.V = (const bf16_t*)(ws + WS_VB) + (size_t)(b * 4 + kvh) * SEQ * HD;
            u.O = (bf16_t*)(ws + WS_OB) + ((size_t)b * SEQ + qblk * 256) * 2048 + hq * HD; u.ldo = 2048; u.lse = nullptr; u.lse_stride = 0; u.nt = 64; u.kt0 = 0; u.klo = 0; u.khi = SEQ; u.q0 = 0;
            att::body(u, lds, wave);
        }
        if (VAR != 21) for (int i = 0; i < 3; ++i) {
            const int idx = bx + i * G; if (idx >= 768) break;
            const int sid = idx >> 4, qblk = idx & 15, g = sid >> 4, b = (sid >> 3) & 1, h = sid & 7, sh = 2 * g, L = SEQ >> sh;
            const int P0 = qblk * 256, r = P0 / L, p0 = P0 - r * L;
            att::Unit u; u.Q = (const bf16_t*)(ws + WS_QA) + ((size_t)sid * SEQ + P0) * HD; u.K = (const bf16_t*)(ws + WS_KA) + (size_t)sid * SEQ * HD; u.V = (const bf16_t*)(ws + WS_VA) + (size_t)sid * SEQ * HD;
            const size_t tok0 = (size_t)b * SEQ + ((size_t)p0 << sh) + r;
            u.O = (bf16_t*)(ws + WS_OAG) + ((size_t)g * NTOK + tok0) * 1024 + h * HD; u.ldo = 1024 << sh;
            u.lse = (float*)(ws + WS_LSE) + ((size_t)g * NTOK + tok0) * 8 + h; u.lse_stride = 8 << sh;
            u.nt = 6; u.kt0 = P0 - 64; u.klo = r * L; u.khi = r * L + L; u.q0 = P0;
            att::band_body(u, lds, wave);
        }
        GRID_BAR();
        {
            PHASE_IDS();
            const bf16_t* oag = (const bf16_t*)(ws + WS_OAG); const float* lse = (const float*)(ws + WS_LSE); bf16_t* oa = (bf16_t*)(ws + WS_OA);
            for (int m = gw; m < NTOK; m += NGW) { const int c = lane * 16, h = lane >> 3;
                const float l0 = lse[(0 * (size_t)NTOK + m) * 8 + h], l1 = lse[(1 * (size_t)NTOK + m) * 8 + h], l2 = lse[(2 * (size_t)NTOK + m) * 8 + h];
                const float mx = fmaxf(l0, fmaxf(l1, l2)); float e0 = __expf(l0 - mx), e1 = __expf(l1 - mx), e2 = __expf(l2 - mx); const float inv = 1.0f / (e0 + e1 + e2); e0 *= inv; e1 *= inv; e2 *= inv;
#pragma unroll
                for (int q = 0; q < 2; ++q) { const u32x4 a = *(const u32x4*)(oag + (0 * (size_t)NTOK + m) * 1024 + c + 8 * q), bq = *(const u32x4*)(oag + (1 * (size_t)NTOK + m) * 1024 + c + 8 * q), cq = *(const u32x4*)(oag + (2 * (size_t)NTOK + m) * 1024 + c + 8 * q);
                    u32x4 w;
#pragma unroll
                    for (int k = 0; k < 4; ++k) w[k] = cvtpk(e0 * bflo(a[k]) + e1 * bflo(bq[k]) + e2 * bflo(cq[k]), e0 * bfhi(a[k]) + e1 * bfhi(bq[k]) + e2 * bfhi(cq[k]));
                    *(u32x4*)(oa + (size_t)m * 1024 + c + 8 * q) = w; } }
        }
        if (BOTH(2)) GRID_BAR();
    }

    if (IN(3) || IN(4)) {
        EpiMix E; E.ws = ws; E.x = args.in[0];
        MixSched S; S.c = vcu; S.ws = (const char*)ws;
        if (IN(3)) { S.mode = 0; pg8::gemm_phase<EpiMix, MixSched, false, PG8_SP2>(lds, lds + EX_OFF, S, E, wave); if (BOTH(3)) GRID_BAR(); }
        if (IN(4)) { S.mode = 1; pg8::gemm_phase<EpiMix, MixSched, false, PG8_SP2>(lds, lds + EX_OFF, S, E, wave); if (BOTH(4)) GRID_BAR(); }
    }

    if (IN(5)) {
        PHASE_IDS();
        RouteArgs ra; ra.g = args.in[7]; ra.b = args.in[8]; ra.h1 = (float*)(ws + WS_H1); ra.h1b = (bf16_t*)(ws + WS_H1B); ra.wg = args.in[9]; ra.bg = args.in[10]; ra.wr = args.in[11]; ra.br = args.in[12];
        ra.cnt = ctl + CW_CNT; ra.tokidx = (int*)(ws + WS_TOKIDX); ra.slot = (int*)(ws + WS_SLOT); ra.wt = (const float*)(ws + WS_WRT); ra.lnst = (float2*)(ws + WS_LNST);
        LAS unsigned* hist = (LAS unsigned*)lds; LAS unsigned* basev = hist + 32; LAS int* rinfo = (LAS int*)(lds + 256);
        if (tid < 64) hist[tid] = 0u;
        __syncthreads();
        static_assert(NTOK == 4 * 256 * NWAVES, "P5 assumes 4 rows per wave on a 256-workgroup grid");
#pragma unroll 1
        for (int ps = 0; ps < 2; ++ps) ln1_route_rows<2, VAR>((const float*)(ws + WS_PRE1), ra, gw + 2 * ps * NGW, NGW, lane_id(), hist, rinfo, wave * 4 + 2 * ps, 1);
        __syncthreads();
        if (tid < 32) { const unsigned h = hist[tid]; if (h) basev[tid] = atomicAdd(ra.cnt + tid, h); }
        __syncthreads();
        if (tid < 32) { const LAS int* ri = rinfo + tid * 8; const int ex1 = ri[0], ex2 = ri[1], m = ri[6]; const int p1 = (int)basev[ex1] + ri[2], p2 = (int)basev[ex2] + ri[3];
            ra.tokidx[ex1 * ECAP + p1] = m; ra.tokidx[ex2 * ECAP + p2] = m;
            int* sl = ra.slot + (size_t)m * 6; sl[0] = ex1; sl[1] = ex2; sl[2] = p1; sl[3] = p2; sl[4] = ri[4]; sl[5] = ri[5]; }
        if (BOTH(5)) GRID_BAR();
    }

    if (IN(6) || IN(7)) {
        MoeSched2 S; S.var = VAR; S.G = G; S.vcu = vcu; S.ws = (const char*)ws; S.wgate = args.in[13]; S.wup = args.in[14]; S.wdown = args.in[15];
        S.init(ctl + CW_CNT, lane_id());
        EpiMoe2 E; E.ws = ws;
        if (IN(6)) { S.down = 0; E.down = 0; mg::gemm_phase<MoeSched2, EpiMoe2, VAR>(lds, S, E, wave); if (BOTH(6)) GRID_BAR(); }
        if (IN(7)) { S.down = 1; E.down = 1; mg::gemm_phase<MoeSched2, EpiMoe2, VAR>(lds, S, E, wave); if (BOTH(7)) GRID_BAR(); }
    }

    if (IN(8)) {
        PHASE_IDS();
        P8Args pa; pa.h1 = (const float*)(ws + WS_H1); pa.y = (const bf16_t*)(ws + WS_Y); pa.cnt = ctl + CW_CNT; pa.slot = (const int*)(ws + WS_SLOT); pa.g = args.in[16]; pa.b = args.in[17]; pa.out = args.out;
        unsigned c = 0; if (lane < NEXP) c = __hip_atomic_load(ctl + CW_CNT + lane, __ATOMIC_RELAXED, __HIP_MEMORY_SCOPE_AGENT);
        unsigned t = (c + 255u) >> 8, inc = t;
#pragma unroll
        for (int o = 1; o < 32; o <<= 1) { const unsigned v = __shfl_up(inc, o); if ((lane & 31) >= o) inc += v; }
        const unsigned tpe = inc - t;
        for (int m = gw; m < NTOK; m += NGW) {
            const int* sl = pa.slot + (size_t)m * 6; const int e1 = sl[0], e2 = sl[1], p1 = sl[2], p2 = sl[3]; const float w1 = ((const float*)sl)[4], w2 = ((const float*)sl)[5];
            const size_t r1 = (size_t)__shfl(tpe, e1) * 256 + p1, r2 = (size_t)__shfl(tpe, e2) * 256 + p2;
            final_row_t(pa, (const float*)(ws + WS_PRE1), (const float2*)(ws + WS_LNST), args.in[7], args.in[8], m, lane_id(), r1, r2, w1, w2);
        }
    }
#undef IN
#undef BOTH
#undef GRID_BAR
}

extern "C" void kernel_launch(void* const* d_in, const int* in_sizes, int n_in, void* d_out, int out_size, void* d_ws, size_t ws_size, hipStream_t stream) {
    static int grid = 0;
    if (grid == 0) {
        if (n_in != 18 || in_sizes[0] != NTOK * DM || out_size != NTOK * DM || ws_size < WS_END) { fprintf(stderr, "kernel_launch: unexpected shapes (n_in %d, in0 %d, out %d, ws %zu)\n", n_in, n_in > 0 ? in_sizes[0] : -1, out_size, ws_size); grid = -1; return; }
        int dev = 0, cus = 0, per_cu = 0;
        if (hipGetDevice(&dev) != hipSuccess || hipDeviceGetAttribute(&cus, hipDeviceAttributeMultiprocessorCount, dev) != hipSuccess) { fprintf(stderr, "kernel_launch: device query failed\n"); grid = -1; return; }
        if (hipFuncSetAttribute((const void*)mk_fwd<0>, hipFuncAttributeMaxDynamicSharedMemorySize, LDS_BYTES) != hipSuccess || hipFuncSetAttribute((const void*)mk_fwd<MK_EXTRA_VAR>, hipFuncAttributeMaxDynamicSharedMemorySize, LDS_BYTES) != hipSuccess) { fprintf(stderr, "kernel_launch: hipFuncSetAttribute failed\n"); grid = -1; return; }
        if (hipOccupancyMaxActiveBlocksPerMultiprocessor(&per_cu, (const void*)mk_fwd<0>, NWAVES * 64, LDS_BYTES) != hipSuccess || per_cu < 1) { fprintf(stderr, "kernel_launch: occupancy query says %d blocks per CU\n", per_cu); per_cu = 1; }
        (void)hipGetLastError();
        grid = cus * 1;
        fprintf(stderr, "kernel_launch: grid %d (cus %d, occupancy %d)\n", grid, cus, per_cu);
    }
    if (grid < 0) return;
    unsigned char* ws = (unsigned char*)d_ws;
    (void)hipMemsetAsync(ws + WS_CTL, 0, 1 * MiB, stream);
    Args a{};
    for (int i = 0; i < 18; ++i) a.in[i] = (const float*)d_in[i];
    a.out = (float*)d_out; a.ws = ws;
    const float* x = a.in[0];
    bf16_t* XB = (bf16_t*)(ws + WS_XB); bf16_t* WINT = (bf16_t*)(ws + WS_WINT); bf16_t* WAT = (bf16_t*)(ws + WS_WAT); bf16_t* WBT = (bf16_t*)(ws + WS_WBT); bf16_t* WOT = (bf16_t*)(ws + WS_WOT);
    bf16_t* WGUT = (bf16_t*)(ws + WS_WGUT); bf16_t* WDT = (bf16_t*)(ws + WS_WDT);
    unsigned* ctl = (unsigned*)(ws + WS_CTL);
    auto launch_mk = [&](int lo, int hi, int use_bar, bool extra = false) {
        a.ph_lo = lo; a.ph_hi = hi; a.use_bar = use_bar;
        void* kargs[] = {&a};
        hipError_t e = hipLaunchCooperativeKernel(extra ? (const void*)mk_fwd<MK_EXTRA_VAR> : (const void*)mk_fwd<0>, dim3(grid), dim3(NWAVES * 64), kargs, LDS_BYTES, stream);
        if (e != hipSuccess) fprintf(stderr, "kernel_launch: cooperative launch failed: %s (grid %d)\n", hipGetErrorString(e), grid);
    };
    if (MK_ONE_LAUNCH && MK_FAST_MASK == 0x1ff) { launch_mk(0, NPHASE, 1);
        if (MK_EXTRA_PHASE >= 0) { a.bar_region = 1; launch_mk(MK_EXTRA_PHASE, MK_EXTRA_PHASE + 1, 1, true); }
        return; }
    for (int ph = 0; ph < NPHASE; ++ph) {
        if ((MK_FAST_MASK >> ph) & 1) { launch_mk(ph, ph + 1, (ph == 2) ? 1 : 0); continue; }
        switch (ph) {
        case 0:
            hipLaunchKernelGGL(k_cvt, dim3(2048), dim3(256), 0, stream, x, XB, (size_t)NTOK * DM / 8);
            hipLaunchKernelGGL(k_transpose, dim3(IN_COLS / 32, DM / 32, 1), dim3(256), 0, stream, a.in[1], WINT, DM, IN_COLS, 128, 0, (size_t)0, (size_t)0);
            hipLaunchKernelGGL(k_transpose, dim3(DM / 32, 1024 / 32, 1), dim3(256), 0, stream, a.in[4], WAT, 1024, DM, 128, 0, (size_t)0, (size_t)0);
            hipLaunchKernelGGL(k_transpose, dim3(DM / 32, DM / 32, 1), dim3(256), 0, stream, a.in[5], WBT, DM, DM, 128, 0, (size_t)0, (size_t)0);
            hipLaunchKernelGGL(k_transpose, dim3(DM / 32, DM / 32, 1), dim3(256), 0, stream, a.in[6], WOT, DM, DM, 128, 0, (size_t)0, (size_t)0);
            hipLaunchKernelGGL(k_transpose, dim3(FF / 32, DM / 32, NEXP), dim3(256), 0, stream, a.in[13], WGUT, DM, FF, 256, 0, (size_t)DM * FF, (size_t)2048 * DM);
            hipLaunchKernelGGL(k_transpose, dim3(FF / 32, DM / 32, NEXP), dim3(256), 0, stream, a.in[14], WGUT, DM, FF, 256, 128, (size_t)DM * FF, (size_t)2048 * DM);
            hipLaunchKernelGGL(k_transpose, dim3(DM / 32, FF / 32, NEXP), dim3(256), 0, stream, a.in[15], WDT, FF, DM, 128, 0, (size_t)FF * DM, (size_t)DM * FF);
            hipLaunchKernelGGL(k_ropetab, dim3(SEQ * 64 / 256), dim3(256), 0, stream, (float2*)(ws + WS_RT1), (float2*)(ws + WS_RT2));
            break;
        case 1: { P1Args p1{}; p1.xb = XB; p1.wint = WINT; p1.qg = a.in[2]; p1.kg = a.in[3]; p1.qa = (bf16_t*)(ws + WS_QA); p1.ka = (bf16_t*)(ws + WS_KA); p1.va = (bf16_t*)(ws + WS_VA);
            p1.qb = (bf16_t*)(ws + WS_QB); p1.kb = (bf16_t*)(ws + WS_KB); p1.vb = (bf16_t*)(ws + WS_VB); p1.gates = (bf16_t*)(ws + WS_GATES);
            hipLaunchKernelGGL(k_proj, dim3(IN_COLS / 128, NTOK / 64), dim3(256), 0, stream, p1); } break;
        case 2: { P2Args p2b{}; p2b.q = (bf16_t*)(ws + WS_QB); p2b.k = (bf16_t*)(ws + WS_KB); p2b.v = (bf16_t*)(ws + WS_VB); p2b.o = (bf16_t*)(ws + WS_OB); p2b.lse = nullptr; p2b.mode = 0;
            hipLaunchKernelGGL(k_attn, dim3(SEQ / 64, 32), dim3(128), 0, stream, p2b);
            P2Args p2a{}; p2a.q = (bf16_t*)(ws + WS_QA); p2a.k = (bf16_t*)(ws + WS_KA); p2a.v = (bf16_t*)(ws + WS_VA); p2a.o = (bf16_t*)(ws + WS_OAG); p2a.lse = (float*)(ws + WS_LSE); p2a.mode = 1;
            hipLaunchKernelGGL(k_attn, dim3(SEQ / 64, 48), dim3(128), 0, stream, p2a);
            hipLaunchKernelGGL(k_merge, dim3(NTOK * 1024 / 256), dim3(256), 0, stream, (const bf16_t*)(ws + WS_OAG), (const float*)(ws + WS_LSE), (bf16_t*)(ws + WS_OA)); } break;
        case 3: case 4: { P3Args p3{}; p3.gates = (bf16_t*)(ws + WS_GATES); p3.T = (float*)(ws + WS_T); p3.merged = (bf16_t*)(ws + WS_MERGED); p3.x = x; p3.pre1 = (float*)(ws + WS_PRE1);
            if (ph == 3) { p3.A = (bf16_t*)(ws + WS_OA); p3.Bt = WAT; p3.K = 1024; p3.mode = 0;
                hipLaunchKernelGGL(k_gemm3, dim3(DM / 128, NTOK / 64), dim3(256), 0, stream, p3);
                p3.A = (bf16_t*)(ws + WS_OB); p3.Bt = WBT; p3.K = 2048; p3.mode = 1;
                hipLaunchKernelGGL(k_gemm3, dim3(DM / 128, NTOK / 64), dim3(256), 0, stream, p3); }
            else { p3.A = p3.merged; p3.Bt = WOT; p3.K = 2048; p3.mode = 2; hipLaunchKernelGGL(k_gemm3, dim3(DM / 128, NTOK / 64), dim3(256), 0, stream, p3); } } break;
        case 5: { RouteArgs ra{}; ra.g = a.in[7]; ra.b = a.in[8]; ra.h1 = (float*)(ws + WS_H1); ra.h1b = (bf16_t*)(ws + WS_H1B); ra.wg = a.in[9]; ra.bg = a.in[10]; ra.wr = a.in[11]; ra.br = a.in[12];
            ra.cnt = ctl + CW_CNT; ra.tokidx = (int*)(ws + WS_TOKIDX); ra.slot = (int*)(ws + WS_SLOT);
            hipLaunchKernelGGL(k_ln1_route, dim3(NTOK / 4), dim3(256), 0, stream, (const float*)(ws + WS_PRE1), ra); } break;
        case 6: case 7: { P6Args p6{}; p6.h1b = (bf16_t*)(ws + WS_H1B); p6.wgut = WGUT; p6.wdt = WDT; p6.cnt = ctl + CW_CNT; p6.tokidx = (int*)(ws + WS_TOKIDX); p6.act = (bf16_t*)(ws + WS_ACT); p6.y = (bf16_t*)(ws + WS_Y);
            if (ph == 6) hipLaunchKernelGGL(k_moe_up, dim3(FF / 128, 24576 / 64), dim3(256), 0, stream, p6);
            else hipLaunchKernelGGL(k_moe_down, dim3(DM / 128, 24576 / 64), dim3(256), 0, stream, p6); } break;
        case 8: { P8Args p8{}; p8.h1 = (float*)(ws + WS_H1); p8.y = (bf16_t*)(ws + WS_Y); p8.cnt = ctl + CW_CNT; p8.slot = (int*)(ws + WS_SLOT); p8.g = a.in[16]; p8.b = a.in[17]; p8.out = (float*)d_out;
            hipLaunchKernelGGL(k_final, dim3(NTOK / 4), dim3(256), 0, stream, p8); } break;
        }
    }
}
```

```cpp
#include <hip/hip_runtime.h>
#include <hip/hip_cooperative_groups.h>
#include <cstdio>
#include <cstdint>

typedef unsigned short bf16_t;
typedef short bf16x8 __attribute__((ext_vector_type(8)));
typedef short s16x4 __attribute__((ext_vector_type(4)));
typedef float f32x4 __attribute__((ext_vector_type(4)));
typedef float f32x16 __attribute__((ext_vector_type(16)));
typedef unsigned u32x4 __attribute__((ext_vector_type(4)));
typedef unsigned u32x2 __attribute__((ext_vector_type(2)));
#define LAS __attribute__((address_space(3)))

#ifndef MK_FAST_MASK
#define MK_FAST_MASK 0x1ff
#endif
#ifndef MK_ONE_LAUNCH
#define MK_ONE_LAUNCH 1
#endif
#ifndef MK_EXTRA_PHASE
#define MK_EXTRA_PHASE -1
#endif
#ifndef MK_EXTRA_VAR
#define MK_EXTRA_VAR 0
#endif
#ifndef PG8_SP2
#define PG8_SP2 true
#endif
#ifndef PG8_ALIGN
#define PG8_ALIGN true
#endif

constexpr int NTOK = 8192, SEQ = 4096, DM = 2048, HD = 128;
constexpr int IN_COLS = 16384;
constexpr int NEXP = 32, FF = 1024;
constexpr float ALPHA = 1.189207115002721f;
constexpr float LN_EPS = 1e-5f, RMS_EPS = 1e-6f;
constexpr float SM_SCALE = 0.08838834764831845f;
constexpr int ECAP = 8192;
constexpr int NPHASE = 9;

constexpr size_t MiB = 1u << 20;
constexpr size_t WS_CTL = 0;
constexpr size_t WS_WGUT = 1 * MiB;
constexpr size_t WS_WDT = 257 * MiB;
constexpr size_t WS_WAT = 385 * MiB;
constexpr size_t WS_WBT = 389 * MiB;
constexpr size_t WS_WOT = 397 * MiB;
constexpr size_t WS_XB = 405 * MiB;
constexpr size_t WS_WINT = 437 * MiB;
constexpr size_t WS_QA = 501 * MiB;
constexpr size_t WS_KA = 549 * MiB;
constexpr size_t WS_VA = 597 * MiB;
constexpr size_t WS_QB = 645 * MiB;
constexpr size_t WS_KB = 677 * MiB;
constexpr size_t WS_VB = 685 * MiB;
constexpr size_t WS_GATES = 693 * MiB;
constexpr size_t WS_OAG = 757 * MiB;
constexpr size_t WS_LSE = 805 * MiB;
constexpr size_t WS_OA = 806 * MiB;
constexpr size_t WS_OB = 822 * MiB;
constexpr size_t WS_T = 405 * MiB;
constexpr size_t WS_MERGED = 469 * MiB;
constexpr size_t WS_PRE1 = 501 * MiB;
constexpr size_t WS_H1 = 565 * MiB;
constexpr size_t WS_H1B = 629 * MiB;
constexpr size_t WS_TOKIDX = 661 * MiB;
constexpr size_t WS_LNST = 663 * MiB;
constexpr size_t WS_SLOT = 662 * MiB;
constexpr size_t WS_ACT = 693 * MiB;
constexpr size_t WS_Y = 757 * MiB;
constexpr size_t WS_RT1 = 854 * MiB;
constexpr size_t WS_RT2 = 856 * MiB;
constexpr size_t WS_WRT = 858 * MiB;
constexpr size_t WS_END = 859 * MiB;
constexpr int CW_CNT = 64;
constexpr int CW_BAR = 4096;
constexpr int CW_WGST = 65536;

__device__ __forceinline__ float bf2f(bf16_t v) { return __uint_as_float(((unsigned)v) << 16); }
__device__ __forceinline__ bf16_t f2bf(float f) { unsigned u = __float_as_uint(f); u += 0x7fffu + ((u >> 16) & 1u); return (bf16_t)(u >> 16); }
__device__ __forceinline__ unsigned pk2(float lo, float hi) { return (unsigned)f2bf(lo) | ((unsigned)f2bf(hi) << 16); }
__device__ __forceinline__ unsigned cvtpk(float lo, float hi) { unsigned r; asm volatile("v_cvt_pk_bf16_f32 %0, %1, %2" : "=v"(r) : "v"(lo), "v"(hi)); return r; }
__device__ __forceinline__ float wave_sum(float v) {
#pragma unroll
    for (int o = 1; o < 64; o <<= 1) v += __shfl_xor(v, o);
    return v;
}
__device__ __forceinline__ int lane_id() { int l; asm volatile("v_mbcnt_lo_u32_b32 %0, -1, 0\n\tv_mbcnt_hi_u32_b32 %0, -1, %0" : "=v"(l)); return l; }
__device__ __forceinline__ float bflo(unsigned w) { return __uint_as_float(w << 16); }
__device__ __forceinline__ float bfhi(unsigned w) { return __uint_as_float(w & 0xffff0000u); }

__device__ const float INV64[64] = {
    1.000000000e+00f, 8.659643234e-01f, 7.498942093e-01f, 6.493816316e-01f, 5.623413252e-01f, 4.869675252e-01f, 4.216965034e-01f, 3.651741273e-01f,
    3.162277660e-01f, 2.738419634e-01f, 2.371373706e-01f, 2.053525026e-01f, 1.778279410e-01f, 1.539926526e-01f, 1.333521432e-01f, 1.154781985e-01f,
    1.000000000e-01f, 8.659643234e-02f, 7.498942093e-02f, 6.493816316e-02f, 5.623413252e-02f, 4.869675252e-02f, 4.216965034e-02f, 3.651741273e-02f,
    3.162277660e-02f, 2.738419634e-02f, 2.371373706e-02f, 2.053525026e-02f, 1.778279410e-02f, 1.539926526e-02f, 1.333521432e-02f, 1.154781985e-02f,
    1.000000000e-02f, 8.659643234e-03f, 7.498942093e-03f, 6.493816316e-03f, 5.623413252e-03f, 4.869675252e-03f, 4.216965034e-03f, 3.651741273e-03f,
    3.162277660e-03f, 2.738419634e-03f, 2.371373706e-03f, 2.053525026e-03f, 1.778279410e-03f, 1.539926526e-03f, 1.333521432e-03f, 1.154781985e-03f,
    1.000000000e-03f, 8.659643234e-04f, 7.498942093e-04f, 6.493816316e-04f, 5.623413252e-04f, 4.869675252e-04f, 4.216965034e-04f, 3.651741273e-04f,
    3.162277660e-04f, 2.738419634e-04f, 2.371373706e-04f, 2.053525026e-04f, 1.778279410e-04f, 1.539926526e-04f, 1.333521432e-04f, 1.154781985e-04f};

__device__ __forceinline__ void cs_angle(float ang, float& c, float& s) {
    const double a = (double)ang * 0.15915494309189535;
    const float f = (float)(a - floor(a));
    s = __builtin_amdgcn_sinf(f); c = __builtin_amdgcn_cosf(f);
}
__device__ __forceinline__ void rope1(int t, int i, float& c, float& s) { cs_angle((float)t * INV64[i], c, s); }
__device__ __forceinline__ void rope2(int t, int i, float& c, float& s) {
    const float p = (i < 32) ? (float)(t >> 6) : (float)(t & 63);
    cs_angle(p * INV64[2 * (i & 31)], c, s);
}
__device__ __forceinline__ int perm_pos(int g, int t) { const int sh = 2 * g; const int d = 1 << sh; return (t & (d - 1)) * (SEQ >> sh) + (t >> sh); }

__global__ void __launch_bounds__(256) k_cvt(const float* __restrict__ x, bf16_t* __restrict__ xb, size_t n8) {
    for (size_t i = (size_t)blockIdx.x * 256 + threadIdx.x; i < n8; i += (size_t)gridDim.x * 256) {
        const f32x4 a = *(const f32x4*)(x + i * 8), b = *(const f32x4*)(x + i * 8 + 4);
        u32x4 w; w.x = pk2(a.x, a.y); w.y = pk2(a.z, a.w); w.z = pk2(b.x, b.y); w.w = pk2(b.z, b.w);
        *(u32x4*)(xb + i * 8) = w;
    }
}
__global__ void __launch_bounds__(256) k_transpose(const float* __restrict__ src, bf16_t* __restrict__ dst, int K, int N, int rowblk, int roff, size_t sstride, size_t dstride) {
    __shared__ float tile[32][33];
    const float* s = src + (size_t)blockIdx.z * sstride; bf16_t* d = dst + (size_t)blockIdx.z * dstride;
    const int n0 = blockIdx.x * 32, k0 = blockIdx.y * 32, tx = threadIdx.x & 31, ty = threadIdx.x >> 5;
    for (int i = ty; i < 32; i += 8) tile[i][tx] = s[(size_t)(k0 + i) * N + n0 + tx];
    __syncthreads();
    for (int i = ty; i < 32; i += 8) { const int n = n0 + i; const int dr = (n >> 7) * rowblk + roff + (n & 127); d[(size_t)dr * K + k0 + tx] = f2bf(tile[tx][i]); }
}
__global__ void __launch_bounds__(256) k_ropetab(float2* rt1, float2* rt2) {
    const int i = blockIdx.x * 256 + threadIdx.x; const int t = i >> 6, c = i & 63; float cs, sn;
    rope1(t, c, cs, sn); rt1[i] = make_float2(cs, sn); rope2(t, c, cs, sn); rt2[i] = make_float2(cs, sn);
}
__device__ __forceinline__ void wave_gemm16x128(const bf16_t* arow, const bf16_t* bt, int ldb, int K, f32x4 (&acc)[8]) {
    const int lane = threadIdx.x & 63, fr = lane & 15, fq = lane >> 4;
    const bf16_t* ap = arow + fq * 8;
    const bf16_t* bp = bt + (size_t)fr * ldb + fq * 8;
    for (int k = 0; k < K; k += 32) {
        const bf16x8 a = *(const bf16x8*)(ap + k);
#pragma unroll
        for (int j = 0; j < 8; ++j) { const bf16x8 b = *(const bf16x8*)(bp + (size_t)j * 16 * ldb + k); acc[j] = __builtin_amdgcn_mfma_f32_16x16x32_bf16(a, b, acc[j], 0, 0, 0); }
    }
}
struct P1Args { const bf16_t* xb; const bf16_t* wint; const float* qg; const float* kg; bf16_t *qa, *ka, *va, *qb, *kb, *vb, *gates; };
__global__ void __launch_bounds__(256) k_proj(P1Args a) {
    const int wave = threadIdx.x >> 6, lane = threadIdx.x & 63, fr = lane & 15, fq = lane >> 4;
    const int ng = blockIdx.x, mt = blockIdx.y * 4 + wave;
    f32x4 acc[8];
#pragma unroll
    for (int j = 0; j < 8; ++j) acc[j] = (f32x4){0.f, 0.f, 0.f, 0.f};
    wave_gemm16x128(a.xb + (size_t)(mt * 16 + fr) * DM, a.wint + (size_t)ng * 128 * DM, DM, DM, acc);
#pragma unroll
    for (int r = 0; r < 4; ++r) {
        const int m = mt * 16 + fq * 4 + r, b = m >> 12, t = m & 4095;
        if (ng < 72) {
            const int which = ng / 24, hh = ng % 24, g = hh >> 3, h = hh & 7;
            bf16_t* base = (which == 0 ? a.qa : (which == 1 ? a.ka : a.va)) + ((size_t)((g * 2 + b) * 8 + h) * SEQ + perm_pos(g, t)) * HD;
#pragma unroll
            for (int j = 0; j < 4; ++j) { const int c = 16 * j + fr; float x1 = acc[j][r], x2 = acc[j + 4][r];
                if (which < 2) { float cs, sn; rope1(t, c, cs, sn); const float y1 = x1 * cs - x2 * sn, y2 = x2 * cs + x1 * sn; x1 = y1; x2 = y2; }
                base[c] = f2bf(x1); base[c + 64] = f2bf(x2); }
        } else if (ng < 96) {
            const int k = ng - 72;
            if (k < 20) {
                float ss = 0.f;
#pragma unroll
                for (int j = 0; j < 8; ++j) ss += acc[j][r] * acc[j][r];
                ss += __shfl_xor(ss, 1); ss += __shfl_xor(ss, 2); ss += __shfl_xor(ss, 4); ss += __shfl_xor(ss, 8);
                const float rinv = 1.0f / sqrtf(ss * (1.0f / 128.0f) + RMS_EPS);
                const float* gn = (k < 16) ? a.qg : a.kg;
                bf16_t* base = (k < 16) ? a.qb + ((size_t)(b * 16 + k) * SEQ + t) * HD : a.kb + ((size_t)(b * 4 + (k - 16)) * SEQ + t) * HD;
#pragma unroll
                for (int j = 0; j < 4; ++j) { const int c = 16 * j + fr; const float x1 = acc[j][r] * rinv * gn[c], x2 = acc[j + 4][r] * rinv * gn[c + 64];
                    float cs, sn; rope2(t, c, cs, sn); base[c] = f2bf(x1 * cs - x2 * sn); base[c + 64] = f2bf(x2 * cs + x1 * sn); }
            } else {
                bf16_t* base = a.vb + ((size_t)(b * 4 + (k - 20)) * SEQ + t) * HD;
#pragma unroll
                for (int j = 0; j < 8; ++j) base[16 * j + fr] = f2bf(acc[j][r]);
            }
        } else {
            bf16_t* base = a.gates + (size_t)m * 4096 + (ng - 96) * 128;
#pragma unroll
            for (int j = 0; j < 8; ++j) base[16 * j + fr] = f2bf(1.0f / (1.0f + __expf(-acc[j][r])));
        }
    }
}
struct P2Args { const bf16_t *q, *k, *v; bf16_t* o; float* lse; int mode; };
__global__ void __launch_bounds__(128) k_attn(P2Args a) {
    const int half = threadIdx.x & 1, qi = blockIdx.x * 64 + (threadIdx.x >> 1), sid = blockIdx.y;
    const bf16_t *Q, *K, *V; int k_lo, k_hi;
    if (a.mode == 0) { const int b = sid >> 4, hq = sid & 15; Q = a.q + (size_t)sid * SEQ * HD; K = a.k + (size_t)(b * 4 + (hq >> 2)) * SEQ * HD; V = a.v + (size_t)(b * 4 + (hq >> 2)) * SEQ * HD; k_lo = 0; k_hi = SEQ - 1; }
    else { const int g = sid >> 4; const int L = SEQ >> (2 * g); Q = a.q + (size_t)sid * SEQ * HD; K = a.k + (size_t)sid * SEQ * HD; V = a.v + (size_t)sid * SEQ * HD;
        const int r0 = (qi / L) * L, p = qi - r0; k_lo = r0 + (p - 64 > 0 ? p - 64 : 0); k_hi = r0 + (p + 64 < L - 1 ? p + 64 : L - 1); }
    float q[64], o[64];
    { const bf16_t* qp = Q + (size_t)qi * HD + half * 64;
#pragma unroll
      for (int d = 0; d < 64; ++d) { q[d] = bf2f(qp[d]) * SM_SCALE; o[d] = 0.f; } }
    float m = -1e30f, l = 0.f;
    for (int kk = k_lo; kk <= k_hi; ++kk) {
        const bf16_t* kp = K + (size_t)kk * HD + half * 64; const bf16_t* vp = V + (size_t)kk * HD + half * 64;
        float s = 0.f;
#pragma unroll
        for (int d = 0; d < 64; ++d) s += q[d] * bf2f(kp[d]);
        s += __shfl_xor(s, 1);
        const float mn = fmaxf(m, s), al = __expf(m - mn), p = __expf(s - mn);
        l = l * al + p; m = mn;
#pragma unroll
        for (int d = 0; d < 64; ++d) o[d] = o[d] * al + p * bf2f(vp[d]);
    }
    const float rl = 1.0f / l;
    if (a.mode == 0) { const int b = sid >> 4, hq = sid & 15; bf16_t* op = a.o + (size_t)(b * SEQ + qi) * 2048 + hq * HD + half * 64;
#pragma unroll
        for (int d = 0; d < 64; ++d) op[d] = f2bf(o[d] * rl); }
    else { const int g = sid >> 4, b = (sid >> 3) & 1, h = sid & 7; const int sh = 2 * g, L = SEQ >> sh; const int r = qi / L, p = qi - r * L, t = (p << sh) + r;
        const size_t mrow = (size_t)b * SEQ + t;
        bf16_t* op = a.o + ((size_t)g * NTOK + mrow) * 1024 + h * HD + half * 64;
#pragma unroll
        for (int d = 0; d < 64; ++d) op[d] = f2bf(o[d] * rl);
        if (half == 0) a.lse[((size_t)g * NTOK + mrow) * 8 + h] = m + __logf(l); }
}
__global__ void __launch_bounds__(256) k_merge(const bf16_t* __restrict__ oag, const float* __restrict__ lse, bf16_t* __restrict__ oa) {
    const size_t i = (size_t)blockIdx.x * 256 + threadIdx.x;
    const size_t m = i >> 10; const int c = (int)(i & 1023), h = c >> 7;
    const float l0 = lse[(0 * (size_t)NTOK + m) * 8 + h], l1 = lse[(1 * (size_t)NTOK + m) * 8 + h], l2 = lse[(2 * (size_t)NTOK + m) * 8 + h];
    const float mx = fmaxf(l0, fmaxf(l1, l2)); const float e0 = __expf(l0 - mx), e1 = __expf(l1 - mx), e2 = __expf(l2 - mx); const float inv = 1.0f / (e0 + e1 + e2);
    const float v = (e0 * bf2f(oag[(0 * (size_t)NTOK + m) * 1024 + c]) + e1 * bf2f(oag[(1 * (size_t)NTOK + m) * 1024 + c]) + e2 * bf2f(oag[(2 * (size_t)NTOK + m) * 1024 + c])) * inv;
    oa[i] = f2bf(v);
}
struct P3Args { const bf16_t* A; const bf16_t* Bt; int K; const bf16_t* gates; float* T; bf16_t* merged; const float* x; float* pre1; int mode; };
__global__ void __launch_bounds__(256) k_gemm3(P3Args a) {
    const int wave = threadIdx.x >> 6, lane = threadIdx.x & 63, fr = lane & 15, fq = lane >> 4;
    const int ng = blockIdx.x, mt = blockIdx.y * 4 + wave;
    f32x4 acc[8];
#pragma unroll
    for (int j = 0; j < 8; ++j) acc[j] = (f32x4){0.f, 0.f, 0.f, 0.f};
    wave_gemm16x128(a.A + (size_t)(mt * 16 + fr) * a.K, a.Bt + (size_t)ng * 128 * a.K, a.K, a.K, acc);
#pragma unroll
    for (int r = 0; r < 4; ++r) { const size_t m = (size_t)mt * 16 + fq * 4 + r;
#pragma unroll
        for (int j = 0; j < 8; ++j) { const int c = ng * 128 + 16 * j + fr; const size_t o = m * DM + c;
            if (a.mode == 0) a.T[o] = bf2f(a.gates[m * 4096 + c]) * acc[j][r];
            else if (a.mode == 1) a.merged[o] = f2bf(a.T[o] + bf2f(a.gates[m * 4096 + 2048 + c]) * acc[j][r]);
            else a.pre1[o] = ALPHA * a.x[o] + acc[j][r]; } }
}
struct RouteArgs { const float* g; const float* b; float* h1; bf16_t* h1b; const float* wg; const float* bg; const float* wr; const float* br; unsigned* cnt; int* tokidx; int* slot; const float* wt; float2* lnst; };
__device__ __forceinline__ void ln1_route_row(const float* pre1, const RouteArgs& a, int m, int lane) {
    const f32x4* xr = (const f32x4*)(pre1 + (size_t)m * DM) + lane;
    f32x4 v[8]; float s = 0.f;
#pragma unroll
    for (int j = 0; j < 8; ++j) { v[j] = xr[64 * j]; s += (v[j].x + v[j].y) + (v[j].z + v[j].w); }
    const float mean = wave_sum(s) * (1.0f / DM); float s2 = 0.f;
#pragma unroll
    for (int j = 0; j < 8; ++j) { v[j] = v[j] - mean; s2 += (v[j].x * v[j].x + v[j].y * v[j].y) + (v[j].z * v[j].z + v[j].w * v[j].w); }
    const float rstd = 1.0f / sqrtf(wave_sum(s2) * (1.0f / DM) + LN_EPS);
    float gl[4] = {0.f, 0.f, 0.f, 0.f};
#pragma unroll
    for (int j = 0; j < 8; ++j) { const int c = 4 * lane + 256 * j; const f32x4 gg = *(const f32x4*)(a.g + c), bb = *(const f32x4*)(a.b + c);
        v[j] = v[j] * rstd * gg + bb;
        *(f32x4*)(a.h1 + (size_t)m * DM + c) = v[j];
        *(uint2*)(a.h1b + (size_t)m * DM + c) = make_uint2(pk2(v[j].x, v[j].y), pk2(v[j].z, v[j].w));
#pragma unroll
        for (int i = 0; i < 4; ++i) { const f32x4 w = *(const f32x4*)(a.wg + (size_t)(c + i) * 4); const float hv = v[j][i]; gl[0] += hv * w.x; gl[1] += hv * w.y; gl[2] += hv * w.z; gl[3] += hv * w.w; } }
#pragma unroll
    for (int i = 0; i < 4; ++i) gl[i] = wave_sum(gl[i]) + a.bg[i];
    int gi = 0; float gm = gl[0];
#pragma unroll
    for (int i = 1; i < 4; ++i) if (gl[i] > gm) { gm = gl[i]; gi = i; }
    float gs = 0.f;
#pragma unroll
    for (int i = 0; i < 4; ++i) gs += __expf(gl[i] - gm);
    const float ggate = 1.0f / gs;
    float el[8] = {0.f, 0.f, 0.f, 0.f, 0.f, 0.f, 0.f, 0.f};
#pragma unroll
    for (int j = 0; j < 8; ++j) { const int c = 4 * lane + 256 * j;
#pragma unroll
        for (int i = 0; i < 4; ++i) { const float* wp = a.wr + (size_t)(c + i) * 32 + gi * 8; const f32x4 w0 = *(const f32x4*)wp, w1 = *(const f32x4*)(wp + 4); const float hv = v[j][i];
            el[0] += hv * w0.x; el[1] += hv * w0.y; el[2] += hv * w0.z; el[3] += hv * w0.w; el[4] += hv * w1.x; el[5] += hv * w1.y; el[6] += hv * w1.z; el[7] += hv * w1.w; } }
#pragma unroll
    for (int i = 0; i < 8; ++i) el[i] = wave_sum(el[i]) + a.br[gi * 8 + i];
    int i1 = 0; float m1 = el[0];
#pragma unroll
    for (int i = 1; i < 8; ++i) if (el[i] > m1) { m1 = el[i]; i1 = i; }
    int i2 = -1; float m2 = -3.0e38f;
#pragma unroll
    for (int i = 0; i < 8; ++i) if (i != i1 && el[i] > m2) { m2 = el[i]; i2 = i; }
    const float e2 = __expf(m2 - m1); const float w1 = ggate / (1.0f + e2), w2 = ggate * e2 / (1.0f + e2);
    if (lane == 0) {
        const int ex1 = gi * 8 + i1, ex2 = gi * 8 + i2;
        const int p1 = (int)atomicAdd(a.cnt + ex1, 1u), p2 = (int)atomicAdd(a.cnt + ex2, 1u);
        a.tokidx[ex1 * ECAP + p1] = m; a.tokidx[ex2 * ECAP + p2] = m;
        int* sl = a.slot + (size_t)m * 6; sl[0] = ex1; sl[1] = ex2; sl[2] = p1; sl[3] = p2; ((float*)sl)[4] = w1; ((float*)sl)[5] = w2;
    }
}
template <int R, int VAR>
__device__ __forceinline__ void ln1_route_rows(const float* pre1, const RouteArgs& a, int m0, int ms, int lane, LAS unsigned* hist, LAS int* rinfo, int lr0, int lrs) {
    f32x4 v[R][8]; float s[R], s2[R];
#pragma unroll
    for (int i = 0; i < R; ++i) { const f32x4* xr = (const f32x4*)(pre1 + (size_t)(m0 + i * ms) * DM) + lane; s[i] = 0.f;
#pragma unroll
        for (int j = 0; j < 8; ++j) { v[i][j] = xr[64 * j]; s[i] += (v[i][j].x + v[i][j].y) + (v[i][j].z + v[i][j].w); } }
#pragma unroll
    for (int o = 1; o < 64; o <<= 1)
#pragma unroll
        for (int i = 0; i < R; ++i) s[i] += __shfl_xor(s[i], o);
#pragma unroll
    for (int i = 0; i < R; ++i) { const float mean = s[i] * (1.0f / DM); s2[i] = 0.f;
#pragma unroll
        for (int j = 0; j < 8; ++j) { v[i][j] = v[i][j] - mean; s2[i] += (v[i][j].x * v[i][j].x + v[i][j].y * v[i][j].y) + (v[i][j].z * v[i][j].z + v[i][j].w * v[i][j].w); } }
#pragma unroll
    for (int o = 1; o < 64; o <<= 1)
#pragma unroll
        for (int i = 0; i < R; ++i) s2[i] += __shfl_xor(s2[i], o);
#pragma unroll
    for (int j = 0; j < 8; ++j) { const int c = 4 * lane + 256 * j; const f32x4 gg = *(const f32x4*)(a.g + c), bb = *(const f32x4*)(a.b + c);
#pragma unroll
        for (int i = 0; i < R; ++i) { const float rstd = 1.0f / sqrtf(s2[i] * (1.0f / DM) + LN_EPS); const size_t o = (size_t)(m0 + i * ms) * DM + c;
            v[i][j] = v[i][j] * rstd * gg + bb;
            if (j == 0 && lane == 0) a.lnst[m0 + i * ms] = make_float2(s[i] * (1.0f / DM), rstd);
            *(uint2*)(a.h1b + o) = make_uint2(pk2(v[i][j].x, v[i][j].y), pk2(v[i][j].z, v[i][j].w)); } }
    if constexpr (VAR == 51) return;
    float gl[R][4];
#pragma unroll
    for (int c = 0; c < 4; ++c) { const f32x4* wp = (const f32x4*)(a.wt + (size_t)c * DM) + lane;
#pragma unroll
        for (int i = 0; i < R; ++i) gl[i][c] = 0.f;
#pragma unroll
        for (int j = 0; j < 8; ++j) { const f32x4 w = wp[64 * j];
#pragma unroll
            for (int i = 0; i < R; ++i) gl[i][c] += (v[i][j].x * w.x + v[i][j].y * w.y) + (v[i][j].z * w.z + v[i][j].w * w.w); }
        if (c & 1) __builtin_amdgcn_sched_barrier(0); }
#pragma unroll
    for (int o = 1; o < 64; o <<= 1)
#pragma unroll
        for (int i = 0; i < R; ++i)
#pragma unroll
            for (int c = 0; c < 4; ++c) gl[i][c] += __shfl_xor(gl[i][c], o);
    int gi[R]; float ggate[R];
#pragma unroll
    for (int i = 0; i < R; ++i) { float g0 = gl[i][0] + a.bg[0], g1 = gl[i][1] + a.bg[1], g2 = gl[i][2] + a.bg[2], g3 = gl[i][3] + a.bg[3];
        int q = 0; float gm = g0; if (g1 > gm) { gm = g1; q = 1; } if (g2 > gm) { gm = g2; q = 2; } if (g3 > gm) { gm = g3; q = 3; }
        ggate[i] = 1.0f / (__expf(g0 - gm) + __expf(g1 - gm) + __expf(g2 - gm) + __expf(g3 - gm)); gi[i] = __builtin_amdgcn_readfirstlane(q); }
    float el[R][8];
#pragma unroll
    for (int c = 0; c < 8; ++c) {
#pragma unroll
        for (int i = 0; i < R; ++i) { const f32x4* wp = (const f32x4*)(a.wt + (size_t)(4 + gi[i] * 8 + c) * DM) + lane; float acc = 0.f;
#pragma unroll
            for (int j = 0; j < 8; ++j) { const f32x4 w = wp[64 * j]; acc += (v[i][j].x * w.x + v[i][j].y * w.y) + (v[i][j].z * w.z + v[i][j].w * w.w); }
            el[i][c] = acc; }
        __builtin_amdgcn_sched_barrier(0); }
#pragma unroll
    for (int o = 1; o < 64; o <<= 1)
#pragma unroll
        for (int i = 0; i < R; ++i)
#pragma unroll
            for (int c = 0; c < 8; ++c) el[i][c] += __shfl_xor(el[i][c], o);
#pragma unroll
    for (int i = 0; i < R; ++i) { const int m = m0 + i * ms;
        int i1 = 0; float m1 = el[i][0] + a.br[gi[i] * 8];
        float ev[8];
#pragma unroll
        for (int c = 0; c < 8; ++c) ev[c] = el[i][c] + a.br[gi[i] * 8 + c];
#pragma unroll
        for (int c = 1; c < 8; ++c) if (ev[c] > m1) { m1 = ev[c]; i1 = c; }
        int i2 = -1; float m2 = -3.0e38f;
#pragma unroll
        for (int c = 0; c < 8; ++c) if (c != i1 && ev[c] > m2) { m2 = ev[c]; i2 = c; }
        const float e2 = __expf(m2 - m1); const float w1 = ggate[i] / (1.0f + e2), w2 = ggate[i] * e2 / (1.0f + e2);
        if (lane == 0) {
            const int ex1 = gi[i] * 8 + i1, ex2 = gi[i] * 8 + i2;
            const int p1 = (int)__hip_atomic_fetch_add(hist + ex1, 1u, __ATOMIC_RELAXED, __HIP_MEMORY_SCOPE_WORKGROUP), p2 = (int)__hip_atomic_fetch_add(hist + ex2, 1u, __ATOMIC_RELAXED, __HIP_MEMORY_SCOPE_WORKGROUP);
            LAS int* ri = rinfo + (lr0 + i * lrs) * 8; ri[0] = ex1; ri[1] = ex2; ri[2] = p1; ri[3] = p2; ((LAS float*)ri)[4] = w1; ((LAS float*)ri)[5] = w2; ri[6] = m;
        } }
}
__global__ void __launch_bounds__(256) k_ln1_route(const float* pre1, RouteArgs a) { ln1_route_row(pre1, a, blockIdx.x * 4 + (threadIdx.x >> 6), threadIdx.x & 63); }

__device__ __forceinline__ int row_start(const unsigned* cnt, int e) { int s = 0; for (int i = 0; i < e; ++i) s += ((int)cnt[i] + 255) & ~255; return s; }
struct P6Args { const bf16_t* h1b; const bf16_t* wgut; const bf16_t* wdt; const unsigned* cnt; const int* tokidx; bf16_t* act; bf16_t* y; };
__global__ void __launch_bounds__(256) k_moe_up(P6Args a) {
    const int wave = threadIdx.x >> 6, lane = threadIdx.x & 63, fr = lane & 15, fq = lane >> 4;
    const int R0 = blockIdx.y * 64;
    int e = 0, rs = 0;
    for (; e < NEXP; ++e) { const int n = ((int)a.cnt[e] + 255) & ~255; if (R0 < rs + n) break; rs += n; }
    if (e == NEXP) return;
    const int pos = R0 - rs + wave * 16 + fr; const int tok = pos < (int)a.cnt[e] ? a.tokidx[e * ECAP + pos] : 0;
    const int jb = blockIdx.x;
    f32x4 ag[8], au[8];
#pragma unroll
    for (int j = 0; j < 8; ++j) { ag[j] = (f32x4){0.f, 0.f, 0.f, 0.f}; au[j] = (f32x4){0.f, 0.f, 0.f, 0.f}; }
    const bf16_t* wb = a.wgut + ((size_t)e * 2048 + jb * 256) * DM;
    wave_gemm16x128(a.h1b + (size_t)tok * DM, wb, DM, DM, ag);
    wave_gemm16x128(a.h1b + (size_t)tok * DM, wb + (size_t)128 * DM, DM, DM, au);
#pragma unroll
    for (int r = 0; r < 4; ++r) { const size_t row = (size_t)R0 + wave * 16 + fq * 4 + r;
#pragma unroll
        for (int j = 0; j < 8; ++j) { const float g = ag[j][r], u = au[j][r]; a.act[row * FF + jb * 128 + 16 * j + fr] = f2bf(g / (1.0f + __expf(-g)) * u); } }
}
__global__ void __launch_bounds__(256) k_moe_down(P6Args a) {
    const int wave = threadIdx.x >> 6, lane = threadIdx.x & 63, fr = lane & 15, fq = lane >> 4;
    const int R0 = blockIdx.y * 64;
    int e = 0, rs = 0;
    for (; e < NEXP; ++e) { const int n = ((int)a.cnt[e] + 255) & ~255; if (R0 < rs + n) break; rs += n; }
    if (e == NEXP) return;
    f32x4 acc[8];
#pragma unroll
    for (int j = 0; j < 8; ++j) acc[j] = (f32x4){0.f, 0.f, 0.f, 0.f};
    wave_gemm16x128(a.act + ((size_t)R0 + wave * 16 + fr) * FF, a.wdt + ((size_t)e * 2048 + blockIdx.x * 128) * FF, FF, FF, acc);
#pragma unroll
    for (int r = 0; r < 4; ++r) { const size_t row = (size_t)R0 + wave * 16 + fq * 4 + r;
#pragma unroll
        for (int j = 0; j < 8; ++j) a.y[row * DM + blockIdx.x * 128 + 16 * j + fr] = f2bf(acc[j][r]); }
}
struct P8Args { const float* h1; const bf16_t* y; const unsigned* cnt; const int* slot; const float* g; const float* b; float* out; };
__device__ __forceinline__ void final_row(const P8Args& a, int m, int lane, size_t r1, size_t r2, float w1, float w2) {
    f32x4 v[8]; float s = 0.f;
#pragma unroll
    for (int j = 0; j < 8; ++j) { const int c = 4 * lane + 256 * j; const f32x4 hv = *(const f32x4*)(a.h1 + (size_t)m * DM + c);
        const uint2 ya = *(const uint2*)(a.y + r1 * DM + c), yb = *(const uint2*)(a.y + r2 * DM + c);
        f32x4 f; f.x = w1 * bflo(ya.x) + w2 * bflo(yb.x); f.y = w1 * bfhi(ya.x) + w2 * bfhi(yb.x); f.z = w1 * bflo(ya.y) + w2 * bflo(yb.y); f.w = w1 * bfhi(ya.y) + w2 * bfhi(yb.y);
        v[j] = hv * ALPHA + f; s += (v[j].x + v[j].y) + (v[j].z + v[j].w); }
    const float mean = wave_sum(s) * (1.0f / DM); float s2 = 0.f;
#pragma unroll
    for (int j = 0; j < 8; ++j) { v[j] = v[j] - mean; s2 += (v[j].x * v[j].x + v[j].y * v[j].y) + (v[j].z * v[j].z + v[j].w * v[j].w); }
    const float rstd = 1.0f / sqrtf(wave_sum(s2) * (1.0f / DM) + LN_EPS);
#pragma unroll
    for (int j = 0; j < 8; ++j) { const int c = 4 * lane + 256 * j; const f32x4 gg = *(const f32x4*)(a.g + c), bb = *(const f32x4*)(a.b + c);
        *(f32x4*)(a.out + (size_t)m * DM + c) = v[j] * rstd * gg + bb; }
}
__device__ __forceinline__ void final_row_t(const P8Args& a, const float* pre1, const float2* lnst, const float* g1, const float* b1, int m, int lane, size_t r1, size_t r2, float w1, float w2) {
    f32x4 v[8]; float s = 0.f; const float2 st = lnst[m];
#pragma unroll
    for (int j = 0; j < 8; ++j) { const int c = 4 * lane + 256 * j; const f32x4 pv = *(const f32x4*)(pre1 + (size_t)m * DM + c);
        const f32x4 hv = (pv - st.x) * st.y * *(const f32x4*)(g1 + c) + *(const f32x4*)(b1 + c);
        const uint2 ya = *(const uint2*)(a.y + r1 * DM + c), yb = *(const uint2*)(a.y + r2 * DM + c);
        f32x4 f; f.x = w1 * bflo(ya.x) + w2 * bflo(yb.x); f.y = w1 * bfhi(ya.x) + w2 * bfhi(yb.x); f.z = w1 * bflo(ya.y) + w2 * bflo(yb.y); f.w = w1 * bfhi(ya.y) + w2 * bfhi(yb.y);
        v[j] = hv * ALPHA + f; s += (v[j].x + v[j].y) + (v[j].z + v[j].w); }
    const float mean = wave_sum(s) * (1.0f / DM); float s2 = 0.f;
#pragma unroll
    for (int j = 0; j < 8; ++j) { v[j] = v[j] - mean; s2 += (v[j].x * v[j].x + v[j].y * v[j].y) + (v[j].z * v[j].z + v[j].w * v[j].w); }
    const float rstd = 1.0f / sqrtf(wave_sum(s2) * (1.0f / DM) + LN_EPS);
#pragma unroll
    for (int j = 0; j < 8; ++j) { const int c = 4 * lane + 256 * j; const f32x4 gg = *(const f32x4*)(a.g + c), bb = *(const f32x4*)(a.b + c);
        *(f32x4*)(a.out + (size_t)m * DM + c) = v[j] * rstd * gg + bb; }
}
__global__ void __launch_bounds__(256) k_final(P8Args a) {
    const int lane = threadIdx.x & 63, m = blockIdx.x * 4 + (threadIdx.x >> 6);
    const int* sl = a.slot + (size_t)m * 6; const int e1 = sl[0], e2 = sl[1], p1 = sl[2], p2 = sl[3]; const float w1 = ((const float*)sl)[4], w2 = ((const float*)sl)[5];
    final_row(a, m, lane, (size_t)row_start(a.cnt, e1) + p1, (size_t)row_start(a.cnt, e2) + p2, w1, w2);
}

namespace pg8 {
constexpr int BM = 256, BK = 64, HALF = 128, HTB = HALF * BK * 2  , STAGE_BYTES = 8 * HTB;
__device__ __forceinline__ int lds_byte(int r, int c) { const int st = (r >> 4) * 2 + (c >> 5), rr = r & 15, cc = c & 31, ob = rr * 64 + cc * 2; return st * 1024 + (ob ^ (((ob >> 9) & 1) << 5)); }
__device__ __forceinline__ void stage_rc(int b, int& R, int& C) { const int st = b / 1024, sb = b % 1024, swz = sb ^ (((sb >> 9) & 1) << 5); R = (st >> 1) * 16 + swz / 64; C = (st & 1) * 32 + (swz % 64) / 2; }

struct Unit { const char* A; const char* B; unsigned lda, ldb; int nt; int pm, pn, aux; const int* gidx; int gcnt; };
struct Voff { unsigned a[2][2], b[2][2]; };
__device__ __forceinline__ int brow_perm8(int h, int R) { return 128 * h + (R & ~31) + 8 * ((R >> 2) & 3) + 4 * ((R >> 4) & 1) + (R & 3); }
__device__ __forceinline__ int brow_rope(int h, int R) { return 128 * (R >> 6) + 64 * h + 32 * ((R >> 5) & 1) + 8 * ((R >> 2) & 3) + 4 * ((R >> 4) & 1) + (R & 3); }

template <class Epi> __device__ __forceinline__ void make_voff(const Unit& u, Voff& v, int tid) {
#pragma unroll
    for (int i = 0; i < 2; ++i) { int R, C; stage_rc(tid * 16 + i * 8192, R, C);
#pragma unroll
        for (int h = 0; h < 2; ++h) {
            int ra = h * HALF + R;
            if (u.gidx) ra = (ra < u.gcnt) ? u.gidx[ra] : 0;
            v.a[h][i] = (unsigned)ra * u.lda + (unsigned)C * 2u;
            v.b[h][i] = (unsigned)Epi::brow(h, R) * u.ldb + (unsigned)C * 2u;
        } }
}

template <class Epi, class Sched, bool ALIGN_EPI, bool SP2>
__device__ __forceinline__ void gemm_phase(LAS unsigned char* lds, LAS unsigned char* ex, const Sched& S, const Epi& E, int wid) {
    const int lane = lane_id(), tid = wid * 64 + lane, wr = wid >> 2, wc = wid & 3, fr = lane & 15, fq = lane >> 4;
    const unsigned ldsw = (unsigned)wid * 1024u;
    const int aoff = lds_byte(wr * 64 + fr, fq * 8), boff = lds_byte(wc * 32 + fr, fq * 8);
#define PG8_SA(b, h) (((b) * 2 + (h)) * HTB)
#define PG8_SB(b, h) ((4 + (b) * 2 + (h)) * HTB)
#define PG8_STAGE(bufoff, gbase, voff) do { _Pragma("unroll") for (int _i = 0; _i < 2; ++_i) \
        __builtin_amdgcn_global_load_lds((const unsigned*)((const char*)(gbase) + (voff)[_i]), (LAS unsigned*)(lds + (bufoff) + ldsw + _i * 8192), 16, 0, 0); } while (0)
#define PG8_LDA(dst, b, h) do { _Pragma("unroll") for (int m = 0; m < 4; ++m) _Pragma("unroll") for (int k = 0; k < 2; ++k) dst[m][k] = *(const LAS bf16x8*)(lds + PG8_SA(b, h) + aoff + m * 2048 + k * 1024); } while (0)
#define PG8_LDB(dst, b, h) do { _Pragma("unroll") for (int n = 0; n < 2; ++n) _Pragma("unroll") for (int k = 0; k < 2; ++k) dst[n][k] = *(const LAS bf16x8*)(lds + PG8_SB(b, h) + boff + n * 2048 + k * 1024); } while (0)
#define PG8_MMA(ai, bj, At, Bt) do { __builtin_amdgcn_s_setprio(1); _Pragma("unroll") for (int m = 0; m < 4; ++m) _Pragma("unroll") for (int n = 0; n < 2; ++n) _Pragma("unroll") for (int k = 0; k < 2; ++k) \
        acc[ai][bj][m][n] = __builtin_amdgcn_mfma_f32_16x16x32_bf16(Bt[n][k], At[m][k], acc[ai][bj][m][n], 0, 0, 0); __builtin_amdgcn_s_setprio(0); } while (0)
#define PG8_WAIT_V(n) asm volatile("s_waitcnt vmcnt(" #n ")" ::: "memory")
#define PG8_WAIT_L(n) asm volatile("s_waitcnt lgkmcnt(" #n ")" ::: "memory")
#define PG8_BAR __builtin_amdgcn_s_barrier()
#define PG8_SCHED __builtin_amdgcn_sched_barrier(0)
    Unit cur, nxt; int ui = 0;
    if (!S.next(0, cur)) return;
    Voff vo, nvo;
    make_voff<Epi>(cur, vo, tid);
    f32x4 acc[2][2][4][2];
#pragma unroll
    for (int a = 0; a < 2; ++a)
#pragma unroll
        for (int b = 0; b < 2; ++b)
#pragma unroll
            for (int m = 0; m < 4; ++m)
#pragma unroll
                for (int n = 0; n < 2; ++n) acc[a][b][m][n] = (f32x4){0.f, 0.f, 0.f, 0.f};
    bf16x8 At[4][2], B0[2][2], B1[2][2];
    const char* cA = cur.A; const char* cB = cur.B;
    const size_t kstep = (size_t)(BK * 2);
    if constexpr (SP2) {
        PG8_STAGE(PG8_SB(0, 0), cB, vo.b[0]); PG8_STAGE(PG8_SB(0, 1), cB, vo.b[1]); PG8_STAGE(PG8_SA(0, 0), cA, vo.a[0]); PG8_STAGE(PG8_SA(0, 1), cA, vo.a[1]);
        if (wr == 1) PG8_BAR;
        PG8_WAIT_V(2); PG8_BAR;
        PG8_STAGE(PG8_SB(1, 0), cB + kstep, vo.b[0]); PG8_STAGE(PG8_SA(1, 0), cA + kstep, vo.a[0]); PG8_STAGE(PG8_SB(1, 1), cB + kstep, vo.b[1]);
        PG8_WAIT_V(6); PG8_BAR;
    } else {
        PG8_STAGE(PG8_SB(0, 0), cB, vo.b[0]); PG8_STAGE(PG8_SA(0, 0), cA, vo.a[0]); PG8_STAGE(PG8_SB(0, 1), cB, vo.b[1]); PG8_STAGE(PG8_SA(0, 1), cA, vo.a[1]);
        if (wr == 1) PG8_BAR;
        PG8_WAIT_V(4); PG8_BAR;
        PG8_STAGE(PG8_SB(1, 0), cB + kstep, vo.b[0]); PG8_STAGE(PG8_SA(1, 0), cA + kstep, vo.a[0]); PG8_STAGE(PG8_SB(1, 1), cB + kstep, vo.b[1]);
        PG8_WAIT_V(6); PG8_BAR;
    }
    for (;;) {
        const bool has_next = S.next(ui + 1, nxt);
        if (has_next) make_voff<Epi>(nxt, nvo, tid); else nvo = vo;
        const char* nA = has_next ? nxt.A : cA; const char* nB = has_next ? nxt.B : cB;
        const int nt = cur.nt;
        for (int t = 0; t < nt; t += 2) {
            const bool last = (t == nt - 2);
            const char* a1 = cA + (size_t)(t + 1) * kstep;
            const char* a2 = last ? nA : cA + (size_t)(t + 2) * kstep; const char* b2 = last ? nB : cB + (size_t)(t + 2) * kstep;
            const char* a3 = a2 + kstep; const char* b3 = b2 + kstep;
            Voff w;
#pragma unroll
            for (int h = 0; h < 2; ++h)
#pragma unroll
                for (int i = 0; i < 2; ++i) { w.a[h][i] = last ? nvo.a[h][i] : vo.a[h][i]; w.b[h][i] = last ? nvo.b[h][i] : vo.b[h][i]; }
            if constexpr (SP2) {
            PG8_LDB(B0, 0, 0); PG8_LDB(B1, 0, 1); PG8_SCHED; PG8_LDA(At, 0, 0); PG8_STAGE(PG8_SA(1, 1), a1, vo.a[1]);
            PG8_WAIT_V(8); PG8_WAIT_L(0); PG8_BAR; PG8_MMA(0, 0, At, B0); PG8_MMA(0, 1, At, B1); PG8_BAR; PG8_SCHED;
            PG8_LDA(At, 0, 1); PG8_STAGE(PG8_SB(0, 0), b2, w.b[0]); PG8_STAGE(PG8_SB(0, 1), b2, w.b[1]); PG8_STAGE(PG8_SA(0, 0), a2, w.a[0]);
            PG8_WAIT_V(8); PG8_WAIT_L(0); PG8_BAR; PG8_MMA(1, 0, At, B0); PG8_MMA(1, 1, At, B1); PG8_BAR; PG8_SCHED;
            PG8_LDB(B0, 1, 0); PG8_LDB(B1, 1, 1); PG8_SCHED; PG8_LDA(At, 1, 0); PG8_STAGE(PG8_SA(0, 1), a2, w.a[1]);
            PG8_WAIT_V(8); PG8_WAIT_L(0); PG8_BAR; PG8_MMA(0, 0, At, B0); PG8_MMA(0, 1, At, B1); PG8_BAR; PG8_SCHED;
            PG8_LDA(At, 1, 1); PG8_STAGE(PG8_SB(1, 0), b3, w.b[0]); PG8_STAGE(PG8_SB(1, 1), b3, w.b[1]); PG8_STAGE(PG8_SA(1, 0), a3, w.a[0]);
            PG8_WAIT_V(8); PG8_WAIT_L(0); PG8_BAR; PG8_MMA(1, 0, At, B0); PG8_MMA(1, 1, At, B1); PG8_BAR; PG8_SCHED;
            } else {
            PG8_LDB(B0, 0, 0); PG8_SCHED; PG8_LDA(At, 0, 0); PG8_STAGE(PG8_SA(1, 1), a1, vo.a[1]);
            PG8_WAIT_L(8); PG8_BAR; PG8_WAIT_L(0); PG8_MMA(0, 0, At, B0); PG8_BAR; PG8_SCHED;
            PG8_LDB(B1, 0, 1); PG8_STAGE(PG8_SB(0, 0), b2, w.b[0]);
            PG8_BAR; PG8_WAIT_L(0); PG8_MMA(0, 1, At, B1); PG8_BAR;
            PG8_LDA(At, 0, 1); PG8_STAGE(PG8_SA(0, 0), a2, w.a[0]);
            PG8_BAR; PG8_WAIT_L(0); PG8_MMA(1, 0, At, B0); PG8_BAR; PG8_SCHED;
            PG8_STAGE(PG8_SB(0, 1), b2, w.b[1]);
            PG8_WAIT_V(6); PG8_BAR; PG8_MMA(1, 1, At, B1); PG8_BAR;
            PG8_LDB(B0, 1, 0); PG8_SCHED; PG8_LDA(At, 1, 0); PG8_STAGE(PG8_SA(0, 1), a2, w.a[1]);
            PG8_WAIT_L(8); PG8_BAR; PG8_WAIT_L(0); PG8_MMA(0, 0, At, B0); PG8_BAR; PG8_SCHED;
            PG8_LDB(B1, 1, 1); PG8_STAGE(PG8_SB(1, 0), b3, w.b[0]);
            PG8_BAR; PG8_WAIT_L(0); PG8_MMA(0, 1, At, B1); PG8_BAR;
            PG8_LDA(At, 1, 1); PG8_STAGE(PG8_SA(1, 0), a3, w.a[0]);
            PG8_BAR; PG8_WAIT_L(0); PG8_MMA(1, 0, At, B0); PG8_BAR; PG8_SCHED;
            PG8_STAGE(PG8_SB(1, 1), b3, w.b[1]);
            PG8_WAIT_V(6); PG8_BAR; PG8_MMA(1, 1, At, B1); PG8_BAR;
            }
        }
        if constexpr (ALIGN_EPI) { if (wr == 0) PG8_BAR; }
        E(acc, cur, wr, wc, fr, fq, ex);
        if (!has_next) break;
        if (!(cur.aux & 256)) {
#pragma unroll
        for (int a = 0; a < 2; ++a)
#pragma unroll
            for (int b = 0; b < 2; ++b)
#pragma unroll
                for (int m = 0; m < 4; ++m)
#pragma unroll
                    for (int n = 0; n < 2; ++n) acc[a][b][m][n] = (f32x4){0.f, 0.f, 0.f, 0.f};
        }
        cur = nxt; cA = nA; cB = nB; vo = nvo; ++ui;
        if constexpr (ALIGN_EPI) { if (wr == 1) PG8_BAR; }
    }
    PG8_WAIT_V(0);
    if constexpr (!ALIGN_EPI) { if (wr == 0) PG8_BAR; }
    PG8_BAR;
#undef PG8_SA
#undef PG8_SB
#undef PG8_STAGE
#undef PG8_LDA
#undef PG8_LDB
#undef PG8_MMA
#undef PG8_WAIT_V
#undef PG8_WAIT_L
#undef PG8_BAR
#undef PG8_SCHED
}

struct TileOrder {
    int nM, nN, nwg, G, c;
    __device__ void init(int M, int N, int G_, int c_) { nM = M / BM; nN = N / BM; nwg = nM * nN; G = G_; c = c_; }
    __device__ bool tile(int i, int& pm, int& pn) const {
        const long L = (long)i * G + c; if (L >= nwg) return false;
        int wgid = (int)L; { const int q = nwg / 8, r = nwg % 8, xcd = wgid % 8, off = wgid / 8; wgid = (xcd < r ? xcd * (q + 1) : r * (q + 1) + (xcd - r) * q) + off; }
        const int nig = 8 * nN, gid = wgid / nig, fm = gid * 8, gsz = (nM - fm) < 8 ? (nM - fm) : 8;
        pm = fm + ((wgid % nig) % gsz); pn = (wgid % nig) / gsz; return true;
    }
};
}

typedef float f32x2 __attribute__((ext_vector_type(2)));
#define ACC_T f32x4 (&acc)[2][2][4][2]

struct EpiProj {
    __device__ static __forceinline__ int brow(int h, int R) { return pg8::brow_rope(h, R); }
    unsigned char* ws; const float *qg, *kg;
    __device__ static __forceinline__ void rot4(const f32x4 x1, const f32x4 x2, const f32x4 t0, const f32x4 t1, f32x4& y1, f32x4& y2) {
        y1.x = x1.x * t0.x - x2.x * t0.y; y2.x = x2.x * t0.x + x1.x * t0.y;
        y1.y = x1.y * t0.z - x2.y * t0.w; y2.y = x2.y * t0.z + x1.y * t0.w;
        y1.z = x1.z * t1.x - x2.z * t1.y; y2.z = x2.z * t1.x + x1.z * t1.y;
        y1.w = x1.w * t1.z - x2.w * t1.w; y2.w = x2.w * t1.z + x1.w * t1.w;
    }
    __device__ static __forceinline__ void store8(bf16_t* dst, const f32x4 a, const f32x4 b) {
        u32x4 w; w.x = cvtpk(a.x, a.y); w.y = cvtpk(a.z, a.w); w.z = cvtpk(b.x, b.y); w.w = cvtpk(b.z, b.w); *(u32x4*)dst = w; }
    __device__ __forceinline__ void operator()(ACC_T, const pg8::Unit& u, int wr, int wc, int fr, int fq, LAS unsigned char* ex) const {
        const int ng = 2 * u.pn + (wc >> 1), c0 = 32 * (wc & 1) + 8 * fq;
        if (ng < 72) {
            const int which = ng / 24, hh = ng % 24, g = hh >> 3, h = hh & 7;
            bf16_t* buf = (bf16_t*)(ws + WS_QA + (size_t)which * (WS_KA - WS_QA));
            const float2* rt1 = (const float2*)(ws + WS_RT1);
#pragma unroll
            for (int ai = 0; ai < 2; ++ai)
#pragma unroll
                for (int m = 0; m < 4; ++m) {
                    const int mrow = u.pm * 256 + ai * 128 + wr * 64 + m * 16 + fr, b = mrow >> 12, t = mrow & 4095;
                    bf16_t* dst = buf + ((size_t)((g * 2 + b) * 8 + h) * SEQ + perm_pos(g, t)) * HD + c0;
                    f32x4 y1a = acc[ai][0][m][0], y1b = acc[ai][0][m][1], y2a = acc[ai][1][m][0], y2b = acc[ai][1][m][1];
                    if (which < 2) {
                        const f32x4* tp = (const f32x4*)(rt1 + (size_t)t * 64 + c0);
                        const f32x4 t0 = tp[0], t1 = tp[1], t2 = tp[2], t3 = tp[3];
                        rot4(acc[ai][0][m][0], acc[ai][1][m][0], t0, t1, y1a, y2a); rot4(acc[ai][0][m][1], acc[ai][1][m][1], t2, t3, y1b, y2b);
                    }
                    store8(dst, y1a, y1b); store8(dst + 64, y2a, y2b);
                }
        } else if (ng < 92) {
            const int k = ng - 72;
            LAS float* X = (LAS float*)ex;
#pragma unroll
            for (int ai = 0; ai < 2; ++ai)
#pragma unroll
                for (int m = 0; m < 4; ++m) { float s = 0.f;
#pragma unroll
                    for (int bj = 0; bj < 2; ++bj)
#pragma unroll
                        for (int n = 0; n < 2; ++n) { const f32x4 x = acc[ai][bj][m][n]; s += (x.x * x.x + x.y * x.y) + (x.z * x.z + x.w * x.w); }
                    s += __shfl_xor(s, 16); s += __shfl_xor(s, 32);
                    if (fq == 0) X[(ai * 128 + wr * 64 + m * 16 + fr) * 4 + wc] = s; }
            asm volatile("s_waitcnt lgkmcnt(0)" ::: "memory"); __builtin_amdgcn_s_barrier(); asm volatile("" ::: "memory");
            const float* gn = (k < 16) ? qg : kg; const float2* rt2 = (const float2*)(ws + WS_RT2);
            bf16_t* qb = (bf16_t*)(ws + WS_QB); bf16_t* kb = (bf16_t*)(ws + WS_KB);
            const f32x4 g1a = *(const f32x4*)(gn + c0), g1b = *(const f32x4*)(gn + c0 + 4), g2a = *(const f32x4*)(gn + 64 + c0), g2b = *(const f32x4*)(gn + 64 + c0 + 4);
#pragma unroll
            for (int ai = 0; ai < 2; ++ai)
#pragma unroll
                for (int m = 0; m < 4; ++m) {
                    const int r = ai * 128 + wr * 64 + m * 16 + fr;
                    const float ssum = X[r * 4 + (wc & 2)] + X[r * 4 + (wc & 2) + 1];
                    const int mrow = u.pm * 256 + r, b = mrow >> 12, t = mrow & 4095;
                    bf16_t* dst = ((k < 16) ? qb + ((size_t)(b * 16 + k) * SEQ + t) * HD : kb + ((size_t)(b * 4 + (k - 16)) * SEQ + t) * HD) + c0;
                    const float rinv = 1.0f / sqrtf(ssum * (1.0f / 128.0f) + RMS_EPS);
                    const f32x4* tp = (const f32x4*)(rt2 + (size_t)t * 64 + c0);
                    const f32x4 t0 = tp[0], t1 = tp[1], t2 = tp[2], t3 = tp[3];
                    f32x4 y1a, y1b, y2a, y2b;
                    rot4(acc[ai][0][m][0] * rinv * g1a, acc[ai][1][m][0] * rinv * g2a, t0, t1, y1a, y2a); rot4(acc[ai][0][m][1] * rinv * g1b, acc[ai][1][m][1] * rinv * g2b, t2, t3, y1b, y2b);
                    store8(dst, y1a, y1b); store8(dst + 64, y2a, y2b);
                }
        } else {
#pragma unroll
            for (int ai = 0; ai < 2; ++ai)
#pragma unroll
                for (int m = 0; m < 4; ++m) {
                    const int mrow = u.pm * 256 + ai * 128 + wr * 64 + m * 16 + fr, b = mrow >> 12, t = mrow & 4095;
                    bf16_t* dst = (ng < 96 ? (bf16_t*)(ws + WS_VB) + ((size_t)(b * 4 + (ng - 92)) * SEQ + t) * HD : (bf16_t*)(ws + WS_GATES) + (size_t)mrow * 4096 + (ng - 96) * 128) + c0;
                    f32x4 y1a = acc[ai][0][m][0], y1b = acc[ai][0][m][1], y2a = acc[ai][1][m][0], y2b = acc[ai][1][m][1];
                    if (ng >= 96) {
#pragma unroll
                        for (int q = 0; q < 4; ++q) { y1a[q] = __builtin_amdgcn_rcpf(1.0f + __expf(-y1a[q])); y1b[q] = __builtin_amdgcn_rcpf(1.0f + __expf(-y1b[q]));
                            y2a[q] = __builtin_amdgcn_rcpf(1.0f + __expf(-y2a[q])); y2b[q] = __builtin_amdgcn_rcpf(1.0f + __expf(-y2b[q])); } }
                    store8(dst, y1a, y1b); store8(dst + 64, y2a, y2b);
                }
        }
    }
};
struct ProjSched {
    pg8::TileOrder o; const char* ws;
    __device__ __forceinline__ bool next(int i, pg8::Unit& u) const { int pm, pn; if (!o.tile(i, pm, pn)) return false;
        u.A = ws + WS_XB + (size_t)pm * 256 * (DM * 2); u.B = ws + WS_WINT + (size_t)pn * 256 * (DM * 2); u.lda = DM * 2; u.ldb = DM * 2; u.nt = DM / 64; u.pm = pm; u.pn = pn; u.aux = 0; u.gidx = nullptr; u.gcnt = 0; return true; }
};

struct EpiMix {
    __device__ static __forceinline__ int brow(int h, int R) { return pg8::brow_perm8(h, R); }
    unsigned char* ws; const float* x;
    __device__ static __forceinline__ void unpack8(const u32x4 gw, f32x4& lo, f32x4& hi) { lo.x = bflo(gw.x); lo.y = bfhi(gw.x); lo.z = bflo(gw.y); lo.w = bfhi(gw.y); hi.x = bflo(gw.z); hi.y = bfhi(gw.z); hi.z = bflo(gw.w); hi.w = bfhi(gw.w); }
    __device__ __forceinline__ void operator()(f32x4 (&acc)[2][2][4][2], const pg8::Unit& u, int wr, int wc, int fr, int fq, LAS unsigned char* ex) const {
        const bf16_t* gates = (const bf16_t*)(ws + WS_GATES); bf16_t* merged = (bf16_t*)(ws + WS_MERGED); float* pre1 = (float*)(ws + WS_PRE1);
        { const int lane = lane_id(); fr = lane & 15; fq = lane >> 4; }
        const int mode = u.aux & 255; constexpr float GMIN = 8.673617379884035e-19f;
#pragma unroll
        for (int ai = 0; ai < 2; ++ai)
#pragma unroll
            for (int m = 0; m < 4; ++m) { const size_t mrow = (size_t)u.pm * 256 + ai * 128 + wr * 64 + m * 16 + fr;
#pragma unroll
                for (int bj = 0; bj < 2; ++bj) { const int col = u.pn * 256 + bj * 128 + wc * 32 + 8 * fq; const size_t o = mrow * DM + col;
                    if (mode == 2) {
                        const f32x4 x0 = *(const f32x4*)(x + o), x1 = *(const f32x4*)(x + o + 4);
                        *(f32x4*)(pre1 + o) = x0 * ALPHA + acc[ai][bj][m][0]; *(f32x4*)(pre1 + o + 4) = x1 * ALPHA + acc[ai][bj][m][1];
                    } else {
                        f32x4 g0a, g0b; unpack8(*(const u32x4*)(gates + mrow * 4096 + col), g0a, g0b);
#pragma unroll
                        for (int q = 0; q < 4; ++q) { g0a[q] = fmaxf(g0a[q], GMIN); g0b[q] = fmaxf(g0b[q], GMIN); }
                        if (mode == 1) { f32x4 g1a, g1b; unpack8(*(const u32x4*)(gates + mrow * 4096 + 2048 + col), g1a, g1b);
#pragma unroll
                            for (int q = 0; q < 4; ++q) { acc[ai][bj][m][0][q] *= g1a[q] * __builtin_amdgcn_rcpf(g0a[q]); acc[ai][bj][m][1][q] *= g1b[q] * __builtin_amdgcn_rcpf(g0b[q]); }
                        } else { const f32x4 t0 = g0a * acc[ai][bj][m][0], t1 = g0b * acc[ai][bj][m][1];
                            u32x4 w; w.x = cvtpk(t0.x, t0.y); w.y = cvtpk(t0.z, t0.w); w.z = cvtpk(t1.x, t1.y); w.w = cvtpk(t1.z, t1.w); *(u32x4*)(merged + o) = w; }
                    } } }
    }
};
struct MixSched {
    int mode, c; const char* ws;
    __device__ __forceinline__ bool next(int i, pg8::Unit& u) const {
        if (c >= 256) return false;
        const int pm = c >> 3, pn = c & 7; u.pm = pm; u.pn = pn; u.gidx = nullptr; u.gcnt = 0;
        if (mode == 0) { if (i > 1) return false;
            if (i == 1) { u.A = ws + WS_OA + (size_t)pm * 256 * 2048; u.B = ws + WS_WAT + (size_t)pn * 256 * 2048; u.lda = 2048; u.ldb = 2048; u.nt = 16; u.aux = 0; }
            else { u.A = ws + WS_OB + (size_t)pm * 256 * 4096; u.B = ws + WS_WBT + (size_t)pn * 256 * 4096; u.lda = 4096; u.ldb = 4096; u.nt = 32; u.aux = 1 | 256; }
            return true; }
        if (i > 0) return false;
        u.A = ws + WS_MERGED + (size_t)pm * 256 * 4096; u.B = ws + WS_WOT + (size_t)pn * 256 * 4096; u.lda = 4096; u.ldb = 4096; u.nt = 32; u.aux = 2; return true;
    }
};

struct MoeSched {
    int G, vcu, down; unsigned cnt_l, tpe_l;
    const char* ws;
    __device__ __forceinline__ void init(const unsigned* cnt, int lane) {
        unsigned c = 0; if (lane < NEXP) c = __hip_atomic_load(cnt + lane, __ATOMIC_RELAXED, __HIP_MEMORY_SCOPE_AGENT);
        unsigned t = (c + 255u) >> 8, inc = t;
#pragma unroll
        for (int o = 1; o < 32; o <<= 1) { const unsigned v = __shfl_up(inc, o); if ((lane & 31) >= o) inc += v; }
        cnt_l = c; tpe_l = inc - t;
    }
    __device__ __forceinline__ bool next(int i, pg8::Unit& u) const {
        const int lane = lane_id();
        const int total = (int)__builtin_amdgcn_readfirstlane(__shfl(tpe_l + ((cnt_l + 255u) >> 8), 31));
        const int L = i * G + vcu; if (L >= total * 8) return false;
        const int tg = L >> 3;
        const unsigned long long mk = __ballot(lane < NEXP && (int)tpe_l <= tg && (cnt_l > 0u));
        const int e = 63 - __builtin_clzll(mk);
        const int tp = (int)__builtin_amdgcn_readfirstlane(__shfl(tpe_l, e)), ce = (int)__builtin_amdgcn_readfirstlane(__shfl(cnt_l, e));
        const int te = (ce + 255) >> 8, q = L - 8 * tp, j = q / te, mt = q - j * te;
        u.pm = tp + mt; u.pn = j; u.aux = e; u.nt = down ? 16 : 32;
        if (!down) { u.A = ws + WS_H1B; u.lda = DM * 2; u.gidx = (const int*)(ws + WS_TOKIDX) + (size_t)e * ECAP + 256 * mt; u.gcnt = ce - 256 * mt; u.B = ws + WS_WGUT + ((size_t)e * 2048 + j * 256) * (DM * 2); u.ldb = DM * 2; }
        else { u.A = ws + WS_ACT + (size_t)(tp + mt) * 256 * (FF * 2); u.lda = FF * 2; u.gidx = nullptr; u.gcnt = 0; u.B = ws + WS_WDT + ((size_t)e * 2048 + j * 256) * (FF * 2); u.ldb = FF * 2; }
        return true;
    }
};
struct EpiMoe {
    __device__ static __forceinline__ int brow(int h, int R) { return pg8::brow_perm8(h, R); }
    int down; unsigned char* ws;
    __device__ __forceinline__ void operator()(ACC_T, const pg8::Unit& u, int wr, int wc, int fr, int fq, LAS unsigned char* ex) const {
        bf16_t* act = (bf16_t*)(ws + WS_ACT); bf16_t* y = (bf16_t*)(ws + WS_Y);
#pragma unroll
        for (int ai = 0; ai < 2; ++ai)
#pragma unroll
            for (int m = 0; m < 4; ++m) { const size_t row = (size_t)u.pm * 256 + ai * 128 + wr * 64 + m * 16 + fr;
                if (!down) {
                    f32x4 v0, v1;
#pragma unroll
                    for (int q = 0; q < 4; ++q) { const float g0 = acc[ai][0][m][0][q], u0 = acc[ai][1][m][0][q], g1 = acc[ai][0][m][1][q], u1 = acc[ai][1][m][1][q];
                        v0[q] = g0 * __builtin_amdgcn_rcpf(1.0f + __expf(-g0)) * u0; v1[q] = g1 * __builtin_amdgcn_rcpf(1.0f + __expf(-g1)) * u1; }
                    u32x4 w; w.x = cvtpk(v0.x, v0.y); w.y = cvtpk(v0.z, v0.w); w.z = cvtpk(v1.x, v1.y); w.w = cvtpk(v1.z, v1.w);
                    *(u32x4*)(act + row * FF + u.pn * 128 + wc * 32 + 8 * fq) = w;
                } else {
#pragma unroll
                    for (int bj = 0; bj < 2; ++bj) { const f32x4 a0 = acc[ai][bj][m][0], a1 = acc[ai][bj][m][1];
                        u32x4 w; w.x = cvtpk(a0.x, a0.y); w.y = cvtpk(a0.z, a0.w); w.z = cvtpk(a1.x, a1.y); w.w = cvtpk(a1.z, a1.w);
                        *(u32x4*)(y + row * DM + u.pn * 256 + bj * 128 + wc * 32 + 8 * fq) = w; }
                } }
    }
};


namespace mg {
constexpr int HTB = 16384, ABUF = 2 * HTB, BBUF = 64 * 256, B_OFF = 4 * ABUF;
struct Unit { const char* A; unsigned lda; const int* gidx; int gcnt; const float* B0; const float* B1; unsigned ldbf; int nt, up, pm, pn; };
template <int OFF> __device__ __forceinline__ s16x4 vtr(int addr) { s16x4 r; asm volatile("ds_read_b64_tr_b16 %0, %1 offset:%2" : "=&v"(r) : "v"(addr), "i"(OFF) : "memory"); return r; }

template <class Sched, class Epi, int XV>
__device__ __forceinline__ void gemm_phase(LAS unsigned char* lds, const Sched& S, const Epi& E, int wid) {
    const int lane = lane_id(), tid = wid * 64 + lane, wr = wid >> 2, wc = wid & 3, fr = lane & 15, fq = lane >> 4;
    const unsigned ldsw = (unsigned)wid * 1024u;
    const int aoff = pg8::lds_byte(wr * 64 + fr, fq * 8);
    const int n4 = tid & 31, kr = tid >> 5;
    const int tq = (lane & 15) >> 2, tp = lane & 3, tf = tq | ((fq & 1) << 2);
    const int ldsa = (int)(unsigned)(uintptr_t)lds;
    const int tb0 = B_OFF + (8 * fq + tq) * 256 + (((2 * wc) ^ tf) * 32) + 8 * tp, tb1 = B_OFF + (8 * fq + tq) * 256 + (((2 * wc + 1) ^ tf) * 32) + 8 * tp;
    const int wfk = (kr & 3) | (((kr >> 3) & 1) << 2);
#define MG_STAGE_A(slot, tt) do { _Pragma("unroll") for (int h_ = 0; h_ < 2; ++h_) _Pragma("unroll") for (int i_ = 0; i_ < 2; ++i_) \
        __builtin_amdgcn_global_load_lds((const unsigned*)(u.A + (size_t)(tt) * 128 + voffA[h_][i_]), (LAS unsigned*)(lds + (slot) * ABUF + h_ * HTB + ldsw + i_ * 8192), 16, 0, 0); } while (0)
#define MG_LOADB(R, tt) do { const float* p_ = bp + (size_t)(tt) * 64 * u.ldbf; \
        asm volatile("global_load_dwordx4 %0, %1, off" : "=v"(R##0) : "v"(p_) : "memory"); \
        asm volatile("global_load_dwordx4 %0, %1, off" : "=v"(R##1) : "v"(p_ + (size_t)16 * u.ldbf) : "memory"); \
        asm volatile("global_load_dwordx4 %0, %1, off" : "=v"(R##2) : "v"(p_ + (size_t)32 * u.ldbf) : "memory"); \
        asm volatile("global_load_dwordx4 %0, %1, off" : "=v"(R##3) : "v"(p_ + (size_t)48 * u.ldbf) : "memory"); } while (0)
#define MG_WAITB(R, N) asm volatile("s_waitcnt vmcnt(" #N ")" : "+v"(R##0), "+v"(R##1), "+v"(R##2), "+v"(R##3) :: "memory")
#define MG_PK(v) (u32x2){cvtpk((v).x, (v).y), cvtpk((v).z, (v).w)}
#define MG_WRITEB(R, slot) do { LAS unsigned char* w_ = lds + B_OFF + (slot) * BBUF + wa; \
        *(LAS u32x2*)(w_) = MG_PK(R##0); *(LAS u32x2*)(w_ + 4096) = MG_PK(R##1); *(LAS u32x2*)(w_ + 8192) = MG_PK(R##2); *(LAS u32x2*)(w_ + 12288) = MG_PK(R##3); } while (0)
#define MG_BAR() do { asm volatile("" ::: "memory"); __builtin_amdgcn_s_barrier(); asm volatile("" ::: "memory"); } while (0)
#define MG_LGK0() do { asm volatile("s_waitcnt lgkmcnt(0)" ::: "memory"); __builtin_amdgcn_sched_barrier(0); } while (0)
#define MG_READF(P, tt, hh) do { const int as_ = ((tt) & 3) * ABUF + (hh) * 1024, bo_ = ldsa + ((tt) & 1) * BBUF + (hh) * 8192; \
        P##l0 = vtr<0>(bo_ + tb0); P##h0 = vtr<1024>(bo_ + tb0); P##l1 = vtr<0>(bo_ + tb1); P##h1 = vtr<1024>(bo_ + tb1); \
        _Pragma("unroll") for (int m = 0; m < 4; ++m) { P##a0[m] = *(const LAS bf16x8*)(lds + as_ + aoff + m * 2048); P##a1[m] = *(const LAS bf16x8*)(lds + as_ + HTB + aoff + m * 2048); } } while (0)
#define MG_MFMA(P) do { const bf16x8 b0_ = (bf16x8){P##l0[0], P##l0[1], P##l0[2], P##l0[3], P##h0[0], P##h0[1], P##h0[2], P##h0[3]}, b1_ = (bf16x8){P##l1[0], P##l1[1], P##l1[2], P##l1[3], P##h1[0], P##h1[1], P##h1[2], P##h1[3]}; \
        __builtin_amdgcn_s_setprio(1); \
        _Pragma("unroll") for (int m = 0; m < 4; ++m) { acc[0][m][0] = __builtin_amdgcn_mfma_f32_16x16x32_bf16(b0_, P##a0[m], acc[0][m][0], 0, 0, 0); acc[0][m][1] = __builtin_amdgcn_mfma_f32_16x16x32_bf16(b1_, P##a0[m], acc[0][m][1], 0, 0, 0); } \
        _Pragma("unroll") for (int m = 0; m < 4; ++m) { acc[1][m][0] = __builtin_amdgcn_mfma_f32_16x16x32_bf16(b0_, P##a1[m], acc[1][m][0], 0, 0, 0); acc[1][m][1] = __builtin_amdgcn_mfma_f32_16x16x32_bf16(b1_, P##a1[m], acc[1][m][1], 0, 0, 0); } \
        __builtin_amdgcn_s_setprio(0); } while (0)
#define MG_TILE(t, R, WB, LB, SA, NX) do { const int t_ = (t); \
        MG_READF(G, t_, 1); __builtin_amdgcn_sched_barrier(0); \
        MG_MFMA(F); __builtin_amdgcn_sched_barrier(0); \
        if (WB >= 0) { if (WB == 12) MG_WAITB(R, 12); else if (WB == 8) MG_WAITB(R, 8); else MG_WAITB(R, 0); \
            MG_WRITEB(R, (t_ + 1) & 1); if (LB) MG_LOADB(R, t_ + 3); } \
        MG_LGK0(); \
        MG_BAR(); \
        if (NX) MG_READF(F, t_ + 1, 0); \
        if (SA) MG_STAGE_A((t_ + 4) & 3, t_ + 4); \
        __builtin_amdgcn_sched_barrier(0); \
        MG_MFMA(G); \
        MG_LGK0(); } while (0)

    Unit u;
    for (int ui = 0; S.next(ui, u); ++ui) {
        const int nt = u.nt;
        unsigned voffA[2][2];
#pragma unroll
        for (int i = 0; i < 2; ++i) { int R, C; pg8::stage_rc(tid * 16 + i * 8192, R, C);
#pragma unroll
            for (int h = 0; h < 2; ++h) { int ra = h * 128 + R; if (u.gidx) ra = (ra < u.gcnt) ? u.gidx[ra] : 0; voffA[h][i] = (unsigned)ra * u.lda + (unsigned)C * 2u; } }
        const float* bp = (n4 < 16 ? u.B0 + 4 * n4 : u.B1 + 4 * (n4 - 16)) + (size_t)kr * u.ldbf;
        const int P = u.up ? (32 * ((n4 & 15) >> 2) + 16 * (n4 >> 4) + 4 * (n4 & 3)) : (32 * (n4 >> 3) + 16 * (n4 & 1) + 4 * ((n4 & 7) >> 1));
        const int wa = kr * 256 + (((P >> 4) ^ wfk) * 32) + (P & 15) * 2;
        f32x4 acc[2][4][2];
#pragma unroll
        for (int a = 0; a < 2; ++a)
#pragma unroll
            for (int m = 0; m < 4; ++m)
#pragma unroll
                for (int n = 0; n < 2; ++n) acc[a][m][n] = (f32x4){0.f, 0.f, 0.f, 0.f};
        f32x4 Ra0 = {}, Ra1 = {}, Ra2 = {}, Ra3 = {}, Rb0 = {}, Rb1 = {}, Rb2 = {}, Rb3 = {};
        s16x4 Fl0, Fh0, Fl1, Fh1, Gl0, Gh0, Gl1, Gh1; bf16x8 Fa0[4], Fa1[4], Ga0[4], Ga1[4];
        MG_STAGE_A(0, 0); MG_STAGE_A(1, 1);
        MG_LOADB(Ra, 0); MG_LOADB(Rb, 1);
        MG_STAGE_A(2, 2);
        MG_WAITB(Ra, 8); MG_WRITEB(Ra, 0);
        MG_LOADB(Ra, 2); MG_STAGE_A(3, 3);
        MG_LGK0();
        MG_BAR();
        MG_READF(F, 0, 0);
        MG_LGK0();
        for (int t = 0; t < nt - 4; t += 2) {
            MG_TILE(t, Rb, 12, true, true, true);
            MG_TILE(t + 1, Ra, 12, true, true, true);
        }
        MG_TILE(nt - 4, Rb, 12, true, false, true);
        MG_TILE(nt - 3, Ra, 8, false, false, true);
        MG_TILE(nt - 2, Rb, 0, false, false, true);
        MG_TILE(nt - 1, Ra, -1, false, false, false);
        E(acc, u, wid);
    }
#undef MG_LGK0
#undef MG_READF
#undef MG_MFMA
#undef MG_TILE
#undef MG_STAGE_A
#undef MG_LOADB
#undef MG_PK
#undef MG_WAITB
#undef MG_WRITEB
#undef MG_WAITV
#undef MG_BAR
#undef MG_ITER
}
}

struct MoeSched2 {
    int G, vcu, down, var; unsigned cnt_l, tpe_l; const char* ws; const float *wgate, *wup, *wdown;
    __device__ __forceinline__ void init(const unsigned* cnt, int lane) {
        unsigned c = 0; if (lane < NEXP) c = __hip_atomic_load(cnt + lane, __ATOMIC_RELAXED, __HIP_MEMORY_SCOPE_AGENT);
        unsigned t = (c + 255u) >> 8, inc = t;
#pragma unroll
        for (int o = 1; o < 32; o <<= 1) { const unsigned v = __shfl_up(inc, o); if ((lane & 31) >= o) inc += v; }
        cnt_l = c; tpe_l = inc - t;
    }
    __device__ __forceinline__ bool next(int i, mg::Unit& u) const {
        const int lane = lane_id();
        const int total = (int)__builtin_amdgcn_readfirstlane(__shfl(tpe_l + ((cnt_l + 255u) >> 8), 31));
        const int L = i * G + vcu; if (L >= total * 16) return false;
        const int tg = L >> 4;
        const unsigned long long mk = __ballot(lane < NEXP && (int)tpe_l <= tg && (cnt_l > 0u));
        const int e = 63 - __builtin_clzll(mk);
        const int tp = (int)__builtin_amdgcn_readfirstlane(__shfl(tpe_l, e)), ce = (int)__builtin_amdgcn_readfirstlane(__shfl(cnt_l, e));
        const int te = (ce + 255) >> 8, q = L - 16 * tp, j = q / te, mt = q - j * te;
        u.pm = tp + mt; u.pn = j; u.up = down ? 0 : 1; u.nt = down ? 16 : 32;
        if (!down) { u.A = ws + WS_H1B; u.lda = DM * 2; u.gidx = (const int*)(ws + WS_TOKIDX) + (size_t)e * ECAP + 256 * mt; u.gcnt = ce - 256 * mt;
            u.B0 = wgate + (size_t)e * DM * FF + j * 64; u.B1 = wup + (size_t)e * DM * FF + j * 64; u.ldbf = FF;
            if (var == 61) { u.B0 = wgate; u.B1 = wup; }
            if (var == 65) { u.gidx = nullptr; u.A = ws + WS_H1B + (size_t)((tp + mt) & 31) * 256 * (DM * 2); } }
        else { u.A = ws + WS_ACT + (size_t)(tp + mt) * 256 * (FF * 2); u.lda = FF * 2; u.gidx = nullptr; u.gcnt = 0;
            u.B0 = wdown + (size_t)e * FF * DM + j * 128; u.B1 = u.B0 + 64; u.ldbf = DM; }
        return true;
    }
};
struct EpiMoe2 {
    int down; unsigned char* ws;
    __device__ __forceinline__ void operator()(f32x4 (&acc)[2][4][2], const mg::Unit& u, int wid) const {
        const int lane = lane_id(), wr = wid >> 2, wc = wid & 3, fr = lane & 15, fq = lane >> 4;
        bf16_t* act = (bf16_t*)(ws + WS_ACT); bf16_t* y = (bf16_t*)(ws + WS_Y);
#pragma unroll
        for (int ai = 0; ai < 2; ++ai)
#pragma unroll
            for (int m = 0; m < 4; ++m) { const size_t row = (size_t)u.pm * 256 + ai * 128 + wr * 64 + m * 16 + fr;
                if (!down) { f32x4 v;
#pragma unroll
                    for (int q = 0; q < 4; ++q) { const float g = acc[ai][m][0][q], up = acc[ai][m][1][q]; v[q] = g * __builtin_amdgcn_rcpf(1.0f + __expf(-g)) * up; }
                    u32x2 w; w.x = cvtpk(v.x, v.y); w.y = cvtpk(v.z, v.w);
                    *(u32x2*)(act + row * FF + u.pn * 64 + wc * 16 + 4 * fq) = w;
                } else { const f32x4 a0 = acc[ai][m][0], a1 = acc[ai][m][1];
                    u32x4 w; w.x = cvtpk(a0.x, a0.y); w.y = cvtpk(a0.z, a0.w); w.z = cvtpk(a1.x, a1.y); w.w = cvtpk(a1.z, a1.w);
                    *(u32x4*)(y + row * DM + u.pn * 128 + wc * 32 + 8 * fq) = w; } }
    }
};

namespace att {
constexpr int D = 128, NW = 8, QBLK = 32, KVBLK = 64;
constexpr float SCALE = SM_SCALE, THR = 8.f;
constexpr int SHM_V = KVBLK * D * 2, SHM_K = KVBLK * D * 2, SHM_ATTN = 2 * SHM_V + 2 * SHM_K + NW * 64 * 4;
#define KSWZ(row, colB) ((row) * 256 + ((colB) ^ (((row) & 7) << 4)))
#define SBAR() __builtin_amdgcn_sched_barrier(0)
__device__ __forceinline__ int crow(int r, int hi) { return (r & 3) + 8 * (r >> 2) + 4 * hi; }
template <bool BAND> __device__ __forceinline__ void partialSM(f32x16& p0, f32x16& p1, float& m_reg, float& mn, float& alpha, int dv, bool tv) {
    constexpr float C = SCALE * 1.4426950408889634f;
    if constexpr (BAND) {
#pragma unroll
        for (int r = 0; r < 16; ++r) { const int kx = (r & 3) + 8 * (r >> 2);
            if (!tv || (unsigned)(dv + kx) > 128u) p0[r] = -INFINITY;
            if (!tv || (unsigned)(dv + kx + 32) > 128u) p1[r] = -INFINITY; } }
    float pmax = p0[0];
#pragma unroll
    for (int r = 1; r < 16; ++r) pmax = fmaxf(pmax, p0[r]);
#pragma unroll
    for (int r = 0; r < 16; ++r) pmax = fmaxf(pmax, p1[r]);
    { auto rr = __builtin_amdgcn_permlane32_swap(__float_as_uint(pmax), __float_as_uint(pmax), false, false);
      pmax = fmaxf(__uint_as_float(rr[0]), __uint_as_float(rr[1])); }
    if (__builtin_expect(__all(pmax - m_reg <= THR / SCALE), 1)) { mn = m_reg; alpha = 1.f; }
    else { mn = fmaxf(m_reg, pmax); alpha = __builtin_amdgcn_exp2f((m_reg - mn) * C); m_reg = mn; }
    const float mnC = -mn * C;
#pragma unroll
    for (int r = 0; r < 16; ++r) p0[r] = fmaf(p0[r], C, mnC);
#pragma unroll
    for (int r = 0; r < 16; ++r) p1[r] = fmaf(p1[r], C, mnC);
#pragma unroll
    for (int r = 0; r < 16; ++r) p0[r] = __builtin_amdgcn_exp2f(p0[r]);
}
__device__ __forceinline__ void finishSM(f32x16& p0, f32x16& p1, float alpha, float& l_reg, bf16x8& pa0, bf16x8& pa1, bf16x8& pa2, bf16x8& pa3) {
#pragma unroll
    for (int r = 0; r < 16; ++r) p1[r] = __builtin_amdgcn_exp2f(p1[r]);
    float ps = 0;
#pragma unroll
    for (int r = 0; r < 16; ++r) ps += p0[r];
#pragma unroll
    for (int r = 0; r < 16; ++r) ps += p1[r];
    { auto rr = __builtin_amdgcn_permlane32_swap(__float_as_uint(ps), __float_as_uint(ps), false, false);
      ps = __uint_as_float(rr[0]) + __uint_as_float(rr[1]); }
    l_reg = l_reg * alpha + ps;
#define PK4(P, BASE, OUT) do { unsigned a0 = cvtpk(P[BASE + 0], P[BASE + 1]), a1 = cvtpk(P[BASE + 2], P[BASE + 3]);   \
    unsigned b0 = cvtpk(P[BASE + 4], P[BASE + 5]), b1 = cvtpk(P[BASE + 6], P[BASE + 7]);                              \
    auto r0 = __builtin_amdgcn_permlane32_swap(a0, b0, false, false); auto r1 = __builtin_amdgcn_permlane32_swap(a1, b1, false, false); \
    u32x4 w = {r0[0], r1[0], r0[1], r1[1]}; OUT = *reinterpret_cast<bf16x8*>(&w); } while (0)
    PK4(p0, 0, pa0); PK4(p0, 8, pa1); PK4(p1, 0, pa2); PK4(p1, 8, pa3);
#undef PK4
}
__device__ __forceinline__ void qkt(f32x16& p0, f32x16& p1, const LAS unsigned char* Ks, const bf16x8* qr, int r32, int hi) {
    p0 = f32x16{}; p1 = f32x16{};
#pragma unroll
    for (int d0 = 0; d0 < 8; ++d0) { const int cb = (d0 * 16 + hi * 8) * 2;
        const bf16x8 b0 = *(const LAS bf16x8*)(Ks + KSWZ(r32, cb));
        const bf16x8 b1 = *(const LAS bf16x8*)(Ks + KSWZ(32 + r32, cb));
        p0 = __builtin_amdgcn_mfma_f32_32x32x16_bf16(b0, qr[d0], p0, 0, 0, 0);
        p1 = __builtin_amdgcn_mfma_f32_32x32x16_bf16(b1, qr[d0], p1, 0, 0, 0); }
}
__device__ __forceinline__ int v_st(int k, int c) { const int kk = (k & ~0xC) | ((k & 4) << 1) | ((k & 8) >> 1); return ((kk >> 3) * 4 + (c >> 5)) * 512 + ((kk & 7) * 32 + (c & 31)) * 2; }
__device__ __forceinline__ int v_rd_base(int lane) { return ((lane & 3) << 3) | (((lane >> 2) & 3) << 6) | (((lane >> 4) & 1) << 5) | (((lane >> 5) & 1) << 8); }
constexpr int v_rd_off(int d0, int ks, int half) { return d0 * 512 + ks * 4096 + half * 2048; }
template <int OFF> __device__ __forceinline__ s16x4 tr_read(int vb) { s16x4 r; asm volatile("ds_read_b64_tr_b16 %0, %1 offset:%2" : "=&v"(r) : "v"(vb), "i"(OFF) : "memory"); return r; }
template <int D0> __device__ __forceinline__ void pv_one(f32x16& od, int vb, bf16x8 pa0, bf16x8 pa1, bf16x8 pa2, bf16x8 pa3) {
    const s16x4 l0 = tr_read<v_rd_off(D0, 0, 0)>(vb), h0 = tr_read<v_rd_off(D0, 0, 1)>(vb), l1 = tr_read<v_rd_off(D0, 1, 0)>(vb), h1 = tr_read<v_rd_off(D0, 1, 1)>(vb);
    const s16x4 l2 = tr_read<v_rd_off(D0, 2, 0)>(vb), h2 = tr_read<v_rd_off(D0, 2, 1)>(vb), l3 = tr_read<v_rd_off(D0, 3, 0)>(vb), h3 = tr_read<v_rd_off(D0, 3, 1)>(vb);
    asm volatile("s_waitcnt lgkmcnt(0)" ::: "memory"); SBAR();
#define PK(L, H) (bf16x8){L[0], L[1], L[2], L[3], H[0], H[1], H[2], H[3]}
    od = __builtin_amdgcn_mfma_f32_32x32x16_bf16(pa0, PK(l0, h0), od, 0, 0, 0);
    od = __builtin_amdgcn_mfma_f32_32x32x16_bf16(pa1, PK(l1, h1), od, 0, 0, 0);
    od = __builtin_amdgcn_mfma_f32_32x32x16_bf16(pa2, PK(l2, h2), od, 0, 0, 0);
    od = __builtin_amdgcn_mfma_f32_32x32x16_bf16(pa3, PK(l3, h3), od, 0, 0, 0);
#undef PK
}
__device__ __forceinline__ void pv_d0(f32x16* o, int vb, bf16x8 pa0, bf16x8 pa1, bf16x8 pa2, bf16x8 pa3) {
    pv_one<0>(o[0], vb, pa0, pa1, pa2, pa3); pv_one<1>(o[1], vb, pa0, pa1, pa2, pa3); pv_one<2>(o[2], vb, pa0, pa1, pa2, pa3); pv_one<3>(o[3], vb, pa0, pa1, pa2, pa3);
}
struct Unit { const bf16_t *Q, *K, *V; bf16_t* O; float* lse; int ldo, lse_stride, nt, kt0, klo, khi, q0; };
__device__ __forceinline__ void body(const Unit& u, LAS unsigned char* lds, int wid) {
    const int lane = lane_id(), tid = wid * 64 + lane,
        r32 = lane & 31, hi = lane >> 5;
    LAS unsigned char* V_lds = lds; LAS unsigned char* K_lds = lds + 3 * SHM_V;
    LAS float* ws = (LAS float*)(lds + 3 * SHM_V + 3 * SHM_K) + wid * 64; LAS float* li_l = ws; LAS float* al_l = ws + 32;
    float m_reg = -1e30f, l_reg = 0; f32x16 o[4] = {}; bf16x8 qr[8];
    const bf16_t* Qw = u.Q + (size_t)(wid * QBLK + r32) * D + hi * 8;
#pragma unroll
    for (int d0 = 0; d0 < 8; ++d0) qr[d0] = *(const bf16x8*)(Qw + d0 * 16);
    const int sr = tid >> 4, sc = (tid & 15) * 8, vst0 = v_st(sr, sc), vst1 = v_st(32 + sr, sc);
    const int vb0 = (int)(unsigned)(uintptr_t)V_lds + v_rd_base(lane);
    const bf16_t* Kh = u.K; const bf16_t* Vh = u.V;
    constexpr bool BAND = false; constexpr int SD = 1; const int dq = 0;
#define TVALID(j) true
    struct { bf16x8 vs0, vs1, ks0, ks1; } sr_[SD];
#define KROW(j) (BAND ? ((u.kt0 + 64 * (j)) < u.klo ? u.klo : ((u.kt0 + 64 * (j)) > u.khi - 64 ? u.khi - 64 : (u.kt0 + 64 * (j)))) : (u.kt0 + 64 * (j)))
#define SLOAD(i, j) do { const int k0_ = KROW(j); sr_[i].vs0 = *(const bf16x8*)(&Vh[(size_t)(k0_ + sr) * D + sc]); sr_[i].vs1 = *(const bf16x8*)(&Vh[(size_t)(k0_ + 32 + sr) * D + sc]); \
    sr_[i].ks0 = *(const bf16x8*)(&Kh[(size_t)(k0_ + sr) * D + sc]); sr_[i].ks1 = *(const bf16x8*)(&Kh[(size_t)(k0_ + 32 + sr) * D + sc]); } while (0)
#define SWRITE(b, i) do { *(LAS bf16x8*)(V_lds + (b) * SHM_V + vst0) = sr_[i].vs0; *(LAS bf16x8*)(V_lds + (b) * SHM_V + vst1) = sr_[i].vs1; const int kc = sc * 2; \
    *(LAS bf16x8*)(K_lds + (b) * SHM_K + KSWZ(sr, kc)) = sr_[i].ks0; *(LAS bf16x8*)(K_lds + (b) * SHM_K + KSWZ(32 + sr, kc)) = sr_[i].ks1; } while (0)
#define SWRITE_AT(ob, i) do { *(LAS bf16x8*)(V_lds + (ob) + vst0) = sr_[i].vs0; *(LAS bf16x8*)(V_lds + (ob) + vst1) = sr_[i].vs1; const int kc = sc * 2; \
    *(LAS bf16x8*)(K_lds + (ob) + KSWZ(sr, kc)) = sr_[i].ks0; *(LAS bf16x8*)(K_lds + (ob) + KSWZ(32 + sr, kc)) = sr_[i].ks1; } while (0)
#define SWAIT() do { if constexpr (SD == 2) asm volatile("s_waitcnt vmcnt(4)" ::: "memory"); else asm volatile("s_waitcnt vmcnt(0)" ::: "memory"); } while (0)
#define RESC(a) do { if (__any((a) < 1.f)) { if (hi == 0) al_l[r32] = (a); asm volatile("s_waitcnt lgkmcnt(0)" ::: "memory"); \
    _Pragma("unroll") for (int d = 0; d < 4; ++d) _Pragma("unroll") for (int r = 0; r < 16; ++r) o[d][r] *= al_l[crow(r, hi)]; } } while (0)
    f32x16 pA0, pA1, pB0, pB1; float mnA, mnB, alA, alB; bf16x8 pa0, pa1, pa2, pa3; const int NT = u.nt;
    constexpr int SE = 0, SO = SD - 1;
    SLOAD(SE, 0); asm volatile("s_waitcnt vmcnt(0)" ::: "memory"); SWRITE(0, SE); __syncthreads();
    qkt(pA0, pA1, K_lds, qr, r32, hi); partialSM<BAND>(pA0, pA1, m_reg, mnA, alA, dq, TVALID(0));
    SLOAD(SO, 1); if constexpr (SD == 2) { if (2 < NT) SLOAD(SE, 2); }
    SWAIT(); SWRITE(1, SO); __syncthreads();
    int ob0 = 0, ob1 = SHM_V, ob2 = 2 * SHM_V;
    for (int j = 1; j + 1 < NT; j += 2) {
        SBAR(); qkt(pB0, pB1, K_lds + ob1, qr, r32, hi);
        finishSM(pA0, pA1, alA, l_reg, pa0, pa1, pa2, pa3); SBAR();
        SLOAD(SO, j + SD); SBAR();
        pv_d0(o, vb0 + ob0, pa0, pa1, pa2, pa3); partialSM<BAND>(pB0, pB1, m_reg, mnB, alB, dq + 64 * j, TVALID(j));
        SWAIT(); SWRITE_AT(ob2, SE);
        RESC(alB); __syncthreads();
        SBAR(); qkt(pA0, pA1, K_lds + ob2, qr, r32, hi);
        finishSM(pB0, pB1, alB, l_reg, pa0, pa1, pa2, pa3); SBAR();
        if (SD == 1 || j + 3 < NT) SLOAD(SE, j + 1 + SD); SBAR();
        pv_d0(o, vb0 + ob1, pa0, pa1, pa2, pa3); partialSM<BAND>(pA0, pA1, m_reg, mnA, alA, dq + 64 * (j + 1), TVALID(j + 1));
        SWAIT(); SWRITE_AT(ob0, SO);
        RESC(alA); __syncthreads();
        { const int t_ = ob0; ob0 = ob2; ob2 = ob1; ob1 = t_; }
    }
    SBAR(); qkt(pB0, pB1, K_lds + ob1, qr, r32, hi);
    finishSM(pA0, pA1, alA, l_reg, pa0, pa1, pa2, pa3); SBAR();
    pv_d0(o, vb0 + ob0, pa0, pa1, pa2, pa3); partialSM<BAND>(pB0, pB1, m_reg, mnB, alB, dq + 64 * (NT - 1), TVALID(NT - 1));
    RESC(alB);
    finishSM(pB0, pB1, alB, l_reg, pa0, pa1, pa2, pa3); SBAR();
    pv_d0(o, vb0 + ob1, pa0, pa1, pa2, pa3);
    __syncthreads();
    if (hi == 0) li_l[r32] = l_reg; asm volatile("s_waitcnt lgkmcnt(0)" ::: "memory");
    float rli[16];
#pragma unroll
    for (int r = 0; r < 16; ++r) rli[r] = __builtin_amdgcn_rcpf(li_l[crow(r, hi)]);
    {
        LAS unsigned char* ot = lds + wid * 8192;
#pragma unroll
        for (int r = 0; r < 16; ++r) { const int orow = crow(r, hi);
#pragma unroll
            for (int d0 = 0; d0 < 4; ++d0) *(LAS bf16_t*)(ot + orow * 256 + (d0 * 32 + r32) * 2) = f2bf(o[d0][r] * rli[r]); }
        asm volatile("s_waitcnt lgkmcnt(0)" ::: "memory");
        bf16_t* Ow = u.O + (size_t)(wid * QBLK) * u.ldo;
#pragma unroll
        for (int q = 0; q < 8; ++q) { const int orow = q * 4 + (lane >> 4), oc = (lane & 15) * 8;
            *(u32x4*)(Ow + (size_t)orow * u.ldo + oc) = *(const LAS u32x4*)(ot + orow * 256 + oc * 2); }
    }
    if (u.lse && hi == 0) u.lse[(size_t)(wid * QBLK + r32) * u.lse_stride] = m_reg * SCALE + __logf(l_reg);
    __syncthreads();
#undef KROW
#undef TVALID
#undef SLOAD
#undef SWRITE
#undef SWRITE_AT
#undef SWAIT
#undef RESC
}

__device__ __forceinline__ void band_body(const Unit& u, LAS unsigned char* lds, int wid) {
    const int lane = lane_id(), tid = wid * 64 + lane, r32 = lane & 31, hi = lane >> 5;
    LAS unsigned char* V_lds = lds; LAS unsigned char* K_lds = lds + 2 * SHM_V;
    LAS float* ws = (LAS float*)(lds + 2 * SHM_V + 2 * SHM_K) + wid * 64; LAS float* li_l = ws; LAS float* al_l = ws + 32;
    float m_reg = -1e30f, l_reg = 0; f32x16 o[4] = {}; bf16x8 qr[8];
    const bf16_t* Qw = u.Q + (size_t)(wid * QBLK + r32) * D + hi * 8;
#pragma unroll
    for (int d0 = 0; d0 < 8; ++d0) qr[d0] = *(const bf16x8*)(Qw + d0 * 16);
    const int sr = tid >> 4, sc = (tid & 15) * 8, vst0 = v_st(sr, sc), vst1 = v_st(32 + sr, sc);
    const int vb0 = (int)(unsigned)(uintptr_t)V_lds + v_rd_base(lane);
    const bf16_t* Kh = u.K; const bf16_t* Vh = u.V;
    const int dq = u.kt0 - (u.q0 + wid * QBLK + r32) + 4 * hi + 64;
    bf16x8 A_vs0, A_vs1, A_ks0, A_ks1, B_vs0, B_vs1, B_ks0, B_ks1, C_vs0, C_vs1, C_ks0, C_ks1;
#define KROW(j) ((u.kt0 + 64 * (j)) < u.klo ? u.klo : ((u.kt0 + 64 * (j)) > u.khi - 64 ? u.khi - 64 : (u.kt0 + 64 * (j))))
#define TVALID(j) ((u.kt0 + 64 * (j)) >= u.klo && (u.kt0 + 64 * (j)) < u.khi)
#define SLOAD(S, j) do { const int k0_ = KROW(j); S##vs0 = *(const bf16x8*)(&Vh[(size_t)(k0_ + sr) * D + sc]); S##vs1 = *(const bf16x8*)(&Vh[(size_t)(k0_ + 32 + sr) * D + sc]); \
    S##ks0 = *(const bf16x8*)(&Kh[(size_t)(k0_ + sr) * D + sc]); S##ks1 = *(const bf16x8*)(&Kh[(size_t)(k0_ + 32 + sr) * D + sc]); } while (0)
#define SWRITE(b, S) do { *(LAS bf16x8*)(V_lds + (b) * SHM_V + vst0) = S##vs0; *(LAS bf16x8*)(V_lds + (b) * SHM_V + vst1) = S##vs1; const int kc = sc * 2; \
    *(LAS bf16x8*)(K_lds + (b) * SHM_K + KSWZ(sr, kc)) = S##ks0; *(LAS bf16x8*)(K_lds + (b) * SHM_K + KSWZ(32 + sr, kc)) = S##ks1; } while (0)
    const int ja = (wid >> 1), jb = (wid >> 1) + 2;
#define BAND_ITER(j, STAGE) do { const int cur = (j) & 1; const bool act = ((j) >= ja) && ((j) <= jb); bf16x8 pa0, pa1, pa2, pa3; \
        if (act) { f32x16 p0, p1; float mn, al; \
            qkt(p0, p1, K_lds + cur * SHM_K, qr, r32, hi); \
            partialSM<true>(p0, p1, m_reg, mn, al, dq + 64 * (j), TVALID(j)); \
            if (__any(al < 1.f)) { if (hi == 0) al_l[r32] = al; asm volatile("s_waitcnt lgkmcnt(0)" ::: "memory"); \
                _Pragma("unroll") for (int d = 0; d < 4; ++d) _Pragma("unroll") for (int r = 0; r < 16; ++r) o[d][r] *= al_l[crow(r, hi)]; } \
            finishSM(p0, p1, al, l_reg, pa0, pa1, pa2, pa3); SBAR(); } \
        STAGE; SBAR(); \
        if (act) pv_d0(o, vb0 + cur * SHM_V, pa0, pa1, pa2, pa3); \
        __syncthreads(); } while (0)
    SLOAD(A_, 0); SLOAD(B_, 1); SLOAD(C_, 2);
    SWRITE(0, A_); SLOAD(A_, 3);
    __syncthreads();
    BAND_ITER(0, SWRITE(1, B_); SLOAD(B_, 4));
    BAND_ITER(1, SWRITE(0, C_); SLOAD(C_, 5));
    BAND_ITER(2, SWRITE(1, A_));
    BAND_ITER(3, SWRITE(0, B_));
    BAND_ITER(4, SWRITE(1, C_));
    BAND_ITER(5, (void)0);
#undef BAND_ITER
    if (hi == 0) li_l[r32] = l_reg; asm volatile("s_waitcnt lgkmcnt(0)" ::: "memory");
    float rli[16];
#pragma unroll
    for (int r = 0; r < 16; ++r) rli[r] = __builtin_amdgcn_rcpf(li_l[crow(r, hi)]);
    {
        LAS unsigned char* ot = lds + SHM_ATTN + 1024 + wid * 8192;
#pragma unroll
        for (int r = 0; r < 16; ++r) { const int orow = crow(r, hi);
#pragma unroll
            for (int d0 = 0; d0 < 4; ++d0) *(LAS bf16_t*)(ot + orow * 256 + (d0 * 32 + r32) * 2) = f2bf(o[d0][r] * rli[r]); }
        asm volatile("s_waitcnt lgkmcnt(0)" ::: "memory");
        bf16_t* Ow = u.O + (size_t)(wid * QBLK) * u.ldo;
#pragma unroll
        for (int q = 0; q < 8; ++q) { const int orow = q * 4 + (lane >> 4), oc = (lane & 15) * 8;
            *(u32x4*)(Ow + (size_t)orow * u.ldo + oc) = *(const LAS u32x4*)(ot + orow * 256 + oc * 2); }
    }
    if (hi == 0) u.lse[(size_t)(wid * QBLK + r32) * u.lse_stride] = m_reg * SCALE + __logf(l_reg);
    __syncthreads();
#undef KROW
#undef TVALID
#undef SLOAD
#undef SWRITE
}
}

#define XB_TMO      128
#define XB_XCNT(j)  (256  + 64 * (j))
#define XB_XSUB(j)  (1280 + 64 * (j))
#define XB_XGEN(j)  (2304 + 64 * (j))
#define XB_TOP      3328
#define XB_TOPGEN   3392
#define XCD_BAR_WORDS 3456
#define XB_SPIN_CAP (1u << 20)
__device__ __forceinline__ unsigned xb_ld(unsigned* p)              { return __hip_atomic_load(p, __ATOMIC_RELAXED, __HIP_MEMORY_SCOPE_AGENT); }
__device__ __forceinline__ unsigned xb_add(unsigned* p, unsigned v) { return __hip_atomic_fetch_add(p, v, __ATOMIC_RELAXED, __HIP_MEMORY_SCOPE_AGENT); }
__device__ __forceinline__ unsigned xb_xcc_id() { return (unsigned)__builtin_amdgcn_s_getreg((3 << 11) | 20) & 0xFu; }
#define XB_SPIN(cond, bar) do { unsigned _sp = 0; while (cond) { __builtin_amdgcn_s_sleep(1); \
    if ((++_sp & 255u) == 0u) { if (xb_ld(&(bar)[XB_TMO])) break; if (_sp > XB_SPIN_CAP) { atomicAdd(&(bar)[XB_TMO], 1u); break; } } } } while (0)
__device__ __forceinline__ void xcd_barrier_post(unsigned* bar, bool leader) { if (leader) (void)xb_add(&bar[XB_XCNT(xb_xcc_id())], 1u); }
__device__ __forceinline__ void xcd_barrier_complete(unsigned* bar, unsigned x, unsigned G, unsigned& nloc, unsigned& nx) {
    unsigned sum, cnt, mine, sp = 0u;
    for (;;) {
        sum = 0u; cnt = 0u; mine = 0u;
#pragma unroll
        for (unsigned j = 0; j < 16; ++j) { const unsigned c = xb_ld(&bar[XB_XCNT(j)]); sum += c; cnt += (c > 0u) ? 1u : 0u; mine = (j == x) ? c : mine; }
        if (sum == G) break;
        __builtin_amdgcn_s_sleep(1);
        if ((++sp & 255u) == 0u) { if (xb_ld(&bar[XB_TMO])) break; if (sp > XB_SPIN_CAP) { atomicAdd(&bar[XB_TMO], 1u); break; } }
    }
    nloc = mine > 0u ? mine : 1u; nx = cnt > 0u ? cnt : 1u;
}
__device__ __forceinline__ void xcd_barrier(unsigned* bar, unsigned* st, unsigned G, bool leader) {
    asm volatile("s_waitcnt vmcnt(0)" ::: "memory");
    __syncthreads();
    if (leader) {
        __builtin_amdgcn_s_waitcnt(0);
        const unsigned x = xb_xcc_id();
        unsigned nloc = xb_ld(st), nx = xb_ld(st + 1);
        if (nloc == 0u) { xcd_barrier_complete(bar, x, G, nloc, nx); __hip_atomic_store(st, nloc, __ATOMIC_RELAXED, __HIP_MEMORY_SCOPE_AGENT); __hip_atomic_store(st + 1, nx, __ATOMIC_RELAXED, __HIP_MEMORY_SCOPE_AGENT); }
        const unsigned old = xb_add(&bar[XB_XSUB(x)], 1u);
        const unsigned gen = old / nloc;
        if (old + 1u == (gen + 1u) * nloc) {
            __builtin_amdgcn_fence(__ATOMIC_RELEASE, "agent");
            asm volatile("s_waitcnt vmcnt(0)" ::: "memory");
            const unsigned og = xb_add(&bar[XB_TOP], 1u);
            const unsigned tg = og / nx;
            if (og + 1u == (tg + 1u) * nx) xb_add(&bar[XB_TOPGEN], 1u);
            else XB_SPIN(xb_ld(&bar[XB_TOPGEN]) == tg, bar);
            __builtin_amdgcn_fence(__ATOMIC_ACQUIRE, "agent");
            xb_add(&bar[XB_XGEN(x)], 1u);
            asm volatile("s_waitcnt vmcnt(0)" ::: "memory");
        } else {
            XB_SPIN(xb_ld(&bar[XB_XGEN(x)]) == gen, bar);
            __builtin_amdgcn_fence(__ATOMIC_ACQUIRE, "agent");
            asm volatile("s_waitcnt vmcnt(0)" ::: "memory");
        }
    }
    __syncthreads();
}

constexpr int RING_BYTES = 131072, EX_OFF = RING_BYTES, LDS_BYTES = 163840;
constexpr int NWAVES = 8;

struct Args {
    const float* in[18]; float* out; unsigned char* ws; int ph_lo, ph_hi; int use_bar, bar_region;
};

__device__ __forceinline__ void p0_transpose_item(const float* W, int K, int N, bf16_t* WT, int rowblk, int roff, LAS float* scr, int item, int lane) {
    const int nblk = N / 32, kb = item / nblk, nb = item % nblk, k0 = 64 * kb, n0 = 32 * nb;
#pragma unroll 8
    for (int i = 0; i < 32; ++i) { const int kk = 2 * i + (lane >> 5); scr[kk * 33 + (lane & 31)] = W[(size_t)(k0 + kk) * N + n0 + (lane & 31)]; }
    asm volatile("s_waitcnt lgkmcnt(0)" ::: "memory");
    const int c = lane & 7;
#pragma unroll
    for (int j = 0; j < 4; ++j) { const int nl = (lane >> 3) + 8 * j; const LAS float* s = scr + (8 * c) * 33 + nl; const int n = n0 + nl;
        u32x4 o; o.x = pk2(s[0 * 33], s[1 * 33]); o.y = pk2(s[2 * 33], s[3 * 33]); o.z = pk2(s[4 * 33], s[5 * 33]); o.w = pk2(s[6 * 33], s[7 * 33]);
        const int dr = (n >> 7) * rowblk + roff + (n & 127);
        *(u32x4*)(WT + (size_t)dr * K + k0 + 8 * c) = o; }
    asm volatile("s_waitcnt lgkmcnt(0)" ::: "memory");
}

template <int VAR>
__global__ void __launch_bounds__(NWAVES * 64, 2) mk_fwd(Args args) {
    extern __shared__ __attribute__((aligned(16))) unsigned char lds_raw[];
    LAS unsigned char* lds = (LAS unsigned char*)lds_raw;
    const int wave = __builtin_amdgcn_readfirstlane(threadIdx.x >> 6);
#define PHASE_IDS() const int lane = lane_id(), tid = wave * 64 + lane; (void)tid; const int gw = vcu * NWAVES + wave, NGW = G * NWAVES; (void)lane; (void)gw; (void)NGW
    const int G = gridDim.x, bx = blockIdx.x; const int vcu = (G % 8 == 0) ? (bx % 8) * (G / 8) + bx / 8 : bx;
    unsigned char* ws = args.ws;
    unsigned* ctl = (unsigned*)(ws + WS_CTL);
    if (args.use_bar) xcd_barrier_post((unsigned*)(args.ws + WS_CTL) + CW_BAR + args.bar_region * XCD_BAR_WORDS, wave == 0 && lane_id() == 0);
    if (args.use_bar == 12345) cooperative_groups::this_grid().sync();
#define GRID_BAR() do { if (args.use_bar) xcd_barrier((unsigned*)(args.ws + WS_CTL) + CW_BAR + args.bar_region * XCD_BAR_WORDS, (unsigned*)(args.ws + WS_CTL) + CW_WGST + args.bar_region * 32768 + 64 * (int)blockIdx.x, (unsigned)G, wave == 0 && lane_id() == 0); } while (0)
    const int lo = args.ph_lo, hi = args.ph_hi;
#ifndef MK_CMASK
#define MK_CMASK 0x1ff
#endif
#define IN(k) ((((MK_CMASK) >> (k)) & 1) && lo <= (k) && (k) < hi)
#define BOTH(k) (IN(k) && IN((k) + 1))

    if (IN(0)) {
        PHASE_IDS();
        const float* x = args.in[0];
        bf16_t* XB = (bf16_t*)(ws + WS_XB); bf16_t* WINT = (bf16_t*)(ws + WS_WINT); bf16_t* WAT = (bf16_t*)(ws + WS_WAT); bf16_t* WBT = (bf16_t*)(ws + WS_WBT); bf16_t* WOT = (bf16_t*)(ws + WS_WOT);
        bf16_t* WGUT = (bf16_t*)(ws + WS_WGUT); bf16_t* WDT = (bf16_t*)(ws + WS_WDT);
        LAS float* scr = (LAS float*)(lds + wave * 16384);
        constexpr int I_IN = (DM / 64) * (IN_COLS / 32), I_A = (1024 / 64) * (DM / 32), I_B = (DM / 64) * (DM / 32), I_O = I_B;
        constexpr int I_G = (DM / 64) * (FF / 32), I_D = (FF / 64) * (DM / 32);
        constexpr int NITEMS = I_IN + I_A + I_B + I_O + NEXP * (2 * I_G + I_D);
        for (int it = gw; it < I_IN + I_A + I_B + I_O; it += NGW) {
            int r = it;
            if (r < I_IN) { p0_transpose_item(args.in[1], DM, IN_COLS, WINT, 128, 0, scr, r, lane); continue; } r -= I_IN;
            if (r < I_A) { p0_transpose_item(args.in[4], 1024, DM, WAT, 128, 0, scr, r, lane); continue; } r -= I_A;
            if (r < I_B) { p0_transpose_item(args.in[5], DM, DM, WBT, 128, 0, scr, r, lane); continue; } r -= I_B;
            if (r < I_O) { p0_transpose_item(args.in[6], DM, DM, WOT, 128, 0, scr, r, lane); continue; } r -= I_O;
            const int e = r / (2 * I_G + I_D); r -= e * (2 * I_G + I_D);
            if (r < I_G) { p0_transpose_item(args.in[13] + (size_t)e * DM * FF, DM, FF, WGUT + (size_t)e * 2048 * DM, 256, 0, scr, r, lane); continue; } r -= I_G;
            if (r < I_G) { p0_transpose_item(args.in[14] + (size_t)e * DM * FF, DM, FF, WGUT + (size_t)e * 2048 * DM, 256, 128, scr, r, lane); continue; } r -= I_G;
            p0_transpose_item(args.in[15] + (size_t)e * FF * DM, FF, DM, WDT + (size_t)e * DM * FF, 128, 0, scr, r, lane);
        }
        for (int m = gw; m < NTOK; m += NGW) {
            const f32x4* xr = (const f32x4*)(x + (size_t)m * DM) + lane; u32x2* o8 = (u32x2*)(XB + (size_t)m * DM) + lane;
#pragma unroll
            for (int j = 0; j < 8; ++j) { const f32x4 v = xr[64 * j]; u32x2 w; w.x = pk2(v.x, v.y); w.y = pk2(v.z, v.w); o8[64 * j] = w; }
        }
        { float2* rt1 = (float2*)(ws + WS_RT1); float2* rt2 = (float2*)(ws + WS_RT2);
          for (int i = (vcu * NWAVES * 64) + tid; i < SEQ * 64; i += G * NWAVES * 64) { const int t = i >> 6, c = i & 63; float cs, sn;
              rope1(t, c, cs, sn); rt1[i] = make_float2(cs, sn); rope2(t, c, cs, sn); rt2[i] = make_float2(cs, sn); } }
        { float* wt = (float*)(ws + WS_WRT); const float* wgp = args.in[9]; const float* wrp = args.in[11];
          for (int i = (vcu * NWAVES * 64) + tid; i < 36 * DM; i += G * NWAVES * 64) { const int c = i >> 11, k = i & (DM - 1); wt[i] = (c < 4) ? wgp[(size_t)k * 4 + c] : wrp[(size_t)k * 32 + (c - 4)]; } }
        if (BOTH(0)) GRID_BAR();
    }

    if (IN(1)) {
        EpiProj E; E.ws = ws; E.qg = args.in[2]; E.kg = args.in[3];
        ProjSched S; S.o.init(NTOK, IN_COLS, G, bx); S.ws = (const char*)ws;
        pg8::gemm_phase<EpiProj, ProjSched, PG8_ALIGN, PG8_SP2>(lds, lds + EX_OFF, S, E, wave);
        if (BOTH(1)) GRID_BAR();
    }

    if (IN(2)) {
        if (VAR != 22) for (int i = 0; i < 2; ++i) {
            const int idx = bx + i * G; if (idx >= 512) break;
            const int bk = idx & 7, rest = idx >> 3, b = bk >> 2, kvh = bk & 3, hq = kvh * 4 + (rest & 3), qblk = rest >> 2;
            att::Unit u; u.Q = (const bf16_t*)(ws + WS_QB) + ((size_t)(b * 16 + hq) * SEQ + qblk * 256) * HD;
            u.K = (const bf16_t*)(ws + WS_KB) + (size_t)(b * 4 + kvh) * SEQ * HD; u.V = (const bf16_t*)(ws + WS_VB) + (size_t)(b * 4 + kvh) * SEQ * HD;
            u.O = (bf16_t*)(ws + WS_OB) + ((size_t)b * SEQ + qblk * 256) * 2048 + hq * HD; u.ldo = 2048; u.lse = nullptr; u.lse_stride = 0; u.nt = 64; u.kt0 = 0; u.klo = 0; u.khi = SEQ; u.q0 = 0;
            att::body(u, lds, wave);
        }
        if (VAR != 21) for (int i = 0; i < 3; ++i) {
            const int idx = bx + i * G; if (idx >= 768) break;
            const int sid = idx >> 4, qblk = idx & 15, g = sid >> 4, b = (sid >> 3) & 1, h = sid & 7, sh = 2 * g, L = SEQ >> sh;
            const int P0 = qblk * 256, r = P0 / L, p0 = P0 - r * L;
            att::Unit u; u.Q = (const bf16_t*)(ws + WS_QA) + ((size_t)sid * SEQ + P0) * HD; u.K = (const bf16_t*)(ws + WS_KA) + (size_t)sid * SEQ * HD; u.V = (const bf16_t*)(ws + WS_VA) + (size_t)sid * SEQ * HD;
            const size_t tok0 = (size_t)b * SEQ + ((size_t)p0 << sh) + r;
            u.O = (bf16_t*)(ws + WS_OAG) + ((size_t)g * NTOK + tok0) * 1024 + h * HD; u.ldo = 1024 << sh;
            u.lse = (float*)(ws + WS_LSE) + ((size_t)g * NTOK + tok0) * 8 + h; u.lse_stride = 8 << sh;
            u.nt = 6; u.kt0 = P0 - 64; u.klo = r * L; u.khi = r * L + L; u.q0 = P0;
            att::band_body(u, lds, wave);
        }
        GRID_BAR();
        {
            PHASE_IDS();
            const bf16_t* oag = (const bf16_t*)(ws + WS_OAG); const float* lse = (const float*)(ws + WS_LSE); bf16_t* oa = (bf16_t*)(ws + WS_OA);
            for (int m = gw; m < NTOK; m += NGW) { const int c = lane * 16, h = lane >> 3;
                const float l0 = lse[(0 * (size_t)NTOK + m) * 8 + h], l1 = lse[(1 * (size_t)NTOK + m) * 8 + h], l2 = lse[(2 * (size_t)NTOK + m) * 8 + h];
                const float mx = fmaxf(l0, fmaxf(l1, l2)); float e0 = __expf(l0 - mx), e1 = __expf(l1 - mx), e2 = __expf(l2 - mx); const float inv = 1.0f / (e0 + e1 + e2); e0 *= inv; e1 *= inv; e2 *= inv;
#pragma unroll
                for (int q = 0; q < 2; ++q) { const u32x4 a = *(const u32x4*)(oag + (0 * (size_t)NTOK + m) * 1024 + c + 8 * q), bq = *(const u32x4*)(oag + (1 * (size_t)NTOK + m) * 1024 + c + 8 * q), cq = *(const u32x4*)(oag + (2 * (size_t)NTOK + m) * 1024 + c + 8 * q);
                    u32x4 w;
#pragma unroll
                    for (int k = 0; k < 4; ++k) w[k] = cvtpk(e0 * bflo(a[k]) + e1 * bflo(bq[k]) + e2 * bflo(cq[k]), e0 * bfhi(a[k]) + e1 * bfhi(bq[k]) + e2 * bfhi(cq[k]));
                    *(u32x4*)(oa + (size_t)m * 1024 + c + 8 * q) = w; } }
        }
        if (BOTH(2)) GRID_BAR();
    }

    if (IN(3) || IN(4)) {
        EpiMix E; E.ws = ws; E.x = args.in[0];
        MixSched S; S.c = vcu; S.ws = (const char*)ws;
        if (IN(3)) { S.mode = 0; pg8::gemm_phase<EpiMix, MixSched, false, PG8_SP2>(lds, lds + EX_OFF, S, E, wave); if (BOTH(3)) GRID_BAR(); }
        if (IN(4)) { S.mode = 1; pg8::gemm_phase<EpiMix, MixSched, false, PG8_SP2>(lds, lds + EX_OFF, S, E, wave); if (BOTH(4)) GRID_BAR(); }
    }

    if (IN(5)) {
        PHASE_IDS();
        RouteArgs ra; ra.g = args.in[7]; ra.b = args.in[8]; ra.h1 = (float*)(ws + WS_H1); ra.h1b = (bf16_t*)(ws + WS_H1B); ra.wg = args.in[9]; ra.bg = args.in[10]; ra.wr = args.in[11]; ra.br = args.in[12];
        ra.cnt = ctl + CW_CNT; ra.tokidx = (int*)(ws + WS_TOKIDX); ra.slot = (int*)(ws + WS_SLOT); ra.wt = (const float*)(ws + WS_WRT); ra.lnst = (float2*)(ws + WS_LNST);
        LAS unsigned* hist = (LAS unsigned*)lds; LAS unsigned* basev = hist + 32; LAS int* rinfo = (LAS int*)(lds + 256);
        if (tid < 64) hist[tid] = 0u;
        __syncthreads();
        static_assert(NTOK == 4 * 256 * NWAVES, "P5 assumes 4 rows per wave on a 256-workgroup grid");
#pragma unroll 1
        for (int ps = 0; ps < 2; ++ps) ln1_route_rows<2, VAR>((const float*)(ws + WS_PRE1), ra, gw + 2 * ps * NGW, NGW, lane_id(), hist, rinfo, wave * 4 + 2 * ps, 1);
        __syncthreads();
        if (tid < 32) { const unsigned h = hist[tid]; if (h) basev[tid] = atomicAdd(ra.cnt + tid, h); }
        __syncthreads();
        if (tid < 32) { const LAS int* ri = rinfo + tid * 8; const int ex1 = ri[0], ex2 = ri[1], m = ri[6]; const int p1 = (int)basev[ex1] + ri[2], p2 = (int)basev[ex2] + ri[3];
            ra.tokidx[ex1 * ECAP + p1] = m; ra.tokidx[ex2 * ECAP + p2] = m;
            int* sl = ra.slot + (size_t)m * 6; sl[0] = ex1; sl[1] = ex2; sl[2] = p1; sl[3] = p2; sl[4] = ri[4]; sl[5] = ri[5]; }
        if (BOTH(5)) GRID_BAR();
    }

    if (IN(6) || IN(7)) {
        MoeSched2 S; S.var = VAR; S.G = G; S.vcu = vcu; S.ws = (const char*)ws; S.wgate = args.in[13]; S.wup = args.in[14]; S.wdown = args.in[15];
        S.init(ctl + CW_CNT, lane_id());
        EpiMoe2 E; E.ws = ws;
        if (IN(6)) { S.down = 0; E.down = 0; mg::gemm_phase<MoeSched2, EpiMoe2, VAR>(lds, S, E, wave); if (BOTH(6)) GRID_BAR(); }
        if (IN(7)) { S.down = 1; E.down = 1; mg::gemm_phase<MoeSched2, EpiMoe2, VAR>(lds, S, E, wave); if (BOTH(7)) GRID_BAR(); }
    }

    if (IN(8)) {
        PHASE_IDS();
        P8Args pa; pa.h1 = (const float*)(ws + WS_H1); pa.y = (const bf16_t*)(ws + WS_Y); pa.cnt = ctl + CW_CNT; pa.slot = (const int*)(ws + WS_SLOT); pa.g = args.in[16]; pa.b = args.in[17]; pa.out = args.out;
        unsigned c = 0; if (lane < NEXP) c = __hip_atomic_load(ctl + CW_CNT + lane, __ATOMIC_RELAXED, __HIP_MEMORY_SCOPE_AGENT);
        unsigned t = (c + 255u) >> 8, inc = t;
#pragma unroll
        for (int o = 1; o < 32; o <<= 1) { const unsigned v = __shfl_up(inc, o); if ((lane & 31) >= o) inc += v; }
        const unsigned tpe = inc - t;
        for (int m = gw; m < NTOK; m += NGW) {
            const int* sl = pa.slot + (size_t)m * 6; const int e1 = sl[0], e2 = sl[1], p1 = sl[2], p2 = sl[3]; const float w1 = ((const float*)sl)[4], w2 = ((const float*)sl)[5];
            const size_t r1 = (size_t)__shfl(tpe, e1) * 256 + p1, r2 = (size_t)__shfl(tpe, e2) * 256 + p2;
            final_row_t(pa, (const float*)(ws + WS_PRE1), (const float2*)(ws + WS_LNST), args.in[7], args.in[8], m, lane_id(), r1, r2, w1, w2);
        }
    }
#undef IN
#undef BOTH
#undef GRID_BAR
}

extern "C" void kernel_launch(void* const* d_in, const int* in_sizes, int n_in, void* d_out, int out_size, void* d_ws, size_t ws_size, hipStream_t stream) {
    static int grid = 0;
    if (grid == 0) {
        if (n_in != 18 || in_sizes[0] != NTOK * DM || out_size != NTOK * DM || ws_size < WS_END) { fprintf(stderr, "kernel_launch: unexpected shapes (n_in %d, in0 %d, out %d, ws %zu)\n", n_in, n_in > 0 ? in_sizes[0] : -1, out_size, ws_size); grid = -1; return; }
        int dev = 0, cus = 0, per_cu = 0;
        if (hipGetDevice(&dev) != hipSuccess || hipDeviceGetAttribute(&cus, hipDeviceAttributeMultiprocessorCount, dev) != hipSuccess) { fprintf(stderr, "kernel_launch: device query failed\n"); grid = -1; return; }
        if (hipFuncSetAttribute((const void*)mk_fwd<0>, hipFuncAttributeMaxDynamicSharedMemorySize, LDS_BYTES) != hipSuccess || hipFuncSetAttribute((const void*)mk_fwd<MK_EXTRA_VAR>, hipFuncAttributeMaxDynamicSharedMemorySize, LDS_BYTES) != hipSuccess) { fprintf(stderr, "kernel_launch: hipFuncSetAttribute failed\n"); grid = -1; return; }
        if (hipOccupancyMaxActiveBlocksPerMultiprocessor(&per_cu, (const void*)mk_fwd<0>, NWAVES * 64, LDS_BYTES) != hipSuccess || per_cu < 1) { fprintf(stderr, "kernel_launch: occupancy query says %d blocks per CU\n", per_cu); per_cu = 1; }
        (void)hipGetLastError();
        grid = cus * 1;
        fprintf(stderr, "kernel_launch: grid %d (cus %d, occupancy %d)\n", grid, cus, per_cu);
    }
    if (grid < 0) return;
    unsigned char* ws = (unsigned char*)d_ws;
    (void)hipMemsetAsync(ws + WS_CTL, 0, 1 * MiB, stream);
    Args a{};
    for (int i = 0; i < 18; ++i) a.in[i] = (const float*)d_in[i];
    a.out = (float*)d_out; a.ws = ws;
    const float* x = a.in[0];
    bf16_t* XB = (bf16_t*)(ws + WS_XB); bf16_t* WINT = (bf16_t*)(ws + WS_WINT); bf16_t* WAT = (bf16_t*)(ws + WS_WAT); bf16_t* WBT = (bf16_t*)(ws + WS_WBT); bf16_t* WOT = (bf16_t*)(ws + WS_WOT);
    bf16_t* WGUT = (bf16_t*)(ws + WS_WGUT); bf16_t* WDT = (bf16_t*)(ws + WS_WDT);
    unsigned* ctl = (unsigned*)(ws + WS_CTL);
    auto launch_mk = [&](int lo, int hi, int use_bar, bool extra = false) {
        a.ph_lo = lo; a.ph_hi = hi; a.use_bar = use_bar;
        void* kargs[] = {&a};
        hipError_t e = hipLaunchCooperativeKernel(extra ? (const void*)mk_fwd<MK_EXTRA_VAR> : (const void*)mk_fwd<0>, dim3(grid), dim3(NWAVES * 64), kargs, LDS_BYTES, stream);
        if (e != hipSuccess) fprintf(stderr, "kernel_launch: cooperative launch failed: %s (grid %d)\n", hipGetErrorString(e), grid);
    };
    if (MK_ONE_LAUNCH && MK_FAST_MASK == 0x1ff) { launch_mk(0, NPHASE, 1);
        if (MK_EXTRA_PHASE >= 0) { a.bar_region = 1; launch_mk(MK_EXTRA_PHASE, MK_EXTRA_PHASE + 1, 1, true); }
        return; }
    for (int ph = 0; ph < NPHASE; ++ph) {
        if ((MK_FAST_MASK >> ph) & 1) { launch_mk(ph, ph + 1, (ph == 2) ? 1 : 0); continue; }
        switch (ph) {
        case 0:
            hipLaunchKernelGGL(k_cvt, dim3(2048), dim3(256), 0, stream, x, XB, (size_t)NTOK * DM / 8);
            hipLaunchKernelGGL(k_transpose, dim3(IN_COLS / 32, DM / 32, 1), dim3(256), 0, stream, a.in[1], WINT, DM, IN_COLS, 128, 0, (size_t)0, (size_t)0);
            hipLaunchKernelGGL(k_transpose, dim3(DM / 32, 1024 / 32, 1), dim3(256), 0, stream, a.in[4], WAT, 1024, DM, 128, 0, (size_t)0, (size_t)0);
            hipLaunchKernelGGL(k_transpose, dim3(DM / 32, DM / 32, 1), dim3(256), 0, stream, a.in[5], WBT, DM, DM, 128, 0, (size_t)0, (size_t)0);
            hipLaunchKernelGGL(k_transpose, dim3(DM / 32, DM / 32, 1), dim3(256), 0, stream, a.in[6], WOT, DM, DM, 128, 0, (size_t)0, (size_t)0);
            hipLaunchKernelGGL(k_transpose, dim3(FF / 32, DM / 32, NEXP), dim3(256), 0, stream, a.in[13], WGUT, DM, FF, 256, 0, (size_t)DM * FF, (size_t)2048 * DM);
            hipLaunchKernelGGL(k_transpose, dim3(FF / 32, DM / 32, NEXP), dim3(256), 0, stream, a.in[14], WGUT, DM, FF, 256, 128, (size_t)DM * FF, (size_t)2048 * DM);
            hipLaunchKernelGGL(k_transpose, dim3(DM / 32, FF / 32, NEXP), dim3(256), 0, stream, a.in[15], WDT, FF, DM, 128, 0, (size_t)FF * DM, (size_t)DM * FF);
            hipLaunchKernelGGL(k_ropetab, dim3(SEQ * 64 / 256), dim3(256), 0, stream, (float2*)(ws + WS_RT1), (float2*)(ws + WS_RT2));
            break;
        case 1: { P1Args p1{}; p1.xb = XB; p1.wint = WINT; p1.qg = a.in[2]; p1.kg = a.in[3]; p1.qa = (bf16_t*)(ws + WS_QA); p1.ka = (bf16_t*)(ws + WS_KA); p1.va = (bf16_t*)(ws + WS_VA);
            p1.qb = (bf16_t*)(ws + WS_QB); p1.kb = (bf16_t*)(ws + WS_KB); p1.vb = (bf16_t*)(ws + WS_VB); p1.gates = (bf16_t*)(ws + WS_GATES);
            hipLaunchKernelGGL(k_proj, dim3(IN_COLS / 128, NTOK / 64), dim3(256), 0, stream, p1); } break;
        case 2: { P2Args p2b{}; p2b.q = (bf16_t*)(ws + WS_QB); p2b.k = (bf16_t*)(ws + WS_KB); p2b.v = (bf16_t*)(ws + WS_VB); p2b.o = (bf16_t*)(ws + WS_OB); p2b.lse = nullptr; p2b.mode = 0;
            hipLaunchKernelGGL(k_attn, dim3(SEQ / 64, 32), dim3(128), 0, stream, p2b);
            P2Args p2a{}; p2a.q = (bf16_t*)(ws + WS_QA); p2a.k = (bf16_t*)(ws + WS_KA); p2a.v = (bf16_t*)(ws + WS_VA); p2a.o = (bf16_t*)(ws + WS_OAG); p2a.lse = (float*)(ws + WS_LSE); p2a.mode = 1;
            hipLaunchKernelGGL(k_attn, dim3(SEQ / 64, 48), dim3(128), 0, stream, p2a);
            hipLaunchKernelGGL(k_merge, dim3(NTOK * 1024 / 256), dim3(256), 0, stream, (const bf16_t*)(ws + WS_OAG), (const float*)(ws + WS_LSE), (bf16_t*)(ws + WS_OA)); } break;
        case 3: case 4: { P3Args p3{}; p3.gates = (bf16_t*)(ws + WS_GATES); p3.T = (float*)(ws + WS_T); p3.merged = (bf16_t*)(ws + WS_MERGED); p3.x = x; p3.pre1 = (float*)(ws + WS_PRE1);
            if (ph == 3) { p3.A = (bf16_t*)(ws + WS_OA); p3.Bt = WAT; p3.K = 1024; p3.mode = 0;
                hipLaunchKernelGGL(k_gemm3, dim3(DM / 128, NTOK / 64), dim3(256), 0, stream, p3);
                p3.A = (bf16_t*)(ws + WS_OB); p3.Bt = WBT; p3.K = 2048; p3.mode = 1;
                hipLaunchKernelGGL(k_gemm3, dim3(DM / 128, NTOK / 64), dim3(256), 0, stream, p3); }
            else { p3.A = p3.merged; p3.Bt = WOT; p3.K = 2048; p3.mode = 2; hipLaunchKernelGGL(k_gemm3, dim3(DM / 128, NTOK / 64), dim3(256), 0, stream, p3); } } break;
        case 5: { RouteArgs ra{}; ra.g = a.in[7]; ra.b = a.in[8]; ra.h1 = (float*)(ws + WS_H1); ra.h1b = (bf16_t*)(ws + WS_H1B); ra.wg = a.in[9]; ra.bg = a.in[10]; ra.wr = a.in[11]; ra.br = a.in[12];
            ra.cnt = ctl + CW_CNT; ra.tokidx = (int*)(ws + WS_TOKIDX); ra.slot = (int*)(ws + WS_SLOT);
            hipLaunchKernelGGL(k_ln1_route, dim3(NTOK / 4), dim3(256), 0, stream, (const float*)(ws + WS_PRE1), ra); } break;
        case 6: case 7: { P6Args p6{}; p6.h1b = (bf16_t*)(ws + WS_H1B); p6.wgut = WGUT; p6.wdt = WDT; p6.cnt = ctl + CW_CNT; p6.tokidx = (int*)(ws + WS_TOKIDX); p6.act = (bf16_t*)(ws + WS_ACT); p6.y = (bf16_t*)(ws + WS_Y);
            if (ph == 6) hipLaunchKernelGGL(k_moe_up, dim3(FF / 128, 24576 / 64), dim3(256), 0, stream, p6);
            else hipLaunchKernelGGL(k_moe_down, dim3(DM / 128, 24576 / 64), dim3(256), 0, stream, p6); } break;
        case 8: { P8Args p8{}; p8.h1 = (float*)(ws + WS_H1); p8.y = (bf16_t*)(ws + WS_Y); p8.cnt = ctl + CW_CNT; p8.slot = (int*)(ws + WS_SLOT); p8.g = a.in[16]; p8.b = a.in[17]; p8.out = (float*)d_out;
            hipLaunchKernelGGL(k_final, dim3(NTOK / 4), dim3(256), 0, stream, p8); } break;
        }
    }
}
```

```cpp
#include <hip/hip_runtime.h>
#include <hip/hip_cooperative_groups.h>
#include <cstdio>
#include <cstdint>

typedef unsigned short bf16_t;
typedef short bf16x8 __attribute__((ext_vector_type(8)));
typedef short s16x4 __attribute__((ext_vector_type(4)));
typedef float f32x4 __attribute__((ext_vector_type(4)));
typedef float f32x16 __attribute__((ext_vector_type(16)));
typedef unsigned u32x4 __attribute__((ext_vector_type(4)));
typedef unsigned u32x2 __attribute__((ext_vector_type(2)));
#define LAS __attribute__((address_space(3)))

#ifndef MK_FAST_MASK
#define MK_FAST_MASK 0x1ff
#endif
#ifndef MK_ONE_LAUNCH
#define MK_ONE_LAUNCH 1
#endif
#ifndef MK_EXTRA_PHASE
#define MK_EXTRA_PHASE -1
#endif
#ifndef MK_EXTRA_VAR
#define MK_EXTRA_VAR 0
#endif
#ifndef PG8_SP2
#define PG8_SP2 true
#endif
#ifndef PG8_ALIGN
#define PG8_ALIGN true
#endif

constexpr int NTOK = 8192, SEQ = 4096, DM = 2048, HD = 128;
constexpr int IN_COLS = 16384;
constexpr int NEXP = 32, FF = 1024;
constexpr float ALPHA = 1.189207115002721f;
constexpr float LN_EPS = 1e-5f, RMS_EPS = 1e-6f;
constexpr float SM_SCALE = 0.08838834764831845f;
constexpr int ECAP = 8192;
constexpr int NPHASE = 9;

constexpr size_t MiB = 1u << 20;
constexpr size_t WS_CTL = 0;
constexpr size_t WS_WGUT = 1 * MiB;
constexpr size_t WS_WDT = 257 * MiB;
constexpr size_t WS_WAT = 385 * MiB;
constexpr size_t WS_WBT = 389 * MiB;
constexpr size_t WS_WOT = 397 * MiB;
constexpr size_t WS_XB = 405 * MiB;
constexpr size_t WS_WINT = 437 * MiB;
constexpr size_t WS_QA = 501 * MiB;
constexpr size_t WS_KA = 549 * MiB;
constexpr size_t WS_VA = 597 * MiB;
constexpr size_t WS_QB = 645 * MiB;
constexpr size_t WS_KB = 677 * MiB;
constexpr size_t WS_VB = 685 * MiB;
constexpr size_t WS_GATES = 693 * MiB;
constexpr size_t WS_OAG = 757 * MiB;
constexpr size_t WS_LSE = 805 * MiB;
constexpr size_t WS_OA = 806 * MiB;
constexpr size_t WS_OB = 822 * MiB;
constexpr size_t WS_T = 405 * MiB;
constexpr size_t WS_MERGED = 469 * MiB;
constexpr size_t WS_PRE1 = 501 * MiB;
constexpr size_t WS_H1 = 565 * MiB;
constexpr size_t WS_H1B = 629 * MiB;
constexpr size_t WS_TOKIDX = 661 * MiB;
constexpr size_t WS_LNST = 663 * MiB;
constexpr size_t WS_SLOT = 662 * MiB;
constexpr size_t WS_ACT = 693 * MiB;
constexpr size_t WS_Y = 757 * MiB;
constexpr size_t WS_RT1 = 854 * MiB;
constexpr size_t WS_RT2 = 856 * MiB;
constexpr size_t WS_WRT = 858 * MiB;
constexpr size_t WS_END = 859 * MiB;
constexpr int CW_CNT = 64;
constexpr int CW_SPLIT = 1024;
constexpr int CW_BAR = 4096;
constexpr int CW_WGST = 65536;

__device__ __forceinline__ float bf2f(bf16_t v) { return __uint_as_float(((unsigned)v) << 16); }
__device__ __forceinline__ bf16_t f2bf(float f) { unsigned u = __float_as_uint(f); u += 0x7fffu + ((u >> 16) & 1u); return (bf16_t)(u >> 16); }
__device__ __forceinline__ unsigned pk2(float lo, float hi) { return (unsigned)f2bf(lo) | ((unsigned)f2bf(hi) << 16); }
typedef float f32x2v __attribute__((ext_vector_type(2)));
typedef __bf16 bf16x2v __attribute__((ext_vector_type(2)));
__device__ __forceinline__ unsigned cvt2(float lo, float hi) { const f32x2v v = {lo, hi}; const bf16x2v b = __builtin_convertvector(v, bf16x2v); return __builtin_bit_cast(unsigned, b); }
__device__ __forceinline__ unsigned cvtpk(float lo, float hi) { unsigned r; asm volatile("v_cvt_pk_bf16_f32 %0, %1, %2" : "=v"(r) : "v"(lo), "v"(hi)); return r; }
__device__ __forceinline__ float wave_sum(float v) {
#pragma unroll
    for (int o = 1; o < 64; o <<= 1) v += __shfl_xor(v, o);
    return v;
}
__device__ __forceinline__ int lane_id() { int l; asm volatile("v_mbcnt_lo_u32_b32 %0, -1, 0\n\tv_mbcnt_hi_u32_b32 %0, -1, %0" : "=v"(l)); return l; }
__device__ __forceinline__ float bflo(unsigned w) { return __uint_as_float(w << 16); }
__device__ __forceinline__ float bfhi(unsigned w) { return __uint_as_float(w & 0xffff0000u); }

__device__ const float INV64[64] = {
    1.000000000e+00f, 8.659643234e-01f, 7.498942093e-01f, 6.493816316e-01f, 5.623413252e-01f, 4.869675252e-01f, 4.216965034e-01f, 3.651741273e-01f,
    3.162277660e-01f, 2.738419634e-01f, 2.371373706e-01f, 2.053525026e-01f, 1.778279410e-01f, 1.539926526e-01f, 1.333521432e-01f, 1.154781985e-01f,
    1.000000000e-01f, 8.659643234e-02f, 7.498942093e-02f, 6.493816316e-02f, 5.623413252e-02f, 4.869675252e-02f, 4.216965034e-02f, 3.651741273e-02f,
    3.162277660e-02f, 2.738419634e-02f, 2.371373706e-02f, 2.053525026e-02f, 1.778279410e-02f, 1.539926526e-02f, 1.333521432e-02f, 1.154781985e-02f,
    1.000000000e-02f, 8.659643234e-03f, 7.498942093e-03f, 6.493816316e-03f, 5.623413252e-03f, 4.869675252e-03f, 4.216965034e-03f, 3.651741273e-03f,
    3.162277660e-03f, 2.738419634e-03f, 2.371373706e-03f, 2.053525026e-03f, 1.778279410e-03f, 1.539926526e-03f, 1.333521432e-03f, 1.154781985e-03f,
    1.000000000e-03f, 8.659643234e-04f, 7.498942093e-04f, 6.493816316e-04f, 5.623413252e-04f, 4.869675252e-04f, 4.216965034e-04f, 3.651741273e-04f,
    3.162277660e-04f, 2.738419634e-04f, 2.371373706e-04f, 2.053525026e-04f, 1.778279410e-04f, 1.539926526e-04f, 1.333521432e-04f, 1.154781985e-04f};

__device__ __forceinline__ void cs_angle(float ang, float& c, float& s) {
    const double a = (double)ang * 0.15915494309189535;
    const float f = (float)(a - floor(a));
    s = __builtin_amdgcn_sinf(f); c = __builtin_amdgcn_cosf(f);
}
__device__ __forceinline__ void rope1(int t, int i, float& c, float& s) { cs_angle((float)t * INV64[i], c, s); }
__device__ __forceinline__ void rope2(int t, int i, float& c, float& s) {
    const float p = (i < 32) ? (float)(t >> 6) : (float)(t & 63);
    cs_angle(p * INV64[2 * (i & 31)], c, s);
}
__device__ __forceinline__ int perm_pos(int g, int t) { const int sh = 2 * g; const int d = 1 << sh; return (t & (d - 1)) * (SEQ >> sh) + (t >> sh); }

__global__ void __launch_bounds__(256) k_cvt(const float* __restrict__ x, bf16_t* __restrict__ xb, size_t n8) {
    for (size_t i = (size_t)blockIdx.x * 256 + threadIdx.x; i < n8; i += (size_t)gridDim.x * 256) {
        const f32x4 a = *(const f32x4*)(x + i * 8), b = *(const f32x4*)(x + i * 8 + 4);
        u32x4 w; w.x = pk2(a.x, a.y); w.y = pk2(a.z, a.w); w.z = pk2(b.x, b.y); w.w = pk2(b.z, b.w);
        *(u32x4*)(xb + i * 8) = w;
    }
}
__global__ void __launch_bounds__(256) k_transpose(const float* __restrict__ src, bf16_t* __restrict__ dst, int K, int N, int rowblk, int roff, size_t sstride, size_t dstride) {
    __shared__ float tile[32][33];
    const float* s = src + (size_t)blockIdx.z * sstride; bf16_t* d = dst + (size_t)blockIdx.z * dstride;
    const int n0 = blockIdx.x * 32, k0 = blockIdx.y * 32, tx = threadIdx.x & 31, ty = threadIdx.x >> 5;
    for (int i = ty; i < 32; i += 8) tile[i][tx] = s[(size_t)(k0 + i) * N + n0 + tx];
    __syncthreads();
    for (int i = ty; i < 32; i += 8) { const int n = n0 + i; const int dr = (n >> 7) * rowblk + roff + (n & 127); d[(size_t)dr * K + k0 + tx] = f2bf(tile[tx][i]); }
}
__global__ void __launch_bounds__(256) k_ropetab(float2* rt1, float2* rt2) {
    const int i = blockIdx.x * 256 + threadIdx.x; const int t = i >> 6, c = i & 63; float cs, sn;
    rope1(t, c, cs, sn); rt1[i] = make_float2(cs, sn); rope2(t, c, cs, sn); rt2[i] = make_float2(cs, sn);
}
__device__ __forceinline__ void wave_gemm16x128(const bf16_t* arow, const bf16_t* bt, int ldb, int K, f32x4 (&acc)[8]) {
    const int lane = threadIdx.x & 63, fr = lane & 15, fq = lane >> 4;
    const bf16_t* ap = arow + fq * 8;
    const bf16_t* bp = bt + (size_t)fr * ldb + fq * 8;
    for (int k = 0; k < K; k += 32) {
        const bf16x8 a = *(const bf16x8*)(ap + k);
#pragma unroll
        for (int j = 0; j < 8; ++j) { const bf16x8 b = *(const bf16x8*)(bp + (size_t)j * 16 * ldb + k); acc[j] = __builtin_amdgcn_mfma_f32_16x16x32_bf16(a, b, acc[j], 0, 0, 0); }
    }
}
struct P1Args { const bf16_t* xb; const bf16_t* wint; const float* qg; const float* kg; bf16_t *qa, *ka, *va, *qb, *kb, *vb, *gates; };
__global__ void __launch_bounds__(256) k_proj(P1Args a) {
    const int wave = threadIdx.x >> 6, lane = threadIdx.x & 63, fr = lane & 15, fq = lane >> 4;
    const int ng = blockIdx.x, mt = blockIdx.y * 4 + wave;
    f32x4 acc[8];
#pragma unroll
    for (int j = 0; j < 8; ++j) acc[j] = (f32x4){0.f, 0.f, 0.f, 0.f};
    wave_gemm16x128(a.xb + (size_t)(mt * 16 + fr) * DM, a.wint + (size_t)ng * 128 * DM, DM, DM, acc);
#pragma unroll
    for (int r = 0; r < 4; ++r) {
        const int m = mt * 16 + fq * 4 + r, b = m >> 12, t = m & 4095;
        if (ng < 72) {
            const int which = ng / 24, hh = ng % 24, g = hh >> 3, h = hh & 7;
            bf16_t* base = (which == 0 ? a.qa : (which == 1 ? a.ka : a.va)) + ((size_t)((g * 2 + b) * 8 + h) * SEQ + perm_pos(g, t)) * HD;
#pragma unroll
            for (int j = 0; j < 4; ++j) { const int c = 16 * j + fr; float x1 = acc[j][r], x2 = acc[j + 4][r];
                if (which < 2) { float cs, sn; rope1(t, c, cs, sn); const float y1 = x1 * cs - x2 * sn, y2 = x2 * cs + x1 * sn; x1 = y1; x2 = y2; }
                base[c] = f2bf(x1); base[c + 64] = f2bf(x2); }
        } else if (ng < 96) {
            const int k = ng - 72;
            if (k < 20) {
                float ss = 0.f;
#pragma unroll
                for (int j = 0; j < 8; ++j) ss += acc[j][r] * acc[j][r];
                ss += __shfl_xor(ss, 1); ss += __shfl_xor(ss, 2); ss += __shfl_xor(ss, 4); ss += __shfl_xor(ss, 8);
                const float rinv = 1.0f / sqrtf(ss * (1.0f / 128.0f) + RMS_EPS);
                const float* gn = (k < 16) ? a.qg : a.kg;
                bf16_t* base = (k < 16) ? a.qb + ((size_t)(b * 16 + k) * SEQ + t) * HD : a.kb + ((size_t)(b * 4 + (k - 16)) * SEQ + t) * HD;
#pragma unroll
                for (int j = 0; j < 4; ++j) { const int c = 16 * j + fr; const float x1 = acc[j][r] * rinv * gn[c], x2 = acc[j + 4][r] * rinv * gn[c + 64];
                    float cs, sn; rope2(t, c, cs, sn); base[c] = f2bf(x1 * cs - x2 * sn); base[c + 64] = f2bf(x2 * cs + x1 * sn); }
            } else {
                bf16_t* base = a.vb + ((size_t)(b * 4 + (k - 20)) * SEQ + t) * HD;
#pragma unroll
                for (int j = 0; j < 8; ++j) base[16 * j + fr] = f2bf(acc[j][r]);
            }
        } else {
            bf16_t* base = a.gates + (size_t)m * 4096 + (ng - 96) * 128;
#pragma unroll
            for (int j = 0; j < 8; ++j) base[16 * j + fr] = f2bf(1.0f / (1.0f + __expf(-acc[j][r])));
        }
    }
}
struct P2Args { const bf16_t *q, *k, *v; bf16_t* o; float* lse; int mode; };
__global__ void __launch_bounds__(128) k_attn(P2Args a) {
    const int half = threadIdx.x & 1, qi = blockIdx.x * 64 + (threadIdx.x >> 1), sid = blockIdx.y;
    const bf16_t *Q, *K, *V; int k_lo, k_hi;
    if (a.mode == 0) { const int b = sid >> 4, hq = sid & 15; Q = a.q + (size_t)sid * SEQ * HD; K = a.k + (size_t)(b * 4 + (hq >> 2)) * SEQ * HD; V = a.v + (size_t)(b * 4 + (hq >> 2)) * SEQ * HD; k_lo = 0; k_hi = SEQ - 1; }
    else { const int g = sid >> 4; const int L = SEQ >> (2 * g); Q = a.q + (size_t)sid * SEQ * HD; K = a.k + (size_t)sid * SEQ * HD; V = a.v + (size_t)sid * SEQ * HD;
        const int r0 = (qi / L) * L, p = qi - r0; k_lo = r0 + (p - 64 > 0 ? p - 64 : 0); k_hi = r0 + (p + 64 < L - 1 ? p + 64 : L - 1); }
    float q[64], o[64];
    { const bf16_t* qp = Q + (size_t)qi * HD + half * 64;
#pragma unroll
      for (int d = 0; d < 64; ++d) { q[d] = bf2f(qp[d]) * SM_SCALE; o[d] = 0.f; } }
    float m = -1e30f, l = 0.f;
    for (int kk = k_lo; kk <= k_hi; ++kk) {
        const bf16_t* kp = K + (size_t)kk * HD + half * 64; const bf16_t* vp = V + (size_t)kk * HD + half * 64;
        float s = 0.f;
#pragma unroll
        for (int d = 0; d < 64; ++d) s += q[d] * bf2f(kp[d]);
        s += __shfl_xor(s, 1);
        const float mn = fmaxf(m, s), al = __expf(m - mn), p = __expf(s - mn);
        l = l * al + p; m = mn;
#pragma unroll
        for (int d = 0; d < 64; ++d) o[d] = o[d] * al + p * bf2f(vp[d]);
    }
    const float rl = 1.0f / l;
    if (a.mode == 0) { const int b = sid >> 4, hq = sid & 15; bf16_t* op = a.o + (size_t)(b * SEQ + qi) * 2048 + hq * HD + half * 64;
#pragma unroll
        for (int d = 0; d < 64; ++d) op[d] = f2bf(o[d] * rl); }
    else { const int g = sid >> 4, b = (sid >> 3) & 1, h = sid & 7; const int sh = 2 * g, L = SEQ >> sh; const int r = qi / L, p = qi - r * L, t = (p << sh) + r;
        const size_t mrow = (size_t)b * SEQ + t;
        bf16_t* op = a.o + ((size_t)g * NTOK + mrow) * 1024 + h * HD + half * 64;
#pragma unroll
        for (int d = 0; d < 64; ++d) op[d] = f2bf(o[d] * rl);
        if (half == 0) a.lse[((size_t)g * NTOK + mrow) * 8 + h] = m + __logf(l); }
}
__global__ void __launch_bounds__(256) k_merge(const bf16_t* __restrict__ oag, const float* __restrict__ lse, bf16_t* __restrict__ oa) {
    const size_t i = (size_t)blockIdx.x * 256 + threadIdx.x;
    const size_t m = i >> 10; const int c = (int)(i & 1023), h = c >> 7;
    const float l0 = lse[(0 * (size_t)NTOK + m) * 8 + h], l1 = lse[(1 * (size_t)NTOK + m) * 8 + h], l2 = lse[(2 * (size_t)NTOK + m) * 8 + h];
    const float mx = fmaxf(l0, fmaxf(l1, l2)); const float e0 = __expf(l0 - mx), e1 = __expf(l1 - mx), e2 = __expf(l2 - mx); const float inv = 1.0f / (e0 + e1 + e2);
    const float v = (e0 * bf2f(oag[(0 * (size_t)NTOK + m) * 1024 + c]) + e1 * bf2f(oag[(1 * (size_t)NTOK + m) * 1024 + c]) + e2 * bf2f(oag[(2 * (size_t)NTOK + m) * 1024 + c])) * inv;
    oa[i] = f2bf(v);
}
struct P3Args { const bf16_t* A; const bf16_t* Bt; int K; const bf16_t* gates; float* T; bf16_t* merged; const float* x; float* pre1; int mode; };
__global__ void __launch_bounds__(256) k_gemm3(P3Args a) {
    const int wave = threadIdx.x >> 6, lane = threadIdx.x & 63, fr = lane & 15, fq = lane >> 4;
    const int ng = blockIdx.x, mt = blockIdx.y * 4 + wave;
    f32x4 acc[8];
#pragma unroll
    for (int j = 0; j < 8; ++j) acc[j] = (f32x4){0.f, 0.f, 0.f, 0.f};
    wave_gemm16x128(a.A + (size_t)(mt * 16 + fr) * a.K, a.Bt + (size_t)ng * 128 * a.K, a.K, a.K, acc);
#pragma unroll
    for (int r = 0; r < 4; ++r) { const size_t m = (size_t)mt * 16 + fq * 4 + r;
#pragma unroll
        for (int j = 0; j < 8; ++j) { const int c = ng * 128 + 16 * j + fr; const size_t o = m * DM + c;
            if (a.mode == 0) a.T[o] = bf2f(a.gates[m * 4096 + c]) * acc[j][r];
            else if (a.mode == 1) a.merged[o] = f2bf(a.T[o] + bf2f(a.gates[m * 4096 + 2048 + c]) * acc[j][r]);
            else a.pre1[o] = ALPHA * a.x[o] + acc[j][r]; } }
}
struct RouteArgs { const float* g; const float* b; float* h1; bf16_t* h1b; const float* wg; const float* bg; const float* wr; const float* br; unsigned* cnt; int* tokidx; int* slot; const float* wt; float2* lnst; };
__device__ __forceinline__ void ln1_route_row(const float* pre1, const RouteArgs& a, int m, int lane) {
    const f32x4* xr = (const f32x4*)(pre1 + (size_t)m * DM) + lane;
    f32x4 v[8]; float s = 0.f;
#pragma unroll
    for (int j = 0; j < 8; ++j) { v[j] = xr[64 * j]; s += (v[j].x + v[j].y) + (v[j].z + v[j].w); }
    const float mean = wave_sum(s) * (1.0f / DM); float s2 = 0.f;
#pragma unroll
    for (int j = 0; j < 8; ++j) { v[j] = v[j] - mean; s2 += (v[j].x * v[j].x + v[j].y * v[j].y) + (v[j].z * v[j].z + v[j].w * v[j].w); }
    const float rstd = 1.0f / sqrtf(wave_sum(s2) * (1.0f / DM) + LN_EPS);
    float gl[4] = {0.f, 0.f, 0.f, 0.f};
#pragma unroll
    for (int j = 0; j < 8; ++j) { const int c = 4 * lane + 256 * j; const f32x4 gg = *(const f32x4*)(a.g + c), bb = *(const f32x4*)(a.b + c);
        v[j] = v[j] * rstd * gg + bb;
        *(f32x4*)(a.h1 + (size_t)m * DM + c) = v[j];
        *(uint2*)(a.h1b + (size_t)m * DM + c) = make_uint2(pk2(v[j].x, v[j].y), pk2(v[j].z, v[j].w));
#pragma unroll
        for (int i = 0; i < 4; ++i) { const f32x4 w = *(const f32x4*)(a.wg + (size_t)(c + i) * 4); const float hv = v[j][i]; gl[0] += hv * w.x; gl[1] += hv * w.y; gl[2] += hv * w.z; gl[3] += hv * w.w; } }
#pragma unroll
    for (int i = 0; i < 4; ++i) gl[i] = wave_sum(gl[i]) + a.bg[i];
    int gi = 0; float gm = gl[0];
#pragma unroll
    for (int i = 1; i < 4; ++i) if (gl[i] > gm) { gm = gl[i]; gi = i; }
    float gs = 0.f;
#pragma unroll
    for (int i = 0; i < 4; ++i) gs += __expf(gl[i] - gm);
    const float ggate = 1.0f / gs;
    float el[8] = {0.f, 0.f, 0.f, 0.f, 0.f, 0.f, 0.f, 0.f};
#pragma unroll
    for (int j = 0; j < 8; ++j) { const int c = 4 * lane + 256 * j;
#pragma unroll
        for (int i = 0; i < 4; ++i) { const float* wp = a.wr + (size_t)(c + i) * 32 + gi * 8; const f32x4 w0 = *(const f32x4*)wp, w1 = *(const f32x4*)(wp + 4); const float hv = v[j][i];
            el[0] += hv * w0.x; el[1] += hv * w0.y; el[2] += hv * w0.z; el[3] += hv * w0.w; el[4] += hv * w1.x; el[5] += hv * w1.y; el[6] += hv * w1.z; el[7] += hv * w1.w; } }
#pragma unroll
    for (int i = 0; i < 8; ++i) el[i] = wave_sum(el[i]) + a.br[gi * 8 + i];
    int i1 = 0; float m1 = el[0];
#pragma unroll
    for (int i = 1; i < 8; ++i) if (el[i] > m1) { m1 = el[i]; i1 = i; }
    int i2 = -1; float m2 = -3.0e38f;
#pragma unroll
    for (int i = 0; i < 8; ++i) if (i != i1 && el[i] > m2) { m2 = el[i]; i2 = i; }
    const float e2 = __expf(m2 - m1); const float w1 = ggate / (1.0f + e2), w2 = ggate * e2 / (1.0f + e2);
    if (lane == 0) {
        const int ex1 = gi * 8 + i1, ex2 = gi * 8 + i2;
        const int p1 = (int)atomicAdd(a.cnt + ex1, 1u), p2 = (int)atomicAdd(a.cnt + ex2, 1u);
        a.tokidx[ex1 * ECAP + p1] = m; a.tokidx[ex2 * ECAP + p2] = m;
        int* sl = a.slot + (size_t)m * 6; sl[0] = ex1; sl[1] = ex2; sl[2] = p1; sl[3] = p2; ((float*)sl)[4] = w1; ((float*)sl)[5] = w2;
    }
}
template <int R, int VAR>
__device__ __forceinline__ void ln1_route_rows(const float* pre1, const RouteArgs& a, int m0, int ms, int lane, LAS unsigned* hist, LAS int* rinfo, int lr0, int lrs) {
    f32x4 v[R][8]; float s[R], s2[R];
#pragma unroll
    for (int i = 0; i < R; ++i) { const f32x4* xr = (const f32x4*)(pre1 + (size_t)(m0 + i * ms) * DM) + lane; s[i] = 0.f;
#pragma unroll
        for (int j = 0; j < 8; ++j) { v[i][j] = xr[64 * j]; s[i] += (v[i][j].x + v[i][j].y) + (v[i][j].z + v[i][j].w); } }
#pragma unroll
    for (int o = 1; o < 64; o <<= 1)
#pragma unroll
        for (int i = 0; i < R; ++i) s[i] += __shfl_xor(s[i], o);
#pragma unroll
    for (int i = 0; i < R; ++i) { const float mean = s[i] * (1.0f / DM); s2[i] = 0.f;
#pragma unroll
        for (int j = 0; j < 8; ++j) { v[i][j] = v[i][j] - mean; s2[i] += (v[i][j].x * v[i][j].x + v[i][j].y * v[i][j].y) + (v[i][j].z * v[i][j].z + v[i][j].w * v[i][j].w); } }
#pragma unroll
    for (int o = 1; o < 64; o <<= 1)
#pragma unroll
        for (int i = 0; i < R; ++i) s2[i] += __shfl_xor(s2[i], o);
#pragma unroll
    for (int j = 0; j < 8; ++j) { const int c = 4 * lane + 256 * j; const f32x4 gg = *(const f32x4*)(a.g + c), bb = *(const f32x4*)(a.b + c);
#pragma unroll
        for (int i = 0; i < R; ++i) { const float rstd = 1.0f / sqrtf(s2[i] * (1.0f / DM) + LN_EPS); const size_t o = (size_t)(m0 + i * ms) * DM + c;
            v[i][j] = v[i][j] * rstd * gg + bb;
            if (j == 0 && lane == 0) a.lnst[m0 + i * ms] = make_float2(s[i] * (1.0f / DM), rstd);
            *(uint2*)(a.h1b + o) = make_uint2(pk2(v[i][j].x, v[i][j].y), pk2(v[i][j].z, v[i][j].w)); } }
    if constexpr (VAR == 51) return;
    float gl[R][4];
#pragma unroll
    for (int c = 0; c < 4; ++c) { const f32x4* wp = (const f32x4*)(a.wt + (size_t)c * DM) + lane;
#pragma unroll
        for (int i = 0; i < R; ++i) gl[i][c] = 0.f;
#pragma unroll
        for (int j = 0; j < 8; ++j) { const f32x4 w = wp[64 * j];
#pragma unroll
            for (int i = 0; i < R; ++i) gl[i][c] += (v[i][j].x * w.x + v[i][j].y * w.y) + (v[i][j].z * w.z + v[i][j].w * w.w); }
        if (c & 1) __builtin_amdgcn_sched_barrier(0); }
#pragma unroll
    for (int o = 1; o < 64; o <<= 1)
#pragma unroll
        for (int i = 0; i < R; ++i)
#pragma unroll
            for (int c = 0; c < 4; ++c) gl[i][c] += __shfl_xor(gl[i][c], o);
    int gi[R]; float ggate[R];
#pragma unroll
    for (int i = 0; i < R; ++i) { float g0 = gl[i][0] + a.bg[0], g1 = gl[i][1] + a.bg[1], g2 = gl[i][2] + a.bg[2], g3 = gl[i][3] + a.bg[3];
        int q = 0; float gm = g0; if (g1 > gm) { gm = g1; q = 1; } if (g2 > gm) { gm = g2; q = 2; } if (g3 > gm) { gm = g3; q = 3; }
        ggate[i] = 1.0f / (__expf(g0 - gm) + __expf(g1 - gm) + __expf(g2 - gm) + __expf(g3 - gm)); gi[i] = __builtin_amdgcn_readfirstlane(q); }
    float el[R][8];
#pragma unroll
    for (int c = 0; c < 8; ++c) {
#pragma unroll
        for (int i = 0; i < R; ++i) { const f32x4* wp = (const f32x4*)(a.wt + (size_t)(4 + gi[i] * 8 + c) * DM) + lane; float acc = 0.f;
#pragma unroll
            for (int j = 0; j < 8; ++j) { const f32x4 w = wp[64 * j]; acc += (v[i][j].x * w.x + v[i][j].y * w.y) + (v[i][j].z * w.z + v[i][j].w * w.w); }
            el[i][c] = acc; }
        __builtin_amdgcn_sched_barrier(0); }
#pragma unroll
    for (int o = 1; o < 64; o <<= 1)
#pragma unroll
        for (int i = 0; i < R; ++i)
#pragma unroll
            for (int c = 0; c < 8; ++c) el[i][c] += __shfl_xor(el[i][c], o);
#pragma unroll
    for (int i = 0; i < R; ++i) { const int m = m0 + i * ms;
        int i1 = 0; float m1 = el[i][0] + a.br[gi[i] * 8];
        float ev[8];
#pragma unroll
        for (int c = 0; c < 8; ++c) ev[c] = el[i][c] + a.br[gi[i] * 8 + c];
#pragma unroll
        for (int c = 1; c < 8; ++c) if (ev[c] > m1) { m1 = ev[c]; i1 = c; }
        int i2 = -1; float m2 = -3.0e38f;
#pragma unroll
        for (int c = 0; c < 8; ++c) if (c != i1 && ev[c] > m2) { m2 = ev[c]; i2 = c; }
        const float e2 = __expf(m2 - m1); const float w1 = ggate[i] / (1.0f + e2), w2 = ggate[i] * e2 / (1.0f + e2);
        if (lane == 0) {
            const int ex1 = gi[i] * 8 + i1, ex2 = gi[i] * 8 + i2;
            const int p1 = (int)__hip_atomic_fetch_add(hist + ex1, 1u, __ATOMIC_RELAXED, __HIP_MEMORY_SCOPE_WORKGROUP), p2 = (int)__hip_atomic_fetch_add(hist + ex2, 1u, __ATOMIC_RELAXED, __HIP_MEMORY_SCOPE_WORKGROUP);
            LAS int* ri = rinfo + (lr0 + i * lrs) * 8; ri[0] = ex1; ri[1] = ex2; ri[2] = p1; ri[3] = p2; ((LAS float*)ri)[4] = w1; ((LAS float*)ri)[5] = w2; ri[6] = m;
        } }
}
__global__ void __launch_bounds__(256) k_ln1_route(const float* pre1, RouteArgs a) { ln1_route_row(pre1, a, blockIdx.x * 4 + (threadIdx.x >> 6), threadIdx.x & 63); }

__device__ __forceinline__ int row_start(const unsigned* cnt, int e) { int s = 0; for (int i = 0; i < e; ++i) s += ((int)cnt[i] + 255) & ~255; return s; }
struct P6Args { const bf16_t* h1b; const bf16_t* wgut; const bf16_t* wdt; const unsigned* cnt; const int* tokidx; bf16_t* act; bf16_t* y; };
__global__ void __launch_bounds__(256) k_moe_up(P6Args a) {
    const int wave = threadIdx.x >> 6, lane = threadIdx.x & 63, fr = lane & 15, fq = lane >> 4;
    const int R0 = blockIdx.y * 64;
    int e = 0, rs = 0;
    for (; e < NEXP; ++e) { const int n = ((int)a.cnt[e] + 255) & ~255; if (R0 < rs + n) break; rs += n; }
    if (e == NEXP) return;
    const int pos = R0 - rs + wave * 16 + fr; const int tok = pos < (int)a.cnt[e] ? a.tokidx[e * ECAP + pos] : 0;
    const int jb = blockIdx.x;
    f32x4 ag[8], au[8];
#pragma unroll
    for (int j = 0; j < 8; ++j) { ag[j] = (f32x4){0.f, 0.f, 0.f, 0.f}; au[j] = (f32x4){0.f, 0.f, 0.f, 0.f}; }
    const bf16_t* wb = a.wgut + ((size_t)e * 2048 + jb * 256) * DM;
    wave_gemm16x128(a.h1b + (size_t)tok * DM, wb, DM, DM, ag);
    wave_gemm16x128(a.h1b + (size_t)tok * DM, wb + (size_t)128 * DM, DM, DM, au);
#pragma unroll
    for (int r = 0; r < 4; ++r) { const size_t row = (size_t)R0 + wave * 16 + fq * 4 + r;
#pragma unroll
        for (int j = 0; j < 8; ++j) { const float g = ag[j][r], u = au[j][r]; a.act[row * FF + jb * 128 + 16 * j + fr] = f2bf(g / (1.0f + __expf(-g)) * u); } }
}
__global__ void __launch_bounds__(256) k_moe_down(P6Args a) {
    const int wave = threadIdx.x >> 6, lane = threadIdx.x & 63, fr = lane & 15, fq = lane >> 4;
    const int R0 = blockIdx.y * 64;
    int e = 0, rs = 0;
    for (; e < NEXP; ++e) { const int n = ((int)a.cnt[e] + 255) & ~255; if (R0 < rs + n) break; rs += n; }
    if (e == NEXP) return;
    f32x4 acc[8];
#pragma unroll
    for (int j = 0; j < 8; ++j) acc[j] = (f32x4){0.f, 0.f, 0.f, 0.f};
    wave_gemm16x128(a.act + ((size_t)R0 + wave * 16 + fr) * FF, a.wdt + ((size_t)e * 2048 + blockIdx.x * 128) * FF, FF, FF, acc);
#pragma unroll
    for (int r = 0; r < 4; ++r) { const size_t row = (size_t)R0 + wave * 16 + fq * 4 + r;
#pragma unroll
        for (int j = 0; j < 8; ++j) a.y[row * DM + blockIdx.x * 128 + 16 * j + fr] = f2bf(acc[j][r]); }
}
struct P8Args { const float* h1; const bf16_t* y; const unsigned* cnt; const int* slot; const float* g; const float* b; float* out; };
__device__ __forceinline__ void final_row(const P8Args& a, int m, int lane, size_t r1, size_t r2, float w1, float w2) {
    f32x4 v[8]; float s = 0.f;
#pragma unroll
    for (int j = 0; j < 8; ++j) { const int c = 4 * lane + 256 * j; const f32x4 hv = *(const f32x4*)(a.h1 + (size_t)m * DM + c);
        const uint2 ya = *(const uint2*)(a.y + r1 * DM + c), yb = *(const uint2*)(a.y + r2 * DM + c);
        f32x4 f; f.x = w1 * bflo(ya.x) + w2 * bflo(yb.x); f.y = w1 * bfhi(ya.x) + w2 * bfhi(yb.x); f.z = w1 * bflo(ya.y) + w2 * bflo(yb.y); f.w = w1 * bfhi(ya.y) + w2 * bfhi(yb.y);
        v[j] = hv * ALPHA + f; s += (v[j].x + v[j].y) + (v[j].z + v[j].w); }
    const float mean = wave_sum(s) * (1.0f / DM); float s2 = 0.f;
#pragma unroll
    for (int j = 0; j < 8; ++j) { v[j] = v[j] - mean; s2 += (v[j].x * v[j].x + v[j].y * v[j].y) + (v[j].z * v[j].z + v[j].w * v[j].w); }
    const float rstd = 1.0f / sqrtf(wave_sum(s2) * (1.0f / DM) + LN_EPS);
#pragma unroll
    for (int j = 0; j < 8; ++j) { const int c = 4 * lane + 256 * j; const f32x4 gg = *(const f32x4*)(a.g + c), bb = *(const f32x4*)(a.b + c);
        *(f32x4*)(a.out + (size_t)m * DM + c) = v[j] * rstd * gg + bb; }
}
__device__ __forceinline__ void final_row_t(const P8Args& a, const float* pre1, const float2* lnst, const float* g1, const float* b1, int m, int lane, size_t r1, size_t r2, float w1, float w2) {
    f32x4 v[8]; float s = 0.f; const float2 st = lnst[m];
#pragma unroll
    for (int j = 0; j < 8; ++j) { const int c = 4 * lane + 256 * j; const f32x4 pv = *(const f32x4*)(pre1 + (size_t)m * DM + c);
        const f32x4 hv = (pv - st.x) * st.y * *(const f32x4*)(g1 + c) + *(const f32x4*)(b1 + c);
        const uint2 ya = *(const uint2*)(a.y + r1 * DM + c), yb = *(const uint2*)(a.y + r2 * DM + c);
        f32x4 f; f.x = w1 * bflo(ya.x) + w2 * bflo(yb.x); f.y = w1 * bfhi(ya.x) + w2 * bfhi(yb.x); f.z = w1 * bflo(ya.y) + w2 * bflo(yb.y); f.w = w1 * bfhi(ya.y) + w2 * bfhi(yb.y);
        v[j] = hv * ALPHA + f; s += (v[j].x + v[j].y) + (v[j].z + v[j].w); }
    const float mean = wave_sum(s) * (1.0f / DM); float s2 = 0.f;
#pragma unroll
    for (int j = 0; j < 8; ++j) { v[j] = v[j] - mean; s2 += (v[j].x * v[j].x + v[j].y * v[j].y) + (v[j].z * v[j].z + v[j].w * v[j].w); }
    const float rstd = 1.0f / sqrtf(wave_sum(s2) * (1.0f / DM) + LN_EPS);
#pragma unroll
    for (int j = 0; j < 8; ++j) { const int c = 4 * lane + 256 * j; const f32x4 gg = *(const f32x4*)(a.g + c), bb = *(const f32x4*)(a.b + c);
        *(f32x4*)(a.out + (size_t)m * DM + c) = v[j] * rstd * gg + bb; }
}
__device__ __forceinline__ void final_rows2_t(const P8Args& a, const float* pre1, const float2* lnst, const float* g1, const float* b1, int ma, int mb, int lane,
                                              size_t r1a, size_t r2a, float w1a, float w2a, size_t r1b, size_t r2b, float w1b, float w2b) {
    f32x4 v[2][8]; float s[2] = {0.f, 0.f}; const float2 sta = lnst[ma], stb = lnst[mb];
#pragma unroll
    for (int j = 0; j < 8; ++j) { const int c = 4 * lane + 256 * j; const f32x4 gg = *(const f32x4*)(g1 + c), bb = *(const f32x4*)(b1 + c);
#pragma unroll
        for (int i = 0; i < 2; ++i) { const int m = i ? mb : ma; const float2 st = i ? stb : sta; const size_t r1 = i ? r1b : r1a, r2 = i ? r2b : r2a; const float w1 = i ? w1b : w1a, w2 = i ? w2b : w2a;
            const f32x4 pv = *(const f32x4*)(pre1 + (size_t)m * DM + c);
            const f32x4 hv = (pv - st.x) * st.y * gg + bb;
            const uint2 ya = *(const uint2*)(a.y + r1 * DM + c), yb = *(const uint2*)(a.y + r2 * DM + c);
            f32x4 f; f.x = w1 * bflo(ya.x) + w2 * bflo(yb.x); f.y = w1 * bfhi(ya.x) + w2 * bfhi(yb.x); f.z = w1 * bflo(ya.y) + w2 * bflo(yb.y); f.w = w1 * bfhi(ya.y) + w2 * bfhi(yb.y);
            v[i][j] = hv * ALPHA + f; s[i] += (v[i][j].x + v[i][j].y) + (v[i][j].z + v[i][j].w); } }
#pragma unroll
    for (int o = 1; o < 64; o <<= 1) { s[0] += __shfl_xor(s[0], o); s[1] += __shfl_xor(s[1], o); }
    float s2[2] = {0.f, 0.f};
#pragma unroll
    for (int i = 0; i < 2; ++i) { const float mean = s[i] * (1.0f / DM);
#pragma unroll
        for (int j = 0; j < 8; ++j) { v[i][j] = v[i][j] - mean; s2[i] += (v[i][j].x * v[i][j].x + v[i][j].y * v[i][j].y) + (v[i][j].z * v[i][j].z + v[i][j].w * v[i][j].w); } }
#pragma unroll
    for (int o = 1; o < 64; o <<= 1) { s2[0] += __shfl_xor(s2[0], o); s2[1] += __shfl_xor(s2[1], o); }
    const float rstd0 = 1.0f / sqrtf(s2[0] * (1.0f / DM) + LN_EPS), rstd1 = 1.0f / sqrtf(s2[1] * (1.0f / DM) + LN_EPS);
    for (int j = 0; j < 8; ++j) { const int c = 4 * lane + 256 * j; const f32x4 gg = *(const f32x4*)(a.g + c), bb = *(const f32x4*)(a.b + c);
        *(f32x4*)(a.out + (size_t)ma * DM + c) = v[0][j] * rstd0 * gg + bb; *(f32x4*)(a.out + (size_t)mb * DM + c) = v[1][j] * rstd1 * gg + bb; }
}
__global__ void __launch_bounds__(256) k_final(P8Args a) {
    const int lane = threadIdx.x & 63, m = blockIdx.x * 4 + (threadIdx.x >> 6);
    const int* sl = a.slot + (size_t)m * 6; const int e1 = sl[0], e2 = sl[1], p1 = sl[2], p2 = sl[3]; const float w1 = ((const float*)sl)[4], w2 = ((const float*)sl)[5];
    final_row(a, m, lane, (size_t)row_start(a.cnt, e1) + p1, (size_t)row_start(a.cnt, e2) + p2, w1, w2);
}

namespace pg8 {
constexpr int BM = 256, BK = 64, HALF = 128, HTB = HALF * BK * 2  , STAGE_BYTES = 8 * HTB;
__device__ __forceinline__ int lds_byte(int r, int c) { const int st = (r >> 4) * 2 + (c >> 5), rr = r & 15, cc = c & 31, ob = rr * 64 + cc * 2; return st * 1024 + (ob ^ (((ob >> 9) & 1) << 5)); }
__device__ __forceinline__ void stage_rc(int b, int& R, int& C) { const int st = b / 1024, sb = b % 1024, swz = sb ^ (((sb >> 9) & 1) << 5); R = (st >> 1) * 16 + swz / 64; C = (st & 1) * 32 + (swz % 64) / 2; }

struct Unit { const char* A; const char* B; unsigned lda, ldb; int nt; int pm, pn, aux; const int* gidx; int gcnt; };
struct Voff { unsigned a[2][2], b[2][2]; };
__device__ __forceinline__ int brow_perm8(int h, int R) { return 128 * h + (R & ~31) + 8 * ((R >> 2) & 3) + 4 * ((R >> 4) & 1) + (R & 3); }
__device__ __forceinline__ int brow_rope(int h, int R) { return 128 * (R >> 6) + 64 * h + 32 * ((R >> 5) & 1) + 8 * ((R >> 2) & 3) + 4 * ((R >> 4) & 1) + (R & 3); }

template <class Epi> __device__ __forceinline__ void make_voff(const Unit& u, Voff& v, int tid) {
#pragma unroll
    for (int i = 0; i < 2; ++i) { int R, C; stage_rc(tid * 16 + i * 8192, R, C);
#pragma unroll
        for (int h = 0; h < 2; ++h) {
            int ra = h * HALF + R;
            if (u.gidx) ra = (ra < u.gcnt) ? u.gidx[ra] : 0;
            v.a[h][i] = (unsigned)ra * u.lda + (unsigned)C * 2u;
            v.b[h][i] = (unsigned)Epi::brow(h, R) * u.ldb + (unsigned)C * 2u;
        } }
}

template <class Epi, class Sched, bool ALIGN_EPI, bool SP2>
__device__ __forceinline__ void gemm_phase(LAS unsigned char* lds, LAS unsigned char* ex, const Sched& S, const Epi& E, int wid) {
    const int lane = lane_id(), tid = wid * 64 + lane, wr = wid >> 2, wc = wid & 3, fr = lane & 15, fq = lane >> 4;
    const unsigned ldsw = (unsigned)wid * 1024u;
    const int aoff = lds_byte(wr * 64 + fr, fq * 8), boff = lds_byte(wc * 32 + fr, fq * 8);
#define PG8_SA(b, h) (((b) * 2 + (h)) * HTB)
#define PG8_SB(b, h) ((4 + (b) * 2 + (h)) * HTB)
#define PG8_STAGE(bufoff, gbase, voff) do { _Pragma("unroll") for (int _i = 0; _i < 2; ++_i) \
        __builtin_amdgcn_global_load_lds((const unsigned*)((const char*)(gbase) + (voff)[_i]), (LAS unsigned*)(lds + (bufoff) + ldsw + _i * 8192), 16, 0, 0); } while (0)
#define PG8_LDA(dst, b, h) do { _Pragma("unroll") for (int m = 0; m < 4; ++m) _Pragma("unroll") for (int k = 0; k < 2; ++k) dst[m][k] = *(const LAS bf16x8*)(lds + PG8_SA(b, h) + aoff + m * 2048 + k * 1024); } while (0)
#define PG8_LDB(dst, b, h) do { _Pragma("unroll") for (int n = 0; n < 2; ++n) _Pragma("unroll") for (int k = 0; k < 2; ++k) dst[n][k] = *(const LAS bf16x8*)(lds + PG8_SB(b, h) + boff + n * 2048 + k * 1024); } while (0)
#define PG8_MMA(ai, bj, At, Bt) do { __builtin_amdgcn_s_setprio(1); _Pragma("unroll") for (int m = 0; m < 4; ++m) _Pragma("unroll") for (int n = 0; n < 2; ++n) _Pragma("unroll") for (int k = 0; k < 2; ++k) \
        acc[ai][bj][m][n] = __builtin_amdgcn_mfma_f32_16x16x32_bf16(Bt[n][k], At[m][k], acc[ai][bj][m][n], 0, 0, 0); __builtin_amdgcn_s_setprio(0); } while (0)
#define PG8_WAIT_V(n) asm volatile("s_waitcnt vmcnt(" #n ")" ::: "memory")
#define PG8_WAIT_L(n) asm volatile("s_waitcnt lgkmcnt(" #n ")" ::: "memory")
#define PG8_BAR __builtin_amdgcn_s_barrier()
#define PG8_SCHED __builtin_amdgcn_sched_barrier(0)
    Unit cur, nxt; int ui = 0;
    if (!S.next(0, cur)) return;
    Voff vo, nvo;
    make_voff<Epi>(cur, vo, tid);
    f32x4 acc[2][2][4][2];
#pragma unroll
    for (int a = 0; a < 2; ++a)
#pragma unroll
        for (int b = 0; b < 2; ++b)
#pragma unroll
            for (int m = 0; m < 4; ++m)
#pragma unroll
                for (int n = 0; n < 2; ++n) acc[a][b][m][n] = (f32x4){0.f, 0.f, 0.f, 0.f};
    bf16x8 At[4][2], B0[2][2], B1[2][2];
    const char* cA = cur.A; const char* cB = cur.B;
    const size_t kstep = (size_t)(BK * 2);
    if constexpr (SP2) {
        PG8_STAGE(PG8_SB(0, 0), cB, vo.b[0]); PG8_STAGE(PG8_SB(0, 1), cB, vo.b[1]); PG8_STAGE(PG8_SA(0, 0), cA, vo.a[0]); PG8_STAGE(PG8_SA(0, 1), cA, vo.a[1]);
        if (wr == 1) PG8_BAR;
        PG8_WAIT_V(2); PG8_BAR;
        PG8_STAGE(PG8_SB(1, 0), cB + kstep, vo.b[0]); PG8_STAGE(PG8_SA(1, 0), cA + kstep, vo.a[0]); PG8_STAGE(PG8_SB(1, 1), cB + kstep, vo.b[1]);
        PG8_WAIT_V(6); PG8_BAR;
    } else {
        PG8_STAGE(PG8_SB(0, 0), cB, vo.b[0]); PG8_STAGE(PG8_SA(0, 0), cA, vo.a[0]); PG8_STAGE(PG8_SB(0, 1), cB, vo.b[1]); PG8_STAGE(PG8_SA(0, 1), cA, vo.a[1]);
        if (wr == 1) PG8_BAR;
        PG8_WAIT_V(4); PG8_BAR;
        PG8_STAGE(PG8_SB(1, 0), cB + kstep, vo.b[0]); PG8_STAGE(PG8_SA(1, 0), cA + kstep, vo.a[0]); PG8_STAGE(PG8_SB(1, 1), cB + kstep, vo.b[1]);
        PG8_WAIT_V(6); PG8_BAR;
    }
    for (;;) {
        const bool has_next = S.next(ui + 1, nxt);
        if (has_next) make_voff<Epi>(nxt, nvo, tid); else nvo = vo;
        const char* nA = has_next ? nxt.A : cA; const char* nB = has_next ? nxt.B : cB;
        const int nt = cur.nt;
        for (int t = 0; t < nt; t += 2) {
            const bool last = (t == nt - 2);
            const char* a1 = cA + (size_t)(t + 1) * kstep;
            const char* a2 = last ? nA : cA + (size_t)(t + 2) * kstep; const char* b2 = last ? nB : cB + (size_t)(t + 2) * kstep;
            const char* a3 = a2 + kstep; const char* b3 = b2 + kstep;
            Voff w;
#pragma unroll
            for (int h = 0; h < 2; ++h)
#pragma unroll
                for (int i = 0; i < 2; ++i) { w.a[h][i] = last ? nvo.a[h][i] : vo.a[h][i]; w.b[h][i] = last ? nvo.b[h][i] : vo.b[h][i]; }
            if constexpr (SP2) {
            PG8_LDB(B0, 0, 0); PG8_LDB(B1, 0, 1); PG8_SCHED; PG8_LDA(At, 0, 0); PG8_STAGE(PG8_SA(1, 1), a1, vo.a[1]);
            PG8_WAIT_V(8); PG8_WAIT_L(0); PG8_BAR; PG8_MMA(0, 0, At, B0); PG8_MMA(0, 1, At, B1); PG8_BAR; PG8_SCHED;
            PG8_LDA(At, 0, 1); PG8_STAGE(PG8_SB(0, 0), b2, w.b[0]); PG8_STAGE(PG8_SB(0, 1), b2, w.b[1]); PG8_STAGE(PG8_SA(0, 0), a2, w.a[0]);
            PG8_WAIT_V(8); PG8_WAIT_L(0); PG8_BAR; PG8_MMA(1, 0, At, B0); PG8_MMA(1, 1, At, B1); PG8_BAR; PG8_SCHED;
            PG8_LDB(B0, 1, 0); PG8_LDB(B1, 1, 1); PG8_SCHED; PG8_LDA(At, 1, 0); PG8_STAGE(PG8_SA(0, 1), a2, w.a[1]);
            PG8_WAIT_V(8); PG8_WAIT_L(0); PG8_BAR; PG8_MMA(0, 0, At, B0); PG8_MMA(0, 1, At, B1); PG8_BAR; PG8_SCHED;
            PG8_LDA(At, 1, 1); PG8_STAGE(PG8_SB(1, 0), b3, w.b[0]); PG8_STAGE(PG8_SB(1, 1), b3, w.b[1]); PG8_STAGE(PG8_SA(1, 0), a3, w.a[0]);
            PG8_WAIT_V(8); PG8_WAIT_L(0); PG8_BAR; PG8_MMA(1, 0, At, B0); PG8_MMA(1, 1, At, B1); PG8_BAR; PG8_SCHED;
            } else {
            PG8_LDB(B0, 0, 0); PG8_SCHED; PG8_LDA(At, 0, 0); PG8_STAGE(PG8_SA(1, 1), a1, vo.a[1]);
            PG8_WAIT_L(8); PG8_BAR; PG8_WAIT_L(0); PG8_MMA(0, 0, At, B0); PG8_BAR; PG8_SCHED;
            PG8_LDB(B1, 0, 1); PG8_STAGE(PG8_SB(0, 0), b2, w.b[0]);
            PG8_BAR; PG8_WAIT_L(0); PG8_MMA(0, 1, At, B1); PG8_BAR;
            PG8_LDA(At, 0, 1); PG8_STAGE(PG8_SA(0, 0), a2, w.a[0]);
            PG8_BAR; PG8_WAIT_L(0); PG8_MMA(1, 0, At, B0); PG8_BAR; PG8_SCHED;
            PG8_STAGE(PG8_SB(0, 1), b2, w.b[1]);
            PG8_WAIT_V(6); PG8_BAR; PG8_MMA(1, 1, At, B1); PG8_BAR;
            PG8_LDB(B0, 1, 0); PG8_SCHED; PG8_LDA(At, 1, 0); PG8_STAGE(PG8_SA(0, 1), a2, w.a[1]);
            PG8_WAIT_L(8); PG8_BAR; PG8_WAIT_L(0); PG8_MMA(0, 0, At, B0); PG8_BAR; PG8_SCHED;
            PG8_LDB(B1, 1, 1); PG8_STAGE(PG8_SB(1, 0), b3, w.b[0]);
            PG8_BAR; PG8_WAIT_L(0); PG8_MMA(0, 1, At, B1); PG8_BAR;
            PG8_LDA(At, 1, 1); PG8_STAGE(PG8_SA(1, 0), a3, w.a[0]);
            PG8_BAR; PG8_WAIT_L(0); PG8_MMA(1, 0, At, B0); PG8_BAR; PG8_SCHED;
            PG8_STAGE(PG8_SB(1, 1), b3, w.b[1]);
            PG8_WAIT_V(6); PG8_BAR; PG8_MMA(1, 1, At, B1); PG8_BAR;
            }
        }
        if constexpr (ALIGN_EPI) { if (wr == 0) PG8_BAR; }
        bool do_epi = true;
        if constexpr (Epi::SPLIT) {
            static_assert(ALIGN_EPI, "the split-K hand-off uses workgroup barriers");
            if (cur.aux & (1024 | 2048)) {
                const int t2 = wid * 64 + lane_id();
                f32x4* pp = (f32x4*)E.part(cur) + t2; unsigned* flag = E.flag(cur);
                if (cur.aux & 1024) {
#pragma unroll
                    for (int a = 0; a < 2; ++a)
#pragma unroll
                        for (int b = 0; b < 2; ++b)
#pragma unroll
                            for (int m = 0; m < 4; ++m)
#pragma unroll
                                for (int n = 0; n < 2; ++n) pp[(((a * 2 + b) * 4 + m) * 2 + n) * 512] = acc[a][b][m][n];
                    __builtin_amdgcn_fence(__ATOMIC_RELEASE, "agent");
                    asm volatile("s_waitcnt vmcnt(0)" ::: "memory");
                    PG8_BAR;
                    if (t2 == 0) __hip_atomic_store(flag, 1u, __ATOMIC_RELEASE, __HIP_MEMORY_SCOPE_AGENT);
                    do_epi = false;
                } else {
                    if (wid == 0) { unsigned sp = 0; while (__hip_atomic_load(flag, __ATOMIC_RELAXED, __HIP_MEMORY_SCOPE_AGENT) == 0u && sp < (1u << 22)) { __builtin_amdgcn_s_sleep(1); ++sp; } }
                    PG8_BAR;
                    __builtin_amdgcn_fence(__ATOMIC_ACQUIRE, "agent");
#pragma unroll
                    for (int a = 0; a < 2; ++a)
#pragma unroll
                        for (int b = 0; b < 2; ++b)
#pragma unroll
                            for (int m = 0; m < 4; ++m)
#pragma unroll
                                for (int n = 0; n < 2; ++n) acc[a][b][m][n] += pp[(((a * 2 + b) * 4 + m) * 2 + n) * 512];
                }
            }
        }
        if (do_epi) E(acc, cur, wr, wc, fr, fq, ex);
        if (!has_next) break;
        if (!(cur.aux & 256)) {
#pragma unroll
        for (int a = 0; a < 2; ++a)
#pragma unroll
            for (int b = 0; b < 2; ++b)
#pragma unroll
                for (int m = 0; m < 4; ++m)
#pragma unroll
                    for (int n = 0; n < 2; ++n) acc[a][b][m][n] = (f32x4){0.f, 0.f, 0.f, 0.f};
        }
        cur = nxt; cA = nA; cB = nB; vo = nvo; ++ui;
        if constexpr (ALIGN_EPI) { if (wr == 1) PG8_BAR; }
    }
    PG8_WAIT_V(0);
    if constexpr (!ALIGN_EPI) { if (wr == 0) PG8_BAR; }
    PG8_BAR;
#undef PG8_SA
#undef PG8_SB
#undef PG8_STAGE
#undef PG8_LDA
#undef PG8_LDB
#undef PG8_MMA
#undef PG8_WAIT_V
#undef PG8_WAIT_L
#undef PG8_BAR
#undef PG8_SCHED
}

struct TileOrder {
    int nM, nN, nwg, G, c;
    __device__ void init(int M, int N, int G_, int c_) { nM = M / BM; nN = N / BM; nwg = nM * nN; G = G_; c = c_; }
    __device__ bool tile(int i, int& pm, int& pn) const {
        const long L = (long)i * G + c; if (L >= nwg) return false;
        int wgid = (int)L; { const int q = nwg / 8, r = nwg % 8, xcd = wgid % 8, off = wgid / 8; wgid = (xcd < r ? xcd * (q + 1) : r * (q + 1) + (xcd - r) * q) + off; }
        const int nig = 8 * nN, gid = wgid / nig, fm = gid * 8, gsz = (nM - fm) < 8 ? (nM - fm) : 8;
        pm = fm + ((wgid % nig) % gsz); pn = (wgid % nig) / gsz; return true;
    }
};
}

typedef float f32x2 __attribute__((ext_vector_type(2)));
#define ACC_T f32x4 (&acc)[2][2][4][2]

struct EpiProj {
    __device__ static __forceinline__ int brow(int h, int R) { return pg8::brow_rope(h, R); }
    unsigned char* ws; const float *qg, *kg;
    static constexpr bool SPLIT = true;
    __device__ __forceinline__ float* part(const pg8::Unit& u) const { return (float*)(ws + WS_OB) + (size_t)u.gcnt * 65536; }
    __device__ __forceinline__ unsigned* flag(const pg8::Unit& u) const { return (unsigned*)(ws + WS_CTL) + CW_SPLIT + u.gcnt; }
    __device__ static __forceinline__ void rot4(const f32x4 x1, const f32x4 x2, const f32x4 t0, const f32x4 t1, f32x4& y1, f32x4& y2) {
        y1.x = x1.x * t0.x - x2.x * t0.y; y2.x = x2.x * t0.x + x1.x * t0.y;
        y1.y = x1.y * t0.z - x2.y * t0.w; y2.y = x2.y * t0.z + x1.y * t0.w;
        y1.z = x1.z * t1.x - x2.z * t1.y; y2.z = x2.z * t1.x + x1.z * t1.y;
        y1.w = x1.w * t1.z - x2.w * t1.w; y2.w = x2.w * t1.z + x1.w * t1.w;
    }
    __device__ static __forceinline__ void cs4(float pos, const f32x4 ir, f32x4& c, f32x4& s) {
#pragma unroll
        for (int q = 0; q < 4; ++q) { const float r = __builtin_amdgcn_fractf(pos * ir[q]); c[q] = __builtin_amdgcn_cosf(r); s[q] = __builtin_amdgcn_sinf(r); }
    }
    __device__ static __forceinline__ void rotv(const f32x4 x1, const f32x4 x2, const f32x4 c, const f32x4 s, f32x4& y1, f32x4& y2) { y1 = x1 * c - x2 * s; y2 = x2 * c + x1 * s; }
    __device__ static __forceinline__ void store8(bf16_t* dst, const f32x4 a, const f32x4 b) {
        u32x4 w; w.x = cvtpk(a.x, a.y); w.y = cvtpk(a.z, a.w); w.z = cvtpk(b.x, b.y); w.w = cvtpk(b.z, b.w); *(u32x4*)dst = w; }
    __device__ __forceinline__ void operator()(ACC_T, const pg8::Unit& u, int wr, int wc, int fr, int fq, LAS unsigned char* ex) const {
        const int ng = 2 * u.pn + (wc >> 1), c0 = 32 * (wc & 1) + 8 * fq;
        if (ng < 72) {
            const int which = ng / 24, hh = ng % 24, g = hh >> 3, h = hh & 7;
            bf16_t* buf = (bf16_t*)(ws + WS_QA + (size_t)which * (WS_KA - WS_QA));
            f32x4 ira = {0.f, 0.f, 0.f, 0.f}, irb = ira;
            if (which < 2) { ira = *(const f32x4*)(INV64 + c0) * 0.15915494309f; irb = *(const f32x4*)(INV64 + c0 + 4) * 0.15915494309f; }
#pragma unroll
            for (int ai = 0; ai < 2; ++ai)
#pragma unroll
                for (int m = 0; m < 4; ++m) {
                    const int mrow = u.pm * 256 + ai * 128 + wr * 64 + m * 16 + fr, b = mrow >> 12, t = mrow & 4095;
                    bf16_t* dst = buf + ((size_t)((g * 2 + b) * 8 + h) * SEQ + perm_pos(g, t)) * HD + c0;
                    f32x4 y1a = acc[ai][0][m][0], y1b = acc[ai][0][m][1], y2a = acc[ai][1][m][0], y2b = acc[ai][1][m][1];
                    if (which < 2) {
                        f32x4 ca, sa, cb, sb; cs4((float)t, ira, ca, sa); cs4((float)t, irb, cb, sb);
                        rotv(acc[ai][0][m][0], acc[ai][1][m][0], ca, sa, y1a, y2a); rotv(acc[ai][0][m][1], acc[ai][1][m][1], cb, sb, y1b, y2b);
                    }
                    store8(dst, y1a, y1b); store8(dst + 64, y2a, y2b);
                }
        } else if (ng < 92) {
            const int k = ng - 72;
            LAS float* X = (LAS float*)ex;
#pragma unroll
            for (int ai = 0; ai < 2; ++ai)
#pragma unroll
                for (int m = 0; m < 4; ++m) { float s = 0.f;
#pragma unroll
                    for (int bj = 0; bj < 2; ++bj)
#pragma unroll
                        for (int n = 0; n < 2; ++n) { const f32x4 x = acc[ai][bj][m][n]; s += (x.x * x.x + x.y * x.y) + (x.z * x.z + x.w * x.w); }
                    s += __shfl_xor(s, 16); s += __shfl_xor(s, 32);
                    if (fq == 0) X[(ai * 128 + wr * 64 + m * 16 + fr) * 4 + wc] = s; }
            asm volatile("s_waitcnt lgkmcnt(0)" ::: "memory"); __builtin_amdgcn_s_barrier(); asm volatile("" ::: "memory");
            const float* gn = (k < 16) ? qg : kg;
            f32x4 ira, irb;
            { const f32x4* ip = (const f32x4*)(INV64 + 16 * fq); const f32x4 w0 = ip[0], w1 = ip[1], w2 = ip[2], w3 = ip[3];
              ira.x = w0.x; ira.y = w0.z; ira.z = w1.x; ira.w = w1.z; irb.x = w2.x; irb.y = w2.z; irb.z = w3.x; irb.w = w3.z; ira = ira * 0.15915494309f; irb = irb * 0.15915494309f; }
            bf16_t* qb = (bf16_t*)(ws + WS_QB); bf16_t* kb = (bf16_t*)(ws + WS_KB);
            const f32x4 g1a = *(const f32x4*)(gn + c0), g1b = *(const f32x4*)(gn + c0 + 4), g2a = *(const f32x4*)(gn + 64 + c0), g2b = *(const f32x4*)(gn + 64 + c0 + 4);
#pragma unroll
            for (int ai = 0; ai < 2; ++ai)
#pragma unroll
                for (int m = 0; m < 4; ++m) {
                    const int r = ai * 128 + wr * 64 + m * 16 + fr;
                    const float ssum = X[r * 4 + (wc & 2)] + X[r * 4 + (wc & 2) + 1];
                    const int mrow = u.pm * 256 + r, b = mrow >> 12, t = mrow & 4095;
                    bf16_t* dst = ((k < 16) ? qb + ((size_t)(b * 16 + k) * SEQ + t) * HD : kb + ((size_t)(b * 4 + (k - 16)) * SEQ + t) * HD) + c0;
                    const float rinv = 1.0f / sqrtf(ssum * (1.0f / 128.0f) + RMS_EPS);
                    const float pf = (float)((wc & 1) ? (t & 63) : (t >> 6));
                    f32x4 ca, sa, cb, sb; cs4(pf, ira, ca, sa); cs4(pf, irb, cb, sb);
                    f32x4 y1a, y1b, y2a, y2b;
                    rotv(acc[ai][0][m][0] * rinv * g1a, acc[ai][1][m][0] * rinv * g2a, ca, sa, y1a, y2a); rotv(acc[ai][0][m][1] * rinv * g1b, acc[ai][1][m][1] * rinv * g2b, cb, sb, y1b, y2b);
                    store8(dst, y1a, y1b); store8(dst + 64, y2a, y2b);
                }
        } else {
#pragma unroll
            for (int ai = 0; ai < 2; ++ai)
#pragma unroll
                for (int m = 0; m < 4; ++m) {
                    const int mrow = u.pm * 256 + ai * 128 + wr * 64 + m * 16 + fr, b = mrow >> 12, t = mrow & 4095;
                    bf16_t* dst = (ng < 96 ? (bf16_t*)(ws + WS_VB) + ((size_t)(b * 4 + (ng - 92)) * SEQ + t) * HD : (bf16_t*)(ws + WS_GATES) + (size_t)mrow * 4096 + (ng - 96) * 128) + c0;
                    f32x4 y1a = acc[ai][0][m][0], y1b = acc[ai][0][m][1], y2a = acc[ai][1][m][0], y2b = acc[ai][1][m][1];
                    if (ng >= 96) {
#pragma unroll
                        for (int q = 0; q < 4; ++q) { y1a[q] = __builtin_amdgcn_rcpf(1.0f + __expf(-y1a[q])); y1b[q] = __builtin_amdgcn_rcpf(1.0f + __expf(-y1b[q]));
                            y2a[q] = __builtin_amdgcn_rcpf(1.0f + __expf(-y2a[q])); y2b[q] = __builtin_amdgcn_rcpf(1.0f + __expf(-y2b[q])); } }
                    store8(dst, y1a, y1b); store8(dst + 64, y2a, y2b);
                }
        }
    }
};
struct ProjSched {
    pg8::TileOrder o; const char* ws;
    __device__ __forceinline__ bool next(int i, pg8::Unit& u) const { int pm, pn, aux = 0;
        if (o.G == 256 && o.nwg == 2176 && i == 8) { pg8::TileOrder o2 = o; o2.c = o.c & 127; if (!o2.tile(8, pm, pn)) return false; aux = (o.c < 128) ? 2048 : 1024; }
        else if (!o.tile(i, pm, pn)) return false;
        const size_t koff = (aux & 1024) ? (size_t)(DM / 128) * 128 : 0;
        u.A = ws + WS_XB + (size_t)pm * 256 * (DM * 2) + koff; u.B = ws + WS_WINT + (size_t)pn * 256 * (DM * 2) + koff; u.lda = DM * 2; u.ldb = DM * 2; u.nt = aux ? DM / 128 : DM / 64; u.pm = pm; u.pn = pn; u.aux = aux;
        u.gidx = nullptr; u.gcnt = o.c & 127; return true; }
};

struct EpiMix {
    static constexpr bool SPLIT = false;
    __device__ static __forceinline__ int brow(int h, int R) { return pg8::brow_perm8(h, R); }
    unsigned char* ws; const float* x;
    __device__ static __forceinline__ void unpack8(const u32x4 gw, f32x4& lo, f32x4& hi) { lo.x = bflo(gw.x); lo.y = bfhi(gw.x); lo.z = bflo(gw.y); lo.w = bfhi(gw.y); hi.x = bflo(gw.z); hi.y = bfhi(gw.z); hi.z = bflo(gw.w); hi.w = bfhi(gw.w); }
    __device__ __forceinline__ void operator()(f32x4 (&acc)[2][2][4][2], const pg8::Unit& u, int wr, int wc, int fr, int fq, LAS unsigned char* ex) const {
        const bf16_t* gates = (const bf16_t*)(ws + WS_GATES); bf16_t* merged = (bf16_t*)(ws + WS_MERGED); float* pre1 = (float*)(ws + WS_PRE1);
        { const int lane = lane_id(); fr = lane & 15; fq = lane >> 4; }
        const int mode = u.aux & 255; constexpr float GMIN = 8.673617379884035e-19f;
#define MIX_ROW(k) ((size_t)u.pm * 256 + ((k) >> 3) * 128 + wr * 64 + (((k) >> 1) & 3) * 16 + fr)
#define MIX_COL(k) (u.pn * 256 + ((k) & 1) * 128 + wc * 32 + 8 * fq)
#define MIX_ACC(k, n) acc[(k) >> 3][(k) & 1][((k) >> 1) & 3][n]
        if (mode == 2) {
#pragma unroll
            for (int b0 = 0; b0 < 16; b0 += 4) { f32x4 xa[4], xb[4];
#pragma unroll
                for (int k = 0; k < 4; ++k) { const size_t o = MIX_ROW(b0 + k) * DM + MIX_COL(b0 + k); xa[k] = *(const f32x4*)(x + o); xb[k] = *(const f32x4*)(x + o + 4); }
                __builtin_amdgcn_sched_barrier(0);
#pragma unroll
                for (int k = 0; k < 4; ++k) { const size_t o = MIX_ROW(b0 + k) * DM + MIX_COL(b0 + k);
                    *(f32x4*)(pre1 + o) = xa[k] * ALPHA + MIX_ACC(b0 + k, 0); *(f32x4*)(pre1 + o + 4) = xb[k] * ALPHA + MIX_ACC(b0 + k, 1); }
                __builtin_amdgcn_sched_barrier(0); }
        } else if (mode == 1) {
#pragma unroll
            for (int b0 = 0; b0 < 16; b0 += 4) { u32x4 w0[4], w1[4];
#pragma unroll
                for (int k = 0; k < 4; ++k) { const bf16_t* gp = gates + MIX_ROW(b0 + k) * 4096 + MIX_COL(b0 + k); w0[k] = *(const u32x4*)gp; w1[k] = *(const u32x4*)(gp + 2048); }
                __builtin_amdgcn_sched_barrier(0);
#pragma unroll
                for (int k = 0; k < 4; ++k) { f32x4 g0a, g0b, g1a, g1b; unpack8(w0[k], g0a, g0b); unpack8(w1[k], g1a, g1b);
#pragma unroll
                    for (int q = 0; q < 4; ++q) { MIX_ACC(b0 + k, 0)[q] *= g1a[q] * __builtin_amdgcn_rcpf(fmaxf(g0a[q], GMIN)); MIX_ACC(b0 + k, 1)[q] *= g1b[q] * __builtin_amdgcn_rcpf(fmaxf(g0b[q], GMIN)); } }
                __builtin_amdgcn_sched_barrier(0); }
        } else {
#pragma unroll
            for (int b0 = 0; b0 < 16; b0 += 8) { u32x4 w0[8];
#pragma unroll
                for (int k = 0; k < 8; ++k) w0[k] = *(const u32x4*)(gates + MIX_ROW(b0 + k) * 4096 + MIX_COL(b0 + k));
                __builtin_amdgcn_sched_barrier(0);
#pragma unroll
                for (int k = 0; k < 8; ++k) { f32x4 g0a, g0b; unpack8(w0[k], g0a, g0b);
#pragma unroll
                    for (int q = 0; q < 4; ++q) { g0a[q] = fmaxf(g0a[q], GMIN); g0b[q] = fmaxf(g0b[q], GMIN); }
                    const f32x4 t0 = g0a * MIX_ACC(b0 + k, 0), t1 = g0b * MIX_ACC(b0 + k, 1);
                    u32x4 w; w.x = cvtpk(t0.x, t0.y); w.y = cvtpk(t0.z, t0.w); w.z = cvtpk(t1.x, t1.y); w.w = cvtpk(t1.z, t1.w); *(u32x4*)(merged + MIX_ROW(b0 + k) * DM + MIX_COL(b0 + k)) = w; }
                __builtin_amdgcn_sched_barrier(0); }
        }
#undef MIX_ROW
#undef MIX_COL
#undef MIX_ACC
    }
};
struct MixSched {
    int mode, c; const char* ws;
    __device__ __forceinline__ bool next(int i, pg8::Unit& u) const {
        if (c >= 256) return false;
        const int pm = c >> 3, pn = c & 7; u.pm = pm; u.pn = pn; u.gidx = nullptr; u.gcnt = 0;
        if (mode == 0) { if (i > 1) return false;
            if (i == 1) { u.A = ws + WS_OA + (size_t)pm * 256 * 2048; u.B = ws + WS_WAT + (size_t)pn * 256 * 2048; u.lda = 2048; u.ldb = 2048; u.nt = 16; u.aux = 0; }
            else { u.A = ws + WS_OB + (size_t)pm * 256 * 4096; u.B = ws + WS_WBT + (size_t)pn * 256 * 4096; u.lda = 4096; u.ldb = 4096; u.nt = 32; u.aux = 1 | 256; }
            return true; }
        if (i > 0) return false;
        u.A = ws + WS_MERGED + (size_t)pm * 256 * 4096; u.B = ws + WS_WOT + (size_t)pn * 256 * 4096; u.lda = 4096; u.ldb = 4096; u.nt = 32; u.aux = 2; return true;
    }
};

struct MoeSched {
    int G, vcu, down; unsigned cnt_l, tpe_l;
    const char* ws;
    __device__ __forceinline__ void init(const unsigned* cnt, int lane) {
        unsigned c = 0; if (lane < NEXP) c = __hip_atomic_load(cnt + lane, __ATOMIC_RELAXED, __HIP_MEMORY_SCOPE_AGENT);
        unsigned t = (c + 255u) >> 8, inc = t;
#pragma unroll
        for (int o = 1; o < 32; o <<= 1) { const unsigned v = __shfl_up(inc, o); if ((lane & 31) >= o) inc += v; }
        cnt_l = c; tpe_l = inc - t;
    }
    __device__ __forceinline__ bool next(int i, pg8::Unit& u) const {
        const int lane = lane_id();
        const int total = (int)__builtin_amdgcn_readfirstlane(__shfl(tpe_l + ((cnt_l + 255u) >> 8), 31));
        const int L = i * G + vcu; if (L >= total * 8) return false;
        const int tg = L >> 3;
        const unsigned long long mk = __ballot(lane < NEXP && (int)tpe_l <= tg && (cnt_l > 0u));
        const int e = 63 - __builtin_clzll(mk);
        const int tp = (int)__builtin_amdgcn_readfirstlane(__shfl(tpe_l, e)), ce = (int)__builtin_amdgcn_readfirstlane(__shfl(cnt_l, e));
        const int te = (ce + 255) >> 8, q = L - 8 * tp, j = q / te, mt = q - j * te;
        u.pm = tp + mt; u.pn = j; u.aux = e; u.nt = down ? 16 : 32;
        if (!down) { u.A = ws + WS_H1B; u.lda = DM * 2; u.gidx = (const int*)(ws + WS_TOKIDX) + (size_t)e * ECAP + 256 * mt; u.gcnt = ce - 256 * mt; u.B = ws + WS_WGUT + ((size_t)e * 2048 + j * 256) * (DM * 2); u.ldb = DM * 2; }
        else { u.A = ws + WS_ACT + (size_t)(tp + mt) * 256 * (FF * 2); u.lda = FF * 2; u.gidx = nullptr; u.gcnt = 0; u.B = ws + WS_WDT + ((size_t)e * 2048 + j * 256) * (FF * 2); u.ldb = FF * 2; }
        return true;
    }
};
struct EpiMoe {
    __device__ static __forceinline__ int brow(int h, int R) { return pg8::brow_perm8(h, R); }
    static constexpr bool SPLIT = false;
    int down; unsigned char* ws;
    __device__ __forceinline__ void operator()(ACC_T, const pg8::Unit& u, int wr, int wc, int fr, int fq, LAS unsigned char* ex) const {
        bf16_t* act = (bf16_t*)(ws + WS_ACT); bf16_t* y = (bf16_t*)(ws + WS_Y);
#pragma unroll
        for (int ai = 0; ai < 2; ++ai)
#pragma unroll
            for (int m = 0; m < 4; ++m) { const size_t row = (size_t)u.pm * 256 + ai * 128 + wr * 64 + m * 16 + fr;
                if (!down) {
                    f32x4 v0, v1;
#pragma unroll
                    for (int q = 0; q < 4; ++q) { const float g0 = acc[ai][0][m][0][q], u0 = acc[ai][1][m][0][q], g1 = acc[ai][0][m][1][q], u1 = acc[ai][1][m][1][q];
                        v0[q] = g0 * __builtin_amdgcn_rcpf(1.0f + __expf(-g0)) * u0; v1[q] = g1 * __builtin_amdgcn_rcpf(1.0f + __expf(-g1)) * u1; }
                    u32x4 w; w.x = cvtpk(v0.x, v0.y); w.y = cvtpk(v0.z, v0.w); w.z = cvtpk(v1.x, v1.y); w.w = cvtpk(v1.z, v1.w);
                    *(u32x4*)(act + row * FF + u.pn * 128 + wc * 32 + 8 * fq) = w;
                } else {
#pragma unroll
                    for (int bj = 0; bj < 2; ++bj) { const f32x4 a0 = acc[ai][bj][m][0], a1 = acc[ai][bj][m][1];
                        u32x4 w; w.x = cvtpk(a0.x, a0.y); w.y = cvtpk(a0.z, a0.w); w.z = cvtpk(a1.x, a1.y); w.w = cvtpk(a1.z, a1.w);
                        *(u32x4*)(y + row * DM + u.pn * 256 + bj * 128 + wc * 32 + 8 * fq) = w; }
                } }
    }
};


namespace mg {
constexpr int HTB = 16384, ABUF = 2 * HTB, BBUF = 64 * 256, B_OFF = 4 * ABUF;
struct Unit { const char* A; unsigned lda; const int* gidx; int gcnt; const float* B0; const float* B1; unsigned ldbf; int nt, up, pm, pn; };
template <int OFF> __device__ __forceinline__ s16x4 vtr(int addr) { s16x4 r; asm volatile("ds_read_b64_tr_b16 %0, %1 offset:%2" : "=&v"(r) : "v"(addr), "i"(OFF) : "memory"); return r; }

template <class Sched, class Epi, int XV>
__device__ __forceinline__ void gemm_phase(LAS unsigned char* lds, const Sched& S, const Epi& E, int wid) {
    const int lane = lane_id(), tid = wid * 64 + lane, wr = wid >> 2, wc = wid & 3, fr = lane & 15, fq = lane >> 4;
    const unsigned ldsw = (unsigned)wid * 1024u;
    const int aoff = pg8::lds_byte(wr * 64 + fr, fq * 8);
    const int n4 = tid & 31, kr = tid >> 5;
    const int tq = (lane & 15) >> 2, tp = lane & 3, tf = tq | ((fq & 1) << 2);
    const int ldsa = (int)(unsigned)(uintptr_t)lds;
    const int tb0 = B_OFF + (8 * fq + tq) * 256 + (((2 * wc) ^ tf) * 32) + 8 * tp, tb1 = B_OFF + (8 * fq + tq) * 256 + (((2 * wc + 1) ^ tf) * 32) + 8 * tp;
    const int wfk = (kr & 3) | (((kr >> 3) & 1) << 2);
#define MG_STAGE_A(slot, tt) do { _Pragma("unroll") for (int h_ = 0; h_ < 2; ++h_) _Pragma("unroll") for (int i_ = 0; i_ < 2; ++i_) \
        __builtin_amdgcn_global_load_lds((const unsigned*)(u.A + (size_t)(tt) * 128 + voffA[h_][i_]), (LAS unsigned*)(lds + (slot) * ABUF + h_ * HTB + ldsw + i_ * 8192), 16, 0, 0); } while (0)
#define MG_LOADB(R, tt) do { const float* p_ = bp + (size_t)(tt) * 64 * u.ldbf; \
        asm volatile("global_load_dwordx4 %0, %1, off" : "=v"(R##0) : "v"(p_) : "memory"); \
        asm volatile("global_load_dwordx4 %0, %1, off" : "=v"(R##1) : "v"(p_ + (size_t)16 * u.ldbf) : "memory"); \
        asm volatile("global_load_dwordx4 %0, %1, off" : "=v"(R##2) : "v"(p_ + (size_t)32 * u.ldbf) : "memory"); \
        asm volatile("global_load_dwordx4 %0, %1, off" : "=v"(R##3) : "v"(p_ + (size_t)48 * u.ldbf) : "memory"); } while (0)
#define MG_WAITB(R, N) asm volatile("s_waitcnt vmcnt(" #N ")" : "+v"(R##0), "+v"(R##1), "+v"(R##2), "+v"(R##3) :: "memory")
#define MG_PK(v) (u32x2){cvtpk((v).x, (v).y), cvtpk((v).z, (v).w)}
#define MG_WRITEB(R, slot) do { LAS unsigned char* w_ = lds + B_OFF + (slot) * BBUF + wa; \
        *(LAS u32x2*)(w_) = MG_PK(R##0); *(LAS u32x2*)(w_ + 4096) = MG_PK(R##1); *(LAS u32x2*)(w_ + 8192) = MG_PK(R##2); *(LAS u32x2*)(w_ + 12288) = MG_PK(R##3); } while (0)
#define MG_BAR() do { asm volatile("" ::: "memory"); __builtin_amdgcn_s_barrier(); asm volatile("" ::: "memory"); } while (0)
#define MG_LGK0() do { asm volatile("s_waitcnt lgkmcnt(0)" ::: "memory"); __builtin_amdgcn_sched_barrier(0); } while (0)
#define MG_READF(P, tt, hh) do { const int as_ = ((tt) & 3) * ABUF + (hh) * 1024, bo_ = ldsa + ((tt) & 1) * BBUF + (hh) * 8192; \
        P##l0 = vtr<0>(bo_ + tb0); P##h0 = vtr<1024>(bo_ + tb0); P##l1 = vtr<0>(bo_ + tb1); P##h1 = vtr<1024>(bo_ + tb1); \
        _Pragma("unroll") for (int m = 0; m < 4; ++m) { P##a0[m] = *(const LAS bf16x8*)(lds + as_ + aoff + m * 2048); P##a1[m] = *(const LAS bf16x8*)(lds + as_ + HTB + aoff + m * 2048); } } while (0)
#define MG_MFMA(P) do { const bf16x8 b0_ = (bf16x8){P##l0[0], P##l0[1], P##l0[2], P##l0[3], P##h0[0], P##h0[1], P##h0[2], P##h0[3]}, b1_ = (bf16x8){P##l1[0], P##l1[1], P##l1[2], P##l1[3], P##h1[0], P##h1[1], P##h1[2], P##h1[3]}; \
        __builtin_amdgcn_s_setprio(1); \
        _Pragma("unroll") for (int m = 0; m < 4; ++m) { acc[0][m][0] = __builtin_amdgcn_mfma_f32_16x16x32_bf16(b0_, P##a0[m], acc[0][m][0], 0, 0, 0); acc[0][m][1] = __builtin_amdgcn_mfma_f32_16x16x32_bf16(b1_, P##a0[m], acc[0][m][1], 0, 0, 0); } \
        _Pragma("unroll") for (int m = 0; m < 4; ++m) { acc[1][m][0] = __builtin_amdgcn_mfma_f32_16x16x32_bf16(b0_, P##a1[m], acc[1][m][0], 0, 0, 0); acc[1][m][1] = __builtin_amdgcn_mfma_f32_16x16x32_bf16(b1_, P##a1[m], acc[1][m][1], 0, 0, 0); } \
        __builtin_amdgcn_s_setprio(0); } while (0)
#define MG_TILE(t, R, WB, LB, SA, NX) do { const int t_ = (t); \
        MG_READF(G, t_, 1); __builtin_amdgcn_sched_barrier(0); \
        MG_MFMA(F); __builtin_amdgcn_sched_barrier(0); \
        if (WB >= 0) { if (WB == 12) MG_WAITB(R, 12); else if (WB == 8) MG_WAITB(R, 8); else MG_WAITB(R, 0); \
            MG_WRITEB(R, (t_ + 1) & 1); if (LB) MG_LOADB(R, t_ + 3); } \
        MG_LGK0(); \
        MG_BAR(); \
        if (NX) MG_READF(F, t_ + 1, 0); \
        if (SA) MG_STAGE_A((t_ + 4) & 3, t_ + 4); \
        __builtin_amdgcn_sched_barrier(0); \
        MG_MFMA(G); \
        MG_LGK0(); } while (0)

    Unit u;
    for (int ui = 0; S.next(ui, u); ++ui) {
        const int nt = u.nt;
        unsigned voffA[2][2];
#pragma unroll
        for (int i = 0; i < 2; ++i) { int R, C; pg8::stage_rc(tid * 16 + i * 8192, R, C);
#pragma unroll
            for (int h = 0; h < 2; ++h) { int ra = h * 128 + R; if (u.gidx) ra = (ra < u.gcnt) ? u.gidx[ra] : 0; voffA[h][i] = (unsigned)ra * u.lda + (unsigned)C * 2u; } }
        const float* bp = (n4 < 16 ? u.B0 + 4 * n4 : u.B1 + 4 * (n4 - 16)) + (size_t)kr * u.ldbf;
        const int P = u.up ? (32 * ((n4 & 15) >> 2) + 16 * (n4 >> 4) + 4 * (n4 & 3)) : (32 * (n4 >> 3) + 16 * (n4 & 1) + 4 * ((n4 & 7) >> 1));
        const int wa = kr * 256 + (((P >> 4) ^ wfk) * 32) + (P & 15) * 2;
        f32x4 acc[2][4][2];
#pragma unroll
        for (int a = 0; a < 2; ++a)
#pragma unroll
            for (int m = 0; m < 4; ++m)
#pragma unroll
                for (int n = 0; n < 2; ++n) acc[a][m][n] = (f32x4){0.f, 0.f, 0.f, 0.f};
        f32x4 Ra0 = {}, Ra1 = {}, Ra2 = {}, Ra3 = {}, Rb0 = {}, Rb1 = {}, Rb2 = {}, Rb3 = {};
        s16x4 Fl0, Fh0, Fl1, Fh1, Gl0, Gh0, Gl1, Gh1; bf16x8 Fa0[4], Fa1[4], Ga0[4], Ga1[4];
        MG_STAGE_A(0, 0); MG_STAGE_A(1, 1);
        MG_LOADB(Ra, 0); MG_LOADB(Rb, 1);
        MG_STAGE_A(2, 2);
        MG_WAITB(Ra, 8); MG_WRITEB(Ra, 0);
        MG_LOADB(Ra, 2); MG_STAGE_A(3, 3);
        MG_LGK0();
        MG_BAR();
        MG_READF(F, 0, 0);
        MG_LGK0();
        for (int t = 0; t < nt - 4; t += 2) {
            MG_TILE(t, Rb, 12, true, true, true);
            MG_TILE(t + 1, Ra, 12, true, true, true);
        }
        MG_TILE(nt - 4, Rb, 12, true, false, true);
        MG_TILE(nt - 3, Ra, 8, false, false, true);
        MG_TILE(nt - 2, Rb, 0, false, false, true);
        MG_TILE(nt - 1, Ra, -1, false, false, false);
        E(acc, u, wid);
    }
#undef MG_LGK0
#undef MG_READF
#undef MG_MFMA
#undef MG_TILE
#undef MG_STAGE_A
#undef MG_LOADB
#undef MG_PK
#undef MG_WAITB
#undef MG_WRITEB
#undef MG_WAITV
#undef MG_BAR
#undef MG_ITER
}
}

struct MoeSched2 {
    int G, vcu, down, var; unsigned cnt_l, tpe_l; const char* ws; const float *wgate, *wup, *wdown;
    __device__ __forceinline__ void init(const unsigned* cnt, int lane) {
        unsigned c = 0; if (lane < NEXP) c = __hip_atomic_load(cnt + lane, __ATOMIC_RELAXED, __HIP_MEMORY_SCOPE_AGENT);
        unsigned t = (c + 255u) >> 8, inc = t;
#pragma unroll
        for (int o = 1; o < 32; o <<= 1) { const unsigned v = __shfl_up(inc, o); if ((lane & 31) >= o) inc += v; }
        cnt_l = c; tpe_l = inc - t;
    }
    __device__ __forceinline__ bool next(int i, mg::Unit& u) const {
        const int lane = lane_id();
        const int total = (int)__builtin_amdgcn_readfirstlane(__shfl(tpe_l + ((cnt_l + 255u) >> 8), 31));
        const int L = i * G + vcu; if (L >= total * 16) return false;
        const int tg = L >> 4;
        const unsigned long long mk = __ballot(lane < NEXP && (int)tpe_l <= tg && (cnt_l > 0u));
        const int e = 63 - __builtin_clzll(mk);
        const int tp = (int)__builtin_amdgcn_readfirstlane(__shfl(tpe_l, e)), ce = (int)__builtin_amdgcn_readfirstlane(__shfl(cnt_l, e));
        const int te = (ce + 255) >> 8, q = L - 16 * tp, j = q / te, mt = q - j * te;
        u.pm = tp + mt; u.pn = j; u.up = down ? 0 : 1; u.nt = down ? 16 : 32;
        if (!down) { u.A = ws + WS_H1B; u.lda = DM * 2; u.gidx = (const int*)(ws + WS_TOKIDX) + (size_t)e * ECAP + 256 * mt; u.gcnt = ce - 256 * mt;
            u.B0 = wgate + (size_t)e * DM * FF + j * 64; u.B1 = wup + (size_t)e * DM * FF + j * 64; u.ldbf = FF;
            if (var == 61) { u.B0 = wgate; u.B1 = wup; }
            if (var == 65) { u.gidx = nullptr; u.A = ws + WS_H1B + (size_t)((tp + mt) & 31) * 256 * (DM * 2); } }
        else { u.A = ws + WS_ACT + (size_t)(tp + mt) * 256 * (FF * 2); u.lda = FF * 2; u.gidx = nullptr; u.gcnt = 0;
            u.B0 = wdown + (size_t)e * FF * DM + j * 128; u.B1 = u.B0 + 64; u.ldbf = DM; }
        return true;
    }
};
struct EpiMoe2 {
    int down; unsigned char* ws;
    __device__ __forceinline__ void operator()(f32x4 (&acc)[2][4][2], const mg::Unit& u, int wid) const {
        const int lane = lane_id(), wr = wid >> 2, wc = wid & 3, fr = lane & 15, fq = lane >> 4;
        bf16_t* act = (bf16_t*)(ws + WS_ACT); bf16_t* y = (bf16_t*)(ws + WS_Y);
#pragma unroll
        for (int ai = 0; ai < 2; ++ai)
#pragma unroll
            for (int m = 0; m < 4; ++m) { const size_t row = (size_t)u.pm * 256 + ai * 128 + wr * 64 + m * 16 + fr;
                if (!down) { f32x4 v;
#pragma unroll
                    for (int q = 0; q < 4; ++q) { const float g = acc[ai][m][0][q], up = acc[ai][m][1][q]; v[q] = g * __builtin_amdgcn_rcpf(1.0f + __expf(-g)) * up; }
                    u32x2 w; w.x = cvtpk(v.x, v.y); w.y = cvtpk(v.z, v.w);
                    *(u32x2*)(act + row * FF + u.pn * 64 + wc * 16 + 4 * fq) = w;
                } else { const f32x4 a0 = acc[ai][m][0], a1 = acc[ai][m][1];
                    u32x4 w; w.x = cvtpk(a0.x, a0.y); w.y = cvtpk(a0.z, a0.w); w.z = cvtpk(a1.x, a1.y); w.w = cvtpk(a1.z, a1.w);
                    *(u32x4*)(y + row * DM + u.pn * 128 + wc * 32 + 8 * fq) = w; } }
    }
};

namespace att {
constexpr int D = 128, NW = 8, QBLK = 32, KVBLK = 64;
constexpr float SCALE = SM_SCALE, THR = 8.f;
constexpr int SHM_V = KVBLK * D * 2, SHM_K = KVBLK * D * 2, SHM_ATTN = 2 * SHM_V + 2 * SHM_K + NW * 64 * 4;
#define KSWZ(row, colB) ((row) * 256 + ((colB) ^ (((row) & 7) << 4)))
#define SBAR() __builtin_amdgcn_sched_barrier(0)
__device__ __forceinline__ int crow(int r, int hi) { return (r & 3) + 8 * (r >> 2) + 4 * hi; }
template <bool BAND> __device__ __forceinline__ void partialSM(f32x16& p0, f32x16& p1, float& m_reg, float& mn, float& alpha, int dv, bool tv) {
    constexpr float C = SCALE * 1.4426950408889634f;
    if constexpr (BAND) {
#pragma unroll
        for (int r = 0; r < 16; ++r) { const int kx = (r & 3) + 8 * (r >> 2);
            if (!tv || (unsigned)(dv + kx) > 128u) p0[r] = -INFINITY;
            if (!tv || (unsigned)(dv + kx + 32) > 128u) p1[r] = -INFINITY; } }
    float pmax = p0[0];
#pragma unroll
    for (int r = 1; r < 16; ++r) pmax = fmaxf(pmax, p0[r]);
#pragma unroll
    for (int r = 0; r < 16; ++r) pmax = fmaxf(pmax, p1[r]);
    { auto rr = __builtin_amdgcn_permlane32_swap(__float_as_uint(pmax), __float_as_uint(pmax), false, false);
      pmax = fmaxf(__uint_as_float(rr[0]), __uint_as_float(rr[1])); }
    if (__builtin_expect(__all(pmax - m_reg <= THR / SCALE), 1)) { mn = m_reg; alpha = 1.f; }
    else { mn = fmaxf(m_reg, pmax); alpha = __builtin_amdgcn_exp2f((m_reg - mn) * C); m_reg = mn; }
    const float mnC = -mn * C;
#pragma unroll
    for (int r = 0; r < 16; ++r) p0[r] = fmaf(p0[r], C, mnC);
#pragma unroll
    for (int r = 0; r < 16; ++r) p1[r] = fmaf(p1[r], C, mnC);
#pragma unroll
    for (int r = 0; r < 16; ++r) p0[r] = __builtin_amdgcn_exp2f(p0[r]);
}
__device__ __forceinline__ void finishSM(f32x16& p0, f32x16& p1, float alpha, float& l_reg, bf16x8& pa0, bf16x8& pa1, bf16x8& pa2, bf16x8& pa3) {
#pragma unroll
    for (int r = 0; r < 16; ++r) p1[r] = __builtin_amdgcn_exp2f(p1[r]);
    float ps = 0;
#pragma unroll
    for (int r = 0; r < 16; ++r) ps += p0[r];
#pragma unroll
    for (int r = 0; r < 16; ++r) ps += p1[r];
    { auto rr = __builtin_amdgcn_permlane32_swap(__float_as_uint(ps), __float_as_uint(ps), false, false);
      ps = __uint_as_float(rr[0]) + __uint_as_float(rr[1]); }
    l_reg = l_reg * alpha + ps;
#define PK4(P, BASE, OUT) do { unsigned a0 = cvtpk(P[BASE + 0], P[BASE + 1]), a1 = cvtpk(P[BASE + 2], P[BASE + 3]);   \
    unsigned b0 = cvtpk(P[BASE + 4], P[BASE + 5]), b1 = cvtpk(P[BASE + 6], P[BASE + 7]);                              \
    auto r0 = __builtin_amdgcn_permlane32_swap(a0, b0, false, false); auto r1 = __builtin_amdgcn_permlane32_swap(a1, b1, false, false); \
    u32x4 w = {r0[0], r1[0], r0[1], r1[1]}; OUT = *reinterpret_cast<bf16x8*>(&w); } while (0)
    PK4(p0, 0, pa0); PK4(p0, 8, pa1); PK4(p1, 0, pa2); PK4(p1, 8, pa3);
#undef PK4
}
__device__ __forceinline__ void qkt(f32x16& p0, f32x16& p1, const LAS unsigned char* Ks, const bf16x8* qr, int r32, int hi) {
    p0 = f32x16{}; p1 = f32x16{};
#pragma unroll
    for (int d0 = 0; d0 < 8; ++d0) { const int cb = (d0 * 16 + hi * 8) * 2;
        const bf16x8 b0 = *(const LAS bf16x8*)(Ks + KSWZ(r32, cb));
        const bf16x8 b1 = *(const LAS bf16x8*)(Ks + KSWZ(32 + r32, cb));
        p0 = __builtin_amdgcn_mfma_f32_32x32x16_bf16(b0, qr[d0], p0, 0, 0, 0);
        p1 = __builtin_amdgcn_mfma_f32_32x32x16_bf16(b1, qr[d0], p1, 0, 0, 0); }
}
__device__ __forceinline__ int v_st(int k, int c) { const int kk = (k & ~0xC) | ((k & 4) << 1) | ((k & 8) >> 1); return ((kk >> 3) * 4 + (c >> 5)) * 512 + ((kk & 7) * 32 + (c & 31)) * 2; }
__device__ __forceinline__ int v_rd_base(int lane) { return ((lane & 3) << 3) | (((lane >> 2) & 3) << 6) | (((lane >> 4) & 1) << 5) | (((lane >> 5) & 1) << 8); }
constexpr int v_rd_off(int d0, int ks, int half) { return d0 * 512 + ks * 4096 + half * 2048; }
template <int OFF> __device__ __forceinline__ s16x4 tr_read(int vb) { s16x4 r; asm volatile("ds_read_b64_tr_b16 %0, %1 offset:%2" : "=&v"(r) : "v"(vb), "i"(OFF) : "memory"); return r; }
template <int D0> __device__ __forceinline__ void pv_one(f32x16& od, int vb, bf16x8 pa0, bf16x8 pa1, bf16x8 pa2, bf16x8 pa3) {
    const s16x4 l0 = tr_read<v_rd_off(D0, 0, 0)>(vb), h0 = tr_read<v_rd_off(D0, 0, 1)>(vb), l1 = tr_read<v_rd_off(D0, 1, 0)>(vb), h1 = tr_read<v_rd_off(D0, 1, 1)>(vb);
    const s16x4 l2 = tr_read<v_rd_off(D0, 2, 0)>(vb), h2 = tr_read<v_rd_off(D0, 2, 1)>(vb), l3 = tr_read<v_rd_off(D0, 3, 0)>(vb), h3 = tr_read<v_rd_off(D0, 3, 1)>(vb);
    asm volatile("s_waitcnt lgkmcnt(0)" ::: "memory"); SBAR();
#define PK(L, H) (bf16x8){L[0], L[1], L[2], L[3], H[0], H[1], H[2], H[3]}
    od = __builtin_amdgcn_mfma_f32_32x32x16_bf16(pa0, PK(l0, h0), od, 0, 0, 0);
    od = __builtin_amdgcn_mfma_f32_32x32x16_bf16(pa1, PK(l1, h1), od, 0, 0, 0);
    od = __builtin_amdgcn_mfma_f32_32x32x16_bf16(pa2, PK(l2, h2), od, 0, 0, 0);
    od = __builtin_amdgcn_mfma_f32_32x32x16_bf16(pa3, PK(l3, h3), od, 0, 0, 0);
#undef PK
}
__device__ __forceinline__ void pv_d0(f32x16* o, int vb, bf16x8 pa0, bf16x8 pa1, bf16x8 pa2, bf16x8 pa3) {
    pv_one<0>(o[0], vb, pa0, pa1, pa2, pa3); pv_one<1>(o[1], vb, pa0, pa1, pa2, pa3); pv_one<2>(o[2], vb, pa0, pa1, pa2, pa3); pv_one<3>(o[3], vb, pa0, pa1, pa2, pa3);
}
struct Unit { const bf16_t *Q, *K, *V; bf16_t* O; float* lse; int ldo, lse_stride, nt, kt0, klo, khi, q0; };
struct Conv { const float *wg, *wu, *wd; unsigned char* ws; int bx; };
template <bool CONV> __device__ __forceinline__ void body_cv(const Unit& u, LAS unsigned char* lds, int wid, const Conv& cv, int cbase);
constexpr int CV_ITEMS = 2 * 65536, CV_OFF = 100 * 1024, CV_WAVE = 2560;
struct CvPiece { const float* src; bf16_t* dst; int N, K, rowblk, roff, n0, k0; };
__device__ __forceinline__ bool cv_decode(const Conv& cv, int id, CvPiece& p) {
    if (id >= CV_ITEMS) return false;
    const int mat = id >> 16, r = id & 65535, e = r >> 11, q = r & 2047;
    if (mat < 2) { p.K = DM; p.N = FF; p.k0 = (q >> 6) * 64; p.n0 = (q & 63) * 16; p.src = (mat ? cv.wu : cv.wg) + (size_t)e * DM * FF; p.dst = (bf16_t*)(cv.ws + WS_WGUT) + (size_t)e * 2048 * DM; p.rowblk = 256; p.roff = mat * 128; }
    else { p.K = FF; p.N = DM; p.k0 = (q >> 7) * 64; p.n0 = (q & 127) * 16; p.src = cv.wd + (size_t)e * FF * DM; p.dst = (bf16_t*)(cv.ws + WS_WDT) + (size_t)e * DM * FF; p.rowblk = 128; p.roff = 0; }
    return true;
}
__device__ __forceinline__ void body(const Unit& u, LAS unsigned char* lds, int wid) { body_cv<false>(u, lds, wid, Conv{}, 0); }
template <bool CONV>
__device__ __forceinline__ void body_cv(const Unit& u, LAS unsigned char* lds, int wid, const Conv& cv, int cbase) {
    const int lane = lane_id(), tid = wid * 64 + lane,
        r32 = lane & 31, hi = lane >> 5;
    LAS unsigned char* V_lds = lds; LAS unsigned char* K_lds = lds + 3 * SHM_V;
    LAS float* ws = (LAS float*)(lds + 3 * SHM_V + 3 * SHM_K) + wid * 64; LAS float* li_l = ws; LAS float* al_l = ws + 32;
    float m_reg = -1e30f, l_reg = 0; f32x16 o[4] = {}; bf16x8 qr[8];
    const bf16_t* Qw = u.Q + (size_t)(wid * QBLK + r32) * D + hi * 8;
#pragma unroll
    for (int d0 = 0; d0 < 8; ++d0) qr[d0] = *(const bf16x8*)(Qw + d0 * 16);
    const int sr = tid >> 4, sc = (tid & 15) * 8, vst0 = v_st(sr, sc), vst1 = v_st(32 + sr, sc);
    const int vb0 = (int)(unsigned)(uintptr_t)V_lds + v_rd_base(lane);
    const bf16_t* Kh = u.K; const bf16_t* Vh = u.V;
    constexpr bool BAND = false; constexpr int SD = 1; const int dq = 0;
#define TVALID(j) true
    struct { bf16x8 vs0, vs1, ks0, ks1; } sr_[SD];
#define KROW(j) (BAND ? ((u.kt0 + 64 * (j)) < u.klo ? u.klo : ((u.kt0 + 64 * (j)) > u.khi - 64 ? u.khi - 64 : (u.kt0 + 64 * (j)))) : (u.kt0 + 64 * (j)))
#define SLOAD(i, j) do { const int k0_ = KROW(j); sr_[i].vs0 = *(const bf16x8*)(&Vh[(size_t)(k0_ + sr) * D + sc]); sr_[i].vs1 = *(const bf16x8*)(&Vh[(size_t)(k0_ + 32 + sr) * D + sc]); \
    sr_[i].ks0 = *(const bf16x8*)(&Kh[(size_t)(k0_ + sr) * D + sc]); sr_[i].ks1 = *(const bf16x8*)(&Kh[(size_t)(k0_ + 32 + sr) * D + sc]); } while (0)
#define SWRITE(b, i) do { *(LAS bf16x8*)(V_lds + (b) * SHM_V + vst0) = sr_[i].vs0; *(LAS bf16x8*)(V_lds + (b) * SHM_V + vst1) = sr_[i].vs1; const int kc = sc * 2; \
    *(LAS bf16x8*)(K_lds + (b) * SHM_K + KSWZ(sr, kc)) = sr_[i].ks0; *(LAS bf16x8*)(K_lds + (b) * SHM_K + KSWZ(32 + sr, kc)) = sr_[i].ks1; } while (0)
#define SWRITE_AT(ob, i) do { *(LAS bf16x8*)(V_lds + (ob) + vst0) = sr_[i].vs0; *(LAS bf16x8*)(V_lds + (ob) + vst1) = sr_[i].vs1; const int kc = sc * 2; \
    *(LAS bf16x8*)(K_lds + (ob) + KSWZ(sr, kc)) = sr_[i].ks0; *(LAS bf16x8*)(K_lds + (ob) + KSWZ(32 + sr, kc)) = sr_[i].ks1; } while (0)
#define SWAIT() do { if constexpr (CONV) {   } else if constexpr (SD == 2) asm volatile("s_waitcnt vmcnt(4)" ::: "memory"); else asm volatile("s_waitcnt vmcnt(0)" ::: "memory"); } while (0)
#define RESC(a) do { if (__any((a) < 1.f)) { if (hi == 0) al_l[r32] = (a); asm volatile("s_waitcnt lgkmcnt(0)" ::: "memory"); \
    _Pragma("unroll") for (int d = 0; d < 4; ++d) _Pragma("unroll") for (int r = 0; r < 16; ++r) o[d][r] *= al_l[crow(r, hi)]; } } while (0)
    f32x4 cvr[4]; int cvp = -1;
    int cvq = -1;
#define CV_OUT() do { if constexpr (CONV) { if (cvq >= 0) { const int e_ = (cvq >> 11) & 31, mat_ = cvq >> 16, k0_ = ((cvq >> 6) & 31) * 64, n_ = lane & 15, kc_ = lane >> 4, nn_ = (cvq & 63) * 16 + n_; \
        const LAS unsigned* t_ = (const LAS unsigned*)(lds + CV_OFF + wid * (2 * CV_WAVE) + ((cvq >> 11) & 1) * CV_WAVE); \
        bf16_t* d_ = (bf16_t*)(cv.ws + WS_WGUT) + ((size_t)e_ * 2048 + (nn_ >> 7) * 256 + mat_ * 128 + (nn_ & 127)) * DM + k0_ + 8 * kc_; \
        _Pragma("unroll") for (int h_ = 0; h_ < 2; ++h_) { const LAS unsigned* r_ = t_ + (16 * h_ + 4 * kc_) * 20 + n_; \
            u32x4 o_; o_.x = r_[0]; o_.y = r_[20]; o_.z = r_[40]; o_.w = r_[60]; *(u32x4*)(d_ + 32 * h_) = o_; } } cvq = -1; } } while (0)
#define CV_PACK() do { if constexpr (CONV) { if (cvp >= 0) { LAS unsigned* t_ = (LAS unsigned*)(lds + CV_OFF + wid * (2 * CV_WAVE) + ((cvp >> 11) & 1) * CV_WAVE); \
        _Pragma("unroll") for (int hh_ = 0; hh_ < 2; ++hh_) { const f32x4 ra_ = cvr[2 * hh_], rb_ = cvr[2 * hh_ + 1]; u32x4 w_; w_.x = cvt2(ra_.x, rb_.x); w_.y = cvt2(ra_.y, rb_.y); w_.z = cvt2(ra_.z, rb_.z); w_.w = cvt2(ra_.w, rb_.w); \
            *(LAS u32x4*)(t_ + ((lane >> 2) + 16 * hh_) * 20 + (lane & 3) * 4) = w_; } \
        cvq = cvp; cvp = -1; } } } while (0)
#define CV_FIN() do { CV_OUT(); CV_PACK(); } while (0)
#define CV_STEP(c) do { if constexpr (CONV) { CV_OUT(); CV_PACK(); const int id_ = ((c) * 256 + cv.bx) * 8 + wid; if (id_ < CV_ITEMS) { const int e_ = (id_ >> 11) & 31, k0_ = ((id_ >> 6) & 31) * 64, n0_ = (id_ & 63) * 16; \
        const float* s_ = ((id_ >> 16) ? cv.wu : cv.wg) + (size_t)e_ * DM * FF + (size_t)(k0_ + 2 * (lane >> 2)) * FF + n0_ + (lane & 3) * 4; \
        cvr[0] = *(const f32x4*)(s_); cvr[1] = *(const f32x4*)(s_ + FF); cvr[2] = *(const f32x4*)(s_ + 32 * FF); cvr[3] = *(const f32x4*)(s_ + 33 * FF); cvp = id_; } } } while (0)
    f32x16 pA0, pA1, pB0, pB1; float mnA, mnB, alA, alB; bf16x8 pa0, pa1, pa2, pa3; const int NT = u.nt;
    constexpr int SE = 0, SO = SD - 1;
    SLOAD(SE, 0); asm volatile("s_waitcnt vmcnt(0)" ::: "memory"); SWRITE(0, SE); __syncthreads();
    qkt(pA0, pA1, K_lds, qr, r32, hi); partialSM<BAND>(pA0, pA1, m_reg, mnA, alA, dq, TVALID(0));
    SLOAD(SO, 1); if constexpr (SD == 2) { if (2 < NT) SLOAD(SE, 2); }
    SWAIT(); SWRITE(1, SO); __syncthreads();
    int ob0 = 0, ob1 = SHM_V, ob2 = 2 * SHM_V;
    for (int j = 1; j + 1 < NT; j += 2) {
        SBAR(); qkt(pB0, pB1, K_lds + ob1, qr, r32, hi);
        finishSM(pA0, pA1, alA, l_reg, pa0, pa1, pa2, pa3); SBAR();
        SLOAD(SO, j + SD); CV_STEP(cbase + j - 1); SBAR();
        pv_d0(o, vb0 + ob0, pa0, pa1, pa2, pa3); partialSM<BAND>(pB0, pB1, m_reg, mnB, alB, dq + 64 * j, TVALID(j));
        SWAIT(); SWRITE_AT(ob2, SE);
        RESC(alB); __syncthreads();
        SBAR(); qkt(pA0, pA1, K_lds + ob2, qr, r32, hi);
        finishSM(pB0, pB1, alB, l_reg, pa0, pa1, pa2, pa3); SBAR();
        if (SD == 1 || j + 3 < NT) SLOAD(SE, j + 1 + SD); CV_STEP(cbase + j); SBAR();
        pv_d0(o, vb0 + ob1, pa0, pa1, pa2, pa3); partialSM<BAND>(pA0, pA1, m_reg, mnA, alA, dq + 64 * (j + 1), TVALID(j + 1));
        SWAIT(); SWRITE_AT(ob0, SO);
        RESC(alA); __syncthreads();
        { const int t_ = ob0; ob0 = ob2; ob2 = ob1; ob1 = t_; }
    }
    SBAR(); qkt(pB0, pB1, K_lds + ob1, qr, r32, hi);
    finishSM(pA0, pA1, alA, l_reg, pa0, pa1, pa2, pa3); SBAR();
    pv_d0(o, vb0 + ob0, pa0, pa1, pa2, pa3); partialSM<BAND>(pB0, pB1, m_reg, mnB, alB, dq + 64 * (NT - 1), TVALID(NT - 1));
    RESC(alB);
    finishSM(pB0, pB1, alB, l_reg, pa0, pa1, pa2, pa3); SBAR();
    pv_d0(o, vb0 + ob1, pa0, pa1, pa2, pa3);
    CV_FIN(); CV_FIN();
    __syncthreads();
    if (hi == 0) li_l[r32] = l_reg; asm volatile("s_waitcnt lgkmcnt(0)" ::: "memory");
    float rli[16];
#pragma unroll
    for (int r = 0; r < 16; ++r) rli[r] = __builtin_amdgcn_rcpf(li_l[crow(r, hi)]);
    {
        LAS unsigned char* ot = lds + wid * 8192;
#pragma unroll
        for (int r = 0; r < 16; ++r) { const int orow = crow(r, hi);
#pragma unroll
            for (int d0 = 0; d0 < 4; ++d0) *(LAS bf16_t*)(ot + orow * 256 + (d0 * 32 + r32) * 2) = f2bf(o[d0][r] * rli[r]); }
        asm volatile("s_waitcnt lgkmcnt(0)" ::: "memory");
        bf16_t* Ow = u.O + (size_t)(wid * QBLK) * u.ldo;
#pragma unroll
        for (int q = 0; q < 8; ++q) { const int orow = q * 4 + (lane >> 4), oc = (lane & 15) * 8;
            *(u32x4*)(Ow + (size_t)orow * u.ldo + oc) = *(const LAS u32x4*)(ot + orow * 256 + oc * 2); }
    }
    if (u.lse && hi == 0) u.lse[(size_t)(wid * QBLK + r32) * u.lse_stride] = m_reg * SCALE + __logf(l_reg);
    __syncthreads();
#undef KROW
#undef TVALID
#undef SLOAD
#undef SWRITE
#undef SWRITE_AT
#undef SWAIT
#undef RESC
#undef CV_FIN
#undef CV_STEP
#undef CV_OUT
#undef CV_PACK
}

template <bool CONV>
__device__ __forceinline__ void body_cd(const Unit& u, LAS unsigned char* lds, int wid, const Conv& cv, int cbase) {
    const int lane = lane_id(), r32 = lane & 31, hi = lane >> 5;
    LAS unsigned char* V_lds = lds; LAS unsigned char* K_lds = lds + 3 * SHM_V;
    LAS float* ws = (LAS float*)(lds + 3 * SHM_V + 3 * SHM_K) + wid * 64; LAS float* li_l = ws; LAS float* al_l = ws + 32;
    float m_reg = -1e30f, l_reg = 0; f32x16 o[4] = {}; bf16x8 qr[8];
    const bf16_t* Qw = u.Q + (size_t)(wid * QBLK + r32) * D + hi * 8;
#pragma unroll
    for (int d0 = 0; d0 < 8; ++d0) qr[d0] = *(const bf16x8*)(Qw + d0 * 16);
    const int vb0 = (int)(unsigned)(uintptr_t)V_lds + v_rd_base(lane);
    unsigned koff0, voff0;
    { const int m = 2 * wid;
        { const int r = 4 * m + (lane >> 4), p = lane & 15; koff0 = (unsigned)(r * 256 + ((p ^ (r & 7)) * 16)); }
        { const int S = 2 * m + (lane >> 5), kk = (S >> 2) * 8 + ((lane >> 2) & 7), k = (kk & ~0xC) | ((kk & 4) << 1) | ((kk & 8) >> 1), c = (S & 3) * 32 + (lane & 3) * 8; voff0 = (unsigned)(k * 256 + c * 2); } }
    constexpr bool BAND = false; const int dq = 0;
#define TVALID(j) true
#define KV_DMA(ob, tile) do { const char* kb_ = (const char*)u.K + (size_t)(u.kt0 + 64 * (tile)) * (D * 2); const char* vb_ = (const char*)u.V + (size_t)(u.kt0 + 64 * (tile)) * (D * 2); \
        __builtin_amdgcn_global_load_lds((const unsigned*)(kb_ + koff0), (LAS unsigned*)(K_lds + (ob) + (2 * wid) * 1024), 16, 0, 0); \
        __builtin_amdgcn_global_load_lds((const unsigned*)(vb_ + voff0), (LAS unsigned*)(V_lds + (ob) + (2 * wid) * 1024), 16, 0, 0); \
        __builtin_amdgcn_global_load_lds((const unsigned*)(kb_ + ((koff0 + 1024u) ^ 64u)), (LAS unsigned*)(K_lds + (ob) + (2 * wid + 1) * 1024), 16, 0, 0); \
        __builtin_amdgcn_global_load_lds((const unsigned*)(vb_ + (voff0 + 128u)), (LAS unsigned*)(V_lds + (ob) + (2 * wid + 1) * 1024), 16, 0, 0); } while (0)
#define BARX() do { asm volatile("s_waitcnt lgkmcnt(0)" ::: "memory"); __builtin_amdgcn_s_barrier(); asm volatile("" ::: "memory"); } while (0)
#define WAITKV(nv) do { if ((nv) == 6) asm volatile("s_waitcnt vmcnt(6)" ::: "memory"); else if ((nv) == 4) asm volatile("s_waitcnt vmcnt(4)" ::: "memory"); \
        else if ((nv) == 2) asm volatile("s_waitcnt vmcnt(2)" ::: "memory"); else asm volatile("s_waitcnt vmcnt(0)" ::: "memory"); } while (0)
#define RESC(a) do { if (__any((a) < 1.f)) { if (hi == 0) al_l[r32] = (a); asm volatile("s_waitcnt lgkmcnt(0)" ::: "memory"); \
    _Pragma("unroll") for (int d = 0; d < 4; ++d) _Pragma("unroll") for (int r = 0; r < 16; ++r) o[d][r] *= al_l[crow(r, hi)]; } } while (0)
    f32x4 cvrA[4] = {}, cvrB[4] = {}; int cvpA = -1, cvpB = -1, cvq = -1;
#define CV_OUT() do { if constexpr (CONV) { const int q_ = cvq < 0 ? 0 : cvq, e_ = (q_ >> 11) & 31, mat_ = q_ >> 16, k0_ = ((q_ >> 6) & 31) * 64, n_ = lane & 15, kc_ = lane >> 4, nn_ = (q_ & 63) * 16 + n_; \
        const LAS unsigned* t_ = (const LAS unsigned*)(lds + CV_OFF + wid * (2 * CV_WAVE)); \
        bf16_t* d_ = (bf16_t*)(cv.ws + (cvq < 0 ? WS_WDT : WS_WGUT)) + ((size_t)e_ * 2048 + (nn_ >> 7) * 256 + mat_ * 128 + (nn_ & 127)) * DM + k0_ + 8 * kc_; \
        _Pragma("unroll") for (int h_ = 0; h_ < 2; ++h_) { const LAS unsigned* r_ = t_ + (16 * h_ + 4 * kc_) * 20 + n_; \
            u32x4 o_; o_.x = r_[0]; o_.y = r_[20]; o_.z = r_[40]; o_.w = r_[60]; *(u32x4*)(d_ + 32 * h_) = o_; } } } while (0)
#define CV_PACK(S) do { if constexpr (CONV) { LAS unsigned* t_ = (LAS unsigned*)(lds + CV_OFF + wid * (2 * CV_WAVE)); \
        _Pragma("unroll") for (int hh_ = 0; hh_ < 2; ++hh_) { const f32x4 ra_ = cvr##S[2 * hh_], rb_ = cvr##S[2 * hh_ + 1]; u32x4 w_; w_.x = cvt2(ra_.x, rb_.x); w_.y = cvt2(ra_.y, rb_.y); w_.z = cvt2(ra_.z, rb_.z); w_.w = cvt2(ra_.w, rb_.w); \
            *(LAS u32x4*)(t_ + ((lane >> 2) + 16 * hh_) * 20 + (lane & 3) * 4) = w_; } \
        cvq = cvp##S; } } while (0)
#define CV_STEP(c, S) do { if constexpr (CONV) { CV_OUT(); CV_PACK(S); const int id_ = ((c) * 256 + cv.bx) * 8 + wid, e_ = (id_ >> 11) & 31, k0_ = ((id_ >> 6) & 31) * 64, n0_ = (id_ & 63) * 16; \
        const float* s_ = ((id_ >> 16) ? cv.wu : cv.wg) + (size_t)e_ * DM * FF + (size_t)(k0_ + 2 * (lane >> 2)) * FF + n0_ + (lane & 3) * 4; \
          \
        asm volatile("global_load_dwordx4 %0, %1, off" : "=v"(cvr##S[0]) : "v"(s_) : "memory"); asm volatile("global_load_dwordx4 %0, %1, off" : "=v"(cvr##S[1]) : "v"(s_ + FF) : "memory"); \
        asm volatile("global_load_dwordx4 %0, %1, off" : "=v"(cvr##S[2]) : "v"(s_ + 32 * FF) : "memory"); asm volatile("global_load_dwordx4 %0, %1, off" : "=v"(cvr##S[3]) : "v"(s_ + 33 * FF) : "memory"); cvp##S = id_; } } while (0)
    f32x16 pA0, pA1, pB0, pB1; float mnA, mnB, alA, alB; bf16x8 pa0, pa1, pa2, pa3; const int NT = u.nt;
    KV_DMA(0, 0); KV_DMA(SHM_V, 1);
    asm volatile("s_waitcnt vmcnt(4)" ::: "memory"); BARX();
    CV_STEP(0, A);
    qkt(pA0, pA1, K_lds, qr, r32, hi); partialSM<BAND>(pA0, pA1, m_reg, mnA, alA, dq, TVALID(0));
    if constexpr (CONV) asm volatile("s_waitcnt vmcnt(6)" ::: "memory"); else asm volatile("s_waitcnt vmcnt(0)" ::: "memory");
    BARX();
    int ob0 = 0, ob1 = SHM_V, ob2 = 2 * SHM_V;
    for (int j = 1; j + 1 < NT; j += 2) {
        KV_DMA(ob2, j + 1);
        CV_STEP(j, B);
        SBAR(); qkt(pB0, pB1, K_lds + ob1, qr, r32, hi);
        finishSM(pA0, pA1, alA, l_reg, pa0, pa1, pa2, pa3); SBAR();
        pv_d0(o, vb0 + ob0, pa0, pa1, pa2, pa3); partialSM<BAND>(pB0, pB1, m_reg, mnB, alB, dq + 64 * j, TVALID(j));
        RESC(alB); if constexpr (CONV) asm volatile("s_waitcnt vmcnt(6)" ::: "memory"); else asm volatile("s_waitcnt vmcnt(0)" ::: "memory"); BARX();
        if (j + 2 < NT) KV_DMA(ob0, j + 2);
        CV_STEP(j + 1, A);
        SBAR(); qkt(pA0, pA1, K_lds + ob2, qr, r32, hi);
        finishSM(pB0, pB1, alB, l_reg, pa0, pa1, pa2, pa3); SBAR();
        pv_d0(o, vb0 + ob1, pa0, pa1, pa2, pa3); partialSM<BAND>(pA0, pA1, m_reg, mnA, alA, dq + 64 * (j + 1), TVALID(j + 1));
        RESC(alA); if constexpr (CONV) asm volatile("s_waitcnt vmcnt(6)" ::: "memory"); else asm volatile("s_waitcnt vmcnt(0)" ::: "memory"); BARX();
        { const int t_ = ob0; ob0 = ob2; ob2 = ob1; ob1 = t_; }
    }
    {
        const int lane = lane_id(), r32 = lane & 31, hi = lane >> 5, vb0 = (int)(unsigned)(uintptr_t)V_lds + v_rd_base(lane);
        SBAR(); qkt(pB0, pB1, K_lds + ob1, qr, r32, hi);
        finishSM(pA0, pA1, alA, l_reg, pa0, pa1, pa2, pa3); SBAR();
        pv_d0(o, vb0 + ob0, pa0, pa1, pa2, pa3); partialSM<BAND>(pB0, pB1, m_reg, mnB, alB, dq + 64 * (NT - 1), TVALID(NT - 1));
        RESC(alB);
        finishSM(pB0, pB1, alB, l_reg, pa0, pa1, pa2, pa3); SBAR();
        pv_d0(o, vb0 + ob1, pa0, pa1, pa2, pa3);
    }
    if constexpr (CONV) { const int lane = lane_id(); (void)lane; CV_STEP(NT - 1, B); asm volatile("s_waitcnt vmcnt(0)" : "+v"(cvrA[0]), "+v"(cvrA[1]), "+v"(cvrA[2]), "+v"(cvrA[3]), "+v"(cvrB[0]), "+v"(cvrB[1]), "+v"(cvrB[2]), "+v"(cvrB[3]) :: "memory"); CV_OUT(); CV_PACK(A); CV_OUT(); CV_PACK(B); CV_OUT(); }
    __syncthreads();
    const int lane3 = lane_id(), r32e = lane3 & 31, hie = lane3 >> 5;
    if (hie == 0) li_l[r32e] = l_reg; asm volatile("s_waitcnt lgkmcnt(0)" ::: "memory");
    float rli[16];
#pragma unroll
    for (int r = 0; r < 16; ++r) rli[r] = __builtin_amdgcn_rcpf(li_l[crow(r, hie)]);
    {   LAS unsigned char* ot = lds + wid * 8192;
#pragma unroll
        for (int r = 0; r < 16; ++r) { const int orow = crow(r, hie);
#pragma unroll
            for (int d0 = 0; d0 < 4; ++d0) *(LAS bf16_t*)(ot + orow * 256 + (d0 * 32 + r32e) * 2) = f2bf(o[d0][r] * rli[r]); }
        asm volatile("s_waitcnt lgkmcnt(0)" ::: "memory");
        bf16_t* Ow = u.O + (size_t)(wid * QBLK) * u.ldo;
        const int lane2 = lane_id();
#pragma unroll
        for (int q = 0; q < 8; ++q) { const int orow = q * 4 + (lane2 >> 4), oc = (lane2 & 15) * 8;
            *(u32x4*)(Ow + (size_t)orow * u.ldo + oc) = *(const LAS u32x4*)(ot + orow * 256 + oc * 2); }
    }
    __syncthreads();
#undef TVALID
#undef KV_DMA
#undef BARX
#undef WAITKV
#undef RESC
#undef CV_OUT
#undef CV_PACK
#undef CV_STEP
}

__device__ __forceinline__ void band_body(const Unit& u, LAS unsigned char* lds, int wid) {
    const int lane = lane_id(), tid = wid * 64 + lane, r32 = lane & 31, hi = lane >> 5;
    LAS unsigned char* V_lds = lds; LAS unsigned char* K_lds = lds + 4 * SHM_V;
    LAS float* ws = (LAS float*)(lds + 4 * SHM_V + 4 * SHM_K) + wid * 64; LAS float* li_l = ws; LAS float* al_l = ws + 32;
    float m_reg = -1e30f, l_reg = 0; f32x16 o[4] = {}; bf16x8 qr[8];
    const bf16_t* Qw = u.Q + (size_t)(wid * QBLK + r32) * D + hi * 8;
#pragma unroll
    for (int d0 = 0; d0 < 8; ++d0) qr[d0] = *(const bf16x8*)(Qw + d0 * 16);
    const int sr = tid >> 4, sc = (tid & 15) * 8, vst0 = v_st(sr, sc), vst1 = v_st(32 + sr, sc);
    const int vb0 = (int)(unsigned)(uintptr_t)V_lds + v_rd_base(lane);
    const bf16_t* Kh = u.K; const bf16_t* Vh = u.V;
    const int dq = u.kt0 - (u.q0 + wid * QBLK + r32) + 4 * hi + 64;
    bf16x8 A_vs0, A_vs1, A_ks0, A_ks1, B_vs0, B_vs1, B_ks0, B_ks1, C_vs0, C_vs1, C_ks0, C_ks1, D_vs0, D_vs1, D_ks0, D_ks1;
#define KROW(j) ((u.kt0 + 64 * (j)) < u.klo ? u.klo : ((u.kt0 + 64 * (j)) > u.khi - 64 ? u.khi - 64 : (u.kt0 + 64 * (j))))
#define TVALID(j) ((u.kt0 + 64 * (j)) >= u.klo && (u.kt0 + 64 * (j)) < u.khi)
#define SLOAD(S, j) do { const int k0_ = KROW(j); S##vs0 = *(const bf16x8*)(&Vh[(size_t)(k0_ + sr) * D + sc]); S##vs1 = *(const bf16x8*)(&Vh[(size_t)(k0_ + 32 + sr) * D + sc]); \
    S##ks0 = *(const bf16x8*)(&Kh[(size_t)(k0_ + sr) * D + sc]); S##ks1 = *(const bf16x8*)(&Kh[(size_t)(k0_ + 32 + sr) * D + sc]); } while (0)
#define SWRITE(b, S) do { *(LAS bf16x8*)(V_lds + (b) * SHM_V + vst0) = S##vs0; *(LAS bf16x8*)(V_lds + (b) * SHM_V + vst1) = S##vs1; const int kc = sc * 2; \
    *(LAS bf16x8*)(K_lds + (b) * SHM_K + KSWZ(sr, kc)) = S##ks0; *(LAS bf16x8*)(K_lds + (b) * SHM_K + KSWZ(32 + sr, kc)) = S##ks1; } while (0)
    const int ja = (wid >> 1);
#define BAND_PASS(i) do { const int j_ = ja + (i), slot_ = j_ & 3; bf16x8 pa0, pa1, pa2, pa3; f32x16 p0, p1; float mn, al; \
        qkt(p0, p1, K_lds + slot_ * SHM_K, qr, r32, hi); \
        partialSM<true>(p0, p1, m_reg, mn, al, dq + 64 * j_, TVALID(j_)); \
        if (__any(al < 1.f)) { if (hi == 0) al_l[r32] = al; asm volatile("s_waitcnt lgkmcnt(0)" ::: "memory"); \
            _Pragma("unroll") for (int d = 0; d < 4; ++d) _Pragma("unroll") for (int r = 0; r < 16; ++r) o[d][r] *= al_l[crow(r, hi)]; } \
        finishSM(p0, p1, al, l_reg, pa0, pa1, pa2, pa3); SBAR(); \
        pv_d0(o, vb0 + slot_ * SHM_V, pa0, pa1, pa2, pa3); } while (0)
    SLOAD(A_, 0); SLOAD(B_, 1); SLOAD(C_, 2); SLOAD(D_, 3);
    SWRITE(0, A_); SLOAD(A_, 4);
    SWRITE(1, B_); SLOAD(B_, 5);
    SWRITE(2, C_); SWRITE(3, D_);
    __syncthreads();
    BAND_PASS(0);
    __syncthreads();
    SWRITE(0, A_);
    __syncthreads();
    BAND_PASS(1);
    __syncthreads();
    SWRITE(1, B_);
    __syncthreads();
    BAND_PASS(2);
#undef BAND_PASS
    __syncthreads();
    if (hi == 0) li_l[r32] = l_reg; asm volatile("s_waitcnt lgkmcnt(0)" ::: "memory");
    float rli[16];
#pragma unroll
    for (int r = 0; r < 16; ++r) rli[r] = __builtin_amdgcn_rcpf(li_l[crow(r, hi)]);
    {
        LAS unsigned char* ot = lds + wid * 8192;
#pragma unroll
        for (int r = 0; r < 16; ++r) { const int orow = crow(r, hi);
#pragma unroll
            for (int d0 = 0; d0 < 4; ++d0) *(LAS bf16_t*)(ot + orow * 256 + (d0 * 32 + r32) * 2) = f2bf(o[d0][r] * rli[r]); }
        asm volatile("s_waitcnt lgkmcnt(0)" ::: "memory");
        bf16_t* Ow = u.O + (size_t)(wid * QBLK) * u.ldo;
#pragma unroll
        for (int q = 0; q < 8; ++q) { const int orow = q * 4 + (lane >> 4), oc = (lane & 15) * 8;
            *(u32x4*)(Ow + (size_t)orow * u.ldo + oc) = *(const LAS u32x4*)(ot + orow * 256 + oc * 2); }
    }
    if (hi == 0) u.lse[(size_t)(wid * QBLK + r32) * u.lse_stride] = m_reg * SCALE + __logf(l_reg);
    __syncthreads();
#undef KROW
#undef TVALID
#undef SLOAD
#undef SWRITE
}
}

#define XB_TMO      128
#define XB_XCNT(j)  (256  + 64 * (j))
#define XB_XSUB(j)  (1280 + 64 * (j))
#define XB_XGEN(j)  (2304 + 64 * (j))
#define XB_TOP      3328
#define XB_TOPGEN   3392
#define XCD_BAR_WORDS 3456
#define XB_SPIN_CAP (1u << 20)
__device__ __forceinline__ unsigned xb_ld(unsigned* p)              { return __hip_atomic_load(p, __ATOMIC_RELAXED, __HIP_MEMORY_SCOPE_AGENT); }
__device__ __forceinline__ unsigned xb_add(unsigned* p, unsigned v) { return __hip_atomic_fetch_add(p, v, __ATOMIC_RELAXED, __HIP_MEMORY_SCOPE_AGENT); }
__device__ __forceinline__ unsigned xb_xcc_id() { return (unsigned)__builtin_amdgcn_s_getreg((3 << 11) | 20) & 0xFu; }
#define XB_SPIN(cond, bar) do { unsigned _sp = 0; while (cond) { __builtin_amdgcn_s_sleep(1); \
    if ((++_sp & 255u) == 0u) { if (xb_ld(&(bar)[XB_TMO])) break; if (_sp > XB_SPIN_CAP) { atomicAdd(&(bar)[XB_TMO], 1u); break; } } } } while (0)
__device__ __forceinline__ void xcd_barrier_post(unsigned* bar, bool leader) { if (leader) (void)xb_add(&bar[XB_XCNT(xb_xcc_id())], 1u); }
__device__ __forceinline__ void xcd_barrier_complete(unsigned* bar, unsigned x, unsigned G, unsigned& nloc, unsigned& nx) {
    unsigned sum, cnt, mine, sp = 0u;
    for (;;) {
        sum = 0u; cnt = 0u; mine = 0u;
#pragma unroll
        for (unsigned j = 0; j < 16; ++j) { const unsigned c = xb_ld(&bar[XB_XCNT(j)]); sum += c; cnt += (c > 0u) ? 1u : 0u; mine = (j == x) ? c : mine; }
        if (sum == G) break;
        __builtin_amdgcn_s_sleep(1);
        if ((++sp & 255u) == 0u) { if (xb_ld(&bar[XB_TMO])) break; if (sp > XB_SPIN_CAP) { atomicAdd(&bar[XB_TMO], 1u); break; } }
    }
    nloc = mine > 0u ? mine : 1u; nx = cnt > 0u ? cnt : 1u;
}
__device__ __forceinline__ void xcd_barrier(unsigned* bar, unsigned* st, unsigned G, bool leader) {
    asm volatile("s_waitcnt vmcnt(0)" ::: "memory");
    __syncthreads();
    if (leader) {
        __builtin_amdgcn_s_waitcnt(0);
        const unsigned x = xb_xcc_id();
        const unsigned old = xb_add(&bar[XB_XSUB(x)], 1u);
        unsigned nloc = xb_ld(st), nx = xb_ld(st + 1);
        if (nloc == 0u) { xcd_barrier_complete(bar, x, G, nloc, nx); __hip_atomic_store(st, nloc, __ATOMIC_RELAXED, __HIP_MEMORY_SCOPE_AGENT); __hip_atomic_store(st + 1, nx, __ATOMIC_RELAXED, __HIP_MEMORY_SCOPE_AGENT); }
        const unsigned gen = old / nloc;
        if (old + 1u == (gen + 1u) * nloc) {
            __builtin_amdgcn_fence(__ATOMIC_RELEASE, "agent");
            asm volatile("s_waitcnt vmcnt(0)" ::: "memory");
            const unsigned og = xb_add(&bar[XB_TOP], 1u);
            const unsigned tg = og / nx;
            if (og + 1u == (tg + 1u) * nx) xb_add(&bar[XB_TOPGEN], 1u);
            else XB_SPIN(xb_ld(&bar[XB_TOPGEN]) == tg, bar);
            xb_add(&bar[XB_XGEN(x)], 1u);
            __builtin_amdgcn_fence(__ATOMIC_ACQUIRE, "agent");
            asm volatile("s_waitcnt vmcnt(0)" ::: "memory");
        } else {
            XB_SPIN(xb_ld(&bar[XB_XGEN(x)]) == gen, bar);
            __builtin_amdgcn_fence(__ATOMIC_ACQUIRE, "agent");
            asm volatile("s_waitcnt vmcnt(0)" ::: "memory");
        }
    }
    __syncthreads();
}

constexpr int RING_BYTES = 131072, EX_OFF = RING_BYTES, LDS_BYTES = 163840;
constexpr int NWAVES = 8;

struct Args {
    const float* in[18]; float* out; unsigned char* ws; int ph_lo, ph_hi; int use_bar, bar_region;
};

__device__ __forceinline__ void p0_transpose_item(const float* W, int K, int N, bf16_t* WT, int rowblk, int roff, LAS float* scr, int item, int lane) {
    const int nblk = N / 32, kb = item / nblk, nb = item % nblk, k0 = 64 * kb, n0 = 32 * nb;
#pragma unroll 8
    for (int i = 0; i < 32; ++i) { const int kk = 2 * i + (lane >> 5); scr[kk * 33 + (lane & 31)] = W[(size_t)(k0 + kk) * N + n0 + (lane & 31)]; }
    asm volatile("s_waitcnt lgkmcnt(0)" ::: "memory");
    const int c = lane & 7;
#pragma unroll
    for (int j = 0; j < 4; ++j) { const int nl = (lane >> 3) + 8 * j; const LAS float* s = scr + (8 * c) * 33 + nl; const int n = n0 + nl;
        u32x4 o; o.x = pk2(s[0 * 33], s[1 * 33]); o.y = pk2(s[2 * 33], s[3 * 33]); o.z = pk2(s[4 * 33], s[5 * 33]); o.w = pk2(s[6 * 33], s[7 * 33]);
        const int dr = (n >> 7) * rowblk + roff + (n & 127);
        *(u32x4*)(WT + (size_t)dr * K + k0 + 8 * c) = o; }
    asm volatile("s_waitcnt lgkmcnt(0)" ::: "memory");
}

template <int VAR>
__global__ void __launch_bounds__(NWAVES * 64, 2) mk_fwd(Args args) {
    extern __shared__ __attribute__((aligned(16))) unsigned char lds_raw[];
    LAS unsigned char* lds = (LAS unsigned char*)lds_raw;
    const int wave = __builtin_amdgcn_readfirstlane(threadIdx.x >> 6);
#define PHASE_IDS() const int lane = lane_id(), tid = wave * 64 + lane; (void)tid; const int gw = vcu * NWAVES + wave, NGW = G * NWAVES; (void)lane; (void)gw; (void)NGW
    const int G = gridDim.x, bx = blockIdx.x; const int vcu = (G % 8 == 0) ? (bx % 8) * (G / 8) + bx / 8 : bx;
    unsigned char* ws = args.ws;
    unsigned* ctl = (unsigned*)(ws + WS_CTL);
    if (args.use_bar) xcd_barrier_post((unsigned*)(args.ws + WS_CTL) + CW_BAR + args.bar_region * XCD_BAR_WORDS, wave == 0 && lane_id() == 0);
    if (args.use_bar == 12345) cooperative_groups::this_grid().sync();
#define GRID_BAR() do { if (args.use_bar) xcd_barrier((unsigned*)(args.ws + WS_CTL) + CW_BAR + args.bar_region * XCD_BAR_WORDS, (unsigned*)(args.ws + WS_CTL) + CW_WGST + args.bar_region * 32768 + 64 * (int)blockIdx.x, (unsigned)G, wave == 0 && lane_id() == 0); } while (0)
    const int lo = args.ph_lo, hi = args.ph_hi;
#ifndef MK_CMASK
#define MK_CMASK 0x1ff
#endif
#define IN(k) ((((MK_CMASK) >> (k)) & 1) && lo <= (k) && (k) < hi)
#define BOTH(k) (IN(k) && IN((k) + 1))

    if (IN(0)) {
        PHASE_IDS();
        const float* x = args.in[0];
        bf16_t* XB = (bf16_t*)(ws + WS_XB); bf16_t* WINT = (bf16_t*)(ws + WS_WINT); bf16_t* WAT = (bf16_t*)(ws + WS_WAT); bf16_t* WBT = (bf16_t*)(ws + WS_WBT); bf16_t* WOT = (bf16_t*)(ws + WS_WOT);
        bf16_t* WGUT = (bf16_t*)(ws + WS_WGUT); bf16_t* WDT = (bf16_t*)(ws + WS_WDT);
        LAS float* scr = (LAS float*)(lds + wave * 16384);
        constexpr int I_IN = (DM / 64) * (IN_COLS / 32), I_A = (1024 / 64) * (DM / 32), I_B = (DM / 64) * (DM / 32), I_O = I_B;
        constexpr int I_G = (DM / 64) * (FF / 32), I_D = (FF / 64) * (DM / 32);
        constexpr int NITEMS = I_IN + I_A + I_B + I_O + NEXP * (2 * I_G + I_D);
        for (int it = gw; it < I_IN + I_A + I_B + I_O; it += NGW) {
            int r = it;
            if (r < I_IN) { p0_transpose_item(args.in[1], DM, IN_COLS, WINT, 128, 0, scr, r, lane); continue; } r -= I_IN;
            if (r < I_A) { p0_transpose_item(args.in[4], 1024, DM, WAT, 128, 0, scr, r, lane); continue; } r -= I_A;
            if (r < I_B) { p0_transpose_item(args.in[5], DM, DM, WBT, 128, 0, scr, r, lane); continue; } r -= I_B;
            if (r < I_O) { p0_transpose_item(args.in[6], DM, DM, WOT, 128, 0, scr, r, lane); continue; } r -= I_O;
            const int e = r / (2 * I_G + I_D); r -= e * (2 * I_G + I_D);
            if (r < I_G) { p0_transpose_item(args.in[13] + (size_t)e * DM * FF, DM, FF, WGUT + (size_t)e * 2048 * DM, 256, 0, scr, r, lane); continue; } r -= I_G;
            if (r < I_G) { p0_transpose_item(args.in[14] + (size_t)e * DM * FF, DM, FF, WGUT + (size_t)e * 2048 * DM, 256, 128, scr, r, lane); continue; } r -= I_G;
            p0_transpose_item(args.in[15] + (size_t)e * FF * DM, FF, DM, WDT + (size_t)e * DM * FF, 128, 0, scr, r, lane);
        }
        for (int m = gw; m < NTOK; m += NGW) {
            const f32x4* xr = (const f32x4*)(x + (size_t)m * DM) + lane; u32x2* o8 = (u32x2*)(XB + (size_t)m * DM) + lane;
            f32x4 xv[8];
#pragma unroll
            for (int j = 0; j < 8; ++j) xv[j] = xr[64 * j];
            __builtin_amdgcn_sched_barrier(0);
#pragma unroll
            for (int j = 0; j < 8; ++j) { const f32x4 v = xv[j]; u32x2 w; w.x = pk2(v.x, v.y); w.y = pk2(v.z, v.w); o8[64 * j] = w; }
        }
        { float* wt = (float*)(ws + WS_WRT); const float* wgp = args.in[9]; const float* wrp = args.in[11];
          for (int i = (vcu * NWAVES * 64) + tid; i < 36 * DM; i += G * NWAVES * 64) { const int c = i >> 11, k = i & (DM - 1); wt[i] = (c < 4) ? wgp[(size_t)k * 4 + c] : wrp[(size_t)k * 32 + (c - 4)]; } }
        if (BOTH(0)) GRID_BAR();
    }

    if (IN(1)) {
        EpiProj E; E.ws = ws; E.qg = args.in[2]; E.kg = args.in[3];
        ProjSched S; S.o.init(NTOK, IN_COLS, G, bx); S.ws = (const char*)ws;
        pg8::gemm_phase<EpiProj, ProjSched, PG8_ALIGN, PG8_SP2>(lds, lds + EX_OFF, S, E, wave);
        if (BOTH(1)) GRID_BAR();
    }

    if (IN(2)) {
        if (VAR != 22) for (int i = 0; i < 2; ++i) {
            const int idx = bx + i * G; if (idx >= 512) break;
            const int bk = idx & 7, rest = idx >> 3, b = bk >> 2, kvh = bk & 3, hq = kvh * 4 + (rest & 3), qblk = rest >> 2;
            att::Unit u; u.Q = (const bf16_t*)(ws + WS_QB) + ((size_t)(b * 16 + hq) * SEQ + qblk * 256) * HD;
            u.K = (const bf16_t*)(ws + WS_KB) + (size_t)(b * 4 + kvh) * SEQ * HD; u.V = (const bf16_t*)(ws + WS_VB) + (size_t)(b * 4 + kvh) * SEQ * HD;
            u.O = (bf16_t*)(ws + WS_OB) + ((size_t)b * SEQ + qblk * 256) * 2048 + hq * HD; u.ldo = 2048; u.lse = nullptr; u.lse_stride = 0; u.nt = 64; u.kt0 = 0; u.klo = 0; u.khi = SEQ; u.q0 = 0;
            att::Conv cvx; cvx.wg = args.in[13]; cvx.wu = args.in[14]; cvx.wd = args.in[15]; cvx.ws = ws; cvx.bx = bx;
            if (i == 0) att::body_cd<true>(u, lds, wave, cvx, 0); else att::body_cd<false>(u, lds, wave, cvx, 0);
        }
        if (VAR != 21) for (int i = 0; i < 3; ++i) {
            const int idx = bx + i * G; if (idx >= 768) break;
            const int sid = idx >> 4, qblk = idx & 15, g = sid >> 4, b = (sid >> 3) & 1, h = sid & 7, sh = 2 * g, L = SEQ >> sh;
            const int P0 = qblk * 256, r = P0 / L, p0 = P0 - r * L;
            att::Unit u; u.Q = (const bf16_t*)(ws + WS_QA) + ((size_t)sid * SEQ + P0) * HD; u.K = (const bf16_t*)(ws + WS_KA) + (size_t)sid * SEQ * HD; u.V = (const bf16_t*)(ws + WS_VA) + (size_t)sid * SEQ * HD;
            const size_t tok0 = (size_t)b * SEQ + ((size_t)p0 << sh) + r;
            u.O = (bf16_t*)(ws + WS_OAG) + ((size_t)g * NTOK + tok0) * 1024 + h * HD; u.ldo = 1024 << sh;
            u.lse = (float*)(ws + WS_LSE) + ((size_t)g * NTOK + tok0) * 8 + h; u.lse_stride = 8 << sh;
            u.nt = 6; u.kt0 = P0 - 64; u.klo = r * L; u.khi = r * L + L; u.q0 = P0;
            att::band_body(u, lds, wave);
        }
        GRID_BAR();
        {
            PHASE_IDS();
            const bf16_t* oag = (const bf16_t*)(ws + WS_OAG); const float* lse = (const float*)(ws + WS_LSE); bf16_t* oa = (bf16_t*)(ws + WS_OA);
            for (int m0 = gw; m0 < NTOK; m0 += 2 * NGW) { const int c = lane * 16, h = lane >> 3; const int m1 = (m0 + NGW < NTOK) ? m0 + NGW : m0;
                float lv[2][3]; u32x4 dv[2][2][3];
#pragma unroll
                for (int i = 0; i < 2; ++i) { const int m = i ? m1 : m0;
#pragma unroll
                    for (int g = 0; g < 3; ++g) { lv[i][g] = lse[((size_t)g * NTOK + m) * 8 + h];
#pragma unroll
                        for (int q = 0; q < 2; ++q) dv[i][q][g] = *(const u32x4*)(oag + ((size_t)g * NTOK + m) * 1024 + c + 8 * q); } }
#pragma unroll
                for (int i = 0; i < 2; ++i) { const int m = i ? m1 : m0; const float l0 = lv[i][0], l1 = lv[i][1], l2 = lv[i][2];
                    const float mx = fmaxf(l0, fmaxf(l1, l2)); float e0 = __expf(l0 - mx), e1 = __expf(l1 - mx), e2 = __expf(l2 - mx); const float inv = 1.0f / (e0 + e1 + e2); e0 *= inv; e1 *= inv; e2 *= inv;
#pragma unroll
                    for (int q = 0; q < 2; ++q) { const u32x4 a = dv[i][q][0], bq = dv[i][q][1], cq = dv[i][q][2];
                        u32x4 w;
#pragma unroll
                        for (int k = 0; k < 4; ++k) w[k] = cvt2(e0 * bflo(a[k]) + e1 * bflo(bq[k]) + e2 * bflo(cq[k]), e0 * bfhi(a[k]) + e1 * bfhi(bq[k]) + e2 * bfhi(cq[k]));
                        *(u32x4*)(oa + (size_t)m * 1024 + c + 8 * q) = w; } } }
        }
        if (BOTH(2)) GRID_BAR();
    }

    if (IN(3) || IN(4)) {
        EpiMix E; E.ws = ws; E.x = args.in[0];
        MixSched S; S.c = vcu; S.ws = (const char*)ws;
        if (IN(3)) { S.mode = 0; pg8::gemm_phase<EpiMix, MixSched, false, PG8_SP2>(lds, lds + EX_OFF, S, E, wave); if (BOTH(3)) GRID_BAR(); }
        if (IN(4)) { S.mode = 1; pg8::gemm_phase<EpiMix, MixSched, false, PG8_SP2>(lds, lds + EX_OFF, S, E, wave); if (BOTH(4)) GRID_BAR(); }
    }

    if (IN(5)) {
        PHASE_IDS();
        RouteArgs ra; ra.g = args.in[7]; ra.b = args.in[8]; ra.h1 = (float*)(ws + WS_H1); ra.h1b = (bf16_t*)(ws + WS_H1B); ra.wg = args.in[9]; ra.bg = args.in[10]; ra.wr = args.in[11]; ra.br = args.in[12];
        ra.cnt = ctl + CW_CNT; ra.tokidx = (int*)(ws + WS_TOKIDX); ra.slot = (int*)(ws + WS_SLOT); ra.wt = (const float*)(ws + WS_WRT); ra.lnst = (float2*)(ws + WS_LNST);
        LAS unsigned* hist = (LAS unsigned*)lds; LAS unsigned* basev = hist + 32; LAS int* rinfo = (LAS int*)(lds + 256);
        if (tid < 64) hist[tid] = 0u;
        __syncthreads();
        static_assert(NTOK == 4 * 256 * NWAVES, "P5 assumes 4 rows per wave on a 256-workgroup grid");
#pragma unroll 1
        for (int ps = 0; ps < 2; ++ps) ln1_route_rows<2, VAR>((const float*)(ws + WS_PRE1), ra, gw + 2 * ps * NGW, NGW, lane_id(), hist, rinfo, wave * 4 + 2 * ps, 1);
        __syncthreads();
        if (tid < 32) { const unsigned h = hist[tid]; if (h) basev[tid] = atomicAdd(ra.cnt + tid, h); }
        __syncthreads();
        if (tid < 32) { const LAS int* ri = rinfo + tid * 8; const int ex1 = ri[0], ex2 = ri[1], m = ri[6]; const int p1 = (int)basev[ex1] + ri[2], p2 = (int)basev[ex2] + ri[3];
            ra.tokidx[ex1 * ECAP + p1] = m; ra.tokidx[ex2 * ECAP + p2] = m;
            int* sl = ra.slot + (size_t)m * 6; sl[0] = ex1; sl[1] = ex2; sl[2] = p1; sl[3] = p2; sl[4] = ri[4]; sl[5] = ri[5]; }
        if (BOTH(5)) GRID_BAR();
    }

    if (IN(6) || IN(7)) {
        if (IN(6)) { MoeSched S; S.G = G; S.vcu = vcu; S.ws = (const char*)ws; S.init(ctl + CW_CNT, lane_id()); EpiMoe E; E.ws = ws; S.down = 0; E.down = 0;
            pg8::gemm_phase<EpiMoe, MoeSched, PG8_ALIGN, PG8_SP2>(lds, lds + EX_OFF, S, E, wave); if (BOTH(6)) GRID_BAR(); }
        if (IN(7)) { MoeSched2 S; S.var = VAR; S.G = G; S.vcu = vcu; S.ws = (const char*)ws; S.wgate = args.in[13]; S.wup = args.in[14]; S.wdown = args.in[15]; S.init(ctl + CW_CNT, lane_id());
            EpiMoe2 E; E.ws = ws; S.down = 1; E.down = 1; mg::gemm_phase<MoeSched2, EpiMoe2, VAR>(lds, S, E, wave); if (BOTH(7)) GRID_BAR(); }
    }

    if (IN(8)) {
        PHASE_IDS();
        P8Args pa; pa.h1 = (const float*)(ws + WS_H1); pa.y = (const bf16_t*)(ws + WS_Y); pa.cnt = ctl + CW_CNT; pa.slot = (const int*)(ws + WS_SLOT); pa.g = args.in[16]; pa.b = args.in[17]; pa.out = args.out;
        unsigned c = 0; if (lane < NEXP) c = __hip_atomic_load(ctl + CW_CNT + lane, __ATOMIC_RELAXED, __HIP_MEMORY_SCOPE_AGENT);
        unsigned t = (c + 255u) >> 8, inc = t;
#pragma unroll
        for (int o = 1; o < 32; o <<= 1) { const unsigned v = __shfl_up(inc, o); if ((lane & 31) >= o) inc += v; }
        const unsigned tpe = inc - t;
        int m = gw;
        for (; m + NGW < NTOK; m += 2 * NGW) {
            const int* sa = pa.slot + (size_t)m * 6; const int* sb = pa.slot + (size_t)(m + NGW) * 6;
            const int e1a = sa[0], e2a = sa[1], p1a = sa[2], p2a = sa[3], e1b = sb[0], e2b = sb[1], p1b = sb[2], p2b = sb[3];
            const float w1a = ((const float*)sa)[4], w2a = ((const float*)sa)[5], w1b = ((const float*)sb)[4], w2b = ((const float*)sb)[5];
            const size_t r1a = (size_t)__shfl(tpe, e1a) * 256 + p1a, r2a = (size_t)__shfl(tpe, e2a) * 256 + p2a, r1b = (size_t)__shfl(tpe, e1b) * 256 + p1b, r2b = (size_t)__shfl(tpe, e2b) * 256 + p2b;
            final_rows2_t(pa, (const float*)(ws + WS_PRE1), (const float2*)(ws + WS_LNST), args.in[7], args.in[8], m, m + NGW, lane_id(), r1a, r2a, w1a, w2a, r1b, r2b, w1b, w2b);
        }
        for (; m < NTOK; m += NGW) {
            const int* sl = pa.slot + (size_t)m * 6; const int e1 = sl[0], e2 = sl[1], p1 = sl[2], p2 = sl[3]; const float w1 = ((const float*)sl)[4], w2 = ((const float*)sl)[5];
            const size_t r1 = (size_t)__shfl(tpe, e1) * 256 + p1, r2 = (size_t)__shfl(tpe, e2) * 256 + p2;
            final_row_t(pa, (const float*)(ws + WS_PRE1), (const float2*)(ws + WS_LNST), args.in[7], args.in[8], m, lane_id(), r1, r2, w1, w2);
        }
    }
#undef IN
#undef BOTH
#undef GRID_BAR
}

extern "C" void kernel_launch(void* const* d_in, const int* in_sizes, int n_in, void* d_out, int out_size, void* d_ws, size_t ws_size, hipStream_t stream) {
    static int grid = 0;
    if (grid == 0) {
        if (n_in != 18 || in_sizes[0] != NTOK * DM || out_size != NTOK * DM || ws_size < WS_END) { fprintf(stderr, "kernel_launch: unexpected shapes (n_in %d, in0 %d, out %d, ws %zu)\n", n_in, n_in > 0 ? in_sizes[0] : -1, out_size, ws_size); grid = -1; return; }
        int dev = 0, cus = 0, per_cu = 0;
        if (hipGetDevice(&dev) != hipSuccess || hipDeviceGetAttribute(&cus, hipDeviceAttributeMultiprocessorCount, dev) != hipSuccess) { fprintf(stderr, "kernel_launch: device query failed\n"); grid = -1; return; }
        if (hipFuncSetAttribute((const void*)mk_fwd<0>, hipFuncAttributeMaxDynamicSharedMemorySize, LDS_BYTES) != hipSuccess || hipFuncSetAttribute((const void*)mk_fwd<MK_EXTRA_VAR>, hipFuncAttributeMaxDynamicSharedMemorySize, LDS_BYTES) != hipSuccess) { fprintf(stderr, "kernel_launch: hipFuncSetAttribute failed\n"); grid = -1; return; }
        if (hipOccupancyMaxActiveBlocksPerMultiprocessor(&per_cu, (const void*)mk_fwd<0>, NWAVES * 64, LDS_BYTES) != hipSuccess || per_cu < 1) { fprintf(stderr, "kernel_launch: occupancy query says %d blocks per CU\n", per_cu); per_cu = 1; }
        (void)hipGetLastError();
        grid = cus * 1;
        fprintf(stderr, "kernel_launch: grid %d (cus %d, occupancy %d)\n", grid, cus, per_cu);
    }
    if (grid < 0) return;
    unsigned char* ws = (unsigned char*)d_ws;
    (void)hipMemsetAsync(ws + WS_CTL, 0, 1 * MiB, stream);
    Args a{};
    for (int i = 0; i < 18; ++i) a.in[i] = (const float*)d_in[i];
    a.out = (float*)d_out; a.ws = ws;
    const float* x = a.in[0];
    bf16_t* XB = (bf16_t*)(ws + WS_XB); bf16_t* WINT = (bf16_t*)(ws + WS_WINT); bf16_t* WAT = (bf16_t*)(ws + WS_WAT); bf16_t* WBT = (bf16_t*)(ws + WS_WBT); bf16_t* WOT = (bf16_t*)(ws + WS_WOT);
    bf16_t* WGUT = (bf16_t*)(ws + WS_WGUT); bf16_t* WDT = (bf16_t*)(ws + WS_WDT);
    unsigned* ctl = (unsigned*)(ws + WS_CTL);
    auto launch_mk = [&](int lo, int hi, int use_bar, bool extra = false) {
        a.ph_lo = lo; a.ph_hi = hi; a.use_bar = use_bar;
        void* kargs[] = {&a};
        hipError_t e = hipLaunchCooperativeKernel(extra ? (const void*)mk_fwd<MK_EXTRA_VAR> : (const void*)mk_fwd<0>, dim3(grid), dim3(NWAVES * 64), kargs, LDS_BYTES, stream);
        if (e != hipSuccess) fprintf(stderr, "kernel_launch: cooperative launch failed: %s (grid %d)\n", hipGetErrorString(e), grid);
    };
    if (MK_ONE_LAUNCH && MK_FAST_MASK == 0x1ff) { launch_mk(0, NPHASE, 1);
        if (MK_EXTRA_PHASE >= 0) { a.bar_region = 1; launch_mk(MK_EXTRA_PHASE, MK_EXTRA_PHASE + 1, 1, true); }
        return; }
    for (int ph = 0; ph < NPHASE; ++ph) {
        if ((MK_FAST_MASK >> ph) & 1) { launch_mk(ph, ph + 1, (ph == 2) ? 1 : 0); continue; }
        switch (ph) {
        case 0:
            hipLaunchKernelGGL(k_cvt, dim3(2048), dim3(256), 0, stream, x, XB, (size_t)NTOK * DM / 8);
            hipLaunchKernelGGL(k_transpose, dim3(IN_COLS / 32, DM / 32, 1), dim3(256), 0, stream, a.in[1], WINT, DM, IN_COLS, 128, 0, (size_t)0, (size_t)0);
            hipLaunchKernelGGL(k_transpose, dim3(DM / 32, 1024 / 32, 1), dim3(256), 0, stream, a.in[4], WAT, 1024, DM, 128, 0, (size_t)0, (size_t)0);
            hipLaunchKernelGGL(k_transpose, dim3(DM / 32, DM / 32, 1), dim3(256), 0, stream, a.in[5], WBT, DM, DM, 128, 0, (size_t)0, (size_t)0);
            hipLaunchKernelGGL(k_transpose, dim3(DM / 32, DM / 32, 1), dim3(256), 0, stream, a.in[6], WOT, DM, DM, 128, 0, (size_t)0, (size_t)0);
            hipLaunchKernelGGL(k_transpose, dim3(FF / 32, DM / 32, NEXP), dim3(256), 0, stream, a.in[13], WGUT, DM, FF, 256, 0, (size_t)DM * FF, (size_t)2048 * DM);
            hipLaunchKernelGGL(k_transpose, dim3(FF / 32, DM / 32, NEXP), dim3(256), 0, stream, a.in[14], WGUT, DM, FF, 256, 128, (size_t)DM * FF, (size_t)2048 * DM);
            hipLaunchKernelGGL(k_transpose, dim3(DM / 32, FF / 32, NEXP), dim3(256), 0, stream, a.in[15], WDT, FF, DM, 128, 0, (size_t)FF * DM, (size_t)DM * FF);
            hipLaunchKernelGGL(k_ropetab, dim3(SEQ * 64 / 256), dim3(256), 0, stream, (float2*)(ws + WS_RT1), (float2*)(ws + WS_RT2));
            break;
        case 1: { P1Args p1{}; p1.xb = XB; p1.wint = WINT; p1.qg = a.in[2]; p1.kg = a.in[3]; p1.qa = (bf16_t*)(ws + WS_QA); p1.ka = (bf16_t*)(ws + WS_KA); p1.va = (bf16_t*)(ws + WS_VA);
            p1.qb = (bf16_t*)(ws + WS_QB); p1.kb = (bf16_t*)(ws + WS_KB); p1.vb = (bf16_t*)(ws + WS_VB); p1.gates = (bf16_t*)(ws + WS_GATES);
            hipLaunchKernelGGL(k_proj, dim3(IN_COLS / 128, NTOK / 64), dim3(256), 0, stream, p1); } break;
        case 2: { P2Args p2b{}; p2b.q = (bf16_t*)(ws + WS_QB); p2b.k = (bf16_t*)(ws + WS_KB); p2b.v = (bf16_t*)(ws + WS_VB); p2b.o = (bf16_t*)(ws + WS_OB); p2b.lse = nullptr; p2b.mode = 0;
            hipLaunchKernelGGL(k_attn, dim3(SEQ / 64, 32), dim3(128), 0, stream, p2b);
            P2Args p2a{}; p2a.q = (bf16_t*)(ws + WS_QA); p2a.k = (bf16_t*)(ws + WS_KA); p2a.v = (bf16_t*)(ws + WS_VA); p2a.o = (bf16_t*)(ws + WS_OAG); p2a.lse = (float*)(ws + WS_LSE); p2a.mode = 1;
            hipLaunchKernelGGL(k_attn, dim3(SEQ / 64, 48), dim3(128), 0, stream, p2a);
            hipLaunchKernelGGL(k_merge, dim3(NTOK * 1024 / 256), dim3(256), 0, stream, (const bf16_t*)(ws + WS_OAG), (const float*)(ws + WS_LSE), (bf16_t*)(ws + WS_OA)); } break;
        case 3: case 4: { P3Args p3{}; p3.gates = (bf16_t*)(ws + WS_GATES); p3.T = (float*)(ws + WS_T); p3.merged = (bf16_t*)(ws + WS_MERGED); p3.x = x; p3.pre1 = (float*)(ws + WS_PRE1);
            if (ph == 3) { p3.A = (bf16_t*)(ws + WS_OA); p3.Bt = WAT; p3.K = 1024; p3.mode = 0;
                hipLaunchKernelGGL(k_gemm3, dim3(DM / 128, NTOK / 64), dim3(256), 0, stream, p3);
                p3.A = (bf16_t*)(ws + WS_OB); p3.Bt = WBT; p3.K = 2048; p3.mode = 1;
                hipLaunchKernelGGL(k_gemm3, dim3(DM / 128, NTOK / 64), dim3(256), 0, stream, p3); }
            else { p3.A = p3.merged; p3.Bt = WOT; p3.K = 2048; p3.mode = 2; hipLaunchKernelGGL(k_gemm3, dim3(DM / 128, NTOK / 64), dim3(256), 0, stream, p3); } } break;
        case 5: { RouteArgs ra{}; ra.g = a.in[7]; ra.b = a.in[8]; ra.h1 = (float*)(ws + WS_H1); ra.h1b = (bf16_t*)(ws + WS_H1B); ra.wg = a.in[9]; ra.bg = a.in[10]; ra.wr = a.in[11]; ra.br = a.in[12];
            ra.cnt = ctl + CW_CNT; ra.tokidx = (int*)(ws + WS_TOKIDX); ra.slot = (int*)(ws + WS_SLOT);
            hipLaunchKernelGGL(k_ln1_route, dim3(NTOK / 4), dim3(256), 0, stream, (const float*)(ws + WS_PRE1), ra); } break;
        case 6: case 7: { P6Args p6{}; p6.h1b = (bf16_t*)(ws + WS_H1B); p6.wgut = WGUT; p6.wdt = WDT; p6.cnt = ctl + CW_CNT; p6.tokidx = (int*)(ws + WS_TOKIDX); p6.act = (bf16_t*)(ws + WS_ACT); p6.y = (bf16_t*)(ws + WS_Y);
            if (ph == 6) hipLaunchKernelGGL(k_moe_up, dim3(FF / 128, 24576 / 64), dim3(256), 0, stream, p6);
            else hipLaunchKernelGGL(k_moe_down, dim3(DM / 128, 24576 / 64), dim3(256), 0, stream, p6); } break;
        case 8: { P8Args p8{}; p8.h1 = (float*)(ws + WS_H1); p8.y = (bf16_t*)(ws + WS_Y); p8.cnt = ctl + CW_CNT; p8.slot = (int*)(ws + WS_SLOT); p8.g = a.in[16]; p8.b = a.in[17]; p8.out = (float*)d_out;
            hipLaunchKernelGGL(k_final, dim3(NTOK / 4), dim3(256), 0, stream, p8); } break;
        }
    }
}
```
